# Optimizing an MI355X kernel written in HIP

```python
import math
import jax, jax.numpy as jnp
from jax import lax
import numpy as np

D_MODEL = 1024
BATCH = 32
SEQ = 2048
DEPTH = 1

CHUNK = 64
Q_BLOCK = 128
HEAD_DIM = 64
MIX_WIDTH = D_MODEL
A_WIDTH = MIX_WIDTH // 2
B_WIDTH = MIX_WIDTH - A_WIDTH
A_HEADS = A_WIDTH // HEAD_DIM
B_HEADS = B_WIDTH // HEAD_DIM
KV_LATENT = 128
IDX_HEADS = 4
IDX_DIM = 32
TOPK_MAX = 256
NUM_BUCKETS = 32
MAX_DISTANCE = 128
ROPE_BASE = 10000.0
RMS_EPS = 1e-6
GN_EPS = 1e-5
FFN_HIDDEN = ((-(-(8 * D_MODEL) // 3) + 255) // 256) * 256

IN_SIZES = [A_WIDTH, KV_LATENT, IDX_HEADS * IDX_DIM, IDX_DIM, IDX_HEADS,
            B_WIDTH, B_WIDTH, B_WIDTH, B_WIDTH]
IN_WIDTH = sum(IN_SIZES)
IN_OFFSETS = [int(o) for o in np.cumsum(IN_SIZES)[:-1]]

kernel_name = "hybrid_dsa_retention_chunk_causal"


def rmsnorm(x, w):
    xf = x.astype(jnp.float32)
    y = xf * lax.rsqrt(jnp.mean(xf * xf, axis=-1, keepdims=True) + RMS_EPS)
    return (y * w.astype(jnp.float32)).astype(x.dtype)


def t5_bucket(rel):
    half = NUM_BUCKETS // 2
    max_exact = half // 2
    ret = jnp.where(rel > 0, half, 0)
    n = jnp.abs(rel)
    nf = jnp.maximum(n, 1).astype(jnp.float32)
    large = max_exact + (jnp.log(nf / max_exact) / math.log(MAX_DISTANCE / max_exact)
                         * (half - max_exact)).astype(jnp.int32)
    large = jnp.minimum(large, half - 1)
    return ret + jnp.where(n < max_exact, n, large)


def rotary(x, pos):
    half = x.shape[-1] // 2
    inv = ROPE_BASE ** (-jnp.arange(half, dtype=jnp.float32) / half)
    ang = pos.astype(jnp.float32)[:, None] * inv[None, :]
    cos = jnp.cos(ang)[:, None, :]
    sin = jnp.sin(ang)[:, None, :]
    x1, x2 = x[..., :half], x[..., half:]
    return jnp.concatenate([x1 * cos - x2 * sin, x1 * sin + x2 * cos], axis=-1)


def indexed_sparse_attention(q, k, v, iq, ik, iw, rel_bias):
    b, s, h, dh = q.shape
    topk = min(TOPK_MAX, s // 4)
    n_blocks = s // Q_BLOCK
    key_pos = jnp.arange(s)
    idx_scale = IDX_DIM ** -0.5
    w_scale = IDX_HEADS ** -0.5

    def block(i):
        t0 = i * Q_BLOCK
        qb = lax.dynamic_slice_in_dim(q, t0, Q_BLOCK, axis=1)
        iqb = lax.dynamic_slice_in_dim(iq, t0, Q_BLOCK, axis=1)
        iwb = lax.dynamic_slice_in_dim(iw, t0, Q_BLOCK, axis=1)
        qpos = t0 + jnp.arange(Q_BLOCK)
        limit = (qpos // CHUNK + 1) * CHUNK
        admissible = key_pos[None, :] < limit[:, None]
        dots = jnp.einsum('bthd,bsd->bths', iqb, ik).astype(jnp.float32) * idx_scale
        score = jnp.einsum('bth,bths->bts', iwb.astype(jnp.float32) * w_scale,
                           jax.nn.relu(dots))
        score = jnp.where(admissible[None], score, -jnp.inf)
        _, idx = lax.top_k(score, topk)
        valid = idx < limit[None, :, None]
        kg = jax.vmap(lambda kb, ib: kb[ib])(k, idx)
        vg = jax.vmap(lambda vb, ib: vb[ib])(v, idx)
        logits = jnp.einsum('bthd,btkd->bhtk', qb, kg).astype(jnp.float32) * dh ** -0.5
        bias = rel_bias[t5_bucket(idx - qpos[None, :, None])]
        logits = logits + jnp.transpose(bias, (0, 3, 1, 2)).astype(jnp.float32)
        logits = jnp.where(valid[:, None], logits, -jnp.inf)
        p = jax.nn.softmax(logits, axis=-1)
        return jnp.einsum('bhtk,btkd->bthd', p.astype(v.dtype), vg)

    outs = lax.map(block, jnp.arange(n_blocks))
    return jnp.moveaxis(outs, 0, 1).reshape(b, s, h * dh)


def chunkwise_retention(q, k, v):
    b, s, h, dh = q.shape
    nc = s // CHUNK
    log_g = jnp.log1p(-(2.0 ** (-5.0 - jnp.arange(h, dtype=jnp.float32))))
    j = jnp.arange(CHUNK, dtype=jnp.float32)
    rel = j[:, None] - j[None, :]
    inner_decay = jnp.where(rel[None] >= 0,
                            jnp.exp(jnp.maximum(rel, 0.0)[None] * log_g[:, None, None]), 0.0)
    query_decay = jnp.exp((j + 1.0)[:, None] * log_g[None, :])[None, :, :, None]
    key_decay = jnp.exp((CHUNK - 1.0 - j)[:, None] * log_g[None, :])[None, :, :, None]
    chunk_decay = jnp.exp(CHUNK * log_g)[None, :, None, None]

    def to_chunks(t):
        return jnp.transpose(t.reshape(b, nc, CHUNK, h, dh), (1, 0, 2, 3, 4))

    def step(state, xs):
        qc, kc, vc = xs
        scores = jnp.einsum('bihd,bjhd->bhij', qc, kc) * inner_decay[None]
        inner = jnp.einsum('bhij,bjhd->bihd', scores, vc)
        cross = jnp.einsum('bihd,bhde->bihe', qc, state) * query_decay
        new_state = state * chunk_decay + jnp.einsum('bjhd,bjhe->bhde', kc * key_decay, vc)
        return new_state, inner + cross

    state0 = jnp.zeros((b, h, dh, dh), jnp.float32)
    _, ys = lax.scan(step, state0, (to_chunks(q), to_chunks(k), to_chunks(v)))
    return jnp.transpose(ys, (1, 0, 2, 3, 4)).reshape(b, s, h, dh)


def setup_inputs(seed: int = 0) -> dict:
    key = jax.random.key(seed)
    ks = jax.random.split(key, 20)
    f32 = jnp.float32

    def nrm(k, shape, fan_in):
        return jax.random.normal(k, shape, f32) * fan_in ** -0.5

    def gain(k, shape):
        return 1.0 + 0.02 * jax.random.normal(k, shape, f32)

    return {
        "x": jax.random.normal(ks[0], (BATCH, SEQ, D_MODEL), f32),
        "norm1_w": gain(ks[1], (DEPTH, D_MODEL)),
        "w_in": nrm(ks[2], (DEPTH, D_MODEL, IN_WIDTH), D_MODEL),
        "q_norm_w": gain(ks[3], (DEPTH, HEAD_DIM)),
        "k_norm_w": gain(ks[4], (DEPTH, HEAD_DIM)),
        "kv_norm_w": gain(ks[5], (DEPTH, KV_LATENT)),
        "w_uk": nrm(ks[6], (DEPTH, KV_LATENT, HEAD_DIM), KV_LATENT),
        "w_uv": nrm(ks[7], (DEPTH, KV_LATENT, HEAD_DIM), KV_LATENT),
        "rel_bias": 0.1 * jax.random.normal(ks[8], (NUM_BUCKETS, A_HEADS), f32),
        "ret_gn_w": gain(ks[9], (DEPTH, B_WIDTH)),
        "ret_gn_b": 0.02 * jax.random.normal(ks[10], (DEPTH, B_WIDTH), f32),
        "w_out": nrm(ks[11], (DEPTH, MIX_WIDTH, D_MODEL), MIX_WIDTH),
        "norm2_w": gain(ks[12], (DEPTH, D_MODEL)),
        "w_gate": nrm(ks[13], (DEPTH, D_MODEL, FFN_HIDDEN), D_MODEL),
        "w_up": nrm(ks[14], (DEPTH, D_MODEL, FFN_HIDDEN), D_MODEL),
        "w_down": nrm(ks[15], (DEPTH, FFN_HIDDEN, D_MODEL), FFN_HIDDEN),
    }


def reference(x, norm1_w, w_in, q_norm_w, k_norm_w, kv_norm_w, w_uk, w_uv, rel_bias,
              ret_gn_w, ret_gn_b, w_out, norm2_w, w_gate, w_up, w_down):
    b, s, _ = x.shape
    pos = jnp.arange(s)
    for l in range(DEPTH):
        h = rmsnorm(x, norm1_w[l])
        z = h @ w_in[l]
        qa, c_kv, iq, ik, iw, qb, kb, vb, gb = jnp.split(z, IN_OFFSETS, axis=-1)

        qa = rmsnorm(qa.reshape(b, s, A_HEADS, HEAD_DIM), q_norm_w[l])
        c = rmsnorm(c_kv, kv_norm_w[l])
        ka = rmsnorm(c @ w_uk[l], k_norm_w[l])
        va = c @ w_uv[l]
        out_a = indexed_sparse_attention(qa, ka, va,
                                         iq.reshape(b, s, IDX_HEADS, IDX_DIM), ik, iw, rel_bias)

        qr = rotary(qb.reshape(b, s, B_HEADS, HEAD_DIM).astype(jnp.float32), pos)
        kr = rotary(kb.reshape(b, s, B_HEADS, HEAD_DIM).astype(jnp.float32), pos) * HEAD_DIM ** -0.5
        vr = vb.reshape(b, s, B_HEADS, HEAD_DIM).astype(jnp.float32)
        y = chunkwise_retention(qr, kr, vr)
        mu = jnp.mean(y, axis=-1, keepdims=True)
        var = jnp.mean(jnp.square(y - mu), axis=-1, keepdims=True)
        y = ((y - mu) * lax.rsqrt(var + GN_EPS)).reshape(b, s, B_WIDTH)
        y = y * ret_gn_w[l].astype(jnp.float32) + ret_gn_b[l].astype(jnp.float32)
        out_b = (jax.nn.silu(gb.astype(jnp.float32)) * y).astype(x.dtype)

        x = x + jnp.concatenate([out_a, out_b], axis=-1) @ w_out[l]

        h2 = rmsnorm(x, norm2_w[l])
        x = x + (jax.nn.silu(h2 @ w_gate[l]) * (h2 @ w_up[l])) @ w_down[l]
    return x
```

```cpp
#include <hip/hip_runtime.h>
#include <hip/hip_cooperative_groups.h>
#include <cstdio>
#include <cstdint>
namespace cg = cooperative_groups;
namespace pg8 {
#define PG8_LAS __attribute__((address_space(3)))
typedef unsigned short bf16_t;
typedef short bf16x8 __attribute__((ext_vector_type(8)));
typedef float f32x4 __attribute__((ext_vector_type(4)));
typedef unsigned u32x4 __attribute__((ext_vector_type(4)));
constexpr int BM = 256, BK = 64, HALF = 128, HTB = HALF * BK * 2  , STAGE_BYTES = 8 * HTB, NXCD = 8, WGM = 8;

__host__ __device__ __forceinline__ int lds_byte(int r, int c) { const int st = (r >> 4) * 2 + (c >> 5), rr = r & 15, cc = c & 31, ob = rr * 64 + cc * 2; return st * 1024 + (ob ^ (((ob >> 9) & 1) << 5)); }
__host__ __device__ __forceinline__ void stage_rc(int b, int& R, int& C) { const int st = b / 1024, sb = b % 1024, swz = sb ^ (((sb >> 9) & 1) << 5); R = (st >> 1) * 16 + swz / 64; C = (st & 1) * 32 + (swz % 64) / 2; }
__host__ __device__ __forceinline__ int perm32(int rho) { const int n = rho >> 4, i = rho & 15; return 8 * (i >> 2) + 4 * n + (i & 3); }

struct Unit { int pm, pn; };
struct Gemm { const bf16_t* A; const bf16_t* Bt; int M, N, K; };

struct StaticOrder {
    int nM, nN, nwg, G, c;
    __host__ __device__ void init(int M, int N, int G_, int c_) { nM = M / BM; nN = N / BM; nwg = nM * nN; G = G_; c = c_; }
    __host__ __device__ bool next(int i, Unit& u) const {
        const long L = (long)i * G + c; if (L >= nwg) return false;
        int wgid = (int)L; { const int q = nwg / NXCD, r = nwg % NXCD, xcd = wgid % NXCD, off = wgid / NXCD; wgid = (xcd < r ? xcd * (q + 1) : r * (q + 1) + (xcd - r) * q) + off; }
        const int nig = WGM * nN, gid = wgid / nig, fm = gid * WGM, gsz = (nM - fm) < WGM ? (nM - fm) : WGM;
        u.pm = fm + ((wgid % nig) % gsz); u.pn = (wgid % nig) / gsz; return true;
    }
    __device__ __forceinline__ void a_ready(const Unit&) const {}
    __device__ __forceinline__ void done(const Unit&) const {}
};

__device__ __forceinline__ unsigned cvt_pk_bf16(float lo, float hi) { unsigned r; asm volatile("v_cvt_pk_bf16_f32 %0, %1, %2" : "=v"(r) : "v"(lo), "v"(hi)); return r; }
typedef float f32x2 __attribute__((ext_vector_type(2)));
typedef __bf16 bf16x2_t __attribute__((ext_vector_type(2)));
typedef unsigned u32x2 __attribute__((ext_vector_type(2)));
__device__ __forceinline__ unsigned pkbf(float lo, float hi) { f32x2 v = {lo, hi}; bf16x2_t b = __builtin_convertvector(v, bf16x2_t); return __builtin_bit_cast(unsigned, b); }
__device__ __forceinline__ u32x4 pk8(f32x4 a, f32x4 b) { return (u32x4){pkbf(a[0], a[1]), pkbf(a[2], a[3]), pkbf(b[0], b[1]), pkbf(b[2], b[3])}; }
__device__ __forceinline__ float dot4(f32x4 a) { return (a[0] * a[0] + a[1] * a[1]) + (a[2] * a[2] + a[3] * a[3]); }
__device__ __forceinline__ float sum4(f32x4 a) { return (a[0] + a[1]) + (a[2] + a[3]); }
__device__ __forceinline__ float silu1(float v) { return v / (1.0f + __expf(-v)); }
__device__ __forceinline__ f32x4 silu4(f32x4 v) { return (f32x4){silu1(v[0]), silu1(v[1]), silu1(v[2]), silu1(v[3])}; }
constexpr float RMS_EPS_F = 1e-6f;
constexpr float QSCALE = 0.125f * 1.4426950408889634f;

struct EpiIn {
    static constexpr bool PERM = true, AFTER_DRAIN = false;
    bf16_t *QA, *KA, *VA, *IQ, *IK, *QB, *KB, *VB, *GB; float* IW;
    const float *qnw, *knw, *cosT, *sinT;
    PG8_LAS float* xch;
    __device__ __forceinline__ void operator()(const f32x4 (&acc)[2][2][4][2], const Unit& u, int wr, int wc, int fr, int fq) {
        const int row0 = u.pm * BM + wr * 64 + fr, pn = u.pn;
        if (pn < 2) {
            const int head = 4 * pn + wc;
            const f32x4 w0 = *(const f32x4*)(qnw + 8 * fq), w1 = *(const f32x4*)(qnw + 8 * fq + 4), w2 = *(const f32x4*)(qnw + 32 + 8 * fq), w3 = *(const f32x4*)(qnw + 36 + 8 * fq);
#pragma unroll
            for (int ai = 0; ai < 2; ++ai)
#pragma unroll
                for (int m = 0; m < 4; ++m) {
                    f32x4 a0 = acc[ai][0][m][0], a1 = acc[ai][0][m][1], b0 = acc[ai][1][m][0], b1 = acc[ai][1][m][1];
                    float ss = (dot4(a0) + dot4(a1)) + (dot4(b0) + dot4(b1));
                    ss += __shfl_xor(ss, 16); ss += __shfl_xor(ss, 32);
                    const float rs = QSCALE / sqrtf(ss * (1.0f / 64.0f) + RMS_EPS_F);
                    bf16_t* p = QA + (size_t)(row0 + ai * HALF + m * 16) * 512 + head * 64 + 8 * fq;
                    *(u32x4*)p = pk8(a0 * w0 * rs, a1 * w1 * rs); *(u32x4*)(p + 32) = pk8(b0 * w2 * rs, b1 * w3 * rs);
                }
        } else if (pn == 2) {
            if (wc >= 2) {
#pragma unroll
                for (int ai = 0; ai < 2; ++ai)
#pragma unroll
                    for (int m = 0; m < 4; ++m) {
                        float ss = (dot4(acc[ai][0][m][0]) + dot4(acc[ai][0][m][1])) + (dot4(acc[ai][1][m][0]) + dot4(acc[ai][1][m][1]));
                        ss += __shfl_xor(ss, 16); ss += __shfl_xor(ss, 32);
                        if (fq == 0) xch[(ai * HALF + wr * 64 + m * 16 + fr) * 2 + (wc - 2)] = ss;
                    }
            }
            asm volatile("s_waitcnt lgkmcnt(0)" ::: "memory"); __builtin_amdgcn_s_barrier(); asm volatile("" ::: "memory");
            if (wc < 2) {
                const f32x4 w0 = *(const f32x4*)(knw + 8 * fq), w1 = *(const f32x4*)(knw + 8 * fq + 4), w2 = *(const f32x4*)(knw + 32 + 8 * fq), w3 = *(const f32x4*)(knw + 36 + 8 * fq);
#pragma unroll
                for (int ai = 0; ai < 2; ++ai)
#pragma unroll
                    for (int m = 0; m < 4; ++m) {
                        const int rl = ai * HALF + wr * 64 + m * 16 + fr;
                        const f32x2 pr = *(const PG8_LAS f32x2*)(xch + rl * 2);
                        const float rc = 1.0f / sqrtf((pr[0] + pr[1]) * (1.0f / 128.0f) + RMS_EPS_F);
                        f32x4 a0 = acc[ai][0][m][0] * rc, a1 = acc[ai][0][m][1] * rc, b0 = acc[ai][1][m][0] * rc, b1 = acc[ai][1][m][1] * rc;
                        const size_t row = (size_t)(row0 + ai * HALF + m * 16);
                        if (wc == 0) {
                            float ss = (dot4(a0) + dot4(a1)) + (dot4(b0) + dot4(b1));
                            ss += __shfl_xor(ss, 16); ss += __shfl_xor(ss, 32);
                            const float rs = 1.0f / sqrtf(ss * (1.0f / 64.0f) + RMS_EPS_F);
                            bf16_t* p = KA + row * 64 + 8 * fq;
                            *(u32x4*)p = pk8(a0 * w0 * rs, a1 * w1 * rs); *(u32x4*)(p + 32) = pk8(b0 * w2 * rs, b1 * w3 * rs);
                        } else {
                            bf16_t* p = VA + row * 64 + 8 * fq;
                            *(u32x4*)p = pk8(a0, a1); *(u32x4*)(p + 32) = pk8(b0, b1);
                        }
                    }
            }
        } else if (pn == 3) {
#pragma unroll
            for (int ai = 0; ai < 2; ++ai)
#pragma unroll
                for (int m = 0; m < 4; ++m) {
                    const size_t row = (size_t)(row0 + ai * HALF + m * 16);
                    *(u32x4*)(IQ + row * 128 + 32 * wc + 8 * fq) = pk8(acc[ai][0][m][0], acc[ai][0][m][1]);
                    if (wc == 0) *(u32x4*)(IK + row * 32 + 8 * fq) = pk8(acc[ai][1][m][0], acc[ai][1][m][1]);
                    if (wc == 1 && fq == 0) *(f32x4*)(IW + row * 4) = acc[ai][1][m][0];
                }
        } else if (pn < 8) {
            const int head = 4 * (pn & 1) + wc; bf16_t* dst = pn < 6 ? QB : KB; const float sc = pn < 6 ? 1.0f : 0.125f;
#pragma unroll
            for (int ai = 0; ai < 2; ++ai)
#pragma unroll
                for (int m = 0; m < 4; ++m) {
                    const int row = row0 + ai * HALF + m * 16, pos = row & 2047;
                    const f32x4 c0 = *(const f32x4*)(cosT + pos * 32 + 8 * fq) * sc, c1 = *(const f32x4*)(cosT + pos * 32 + 8 * fq + 4) * sc;
                    const f32x4 s0 = *(const f32x4*)(sinT + pos * 32 + 8 * fq) * sc, s1 = *(const f32x4*)(sinT + pos * 32 + 8 * fq + 4) * sc;
                    const f32x4 a0 = acc[ai][0][m][0], a1 = acc[ai][0][m][1], b0 = acc[ai][1][m][0], b1 = acc[ai][1][m][1];
                    bf16_t* p = dst + (size_t)row * 512 + head * 64 + 8 * fq;
                    *(u32x4*)p = pk8(a0 * c0 - b0 * s0, a1 * c1 - b1 * s1); *(u32x4*)(p + 32) = pk8(a0 * s0 + b0 * c0, a1 * s1 + b1 * c1);
                }
        } else {
            const int head = 4 * (pn & 1) + wc; bf16_t* dst = pn < 10 ? VB : GB; const bool act = pn >= 10;
#pragma unroll
            for (int ai = 0; ai < 2; ++ai)
#pragma unroll
                for (int m = 0; m < 4; ++m) {
                    f32x4 a0 = acc[ai][0][m][0], a1 = acc[ai][0][m][1], b0 = acc[ai][1][m][0], b1 = acc[ai][1][m][1];
                    if (act) { a0 = silu4(a0); a1 = silu4(a1); b0 = silu4(b0); b1 = silu4(b1); }
                    bf16_t* p = dst + (size_t)(row0 + ai * HALF + m * 16) * 512 + head * 64 + 8 * fq;
                    *(u32x4*)p = pk8(a0, a1); *(u32x4*)(p + 32) = pk8(b0, b1);
                }
        }
    }
};

struct EpiOut {
    static constexpr bool PERM = true, AFTER_DRAIN = false;
    const float* x; float* out; bf16_t* x1b; float ss[8];
    __device__ __forceinline__ void operator()(const f32x4 (&acc)[2][2][4][2], const Unit& u, int wr, int wc, int fr, int fq) {
        const int row0 = u.pm * BM + wr * 64 + fr, col0 = u.pn * BM + wc * 32 + 8 * fq;
#pragma unroll
        for (int ai = 0; ai < 2; ++ai)
#pragma unroll
            for (int m = 0; m < 4; ++m) {
                const size_t off = (size_t)(row0 + ai * HALF + m * 16) * 1024 + col0; float s = 0.f;
#pragma unroll
                for (int bj = 0; bj < 2; ++bj) {
                    const f32x4 r0 = *(const f32x4*)(x + off + bj * HALF) + acc[ai][bj][m][0], r1 = *(const f32x4*)(x + off + bj * HALF + 4) + acc[ai][bj][m][1];
                    *(f32x4*)(out + off + bj * HALF) = r0; *(f32x4*)(out + off + bj * HALF + 4) = r1;
                    *(u32x4*)(x1b + off + bj * HALF) = pk8(r0, r1);
                    s += dot4(r0) + dot4(r1);
                }
                ss[ai * 4 + m] += s;
            }
    }
};

struct EpiGU {
    static constexpr bool PERM = true, AFTER_DRAIN = false;
    const float* r2; bf16_t* act;
    __device__ __forceinline__ void operator()(const f32x4 (&acc)[2][2][4][2], const Unit& u, int wr, int wc, int fr, int fq) {
        const int row0 = u.pm * BM + wr * 64 + fr, col0 = u.pn * HALF + wc * 32 + 8 * fq;
#pragma unroll
        for (int ai = 0; ai < 2; ++ai)
#pragma unroll
            for (int m = 0; m < 4; ++m) {
                const int row = row0 + ai * HALF + m * 16; const float rr = r2[row];
                const f32x4 g0 = acc[ai][0][m][0] * rr, g1 = acc[ai][0][m][1] * rr, u0 = acc[ai][1][m][0] * rr, u1 = acc[ai][1][m][1] * rr;
                *(u32x4*)(act + (size_t)row * 2816 + col0) = pk8(silu4(g0) * u0, silu4(g1) * u1);
            }
    }
};

struct EpiDown {
    static constexpr bool PERM = true, AFTER_DRAIN = false;
    float* out;
    __device__ __forceinline__ void operator()(const f32x4 (&acc)[2][2][4][2], const Unit& u, int wr, int wc, int fr, int fq) {
        const int row0 = u.pm * BM + wr * 64 + fr, col0 = u.pn * BM + wc * 32 + 8 * fq;
#pragma unroll
        for (int ai = 0; ai < 2; ++ai)
#pragma unroll
            for (int m = 0; m < 4; ++m) {
                const size_t off = (size_t)(row0 + ai * HALF + m * 16) * 1024 + col0;
#pragma unroll
                for (int bj = 0; bj < 2; ++bj) {
                    const f32x4 r0 = *(const f32x4*)(out + off + bj * HALF) + acc[ai][bj][m][0], r1 = *(const f32x4*)(out + off + bj * HALF + 4) + acc[ai][bj][m][1];
                    *(f32x4*)(out + off + bj * HALF) = r0; *(f32x4*)(out + off + bj * HALF + 4) = r1;
                }
            }
    }
};

struct PanelOrder {
    int pm, ntn;
    __device__ __forceinline__ bool next(int i, Unit& u) const { if (i >= ntn) return false; u.pm = pm; u.pn = i; return true; }
    __device__ __forceinline__ void a_ready(const Unit&) const {}
    __device__ __forceinline__ void done(const Unit&) const {}
};

template <class Epi, class Sched, bool ALIGN_EPI = false, bool SP2 = false>
__device__ __forceinline__ void gemm_phase(PG8_LAS unsigned char* lds, const Gemm g, const Sched& S, Epi& E) {
    const int tid = threadIdx.x, wid = __builtin_amdgcn_readfirstlane(tid >> 6), lane = tid & 63, wr = wid >> 2, wc = wid & 3, fr = lane & 15, fq = lane >> 4;
    const int K = g.K, nt = K / BK;
    unsigned voffA[2], voffB[2];
#pragma unroll
    for (int i = 0; i < 2; ++i) { int R, C; stage_rc(tid * 16 + i * 8192, R, C); const int Rb = Epi::PERM ? ((R & ~31) + perm32(R & 31)) : R;
        voffA[i] = (unsigned)(R * K + C) * 2u; voffB[i] = (unsigned)(Rb * K + C) * 2u; }
    const size_t kstep = (size_t)(BK * 2);
    const size_t hstep = (size_t)HALF * K * 2;
    const size_t tstep = 2 * hstep;
    const unsigned ldsw = (unsigned)wid * 1024u;
    const int aoff = lds_byte(wr * 64 + fr, fq * 8), boff = lds_byte(wc * 32 + fr, fq * 8);
#define PG8_SA(b, h) (((b) * 2 + (h)) * HTB)
#define PG8_SB(b, h) ((4 + (b) * 2 + (h)) * HTB)
#define PG8_STAGE(bufoff, gbase, voff) do { _Pragma("unroll") for (int _i = 0; _i < 2; ++_i) \
        __builtin_amdgcn_global_load_lds((const unsigned*)((const char*)(gbase) + (voff)[_i]), (PG8_LAS unsigned*)(lds + (bufoff) + ldsw + _i * 8192), 16, 0, 0); } while (0)
#define PG8_LDA(dst, b, h) do { _Pragma("unroll") for (int m = 0; m < 4; ++m) _Pragma("unroll") for (int k = 0; k < 2; ++k) dst[m][k] = *(const PG8_LAS bf16x8*)(lds + PG8_SA(b, h) + aoff + m * 2048 + k * 1024); } while (0)
#define PG8_LDB(dst, b, h) do { _Pragma("unroll") for (int n = 0; n < 2; ++n) _Pragma("unroll") for (int k = 0; k < 2; ++k) dst[n][k] = *(const PG8_LAS bf16x8*)(lds + PG8_SB(b, h) + boff + n * 2048 + k * 1024); } while (0)
#define PG8_MMA(ai, bj, At, Bt) do { __builtin_amdgcn_s_setprio(1); _Pragma("unroll") for (int m = 0; m < 4; ++m) _Pragma("unroll") for (int n = 0; n < 2; ++n) _Pragma("unroll") for (int k = 0; k < 2; ++k) \
        acc[ai][bj][m][n] = __builtin_amdgcn_mfma_f32_16x16x32_bf16(Bt[n][k], At[m][k], acc[ai][bj][m][n], 0, 0, 0); __builtin_amdgcn_s_setprio(0); } while (0)
#define PG8_WAIT_V(n) asm volatile("s_waitcnt vmcnt(" #n ")" ::: "memory")
#define PG8_WAIT_L(n) asm volatile("s_waitcnt lgkmcnt(" #n ")" ::: "memory")
#define PG8_BAR __builtin_amdgcn_s_barrier()
#define PG8_SCHED __builtin_amdgcn_sched_barrier(0)
    Unit cur, nxt; int ui = 0;
    if (!S.next(0, cur)) return;
    f32x4 acc[2][2][4][2];
#pragma unroll
    for (int a = 0; a < 2; ++a)
#pragma unroll
        for (int b = 0; b < 2; ++b)
#pragma unroll
            for (int m = 0; m < 4; ++m)
#pragma unroll
                for (int n = 0; n < 2; ++n) acc[a][b][m][n] = (f32x4){0.f, 0.f, 0.f, 0.f};
    bf16x8 At[4][2], B0[2][2], B1[2][2];
    const char* cA = (const char*)g.A + (size_t)cur.pm * tstep; const char* cB = (const char*)g.Bt + (size_t)cur.pn * tstep;
    S.a_ready(cur);
    if constexpr (SP2) {
        PG8_STAGE(PG8_SB(0, 0), cB, voffB); PG8_STAGE(PG8_SB(0, 1), cB + hstep, voffB); PG8_STAGE(PG8_SA(0, 0), cA, voffA); PG8_STAGE(PG8_SA(0, 1), cA + hstep, voffA);
        if (wr == 1) PG8_BAR;
        PG8_WAIT_V(2); PG8_BAR;
        PG8_STAGE(PG8_SB(1, 0), cB + kstep, voffB); PG8_STAGE(PG8_SA(1, 0), cA + kstep, voffA); PG8_STAGE(PG8_SB(1, 1), cB + hstep + kstep, voffB);
        PG8_WAIT_V(6); PG8_BAR;
    } else {
        PG8_STAGE(PG8_SB(0, 0), cB, voffB); PG8_STAGE(PG8_SA(0, 0), cA, voffA); PG8_STAGE(PG8_SB(0, 1), cB + hstep, voffB); PG8_STAGE(PG8_SA(0, 1), cA + hstep, voffA);
        if (wr == 1) PG8_BAR;
        PG8_WAIT_V(4); PG8_BAR;
        PG8_STAGE(PG8_SB(1, 0), cB + kstep, voffB); PG8_STAGE(PG8_SA(1, 0), cA + kstep, voffA); PG8_STAGE(PG8_SB(1, 1), cB + hstep + kstep, voffB);
        PG8_WAIT_V(6); PG8_BAR;
    }
    for (;;) {
        const bool has_next = S.next(ui + 1, nxt);
        const char* nA = has_next ? (const char*)g.A + (size_t)nxt.pm * tstep : cA; const char* nB = has_next ? (const char*)g.Bt + (size_t)nxt.pn * tstep : cB;
        for (int t = 0; t < nt; t += 2) {
            const bool last = (t == nt - 2);
            const char* a1 = cA + (size_t)(t + 1) * kstep;
            const char* a2 = last ? nA : cA + (size_t)(t + 2) * kstep; const char* b2 = last ? nB : cB + (size_t)(t + 2) * kstep;
            const char* a3 = a2 + kstep; const char* b3 = b2 + kstep;
            if (last && has_next) S.a_ready(nxt);
            if constexpr (SP2) {
            PG8_LDB(B0, 0, 0); PG8_LDB(B1, 0, 1); PG8_SCHED; PG8_LDA(At, 0, 0); PG8_STAGE(PG8_SA(1, 1), a1 + hstep, voffA);
            PG8_WAIT_V(8); PG8_WAIT_L(0); PG8_BAR; PG8_MMA(0, 0, At, B0); PG8_MMA(0, 1, At, B1); PG8_BAR; PG8_SCHED;
            PG8_LDA(At, 0, 1); PG8_STAGE(PG8_SB(0, 0), b2, voffB); PG8_STAGE(PG8_SB(0, 1), b2 + hstep, voffB); PG8_STAGE(PG8_SA(0, 0), a2, voffA);
            PG8_WAIT_V(8); PG8_WAIT_L(0); PG8_BAR; PG8_MMA(1, 0, At, B0); PG8_MMA(1, 1, At, B1); PG8_BAR; PG8_SCHED;
            PG8_LDB(B0, 1, 0); PG8_LDB(B1, 1, 1); PG8_SCHED; PG8_LDA(At, 1, 0); PG8_STAGE(PG8_SA(0, 1), a2 + hstep, voffA);
            PG8_WAIT_V(8); PG8_WAIT_L(0); PG8_BAR; PG8_MMA(0, 0, At, B0); PG8_MMA(0, 1, At, B1); PG8_BAR; PG8_SCHED;
            PG8_LDA(At, 1, 1); PG8_STAGE(PG8_SB(1, 0), b3, voffB); PG8_STAGE(PG8_SB(1, 1), b3 + hstep, voffB); PG8_STAGE(PG8_SA(1, 0), a3, voffA);
            PG8_WAIT_V(8); PG8_WAIT_L(0); PG8_BAR; PG8_MMA(1, 0, At, B0); PG8_MMA(1, 1, At, B1); PG8_BAR; PG8_SCHED;
            } else {
            PG8_LDB(B0, 0, 0); PG8_SCHED; PG8_LDA(At, 0, 0); PG8_STAGE(PG8_SA(1, 1), a1 + hstep, voffA);
            PG8_WAIT_L(8); PG8_BAR; PG8_WAIT_L(0); PG8_MMA(0, 0, At, B0); PG8_BAR; PG8_SCHED;
            PG8_LDB(B1, 0, 1); PG8_STAGE(PG8_SB(0, 0), b2, voffB);
            PG8_BAR; PG8_WAIT_L(0); PG8_MMA(0, 1, At, B1); PG8_BAR;
            PG8_LDA(At, 0, 1); PG8_STAGE(PG8_SA(0, 0), a2, voffA);
            PG8_BAR; PG8_WAIT_L(0); PG8_MMA(1, 0, At, B0); PG8_BAR; PG8_SCHED;
            PG8_STAGE(PG8_SB(0, 1), b2 + hstep, voffB);
            PG8_WAIT_V(6); PG8_BAR; PG8_MMA(1, 1, At, B1); PG8_BAR;
            PG8_LDB(B0, 1, 0); PG8_SCHED; PG8_LDA(At, 1, 0); PG8_STAGE(PG8_SA(0, 1), a2 + hstep, voffA);
            PG8_WAIT_L(8); PG8_BAR; PG8_WAIT_L(0); PG8_MMA(0, 0, At, B0); PG8_BAR; PG8_SCHED;
            PG8_LDB(B1, 1, 1); PG8_STAGE(PG8_SB(1, 0), b3, voffB);
            PG8_BAR; PG8_WAIT_L(0); PG8_MMA(0, 1, At, B1); PG8_BAR;
            PG8_LDA(At, 1, 1); PG8_STAGE(PG8_SA(1, 0), a3, voffA);
            PG8_BAR; PG8_WAIT_L(0); PG8_MMA(1, 0, At, B0); PG8_BAR; PG8_SCHED;
            PG8_STAGE(PG8_SB(1, 1), b3 + hstep, voffB);
            PG8_WAIT_V(6); PG8_BAR; PG8_MMA(1, 1, At, B1); PG8_BAR;
            }
        }
        if constexpr (ALIGN_EPI) { if (wr == 0) PG8_BAR; }
        if constexpr (!Epi::AFTER_DRAIN) { E(acc, cur, wr, wc, fr, fq); S.done(cur); }
        if (!has_next) break;
#pragma unroll
        for (int a = 0; a < 2; ++a)
#pragma unroll
            for (int b = 0; b < 2; ++b)
#pragma unroll
                for (int m = 0; m < 4; ++m)
#pragma unroll
                    for (int n = 0; n < 2; ++n) acc[a][b][m][n] = (f32x4){0.f, 0.f, 0.f, 0.f};
        cur = nxt; cA = nA; cB = nB; ++ui;
        if constexpr (ALIGN_EPI) { if (wr == 1) PG8_BAR; }
    }
    PG8_WAIT_V(0);
    if constexpr (!ALIGN_EPI) { if (wr == 0) PG8_BAR; }
    PG8_BAR;
    (void)lane;
#undef PG8_SA
#undef PG8_SB
#undef PG8_STAGE
#undef PG8_LDA
#undef PG8_LDB
#undef PG8_MMA
#undef PG8_WAIT_V
#undef PG8_WAIT_L
#undef PG8_BAR
#undef PG8_SCHED
}
}

constexpr int BATCH = 32, SEQ = 2048, DM = 1024, MTOK = BATCH * SEQ;
constexpr int INW = 2852, NIN = 3072, FF = 2816, NGU = 2 * FF;
constexpr int NWAVES = 8, NTHR = 512;
#ifndef MK_N_LAUNCHES
#define MK_N_LAUNCHES 6
#endif
constexpr int N_PHASES = 6;
constexpr size_t MiB = 1u << 20;
constexpr size_t WS_CTL = 0;
constexpr size_t WS_COS = 1 * MiB, WS_SIN = WS_COS + 256 * 1024;
constexpr size_t WS_BT = WS_SIN + 256 * 1024;
constexpr size_t WS_R2 = 2 * MiB;
constexpr size_t WS_WIN = 4 * MiB, WS_WOUT = 10 * MiB, WS_WGU = 12 * MiB, WS_WDN = 23 * MiB;
constexpr size_t WS_XB = 32 * MiB;
constexpr size_t WS_MIX = 160 * MiB;
constexpr size_t WS_QA = 288 * MiB, WS_QB = 352 * MiB, WS_KB = 416 * MiB, WS_VB = 480 * MiB, WS_GB = 544 * MiB;
constexpr size_t WS_KA = 608 * MiB, WS_VA = 616 * MiB;
constexpr size_t WS_IQ = 624 * MiB;
constexpr size_t WS_ACT = 288 * MiB;
constexpr size_t WS_IK = 640 * MiB, WS_IW = 644 * MiB;
constexpr size_t WS_MASK = 648 * MiB;
constexpr size_t WS_SCR = 672 * MiB;
constexpr size_t WS_END = 800 * MiB;
static_assert(WS_ACT + (size_t)MTOK * FF * 2 <= WS_IK && WS_IQ + (size_t)MTOK * 128 * 2 <= WS_IK && WS_WDN + (size_t)DM * FF * 2 <= WS_XB && WS_WGU + (size_t)NGU * DM * 2 <= WS_WDN, "d_ws map");
constexpr int RING_BYTES = 131072;
constexpr int XCH_OFF = RING_BYTES;
constexpr int MISC_OFF = RING_BYTES + 4096;
constexpr int LDS_BYTES = 147456;

#define LAS __attribute__((address_space(3)))
typedef unsigned short bf16;
typedef unsigned v4u __attribute__((ext_vector_type(4)));
typedef unsigned v2u __attribute__((ext_vector_type(2)));
typedef float f32x4 __attribute__((ext_vector_type(4)));
typedef float f32x16 __attribute__((ext_vector_type(16)));
typedef short bf16x8 __attribute__((ext_vector_type(8)));
typedef short s16x4 __attribute__((ext_vector_type(4)));
#define LDS_WAIT() asm volatile("s_waitcnt lgkmcnt(0)" ::: "memory")
using pg8::pkbf;
__device__ __forceinline__ float bf2f(unsigned short h) { return __uint_as_float((unsigned)h << 16); }
__device__ __forceinline__ float bflo(unsigned w) { return __uint_as_float(w << 16); }
__device__ __forceinline__ float bfhi(unsigned w) { return __uint_as_float(w & 0xffff0000u); }
__device__ __forceinline__ float wave_sum(float v) {
#pragma unroll
    for (int o = 1; o < 64; o <<= 1) v += __shfl_xor(v, o);
    return v;
}
__device__ __forceinline__ s16x4 vtr(const LAS unsigned char* p) { return __builtin_bit_cast(s16x4, __builtin_amdgcn_ds_read_tr16_b64_v4i16((LAS s16x4*)p)); }
__device__ __forceinline__ bf16x8 cat8(s16x4 lo, s16x4 hi) { return (bf16x8){lo[0], lo[1], lo[2], lo[3], hi[0], hi[1], hi[2], hi[3]}; }
__device__ __forceinline__ int crow(int r, int hi) { return (r & 3) + 8 * (r >> 2) + 4 * hi; }

struct Frame {
    LAS unsigned char* lds;
    unsigned* ctl;
    int tid, lane, wave, vcu, G;
    const float *x, *norm1_w, *w_in, *q_norm_w, *k_norm_w, *kv_norm_w, *w_uk, *w_uv, *rel_bias, *ret_gn_w, *ret_gn_b, *w_out, *norm2_w, *w_gate, *w_up, *w_down;
    float* out;
    bf16 *WIN, *WOUT, *WGU, *WDN, *XB, *MIX, *QA, *QB, *KB, *VB, *GB, *KA, *VA, *IQ, *IK, *ACT;
    float *IW, *R2, *COS, *SIN, *BT, *SCR;
    unsigned long long* MASK;
};

__device__ __forceinline__ int zcol(int n) {
    const int pn = n >> 8, tc = n & 255, bj = tc >> 7, wc = (tc >> 5) & 3, j = tc & 31, d = bj * 32 + j;
    if (pn < 2) return (4 * pn + wc) * 64 + d;
    if (pn == 2) { if (wc == 0) return -2 - d; if (wc == 1) return -2 - (64 + d); return 512 + (wc - 2) * 64 + d; }
    if (pn == 3) { if (bj == 0) return 640 + wc * 32 + j; if (wc == 0) return 768 + j; if (wc == 1 && j < 4) return 800 + j; return -1; }
    const int g = (pn - 4) >> 1, head = 4 * ((pn - 4) & 1) + wc;
    return 804 + g * 512 + head * 64 + d;
}
template <class SRC>
__device__ __forceinline__ void tr_item(SRC src, int Kdim, bf16* WT, int k0, int n0, LAS float* scr, int lane) {
#pragma unroll 4
    for (int i = 0; i < 32; ++i) { const int kk = 2 * i + (lane >> 5); scr[kk * 33 + (lane & 31)] = src(k0 + kk); }
    LDS_WAIT(); asm volatile("" ::: "memory");
    const int c = lane & 7;
#pragma unroll
    for (int j = 0; j < 4; ++j) { const int n = (lane >> 3) + 8 * j; const LAS float* s = scr + (8 * c) * 33 + n;
        v4u o; o.x = pkbf(s[0 * 33], s[1 * 33]); o.y = pkbf(s[2 * 33], s[3 * 33]); o.z = pkbf(s[4 * 33], s[5 * 33]); o.w = pkbf(s[6 * 33], s[7 * 33]);
        *(v4u*)(WT + (size_t)(n0 + n) * Kdim + k0 + 8 * c) = o; }
    LDS_WAIT(); asm volatile("" ::: "memory");
}
__device__ __forceinline__ int t5_bucket(int rel) {
    const int n = rel < 0 ? -rel : rel; int b;
    if (n < 8) b = n; else if (n < 12) b = 8; else if (n < 16) b = 9; else if (n < 23) b = 10; else if (n < 32) b = 11; else if (n < 46) b = 12; else if (n < 64) b = 13; else if (n < 91) b = 14; else b = 15;
    return (rel > 0 ? 16 : 0) + b;
}
__device__ __forceinline__ void p0_prologue(Frame& F) {
    LAS float* scr = (LAS float*)(F.lds + F.wave * 16384);
    const int lane = F.lane, gw = F.vcu * NWAVES + F.wave, NGW = F.G * NWAVES;
    if (blockIdx.x == 0 && F.tid == 0) F.ctl[0] = 0u;
    constexpr int I_IN = 16 * (NIN / 32), I_OUT = 16 * 32, I_GU = 16 * (NGU / 32), I_DN = (FF / 64) * 32, NITEMS = I_IN + I_OUT + I_GU + I_DN;
    for (int it = gw; it < NITEMS; it += NGW) {
        int r = it;
        if (r < I_IN) {
            const int kb = r / (NIN / 32), nb = r % (NIN / 32), f = zcol(32 * nb + (lane & 31));
            const float* w_in = F.w_in; const float* nw = F.norm1_w;
            if (f >= -1) {
                tr_item([&](int k) { return f >= 0 ? nw[k] * w_in[(size_t)k * INW + f] : 0.0f; }, DM, F.WIN, 64 * kb, 32 * nb, scr, lane);
            } else {
                const int idx = -2 - f; const float* wu = (idx < 64 ? F.w_uk : F.w_uv) + (idx & 63); const float* kvw = F.kv_norm_w;
                tr_item([&](int k) { const float* wr_ = w_in + (size_t)k * INW + 512; float a = 0.f;
#pragma unroll 8
                        for (int j = 0; j < 128; ++j) a += wr_[j] * kvw[j] * wu[j * 64];
                        return nw[k] * a; }, DM, F.WIN, 64 * kb, 32 * nb, scr, lane);
            }
            continue;
        }
        r -= I_IN;
        if (r < I_OUT) { const int kb = r / 32, nb = r % 32; const float* w = F.w_out + 32 * nb + (lane & 31);
            tr_item([&](int k) { return w[(size_t)k * DM]; }, DM, F.WOUT, 64 * kb, 32 * nb, scr, lane); continue; }
        r -= I_OUT;
        if (r < I_GU) { const int kb = r / (NGU / 32), nb = r % (NGU / 32), n = 32 * nb + (lane & 31), pn = n >> 8, tc = n & 255;
            const float* w = ((tc >> 7) ? F.w_up : F.w_gate) + 128 * pn + (tc & 127); const float* nw = F.norm2_w;
            tr_item([&](int k) { return nw[k] * w[(size_t)k * FF]; }, DM, F.WGU, 64 * kb, 32 * nb, scr, lane); continue; }
        r -= I_GU;
        { const int kb = r / 32, nb = r % 32; const float* w = F.w_down + 32 * nb + (lane & 31);
            tr_item([&](int k) { return w[(size_t)k * DM]; }, FF, F.WDN, 64 * kb, 32 * nb, scr, lane); }
    }
    for (int m = gw; m < MTOK; m += NGW) {
        const f32x4* xr = (const f32x4*)(F.x + (size_t)m * DM) + lane;
        f32x4 v[4]; float s = 0.f;
#pragma unroll
        for (int j = 0; j < 4; ++j) { v[j] = xr[64 * j]; s += pg8::dot4(v[j]); }
        const float rr = 1.0f / sqrtf(wave_sum(s) * (1.0f / DM) + 1e-6f);
        v2u* o8 = (v2u*)(F.XB + (size_t)m * DM) + lane;
#pragma unroll
        for (int j = 0; j < 4; ++j) o8[64 * j] = (v2u){pkbf(v[j][0] * rr, v[j][1] * rr), pkbf(v[j][2] * rr, v[j][3] * rr)};
    }
    const int gt = F.vcu * NTHR + F.tid, NGT = F.G * NTHR;
    for (int i = gt; i < SEQ * 32; i += NGT) { const int pos = i >> 5, j = i & 31;
        const float inv = powf(10000.0f, -(float)j / 32.0f), ang = (float)pos * inv;
        F.COS[i] = cosf(ang); F.SIN[i] = sinf(ang); }
    for (int i = gt; i < 8 * 256; i += NGT) { const int h = i >> 8, rel = (i & 255) - 191;
        float mq = 0.f, mk = 0.f, mb = 0.f;
        for (int j = 0; j < 64; ++j) { mq = fmaxf(mq, fabsf(F.q_norm_w[j])); mk = fmaxf(mk, fabsf(F.k_norm_w[j])); }
        for (int j = 0; j < 256; ++j) mb = fmaxf(mb, fabsf(F.rel_bias[j]));
        const float bound = 8.0f * mq * mk + mb;
        F.BT[i] = (F.rel_bias[t5_bucket(rel) * 8 + h] - bound) * 1.4426950408889634f; }
}

__device__ __forceinline__ void idx_scores(const Frame& F, int b, int c, float* scr) {
    const int w = F.wave, lane = F.lane, r = lane & 31, hi = lane >> 5, qb = w & 1;
    const size_t rowq = (size_t)b * SEQ + 64 * c + 32 * qb + r;
    bf16x8 bq[4][2];
#pragma unroll
    for (int h = 0; h < 4; ++h)
#pragma unroll
        for (int s = 0; s < 2; ++s) bq[h][s] = *(const bf16x8*)(F.IQ + rowq * 128 + 32 * h + 16 * s + 8 * hi);
    const f32x4 wv = *(const f32x4*)(F.IW + rowq * 4) * (0.5f * 0.17677669529663687f);
    const int nkb = 2 * (c + 1);
    for (int kb = w >> 1; kb < nkb; kb += 4) {
        const bf16* kp = F.IK + ((size_t)b * SEQ + 32 * kb + r) * 32 + 8 * hi;
        const bf16x8 a0 = *(const bf16x8*)kp, a1 = *(const bf16x8*)(kp + 16);
        f32x16 sc;
#pragma unroll
        for (int i = 0; i < 16; ++i) sc[i] = 0.f;
#pragma unroll
        for (int h = 0; h < 4; ++h) {
            f32x16 d;
#pragma unroll
            for (int i = 0; i < 16; ++i) d[i] = 0.f;
            d = __builtin_amdgcn_mfma_f32_32x32x16_bf16(a0, bq[h][0], d, 0, 0, 0);
            d = __builtin_amdgcn_mfma_f32_32x32x16_bf16(a1, bq[h][1], d, 0, 0, 0);
#pragma unroll
            for (int i = 0; i < 16; ++i) sc[i] += wv[h] * fmaxf(d[i], 0.f);
        }
        float* dst = scr + (size_t)(32 * qb + r) * 2048 + 32 * kb + 4 * hi;
#pragma unroll
        for (int g = 0; g < 4; ++g) *(f32x4*)(dst + 8 * g) = (f32x4){sc[4 * g] + 0.f, sc[4 * g + 1] + 0.f, sc[4 * g + 2] + 0.f, sc[4 * g + 3] + 0.f};
    }
}
template <int NJ>
__device__ __forceinline__ void select_rows(const float* scr, unsigned long long* mask_rows, int nj, int wave, int lane) {
#pragma unroll 1
    for (int rr = 0; rr < 8; ++rr) {
        const int ql = wave * 8 + rr; const float* row = scr + (size_t)ql * 2048 + lane;
        unsigned u[NJ];
#pragma unroll
        for (int j = 0; j < NJ; ++j) { const unsigned bits = __float_as_uint(row[64 * j] + 0.0f); const unsigned k = bits ^ ((unsigned)((int)bits >> 31) | 0x80000000u); u[j] = (j < nj) ? k : 0u; }
        unsigned prefix = 0u;
#pragma unroll 1
        for (int bit = 31; bit >= 0; --bit) {
            const unsigned trial = prefix | (1u << bit); int cnt = 0;
#pragma unroll
            for (int j = 0; j < NJ; ++j) cnt += __popcll(__ballot(u[j] >= trial));
            if (cnt >= 256) prefix = trial;
            if (cnt == 256) break;
        }
        int ngt = 0;
#pragma unroll
        for (int j = 0; j < NJ; ++j) ngt += __popcll(__ballot(u[j] > prefix));
        int need = 256 - ngt; unsigned long long mv = 0ull;
#pragma unroll
        for (int j = 0; j < NJ; ++j) {
            const unsigned long long eq = __ballot(u[j] == prefix);
            const int rank = (int)__builtin_amdgcn_mbcnt_hi((unsigned)(eq >> 32), __builtin_amdgcn_mbcnt_lo((unsigned)eq, 0u));
            const unsigned long long sel = __ballot(u[j] > prefix || (u[j] == prefix && rank < need));
            need -= __popcll(eq);
            if (lane == j) mv = sel;
        }
        if (lane < nj) mask_rows[(size_t)ql * 32 + lane] = mv;
    }
}
constexpr int AT_K = 0, AT_V = 16384, AT_BT = 32768, AT_WS = 40960;
__device__ __forceinline__ void attn_half(const Frame& F, int b, int c, int half, LAS unsigned char* lds) {
    const int wid = F.wave, lane = F.lane, r = lane & 31, hi = lane >> 5;
    const size_t rowbase = (size_t)b * SEQ; const int q0 = 64 * c + 32 * half, nt = c + 1; const bool usemask = c >= 4;
    bf16x8 qr[4];
#pragma unroll
    for (int d0 = 0; d0 < 4; ++d0) qr[d0] = *(const bf16x8*)(F.QA + (rowbase + q0 + r) * 512 + wid * 64 + 16 * d0 + 8 * hi);
    const LAS float* BT = (const LAS float*)(lds + AT_BT) + wid * 256;
    const float farc = BT[0];
    const bf16* ksrc = F.KA + (rowbase + lane) * 64 + 8 * wid;
    const bf16* vsrc = F.VA + (rowbase + 16 * (wid & 3) + (lane >> 2)) * 64 + (wid >> 2) * 32 + (lane & 3) * 8;
    const unsigned long long* mrow = F.MASK + (rowbase + q0 + r) * 32;
    const int stoff = wid * 1024 + lane * 16;
    const int voff = ((lane >> 4) & 1) * 32 + (lane & 3) * 8 + (4 * hi + ((lane & 15) >> 2)) * 64;
    f32x16 o0, o1;
#pragma unroll
    for (int i = 0; i < 16; ++i) { o0[i] = 0.f; o1[i] = 0.f; }
    float lsum = 0.f;
    v4u kreg = *(const v4u*)ksrc, vreg = *(const v4u*)vsrc;
    unsigned long long mw = usemask ? mrow[0] : ~0ull;
    *(LAS v4u*)(lds + AT_K + stoff) = kreg; *(LAS v4u*)(lds + AT_V + stoff) = vreg;
    __syncthreads();
    for (int t = 0; t < nt; ++t) {
        const int cur = (t & 1) * 8192, nxt = 8192 - cur;
        unsigned long long mwn = ~0ull;
        if (t + 1 < nt) { kreg = *(const v4u*)(ksrc + (size_t)(t + 1) * 64 * 64); vreg = *(const v4u*)(vsrc + (size_t)(t + 1) * 64 * 64); if (usemask) mwn = mrow[t + 1]; }
        const LAS unsigned char* Kb = lds + AT_K + cur + hi * 1024 + r * 16; const LAS unsigned char* Vb = lds + AT_V + cur + voff;
        const bool nearT = t + 2 >= c;
        const float ci = nearT ? 0.f : farc;
        f32x16 p0, p1;
#pragma unroll
        for (int i = 0; i < 16; ++i) { p0[i] = ci; p1[i] = ci; }
#pragma unroll
        for (int d0 = 0; d0 < 4; ++d0) {
            const bf16x8 k0 = *(const LAS bf16x8*)(Kb + d0 * 2048), k1 = *(const LAS bf16x8*)(Kb + d0 * 2048 + 512);
            p0 = __builtin_amdgcn_mfma_f32_32x32x16_bf16(k0, qr[d0], p0, 0, 0, 0);
            p1 = __builtin_amdgcn_mfma_f32_32x32x16_bf16(k1, qr[d0], p1, 0, 0, 0);
        }
        if (nearT) {
            const LAS float* bt = BT + (64 * (t - c) + 191 - 32 * half - r + 4 * hi);
#pragma unroll
            for (int i = 0; i < 16; ++i) { p0[i] += bt[(i & 3) + 8 * (i >> 2)]; p1[i] += bt[32 + (i & 3) + 8 * (i >> 2)]; }
        }
#pragma unroll
        for (int i = 0; i < 16; ++i) { p0[i] = __builtin_amdgcn_exp2f(p0[i]); p1[i] = __builtin_amdgcn_exp2f(p1[i]); }
        if (usemask) {
            const unsigned long long ws_ = mw >> (4 * hi); const int lo = (int)(unsigned)ws_, hh = (int)(unsigned)(ws_ >> 32);
#pragma unroll
            for (int i = 0; i < 16; ++i) {
                p0[i] = __uint_as_float(__float_as_uint(p0[i]) & (unsigned)__builtin_amdgcn_sbfe(lo, (i & 3) + 8 * (i >> 2), 1));
                p1[i] = __uint_as_float(__float_as_uint(p1[i]) & (unsigned)__builtin_amdgcn_sbfe(hh, (i & 3) + 8 * (i >> 2), 1));
            }
        }
        float sa = 0.f;
#pragma unroll
        for (int i = 0; i < 16; ++i) sa += p0[i] + p1[i];
        lsum += sa;
        const bf16x8 pa0 = __builtin_bit_cast(bf16x8, (v4u){pkbf(p0[0], p0[1]), pkbf(p0[2], p0[3]), pkbf(p0[4], p0[5]), pkbf(p0[6], p0[7])});
        const bf16x8 pa1 = __builtin_bit_cast(bf16x8, (v4u){pkbf(p0[8], p0[9]), pkbf(p0[10], p0[11]), pkbf(p0[12], p0[13]), pkbf(p0[14], p0[15])});
        const bf16x8 pa2 = __builtin_bit_cast(bf16x8, (v4u){pkbf(p1[0], p1[1]), pkbf(p1[2], p1[3]), pkbf(p1[4], p1[5]), pkbf(p1[6], p1[7])});
        const bf16x8 pa3 = __builtin_bit_cast(bf16x8, (v4u){pkbf(p1[8], p1[9]), pkbf(p1[10], p1[11]), pkbf(p1[12], p1[13]), pkbf(p1[14], p1[15])});
        o0 = __builtin_amdgcn_mfma_f32_32x32x16_bf16(pa0, cat8(vtr(Vb + 0), vtr(Vb + 512)), o0, 0, 0, 0);
        o0 = __builtin_amdgcn_mfma_f32_32x32x16_bf16(pa1, cat8(vtr(Vb + 1024), vtr(Vb + 1536)), o0, 0, 0, 0);
        o0 = __builtin_amdgcn_mfma_f32_32x32x16_bf16(pa2, cat8(vtr(Vb + 2048), vtr(Vb + 2560)), o0, 0, 0, 0);
        o0 = __builtin_amdgcn_mfma_f32_32x32x16_bf16(pa3, cat8(vtr(Vb + 3072), vtr(Vb + 3584)), o0, 0, 0, 0);
        o1 = __builtin_amdgcn_mfma_f32_32x32x16_bf16(pa0, cat8(vtr(Vb + 4096), vtr(Vb + 4608)), o1, 0, 0, 0);
        o1 = __builtin_amdgcn_mfma_f32_32x32x16_bf16(pa1, cat8(vtr(Vb + 5120), vtr(Vb + 5632)), o1, 0, 0, 0);
        o1 = __builtin_amdgcn_mfma_f32_32x32x16_bf16(pa2, cat8(vtr(Vb + 6144), vtr(Vb + 6656)), o1, 0, 0, 0);
        o1 = __builtin_amdgcn_mfma_f32_32x32x16_bf16(pa3, cat8(vtr(Vb + 7168), vtr(Vb + 7680)), o1, 0, 0, 0);
        if (t + 1 < nt) { *(LAS v4u*)(lds + AT_K + nxt + stoff) = kreg; *(LAS v4u*)(lds + AT_V + nxt + stoff) = vreg; }
        mw = mwn;
        __syncthreads();
    }
    lsum += __shfl_xor(lsum, 32);
    LAS float* wsf = (LAS float*)(lds + AT_WS) + wid * 64;
    if (hi == 0) wsf[r] = lsum;
    LDS_WAIT(); asm volatile("" ::: "memory");
    bf16* orow = F.MIX + (rowbase + q0) * DM + wid * 64 + r;
#pragma unroll
    for (int i = 0; i < 16; ++i) {
        const int q = crow(i, hi); const float rl = 1.0f / wsf[q];
        orow[(size_t)q * DM] = (bf16)(pkbf(o0[i] * rl, 0.f) & 0xffffu); orow[(size_t)q * DM + 32] = (bf16)(pkbf(o1[i] * rl, 0.f) & 0xffffu);
    }
}
__device__ __forceinline__ void attn_unit(const Frame& F, int b, int c, LAS unsigned char* lds) {
    if (c >= 4) {
        float* scr = F.SCR + (size_t)blockIdx.x * 64 * 2048;
        idx_scores(F, b, c, scr);
        __syncthreads();
        unsigned long long* mrows = F.MASK + ((size_t)b * SEQ + 64 * c) * 32; const int nj = c + 1;
        if (nj <= 8) select_rows<8>(scr, mrows, nj, F.wave, F.lane);
        else if (nj <= 16) select_rows<16>(scr, mrows, nj, F.wave, F.lane);
        else if (nj <= 24) select_rows<24>(scr, mrows, nj, F.wave, F.lane);
        else select_rows<32>(scr, mrows, nj, F.wave, F.lane);
    }
    { const f32x4 v = *(const f32x4*)(F.BT + F.tid * 4); *(LAS f32x4*)(lds + AT_BT + F.tid * 16) = v; }
    __syncthreads();
    attn_half(F, b, c, 0, lds);
    attn_half(F, b, c, 1, lds);
}

constexpr int RT_Q = 0, RT_K = 16384, RT_KT = 32768, RT_V = 49152, RT_S = 65536, RT_Y = 81920;
__device__ __forceinline__ v4u scale8(v4u k, float f) {
    return (v4u){pkbf(bflo(k.x) * f, bfhi(k.x) * f), pkbf(bflo(k.y) * f, bfhi(k.y) * f), pkbf(bflo(k.z) * f, bfhi(k.z) * f), pkbf(bflo(k.w) * f, bfhi(k.w) * f)};
}
__device__ __forceinline__ void ret_unit(const Frame& F, int b, int h, LAS unsigned char* lds) {
    const int tid = F.tid, lane = F.lane, w = F.wave, r = lane & 31, hi = lane >> 5;
    const float gam = 1.0f - exp2f(-5.0f - (float)h), lg2 = log2f(gam), cdec = exp2f(64.0f * lg2);
    const int rB = 16 * (w & 3) + (lane >> 2), cB = (w >> 2) * 32 + (lane & 3) * 8;
    const float kdec = exp2f((float)(63 - rB) * lg2);
    const size_t base = (size_t)b * SEQ * 512 + h * 64;
    const bf16* qsrc = F.QB + base + (size_t)lane * 512 + 8 * w;
    const bf16* ksrc = F.KB + base + (size_t)lane * 512 + 8 * w;
    const bf16* k2src = F.KB + base + (size_t)rB * 512 + cB;
    const bf16* vsrc = F.VB + base + (size_t)rB * 512 + cB;
    const int ei = tid >> 3, eseg = tid & 7;
    const bf16* gsrc = F.GB + base + (size_t)ei * 512 + 8 * eseg;
    bf16* osrc = F.MIX + ((size_t)b * SEQ + ei) * DM + 512 + h * 64 + 8 * eseg;
    const f32x4 gw0 = *(const f32x4*)(F.ret_gn_w + h * 64 + 8 * eseg), gw1 = *(const f32x4*)(F.ret_gn_w + h * 64 + 8 * eseg + 4);
    const f32x4 gb0 = *(const f32x4*)(F.ret_gn_b + h * 64 + 8 * eseg), gb1 = *(const f32x4*)(F.ret_gn_b + h * 64 + 8 * eseg + 4);
    const int stoff = w * 1024 + lane * 16;
    const int voff = ((lane >> 4) & 1) * 32 + (lane & 3) * 8 + (4 * hi + ((lane & 15) >> 2)) * 64;
    f32x16 st;
#pragma unroll
    for (int i = 0; i < 16; ++i) st[i] = 0.f;
    *(LAS v4u*)(lds + RT_S + tid * 16) = (v4u){0u, 0u, 0u, 0u};
    v4u qreg = *(const v4u*)qsrc, kreg = *(const v4u*)ksrc, k2reg = *(const v4u*)k2src, vreg = *(const v4u*)vsrc;
    *(LAS v4u*)(lds + RT_Q + stoff) = qreg; *(LAS v4u*)(lds + RT_K + stoff) = kreg; *(LAS v4u*)(lds + RT_KT + stoff) = scale8(k2reg, kdec); *(LAS v4u*)(lds + RT_V + stoff) = vreg;
    __syncthreads();
    for (int n = 0; n < 32; ++n) {
        const int cur = (n & 1) * 8192, nxt = 8192 - cur;
        const size_t adv = (size_t)(n + 1) * 64 * 512;
        if (n + 1 < 32) { qreg = *(const v4u*)(qsrc + adv); kreg = *(const v4u*)(ksrc + adv); k2reg = *(const v4u*)(k2src + adv); vreg = *(const v4u*)(vsrc + adv); }
        const v4u greg = *(const v4u*)(gsrc + (size_t)n * 64 * 512);
        float lg2v = lg2; asm volatile("" : "+v"(lg2v));
        if (w < 4) {
            const int ib = w & 1, db = w >> 1;
            const LAS unsigned char* Qb = lds + RT_Q + cur + hi * 1024 + (32 * ib + r) * 16;
            const LAS unsigned char* Kb = lds + RT_K + cur + hi * 1024 + r * 16;
            const LAS unsigned char* Vb = lds + RT_V + cur + voff + db * 4096;
            const LAS unsigned char* Sb = lds + RT_S + cur + hi * 1024 + (32 * db + r) * 16;
            bf16x8 qf[4];
#pragma unroll
            for (int s = 0; s < 4; ++s) qf[s] = *(const LAS bf16x8*)(Qb + s * 2048);
            f32x16 s0, s1, yin, ycr;
#pragma unroll
            for (int i = 0; i < 16; ++i) { s0[i] = 0.f; s1[i] = 0.f; yin[i] = 0.f; ycr[i] = 0.f; }
#pragma unroll
            for (int s = 0; s < 4; ++s) s0 = __builtin_amdgcn_mfma_f32_32x32x16_bf16(*(const LAS bf16x8*)(Kb + s * 2048), qf[s], s0, 0, 0, 0);
            if (ib == 1) {
#pragma unroll
                for (int s = 0; s < 4; ++s) s1 = __builtin_amdgcn_mfma_f32_32x32x16_bf16(*(const LAS bf16x8*)(Kb + s * 2048 + 512), qf[s], s1, 0, 0, 0);
            }
#pragma unroll
            for (int i = 0; i < 16; ++i) {
                const int e0 = 32 * ib + r - crow(i, hi), e1 = e0 - 32;
                s0[i] *= (e0 >= 0) ? __builtin_amdgcn_exp2f((float)e0 * lg2v) : 0.f;
                s1[i] *= (e1 >= 0) ? __builtin_amdgcn_exp2f((float)e1 * lg2v) : 0.f;
            }
            const bf16x8 pa0 = __builtin_bit_cast(bf16x8, (v4u){pkbf(s0[0], s0[1]), pkbf(s0[2], s0[3]), pkbf(s0[4], s0[5]), pkbf(s0[6], s0[7])});
            const bf16x8 pa1 = __builtin_bit_cast(bf16x8, (v4u){pkbf(s0[8], s0[9]), pkbf(s0[10], s0[11]), pkbf(s0[12], s0[13]), pkbf(s0[14], s0[15])});
            yin = __builtin_amdgcn_mfma_f32_32x32x16_bf16(pa0, cat8(vtr(Vb + 0), vtr(Vb + 512)), yin, 0, 0, 0);
            yin = __builtin_amdgcn_mfma_f32_32x32x16_bf16(pa1, cat8(vtr(Vb + 1024), vtr(Vb + 1536)), yin, 0, 0, 0);
            if (ib == 1) {
                const bf16x8 pa2 = __builtin_bit_cast(bf16x8, (v4u){pkbf(s1[0], s1[1]), pkbf(s1[2], s1[3]), pkbf(s1[4], s1[5]), pkbf(s1[6], s1[7])});
                const bf16x8 pa3 = __builtin_bit_cast(bf16x8, (v4u){pkbf(s1[8], s1[9]), pkbf(s1[10], s1[11]), pkbf(s1[12], s1[13]), pkbf(s1[14], s1[15])});
                yin = __builtin_amdgcn_mfma_f32_32x32x16_bf16(pa2, cat8(vtr(Vb + 2048), vtr(Vb + 2560)), yin, 0, 0, 0);
                yin = __builtin_amdgcn_mfma_f32_32x32x16_bf16(pa3, cat8(vtr(Vb + 3072), vtr(Vb + 3584)), yin, 0, 0, 0);
            }
#pragma unroll
            for (int s = 0; s < 4; ++s) ycr = __builtin_amdgcn_mfma_f32_32x32x16_bf16(qf[s], *(const LAS bf16x8*)(Sb + s * 2048), ycr, 0, 0, 0);
            LAS float* Y = (LAS float*)(lds + RT_Y);
#pragma unroll
            for (int i = 0; i < 16; ++i) { const int ii = 32 * ib + crow(i, hi);
                Y[ii * 65 + 32 * db + r] = yin[i] + __builtin_amdgcn_exp2f((float)(ii + 1) * lg2v) * ycr[i]; }
        } else {
            const int eb = w & 1, db = (w >> 1) & 1;
            const LAS unsigned char* Kt = lds + RT_KT + cur + voff + eb * 4096;
            const LAS unsigned char* Vb = lds + RT_V + cur + voff + db * 4096;
            LAS unsigned char* Sn = lds + RT_S + nxt + (4 * eb) * 1024 + (32 * db + r) * 16 + hi * 8;
#pragma unroll
            for (int i = 0; i < 16; ++i) st[i] *= cdec;
#pragma unroll
            for (int ks = 0; ks < 4; ++ks)
                st = __builtin_amdgcn_mfma_f32_32x32x16_bf16(cat8(vtr(Kt + ks * 1024), vtr(Kt + ks * 1024 + 512)), cat8(vtr(Vb + ks * 1024), vtr(Vb + ks * 1024 + 512)), st, 0, 0, 0);
#pragma unroll
            for (int g = 0; g < 4; ++g) *(LAS v2u*)(Sn + g * 1024) = (v2u){pkbf(st[4 * g], st[4 * g + 1]), pkbf(st[4 * g + 2], st[4 * g + 3])};
        }
        __syncthreads();
        {
            const LAS float* Y = (const LAS float*)(lds + RT_Y) + ei * 65 + 8 * eseg;
            float y[8];
#pragma unroll
            for (int k = 0; k < 8; ++k) y[k] = Y[k];
            float s = ((y[0] + y[1]) + (y[2] + y[3])) + ((y[4] + y[5]) + (y[6] + y[7]));
            s += __shfl_xor(s, 1); s += __shfl_xor(s, 2); s += __shfl_xor(s, 4);
            const float mean = s * (1.0f / 64.0f); float v = 0.f;
#pragma unroll
            for (int k = 0; k < 8; ++k) { y[k] -= mean; v += y[k] * y[k]; }
            v += __shfl_xor(v, 1); v += __shfl_xor(v, 2); v += __shfl_xor(v, 4);
            const float rstd = 1.0f / sqrtf(v * (1.0f / 64.0f) + 1e-5f);
            const float o0 = (y[0] * rstd * gw0[0] + gb0[0]) * bflo(greg.x), o1 = (y[1] * rstd * gw0[1] + gb0[1]) * bfhi(greg.x);
            const float o2 = (y[2] * rstd * gw0[2] + gb0[2]) * bflo(greg.y), o3 = (y[3] * rstd * gw0[3] + gb0[3]) * bfhi(greg.y);
            const float o4 = (y[4] * rstd * gw1[0] + gb1[0]) * bflo(greg.z), o5 = (y[5] * rstd * gw1[1] + gb1[1]) * bfhi(greg.z);
            const float o6 = (y[6] * rstd * gw1[2] + gb1[2]) * bflo(greg.w), o7 = (y[7] * rstd * gw1[3] + gb1[3]) * bfhi(greg.w);
            *(v4u*)(osrc + (size_t)n * 64 * DM) = (v4u){pkbf(o0, o1), pkbf(o2, o3), pkbf(o4, o5), pkbf(o6, o7)};
        }
        if (n + 1 < 32) { *(LAS v4u*)(lds + RT_Q + nxt + stoff) = qreg; *(LAS v4u*)(lds + RT_K + nxt + stoff) = kreg; *(LAS v4u*)(lds + RT_KT + nxt + stoff) = scale8(k2reg, kdec); *(LAS v4u*)(lds + RT_V + nxt + stoff) = vreg; }
        __syncthreads();
    }
}
constexpr int N_RET = BATCH * 8, N_ATT = BATCH * 32, N_MIX = N_RET + N_ATT;
__device__ __forceinline__ void p2_mixers(Frame& F) {
    volatile LAS unsigned* misc = (volatile LAS unsigned*)(F.lds + MISC_OFF);
    for (;;) {
        __syncthreads();
        if (F.tid == 0) misc[0] = __hip_atomic_fetch_add(F.ctl, 1u, __ATOMIC_RELAXED, __HIP_MEMORY_SCOPE_AGENT);
        __syncthreads();
        const int u = (int)misc[0];
        if (u >= N_MIX) break;
        { int t_ = threadIdx.x; asm volatile("" : "+v"(t_)); F.tid = t_; F.lane = t_ & 63; }
#ifndef MIXSEL
#define MIXSEL 3
#endif
        if (u < N_RET) { if (MIXSEL & 1) ret_unit(F, u >> 3, u & 7, F.lds); }
        else { const int a = u - N_RET; if (MIXSEL & 2) attn_unit(F, a & 31, 31 - (a >> 5), F.lds); }
    }
}

struct Args { const float* in[16]; float* out; unsigned char* ws; int ph_lo, ph_hi; };
__global__ void __launch_bounds__(NTHR, 2) fwd_kernel(Args args) {
    extern __shared__ __attribute__((aligned(16))) unsigned char lds[];
    Frame F;
    F.lds = (LAS unsigned char*)lds;
    F.tid = threadIdx.x; F.lane = F.tid & 63; F.wave = __builtin_amdgcn_readfirstlane(F.tid >> 6);
    F.G = gridDim.x; { const int bx = blockIdx.x; F.vcu = (F.G % 8 == 0) ? (bx % 8) * (F.G / 8) + bx / 8 : bx; }
    unsigned char* ws = args.ws;
    F.ctl = (unsigned*)(ws + WS_CTL);
    F.x = args.in[0]; F.norm1_w = args.in[1]; F.w_in = args.in[2]; F.q_norm_w = args.in[3]; F.k_norm_w = args.in[4]; F.kv_norm_w = args.in[5]; F.w_uk = args.in[6]; F.w_uv = args.in[7];
    F.rel_bias = args.in[8]; F.ret_gn_w = args.in[9]; F.ret_gn_b = args.in[10]; F.w_out = args.in[11]; F.norm2_w = args.in[12]; F.w_gate = args.in[13]; F.w_up = args.in[14]; F.w_down = args.in[15];
    F.out = args.out;
    F.WIN = (bf16*)(ws + WS_WIN); F.WOUT = (bf16*)(ws + WS_WOUT); F.WGU = (bf16*)(ws + WS_WGU); F.WDN = (bf16*)(ws + WS_WDN);
    F.XB = (bf16*)(ws + WS_XB); F.MIX = (bf16*)(ws + WS_MIX); F.QA = (bf16*)(ws + WS_QA); F.QB = (bf16*)(ws + WS_QB); F.KB = (bf16*)(ws + WS_KB); F.VB = (bf16*)(ws + WS_VB); F.GB = (bf16*)(ws + WS_GB);
    F.KA = (bf16*)(ws + WS_KA); F.VA = (bf16*)(ws + WS_VA); F.IQ = (bf16*)(ws + WS_IQ); F.IK = (bf16*)(ws + WS_IK); F.ACT = (bf16*)(ws + WS_ACT);
    F.IW = (float*)(ws + WS_IW); F.R2 = (float*)(ws + WS_R2); F.COS = (float*)(ws + WS_COS); F.SIN = (float*)(ws + WS_SIN); F.BT = (float*)(ws + WS_BT); F.SCR = (float*)(ws + WS_SCR);
    F.MASK = (unsigned long long*)(ws + WS_MASK);
    const int lo = args.ph_lo, hi = args.ph_hi;
#ifndef PHSEL
#define PHSEL 63
#endif
#define IN(k) (((PHSEL >> (k)) & 1) && lo <= (k) && (k) < hi)
#define SEAM(k) do { if (IN(k) && IN((k) + 1)) cg::this_grid().sync(); } while (0)

    if (IN(0)) { p0_prologue(F); }
    SEAM(0);
    if (IN(1)) {
        pg8::Gemm g{F.XB, F.WIN, MTOK, NIN, DM}; pg8::StaticOrder S; S.init(MTOK, NIN, F.G, (int)blockIdx.x);
        pg8::EpiIn E{F.QA, F.KA, F.VA, F.IQ, F.IK, F.QB, F.KB, F.VB, F.GB, F.IW, F.q_norm_w, F.k_norm_w, F.COS, F.SIN, (LAS float*)(F.lds + XCH_OFF)};
        pg8::gemm_phase<pg8::EpiIn, pg8::StaticOrder, true, true>(F.lds, g, S, E);
    }
    SEAM(1);
    if (IN(2)) { p2_mixers(F); }
    SEAM(2);
    if (IN(3)) {
        pg8::Gemm g{F.MIX, F.WOUT, MTOK, DM, DM}; pg8::PanelOrder S{(int)blockIdx.x, 4};
        pg8::EpiOut E{F.x, F.out, F.XB, {0.f, 0.f, 0.f, 0.f, 0.f, 0.f, 0.f, 0.f}};
        if ((int)blockIdx.x < MTOK / 256) {
            pg8::gemm_phase<pg8::EpiOut, pg8::PanelOrder, true, true>(F.lds, g, S, E);
            const int wr = F.wave >> 2, wc = F.wave & 3, fr = F.lane & 15, fq = F.lane >> 4;
            LAS float* P = (LAS float*)(F.lds + XCH_OFF);
#pragma unroll
            for (int k = 0; k < 8; ++k) { float s = E.ss[k]; s += __shfl_xor(s, 16); s += __shfl_xor(s, 32);
                if (fq == 0) P[((k >> 2) * 128 + wr * 64 + (k & 3) * 16 + fr) * 4 + wc] = s; }
            __syncthreads();
            if (F.tid < 256) { const f32x4 p = *(const LAS f32x4*)(P + F.tid * 4);
                F.R2[(size_t)blockIdx.x * 256 + F.tid] = 1.0f / sqrtf(((p[0] + p[1]) + (p[2] + p[3])) * (1.0f / DM) + 1e-6f); }
        }
    }
    SEAM(3);
    if (IN(4)) {
        pg8::Gemm g{F.XB, F.WGU, MTOK, NGU, DM}; pg8::StaticOrder S; S.init(MTOK, NGU, F.G, (int)blockIdx.x);
        pg8::EpiGU E{F.R2, F.ACT};
        pg8::gemm_phase<pg8::EpiGU, pg8::StaticOrder, true, true>(F.lds, g, S, E);
    }
    SEAM(4);
    if (IN(5)) {
        pg8::Gemm g{F.ACT, F.WDN, MTOK, DM, FF}; pg8::StaticOrder S; S.init(MTOK, DM, F.G, (int)blockIdx.x);
        pg8::EpiDown E{F.out};
        pg8::gemm_phase<pg8::EpiDown, pg8::StaticOrder, true, true>(F.lds, g, S, E);
    }
#undef IN
#undef SEAM
}

extern "C" void kernel_launch(void* const* d_in, const int* in_sizes, int n_in, void* d_out, int out_size, void* d_ws, size_t ws_size, hipStream_t stream) {
    static int grid = 0;
    if (grid == 0) {
        if (n_in != 16 || in_sizes[0] != MTOK * DM || out_size != MTOK * DM || ws_size < WS_END) {
            fprintf(stderr, "kernel_launch: unexpected problem (n_in %d, in0 %d, out %d, ws %zu); nothing launched\n", n_in, n_in > 0 ? in_sizes[0] : -1, out_size, ws_size); grid = -1; return; }
        int dev = 0, cus = 0, per_cu = 0;
        if (hipGetDevice(&dev) != hipSuccess || hipDeviceGetAttribute(&cus, hipDeviceAttributeMultiprocessorCount, dev) != hipSuccess) { grid = -1; return; }
        if (hipFuncSetAttribute((const void*)fwd_kernel, hipFuncAttributeMaxDynamicSharedMemorySize, LDS_BYTES) != hipSuccess) { fprintf(stderr, "kernel_launch: hipFuncSetAttribute failed\n"); grid = -1; return; }
        if (hipOccupancyMaxActiveBlocksPerMultiprocessor(&per_cu, (const void*)fwd_kernel, NTHR, LDS_BYTES) != hipSuccess || per_cu < 1) { fprintf(stderr, "kernel_launch: occupancy query says %d blocks per CU\n", per_cu); (void)hipGetLastError(); grid = -1; return; }
        grid = cus;
        if (grid != 256) fprintf(stderr, "kernel_launch: %d CUs; this kernel is laid out for 256\n", grid);
    }
    if (grid < 0) return;
    Args a{};
    for (int i = 0; i < 16; ++i) a.in[i] = (const float*)d_in[i];
    a.out = (float*)d_out; a.ws = (unsigned char*)d_ws;
#if MK_N_LAUNCHES == 1
    a.ph_lo = 0; a.ph_hi = N_PHASES;
    void* kargs[] = {&a};
    hipError_t e = hipLaunchCooperativeKernel((const void*)fwd_kernel, dim3(grid), dim3(NTHR), kargs, LDS_BYTES, stream);
    if (e != hipSuccess) fprintf(stderr, "kernel_launch: cooperative launch failed: %s (grid %d)\n", hipGetErrorString(e), grid);
#else
    for (int p = 0; p < N_PHASES; ++p) { a.ph_lo = p; a.ph_hi = p + 1; hipLaunchKernelGGL(fwd_kernel, dim3(grid), dim3(NTHR), LDS_BYTES, stream, a); }
#endif
}
```

```cpp
#include <hip/hip_runtime.h>
#include <hip/hip_cooperative_groups.h>
#include <cstdio>
#include <cstdint>
namespace cg = cooperative_groups;
namespace pg8 {
#define PG8_LAS __attribute__((address_space(3)))
typedef unsigned short bf16_t;
typedef short bf16x8 __attribute__((ext_vector_type(8)));
typedef float f32x4 __attribute__((ext_vector_type(4)));
typedef unsigned u32x4 __attribute__((ext_vector_type(4)));
constexpr int BM = 256, BK = 64, HALF = 128, HTB = HALF * BK * 2  , STAGE_BYTES = 8 * HTB, NXCD = 8, WGM = 8;

__host__ __device__ __forceinline__ int lds_byte(int r, int c) { const int st = (r >> 4) * 2 + (c >> 5), rr = r & 15, cc = c & 31, ob = rr * 64 + cc * 2; return st * 1024 + (ob ^ (((ob >> 9) & 1) << 5)); }
__host__ __device__ __forceinline__ void stage_rc(int b, int& R, int& C) { const int st = b / 1024, sb = b % 1024, swz = sb ^ (((sb >> 9) & 1) << 5); R = (st >> 1) * 16 + swz / 64; C = (st & 1) * 32 + (swz % 64) / 2; }
__host__ __device__ __forceinline__ int perm32(int rho) { const int n = rho >> 4, i = rho & 15; return 8 * (i >> 2) + 4 * n + (i & 3); }

struct Unit { int pm, pn; };
struct Gemm { const bf16_t* A; const bf16_t* Bt; int M, N, K; };

struct StaticOrder {
    int nM, nN, nwg, G, c;
    __host__ __device__ void init(int M, int N, int G_, int c_) { nM = M / BM; nN = N / BM; nwg = nM * nN; G = G_; c = c_; }
    __host__ __device__ bool next(int i, Unit& u) const {
        const long L = (long)i * G + c; if (L >= nwg) return false;
        int wgid = (int)L; { const int q = nwg / NXCD, r = nwg % NXCD, xcd = wgid % NXCD, off = wgid / NXCD; wgid = (xcd < r ? xcd * (q + 1) : r * (q + 1) + (xcd - r) * q) + off; }
        const int nig = WGM * nN, gid = wgid / nig, fm = gid * WGM, gsz = (nM - fm) < WGM ? (nM - fm) : WGM;
        u.pm = fm + ((wgid % nig) % gsz); u.pn = (wgid % nig) / gsz; return true;
    }
    __device__ __forceinline__ void a_ready(const Unit&) const {}
    __device__ __forceinline__ void done(const Unit&) const {}
};

__device__ __forceinline__ unsigned cvt_pk_bf16(float lo, float hi) { unsigned r; asm volatile("v_cvt_pk_bf16_f32 %0, %1, %2" : "=v"(r) : "v"(lo), "v"(hi)); return r; }
typedef float f32x2 __attribute__((ext_vector_type(2)));
typedef __bf16 bf16x2_t __attribute__((ext_vector_type(2)));
typedef unsigned u32x2 __attribute__((ext_vector_type(2)));
__device__ __forceinline__ unsigned pkbf(float lo, float hi) { f32x2 v = {lo, hi}; bf16x2_t b = __builtin_convertvector(v, bf16x2_t); return __builtin_bit_cast(unsigned, b); }
__device__ __forceinline__ u32x4 pk8(f32x4 a, f32x4 b) { return (u32x4){pkbf(a[0], a[1]), pkbf(a[2], a[3]), pkbf(b[0], b[1]), pkbf(b[2], b[3])}; }
__device__ __forceinline__ float dot4(f32x4 a) { return (a[0] * a[0] + a[1] * a[1]) + (a[2] * a[2] + a[3] * a[3]); }
__device__ __forceinline__ float sum4(f32x4 a) { return (a[0] + a[1]) + (a[2] + a[3]); }
__device__ __forceinline__ float silu1(float v) { return v / (1.0f + __expf(-v)); }
__device__ __forceinline__ f32x4 silu4(f32x4 v) { return (f32x4){silu1(v[0]), silu1(v[1]), silu1(v[2]), silu1(v[3])}; }
constexpr float RMS_EPS_F = 1e-6f;
constexpr float QSCALE = 0.125f * 1.4426950408889634f;

struct EpiIn {
    static constexpr bool PERM = true, AFTER_DRAIN = false;
    bf16_t *QA, *KA, *VA, *IQ, *IK, *QB, *KB, *VB, *GB; float* IW;
    const float *qnw, *knw, *cosT, *sinT;
    PG8_LAS float* xch;
    __device__ __forceinline__ void operator()(const f32x4 (&acc)[2][2][4][2], const Unit& u, int wr, int wc, int fr, int fq) {
        const int row0 = u.pm * BM + wr * 64 + fr, pn = u.pn;
        if (pn < 2) {
            const int head = 4 * pn + wc;
            const f32x4 w0 = *(const f32x4*)(qnw + 8 * fq), w1 = *(const f32x4*)(qnw + 8 * fq + 4), w2 = *(const f32x4*)(qnw + 32 + 8 * fq), w3 = *(const f32x4*)(qnw + 36 + 8 * fq);
#pragma unroll
            for (int ai = 0; ai < 2; ++ai)
#pragma unroll
                for (int m = 0; m < 4; ++m) {
                    f32x4 a0 = acc[ai][0][m][0], a1 = acc[ai][0][m][1], b0 = acc[ai][1][m][0], b1 = acc[ai][1][m][1];
                    float ss = (dot4(a0) + dot4(a1)) + (dot4(b0) + dot4(b1));
                    ss += __shfl_xor(ss, 16); ss += __shfl_xor(ss, 32);
                    const float rs = QSCALE / sqrtf(ss * (1.0f / 64.0f) + RMS_EPS_F);
                    bf16_t* p = QA + (size_t)(row0 + ai * HALF + m * 16) * 512 + head * 64 + 8 * fq;
                    *(u32x4*)p = pk8(a0 * w0 * rs, a1 * w1 * rs); *(u32x4*)(p + 32) = pk8(b0 * w2 * rs, b1 * w3 * rs);
                }
        } else if (pn == 2) {
            if (wc >= 2) {
#pragma unroll
                for (int ai = 0; ai < 2; ++ai)
#pragma unroll
                    for (int m = 0; m < 4; ++m) {
                        float ss = (dot4(acc[ai][0][m][0]) + dot4(acc[ai][0][m][1])) + (dot4(acc[ai][1][m][0]) + dot4(acc[ai][1][m][1]));
                        ss += __shfl_xor(ss, 16); ss += __shfl_xor(ss, 32);
                        if (fq == 0) xch[(ai * HALF + wr * 64 + m * 16 + fr) * 2 + (wc - 2)] = ss;
                    }
            }
            asm volatile("s_waitcnt lgkmcnt(0)" ::: "memory"); __builtin_amdgcn_s_barrier(); asm volatile("" ::: "memory");
            if (wc < 2) {
                const f32x4 w0 = *(const f32x4*)(knw + 8 * fq), w1 = *(const f32x4*)(knw + 8 * fq + 4), w2 = *(const f32x4*)(knw + 32 + 8 * fq), w3 = *(const f32x4*)(knw + 36 + 8 * fq);
#pragma unroll
                for (int ai = 0; ai < 2; ++ai)
#pragma unroll
                    for (int m = 0; m < 4; ++m) {
                        const int rl = ai * HALF + wr * 64 + m * 16 + fr;
                        const f32x2 pr = *(const PG8_LAS f32x2*)(xch + rl * 2);
                        const float rc = 1.0f / sqrtf((pr[0] + pr[1]) * (1.0f / 128.0f) + RMS_EPS_F);
                        f32x4 a0 = acc[ai][0][m][0] * rc, a1 = acc[ai][0][m][1] * rc, b0 = acc[ai][1][m][0] * rc, b1 = acc[ai][1][m][1] * rc;
                        const size_t row = (size_t)(row0 + ai * HALF + m * 16);
                        if (wc == 0) {
                            float ss = (dot4(a0) + dot4(a1)) + (dot4(b0) + dot4(b1));
                            ss += __shfl_xor(ss, 16); ss += __shfl_xor(ss, 32);
                            const float rs = 1.0f / sqrtf(ss * (1.0f / 64.0f) + RMS_EPS_F);
                            bf16_t* p = KA + row * 64 + 8 * fq;
                            *(u32x4*)p = pk8(a0 * w0 * rs, a1 * w1 * rs); *(u32x4*)(p + 32) = pk8(b0 * w2 * rs, b1 * w3 * rs);
                        } else {
                            bf16_t* p = VA + row * 64 + 8 * fq;
                            *(u32x4*)p = pk8(a0, a1); *(u32x4*)(p + 32) = pk8(b0, b1);
                        }
                    }
            }
        } else if (pn == 3) {
#pragma unroll
            for (int ai = 0; ai < 2; ++ai)
#pragma unroll
                for (int m = 0; m < 4; ++m) {
                    const size_t row = (size_t)(row0 + ai * HALF + m * 16);
                    *(u32x4*)(IQ + row * 128 + 32 * wc + 8 * fq) = pk8(acc[ai][0][m][0], acc[ai][0][m][1]);
                    if (wc == 0) *(u32x4*)(IK + row * 32 + 8 * fq) = pk8(acc[ai][1][m][0], acc[ai][1][m][1]);
                    if (wc == 1 && fq == 0) *(f32x4*)(IW + row * 4) = acc[ai][1][m][0];
                }
        } else if (pn < 8) {
            const int head = 4 * (pn & 1) + wc; bf16_t* dst = pn < 6 ? QB : KB; const float sc = pn < 6 ? 1.0f : 0.125f;
#pragma unroll
            for (int ai = 0; ai < 2; ++ai)
#pragma unroll
                for (int m = 0; m < 4; ++m) {
                    const int row = row0 + ai * HALF + m * 16, pos = row & 2047;
                    const f32x4 c0 = *(const f32x4*)(cosT + pos * 32 + 8 * fq) * sc, c1 = *(const f32x4*)(cosT + pos * 32 + 8 * fq + 4) * sc;
                    const f32x4 s0 = *(const f32x4*)(sinT + pos * 32 + 8 * fq) * sc, s1 = *(const f32x4*)(sinT + pos * 32 + 8 * fq + 4) * sc;
                    const f32x4 a0 = acc[ai][0][m][0], a1 = acc[ai][0][m][1], b0 = acc[ai][1][m][0], b1 = acc[ai][1][m][1];
                    bf16_t* p = dst + (size_t)row * 512 + head * 64 + 8 * fq;
                    *(u32x4*)p = pk8(a0 * c0 - b0 * s0, a1 * c1 - b1 * s1); *(u32x4*)(p + 32) = pk8(a0 * s0 + b0 * c0, a1 * s1 + b1 * c1);
                }
        } else {
            const int head = 4 * (pn & 1) + wc; bf16_t* dst = pn < 10 ? VB : GB; const bool act = pn >= 10;
#pragma unroll
            for (int ai = 0; ai < 2; ++ai)
#pragma unroll
                for (int m = 0; m < 4; ++m) {
                    f32x4 a0 = acc[ai][0][m][0], a1 = acc[ai][0][m][1], b0 = acc[ai][1][m][0], b1 = acc[ai][1][m][1];
                    if (act) { a0 = silu4(a0); a1 = silu4(a1); b0 = silu4(b0); b1 = silu4(b1); }
                    bf16_t* p = dst + (size_t)(row0 + ai * HALF + m * 16) * 512 + head * 64 + 8 * fq;
                    *(u32x4*)p = pk8(a0, a1); *(u32x4*)(p + 32) = pk8(b0, b1);
                }
        }
    }
};

struct EpiOut {
    static constexpr bool PERM = true, AFTER_DRAIN = false;
    const float* x; float* out; bf16_t* x1b; float ss[8];
    __device__ __forceinline__ void operator()(const f32x4 (&acc)[2][2][4][2], const Unit& u, int wr, int wc, int fr, int fq) {
        const int row0 = u.pm * BM + wr * 64 + fr, col0 = u.pn * BM + wc * 32 + 8 * fq;
#pragma unroll
        for (int ai = 0; ai < 2; ++ai)
#pragma unroll
            for (int m = 0; m < 4; ++m) {
                const size_t off = (size_t)(row0 + ai * HALF + m * 16) * 1024 + col0; float s = 0.f;
#pragma unroll
                for (int bj = 0; bj < 2; ++bj) {
                    const f32x4 r0 = *(const f32x4*)(x + off + bj * HALF) + acc[ai][bj][m][0], r1 = *(const f32x4*)(x + off + bj * HALF + 4) + acc[ai][bj][m][1];
                    *(f32x4*)(out + off + bj * HALF) = r0; *(f32x4*)(out + off + bj * HALF + 4) = r1;
                    *(u32x4*)(x1b + off + bj * HALF) = pk8(r0, r1);
                    s += dot4(r0) + dot4(r1);
                }
                ss[ai * 4 + m] += s;
            }
    }
};

struct EpiGU {
    static constexpr bool PERM = true, AFTER_DRAIN = false;
    const float* r2; bf16_t* act;
    __device__ __forceinline__ void operator()(const f32x4 (&acc)[2][2][4][2], const Unit& u, int wr, int wc, int fr, int fq) {
        const int row0 = u.pm * BM + wr * 64 + fr, col0 = u.pn * HALF + wc * 32 + 8 * fq;
#pragma unroll
        for (int ai = 0; ai < 2; ++ai)
#pragma unroll
            for (int m = 0; m < 4; ++m) {
                const int row = row0 + ai * HALF + m * 16; const float rr = r2[row];
                const f32x4 g0 = acc[ai][0][m][0] * rr, g1 = acc[ai][0][m][1] * rr, u0 = acc[ai][1][m][0] * rr, u1 = acc[ai][1][m][1] * rr;
                *(u32x4*)(act + (size_t)row * 2816 + col0) = pk8(silu4(g0) * u0, silu4(g1) * u1);
            }
    }
};

struct EpiDown {
    static constexpr bool PERM = true, AFTER_DRAIN = false;
    float* out;
    __device__ __forceinline__ void operator()(const f32x4 (&acc)[2][2][4][2], const Unit& u, int wr, int wc, int fr, int fq) {
        const int row0 = u.pm * BM + wr * 64 + fr, col0 = u.pn * BM + wc * 32 + 8 * fq;
#pragma unroll
        for (int ai = 0; ai < 2; ++ai)
#pragma unroll
            for (int m = 0; m < 4; ++m) {
                const size_t off = (size_t)(row0 + ai * HALF + m * 16) * 1024 + col0;
#pragma unroll
                for (int bj = 0; bj < 2; ++bj) {
                    const f32x4 r0 = *(const f32x4*)(out + off + bj * HALF) + acc[ai][bj][m][0], r1 = *(const f32x4*)(out + off + bj * HALF + 4) + acc[ai][bj][m][1];
                    *(f32x4*)(out + off + bj * HALF) = r0; *(f32x4*)(out + off + bj * HALF + 4) = r1;
                }
            }
    }
};

struct PanelOrder {
    int pm, ntn;
    __device__ __forceinline__ bool next(int i, Unit& u) const { if (i >= ntn) return false; u.pm = pm; u.pn = i; return true; }
    __device__ __forceinline__ void a_ready(const Unit&) const {}
    __device__ __forceinline__ void done(const Unit&) const {}
};

template <class Epi, class Sched, bool ALIGN_EPI = false, bool SP2 = false>
__device__ __forceinline__ void gemm_phase(PG8_LAS unsigned char* lds, const Gemm g, const Sched& S, Epi& E) {
    const int tid = threadIdx.x, wid = __builtin_amdgcn_readfirstlane(tid >> 6), lane = tid & 63, wr = wid >> 2, wc = wid & 3, fr = lane & 15, fq = lane >> 4;
    const int K = g.K, nt = K / BK;
    unsigned voffA[2], voffB[2];
#pragma unroll
    for (int i = 0; i < 2; ++i) { int R, C; stage_rc(tid * 16 + i * 8192, R, C); const int Rb = Epi::PERM ? ((R & ~31) + perm32(R & 31)) : R;
        voffA[i] = (unsigned)(R * K + C) * 2u; voffB[i] = (unsigned)(Rb * K + C) * 2u; }
    const size_t kstep = (size_t)(BK * 2);
    const size_t hstep = (size_t)HALF * K * 2;
    const size_t tstep = 2 * hstep;
    const unsigned ldsw = (unsigned)wid * 1024u;
    const int aoff = lds_byte(wr * 64 + fr, fq * 8), boff = lds_byte(wc * 32 + fr, fq * 8);
#define PG8_SA(b, h) (((b) * 2 + (h)) * HTB)
#define PG8_SB(b, h) ((4 + (b) * 2 + (h)) * HTB)
#define PG8_STAGE(bufoff, gbase, voff) do { _Pragma("unroll") for (int _i = 0; _i < 2; ++_i) \
        __builtin_amdgcn_global_load_lds((const unsigned*)((const char*)(gbase) + (voff)[_i]), (PG8_LAS unsigned*)(lds + (bufoff) + ldsw + _i * 8192), 16, 0, 0); } while (0)
#define PG8_LDA(dst, b, h) do { _Pragma("unroll") for (int m = 0; m < 4; ++m) _Pragma("unroll") for (int k = 0; k < 2; ++k) dst[m][k] = *(const PG8_LAS bf16x8*)(lds + PG8_SA(b, h) + aoff + m * 2048 + k * 1024); } while (0)
#define PG8_LDB(dst, b, h) do { _Pragma("unroll") for (int n = 0; n < 2; ++n) _Pragma("unroll") for (int k = 0; k < 2; ++k) dst[n][k] = *(const PG8_LAS bf16x8*)(lds + PG8_SB(b, h) + boff + n * 2048 + k * 1024); } while (0)
#define PG8_MMA(ai, bj, At, Bt) do { __builtin_amdgcn_s_setprio(1); _Pragma("unroll") for (int m = 0; m < 4; ++m) _Pragma("unroll") for (int n = 0; n < 2; ++n) _Pragma("unroll") for (int k = 0; k < 2; ++k) \
        acc[ai][bj][m][n] = __builtin_amdgcn_mfma_f32_16x16x32_bf16(Bt[n][k], At[m][k], acc[ai][bj][m][n], 0, 0, 0); __builtin_amdgcn_s_setprio(0); } while (0)
#define PG8_WAIT_V(n) asm volatile("s_waitcnt vmcnt(" #n ")" ::: "memory")
#define PG8_WAIT_L(n) asm volatile("s_waitcnt lgkmcnt(" #n ")" ::: "memory")
#define PG8_BAR __builtin_amdgcn_s_barrier()
#define PG8_SCHED __builtin_amdgcn_sched_barrier(0)
    Unit cur, nxt; int ui = 0;
    if (!S.next(0, cur)) return;
    f32x4 acc[2][2][4][2];
#pragma unroll
    for (int a = 0; a < 2; ++a)
#pragma unroll
        for (int b = 0; b < 2; ++b)
#pragma unroll
            for (int m = 0; m < 4; ++m)
#pragma unroll
                for (int n = 0; n < 2; ++n) acc[a][b][m][n] = (f32x4){0.f, 0.f, 0.f, 0.f};
    bf16x8 At[4][2], B0[2][2], B1[2][2];
    const char* cA = (const char*)g.A + (size_t)cur.pm * tstep; const char* cB = (const char*)g.Bt + (size_t)cur.pn * tstep;
    S.a_ready(cur);
    if constexpr (SP2) {
        PG8_STAGE(PG8_SB(0, 0), cB, voffB); PG8_STAGE(PG8_SB(0, 1), cB + hstep, voffB); PG8_STAGE(PG8_SA(0, 0), cA, voffA); PG8_STAGE(PG8_SA(0, 1), cA + hstep, voffA);
        if (wr == 1) PG8_BAR;
        PG8_WAIT_V(2); PG8_BAR;
        PG8_STAGE(PG8_SB(1, 0), cB + kstep, voffB); PG8_STAGE(PG8_SA(1, 0), cA + kstep, voffA); PG8_STAGE(PG8_SB(1, 1), cB + hstep + kstep, voffB);
        PG8_WAIT_V(6); PG8_BAR;
    } else {
        PG8_STAGE(PG8_SB(0, 0), cB, voffB); PG8_STAGE(PG8_SA(0, 0), cA, voffA); PG8_STAGE(PG8_SB(0, 1), cB + hstep, voffB); PG8_STAGE(PG8_SA(0, 1), cA + hstep, voffA);
        if (wr == 1) PG8_BAR;
        PG8_WAIT_V(4); PG8_BAR;
        PG8_STAGE(PG8_SB(1, 0), cB + kstep, voffB); PG8_STAGE(PG8_SA(1, 0), cA + kstep, voffA); PG8_STAGE(PG8_SB(1, 1), cB + hstep + kstep, voffB);
        PG8_WAIT_V(6); PG8_BAR;
    }
    for (;;) {
        const bool has_next = S.next(ui + 1, nxt);
        const char* nA = has_next ? (const char*)g.A + (size_t)nxt.pm * tstep : cA; const char* nB = has_next ? (const char*)g.Bt + (size_t)nxt.pn * tstep : cB;
        for (int t = 0; t < nt; t += 2) {
            const bool last = (t == nt - 2);
            const char* a1 = cA + (size_t)(t + 1) * kstep;
            const char* a2 = last ? nA : cA + (size_t)(t + 2) * kstep; const char* b2 = last ? nB : cB + (size_t)(t + 2) * kstep;
            const char* a3 = a2 + kstep; const char* b3 = b2 + kstep;
            if (last && has_next) S.a_ready(nxt);
            if constexpr (SP2) {
            PG8_LDB(B0, 0, 0); PG8_LDB(B1, 0, 1); PG8_SCHED; PG8_LDA(At, 0, 0); PG8_STAGE(PG8_SA(1, 1), a1 + hstep, voffA);
            PG8_WAIT_V(8); PG8_WAIT_L(0); PG8_BAR; PG8_MMA(0, 0, At, B0); PG8_MMA(0, 1, At, B1); PG8_BAR; PG8_SCHED;
            PG8_LDA(At, 0, 1); PG8_STAGE(PG8_SB(0, 0), b2, voffB); PG8_STAGE(PG8_SB(0, 1), b2 + hstep, voffB); PG8_STAGE(PG8_SA(0, 0), a2, voffA);
            PG8_WAIT_V(8); PG8_WAIT_L(0); PG8_BAR; PG8_MMA(1, 0, At, B0); PG8_MMA(1, 1, At, B1); PG8_BAR; PG8_SCHED;
            PG8_LDB(B0, 1, 0); PG8_LDB(B1, 1, 1); PG8_SCHED; PG8_LDA(At, 1, 0); PG8_STAGE(PG8_SA(0, 1), a2 + hstep, voffA);
            PG8_WAIT_V(8); PG8_WAIT_L(0); PG8_BAR; PG8_MMA(0, 0, At, B0); PG8_MMA(0, 1, At, B1); PG8_BAR; PG8_SCHED;
            PG8_LDA(At, 1, 1); PG8_STAGE(PG8_SB(1, 0), b3, voffB); PG8_STAGE(PG8_SB(1, 1), b3 + hstep, voffB); PG8_STAGE(PG8_SA(1, 0), a3, voffA);
            PG8_WAIT_V(8); PG8_WAIT_L(0); PG8_BAR; PG8_MMA(1, 0, At, B0); PG8_MMA(1, 1, At, B1); PG8_BAR; PG8_SCHED;
            } else {
            PG8_LDB(B0, 0, 0); PG8_SCHED; PG8_LDA(At, 0, 0); PG8_STAGE(PG8_SA(1, 1), a1 + hstep, voffA);
            PG8_WAIT_L(8); PG8_BAR; PG8_WAIT_L(0); PG8_MMA(0, 0, At, B0); PG8_BAR; PG8_SCHED;
            PG8_LDB(B1, 0, 1); PG8_STAGE(PG8_SB(0, 0), b2, voffB);
            PG8_BAR; PG8_WAIT_L(0); PG8_MMA(0, 1, At, B1); PG8_BAR;
            PG8_LDA(At, 0, 1); PG8_STAGE(PG8_SA(0, 0), a2, voffA);
            PG8_BAR; PG8_WAIT_L(0); PG8_MMA(1, 0, At, B0); PG8_BAR; PG8_SCHED;
            PG8_STAGE(PG8_SB(0, 1), b2 + hstep, voffB);
            PG8_WAIT_V(6); PG8_BAR; PG8_MMA(1, 1, At, B1); PG8_BAR;
            PG8_LDB(B0, 1, 0); PG8_SCHED; PG8_LDA(At, 1, 0); PG8_STAGE(PG8_SA(0, 1), a2 + hstep, voffA);
            PG8_WAIT_L(8); PG8_BAR; PG8_WAIT_L(0); PG8_MMA(0, 0, At, B0); PG8_BAR; PG8_SCHED;
            PG8_LDB(B1, 1, 1); PG8_STAGE(PG8_SB(1, 0), b3, voffB);
            PG8_BAR; PG8_WAIT_L(0); PG8_MMA(0, 1, At, B1); PG8_BAR;
            PG8_LDA(At, 1, 1); PG8_STAGE(PG8_SA(1, 0), a3, voffA);
            PG8_BAR; PG8_WAIT_L(0); PG8_MMA(1, 0, At, B0); PG8_BAR; PG8_SCHED;
            PG8_STAGE(PG8_SB(1, 1), b3 + hstep, voffB);
            PG8_WAIT_V(6); PG8_BAR; PG8_MMA(1, 1, At, B1); PG8_BAR;
            }
        }
        if constexpr (ALIGN_EPI) { if (wr == 0) PG8_BAR; }
        if constexpr (!Epi::AFTER_DRAIN) { E(acc, cur, wr, wc, fr, fq); S.done(cur); }
        if (!has_next) break;
#pragma unroll
        for (int a = 0; a < 2; ++a)
#pragma unroll
            for (int b = 0; b < 2; ++b)
#pragma unroll
                for (int m = 0; m < 4; ++m)
#pragma unroll
                    for (int n = 0; n < 2; ++n) acc[a][b][m][n] = (f32x4){0.f, 0.f, 0.f, 0.f};
        cur = nxt; cA = nA; cB = nB; ++ui;
        if constexpr (ALIGN_EPI) { if (wr == 1) PG8_BAR; }
    }
    PG8_WAIT_V(0);
    if constexpr (!ALIGN_EPI) { if (wr == 0) PG8_BAR; }
    PG8_BAR;
    (void)lane;
#undef PG8_SA
#undef PG8_SB
#undef PG8_STAGE
#undef PG8_LDA
#undef PG8_LDB
#undef PG8_MMA
#undef PG8_WAIT_V
#undef PG8_WAIT_L
#undef PG8_BAR
#undef PG8_SCHED
}
}

constexpr int BATCH = 32, SEQ = 2048, DM = 1024, MTOK = BATCH * SEQ;
constexpr int INW = 2852, NIN = 3072, FF = 2816, NGU = 2 * FF;
constexpr int NWAVES = 8, NTHR = 512;
#ifndef MK_N_LAUNCHES
#define MK_N_LAUNCHES 1
#endif
constexpr int N_PHASES = 6;
constexpr size_t MiB = 1u << 20;
constexpr size_t WS_CTL = 0;
constexpr size_t WS_COS = 1 * MiB, WS_SIN = WS_COS + 256 * 1024;
constexpr size_t WS_BT = WS_SIN + 256 * 1024;
constexpr size_t WS_R2 = 2 * MiB;
constexpr size_t WS_WIN = 4 * MiB, WS_WOUT = 10 * MiB, WS_WGU = 12 * MiB, WS_WDN = 23 * MiB;
constexpr size_t WS_XB = 32 * MiB;
constexpr size_t WS_MIX = 160 * MiB;
constexpr size_t WS_QA = 288 * MiB, WS_QB = 352 * MiB, WS_KB = 416 * MiB, WS_VB = 480 * MiB, WS_GB = 544 * MiB;
constexpr size_t WS_KA = 608 * MiB, WS_VA = 616 * MiB;
constexpr size_t WS_IQ = 624 * MiB;
constexpr size_t WS_ACT = 288 * MiB;
constexpr size_t WS_IK = 640 * MiB, WS_IW = 644 * MiB;
constexpr size_t WS_MASK = 648 * MiB;
constexpr size_t WS_SCR = 672 * MiB;
constexpr size_t WS_END = 800 * MiB;
static_assert(WS_ACT + (size_t)MTOK * FF * 2 <= WS_IK && WS_IQ + (size_t)MTOK * 128 * 2 <= WS_IK && WS_WDN + (size_t)DM * FF * 2 <= WS_XB && WS_WGU + (size_t)NGU * DM * 2 <= WS_WDN, "d_ws map");
constexpr int RING_BYTES = 131072;
constexpr int XCH_OFF = RING_BYTES;
constexpr int MISC_OFF = RING_BYTES + 4096;
constexpr int LDS_BYTES = 147456;

#define LAS __attribute__((address_space(3)))
typedef unsigned short bf16;
typedef unsigned v4u __attribute__((ext_vector_type(4)));
typedef unsigned v2u __attribute__((ext_vector_type(2)));
typedef float f32x4 __attribute__((ext_vector_type(4)));
typedef float f32x16 __attribute__((ext_vector_type(16)));
typedef short bf16x8 __attribute__((ext_vector_type(8)));
typedef short s16x4 __attribute__((ext_vector_type(4)));
#define LDS_WAIT() asm volatile("s_waitcnt lgkmcnt(0)" ::: "memory")
using pg8::pkbf;
__device__ __forceinline__ float bf2f(unsigned short h) { return __uint_as_float((unsigned)h << 16); }
__device__ __forceinline__ float bflo(unsigned w) { return __uint_as_float(w << 16); }
__device__ __forceinline__ float bfhi(unsigned w) { return __uint_as_float(w & 0xffff0000u); }
__device__ __forceinline__ float wave_sum(float v) {
#pragma unroll
    for (int o = 1; o < 64; o <<= 1) v += __shfl_xor(v, o);
    return v;
}
__device__ __forceinline__ s16x4 vtr(const LAS unsigned char* p) { return __builtin_bit_cast(s16x4, __builtin_amdgcn_ds_read_tr16_b64_v4i16((LAS s16x4*)p)); }
__device__ __forceinline__ bf16x8 cat8(s16x4 lo, s16x4 hi) { return (bf16x8){lo[0], lo[1], lo[2], lo[3], hi[0], hi[1], hi[2], hi[3]}; }
__device__ __forceinline__ int crow(int r, int hi) { return (r & 3) + 8 * (r >> 2) + 4 * hi; }

struct Frame {
    LAS unsigned char* lds;
    unsigned* ctl;
    int tid, lane, wave, vcu, G;
    const float *x, *norm1_w, *w_in, *q_norm_w, *k_norm_w, *kv_norm_w, *w_uk, *w_uv, *rel_bias, *ret_gn_w, *ret_gn_b, *w_out, *norm2_w, *w_gate, *w_up, *w_down;
    float* out;
    bf16 *WIN, *WOUT, *WGU, *WDN, *XB, *MIX, *QA, *QB, *KB, *VB, *GB, *KA, *VA, *IQ, *IK, *ACT;
    float *IW, *R2, *COS, *SIN, *BT, *SCR;
    unsigned long long* MASK;
};

__device__ __forceinline__ int zcol(int n) {
    const int pn = n >> 8, tc = n & 255, bj = tc >> 7, wc = (tc >> 5) & 3, j = tc & 31, d = bj * 32 + j;
    if (pn < 2) return (4 * pn + wc) * 64 + d;
    if (pn == 2) { if (wc == 0) return -2 - d; if (wc == 1) return -2 - (64 + d); return 512 + (wc - 2) * 64 + d; }
    if (pn == 3) { if (bj == 0) return 640 + wc * 32 + j; if (wc == 0) return 768 + j; if (wc == 1 && j < 4) return 800 + j; return -1; }
    const int g = (pn - 4) >> 1, head = 4 * ((pn - 4) & 1) + wc;
    return 804 + g * 512 + head * 64 + d;
}
template <class SRC>
__device__ __forceinline__ void tr_item(SRC src, int Kdim, bf16* WT, int k0, int n0, LAS float* scr, int lane) {
#pragma unroll 4
    for (int i = 0; i < 32; ++i) { const int kk = 2 * i + (lane >> 5); scr[kk * 33 + (lane & 31)] = src(k0 + kk); }
    LDS_WAIT(); asm volatile("" ::: "memory");
    const int c = lane & 7;
#pragma unroll
    for (int j = 0; j < 4; ++j) { const int n = (lane >> 3) + 8 * j; const LAS float* s = scr + (8 * c) * 33 + n;
        v4u o; o.x = pkbf(s[0 * 33], s[1 * 33]); o.y = pkbf(s[2 * 33], s[3 * 33]); o.z = pkbf(s[4 * 33], s[5 * 33]); o.w = pkbf(s[6 * 33], s[7 * 33]);
        *(v4u*)(WT + (size_t)(n0 + n) * Kdim + k0 + 8 * c) = o; }
    LDS_WAIT(); asm volatile("" ::: "memory");
}
__device__ __forceinline__ int t5_bucket(int rel) {
    const int n = rel < 0 ? -rel : rel; int b;
    if (n < 8) b = n; else if (n < 12) b = 8; else if (n < 16) b = 9; else if (n < 23) b = 10; else if (n < 32) b = 11; else if (n < 46) b = 12; else if (n < 64) b = 13; else if (n < 91) b = 14; else b = 15;
    return (rel > 0 ? 16 : 0) + b;
}
__device__ __forceinline__ void p0_prologue(Frame& F) {
    LAS float* scr = (LAS float*)(F.lds + F.wave * 16384);
    const int lane = F.lane, gw = F.vcu * NWAVES + F.wave, NGW = F.G * NWAVES;
    if (blockIdx.x == 0 && F.tid == 0) F.ctl[0] = 0u;
    constexpr int I_IN = 16 * (NIN / 32), I_OUT = 16 * 32, I_GU = 16 * (NGU / 32), I_DN = (FF / 64) * 32, NITEMS = I_IN + I_OUT + I_GU + I_DN;
    for (int it = gw; it < NITEMS; it += NGW) {
        int r = it;
        if (r < I_IN) {
            const int kb = r / (NIN / 32), nb = r % (NIN / 32), f = zcol(32 * nb + (lane & 31));
            const float* w_in = F.w_in; const float* nw = F.norm1_w;
            if (f >= -1) {
                tr_item([&](int k) { return f >= 0 ? nw[k] * w_in[(size_t)k * INW + f] : 0.0f; }, DM, F.WIN, 64 * kb, 32 * nb, scr, lane);
            } else {
                const int idx = -2 - f; const float* wu = (idx < 64 ? F.w_uk : F.w_uv) + (idx & 63); const float* kvw = F.kv_norm_w;
                tr_item([&](int k) { const float* wr_ = w_in + (size_t)k * INW + 512; float a = 0.f;
#pragma unroll 8
                        for (int j = 0; j < 128; ++j) a += wr_[j] * kvw[j] * wu[j * 64];
                        return nw[k] * a; }, DM, F.WIN, 64 * kb, 32 * nb, scr, lane);
            }
            continue;
        }
        r -= I_IN;
        if (r < I_OUT) { const int kb = r / 32, nb = r % 32; const float* w = F.w_out + 32 * nb + (lane & 31);
            tr_item([&](int k) { return w[(size_t)k * DM]; }, DM, F.WOUT, 64 * kb, 32 * nb, scr, lane); continue; }
        r -= I_OUT;
        if (r < I_GU) { const int kb = r / (NGU / 32), nb = r % (NGU / 32), n = 32 * nb + (lane & 31), pn = n >> 8, tc = n & 255;
            const float* w = ((tc >> 7) ? F.w_up : F.w_gate) + 128 * pn + (tc & 127); const float* nw = F.norm2_w;
            tr_item([&](int k) { return nw[k] * w[(size_t)k * FF]; }, DM, F.WGU, 64 * kb, 32 * nb, scr, lane); continue; }
        r -= I_GU;
        { const int kb = r / 32, nb = r % 32; const float* w = F.w_down + 32 * nb + (lane & 31);
            tr_item([&](int k) { return w[(size_t)k * DM]; }, FF, F.WDN, 64 * kb, 32 * nb, scr, lane); }
    }
    for (int m = gw; m < MTOK; m += NGW) {
        const f32x4* xr = (const f32x4*)(F.x + (size_t)m * DM) + lane;
        f32x4 v[4]; float s = 0.f;
#pragma unroll
        for (int j = 0; j < 4; ++j) { v[j] = xr[64 * j]; s += pg8::dot4(v[j]); }
        const float rr = 1.0f / sqrtf(wave_sum(s) * (1.0f / DM) + 1e-6f);
        v2u* o8 = (v2u*)(F.XB + (size_t)m * DM) + lane;
#pragma unroll
        for (int j = 0; j < 4; ++j) o8[64 * j] = (v2u){pkbf(v[j][0] * rr, v[j][1] * rr), pkbf(v[j][2] * rr, v[j][3] * rr)};
    }
    const int gt = F.vcu * NTHR + F.tid, NGT = F.G * NTHR;
    for (int i = gt; i < SEQ * 32; i += NGT) { const int pos = i >> 5, j = i & 31;
        const float inv = powf(10000.0f, -(float)j / 32.0f), ang = (float)pos * inv;
        F.COS[i] = cosf(ang); F.SIN[i] = sinf(ang); }
    for (int i = gt; i < 8 * 256; i += NGT) { const int h = i >> 8, rel = (i & 255) - 191;
        float mq = 0.f, mk = 0.f, mb = 0.f;
        for (int j = 0; j < 64; ++j) { mq = fmaxf(mq, fabsf(F.q_norm_w[j])); mk = fmaxf(mk, fabsf(F.k_norm_w[j])); }
        for (int j = 0; j < 256; ++j) mb = fmaxf(mb, fabsf(F.rel_bias[j]));
        const float bound = 8.0f * mq * mk + mb;
        F.BT[i] = (F.rel_bias[t5_bucket(rel) * 8 + h] - bound) * 1.4426950408889634f; }
}

__device__ __forceinline__ void idx_scores(const Frame& F, int b, int c, float* scr) {
    const int w = F.wave, lane = F.lane, r = lane & 31, hi = lane >> 5, qb = w & 1;
    const size_t rowq = (size_t)b * SEQ + 64 * c + 32 * qb + r;
    bf16x8 bq[4][2];
#pragma unroll
    for (int h = 0; h < 4; ++h)
#pragma unroll
        for (int s = 0; s < 2; ++s) bq[h][s] = *(const bf16x8*)(F.IQ + rowq * 128 + 32 * h + 16 * s + 8 * hi);
    const f32x4 wv = *(const f32x4*)(F.IW + rowq * 4) * (0.5f * 0.17677669529663687f);
    const int nkb = 2 * (c + 1);
    for (int kb = w >> 1; kb < nkb; kb += 4) {
        const bf16* kp = F.IK + ((size_t)b * SEQ + 32 * kb + r) * 32 + 8 * hi;
        const bf16x8 a0 = *(const bf16x8*)kp, a1 = *(const bf16x8*)(kp + 16);
        f32x16 sc;
#pragma unroll
        for (int i = 0; i < 16; ++i) sc[i] = 0.f;
#pragma unroll
        for (int h = 0; h < 4; ++h) {
            f32x16 d;
#pragma unroll
            for (int i = 0; i < 16; ++i) d[i] = 0.f;
            d = __builtin_amdgcn_mfma_f32_32x32x16_bf16(a0, bq[h][0], d, 0, 0, 0);
            d = __builtin_amdgcn_mfma_f32_32x32x16_bf16(a1, bq[h][1], d, 0, 0, 0);
#pragma unroll
            for (int i = 0; i < 16; ++i) sc[i] += wv[h] * fmaxf(d[i], 0.f);
        }
        float* dst = scr + (size_t)(32 * qb + r) * 2048 + 32 * kb + 4 * hi;
#pragma unroll
        for (int g = 0; g < 4; ++g) *(f32x4*)(dst + 8 * g) = (f32x4){sc[4 * g] + 0.f, sc[4 * g + 1] + 0.f, sc[4 * g + 2] + 0.f, sc[4 * g + 3] + 0.f};
    }
}
template <int NJ>
__device__ __forceinline__ void select_rows(const float* scr, unsigned long long* mask_rows, int nj, int wave, int lane) {
#pragma unroll 1
    for (int rr = 0; rr < 8; ++rr) {
        const int ql = wave * 8 + rr; const float* row = scr + (size_t)ql * 2048 + lane;
        unsigned u[NJ];
#pragma unroll
        for (int j = 0; j < NJ; ++j) { const unsigned bits = __float_as_uint(row[64 * j] + 0.0f); const unsigned k = bits ^ ((unsigned)((int)bits >> 31) | 0x80000000u); u[j] = (j < nj) ? k : 0u; }
        unsigned prefix = 0u;
#pragma unroll 1
        for (int bit = 31; bit >= 0; --bit) {
            const unsigned trial = prefix | (1u << bit); int cnt = 0;
#pragma unroll
            for (int j = 0; j < NJ; ++j) cnt += __popcll(__ballot(u[j] >= trial));
            if (cnt >= 256) prefix = trial;
            if (cnt == 256) break;
        }
        int ngt = 0;
#pragma unroll
        for (int j = 0; j < NJ; ++j) ngt += __popcll(__ballot(u[j] > prefix));
        int need = 256 - ngt; unsigned long long mv = 0ull;
#pragma unroll
        for (int j = 0; j < NJ; ++j) {
            const unsigned long long eq = __ballot(u[j] == prefix);
            const int rank = (int)__builtin_amdgcn_mbcnt_hi((unsigned)(eq >> 32), __builtin_amdgcn_mbcnt_lo((unsigned)eq, 0u));
            const unsigned long long sel = __ballot(u[j] > prefix || (u[j] == prefix && rank < need));
            need -= __popcll(eq);
            if (lane == j) mv = sel;
        }
        if (lane < nj) mask_rows[(size_t)ql * 32 + lane] = mv;
    }
}
constexpr int AT_K = 0, AT_V = 16384, AT_BT = 32768, AT_WS = 40960;
__device__ __forceinline__ void attn_half(const Frame& F, int b, int c, int half, LAS unsigned char* lds) {
    const int wid = F.wave, lane = F.lane, r = lane & 31, hi = lane >> 5;
    const size_t rowbase = (size_t)b * SEQ; const int q0 = 64 * c + 32 * half, nt = c + 1; const bool usemask = c >= 4;
    bf16x8 qr[4];
#pragma unroll
    for (int d0 = 0; d0 < 4; ++d0) qr[d0] = *(const bf16x8*)(F.QA + (rowbase + q0 + r) * 512 + wid * 64 + 16 * d0 + 8 * hi);
    const LAS float* BT = (const LAS float*)(lds + AT_BT) + wid * 256;
    const float farc = BT[0];
    const bf16* ksrc = F.KA + (rowbase + lane) * 64 + 8 * wid;
    const bf16* vsrc = F.VA + (rowbase + 16 * (wid & 3) + (lane >> 2)) * 64 + (wid >> 2) * 32 + (lane & 3) * 8;
    const unsigned long long* mrow = F.MASK + (rowbase + q0 + r) * 32;
    const int stoff = wid * 1024 + lane * 16;
    const int voff = ((lane >> 4) & 1) * 32 + (lane & 3) * 8 + (4 * hi + ((lane & 15) >> 2)) * 64;
    f32x16 o0, o1;
#pragma unroll
    for (int i = 0; i < 16; ++i) { o0[i] = 0.f; o1[i] = 0.f; }
    float lsum = 0.f;
    v4u kreg = *(const v4u*)ksrc, vreg = *(const v4u*)vsrc;
    unsigned long long mw = usemask ? mrow[0] : ~0ull;
    *(LAS v4u*)(lds + AT_K + stoff) = kreg; *(LAS v4u*)(lds + AT_V + stoff) = vreg;
    __syncthreads();
    for (int t = 0; t < nt; ++t) {
        const int cur = (t & 1) * 8192, nxt = 8192 - cur;
        unsigned long long mwn = ~0ull;
        if (t + 1 < nt) { kreg = *(const v4u*)(ksrc + (size_t)(t + 1) * 64 * 64); vreg = *(const v4u*)(vsrc + (size_t)(t + 1) * 64 * 64); if (usemask) mwn = mrow[t + 1]; }
        const LAS unsigned char* Kb = lds + AT_K + cur + hi * 1024 + r * 16; const LAS unsigned char* Vb = lds + AT_V + cur + voff;
        const bool nearT = t + 2 >= c;
        const float ci = nearT ? 0.f : farc;
        f32x16 p0, p1;
#pragma unroll
        for (int i = 0; i < 16; ++i) { p0[i] = ci; p1[i] = ci; }
#pragma unroll
        for (int d0 = 0; d0 < 4; ++d0) {
            const bf16x8 k0 = *(const LAS bf16x8*)(Kb + d0 * 2048), k1 = *(const LAS bf16x8*)(Kb + d0 * 2048 + 512);
            p0 = __builtin_amdgcn_mfma_f32_32x32x16_bf16(k0, qr[d0], p0, 0, 0, 0);
            p1 = __builtin_amdgcn_mfma_f32_32x32x16_bf16(k1, qr[d0], p1, 0, 0, 0);
        }
        if (nearT) {
            const LAS float* bt = BT + (64 * (t - c) + 191 - 32 * half - r + 4 * hi);
#pragma unroll
            for (int i = 0; i < 16; ++i) { p0[i] += bt[(i & 3) + 8 * (i >> 2)]; p1[i] += bt[32 + (i & 3) + 8 * (i >> 2)]; }
        }
#pragma unroll
        for (int i = 0; i < 16; ++i) { p0[i] = __builtin_amdgcn_exp2f(p0[i]); p1[i] = __builtin_amdgcn_exp2f(p1[i]); }
        if (usemask) {
            const unsigned long long ws_ = mw >> (4 * hi); const int lo = (int)(unsigned)ws_, hh = (int)(unsigned)(ws_ >> 32);
#pragma unroll
            for (int i = 0; i < 16; ++i) {
                p0[i] = __uint_as_float(__float_as_uint(p0[i]) & (unsigned)__builtin_amdgcn_sbfe(lo, (i & 3) + 8 * (i >> 2), 1));
                p1[i] = __uint_as_float(__float_as_uint(p1[i]) & (unsigned)__builtin_amdgcn_sbfe(hh, (i & 3) + 8 * (i >> 2), 1));
            }
        }
        float sa = 0.f;
#pragma unroll
        for (int i = 0; i < 16; ++i) sa += p0[i] + p1[i];
        lsum += sa;
        const bf16x8 pa0 = __builtin_bit_cast(bf16x8, (v4u){pkbf(p0[0], p0[1]), pkbf(p0[2], p0[3]), pkbf(p0[4], p0[5]), pkbf(p0[6], p0[7])});
        const bf16x8 pa1 = __builtin_bit_cast(bf16x8, (v4u){pkbf(p0[8], p0[9]), pkbf(p0[10], p0[11]), pkbf(p0[12], p0[13]), pkbf(p0[14], p0[15])});
        const bf16x8 pa2 = __builtin_bit_cast(bf16x8, (v4u){pkbf(p1[0], p1[1]), pkbf(p1[2], p1[3]), pkbf(p1[4], p1[5]), pkbf(p1[6], p1[7])});
        const bf16x8 pa3 = __builtin_bit_cast(bf16x8, (v4u){pkbf(p1[8], p1[9]), pkbf(p1[10], p1[11]), pkbf(p1[12], p1[13]), pkbf(p1[14], p1[15])});
        o0 = __builtin_amdgcn_mfma_f32_32x32x16_bf16(pa0, cat8(vtr(Vb + 0), vtr(Vb + 512)), o0, 0, 0, 0);
        o0 = __builtin_amdgcn_mfma_f32_32x32x16_bf16(pa1, cat8(vtr(Vb + 1024), vtr(Vb + 1536)), o0, 0, 0, 0);
        o0 = __builtin_amdgcn_mfma_f32_32x32x16_bf16(pa2, cat8(vtr(Vb + 2048), vtr(Vb + 2560)), o0, 0, 0, 0);
        o0 = __builtin_amdgcn_mfma_f32_32x32x16_bf16(pa3, cat8(vtr(Vb + 3072), vtr(Vb + 3584)), o0, 0, 0, 0);
        o1 = __builtin_amdgcn_mfma_f32_32x32x16_bf16(pa0, cat8(vtr(Vb + 4096), vtr(Vb + 4608)), o1, 0, 0, 0);
        o1 = __builtin_amdgcn_mfma_f32_32x32x16_bf16(pa1, cat8(vtr(Vb + 5120), vtr(Vb + 5632)), o1, 0, 0, 0);
        o1 = __builtin_amdgcn_mfma_f32_32x32x16_bf16(pa2, cat8(vtr(Vb + 6144), vtr(Vb + 6656)), o1, 0, 0, 0);
        o1 = __builtin_amdgcn_mfma_f32_32x32x16_bf16(pa3, cat8(vtr(Vb + 7168), vtr(Vb + 7680)), o1, 0, 0, 0);
        if (t + 1 < nt) { *(LAS v4u*)(lds + AT_K + nxt + stoff) = kreg; *(LAS v4u*)(lds + AT_V + nxt + stoff) = vreg; }
        mw = mwn;
        __syncthreads();
    }
    lsum += __shfl_xor(lsum, 32);
    LAS float* wsf = (LAS float*)(lds + AT_WS) + wid * 64;
    if (hi == 0) wsf[r] = lsum;
    LDS_WAIT(); asm volatile("" ::: "memory");
    bf16* orow = F.MIX + (rowbase + q0) * DM + wid * 64 + r;
#pragma unroll
    for (int i = 0; i < 16; ++i) {
        const int q = crow(i, hi); const float rl = 1.0f / wsf[q];
        orow[(size_t)q * DM] = (bf16)(pkbf(o0[i] * rl, 0.f) & 0xffffu); orow[(size_t)q * DM + 32] = (bf16)(pkbf(o1[i] * rl, 0.f) & 0xffffu);
    }
}
__device__ __forceinline__ void attn_unit(const Frame& F, int b, int c, LAS unsigned char* lds) {
    if (c >= 4) {
        float* scr = F.SCR + (size_t)blockIdx.x * 64 * 2048;
        idx_scores(F, b, c, scr);
        __syncthreads();
        unsigned long long* mrows = F.MASK + ((size_t)b * SEQ + 64 * c) * 32; const int nj = c + 1;
        if (nj <= 8) select_rows<8>(scr, mrows, nj, F.wave, F.lane);
        else if (nj <= 16) select_rows<16>(scr, mrows, nj, F.wave, F.lane);
        else if (nj <= 24) select_rows<24>(scr, mrows, nj, F.wave, F.lane);
        else select_rows<32>(scr, mrows, nj, F.wave, F.lane);
    }
    { const f32x4 v = *(const f32x4*)(F.BT + F.tid * 4); *(LAS f32x4*)(lds + AT_BT + F.tid * 16) = v; }
    __syncthreads();
    attn_half(F, b, c, 0, lds);
    attn_half(F, b, c, 1, lds);
}

constexpr int RT_Q = 0, RT_K = 16384, RT_KT = 32768, RT_V = 49152, RT_S = 65536, RT_Y = 81920;
__device__ __forceinline__ v4u scale8(v4u k, float f) {
    return (v4u){pkbf(bflo(k.x) * f, bfhi(k.x) * f), pkbf(bflo(k.y) * f, bfhi(k.y) * f), pkbf(bflo(k.z) * f, bfhi(k.z) * f), pkbf(bflo(k.w) * f, bfhi(k.w) * f)};
}
__device__ __forceinline__ void ret_unit(const Frame& F, int b, int h, LAS unsigned char* lds) {
    const int tid = F.tid, lane = F.lane, w = F.wave, r = lane & 31, hi = lane >> 5;
    const float gam = 1.0f - exp2f(-5.0f - (float)h), lg2 = log2f(gam), cdec = exp2f(64.0f * lg2);
    const int rB = 16 * (w & 3) + (lane >> 2), cB = (w >> 2) * 32 + (lane & 3) * 8;
    const float kdec = exp2f((float)(63 - rB) * lg2);
    const size_t base = (size_t)b * SEQ * 512 + h * 64;
    const bf16* qsrc = F.QB + base + (size_t)lane * 512 + 8 * w;
    const bf16* ksrc = F.KB + base + (size_t)lane * 512 + 8 * w;
    const bf16* k2src = F.KB + base + (size_t)rB * 512 + cB;
    const bf16* vsrc = F.VB + base + (size_t)rB * 512 + cB;
    const int ei = tid >> 3, eseg = tid & 7;
    const bf16* gsrc = F.GB + base + (size_t)ei * 512 + 8 * eseg;
    bf16* osrc = F.MIX + ((size_t)b * SEQ + ei) * DM + 512 + h * 64 + 8 * eseg;
    const f32x4 gw0 = *(const f32x4*)(F.ret_gn_w + h * 64 + 8 * eseg), gw1 = *(const f32x4*)(F.ret_gn_w + h * 64 + 8 * eseg + 4);
    const f32x4 gb0 = *(const f32x4*)(F.ret_gn_b + h * 64 + 8 * eseg), gb1 = *(const f32x4*)(F.ret_gn_b + h * 64 + 8 * eseg + 4);
    const int stoff = w * 1024 + lane * 16;
    const int voff = ((lane >> 4) & 1) * 32 + (lane & 3) * 8 + (4 * hi + ((lane & 15) >> 2)) * 64;
    f32x16 st;
#pragma unroll
    for (int i = 0; i < 16; ++i) st[i] = 0.f;
    *(LAS v4u*)(lds + RT_S + tid * 16) = (v4u){0u, 0u, 0u, 0u};
    v4u qreg = *(const v4u*)qsrc, kreg = *(const v4u*)ksrc, k2reg = *(const v4u*)k2src, vreg = *(const v4u*)vsrc;
    *(LAS v4u*)(lds + RT_Q + stoff) = qreg; *(LAS v4u*)(lds + RT_K + stoff) = kreg; *(LAS v4u*)(lds + RT_KT + stoff) = scale8(k2reg, kdec); *(LAS v4u*)(lds + RT_V + stoff) = vreg;
    __syncthreads();
    for (int n = 0; n < 32; ++n) {
        const int cur = (n & 1) * 8192, nxt = 8192 - cur;
        const size_t adv = (size_t)(n + 1) * 64 * 512;
        if (n + 1 < 32) { qreg = *(const v4u*)(qsrc + adv); kreg = *(const v4u*)(ksrc + adv); k2reg = *(const v4u*)(k2src + adv); vreg = *(const v4u*)(vsrc + adv); }
        const v4u greg = *(const v4u*)(gsrc + (size_t)n * 64 * 512);
        float lg2v = lg2; asm volatile("" : "+v"(lg2v));
        if (w < 4) {
            const int ib = w & 1, db = w >> 1;
            const LAS unsigned char* Qb = lds + RT_Q + cur + hi * 1024 + (32 * ib + r) * 16;
            const LAS unsigned char* Kb = lds + RT_K + cur + hi * 1024 + r * 16;
            const LAS unsigned char* Vb = lds + RT_V + cur + voff + db * 4096;
            const LAS unsigned char* Sb = lds + RT_S + cur + hi * 1024 + (32 * db + r) * 16;
            bf16x8 qf[4];
#pragma unroll
            for (int s = 0; s < 4; ++s) qf[s] = *(const LAS bf16x8*)(Qb + s * 2048);
            f32x16 s0, s1, yin, ycr;
#pragma unroll
            for (int i = 0; i < 16; ++i) { s0[i] = 0.f; s1[i] = 0.f; yin[i] = 0.f; ycr[i] = 0.f; }
#pragma unroll
            for (int s = 0; s < 4; ++s) s0 = __builtin_amdgcn_mfma_f32_32x32x16_bf16(*(const LAS bf16x8*)(Kb + s * 2048), qf[s], s0, 0, 0, 0);
            if (ib == 1) {
#pragma unroll
                for (int s = 0; s < 4; ++s) s1 = __builtin_amdgcn_mfma_f32_32x32x16_bf16(*(const LAS bf16x8*)(Kb + s * 2048 + 512), qf[s], s1, 0, 0, 0);
            }
#pragma unroll
            for (int i = 0; i < 16; ++i) {
                const int e0 = 32 * ib + r - crow(i, hi), e1 = e0 - 32;
                s0[i] *= (e0 >= 0) ? __builtin_amdgcn_exp2f((float)e0 * lg2v) : 0.f;
                s1[i] *= (e1 >= 0) ? __builtin_amdgcn_exp2f((float)e1 * lg2v) : 0.f;
            }
            const bf16x8 pa0 = __builtin_bit_cast(bf16x8, (v4u){pkbf(s0[0], s0[1]), pkbf(s0[2], s0[3]), pkbf(s0[4], s0[5]), pkbf(s0[6], s0[7])});
            const bf16x8 pa1 = __builtin_bit_cast(bf16x8, (v4u){pkbf(s0[8], s0[9]), pkbf(s0[10], s0[11]), pkbf(s0[12], s0[13]), pkbf(s0[14], s0[15])});
            yin = __builtin_amdgcn_mfma_f32_32x32x16_bf16(pa0, cat8(vtr(Vb + 0), vtr(Vb + 512)), yin, 0, 0, 0);
            yin = __builtin_amdgcn_mfma_f32_32x32x16_bf16(pa1, cat8(vtr(Vb + 1024), vtr(Vb + 1536)), yin, 0, 0, 0);
            if (ib == 1) {
                const bf16x8 pa2 = __builtin_bit_cast(bf16x8, (v4u){pkbf(s1[0], s1[1]), pkbf(s1[2], s1[3]), pkbf(s1[4], s1[5]), pkbf(s1[6], s1[7])});
                const bf16x8 pa3 = __builtin_bit_cast(bf16x8, (v4u){pkbf(s1[8], s1[9]), pkbf(s1[10], s1[11]), pkbf(s1[12], s1[13]), pkbf(s1[14], s1[15])});
                yin = __builtin_amdgcn_mfma_f32_32x32x16_bf16(pa2, cat8(vtr(Vb + 2048), vtr(Vb + 2560)), yin, 0, 0, 0);
                yin = __builtin_amdgcn_mfma_f32_32x32x16_bf16(pa3, cat8(vtr(Vb + 3072), vtr(Vb + 3584)), yin, 0, 0, 0);
            }
#pragma unroll
            for (int s = 0; s < 4; ++s) ycr = __builtin_amdgcn_mfma_f32_32x32x16_bf16(qf[s], *(const LAS bf16x8*)(Sb + s * 2048), ycr, 0, 0, 0);
            LAS float* Y = (LAS float*)(lds + RT_Y);
#pragma unroll
            for (int i = 0; i < 16; ++i) { const int ii = 32 * ib + crow(i, hi);
                Y[ii * 65 + 32 * db + r] = yin[i] + __builtin_amdgcn_exp2f((float)(ii + 1) * lg2v) * ycr[i]; }
        } else {
            const int eb = w & 1, db = (w >> 1) & 1;
            const LAS unsigned char* Kt = lds + RT_KT + cur + voff + eb * 4096;
            const LAS unsigned char* Vb = lds + RT_V + cur + voff + db * 4096;
            LAS unsigned char* Sn = lds + RT_S + nxt + (4 * eb) * 1024 + (32 * db + r) * 16 + hi * 8;
#pragma unroll
            for (int i = 0; i < 16; ++i) st[i] *= cdec;
#pragma unroll
            for (int ks = 0; ks < 4; ++ks)
                st = __builtin_amdgcn_mfma_f32_32x32x16_bf16(cat8(vtr(Kt + ks * 1024), vtr(Kt + ks * 1024 + 512)), cat8(vtr(Vb + ks * 1024), vtr(Vb + ks * 1024 + 512)), st, 0, 0, 0);
#pragma unroll
            for (int g = 0; g < 4; ++g) *(LAS v2u*)(Sn + g * 1024) = (v2u){pkbf(st[4 * g], st[4 * g + 1]), pkbf(st[4 * g + 2], st[4 * g + 3])};
        }
        __syncthreads();
        {
            const LAS float* Y = (const LAS float*)(lds + RT_Y) + ei * 65 + 8 * eseg;
            float y[8];
#pragma unroll
            for (int k = 0; k < 8; ++k) y[k] = Y[k];
            float s = ((y[0] + y[1]) + (y[2] + y[3])) + ((y[4] + y[5]) + (y[6] + y[7]));
            s += __shfl_xor(s, 1); s += __shfl_xor(s, 2); s += __shfl_xor(s, 4);
            const float mean = s * (1.0f / 64.0f); float v = 0.f;
#pragma unroll
            for (int k = 0; k < 8; ++k) { y[k] -= mean; v += y[k] * y[k]; }
            v += __shfl_xor(v, 1); v += __shfl_xor(v, 2); v += __shfl_xor(v, 4);
            const float rstd = 1.0f / sqrtf(v * (1.0f / 64.0f) + 1e-5f);
            const float o0 = (y[0] * rstd * gw0[0] + gb0[0]) * bflo(greg.x), o1 = (y[1] * rstd * gw0[1] + gb0[1]) * bfhi(greg.x);
            const float o2 = (y[2] * rstd * gw0[2] + gb0[2]) * bflo(greg.y), o3 = (y[3] * rstd * gw0[3] + gb0[3]) * bfhi(greg.y);
            const float o4 = (y[4] * rstd * gw1[0] + gb1[0]) * bflo(greg.z), o5 = (y[5] * rstd * gw1[1] + gb1[1]) * bfhi(greg.z);
            const float o6 = (y[6] * rstd * gw1[2] + gb1[2]) * bflo(greg.w), o7 = (y[7] * rstd * gw1[3] + gb1[3]) * bfhi(greg.w);
            *(v4u*)(osrc + (size_t)n * 64 * DM) = (v4u){pkbf(o0, o1), pkbf(o2, o3), pkbf(o4, o5), pkbf(o6, o7)};
        }
        if (n + 1 < 32) { *(LAS v4u*)(lds + RT_Q + nxt + stoff) = qreg; *(LAS v4u*)(lds + RT_K + nxt + stoff) = kreg; *(LAS v4u*)(lds + RT_KT + nxt + stoff) = scale8(k2reg, kdec); *(LAS v4u*)(lds + RT_V + nxt + stoff) = vreg; }
        __syncthreads();
    }
}
constexpr int N_RET = BATCH * 8, N_ATT = BATCH * 32, N_MIX = N_RET + N_ATT;
__device__ __forceinline__ void p2_mixers(Frame& F) {
    volatile LAS unsigned* misc = (volatile LAS unsigned*)(F.lds + MISC_OFF);
    for (;;) {
        __syncthreads();
        if (F.tid == 0) misc[0] = __hip_atomic_fetch_add(F.ctl, 1u, __ATOMIC_RELAXED, __HIP_MEMORY_SCOPE_AGENT);
        __syncthreads();
        const int u = (int)misc[0];
        if (u >= N_MIX) break;
        { int t_ = threadIdx.x; asm volatile("" : "+v"(t_)); F.tid = t_; F.lane = t_ & 63; }
#ifndef MIXSEL
#define MIXSEL 3
#endif
        if (u < N_RET) { if (MIXSEL & 1) ret_unit(F, u >> 3, u & 7, F.lds); }
        else { const int a = u - N_RET; if (MIXSEL & 2) attn_unit(F, a & 31, 31 - (a >> 5), F.lds); }
    }
}

struct Args { const float* in[16]; float* out; unsigned char* ws; int ph_lo, ph_hi; };
__global__ void __launch_bounds__(NTHR, 2) fwd_kernel(Args args) {
    extern __shared__ __attribute__((aligned(16))) unsigned char lds[];
    Frame F;
    F.lds = (LAS unsigned char*)lds;
    F.tid = threadIdx.x; F.lane = F.tid & 63; F.wave = __builtin_amdgcn_readfirstlane(F.tid >> 6);
    F.G = gridDim.x; { const int bx = blockIdx.x; F.vcu = (F.G % 8 == 0) ? (bx % 8) * (F.G / 8) + bx / 8 : bx; }
    unsigned char* ws = args.ws;
    F.ctl = (unsigned*)(ws + WS_CTL);
    F.x = args.in[0]; F.norm1_w = args.in[1]; F.w_in = args.in[2]; F.q_norm_w = args.in[3]; F.k_norm_w = args.in[4]; F.kv_norm_w = args.in[5]; F.w_uk = args.in[6]; F.w_uv = args.in[7];
    F.rel_bias = args.in[8]; F.ret_gn_w = args.in[9]; F.ret_gn_b = args.in[10]; F.w_out = args.in[11]; F.norm2_w = args.in[12]; F.w_gate = args.in[13]; F.w_up = args.in[14]; F.w_down = args.in[15];
    F.out = args.out;
    F.WIN = (bf16*)(ws + WS_WIN); F.WOUT = (bf16*)(ws + WS_WOUT); F.WGU = (bf16*)(ws + WS_WGU); F.WDN = (bf16*)(ws + WS_WDN);
    F.XB = (bf16*)(ws + WS_XB); F.MIX = (bf16*)(ws + WS_MIX); F.QA = (bf16*)(ws + WS_QA); F.QB = (bf16*)(ws + WS_QB); F.KB = (bf16*)(ws + WS_KB); F.VB = (bf16*)(ws + WS_VB); F.GB = (bf16*)(ws + WS_GB);
    F.KA = (bf16*)(ws + WS_KA); F.VA = (bf16*)(ws + WS_VA); F.IQ = (bf16*)(ws + WS_IQ); F.IK = (bf16*)(ws + WS_IK); F.ACT = (bf16*)(ws + WS_ACT);
    F.IW = (float*)(ws + WS_IW); F.R2 = (float*)(ws + WS_R2); F.COS = (float*)(ws + WS_COS); F.SIN = (float*)(ws + WS_SIN); F.BT = (float*)(ws + WS_BT); F.SCR = (float*)(ws + WS_SCR);
    F.MASK = (unsigned long long*)(ws + WS_MASK);
    const int lo = args.ph_lo, hi = args.ph_hi;
#ifndef PHSEL
#define PHSEL 63
#endif
#define IN(k) (((PHSEL >> (k)) & 1) && lo <= (k) && (k) < hi)
#define SEAM(k) do { if (IN(k) && IN((k) + 1)) cg::this_grid().sync(); } while (0)

    if (IN(0)) { p0_prologue(F); }
    SEAM(0);
    if (IN(1)) {
        pg8::Gemm g{F.XB, F.WIN, MTOK, NIN, DM}; pg8::StaticOrder S; S.init(MTOK, NIN, F.G, (int)blockIdx.x);
        pg8::EpiIn E{F.QA, F.KA, F.VA, F.IQ, F.IK, F.QB, F.KB, F.VB, F.GB, F.IW, F.q_norm_w, F.k_norm_w, F.COS, F.SIN, (LAS float*)(F.lds + XCH_OFF)};
        pg8::gemm_phase<pg8::EpiIn, pg8::StaticOrder, true, true>(F.lds, g, S, E);
    }
    SEAM(1);
    if (IN(2)) { p2_mixers(F); }
    SEAM(2);
    if (IN(3)) {
        pg8::Gemm g{F.MIX, F.WOUT, MTOK, DM, DM}; pg8::PanelOrder S{(int)blockIdx.x, 4};
        pg8::EpiOut E{F.x, F.out, F.XB, {0.f, 0.f, 0.f, 0.f, 0.f, 0.f, 0.f, 0.f}};
        if ((int)blockIdx.x < MTOK / 256) {
            pg8::gemm_phase<pg8::EpiOut, pg8::PanelOrder, true, true>(F.lds, g, S, E);
            const int wr = F.wave >> 2, wc = F.wave & 3, fr = F.lane & 15, fq = F.lane >> 4;
            LAS float* P = (LAS float*)(F.lds + XCH_OFF);
#pragma unroll
            for (int k = 0; k < 8; ++k) { float s = E.ss[k]; s += __shfl_xor(s, 16); s += __shfl_xor(s, 32);
                if (fq == 0) P[((k >> 2) * 128 + wr * 64 + (k & 3) * 16 + fr) * 4 + wc] = s; }
            __syncthreads();
            if (F.tid < 256) { const f32x4 p = *(const LAS f32x4*)(P + F.tid * 4);
                F.R2[(size_t)blockIdx.x * 256 + F.tid] = 1.0f / sqrtf(((p[0] + p[1]) + (p[2] + p[3])) * (1.0f / DM) + 1e-6f); }
        }
    }
    SEAM(3);
    if (IN(4)) {
        pg8::Gemm g{F.XB, F.WGU, MTOK, NGU, DM}; pg8::StaticOrder S; S.init(MTOK, NGU, F.G, (int)blockIdx.x);
        pg8::EpiGU E{F.R2, F.ACT};
        pg8::gemm_phase<pg8::EpiGU, pg8::StaticOrder, true, true>(F.lds, g, S, E);
    }
    SEAM(4);
    if (IN(5)) {
        pg8::Gemm g{F.ACT, F.WDN, MTOK, DM, FF}; pg8::StaticOrder S; S.init(MTOK, DM, F.G, (int)blockIdx.x);
        pg8::EpiDown E{F.out};
        pg8::gemm_phase<pg8::EpiDown, pg8::StaticOrder, true, true>(F.lds, g, S, E);
    }
#undef IN
#undef SEAM
}

extern "C" void kernel_launch(void* const* d_in, const int* in_sizes, int n_in, void* d_out, int out_size, void* d_ws, size_t ws_size, hipStream_t stream) {
    static int grid = 0;
    if (grid == 0) {
        if (n_in != 16 || in_sizes[0] != MTOK * DM || out_size != MTOK * DM || ws_size < WS_END) {
            fprintf(stderr, "kernel_launch: unexpected problem (n_in %d, in0 %d, out %d, ws %zu); nothing launched\n", n_in, n_in > 0 ? in_sizes[0] : -1, out_size, ws_size); grid = -1; return; }
        int dev = 0, cus = 0, per_cu = 0;
        if (hipGetDevice(&dev) != hipSuccess || hipDeviceGetAttribute(&cus, hipDeviceAttributeMultiprocessorCount, dev) != hipSuccess) { grid = -1; return; }
        if (hipFuncSetAttribute((const void*)fwd_kernel, hipFuncAttributeMaxDynamicSharedMemorySize, LDS_BYTES) != hipSuccess) { fprintf(stderr, "kernel_launch: hipFuncSetAttribute failed\n"); grid = -1; return; }
        if (hipOccupancyMaxActiveBlocksPerMultiprocessor(&per_cu, (const void*)fwd_kernel, NTHR, LDS_BYTES) != hipSuccess || per_cu < 1) { fprintf(stderr, "kernel_launch: occupancy query says %d blocks per CU\n", per_cu); (void)hipGetLastError(); grid = -1; return; }
        grid = cus;
        if (grid != 256) fprintf(stderr, "kernel_launch: %d CUs; this kernel is laid out for 256\n", grid);
    }
    if (grid < 0) return;
    Args a{};
    for (int i = 0; i < 16; ++i) a.in[i] = (const float*)d_in[i];
    a.out = (float*)d_out; a.ws = (unsigned char*)d_ws;
#if MK_N_LAUNCHES == 1
    a.ph_lo = 0; a.ph_hi = N_PHASES;
    void* kargs[] = {&a};
    hipError_t e = hipLaunchCooperativeKernel((const void*)fwd_kernel, dim3(grid), dim3(NTHR), kargs, LDS_BYTES, stream);
    if (e != hipSuccess) fprintf(stderr, "kernel_launch: cooperative launch failed: %s (grid %d)\n", hipGetErrorString(e), grid);
#else
    for (int p = 0; p < N_PHASES; ++p) { a.ph_lo = p; a.ph_hi = p + 1; hipLaunchKernelGGL(fwd_kernel, dim3(grid), dim3(NTHR), LDS_BYTES, stream, a); }
#endif
}
```

```cpp
#include <hip/hip_runtime.h>
#include <hip/hip_cooperative_groups.h>
#include <cstdio>
#include <cstdint>
namespace cg = cooperative_groups;
namespace pg8 {
#define PG8_LAS __attribute__((address_space(3)))
typedef unsigned short bf16_t;
typedef short bf16x8 __attribute__((ext_vector_type(8)));
typedef float f32x4 __attribute__((ext_vector_type(4)));
typedef unsigned u32x4 __attribute__((ext_vector_type(4)));
constexpr int BM = 256, BK = 64, HALF = 128, HTB = HALF * BK * 2  , STAGE_BYTES = 8 * HTB, NXCD = 8, WGM = 8;

__host__ __device__ __forceinline__ int lds_byte(int r, int c) { const int st = (r >> 4) * 2 + (c >> 5), rr = r & 15, cc = c & 31, ob = rr * 64 + cc * 2; return st * 1024 + (ob ^ (((ob >> 9) & 1) << 5)); }
__host__ __device__ __forceinline__ void stage_rc(int b, int& R, int& C) { const int st = b / 1024, sb = b % 1024, swz = sb ^ (((sb >> 9) & 1) << 5); R = (st >> 1) * 16 + swz / 64; C = (st & 1) * 32 + (swz % 64) / 2; }
__host__ __device__ __forceinline__ int perm32(int rho) { const int n = rho >> 4, i = rho & 15; return 8 * (i >> 2) + 4 * n + (i & 3); }

struct Unit { int pm, pn; };
struct Gemm { const bf16_t* A; const bf16_t* Bt; int M, N, K; };

struct StaticOrder {
    int nM, nN, nwg, G, c;
    __host__ __device__ void init(int M, int N, int G_, int c_) { nM = M / BM; nN = N / BM; nwg = nM * nN; G = G_; c = c_; }
    __host__ __device__ bool next(int i, Unit& u) const {
        const long L = (long)i * G + c; if (L >= nwg) return false;
        int wgid = (int)L; { const int q = nwg / NXCD, r = nwg % NXCD, xcd = wgid % NXCD, off = wgid / NXCD; wgid = (xcd < r ? xcd * (q + 1) : r * (q + 1) + (xcd - r) * q) + off; }
        const int nig = WGM * nN, gid = wgid / nig, fm = gid * WGM, gsz = (nM - fm) < WGM ? (nM - fm) : WGM;
        u.pm = fm + ((wgid % nig) % gsz); u.pn = (wgid % nig) / gsz; return true;
    }
    __device__ __forceinline__ void a_ready(const Unit&) const {}
    __device__ __forceinline__ void done(const Unit&) const {}
};

__device__ __forceinline__ unsigned cvt_pk_bf16(float lo, float hi) { unsigned r; asm volatile("v_cvt_pk_bf16_f32 %0, %1, %2" : "=v"(r) : "v"(lo), "v"(hi)); return r; }
typedef float f32x2 __attribute__((ext_vector_type(2)));
typedef __bf16 bf16x2_t __attribute__((ext_vector_type(2)));
typedef unsigned u32x2 __attribute__((ext_vector_type(2)));
__device__ __forceinline__ unsigned pkbf(float lo, float hi) { f32x2 v = {lo, hi}; bf16x2_t b = __builtin_convertvector(v, bf16x2_t); return __builtin_bit_cast(unsigned, b); }
__device__ __forceinline__ u32x4 pk8(f32x4 a, f32x4 b) { return (u32x4){pkbf(a[0], a[1]), pkbf(a[2], a[3]), pkbf(b[0], b[1]), pkbf(b[2], b[3])}; }
__device__ __forceinline__ float dot4(f32x4 a) { return (a[0] * a[0] + a[1] * a[1]) + (a[2] * a[2] + a[3] * a[3]); }
__device__ __forceinline__ float sum4(f32x4 a) { return (a[0] + a[1]) + (a[2] + a[3]); }
__device__ __forceinline__ float silu1(float v) { return v / (1.0f + __expf(-v)); }
__device__ __forceinline__ f32x4 silu4(f32x4 v) { return (f32x4){silu1(v[0]), silu1(v[1]), silu1(v[2]), silu1(v[3])}; }
constexpr float RMS_EPS_F = 1e-6f;
constexpr float QSCALE = 0.125f * 1.4426950408889634f;

struct EpiIn {
    static constexpr bool PERM = true, AFTER_DRAIN = false;
    bf16_t *QA, *KA, *VA, *IQ, *IK, *QB, *KB, *VB, *GB; float* IW;
    const float *qnw, *knw, *cosT, *sinT;
    PG8_LAS float* xch;
    __device__ __forceinline__ void operator()(const f32x4 (&acc)[2][2][4][2], const Unit& u, int wr, int wc, int fr, int fq) {
        const int row0 = u.pm * BM + wr * 64 + fr, pn = u.pn;
        if (pn < 2) {
            const int head = 4 * pn + wc;
            const f32x4 w0 = *(const f32x4*)(qnw + 8 * fq), w1 = *(const f32x4*)(qnw + 8 * fq + 4), w2 = *(const f32x4*)(qnw + 32 + 8 * fq), w3 = *(const f32x4*)(qnw + 36 + 8 * fq);
#pragma unroll
            for (int ai = 0; ai < 2; ++ai)
#pragma unroll
                for (int m = 0; m < 4; ++m) {
                    f32x4 a0 = acc[ai][0][m][0], a1 = acc[ai][0][m][1], b0 = acc[ai][1][m][0], b1 = acc[ai][1][m][1];
                    float ss = (dot4(a0) + dot4(a1)) + (dot4(b0) + dot4(b1));
                    ss += __shfl_xor(ss, 16); ss += __shfl_xor(ss, 32);
                    const float rs = QSCALE / sqrtf(ss * (1.0f / 64.0f) + RMS_EPS_F);
                    bf16_t* p = QA + (size_t)(row0 + ai * HALF + m * 16) * 512 + head * 64 + 8 * fq;
                    *(u32x4*)p = pk8(a0 * w0 * rs, a1 * w1 * rs); *(u32x4*)(p + 32) = pk8(b0 * w2 * rs, b1 * w3 * rs);
                }
        } else if (pn == 2) {
            if (wc >= 2) {
#pragma unroll
                for (int ai = 0; ai < 2; ++ai)
#pragma unroll
                    for (int m = 0; m < 4; ++m) {
                        float ss = (dot4(acc[ai][0][m][0]) + dot4(acc[ai][0][m][1])) + (dot4(acc[ai][1][m][0]) + dot4(acc[ai][1][m][1]));
                        ss += __shfl_xor(ss, 16); ss += __shfl_xor(ss, 32);
                        if (fq == 0) xch[(ai * HALF + wr * 64 + m * 16 + fr) * 2 + (wc - 2)] = ss;
                    }
            }
            asm volatile("s_waitcnt lgkmcnt(0)" ::: "memory"); __builtin_amdgcn_s_barrier(); asm volatile("" ::: "memory");
            if (wc < 2) {
                const f32x4 w0 = *(const f32x4*)(knw + 8 * fq), w1 = *(const f32x4*)(knw + 8 * fq + 4), w2 = *(const f32x4*)(knw + 32 + 8 * fq), w3 = *(const f32x4*)(knw + 36 + 8 * fq);
#pragma unroll
                for (int ai = 0; ai < 2; ++ai)
#pragma unroll
                    for (int m = 0; m < 4; ++m) {
                        const int rl = ai * HALF + wr * 64 + m * 16 + fr;
                        const f32x2 pr = *(const PG8_LAS f32x2*)(xch + rl * 2);
                        const float rc = 1.0f / sqrtf((pr[0] + pr[1]) * (1.0f / 128.0f) + RMS_EPS_F);
                        f32x4 a0 = acc[ai][0][m][0] * rc, a1 = acc[ai][0][m][1] * rc, b0 = acc[ai][1][m][0] * rc, b1 = acc[ai][1][m][1] * rc;
                        const size_t row = (size_t)(row0 + ai * HALF + m * 16);
                        if (wc == 0) {
                            float ss = (dot4(a0) + dot4(a1)) + (dot4(b0) + dot4(b1));
                            ss += __shfl_xor(ss, 16); ss += __shfl_xor(ss, 32);
                            const float rs = 1.0f / sqrtf(ss * (1.0f / 64.0f) + RMS_EPS_F);
                            bf16_t* p = KA + row * 64 + 8 * fq;
                            *(u32x4*)p = pk8(a0 * w0 * rs, a1 * w1 * rs); *(u32x4*)(p + 32) = pk8(b0 * w2 * rs, b1 * w3 * rs);
                        } else {
                            bf16_t* p = VA + row * 64 + 8 * fq;
                            *(u32x4*)p = pk8(a0, a1); *(u32x4*)(p + 32) = pk8(b0, b1);
                        }
                    }
            }
        } else if (pn == 3) {
#pragma unroll
            for (int ai = 0; ai < 2; ++ai)
#pragma unroll
                for (int m = 0; m < 4; ++m) {
                    const size_t row = (size_t)(row0 + ai * HALF + m * 16);
                    *(u32x4*)(IQ + row * 128 + 32 * wc + 8 * fq) = pk8(acc[ai][0][m][0], acc[ai][0][m][1]);
                    if (wc == 0) *(u32x4*)(IK + row * 32 + 8 * fq) = pk8(acc[ai][1][m][0], acc[ai][1][m][1]);
                    if (wc == 1 && fq == 0) *(f32x4*)(IW + row * 4) = acc[ai][1][m][0];
                }
        } else if (pn < 8) {
            const int head = 4 * (pn & 1) + wc; bf16_t* dst = pn < 6 ? QB : KB; const float sc = pn < 6 ? 1.0f : 0.125f;
#pragma unroll
            for (int ai = 0; ai < 2; ++ai)
#pragma unroll
                for (int m = 0; m < 4; ++m) {
                    const int row = row0 + ai * HALF + m * 16, pos = row & 2047;
                    const f32x4 c0 = *(const f32x4*)(cosT + pos * 32 + 8 * fq) * sc, c1 = *(const f32x4*)(cosT + pos * 32 + 8 * fq + 4) * sc;
                    const f32x4 s0 = *(const f32x4*)(sinT + pos * 32 + 8 * fq) * sc, s1 = *(const f32x4*)(sinT + pos * 32 + 8 * fq + 4) * sc;
                    const f32x4 a0 = acc[ai][0][m][0], a1 = acc[ai][0][m][1], b0 = acc[ai][1][m][0], b1 = acc[ai][1][m][1];
                    bf16_t* p = dst + (size_t)row * 512 + head * 64 + 8 * fq;
                    *(u32x4*)p = pk8(a0 * c0 - b0 * s0, a1 * c1 - b1 * s1); *(u32x4*)(p + 32) = pk8(a0 * s0 + b0 * c0, a1 * s1 + b1 * c1);
                }
        } else {
            const int head = 4 * (pn & 1) + wc; bf16_t* dst = pn < 10 ? VB : GB; const bool act = pn >= 10;
#pragma unroll
            for (int ai = 0; ai < 2; ++ai)
#pragma unroll
                for (int m = 0; m < 4; ++m) {
                    f32x4 a0 = acc[ai][0][m][0], a1 = acc[ai][0][m][1], b0 = acc[ai][1][m][0], b1 = acc[ai][1][m][1];
                    if (act) { a0 = silu4(a0); a1 = silu4(a1); b0 = silu4(b0); b1 = silu4(b1); }
                    bf16_t* p = dst + (size_t)(row0 + ai * HALF + m * 16) * 512 + head * 64 + 8 * fq;
                    *(u32x4*)p = pk8(a0, a1); *(u32x4*)(p + 32) = pk8(b0, b1);
                }
        }
    }
};

struct EpiOut {
    static constexpr bool PERM = true, AFTER_DRAIN = false;
    const float* x; bf16_t* x1b; float ss[8];
    __device__ __forceinline__ void operator()(const f32x4 (&acc)[2][2][4][2], const Unit& u, int wr, int wc, int fr, int fq) {
        const int row0 = u.pm * BM + wr * 64 + fr, col0 = u.pn * BM + wc * 32 + 8 * fq;
#pragma unroll
        for (int ai = 0; ai < 2; ++ai)
#pragma unroll
            for (int m = 0; m < 4; ++m) {
                const size_t off = (size_t)(row0 + ai * HALF + m * 16) * 1024 + col0; float s = 0.f;
#pragma unroll
                for (int bj = 0; bj < 2; ++bj) {
                    const f32x4 r0 = *(const f32x4*)(x + off + bj * HALF) + acc[ai][bj][m][0], r1 = *(const f32x4*)(x + off + bj * HALF + 4) + acc[ai][bj][m][1];
                    *(u32x4*)(x1b + off + bj * HALF) = pk8(r0, r1);
                    s += dot4(r0) + dot4(r1);
                }
                ss[ai * 4 + m] += s;
            }
    }
};

struct EpiGU {
    static constexpr bool PERM = true, AFTER_DRAIN = false;
    const float* r2; bf16_t* act;
    __device__ __forceinline__ void operator()(const f32x4 (&acc)[2][2][4][2], const Unit& u, int wr, int wc, int fr, int fq) {
        const int row0 = u.pm * BM + wr * 64 + fr, col0 = u.pn * HALF + wc * 32 + 8 * fq;
#pragma unroll
        for (int ai = 0; ai < 2; ++ai)
#pragma unroll
            for (int m = 0; m < 4; ++m) {
                const int row = row0 + ai * HALF + m * 16; const float rr = r2[row];
                const f32x4 g0 = acc[ai][0][m][0] * rr, g1 = acc[ai][0][m][1] * rr, u0 = acc[ai][1][m][0] * rr, u1 = acc[ai][1][m][1] * rr;
                *(u32x4*)(act + (size_t)row * 2816 + col0) = pk8(silu4(g0) * u0, silu4(g1) * u1);
            }
    }
};

struct EpiDown {
    static constexpr bool PERM = true, AFTER_DRAIN = false;
    const bf16_t* x1b; float* out;
    __device__ __forceinline__ void operator()(const f32x4 (&acc)[2][2][4][2], const Unit& u, int wr, int wc, int fr, int fq) {
        const int row0 = u.pm * BM + wr * 64 + fr, col0 = u.pn * BM + wc * 32 + 8 * fq;
#pragma unroll
        for (int ai = 0; ai < 2; ++ai)
#pragma unroll
            for (int m = 0; m < 4; ++m) {
                const size_t off = (size_t)(row0 + ai * HALF + m * 16) * 1024 + col0;
#pragma unroll
                for (int bj = 0; bj < 2; ++bj) {
                    const u32x4 xv = *(const u32x4*)(x1b + off + bj * HALF);
                    const f32x4 x0 = {__uint_as_float(xv[0] << 16), __uint_as_float(xv[0] & 0xffff0000u), __uint_as_float(xv[1] << 16), __uint_as_float(xv[1] & 0xffff0000u)};
                    const f32x4 x1 = {__uint_as_float(xv[2] << 16), __uint_as_float(xv[2] & 0xffff0000u), __uint_as_float(xv[3] << 16), __uint_as_float(xv[3] & 0xffff0000u)};
                    *(f32x4*)(out + off + bj * HALF) = x0 + acc[ai][bj][m][0]; *(f32x4*)(out + off + bj * HALF + 4) = x1 + acc[ai][bj][m][1];
                }
            }
    }
};

struct PanelOrder {
    int pm, ntn;
    __device__ __forceinline__ bool next(int i, Unit& u) const { if (i >= ntn) return false; u.pm = pm; u.pn = i; return true; }
    __device__ __forceinline__ void a_ready(const Unit&) const {}
    __device__ __forceinline__ void done(const Unit&) const {}
};

template <class Epi, class Sched, bool ALIGN_EPI = false, bool SP2 = false>
__device__ __forceinline__ void gemm_phase(PG8_LAS unsigned char* lds, const Gemm g, const Sched& S, Epi& E, int wave_in) {
    unsigned ones_ = ~0u; asm volatile("" : "+s"(ones_)); int tid_ = wave_in * 64 + (int)__builtin_amdgcn_mbcnt_hi(ones_, __builtin_amdgcn_mbcnt_lo(ones_, 0u));
    const int tid = tid_, wid = __builtin_amdgcn_readfirstlane(tid >> 6), lane = tid & 63, wr = wid >> 2, wc = wid & 3, fr = lane & 15, fq = lane >> 4;
    const int K = g.K, nt = K / BK;
    unsigned voffA[2], voffB[2];
#pragma unroll
    for (int i = 0; i < 2; ++i) { int R, C; stage_rc(tid * 16 + i * 8192, R, C); const int Rb = Epi::PERM ? ((R & ~31) + perm32(R & 31)) : R;
        voffA[i] = (unsigned)(R * K + C) * 2u; voffB[i] = (unsigned)(Rb * K + C) * 2u; }
    const size_t kstep = (size_t)(BK * 2);
    const size_t hstep = (size_t)HALF * K * 2;
    const size_t tstep = 2 * hstep;
    const unsigned ldsw = (unsigned)wid * 1024u;
    const int aoff = lds_byte(wr * 64 + fr, fq * 8), boff = lds_byte(wc * 32 + fr, fq * 8);
#define PG8_SA(b, h) (((b) * 2 + (h)) * HTB)
#define PG8_SB(b, h) ((4 + (b) * 2 + (h)) * HTB)
#define PG8_STAGE(bufoff, gbase, voff) do { _Pragma("unroll") for (int _i = 0; _i < 2; ++_i) \
        __builtin_amdgcn_global_load_lds((const unsigned*)((const char*)(gbase) + (voff)[_i]), (PG8_LAS unsigned*)(lds + (bufoff) + ldsw + _i * 8192), 16, 0, 0); } while (0)
#define PG8_LDA(dst, b, h) do { _Pragma("unroll") for (int m = 0; m < 4; ++m) _Pragma("unroll") for (int k = 0; k < 2; ++k) dst[m][k] = *(const PG8_LAS bf16x8*)(lds + PG8_SA(b, h) + aoff + m * 2048 + k * 1024); } while (0)
#define PG8_LDB(dst, b, h) do { _Pragma("unroll") for (int n = 0; n < 2; ++n) _Pragma("unroll") for (int k = 0; k < 2; ++k) dst[n][k] = *(const PG8_LAS bf16x8*)(lds + PG8_SB(b, h) + boff + n * 2048 + k * 1024); } while (0)
#define PG8_MMA(ai, bj, At, Bt) do { __builtin_amdgcn_s_setprio(1); _Pragma("unroll") for (int m = 0; m < 4; ++m) _Pragma("unroll") for (int n = 0; n < 2; ++n) _Pragma("unroll") for (int k = 0; k < 2; ++k) \
        acc[ai][bj][m][n] = __builtin_amdgcn_mfma_f32_16x16x32_bf16(Bt[n][k], At[m][k], acc[ai][bj][m][n], 0, 0, 0); __builtin_amdgcn_s_setprio(0); } while (0)
#define PG8_WAIT_V(n) asm volatile("s_waitcnt vmcnt(" #n ")" ::: "memory")
#define PG8_WAIT_L(n) asm volatile("s_waitcnt lgkmcnt(" #n ")" ::: "memory")
#define PG8_BAR __builtin_amdgcn_s_barrier()
#define PG8_SCHED __builtin_amdgcn_sched_barrier(0)
    Unit cur, nxt; int ui = 0;
    if (!S.next(0, cur)) return;
    f32x4 acc[2][2][4][2];
#pragma unroll
    for (int a = 0; a < 2; ++a)
#pragma unroll
        for (int b = 0; b < 2; ++b)
#pragma unroll
            for (int m = 0; m < 4; ++m)
#pragma unroll
                for (int n = 0; n < 2; ++n) acc[a][b][m][n] = (f32x4){0.f, 0.f, 0.f, 0.f};
    bf16x8 At[4][2], B0[2][2], B1[2][2];
    const char* cA = (const char*)g.A + (size_t)cur.pm * tstep; const char* cB = (const char*)g.Bt + (size_t)cur.pn * tstep;
    S.a_ready(cur);
    if constexpr (SP2) {
        PG8_STAGE(PG8_SB(0, 0), cB, voffB); PG8_STAGE(PG8_SB(0, 1), cB + hstep, voffB); PG8_STAGE(PG8_SA(0, 0), cA, voffA); PG8_STAGE(PG8_SA(0, 1), cA + hstep, voffA);
        if (wr == 1) PG8_BAR;
        PG8_WAIT_V(2); PG8_BAR;
        PG8_STAGE(PG8_SB(1, 0), cB + kstep, voffB); PG8_STAGE(PG8_SA(1, 0), cA + kstep, voffA); PG8_STAGE(PG8_SB(1, 1), cB + hstep + kstep, voffB);
        PG8_WAIT_V(6); PG8_BAR;
    } else {
        PG8_STAGE(PG8_SB(0, 0), cB, voffB); PG8_STAGE(PG8_SA(0, 0), cA, voffA); PG8_STAGE(PG8_SB(0, 1), cB + hstep, voffB); PG8_STAGE(PG8_SA(0, 1), cA + hstep, voffA);
        if (wr == 1) PG8_BAR;
        PG8_WAIT_V(4); PG8_BAR;
        PG8_STAGE(PG8_SB(1, 0), cB + kstep, voffB); PG8_STAGE(PG8_SA(1, 0), cA + kstep, voffA); PG8_STAGE(PG8_SB(1, 1), cB + hstep + kstep, voffB);
        PG8_WAIT_V(6); PG8_BAR;
    }
    for (;;) {
        const bool has_next = S.next(ui + 1, nxt);
        const char* nA = has_next ? (const char*)g.A + (size_t)nxt.pm * tstep : cA; const char* nB = has_next ? (const char*)g.Bt + (size_t)nxt.pn * tstep : cB;
        for (int t = 0; t < nt; t += 2) {
            const bool last = (t == nt - 2);
            const char* a1 = cA + (size_t)(t + 1) * kstep;
            const char* a2 = last ? nA : cA + (size_t)(t + 2) * kstep; const char* b2 = last ? nB : cB + (size_t)(t + 2) * kstep;
            const char* a3 = a2 + kstep; const char* b3 = b2 + kstep;
            if (last && has_next) S.a_ready(nxt);
            if constexpr (SP2) {
            PG8_LDB(B0, 0, 0); PG8_LDB(B1, 0, 1); PG8_SCHED; PG8_LDA(At, 0, 0); PG8_STAGE(PG8_SA(1, 1), a1 + hstep, voffA);
            PG8_WAIT_V(8); PG8_WAIT_L(0); PG8_BAR; PG8_MMA(0, 0, At, B0); PG8_MMA(0, 1, At, B1); PG8_BAR; PG8_SCHED;
            PG8_LDA(At, 0, 1); PG8_STAGE(PG8_SB(0, 0), b2, voffB); PG8_STAGE(PG8_SB(0, 1), b2 + hstep, voffB); PG8_STAGE(PG8_SA(0, 0), a2, voffA);
            PG8_WAIT_V(8); PG8_WAIT_L(0); PG8_BAR; PG8_MMA(1, 0, At, B0); PG8_MMA(1, 1, At, B1); PG8_BAR; PG8_SCHED;
            PG8_LDB(B0, 1, 0); PG8_LDB(B1, 1, 1); PG8_SCHED; PG8_LDA(At, 1, 0); PG8_STAGE(PG8_SA(0, 1), a2 + hstep, voffA);
            PG8_WAIT_V(8); PG8_WAIT_L(0); PG8_BAR; PG8_MMA(0, 0, At, B0); PG8_MMA(0, 1, At, B1); PG8_BAR; PG8_SCHED;
            PG8_LDA(At, 1, 1); PG8_STAGE(PG8_SB(1, 0), b3, voffB); PG8_STAGE(PG8_SB(1, 1), b3 + hstep, voffB); PG8_STAGE(PG8_SA(1, 0), a3, voffA);
            PG8_WAIT_V(8); PG8_WAIT_L(0); PG8_BAR; PG8_MMA(1, 0, At, B0); PG8_MMA(1, 1, At, B1); PG8_BAR; PG8_SCHED;
            } else {
            PG8_LDB(B0, 0, 0); PG8_SCHED; PG8_LDA(At, 0, 0); PG8_STAGE(PG8_SA(1, 1), a1 + hstep, voffA);
            PG8_WAIT_L(8); PG8_BAR; PG8_WAIT_L(0); PG8_MMA(0, 0, At, B0); PG8_BAR; PG8_SCHED;
            PG8_LDB(B1, 0, 1); PG8_STAGE(PG8_SB(0, 0), b2, voffB);
            PG8_BAR; PG8_WAIT_L(0); PG8_MMA(0, 1, At, B1); PG8_BAR;
            PG8_LDA(At, 0, 1); PG8_STAGE(PG8_SA(0, 0), a2, voffA);
            PG8_BAR; PG8_WAIT_L(0); PG8_MMA(1, 0, At, B0); PG8_BAR; PG8_SCHED;
            PG8_STAGE(PG8_SB(0, 1), b2 + hstep, voffB);
            PG8_WAIT_V(6); PG8_BAR; PG8_MMA(1, 1, At, B1); PG8_BAR;
            PG8_LDB(B0, 1, 0); PG8_SCHED; PG8_LDA(At, 1, 0); PG8_STAGE(PG8_SA(0, 1), a2 + hstep, voffA);
            PG8_WAIT_L(8); PG8_BAR; PG8_WAIT_L(0); PG8_MMA(0, 0, At, B0); PG8_BAR; PG8_SCHED;
            PG8_LDB(B1, 1, 1); PG8_STAGE(PG8_SB(1, 0), b3, voffB);
            PG8_BAR; PG8_WAIT_L(0); PG8_MMA(0, 1, At, B1); PG8_BAR;
            PG8_LDA(At, 1, 1); PG8_STAGE(PG8_SA(1, 0), a3, voffA);
            PG8_BAR; PG8_WAIT_L(0); PG8_MMA(1, 0, At, B0); PG8_BAR; PG8_SCHED;
            PG8_STAGE(PG8_SB(1, 1), b3 + hstep, voffB);
            PG8_WAIT_V(6); PG8_BAR; PG8_MMA(1, 1, At, B1); PG8_BAR;
            }
        }
        if constexpr (ALIGN_EPI) { if (wr == 0) PG8_BAR; }
        if constexpr (!Epi::AFTER_DRAIN) { E(acc, cur, wr, wc, fr, fq); S.done(cur); }
        if (!has_next) break;
#pragma unroll
        for (int a = 0; a < 2; ++a)
#pragma unroll
            for (int b = 0; b < 2; ++b)
#pragma unroll
                for (int m = 0; m < 4; ++m)
#pragma unroll
                    for (int n = 0; n < 2; ++n) acc[a][b][m][n] = (f32x4){0.f, 0.f, 0.f, 0.f};
        cur = nxt; cA = nA; cB = nB; ++ui;
        if constexpr (ALIGN_EPI) { if (wr == 1) PG8_BAR; }
    }
    PG8_WAIT_V(0);
    if constexpr (!ALIGN_EPI) { if (wr == 0) PG8_BAR; }
    PG8_BAR;
    (void)lane;
#undef PG8_SA
#undef PG8_SB
#undef PG8_STAGE
#undef PG8_LDA
#undef PG8_LDB
#undef PG8_MMA
#undef PG8_WAIT_V
#undef PG8_WAIT_L
#undef PG8_BAR
#undef PG8_SCHED
}
}

constexpr int BATCH = 32, SEQ = 2048, DM = 1024, MTOK = BATCH * SEQ;
constexpr int INW = 2852, NIN = 3072, FF = 2816, NGU = 2 * FF;
constexpr int NWAVES = 8, NTHR = 512;
#ifndef MK_N_LAUNCHES
#define MK_N_LAUNCHES 1
#endif
constexpr int N_PHASES = 6;
constexpr size_t MiB = 1u << 20;
constexpr size_t WS_CTL = 0;
constexpr size_t WS_COS = 1 * MiB, WS_SIN = WS_COS + 256 * 1024;
constexpr size_t WS_BT = WS_SIN + 256 * 1024;
constexpr size_t WS_R2 = 2 * MiB;
constexpr size_t WS_WIN = 4 * MiB, WS_WOUT = 10 * MiB, WS_WGU = 12 * MiB, WS_WDN = 23 * MiB;
constexpr size_t WS_XB = 32 * MiB;
constexpr size_t WS_MIX = 160 * MiB;
constexpr size_t WS_QA = 288 * MiB, WS_QB = 352 * MiB, WS_KB = 416 * MiB, WS_VB = 480 * MiB, WS_GB = 544 * MiB;
constexpr size_t WS_KA = 608 * MiB, WS_VA = 616 * MiB;
constexpr size_t WS_IQ = 624 * MiB;
constexpr size_t WS_ACT = 288 * MiB;
constexpr size_t WS_IK = 640 * MiB, WS_IW = 644 * MiB;
constexpr size_t WS_MASK = 648 * MiB;
constexpr size_t WS_SCR = 672 * MiB;
constexpr size_t WS_END = 800 * MiB;
static_assert(WS_ACT + (size_t)MTOK * FF * 2 <= WS_IK && WS_IQ + (size_t)MTOK * 128 * 2 <= WS_IK && WS_WDN + (size_t)DM * FF * 2 <= WS_XB && WS_WGU + (size_t)NGU * DM * 2 <= WS_WDN, "d_ws map");
constexpr int RING_BYTES = 131072;
constexpr int XCH_OFF = RING_BYTES;
constexpr int P2_SC = 0, SCW = 2052;
constexpr int P2_MASK = 132096;
constexpr int MISC_OFF = 163584;
constexpr int LDS_BYTES = 163840;
static_assert(P2_SC + 16 * SCW * 4 <= P2_MASK && P2_MASK + 16384 <= MISC_OFF, "P2 LDS map");

#define LAS __attribute__((address_space(3)))
typedef unsigned short bf16;
typedef unsigned v4u __attribute__((ext_vector_type(4)));
typedef unsigned v2u __attribute__((ext_vector_type(2)));
typedef float f32x4 __attribute__((ext_vector_type(4)));
typedef float f32x16 __attribute__((ext_vector_type(16)));
typedef short bf16x8 __attribute__((ext_vector_type(8)));
typedef short s16x4 __attribute__((ext_vector_type(4)));
#define LDS_WAIT() asm volatile("s_waitcnt lgkmcnt(0)" ::: "memory")
using pg8::pkbf;
__device__ __forceinline__ float bf2f(unsigned short h) { return __uint_as_float((unsigned)h << 16); }
__device__ __forceinline__ float bflo(unsigned w) { return __uint_as_float(w << 16); }
__device__ __forceinline__ float bfhi(unsigned w) { return __uint_as_float(w & 0xffff0000u); }
__device__ __forceinline__ float wave_sum(float v) {
#pragma unroll
    for (int o = 1; o < 64; o <<= 1) v += __shfl_xor(v, o);
    return v;
}
__device__ __forceinline__ s16x4 vtr(const LAS unsigned char* p) { return __builtin_bit_cast(s16x4, __builtin_amdgcn_ds_read_tr16_b64_v4i16((LAS s16x4*)p)); }
__device__ __forceinline__ bf16x8 cat8(s16x4 lo, s16x4 hi) { return (bf16x8){lo[0], lo[1], lo[2], lo[3], hi[0], hi[1], hi[2], hi[3]}; }
__device__ __forceinline__ int crow(int r, int hi) { return (r & 3) + 8 * (r >> 2) + 4 * hi; }

__device__ __forceinline__ int lane_id() { unsigned ones = ~0u; asm volatile("" : "+s"(ones)); return (int)__builtin_amdgcn_mbcnt_hi(ones, __builtin_amdgcn_mbcnt_lo(ones, 0u)); }
struct Frame {
    LAS unsigned char* lds;
    unsigned* ctl;
    unsigned char* ws;
    int tid, lane, wave, vcu, G;
    const float *x, *norm1_w, *w_in, *q_norm_w, *k_norm_w, *kv_norm_w, *w_uk, *w_uv, *rel_bias, *ret_gn_w, *ret_gn_b, *w_out, *norm2_w, *w_gate, *w_up, *w_down;
    float* out;
#define WSB_(name, off) __device__ __forceinline__ bf16* name() const { return (bf16*)(ws + (off)); }
#define WSF_(name, off) __device__ __forceinline__ float* name() const { return (float*)(ws + (off)); }
    WSB_(WIN, WS_WIN) WSB_(WOUT, WS_WOUT) WSB_(WGU, WS_WGU) WSB_(WDN, WS_WDN) WSB_(XB, WS_XB) WSB_(MIX, WS_MIX) WSB_(QA, WS_QA) WSB_(QB, WS_QB) WSB_(KB, WS_KB) WSB_(VB, WS_VB) WSB_(GB, WS_GB)
    WSB_(KA, WS_KA) WSB_(VA, WS_VA) WSB_(IQ, WS_IQ) WSB_(IK, WS_IK) WSB_(ACT, WS_ACT)
    WSF_(IW, WS_IW) WSF_(R2, WS_R2) WSF_(COS, WS_COS) WSF_(SIN, WS_SIN) WSF_(BT, WS_BT) WSF_(SCR, WS_SCR)
    __device__ __forceinline__ unsigned long long* MASK() const { return (unsigned long long*)(ws + WS_MASK); }
#undef WSB_
#undef WSF_
};

__device__ __forceinline__ int zcol(int n) {
    const int pn = n >> 8, tc = n & 255, bj = tc >> 7, wc = (tc >> 5) & 3, j = tc & 31, d = bj * 32 + j;
    if (pn < 2) return (4 * pn + wc) * 64 + d;
    if (pn == 2) { if (wc == 0) return -2 - d; if (wc == 1) return -2 - (64 + d); return 512 + (wc - 2) * 64 + d; }
    if (pn == 3) { if (bj == 0) return 640 + wc * 32 + j; if (wc == 0) return 768 + j; if (wc == 1 && j < 4) return 800 + j; return -1; }
    const int g = (pn - 4) >> 1, head = 4 * ((pn - 4) & 1) + wc;
    return 804 + g * 512 + head * 64 + d;
}
template <class SRC>
__device__ __forceinline__ void tr_item(SRC src, int Kdim, bf16* WT, int k0, int n0, LAS float* scr, int lane) {
#pragma unroll 4
    for (int i = 0; i < 32; ++i) { const int kk = 2 * i + (lane >> 5); scr[kk * 33 + (lane & 31)] = src(k0 + kk); }
    LDS_WAIT(); asm volatile("" ::: "memory");
    const int c = lane & 7;
#pragma unroll
    for (int j = 0; j < 4; ++j) { const int n = (lane >> 3) + 8 * j; const LAS float* s = scr + (8 * c) * 33 + n;
        v4u o; o.x = pkbf(s[0 * 33], s[1 * 33]); o.y = pkbf(s[2 * 33], s[3 * 33]); o.z = pkbf(s[4 * 33], s[5 * 33]); o.w = pkbf(s[6 * 33], s[7 * 33]);
        *(v4u*)(WT + (size_t)(n0 + n) * Kdim + k0 + 8 * c) = o; }
    LDS_WAIT(); asm volatile("" ::: "memory");
}
__device__ __forceinline__ int t5_bucket(int rel) {
    const int n = rel < 0 ? -rel : rel; int b;
    if (n < 8) b = n; else if (n < 12) b = 8; else if (n < 16) b = 9; else if (n < 23) b = 10; else if (n < 32) b = 11; else if (n < 46) b = 12; else if (n < 64) b = 13; else if (n < 91) b = 14; else b = 15;
    return (rel > 0 ? 16 : 0) + b;
}
__device__ __forceinline__ void p0_prologue(Frame& F) {
    LAS float* scr = (LAS float*)(F.lds + F.wave * 16384);
    const int lane = F.lane, gw = F.vcu * NWAVES + F.wave, NGW = F.G * NWAVES;
    if (blockIdx.x == 0 && F.tid == 0) F.ctl[0] = 0u;
    constexpr int I_IN = 16 * (NIN / 32), I_OUT = 16 * 32, I_GU = 16 * (NGU / 32), I_DN = (FF / 64) * 32, NITEMS = I_IN + I_OUT + I_GU + I_DN;
    for (int it = gw; it < NITEMS; it += NGW) {
        int r = it;
        if (r < I_IN) {
            const int kb = r / (NIN / 32), nb = r % (NIN / 32), f = zcol(32 * nb + (lane & 31));
            const float* w_in = F.w_in; const float* nw = F.norm1_w;
            if (f >= -1) tr_item([&](int k) { return f >= 0 ? nw[k] * w_in[(size_t)k * INW + f] : 0.0f; }, DM, F.WIN(), 64 * kb, 32 * nb, scr, lane);
            continue;
        }
        r -= I_IN;
        if (r < I_OUT) { const int kb = r / 32, nb = r % 32; const float* w = F.w_out + 32 * nb + (lane & 31);
            tr_item([&](int k) { return w[(size_t)k * DM]; }, DM, F.WOUT(), 64 * kb, 32 * nb, scr, lane); continue; }
        r -= I_OUT;
        if (r < I_GU) { const int kb = r / (NGU / 32), nb = r % (NGU / 32), n = 32 * nb + (lane & 31), pn = n >> 8, tc = n & 255;
            const float* w = ((tc >> 7) ? F.w_up : F.w_gate) + 128 * pn + (tc & 127); const float* nw = F.norm2_w;
            tr_item([&](int k) { return nw[k] * w[(size_t)k * FF]; }, DM, F.WGU(), 64 * kb, 32 * nb, scr, lane); continue; }
        r -= I_GU;
        { const int kb = r / 32, nb = r % 32; const float* w = F.w_down + 32 * nb + (lane & 31);
            tr_item([&](int k) { return w[(size_t)k * DM]; }, FF, F.WDN(), 64 * kb, 32 * nb, scr, lane); }
    }
    for (int e = F.vcu * NTHR + F.tid; e < DM * 128; e += F.G * NTHR) {
        const int k = e >> 7, idx = e & 127, d = idx & 63; const float* wu = (idx < 64 ? F.w_uk : F.w_uv) + d; const float* wr_ = F.w_in + (size_t)k * INW + 512; float a = 0.f;
#pragma unroll 8
        for (int j = 0; j < 128; ++j) a += wr_[j] * F.kv_norm_w[j] * wu[j * 64];
        const int n = 512 + (idx < 64 ? 0 : 32) + (d < 32 ? d : 128 + d - 32);
        F.WIN()[(size_t)n * DM + k] = (bf16)(pkbf(F.norm1_w[k] * a, 0.f) & 0xffffu);
    }
    for (int m = gw; m < MTOK; m += NGW) {
        const f32x4* xr = (const f32x4*)(F.x + (size_t)m * DM) + lane;
        f32x4 v[4]; float s = 0.f;
#pragma unroll
        for (int j = 0; j < 4; ++j) { v[j] = xr[64 * j]; s += pg8::dot4(v[j]); }
        const float rr = 1.0f / sqrtf(wave_sum(s) * (1.0f / DM) + 1e-6f);
        v2u* o8 = (v2u*)(F.XB() + (size_t)m * DM) + lane;
#pragma unroll
        for (int j = 0; j < 4; ++j) o8[64 * j] = (v2u){pkbf(v[j][0] * rr, v[j][1] * rr), pkbf(v[j][2] * rr, v[j][3] * rr)};
    }
    const int gt = F.vcu * NTHR + F.tid, NGT = F.G * NTHR;
    for (int i = gt; i < SEQ * 32; i += NGT) { const int pos = i >> 5, j = i & 31;
        const float inv = powf(10000.0f, -(float)j / 32.0f), ang = (float)pos * inv;
        F.COS()[i] = cosf(ang); F.SIN()[i] = sinf(ang); }
    for (int i = gt; i < 8 * 256; i += NGT) { const int h = i >> 8, rel = (i & 255) - 191;
        float mq = 0.f, mk = 0.f, mb = 0.f;
        for (int j = 0; j < 64; ++j) { mq = fmaxf(mq, fabsf(F.q_norm_w[j])); mk = fmaxf(mk, fabsf(F.k_norm_w[j])); }
        for (int j = 0; j < 256; ++j) mb = fmaxf(mb, fabsf(F.rel_bias[j]));
        const float bound = 8.0f * mq * mk + mb;
        F.BT()[i] = (F.rel_bias[t5_bucket(rel) * 8 + h] - bound) * 1.4426950408889634f; }
}

#ifndef MIXREP
#define MIXREP 0
#endif
typedef float f32x4_t __attribute__((ext_vector_type(4)));
typedef float f32x2v __attribute__((ext_vector_type(2)));
__device__ __forceinline__ void idx_round(const Frame& F, int b, int c, int rq, LAS unsigned char* lds) {
    const int w = F.wave, lane = F.lane, q = lane & 15, g = lane >> 4;
    const size_t rowq = (size_t)b * SEQ + 64 * c + 16 * rq + q;
    bf16x8 bq[4];
#pragma unroll
    for (int h = 0; h < 4; ++h) bq[h] = *(const bf16x8*)(F.IQ() + rowq * 128 + 32 * h + 8 * g);
    const f32x4 wv = *(const f32x4*)(F.IW() + rowq * 4) * (0.5f * 0.17677669529663687f);
    const int nkb = 4 * (c + 1);
    const bf16* kp = F.IK() + ((size_t)b * SEQ + q) * 32 + 8 * g;
    LAS float* dst = (LAS float*)(lds + P2_SC) + q * SCW + 4 * g;
    int kb = w; bf16x8 a = *(const bf16x8*)(kp + (size_t)kb * 512);
    for (; kb < nkb; kb += 8) {
        bf16x8 an = a; if (kb + 8 < nkb) an = *(const bf16x8*)(kp + (size_t)(kb + 8) * 512);
        f32x4 sc = {0.f, 0.f, 0.f, 0.f};
#pragma unroll
        for (int h = 0; h < 4; ++h) {
            const f32x4 d = __builtin_amdgcn_mfma_f32_16x16x32_bf16(a, bq[h], (f32x4){0.f, 0.f, 0.f, 0.f}, 0, 0, 0);
#pragma unroll
            for (int i = 0; i < 4; ++i) sc[i] += wv[h] * fmaxf(d[i], 0.f);
        }
        *(LAS f32x4*)(dst + 16 * kb) = (f32x4){sc[0] + 0.f, sc[1] + 0.f, sc[2] + 0.f, sc[3] + 0.f};
        a = an;
    }
}
__device__ __forceinline__ int wave_sum_i(int v) {
    v += __builtin_amdgcn_update_dpp(0, v, 0xB1, 0xF, 0xF, false);
    v += __builtin_amdgcn_update_dpp(0, v, 0x4E, 0xF, 0xF, false);
    v += __builtin_amdgcn_update_dpp(0, v, 0x141, 0xF, 0xF, false);
    v += __builtin_amdgcn_update_dpp(0, v, 0x140, 0xF, 0xF, false);
    return (__builtin_amdgcn_readlane(v, 0) + __builtin_amdgcn_readlane(v, 16)) + (__builtin_amdgcn_readlane(v, 32) + __builtin_amdgcn_readlane(v, 48));
}
__device__ __forceinline__ unsigned sortable(float f) { const unsigned bits = __float_as_uint(f); return bits ^ ((unsigned)((int)bits >> 31) | 0x80000000u); }
template <int NJ>
__device__ __forceinline__ void mask_words(const unsigned (&u)[NJ], unsigned prefix, bool exact, LAS unsigned long long* mrow, int nj, int lane) {
    unsigned long long mv = 0ull;
    if (exact) {
#pragma unroll
        for (int j = 0; j < NJ; ++j) { const unsigned long long sel = __ballot(u[j] >= prefix); if (lane == j) mv = sel; }
    } else {
        int ngt = 0;
#pragma unroll
        for (int j = 0; j < NJ; ++j) ngt += __popcll(__ballot(u[j] > prefix));
        int need = 256 - ngt;
#pragma unroll
        for (int j = 0; j < NJ; ++j) {
            const unsigned long long eq = __ballot(u[j] == prefix);
            const int rank = (int)__builtin_amdgcn_mbcnt_hi((unsigned)(eq >> 32), __builtin_amdgcn_mbcnt_lo((unsigned)eq, 0u));
            const unsigned long long sel = __ballot(u[j] > prefix || (u[j] == prefix && rank < need));
            need -= __popcll(eq);
            if (lane == j) mv = sel;
        }
    }
    if (lane < nj) mrow[lane] = mv;
}
template <int NJ>
__device__ __forceinline__ void select_row(const LAS float* row, LAS unsigned long long* mrow, int nj, int lane) {
    static_assert(NJ % 4 == 0, "groups of four");
    unsigned u[NJ];
#pragma unroll
    for (int j = 0; j < NJ; ++j) u[j] = (j < nj) ? sortable(row[64 * j + lane]) : 0u;
    unsigned prefix = 0u; bool exact = false;
#pragma unroll 1
    for (int bit = 31; bit >= 0; --bit) {
        const unsigned trial = prefix | (1u << bit); int c0 = 0, c1 = 0, c2 = 0, c3 = 0;
#pragma unroll
        for (int j = 0; j < NJ; j += 4) {
            unsigned long long m0, m1, m2, m3;
            asm volatile("v_cmp_le_u32_e64 %4, %12, %8\n\tv_cmp_le_u32_e64 %5, %12, %9\n\tv_cmp_le_u32_e64 %6, %12, %10\n\tv_cmp_le_u32_e64 %7, %12, %11\n\t"
                         "v_addc_co_u32_e64 %0, %4, 0, %0, %4\n\tv_addc_co_u32_e64 %1, %5, 0, %1, %5\n\tv_addc_co_u32_e64 %2, %6, 0, %2, %6\n\tv_addc_co_u32_e64 %3, %7, 0, %3, %7"
                         : "+v"(c0), "+v"(c1), "+v"(c2), "+v"(c3), "=&s"(m0), "=&s"(m1), "=&s"(m2), "=&s"(m3) : "v"(u[j]), "v"(u[j + 1]), "v"(u[j + 2]), "v"(u[j + 3]), "s"(trial));
        }
        const int cnt = wave_sum_i((c0 + c1) + (c2 + c3));
        if (cnt >= 256) prefix = trial;
        if (cnt == 256) { exact = true; break; }
    }
    mask_words<NJ>(u, prefix, exact, mrow, nj, lane);
}
constexpr int AT_K = 0, AT_V = 16384, AT_BT = 32768, AT_WS = 40960;
__device__ __forceinline__ void attn_group(f32x16& o0, f32x16& o1, f32x2v& lacc, const LAS unsigned char* Kb, const bf16x8 (&qr)[4], const LAS unsigned char* Vb, const LAS float* bt, bool nearT, float ci,
                                           bool usemask, unsigned long long mw, int hi) {
    f32x16 p0, p1;
#pragma unroll
    for (int i = 0; i < 16; ++i) { p0[i] = ci; p1[i] = ci; }
    asm volatile("" : "+v"(Kb));
#pragma unroll
    for (int d0 = 0; d0 < 4; ++d0) {
        const bf16x8 k0 = *(const LAS bf16x8*)(Kb + d0 * 2048), k1 = *(const LAS bf16x8*)(Kb + d0 * 2048 + 512);
        p0 = __builtin_amdgcn_mfma_f32_32x32x16_bf16(k0, qr[d0], p0, 0, 0, 0);
        p1 = __builtin_amdgcn_mfma_f32_32x32x16_bf16(k1, qr[d0], p1, 0, 0, 0);
    }
    if (nearT) {
#pragma unroll
        for (int i = 0; i < 16; ++i) { p0[i] += bt[(i & 3) + 8 * (i >> 2)]; p1[i] += bt[32 + (i & 3) + 8 * (i >> 2)]; }
    }
#pragma unroll
    for (int i = 0; i < 16; ++i) { p0[i] = __builtin_amdgcn_exp2f(p0[i]); p1[i] = __builtin_amdgcn_exp2f(p1[i]); }
    if (usemask) {
        const unsigned long long ws_ = mw >> (4 * hi); const int lo = (int)(unsigned)ws_, hh = (int)(unsigned)(ws_ >> 32);
#define MSK_(i) { int m0_, m1_; asm("v_bfe_i32 %0, %1, %2, 1" : "=v"(m0_) : "v"(lo), "n"(((i) & 3) + 8 * ((i) >> 2))); asm("v_bfe_i32 %0, %1, %2, 1" : "=v"(m1_) : "v"(hh), "n"(((i) & 3) + 8 * ((i) >> 2))); \
            p0[i] = __uint_as_float(__float_as_uint(p0[i]) & (unsigned)m0_); p1[i] = __uint_as_float(__float_as_uint(p1[i]) & (unsigned)m1_); }
        MSK_(0) MSK_(1) MSK_(2) MSK_(3) MSK_(4) MSK_(5) MSK_(6) MSK_(7) MSK_(8) MSK_(9) MSK_(10) MSK_(11) MSK_(12) MSK_(13) MSK_(14) MSK_(15)
#undef MSK_
    }
#pragma unroll
    for (int i = 0; i < 16; i += 2) { lacc += (f32x2v){p0[i], p0[i + 1]}; lacc += (f32x2v){p1[i], p1[i + 1]}; }
    const bf16x8 pa0 = __builtin_bit_cast(bf16x8, (v4u){pkbf(p0[0], p0[1]), pkbf(p0[2], p0[3]), pkbf(p0[4], p0[5]), pkbf(p0[6], p0[7])});
    const bf16x8 pa1 = __builtin_bit_cast(bf16x8, (v4u){pkbf(p0[8], p0[9]), pkbf(p0[10], p0[11]), pkbf(p0[12], p0[13]), pkbf(p0[14], p0[15])});
    const bf16x8 pa2 = __builtin_bit_cast(bf16x8, (v4u){pkbf(p1[0], p1[1]), pkbf(p1[2], p1[3]), pkbf(p1[4], p1[5]), pkbf(p1[6], p1[7])});
    const bf16x8 pa3 = __builtin_bit_cast(bf16x8, (v4u){pkbf(p1[8], p1[9]), pkbf(p1[10], p1[11]), pkbf(p1[12], p1[13]), pkbf(p1[14], p1[15])});
    o0 = __builtin_amdgcn_mfma_f32_32x32x16_bf16(pa0, cat8(vtr(Vb + 0), vtr(Vb + 512)), o0, 0, 0, 0);
    o0 = __builtin_amdgcn_mfma_f32_32x32x16_bf16(pa1, cat8(vtr(Vb + 1024), vtr(Vb + 1536)), o0, 0, 0, 0);
    o0 = __builtin_amdgcn_mfma_f32_32x32x16_bf16(pa2, cat8(vtr(Vb + 2048), vtr(Vb + 2560)), o0, 0, 0, 0);
    o0 = __builtin_amdgcn_mfma_f32_32x32x16_bf16(pa3, cat8(vtr(Vb + 3072), vtr(Vb + 3584)), o0, 0, 0, 0);
    o1 = __builtin_amdgcn_mfma_f32_32x32x16_bf16(pa0, cat8(vtr(Vb + 4096), vtr(Vb + 4608)), o1, 0, 0, 0);
    o1 = __builtin_amdgcn_mfma_f32_32x32x16_bf16(pa1, cat8(vtr(Vb + 5120), vtr(Vb + 5632)), o1, 0, 0, 0);
    o1 = __builtin_amdgcn_mfma_f32_32x32x16_bf16(pa2, cat8(vtr(Vb + 6144), vtr(Vb + 6656)), o1, 0, 0, 0);
    o1 = __builtin_amdgcn_mfma_f32_32x32x16_bf16(pa3, cat8(vtr(Vb + 7168), vtr(Vb + 7680)), o1, 0, 0, 0);
}
__device__ __forceinline__ void attn_store(const f32x16& o0, const f32x16& o1, f32x2v lacc, bf16* orow, LAS float* wsf, int r, int hi) {
    float lsum = lacc[0] + lacc[1];
    lsum += __shfl_xor(lsum, 32);
    if (hi == 0) wsf[r] = lsum;
    LDS_WAIT(); asm volatile("" ::: "memory");
#pragma unroll
    for (int i = 0; i < 16; ++i) {
        const int q = crow(i, hi); const float rl = 1.0f / wsf[q];
        orow[(size_t)q * DM] = (bf16)(pkbf(o0[i] * rl, 0.f) & 0xffffu); orow[(size_t)q * DM + 32] = (bf16)(pkbf(o1[i] * rl, 0.f) & 0xffffu);
    }
    LDS_WAIT(); asm volatile("" ::: "memory");
}
__device__ __forceinline__ void attn_chunk(const Frame& F, int b, int c, LAS unsigned char* lds) {
    const int wid = F.wave, lane = F.lane, r = lane & 31, hi = lane >> 5;
    const size_t rowbase = (size_t)b * SEQ; const int q0 = 64 * c, nt = c + 1; const bool usemask = c >= 4;
    bf16x8 qa[4], qb[4];
#pragma unroll
    for (int d0 = 0; d0 < 4; ++d0) { qa[d0] = *(const bf16x8*)(F.QA() + (rowbase + q0 + r) * 512 + wid * 64 + 16 * d0 + 8 * hi); qb[d0] = *(const bf16x8*)(F.QA() + (rowbase + q0 + 32 + r) * 512 + wid * 64 + 16 * d0 + 8 * hi); }
    const LAS float* BT = (const LAS float*)(lds + AT_BT) + wid * 256;
    const float farc = BT[0];
    const bf16* ksrc = F.KA() + (rowbase + lane) * 64 + 8 * wid;
    const bf16* vsrc = F.VA() + (rowbase + 16 * (wid & 3) + (lane >> 2)) * 64 + (wid >> 2) * 32 + (lane & 3) * 8;
    const LAS unsigned long long* mrow = (const LAS unsigned long long*)(lds + P2_MASK) + r * 32;
    const int stoff = wid * 1024 + lane * 16;
    const int voff = ((lane >> 4) & 1) * 32 + (lane & 3) * 8 + (4 * hi + ((lane & 15) >> 2)) * 64;
    f32x16 oa0, oa1, ob0, ob1; f32x2v la = {0.f, 0.f}, lb = {0.f, 0.f};
#pragma unroll
    for (int i = 0; i < 16; ++i) { oa0[i] = 0.f; oa1[i] = 0.f; ob0[i] = 0.f; ob1[i] = 0.f; }
    v4u kreg = *(const v4u*)ksrc, vreg = *(const v4u*)vsrc;
    *(LAS v4u*)(lds + AT_K + stoff) = kreg; *(LAS v4u*)(lds + AT_V + stoff) = vreg;
    __syncthreads();
    for (int t = 0; t < nt; ++t) {
        const int cur = (t & 1) * 8192, nxt = 8192 - cur;
        if (t + 1 < nt) { kreg = *(const v4u*)(ksrc + (size_t)(t + 1) * 64 * 64); vreg = *(const v4u*)(vsrc + (size_t)(t + 1) * 64 * 64); }
        unsigned long long mwa = ~0ull, mwb = ~0ull;
        if (usemask) { mwa = mrow[t]; mwb = mrow[32 * 32 + t]; }
        const LAS unsigned char* Kb = lds + AT_K + cur + hi * 1024 + r * 16; const LAS unsigned char* Vb = lds + AT_V + cur + voff;
        const bool nearT = t + 2 >= c; const float ci = nearT ? 0.f : farc;
        const LAS float* bt = BT + (64 * (t - c) + 191 - r + 4 * hi);
        attn_group(oa0, oa1, la, Kb, qa, Vb, bt, nearT, ci, usemask, mwa, hi);
        attn_group(ob0, ob1, lb, Kb, qb, Vb, bt - 32, nearT, ci, usemask, mwb, hi);
        if (t + 1 < nt) { *(LAS v4u*)(lds + AT_K + nxt + stoff) = kreg; *(LAS v4u*)(lds + AT_V + nxt + stoff) = vreg; }
        __syncthreads();
    }
    LAS float* wsf = (LAS float*)(lds + AT_WS) + wid * 64;
    attn_store(oa0, oa1, la, F.MIX() + (rowbase + q0) * DM + wid * 64 + r, wsf, r, hi);
    attn_store(ob0, ob1, lb, F.MIX() + (rowbase + q0 + 32) * DM + wid * 64 + r, wsf, r, hi);
}
__device__ __forceinline__ void attn_unit(const Frame& F, int b, int c, LAS unsigned char* lds) {
    if (c >= 4) {
        const int nj = c + 1;
        for (int rp_ = 0; rp_ < ((MIXREP & 2) ? 2 : 1); ++rp_)
        for (int rq = 0; rq < 4; ++rq) {
            for (int r2_ = 0; r2_ < ((MIXREP & 16) ? 2 : 1); ++r2_) { if (r2_) __syncthreads(); idx_round(F, b, c, rq, lds); }
            __syncthreads();
#pragma unroll 1
            for (int k = 0; k < ((MIXREP & 32) ? 4 : 2); ++k) {
                const int ql = 2 * F.wave + (k & 1);
                const LAS float* row = (const LAS float*)(lds + P2_SC) + ql * SCW; LAS unsigned long long* mrow = (LAS unsigned long long*)(lds + P2_MASK) + (16 * rq + ql) * 32;
                if (nj <= 8) select_row<8>(row, mrow, nj, F.lane);
                else if (nj <= 16) select_row<16>(row, mrow, nj, F.lane);
                else if (nj <= 24) select_row<24>(row, mrow, nj, F.lane);
                else select_row<32>(row, mrow, nj, F.lane);
            }
            __syncthreads();
        }
    }
    { const f32x4 v = *(const f32x4*)(F.BT() + F.tid * 4); *(LAS f32x4*)(lds + AT_BT + F.tid * 16) = v; }
    __syncthreads();
    for (int rp_ = 0; rp_ < ((MIXREP & 8) ? 2 : 1); ++rp_) {
    attn_chunk(F, b, c, lds);
    }
}

constexpr int RT_Q = 0, RT_K = 16384, RT_KT = 32768, RT_V = 49152, RT_S = 65536, RT_Y = 81920;
__device__ __forceinline__ v4u scale8(v4u k, float f) {
    return (v4u){pkbf(bflo(k.x) * f, bfhi(k.x) * f), pkbf(bflo(k.y) * f, bfhi(k.y) * f), pkbf(bflo(k.z) * f, bfhi(k.z) * f), pkbf(bflo(k.w) * f, bfhi(k.w) * f)};
}
__device__ __forceinline__ void ret_unit(const Frame& F, int b, int h, LAS unsigned char* lds) {
    const int tid = F.tid, lane = F.lane, w = F.wave, r = lane & 31, hi = lane >> 5;
    const float gam = 1.0f - exp2f(-5.0f - (float)h), lg2 = log2f(gam), cdec = exp2f(64.0f * lg2);
    const int rB = 16 * (w & 3) + (lane >> 2), cB = (w >> 2) * 32 + (lane & 3) * 8;
    const float kdec = exp2f((float)(63 - rB) * lg2);
    const size_t base = (size_t)b * SEQ * 512 + h * 64;
    const bf16* qsrc = F.QB() + base + (size_t)lane * 512 + 8 * w;
    const bf16* ksrc = F.KB() + base + (size_t)lane * 512 + 8 * w;
    const bf16* k2src = F.KB() + base + (size_t)rB * 512 + cB;
    const bf16* vsrc = F.VB() + base + (size_t)rB * 512 + cB;
    const int ei = tid >> 3, eseg = tid & 7;
    const bf16* gsrc = F.GB() + base + (size_t)ei * 512 + 8 * eseg;
    bf16* osrc = F.MIX() + ((size_t)b * SEQ + ei) * DM + 512 + h * 64 + 8 * eseg;
    const f32x4 gw0 = *(const f32x4*)(F.ret_gn_w + h * 64 + 8 * eseg), gw1 = *(const f32x4*)(F.ret_gn_w + h * 64 + 8 * eseg + 4);
    const f32x4 gb0 = *(const f32x4*)(F.ret_gn_b + h * 64 + 8 * eseg), gb1 = *(const f32x4*)(F.ret_gn_b + h * 64 + 8 * eseg + 4);
    const int stoff = w * 1024 + lane * 16;
    const int voff = ((lane >> 4) & 1) * 32 + (lane & 3) * 8 + (4 * hi + ((lane & 15) >> 2)) * 64;
    f32x16 st;
#pragma unroll
    for (int i = 0; i < 16; ++i) st[i] = 0.f;
    *(LAS v4u*)(lds + RT_S + tid * 16) = (v4u){0u, 0u, 0u, 0u};
    v4u qreg = *(const v4u*)qsrc, kreg = *(const v4u*)ksrc, k2reg = *(const v4u*)k2src, vreg = *(const v4u*)vsrc;
    *(LAS v4u*)(lds + RT_Q + stoff) = qreg; *(LAS v4u*)(lds + RT_K + stoff) = kreg; *(LAS v4u*)(lds + RT_KT + stoff) = scale8(k2reg, kdec); *(LAS v4u*)(lds + RT_V + stoff) = vreg;
    __syncthreads();
    for (int n = 0; n < 32; ++n) {
        const int cur = (n & 1) * 8192, nxt = 8192 - cur;
        const size_t adv = (size_t)(n + 1) * 64 * 512;
        if (n + 1 < 32) { qreg = *(const v4u*)(qsrc + adv); kreg = *(const v4u*)(ksrc + adv); k2reg = *(const v4u*)(k2src + adv); vreg = *(const v4u*)(vsrc + adv); }
        const v4u greg = *(const v4u*)(gsrc + (size_t)n * 64 * 512);
        float lg2v = lg2; asm volatile("" : "+v"(lg2v));
        if (w < 4) {
            const int ib = w & 1, db = w >> 1;
            const LAS unsigned char* Qb = lds + RT_Q + cur + hi * 1024 + (32 * ib + r) * 16;
            const LAS unsigned char* Kb = lds + RT_K + cur + hi * 1024 + r * 16;
            const LAS unsigned char* Vb = lds + RT_V + cur + voff + db * 4096;
            const LAS unsigned char* Sb = lds + RT_S + cur + hi * 1024 + (32 * db + r) * 16;
            bf16x8 qf[4];
#pragma unroll
            for (int s = 0; s < 4; ++s) qf[s] = *(const LAS bf16x8*)(Qb + s * 2048);
            f32x16 s0, s1, yin, ycr;
#pragma unroll
            for (int i = 0; i < 16; ++i) { s0[i] = 0.f; s1[i] = 0.f; yin[i] = 0.f; ycr[i] = 0.f; }
#pragma unroll
            for (int s = 0; s < 4; ++s) s0 = __builtin_amdgcn_mfma_f32_32x32x16_bf16(*(const LAS bf16x8*)(Kb + s * 2048), qf[s], s0, 0, 0, 0);
            if (ib == 1) {
#pragma unroll
                for (int s = 0; s < 4; ++s) s1 = __builtin_amdgcn_mfma_f32_32x32x16_bf16(*(const LAS bf16x8*)(Kb + s * 2048 + 512), qf[s], s1, 0, 0, 0);
            }
#pragma unroll
            for (int i = 0; i < 16; ++i) {
                const int e0 = 32 * ib + r - crow(i, hi), e1 = e0 - 32;
                s0[i] *= (e0 >= 0) ? __builtin_amdgcn_exp2f((float)e0 * lg2v) : 0.f;
                s1[i] *= (e1 >= 0) ? __builtin_amdgcn_exp2f((float)e1 * lg2v) : 0.f;
            }
            const bf16x8 pa0 = __builtin_bit_cast(bf16x8, (v4u){pkbf(s0[0], s0[1]), pkbf(s0[2], s0[3]), pkbf(s0[4], s0[5]), pkbf(s0[6], s0[7])});
            const bf16x8 pa1 = __builtin_bit_cast(bf16x8, (v4u){pkbf(s0[8], s0[9]), pkbf(s0[10], s0[11]), pkbf(s0[12], s0[13]), pkbf(s0[14], s0[15])});
            yin = __builtin_amdgcn_mfma_f32_32x32x16_bf16(pa0, cat8(vtr(Vb + 0), vtr(Vb + 512)), yin, 0, 0, 0);
            yin = __builtin_amdgcn_mfma_f32_32x32x16_bf16(pa1, cat8(vtr(Vb + 1024), vtr(Vb + 1536)), yin, 0, 0, 0);
            if (ib == 1) {
                const bf16x8 pa2 = __builtin_bit_cast(bf16x8, (v4u){pkbf(s1[0], s1[1]), pkbf(s1[2], s1[3]), pkbf(s1[4], s1[5]), pkbf(s1[6], s1[7])});
                const bf16x8 pa3 = __builtin_bit_cast(bf16x8, (v4u){pkbf(s1[8], s1[9]), pkbf(s1[10], s1[11]), pkbf(s1[12], s1[13]), pkbf(s1[14], s1[15])});
                yin = __builtin_amdgcn_mfma_f32_32x32x16_bf16(pa2, cat8(vtr(Vb + 2048), vtr(Vb + 2560)), yin, 0, 0, 0);
                yin = __builtin_amdgcn_mfma_f32_32x32x16_bf16(pa3, cat8(vtr(Vb + 3072), vtr(Vb + 3584)), yin, 0, 0, 0);
            }
#pragma unroll
            for (int s = 0; s < 4; ++s) ycr = __builtin_amdgcn_mfma_f32_32x32x16_bf16(qf[s], *(const LAS bf16x8*)(Sb + s * 2048), ycr, 0, 0, 0);
            LAS float* Y = (LAS float*)(lds + RT_Y);
#pragma unroll
            for (int i = 0; i < 16; ++i) { const int ii = 32 * ib + crow(i, hi);
                Y[ii * 65 + 32 * db + r] = yin[i] + __builtin_amdgcn_exp2f((float)(ii + 1) * lg2v) * ycr[i]; }
        } else {
            const int eb = w & 1, db = (w >> 1) & 1;
            const LAS unsigned char* Kt = lds + RT_KT + cur + voff + eb * 4096;
            const LAS unsigned char* Vb = lds + RT_V + cur + voff + db * 4096;
            LAS unsigned char* Sn = lds + RT_S + nxt + (4 * eb) * 1024 + (32 * db + r) * 16 + hi * 8;
#pragma unroll
            for (int i = 0; i < 16; ++i) st[i] *= cdec;
#pragma unroll
            for (int ks = 0; ks < 4; ++ks)
                st = __builtin_amdgcn_mfma_f32_32x32x16_bf16(cat8(vtr(Kt + ks * 1024), vtr(Kt + ks * 1024 + 512)), cat8(vtr(Vb + ks * 1024), vtr(Vb + ks * 1024 + 512)), st, 0, 0, 0);
#pragma unroll
            for (int g = 0; g < 4; ++g) *(LAS v2u*)(Sn + g * 1024) = (v2u){pkbf(st[4 * g], st[4 * g + 1]), pkbf(st[4 * g + 2], st[4 * g + 3])};
        }
        __syncthreads();
        {
            const LAS float* Y = (const LAS float*)(lds + RT_Y) + ei * 65 + 8 * eseg;
            float y[8];
#pragma unroll
            for (int k = 0; k < 8; ++k) y[k] = Y[k];
            float s = ((y[0] + y[1]) + (y[2] + y[3])) + ((y[4] + y[5]) + (y[6] + y[7]));
            s += __shfl_xor(s, 1); s += __shfl_xor(s, 2); s += __shfl_xor(s, 4);
            const float mean = s * (1.0f / 64.0f); float v = 0.f;
#pragma unroll
            for (int k = 0; k < 8; ++k) { y[k] -= mean; v += y[k] * y[k]; }
            v += __shfl_xor(v, 1); v += __shfl_xor(v, 2); v += __shfl_xor(v, 4);
            const float rstd = 1.0f / sqrtf(v * (1.0f / 64.0f) + 1e-5f);
            const float o0 = (y[0] * rstd * gw0[0] + gb0[0]) * bflo(greg.x), o1 = (y[1] * rstd * gw0[1] + gb0[1]) * bfhi(greg.x);
            const float o2 = (y[2] * rstd * gw0[2] + gb0[2]) * bflo(greg.y), o3 = (y[3] * rstd * gw0[3] + gb0[3]) * bfhi(greg.y);
            const float o4 = (y[4] * rstd * gw1[0] + gb1[0]) * bflo(greg.z), o5 = (y[5] * rstd * gw1[1] + gb1[1]) * bfhi(greg.z);
            const float o6 = (y[6] * rstd * gw1[2] + gb1[2]) * bflo(greg.w), o7 = (y[7] * rstd * gw1[3] + gb1[3]) * bfhi(greg.w);
            *(v4u*)(osrc + (size_t)n * 64 * DM) = (v4u){pkbf(o0, o1), pkbf(o2, o3), pkbf(o4, o5), pkbf(o6, o7)};
        }
        if (n + 1 < 32) { *(LAS v4u*)(lds + RT_Q + nxt + stoff) = qreg; *(LAS v4u*)(lds + RT_K + nxt + stoff) = kreg; *(LAS v4u*)(lds + RT_KT + nxt + stoff) = scale8(k2reg, kdec); *(LAS v4u*)(lds + RT_V + nxt + stoff) = vreg; }
        __syncthreads();
    }
}
constexpr int N_RET = BATCH * 8, N_ATT = BATCH * 32, N_MIX = N_RET + N_ATT;
__device__ __forceinline__ void p2_mixers(Frame& F) {
    volatile LAS unsigned* misc = (volatile LAS unsigned*)(F.lds + MISC_OFF);
    for (;;) {
        __syncthreads();
        if (F.tid == 0) misc[0] = __hip_atomic_fetch_add(F.ctl, 1u, __ATOMIC_RELAXED, __HIP_MEMORY_SCOPE_AGENT);
        __syncthreads();
        const int u = (int)misc[0];
        if (u >= N_MIX) break;
        { int l_ = lane_id(); asm volatile("" : "+v"(l_)); F.lane = l_; F.tid = F.wave * 64 + l_; }
#ifndef MIXSEL
#define MIXSEL 3
#endif
        if (u < N_RET) { if (MIXSEL & 1) for (int rp_ = 0; rp_ < ((MIXREP & 1) ? 2 : 1); ++rp_) ret_unit(F, u >> 3, u & 7, F.lds); }
        else { const int a = u - N_RET; if (MIXSEL & 2) attn_unit(F, a & 31, 31 - (a >> 5), F.lds); }
    }
}

typedef __attribute__((address_space(1))) unsigned gu32;
#define XB_TMO      128
#define XB_XCNT(j)  (256  + 64 * (j))
#define XB_XSUB(j)  (1280 + 64 * (j))
#define XB_XGEN(j)  (2304 + 64 * (j))
#define XB_TOP      3328
#define XB_TOPGEN   3392
#define XCD_BAR_WORDS 3456
#define XB_SPIN_CAP (1u << 18)

__device__ __forceinline__ unsigned xb_ld(unsigned* p)              { return __hip_atomic_load(p, __ATOMIC_RELAXED, __HIP_MEMORY_SCOPE_AGENT); }
__device__ __forceinline__ unsigned xb_add(unsigned* p, unsigned v) { return __hip_atomic_fetch_add(p, v, __ATOMIC_RELAXED, __HIP_MEMORY_SCOPE_AGENT); }
__device__ __forceinline__ unsigned xb_xcc_id() { return (unsigned)__builtin_amdgcn_s_getreg((3 << 11) | 20) & 0xFu; }
#define XB_SPIN(cond, bar) do { unsigned _sp = 0; while (cond) { __builtin_amdgcn_s_sleep(1); \
    if ((++_sp & 255u) == 0u) { if (xb_ld(&(bar)[XB_TMO])) break; if (_sp > XB_SPIN_CAP) { atomicAdd(&(bar)[XB_TMO], 1u); break; } } } } while (0)

struct XcdBarrier {
    unsigned* bar; unsigned x; int wv;
    volatile LAS unsigned* st;
};

__device__ __forceinline__ XcdBarrier xcd_barrier_post(unsigned* bar, volatile LAS unsigned* st, int wv_) {
    XcdBarrier b; b.bar = bar; b.x = xb_xcc_id(); b.st = st; b.wv = 0;
    if (wv_ == 0 && lane_id() == 0) (void)xb_add(&bar[XB_XCNT(b.x)], 1u);
    return b;
}
__device__ __forceinline__ void xcd_barrier_complete(unsigned* bar, unsigned x, unsigned& nloc, unsigned& nx) {
    const unsigned G = gridDim.x * gridDim.y * gridDim.z;
    unsigned sum, cnt, mine, sp = 0u;
    for (;;) {
        sum = 0u; cnt = 0u; mine = 0u;
#pragma unroll
        for (unsigned j = 0; j < 16; ++j) { const unsigned c = xb_ld(&bar[XB_XCNT(j)]); sum += c; cnt += (c > 0u) ? 1u : 0u; mine = (j == x) ? c : mine; }
        if (sum == G) break;
        __builtin_amdgcn_s_sleep(1);
        if ((++sp & 255u) == 0u) { if (xb_ld(&bar[XB_TMO])) break; if (sp > XB_SPIN_CAP) { atomicAdd(&bar[XB_TMO], 1u); break; } }
    }
    nloc = mine > 0u ? mine : 1u; nx = cnt > 0u ? cnt : 1u;
}

__device__ __forceinline__ void xcd_barrier(const XcdBarrier& b) {
    asm volatile("s_waitcnt vmcnt(0)" ::: "memory");
    __syncthreads();
    if (b.wv == 0 && lane_id() == 0) {
        unsigned* bar = b.bar;
        __builtin_amdgcn_s_waitcnt(0);
        unsigned nloc = b.st[0], nx = b.st[1];
        if (nloc == 0u) { xcd_barrier_complete(bar, b.x, nloc, nx); b.st[0] = nloc; b.st[1] = nx; }
        const unsigned old = xb_add(&bar[XB_XSUB(b.x)], 1u);
        const unsigned gen = old / nloc;
        if (old + 1u == (gen + 1u) * nloc) {
            __builtin_amdgcn_fence(__ATOMIC_RELEASE, "agent");
            asm volatile("s_waitcnt vmcnt(0)" ::: "memory");
            const unsigned og = xb_add(&bar[XB_TOP], 1u);
            const unsigned tg = og / nx;
            if (og + 1u == (tg + 1u) * nx) xb_add(&bar[XB_TOPGEN], 1u);
            else XB_SPIN(xb_ld(&bar[XB_TOPGEN]) == tg, bar);
            __builtin_amdgcn_fence(__ATOMIC_ACQUIRE, "agent");
            xb_add(&bar[XB_XGEN(b.x)], 1u);
            asm volatile("s_waitcnt vmcnt(0)" ::: "memory");
        } else {
            XB_SPIN(xb_ld(&bar[XB_XGEN(b.x)]) == gen, bar);
            __builtin_amdgcn_fence(__ATOMIC_ACQUIRE, "agent");
            asm volatile("s_waitcnt vmcnt(0)" ::: "memory");
        }
    }
    __syncthreads();
}

constexpr int CW_BAR = 4096;
constexpr size_t CTL_ZERO_BYTES = 65536;
struct Args { const float* in[16]; float* out; unsigned char* ws; int ph_lo, ph_hi; };
__global__ void __launch_bounds__(NTHR, 2) fwd_kernel(Args args) {
    extern __shared__ __attribute__((aligned(16))) unsigned char lds[];
    Frame F;
    F.lds = (LAS unsigned char*)lds;
    F.wave = __builtin_amdgcn_readfirstlane((int)threadIdx.x >> 6); F.lane = lane_id(); F.tid = F.wave * 64 + F.lane;
    F.G = gridDim.x; { const int bx = blockIdx.x; F.vcu = (F.G % 8 == 0) ? (bx % 8) * (F.G / 8) + bx / 8 : bx; }
    unsigned char* ws = args.ws;
    F.ctl = (unsigned*)(ws + WS_CTL);
    F.x = args.in[0]; F.norm1_w = args.in[1]; F.w_in = args.in[2]; F.q_norm_w = args.in[3]; F.k_norm_w = args.in[4]; F.kv_norm_w = args.in[5]; F.w_uk = args.in[6]; F.w_uv = args.in[7];
    F.rel_bias = args.in[8]; F.ret_gn_w = args.in[9]; F.ret_gn_b = args.in[10]; F.w_out = args.in[11]; F.norm2_w = args.in[12]; F.w_gate = args.in[13]; F.w_up = args.in[14]; F.w_down = args.in[15];
    F.out = args.out;
    F.ws = ws;
    const int lo = args.ph_lo, hi = args.ph_hi;
    for (int u_ = F.tid; u_ < 64; u_ += NTHR) ((LAS unsigned*)(F.lds + MISC_OFF))[u_] = 0u;
    __syncthreads();
    XcdBarrier bar; bar.bar = F.ctl + CW_BAR; bar.x = 0; bar.st = nullptr; bar.wv = F.wave;
    if (hi - lo > 1) { bar = xcd_barrier_post(F.ctl + CW_BAR, (volatile LAS unsigned*)(F.lds + MISC_OFF) + 8, F.wave); bar.wv = F.wave; }
#ifndef PHSEL
#define PHSEL 63
#endif
#define IN(k) (((PHSEL >> (k)) & 1) && lo <= (k) && (k) < hi)
#ifndef REPEAT_PHASE
#define REPEAT_PHASE -1
#endif
#define REPS(k) ((REPEAT_PHASE == (k)) ? 2 : 1)
#define SEAM(k) do { if (IN(k) && IN((k) + 1)) { if (lo < 0) cg::this_grid().sync(); else xcd_barrier(bar); } } while (0)

    for (int rep_ = 0; rep_ < REPS(0); ++rep_) { if (rep_) cg::this_grid().sync();
    if (IN(0)) { asm volatile("" : "+s"(F.ws)); F.lane = lane_id(); F.tid = F.wave * 64 + F.lane; p0_prologue(F); }
    }
    SEAM(0);
    for (int rep_ = 0; rep_ < REPS(1); ++rep_) { if (rep_) cg::this_grid().sync();
    if (IN(1)) { asm volatile("" : "+s"(F.ws)); F.lane = lane_id(); F.tid = F.wave * 64 + F.lane;
        pg8::Gemm g{F.XB(), F.WIN(), MTOK, NIN, DM}; pg8::StaticOrder S; S.init(MTOK, NIN, F.G, (int)blockIdx.x);
        pg8::EpiIn E{F.QA(), F.KA(), F.VA(), F.IQ(), F.IK(), F.QB(), F.KB(), F.VB(), F.GB(), F.IW(), F.q_norm_w, F.k_norm_w, F.COS(), F.SIN(), (LAS float*)(F.lds + XCH_OFF)};
        pg8::gemm_phase<pg8::EpiIn, pg8::StaticOrder, true, true>(F.lds, g, S, E, F.wave);
    }
    }
    SEAM(1);
    for (int rep_ = 0; rep_ < REPS(2); ++rep_) { if (rep_) { cg::this_grid().sync(); if (blockIdx.x == 0 && F.tid == 0) F.ctl[0] = 0u; cg::this_grid().sync(); }
    if (IN(2)) { asm volatile("" : "+s"(F.ws)); F.lane = lane_id(); F.tid = F.wave * 64 + F.lane; p2_mixers(F); }
    }
    SEAM(2);
    for (int rep_ = 0; rep_ < REPS(3); ++rep_) { if (rep_) cg::this_grid().sync();
    if (IN(3)) { asm volatile("" : "+s"(F.ws)); F.lane = lane_id(); F.tid = F.wave * 64 + F.lane;
        pg8::Gemm g{F.MIX(), F.WOUT(), MTOK, DM, DM}; pg8::PanelOrder S{(int)blockIdx.x, 4};
        pg8::EpiOut E{F.x, F.XB(), {0.f, 0.f, 0.f, 0.f, 0.f, 0.f, 0.f, 0.f}};
        if ((int)blockIdx.x < MTOK / 256) {
            pg8::gemm_phase<pg8::EpiOut, pg8::PanelOrder, true, true>(F.lds, g, S, E, F.wave);
            const int wr = F.wave >> 2, wc = F.wave & 3, fr = F.lane & 15, fq = F.lane >> 4;
            LAS float* P = (LAS float*)(F.lds + XCH_OFF);
#pragma unroll
            for (int k = 0; k < 8; ++k) { float s = E.ss[k]; s += __shfl_xor(s, 16); s += __shfl_xor(s, 32);
                if (fq == 0) P[((k >> 2) * 128 + wr * 64 + (k & 3) * 16 + fr) * 4 + wc] = s; }
            __syncthreads();
            if (F.tid < 256) { const f32x4 p = *(const LAS f32x4*)(P + F.tid * 4);
                F.R2()[(size_t)blockIdx.x * 256 + F.tid] = 1.0f / sqrtf(((p[0] + p[1]) + (p[2] + p[3])) * (1.0f / DM) + 1e-6f); }
        }
    }
    }
    SEAM(3);
    for (int rep_ = 0; rep_ < REPS(4); ++rep_) { if (rep_) cg::this_grid().sync();
    if (IN(4)) { asm volatile("" : "+s"(F.ws)); F.lane = lane_id(); F.tid = F.wave * 64 + F.lane;
        pg8::Gemm g{F.XB(), F.WGU(), MTOK, NGU, DM}; pg8::StaticOrder S; S.init(MTOK, NGU, F.G, (int)blockIdx.x);
        pg8::EpiGU E{F.R2(), F.ACT()};
        pg8::gemm_phase<pg8::EpiGU, pg8::StaticOrder, true, true>(F.lds, g, S, E, F.wave);
    }
    }
    SEAM(4);
    if (IN(5)) { asm volatile("" : "+s"(F.ws)); F.lane = lane_id(); F.tid = F.wave * 64 + F.lane;
        pg8::Gemm g{F.ACT(), F.WDN(), MTOK, DM, FF}; pg8::StaticOrder S; S.init(MTOK, DM, F.G, (int)blockIdx.x);
        pg8::EpiDown E{F.XB(), F.out};
        pg8::gemm_phase<pg8::EpiDown, pg8::StaticOrder, true, true>(F.lds, g, S, E, F.wave);
    }
#undef IN
#undef SEAM
}

extern "C" void kernel_launch(void* const* d_in, const int* in_sizes, int n_in, void* d_out, int out_size, void* d_ws, size_t ws_size, hipStream_t stream) {
    static int grid = 0;
    if (grid == 0) {
        if (n_in != 16 || in_sizes[0] != MTOK * DM || out_size != MTOK * DM || ws_size < WS_END) {
            fprintf(stderr, "kernel_launch: unexpected problem (n_in %d, in0 %d, out %d, ws %zu); nothing launched\n", n_in, n_in > 0 ? in_sizes[0] : -1, out_size, ws_size); grid = -1; return; }
        int dev = 0, cus = 0, per_cu = 0;
        if (hipGetDevice(&dev) != hipSuccess || hipDeviceGetAttribute(&cus, hipDeviceAttributeMultiprocessorCount, dev) != hipSuccess) { grid = -1; return; }
        if (hipFuncSetAttribute((const void*)fwd_kernel, hipFuncAttributeMaxDynamicSharedMemorySize, LDS_BYTES) != hipSuccess) { fprintf(stderr, "kernel_launch: hipFuncSetAttribute failed\n"); grid = -1; return; }
        if (hipOccupancyMaxActiveBlocksPerMultiprocessor(&per_cu, (const void*)fwd_kernel, NTHR, LDS_BYTES) != hipSuccess || per_cu < 1) { fprintf(stderr, "kernel_launch: occupancy query says %d blocks per CU\n", per_cu); (void)hipGetLastError(); grid = -1; return; }
        grid = cus;
        if (grid != 256) fprintf(stderr, "kernel_launch: %d CUs; this kernel is laid out for 256\n", grid);
    }
    if (grid < 0) return;
    if (hipMemsetAsync((char*)d_ws + WS_CTL, 0, CTL_ZERO_BYTES, stream) != hipSuccess) { fprintf(stderr, "kernel_launch: memset failed\n"); return; }
    Args a{};
    for (int i = 0; i < 16; ++i) a.in[i] = (const float*)d_in[i];
    a.out = (float*)d_out; a.ws = (unsigned char*)d_ws;
#if MK_N_LAUNCHES == 1
    a.ph_lo = 0; a.ph_hi = N_PHASES;
    void* kargs[] = {&a};
    hipError_t e = hipLaunchCooperativeKernel((const void*)fwd_kernel, dim3(grid), dim3(NTHR), kargs, LDS_BYTES, stream);
    if (e != hipSuccess) fprintf(stderr, "kernel_launch: cooperative launch failed: %s (grid %d)\n", hipGetErrorString(e), grid);
#else
    for (int p = 0; p < N_PHASES; ++p) { a.ph_lo = p; a.ph_hi = p + 1; hipLaunchKernelGGL(fwd_kernel, dim3(grid), dim3(NTHR), LDS_BYTES, stream, a); }
#endif
}
```

```cpp
#include <hip/hip_runtime.h>
#include <hip/hip_cooperative_groups.h>
#include <cstdio>
#include <cstdint>
namespace cg = cooperative_groups;
namespace pg8 {
#define PG8_LAS __attribute__((address_space(3)))
typedef unsigned short bf16_t;
typedef short bf16x8 __attribute__((ext_vector_type(8)));
typedef float f32x4 __attribute__((ext_vector_type(4)));
typedef unsigned u32x4 __attribute__((ext_vector_type(4)));
constexpr int BM = 256, BK = 64, HALF = 128, HTB = HALF * BK * 2  , STAGE_BYTES = 8 * HTB, NXCD = 8, WGM = 8;

__host__ __device__ __forceinline__ int lds_byte(int r, int c) { const int st = (r >> 4) * 2 + (c >> 5), rr = r & 15, cc = c & 31, ob = rr * 64 + cc * 2; return st * 1024 + (ob ^ (((ob >> 9) & 1) << 5)); }
__host__ __device__ __forceinline__ void stage_rc(int b, int& R, int& C) { const int st = b / 1024, sb = b % 1024, swz = sb ^ (((sb >> 9) & 1) << 5); R = (st >> 1) * 16 + swz / 64; C = (st & 1) * 32 + (swz % 64) / 2; }
__host__ __device__ __forceinline__ int perm32(int rho) { const int n = rho >> 4, i = rho & 15; return 8 * (i >> 2) + 4 * n + (i & 3); }

struct Unit { int pm, pn; };
struct Gemm { const bf16_t* A; const bf16_t* Bt; int M, N, K; };

struct StaticOrder {
    int nM, nN, nwg, G, c;
    __host__ __device__ void init(int M, int N, int G_, int c_) { nM = M / BM; nN = N / BM; nwg = nM * nN; G = G_; c = c_; }
    __host__ __device__ bool next(int i, Unit& u) const {
        const long L = (long)i * G + c; if (L >= nwg) return false;
        int wgid = (int)L; { const int q = nwg / NXCD, r = nwg % NXCD, xcd = wgid % NXCD, off = wgid / NXCD; wgid = (xcd < r ? xcd * (q + 1) : r * (q + 1) + (xcd - r) * q) + off; }
        const int nig = WGM * nN, gid = wgid / nig, fm = gid * WGM, gsz = (nM - fm) < WGM ? (nM - fm) : WGM;
        u.pm = fm + ((wgid % nig) % gsz); u.pn = (wgid % nig) / gsz; return true;
    }
    __device__ __forceinline__ void a_ready(const Unit&) const {}
    __device__ __forceinline__ void done(const Unit&) const {}
};

__device__ __forceinline__ unsigned cvt_pk_bf16(float lo, float hi) { unsigned r; asm volatile("v_cvt_pk_bf16_f32 %0, %1, %2" : "=v"(r) : "v"(lo), "v"(hi)); return r; }
typedef float f32x2 __attribute__((ext_vector_type(2)));
typedef __bf16 bf16x2_t __attribute__((ext_vector_type(2)));
typedef unsigned u32x2 __attribute__((ext_vector_type(2)));
__device__ __forceinline__ unsigned pkbf(float lo, float hi) { f32x2 v = {lo, hi}; bf16x2_t b = __builtin_convertvector(v, bf16x2_t); return __builtin_bit_cast(unsigned, b); }
__device__ __forceinline__ u32x4 pk8(f32x4 a, f32x4 b) { return (u32x4){pkbf(a[0], a[1]), pkbf(a[2], a[3]), pkbf(b[0], b[1]), pkbf(b[2], b[3])}; }
__device__ __forceinline__ float dot4(f32x4 a) { return (a[0] * a[0] + a[1] * a[1]) + (a[2] * a[2] + a[3] * a[3]); }
__device__ __forceinline__ float sum4(f32x4 a) { return (a[0] + a[1]) + (a[2] + a[3]); }
__device__ __forceinline__ float silu1(float v) { return v * __builtin_amdgcn_rcpf(1.0f + __builtin_amdgcn_exp2f(-1.4426950408889634f * v)); }
__device__ __forceinline__ f32x4 silu4(f32x4 v) { return (f32x4){silu1(v[0]), silu1(v[1]), silu1(v[2]), silu1(v[3])}; }
constexpr float RMS_EPS_F = 1e-6f;
constexpr float QSCALE = 0.125f * 1.4426950408889634f;

struct EpiIn {
    static constexpr bool PERM = true, AFTER_DRAIN = false;
    bf16_t *QA, *KA, *VA, *IQ, *IK, *QB, *KB, *VB, *GB; float* IW;
    const float *qnw, *knw, *cosT, *sinT;
    PG8_LAS float* xch;
    __device__ __forceinline__ void prefetch(const Unit&, int, int) {}
    __device__ __forceinline__ void advance() {}
    __device__ __forceinline__ void operator()(const f32x4 (&acc)[2][2][4][2], const Unit& u, int wr, int wc, int fr, int fq) {
        asm volatile("" : "+v"(fr), "+v"(fq));
        const int row0 = u.pm * BM + wr * 64 + fr, pn = u.pn;
        if (pn < 2) {
            const int head = 4 * pn + wc;
            const f32x4 w0 = *(const f32x4*)(qnw + 8 * fq), w1 = *(const f32x4*)(qnw + 8 * fq + 4), w2 = *(const f32x4*)(qnw + 32 + 8 * fq), w3 = *(const f32x4*)(qnw + 36 + 8 * fq);
#pragma unroll
            for (int ai = 0; ai < 2; ++ai)
#pragma unroll
                for (int m = 0; m < 4; ++m) {
                    f32x4 a0 = acc[ai][0][m][0], a1 = acc[ai][0][m][1], b0 = acc[ai][1][m][0], b1 = acc[ai][1][m][1];
                    float ss = (dot4(a0) + dot4(a1)) + (dot4(b0) + dot4(b1));
                    ss += __shfl_xor(ss, 16); ss += __shfl_xor(ss, 32);
                    const float rs = QSCALE / sqrtf(ss * (1.0f / 64.0f) + RMS_EPS_F);
                    bf16_t* p = QA + (size_t)(row0 + ai * HALF + m * 16) * 512 + head * 64 + 8 * fq;
                    *(u32x4*)p = pk8(a0 * w0 * rs, a1 * w1 * rs); *(u32x4*)(p + 32) = pk8(b0 * w2 * rs, b1 * w3 * rs);
                }
        } else if (pn == 2) {
            if (wc >= 2) {
#pragma unroll
                for (int ai = 0; ai < 2; ++ai)
#pragma unroll
                    for (int m = 0; m < 4; ++m) {
                        float ss = (dot4(acc[ai][0][m][0]) + dot4(acc[ai][0][m][1])) + (dot4(acc[ai][1][m][0]) + dot4(acc[ai][1][m][1]));
                        ss += __shfl_xor(ss, 16); ss += __shfl_xor(ss, 32);
                        if (fq == 0) xch[(ai * HALF + wr * 64 + m * 16 + fr) * 2 + (wc - 2)] = ss;
                    }
            }
            asm volatile("s_waitcnt lgkmcnt(0)" ::: "memory"); __builtin_amdgcn_s_barrier(); asm volatile("" ::: "memory");
            if (wc < 2) {
                const f32x4 w0 = *(const f32x4*)(knw + 8 * fq), w1 = *(const f32x4*)(knw + 8 * fq + 4), w2 = *(const f32x4*)(knw + 32 + 8 * fq), w3 = *(const f32x4*)(knw + 36 + 8 * fq);
#pragma unroll
                for (int ai = 0; ai < 2; ++ai)
#pragma unroll
                    for (int m = 0; m < 4; ++m) {
                        const int rl = ai * HALF + wr * 64 + m * 16 + fr;
                        const f32x2 pr = *(const PG8_LAS f32x2*)(xch + rl * 2);
                        const float rc = 1.0f / sqrtf((pr[0] + pr[1]) * (1.0f / 128.0f) + RMS_EPS_F);
                        f32x4 a0 = acc[ai][0][m][0] * rc, a1 = acc[ai][0][m][1] * rc, b0 = acc[ai][1][m][0] * rc, b1 = acc[ai][1][m][1] * rc;
                        const size_t row = (size_t)(row0 + ai * HALF + m * 16);
                        if (wc == 0) {
                            float ss = (dot4(a0) + dot4(a1)) + (dot4(b0) + dot4(b1));
                            ss += __shfl_xor(ss, 16); ss += __shfl_xor(ss, 32);
                            const float rs = 1.0f / sqrtf(ss * (1.0f / 64.0f) + RMS_EPS_F);
                            bf16_t* p = KA + row * 64 + 8 * fq;
                            *(u32x4*)p = pk8(a0 * w0 * rs, a1 * w1 * rs); *(u32x4*)(p + 32) = pk8(b0 * w2 * rs, b1 * w3 * rs);
                        } else {
                            bf16_t* p = VA + row * 64 + 8 * fq;
                            *(u32x4*)p = pk8(a0, a1); *(u32x4*)(p + 32) = pk8(b0, b1);
                        }
                    }
            }
        } else if (pn == 3) {
#pragma unroll
            for (int ai = 0; ai < 2; ++ai)
#pragma unroll
                for (int m = 0; m < 4; ++m) {
                    const size_t row = (size_t)(row0 + ai * HALF + m * 16);
                    *(u32x4*)(IQ + row * 128 + 32 * wc + 8 * fq) = pk8(acc[ai][0][m][0], acc[ai][0][m][1]);
                    if (wc == 0) *(u32x4*)(IK + row * 32 + 8 * fq) = pk8(acc[ai][1][m][0], acc[ai][1][m][1]);
                    if (wc == 1 && fq == 0) *(f32x4*)(IW + row * 4) = acc[ai][1][m][0];
                }
        } else if (pn < 8) {
            const int head = 4 * (pn & 1) + wc; bf16_t* dst = pn < 6 ? QB : KB;
            const float lg2 = __log2f(1.0f - __builtin_amdgcn_exp2f(-5.0f - (float)head));
            f32x4 iv0, iv1;
#pragma unroll
            for (int i = 0; i < 4; ++i) { iv0[i] = __builtin_amdgcn_exp2f(-(float)(8 * fq + i) * (13.287712379549449f / 32.0f)) * 0.15915494309189535f; iv1[i] = __builtin_amdgcn_exp2f(-(float)(8 * fq + 4 + i) * (13.287712379549449f / 32.0f)) * 0.15915494309189535f; }
#pragma unroll
            for (int ai = 0; ai < 2; ++ai)
#pragma unroll
                for (int m = 0; m < 4; ++m) {
                    const int row = row0 + ai * HALF + m * 16, pos = row & 2047; const float fp = (float)pos;
                    const float sc = pn < 6 ? __builtin_amdgcn_exp2f((float)(pos & 63) * lg2) : 0.125f * __builtin_amdgcn_exp2f(-(float)(pos & 63) * lg2);
                    f32x4 c0, c1, s0, s1;
#pragma unroll
                    for (int i = 0; i < 4; ++i) {
                        const float r0 = __builtin_amdgcn_fractf(fp * iv0[i]), r1 = __builtin_amdgcn_fractf(fp * iv1[i]);
                        c0[i] = __builtin_amdgcn_cosf(r0) * sc; s0[i] = __builtin_amdgcn_sinf(r0) * sc; c1[i] = __builtin_amdgcn_cosf(r1) * sc; s1[i] = __builtin_amdgcn_sinf(r1) * sc;
                    }
                    const f32x4 a0 = acc[ai][0][m][0], a1 = acc[ai][0][m][1], b0 = acc[ai][1][m][0], b1 = acc[ai][1][m][1];
                    bf16_t* p = dst + (size_t)row * 512 + head * 64 + 8 * fq;
                    *(u32x4*)p = pk8(a0 * c0 - b0 * s0, a1 * c1 - b1 * s1); *(u32x4*)(p + 32) = pk8(a0 * s0 + b0 * c0, a1 * s1 + b1 * c1);
                }
        } else {
            const int head = 4 * (pn & 1) + wc; bf16_t* dst = pn < 10 ? VB : GB; const bool act = pn >= 10;
#pragma unroll
            for (int ai = 0; ai < 2; ++ai)
#pragma unroll
                for (int m = 0; m < 4; ++m) {
                    f32x4 a0 = acc[ai][0][m][0], a1 = acc[ai][0][m][1], b0 = acc[ai][1][m][0], b1 = acc[ai][1][m][1];
                    if (act) { a0 = silu4(a0); a1 = silu4(a1); b0 = silu4(b0); b1 = silu4(b1); }
                    bf16_t* p = dst + (size_t)(row0 + ai * HALF + m * 16) * 512 + head * 64 + 8 * fq;
                    *(u32x4*)p = pk8(a0, a1); *(u32x4*)(p + 32) = pk8(b0, b1);
                }
        }
    }
};

struct EpiOut {
    static constexpr bool PERM = true, AFTER_DRAIN = false;
    const float* x; bf16_t* x1b; float ss[8];
    __device__ __forceinline__ void prefetch(const Unit&, int, int) {}
    __device__ __forceinline__ void advance() {}
    __device__ __forceinline__ void operator()(const f32x4 (&acc)[2][2][4][2], const Unit& u, int wr, int wc, int fr, int fq) {
        asm volatile("" : "+v"(fr), "+v"(fq));
        const int row0 = u.pm * BM + wr * 64 + fr, col0 = u.pn * BM + wc * 32 + 8 * fq;
#pragma unroll
        for (int ai = 0; ai < 2; ++ai)
#pragma unroll
            for (int m = 0; m < 4; ++m) {
                const size_t off = (size_t)(row0 + ai * HALF + m * 16) * 1024 + col0; float s = 0.f;
#pragma unroll
                for (int bj = 0; bj < 2; ++bj) {
                    const f32x4 r0 = *(const f32x4*)(x + off + bj * HALF) + acc[ai][bj][m][0], r1 = *(const f32x4*)(x + off + bj * HALF + 4) + acc[ai][bj][m][1];
                    *(u32x4*)(x1b + off + bj * HALF) = pk8(r0, r1);
                    s += dot4(r0) + dot4(r1);
                }
                ss[ai * 4 + m] += s;
            }
    }
};

struct EpiGU {
    static constexpr bool PERM = true, AFTER_DRAIN = false;
    const float* r2; bf16_t* act; f32x4 rc0, rc1, rn0, rn1;
    __device__ __forceinline__ void prefetch(const Unit& u, int wr, int fr) {
        const float* p = r2 + u.pm * BM + wr * 64 + fr;
        rn0 = (f32x4){p[0], p[16], p[32], p[48]}; rn1 = (f32x4){p[HALF], p[HALF + 16], p[HALF + 32], p[HALF + 48]};
    }
    __device__ __forceinline__ void advance() { rc0 = rn0; rc1 = rn1; }
    __device__ __forceinline__ void operator()(const f32x4 (&acc)[2][2][4][2], const Unit& u, int wr, int wc, int fr, int fq) {
        asm volatile("" : "+v"(fr), "+v"(fq));
        const int row0 = u.pm * BM + wr * 64 + fr, col0 = u.pn * HALF + wc * 32 + 8 * fq;
#pragma unroll
        for (int ai = 0; ai < 2; ++ai)
#pragma unroll
            for (int m = 0; m < 4; ++m) {
                const int row = row0 + ai * HALF + m * 16; const float rr = ai ? rc1[m] : rc0[m];
                const f32x4 g0 = acc[ai][0][m][0] * rr, g1 = acc[ai][0][m][1] * rr, u0 = acc[ai][1][m][0] * rr, u1 = acc[ai][1][m][1] * rr;
                *(u32x4*)(act + (size_t)row * 2816 + col0) = pk8(silu4(g0) * u0, silu4(g1) * u1);
            }
    }
};

struct EpiDown {
    static constexpr bool PERM = true, AFTER_DRAIN = false;
    const bf16_t* x1b; float* out;
    __device__ __forceinline__ void prefetch(const Unit&, int, int) {}
    __device__ __forceinline__ void advance() {}
    __device__ __forceinline__ void operator()(const f32x4 (&acc)[2][2][4][2], const Unit& u, int wr, int wc, int fr, int fq) {
        asm volatile("" : "+v"(fr), "+v"(fq));
        const int row0 = u.pm * BM + wr * 64 + fr, col0 = u.pn * BM + wc * 32 + 8 * fq;
#pragma unroll
        for (int ai = 0; ai < 2; ++ai)
#pragma unroll
            for (int m = 0; m < 4; ++m) {
                const size_t off = (size_t)(row0 + ai * HALF + m * 16) * 1024 + col0;
#pragma unroll
                for (int bj = 0; bj < 2; ++bj) {
                    const u32x4 xv = *(const u32x4*)(x1b + off + bj * HALF);
                    const f32x4 x0 = {__uint_as_float(xv[0] << 16), __uint_as_float(xv[0] & 0xffff0000u), __uint_as_float(xv[1] << 16), __uint_as_float(xv[1] & 0xffff0000u)};
                    const f32x4 x1 = {__uint_as_float(xv[2] << 16), __uint_as_float(xv[2] & 0xffff0000u), __uint_as_float(xv[3] << 16), __uint_as_float(xv[3] & 0xffff0000u)};
                    *(f32x4*)(out + off + bj * HALF) = x0 + acc[ai][bj][m][0]; *(f32x4*)(out + off + bj * HALF + 4) = x1 + acc[ai][bj][m][1];
                }
            }
    }
};

struct PanelOrder {
    int pm, ntn;
    __device__ __forceinline__ bool next(int i, Unit& u) const { if (i >= ntn) return false; u.pm = pm; u.pn = i; return true; }
    __device__ __forceinline__ void a_ready(const Unit&) const {}
    __device__ __forceinline__ void done(const Unit&) const {}
};

template <class Epi, class Sched, bool ALIGN_EPI = false, bool SP2 = false>
__device__ __forceinline__ void gemm_phase(PG8_LAS unsigned char* lds, const Gemm g, const Sched& S, Epi& E, int wave_in) {
    unsigned ones_ = ~0u; asm volatile("" : "+s"(ones_)); int tid_ = wave_in * 64 + (int)__builtin_amdgcn_mbcnt_hi(ones_, __builtin_amdgcn_mbcnt_lo(ones_, 0u));
    const int tid = tid_, wid = __builtin_amdgcn_readfirstlane(tid >> 6), lane = tid & 63, wr = wid >> 2, wc = wid & 3, fr = lane & 15, fq = lane >> 4;
    const int K = g.K, nt = K / BK;
    unsigned voffA[2], voffB[2];
#pragma unroll
    for (int i = 0; i < 2; ++i) { int R, C; stage_rc(tid * 16 + i * 8192, R, C); const int Rb = Epi::PERM ? ((R & ~31) + perm32(R & 31)) : R;
        voffA[i] = (unsigned)(R * K + C) * 2u; voffB[i] = (unsigned)(Rb * K + C) * 2u; }
    const size_t kstep = (size_t)(BK * 2);
    const size_t hstep = (size_t)HALF * K * 2;
    const size_t tstep = 2 * hstep;
    const unsigned ldsw = (unsigned)wid * 1024u;
    const int aoff = lds_byte(wr * 64 + fr, fq * 8), boff = lds_byte(wc * 32 + fr, fq * 8);
#define PG8_SA(b, h) (((b) * 2 + (h)) * HTB)
#define PG8_SB(b, h) ((4 + (b) * 2 + (h)) * HTB)
#define PG8_STAGE(bufoff, gbase, voff) do { _Pragma("unroll") for (int _i = 0; _i < 2; ++_i) \
        __builtin_amdgcn_global_load_lds((const unsigned*)((const char*)(gbase) + (voff)[_i]), (PG8_LAS unsigned*)(lds + (bufoff) + ldsw + _i * 8192), 16, 0, 0); } while (0)
#define PG8_LDA(dst, b, h) do { _Pragma("unroll") for (int m = 0; m < 4; ++m) _Pragma("unroll") for (int k = 0; k < 2; ++k) dst[m][k] = *(const PG8_LAS bf16x8*)(lds + PG8_SA(b, h) + aoff + m * 2048 + k * 1024); } while (0)
#define PG8_LDB(dst, b, h) do { _Pragma("unroll") for (int n = 0; n < 2; ++n) _Pragma("unroll") for (int k = 0; k < 2; ++k) dst[n][k] = *(const PG8_LAS bf16x8*)(lds + PG8_SB(b, h) + boff + n * 2048 + k * 1024); } while (0)
#define PG8_MMA(ai, bj, At, Bt) do { __builtin_amdgcn_s_setprio(1); _Pragma("unroll") for (int m = 0; m < 4; ++m) _Pragma("unroll") for (int n = 0; n < 2; ++n) _Pragma("unroll") for (int k = 0; k < 2; ++k) \
        acc[ai][bj][m][n] = __builtin_amdgcn_mfma_f32_16x16x32_bf16(Bt[n][k], At[m][k], acc[ai][bj][m][n], 0, 0, 0); __builtin_amdgcn_s_setprio(0); } while (0)
#define PG8_WAIT_V(n) asm volatile("s_waitcnt vmcnt(" #n ")" ::: "memory")
#define PG8_WAIT_L(n) asm volatile("s_waitcnt lgkmcnt(" #n ")" ::: "memory")
#define PG8_BAR __builtin_amdgcn_s_barrier()
#define PG8_SCHED __builtin_amdgcn_sched_barrier(0)
    Unit cur, nxt; int ui = 0;
    if (!S.next(0, cur)) return;
    E.prefetch(cur, wr, fr); E.advance();
    f32x4 acc[2][2][4][2];
#pragma unroll
    for (int a = 0; a < 2; ++a)
#pragma unroll
        for (int b = 0; b < 2; ++b)
#pragma unroll
            for (int m = 0; m < 4; ++m)
#pragma unroll
                for (int n = 0; n < 2; ++n) acc[a][b][m][n] = (f32x4){0.f, 0.f, 0.f, 0.f};
    bf16x8 At[4][2], B0[2][2], B1[2][2];
    const char* cA = (const char*)g.A + (size_t)cur.pm * tstep; const char* cB = (const char*)g.Bt + (size_t)cur.pn * tstep;
    S.a_ready(cur);
    if constexpr (SP2) {
        PG8_STAGE(PG8_SB(0, 0), cB, voffB); PG8_STAGE(PG8_SB(0, 1), cB + hstep, voffB); PG8_STAGE(PG8_SA(0, 0), cA, voffA); PG8_STAGE(PG8_SA(0, 1), cA + hstep, voffA);
        if (wr == 1) PG8_BAR;
        PG8_WAIT_V(2); PG8_BAR;
        PG8_STAGE(PG8_SB(1, 0), cB + kstep, voffB); PG8_STAGE(PG8_SA(1, 0), cA + kstep, voffA); PG8_STAGE(PG8_SB(1, 1), cB + hstep + kstep, voffB);
        PG8_WAIT_V(6); PG8_BAR;
    } else {
        PG8_STAGE(PG8_SB(0, 0), cB, voffB); PG8_STAGE(PG8_SA(0, 0), cA, voffA); PG8_STAGE(PG8_SB(0, 1), cB + hstep, voffB); PG8_STAGE(PG8_SA(0, 1), cA + hstep, voffA);
        if (wr == 1) PG8_BAR;
        PG8_WAIT_V(4); PG8_BAR;
        PG8_STAGE(PG8_SB(1, 0), cB + kstep, voffB); PG8_STAGE(PG8_SA(1, 0), cA + kstep, voffA); PG8_STAGE(PG8_SB(1, 1), cB + hstep + kstep, voffB);
        PG8_WAIT_V(6); PG8_BAR;
    }
    for (;;) {
        const bool has_next = S.next(ui + 1, nxt);
        const char* nA = has_next ? (const char*)g.A + (size_t)nxt.pm * tstep : cA; const char* nB = has_next ? (const char*)g.Bt + (size_t)nxt.pn * tstep : cB;
        for (int t = 0; t < nt; t += 2) {
            const bool last = (t == nt - 2);
            const char* a1 = cA + (size_t)(t + 1) * kstep;
            const char* a2 = last ? nA : cA + (size_t)(t + 2) * kstep; const char* b2 = last ? nB : cB + (size_t)(t + 2) * kstep;
            const char* a3 = a2 + kstep; const char* b3 = b2 + kstep;
            if (last && has_next) { S.a_ready(nxt); E.prefetch(nxt, wr, fr); }
            if constexpr (SP2) {
            PG8_LDB(B0, 0, 0); PG8_LDB(B1, 0, 1); PG8_SCHED; PG8_LDA(At, 0, 0); PG8_STAGE(PG8_SA(1, 1), a1 + hstep, voffA);
            PG8_WAIT_V(8); PG8_WAIT_L(0); PG8_BAR; PG8_MMA(0, 0, At, B0); PG8_MMA(0, 1, At, B1); PG8_BAR; PG8_SCHED;
            PG8_LDA(At, 0, 1); PG8_STAGE(PG8_SB(0, 0), b2, voffB); PG8_STAGE(PG8_SB(0, 1), b2 + hstep, voffB); PG8_STAGE(PG8_SA(0, 0), a2, voffA);
            PG8_WAIT_V(8); PG8_WAIT_L(0); PG8_BAR; PG8_MMA(1, 0, At, B0); PG8_MMA(1, 1, At, B1); PG8_BAR; PG8_SCHED;
            PG8_LDB(B0, 1, 0); PG8_LDB(B1, 1, 1); PG8_SCHED; PG8_LDA(At, 1, 0); PG8_STAGE(PG8_SA(0, 1), a2 + hstep, voffA);
            PG8_WAIT_V(8); PG8_WAIT_L(0); PG8_BAR; PG8_MMA(0, 0, At, B0); PG8_MMA(0, 1, At, B1); PG8_BAR; PG8_SCHED;
            PG8_LDA(At, 1, 1); PG8_STAGE(PG8_SB(1, 0), b3, voffB); PG8_STAGE(PG8_SB(1, 1), b3 + hstep, voffB); PG8_STAGE(PG8_SA(1, 0), a3, voffA);
            PG8_WAIT_V(8); PG8_WAIT_L(0); PG8_BAR; PG8_MMA(1, 0, At, B0); PG8_MMA(1, 1, At, B1); PG8_BAR; PG8_SCHED;
            } else {
            PG8_LDB(B0, 0, 0); PG8_SCHED; PG8_LDA(At, 0, 0); PG8_STAGE(PG8_SA(1, 1), a1 + hstep, voffA);
            PG8_WAIT_L(8); PG8_BAR; PG8_WAIT_L(0); PG8_MMA(0, 0, At, B0); PG8_BAR; PG8_SCHED;
            PG8_LDB(B1, 0, 1); PG8_STAGE(PG8_SB(0, 0), b2, voffB);
            PG8_BAR; PG8_WAIT_L(0); PG8_MMA(0, 1, At, B1); PG8_BAR;
            PG8_LDA(At, 0, 1); PG8_STAGE(PG8_SA(0, 0), a2, voffA);
            PG8_BAR; PG8_WAIT_L(0); PG8_MMA(1, 0, At, B0); PG8_BAR; PG8_SCHED;
            PG8_STAGE(PG8_SB(0, 1), b2 + hstep, voffB);
            PG8_WAIT_V(6); PG8_BAR; PG8_MMA(1, 1, At, B1); PG8_BAR;
            PG8_LDB(B0, 1, 0); PG8_SCHED; PG8_LDA(At, 1, 0); PG8_STAGE(PG8_SA(0, 1), a2 + hstep, voffA);
            PG8_WAIT_L(8); PG8_BAR; PG8_WAIT_L(0); PG8_MMA(0, 0, At, B0); PG8_BAR; PG8_SCHED;
            PG8_LDB(B1, 1, 1); PG8_STAGE(PG8_SB(1, 0), b3, voffB);
            PG8_BAR; PG8_WAIT_L(0); PG8_MMA(0, 1, At, B1); PG8_BAR;
            PG8_LDA(At, 1, 1); PG8_STAGE(PG8_SA(1, 0), a3, voffA);
            PG8_BAR; PG8_WAIT_L(0); PG8_MMA(1, 0, At, B0); PG8_BAR; PG8_SCHED;
            PG8_STAGE(PG8_SB(1, 1), b3 + hstep, voffB);
            PG8_WAIT_V(6); PG8_BAR; PG8_MMA(1, 1, At, B1); PG8_BAR;
            }
        }
        if constexpr (ALIGN_EPI) { if (wr == 0) PG8_BAR; }
        if constexpr (!Epi::AFTER_DRAIN) { E(acc, cur, wr, wc, fr, fq); E.advance(); S.done(cur); }
        if (!has_next) break;
#pragma unroll
        for (int a = 0; a < 2; ++a)
#pragma unroll
            for (int b = 0; b < 2; ++b)
#pragma unroll
                for (int m = 0; m < 4; ++m)
#pragma unroll
                    for (int n = 0; n < 2; ++n) acc[a][b][m][n] = (f32x4){0.f, 0.f, 0.f, 0.f};
        cur = nxt; cA = nA; cB = nB; ++ui;
        if constexpr (ALIGN_EPI) { if (wr == 1) PG8_BAR; }
    }
    PG8_WAIT_V(0);
    if constexpr (!ALIGN_EPI) { if (wr == 0) PG8_BAR; }
    PG8_BAR;
    (void)lane;
#undef PG8_SA
#undef PG8_SB
#undef PG8_STAGE
#undef PG8_LDA
#undef PG8_LDB
#undef PG8_MMA
#undef PG8_WAIT_V
#undef PG8_WAIT_L
#undef PG8_BAR
#undef PG8_SCHED
}
}

constexpr int BATCH = 32, SEQ = 2048, DM = 1024, MTOK = BATCH * SEQ;
constexpr int INW = 2852, NIN = 3072, FF = 2816, NGU = 2 * FF;
constexpr int NWAVES = 8, NTHR = 512;
#ifndef MK_N_LAUNCHES
#define MK_N_LAUNCHES 1
#endif
constexpr int N_PHASES = 6;
constexpr size_t MiB = 1u << 20;
constexpr size_t WS_CTL = 0;
constexpr size_t WS_COS = 1 * MiB, WS_SIN = WS_COS + 256 * 1024;
constexpr size_t WS_BT = WS_SIN + 256 * 1024;
constexpr size_t WS_R2 = 2 * MiB;
constexpr size_t WS_WIN = 4 * MiB, WS_WOUT = 10 * MiB, WS_WGU = 12 * MiB, WS_WDN = 23 * MiB;
constexpr size_t WS_XB = 32 * MiB;
constexpr size_t WS_MIX = 160 * MiB;
constexpr size_t WS_QA = 288 * MiB, WS_QB = 352 * MiB, WS_KB = 416 * MiB, WS_VB = 480 * MiB, WS_GB = 544 * MiB;
constexpr size_t WS_KA = 608 * MiB, WS_VA = 616 * MiB;
constexpr size_t WS_IQ = 624 * MiB;
constexpr size_t WS_ACT = 288 * MiB;
constexpr size_t WS_IK = 640 * MiB, WS_IW = 644 * MiB;
constexpr size_t WS_MASK = 648 * MiB;
constexpr size_t WS_SCR = 672 * MiB;
constexpr size_t WS_END = 800 * MiB;
static_assert(WS_ACT + (size_t)MTOK * FF * 2 <= WS_IK && WS_IQ + (size_t)MTOK * 128 * 2 <= WS_IK && WS_WDN + (size_t)DM * FF * 2 <= WS_XB && WS_WGU + (size_t)NGU * DM * 2 <= WS_WDN, "d_ws map");
constexpr int RING_BYTES = 131072;
constexpr int XCH_OFF = RING_BYTES;
constexpr int P2_SC = 0, SCW = 2052;
constexpr int P2_MASK = 132096;
constexpr int MISC_OFF = 163584;
constexpr int LDS_BYTES = 163840;
static_assert(P2_SC + 16 * SCW * 4 <= P2_MASK && P2_MASK + 16384 <= MISC_OFF, "P2 LDS map");

#define LAS __attribute__((address_space(3)))
typedef unsigned short bf16;
typedef unsigned v4u __attribute__((ext_vector_type(4)));
typedef unsigned v2u __attribute__((ext_vector_type(2)));
typedef float f32x4 __attribute__((ext_vector_type(4)));
typedef float f32x16 __attribute__((ext_vector_type(16)));
typedef short bf16x8 __attribute__((ext_vector_type(8)));
typedef short s16x4 __attribute__((ext_vector_type(4)));
#define LDS_WAIT() asm volatile("s_waitcnt lgkmcnt(0)" ::: "memory")
using pg8::pkbf;
__device__ __forceinline__ float bf2f(unsigned short h) { return __uint_as_float((unsigned)h << 16); }
__device__ __forceinline__ float bflo(unsigned w) { return __uint_as_float(w << 16); }
__device__ __forceinline__ float bfhi(unsigned w) { return __uint_as_float(w & 0xffff0000u); }
__device__ __forceinline__ float wave_sum(float v) {
#pragma unroll
    for (int o = 1; o < 64; o <<= 1) v += __shfl_xor(v, o);
    return v;
}
__device__ __forceinline__ s16x4 vtr(const LAS unsigned char* p) { return __builtin_bit_cast(s16x4, __builtin_amdgcn_ds_read_tr16_b64_v4i16((LAS s16x4*)p)); }
__device__ __forceinline__ bf16x8 cat8(s16x4 lo, s16x4 hi) { return (bf16x8){lo[0], lo[1], lo[2], lo[3], hi[0], hi[1], hi[2], hi[3]}; }
__device__ __forceinline__ int crow(int r, int hi) { return (r & 3) + 8 * (r >> 2) + 4 * hi; }

__device__ __forceinline__ int lane_id() { unsigned ones = ~0u; asm volatile("" : "+s"(ones)); return (int)__builtin_amdgcn_mbcnt_hi(ones, __builtin_amdgcn_mbcnt_lo(ones, 0u)); }
struct KArgs { const float* in[16]; float* out; unsigned char* ws; int ph_lo, ph_hi; };
struct Frame {
    LAS unsigned char* lds;
    unsigned* ctl;
    unsigned char* ws;
    int tid, lane, wave, vcu, G;
    const __attribute__((address_space(4))) KArgs* ap;
    __device__ __forceinline__ const float* x() const { return ap->in[0]; }
    __device__ __forceinline__ const float* norm1_w() const { return ap->in[1]; }
    __device__ __forceinline__ const float* w_in() const { return ap->in[2]; }
    __device__ __forceinline__ const float* q_norm_w() const { return ap->in[3]; }
    __device__ __forceinline__ const float* k_norm_w() const { return ap->in[4]; }
    __device__ __forceinline__ const float* kv_norm_w() const { return ap->in[5]; }
    __device__ __forceinline__ const float* w_uk() const { return ap->in[6]; }
    __device__ __forceinline__ const float* w_uv() const { return ap->in[7]; }
    __device__ __forceinline__ const float* rel_bias() const { return ap->in[8]; }
    __device__ __forceinline__ const float* ret_gn_w() const { return ap->in[9]; }
    __device__ __forceinline__ const float* ret_gn_b() const { return ap->in[10]; }
    __device__ __forceinline__ const float* w_out() const { return ap->in[11]; }
    __device__ __forceinline__ const float* norm2_w() const { return ap->in[12]; }
    __device__ __forceinline__ const float* w_gate() const { return ap->in[13]; }
    __device__ __forceinline__ const float* w_up() const { return ap->in[14]; }
    __device__ __forceinline__ const float* w_down() const { return ap->in[15]; }
    __device__ __forceinline__ float* out() const { return ap->out; }
#define WSB_(name, off) __device__ __forceinline__ bf16* name() const { return (bf16*)(ws + (off)); }
#define WSF_(name, off) __device__ __forceinline__ float* name() const { return (float*)(ws + (off)); }
    WSB_(WIN, WS_WIN) WSB_(WOUT, WS_WOUT) WSB_(WGU, WS_WGU) WSB_(WDN, WS_WDN) WSB_(XB, WS_XB) WSB_(MIX, WS_MIX) WSB_(QA, WS_QA) WSB_(QB, WS_QB) WSB_(KB, WS_KB) WSB_(VB, WS_VB) WSB_(GB, WS_GB)
    WSB_(KA, WS_KA) WSB_(VA, WS_VA) WSB_(IQ, WS_IQ) WSB_(IK, WS_IK) WSB_(ACT, WS_ACT)
    WSF_(IW, WS_IW) WSF_(R2, WS_R2) WSF_(COS, WS_COS) WSF_(SIN, WS_SIN) WSF_(BT, WS_BT) WSF_(SCR, WS_SCR)
    __device__ __forceinline__ unsigned long long* MASK() const { return (unsigned long long*)(ws + WS_MASK); }
#undef WSB_
#undef WSF_
};

__device__ __forceinline__ int zcol(int n) {
    const int pn = n >> 8, tc = n & 255, bj = tc >> 7, wc = (tc >> 5) & 3, j = tc & 31, d = bj * 32 + j;
    if (pn < 2) return (4 * pn + wc) * 64 + d;
    if (pn == 2) { if (wc == 0) return -2 - d; if (wc == 1) return -2 - (64 + d); return 512 + (wc - 2) * 64 + d; }
    if (pn == 3) { if (bj == 0) return 640 + wc * 32 + j; if (wc == 0) return 768 + j; if (wc == 1 && j < 4) return 800 + j; return -1; }
    const int g = (pn - 4) >> 1, head = 4 * ((pn - 4) & 1) + wc;
    return 804 + g * 512 + head * 64 + d;
}
template <class SRC>
__device__ __forceinline__ void tr_item(SRC src, int Kdim, bf16* WT, int k0, int n0, LAS float* scr, int lane) {
#pragma unroll 4
    for (int i = 0; i < 32; ++i) { const int kk = 2 * i + (lane >> 5); scr[kk * 33 + (lane & 31)] = src(k0 + kk); }
    LDS_WAIT(); asm volatile("" ::: "memory");
    const int c = lane & 7;
#pragma unroll
    for (int j = 0; j < 4; ++j) { const int n = (lane >> 3) + 8 * j; const LAS float* s = scr + (8 * c) * 33 + n;
        v4u o; o.x = pkbf(s[0 * 33], s[1 * 33]); o.y = pkbf(s[2 * 33], s[3 * 33]); o.z = pkbf(s[4 * 33], s[5 * 33]); o.w = pkbf(s[6 * 33], s[7 * 33]);
        *(v4u*)(WT + (size_t)(n0 + n) * Kdim + k0 + 8 * c) = o; }
    LDS_WAIT(); asm volatile("" ::: "memory");
}
__device__ __forceinline__ int t5_bucket(int rel) {
    const int n = rel < 0 ? -rel : rel; int b;
    if (n < 8) b = n; else if (n < 12) b = 8; else if (n < 16) b = 9; else if (n < 23) b = 10; else if (n < 32) b = 11; else if (n < 46) b = 12; else if (n < 64) b = 13; else if (n < 91) b = 14; else b = 15;
    return (rel > 0 ? 16 : 0) + b;
}
__device__ __forceinline__ void p0_prologue(Frame& F) {
    LAS float* scr = (LAS float*)(F.lds + F.wave * 16384);
    const int lane = F.lane, gw = F.vcu * NWAVES + F.wave, NGW = F.G * NWAVES;
    if (blockIdx.x == 0 && F.tid == 0) F.ctl[0] = 0u;
    constexpr int I_IN = 16 * (NIN / 32), I_OUT = 16 * 32, I_GU = 16 * (NGU / 32), I_DN = (FF / 64) * 32, NITEMS = I_IN + I_OUT + I_GU + I_DN;
    for (int it = gw; it < NITEMS; it += NGW) {
        int r = it;
        if (r < I_IN) {
            const int kb = r / (NIN / 32), nb = r % (NIN / 32), f = zcol(32 * nb + (lane & 31));
            const float* w_in = F.w_in(); const float* nw = F.norm1_w();
            if (f >= -1) tr_item([&](int k) { return f >= 0 ? nw[k] * w_in[(size_t)k * INW + f] : 0.0f; }, DM, F.WIN(), 64 * kb, 32 * nb, scr, lane);
            continue;
        }
        r -= I_IN;
        if (r < I_OUT) { const int kb = r / 32, nb = r % 32; const float* w = F.w_out() + 32 * nb + (lane & 31);
            tr_item([&](int k) { return w[(size_t)k * DM]; }, DM, F.WOUT(), 64 * kb, 32 * nb, scr, lane); continue; }
        r -= I_OUT;
        if (r < I_GU) { const int kb = r / (NGU / 32), nb = r % (NGU / 32), n = 32 * nb + (lane & 31), pn = n >> 8, tc = n & 255;
            const float* w = ((tc >> 7) ? F.w_up() : F.w_gate()) + 128 * pn + (tc & 127); const float* nw = F.norm2_w();
            tr_item([&](int k) { return nw[k] * w[(size_t)k * FF]; }, DM, F.WGU(), 64 * kb, 32 * nb, scr, lane); continue; }
        r -= I_GU;
        { const int kb = r / 32, nb = r % 32; const float* w = F.w_down() + 32 * nb + (lane & 31);
            tr_item([&](int k) { return w[(size_t)k * DM]; }, FF, F.WDN(), 64 * kb, 32 * nb, scr, lane); }
    }
    for (int e = F.vcu * NTHR + F.tid; e < DM * 128; e += F.G * NTHR) {
        const int k = e >> 7, idx = e & 127, d = idx & 63; const float* wu = (idx < 64 ? F.w_uk() : F.w_uv()) + d; const float* wr_ = F.w_in() + (size_t)k * INW + 512; float a = 0.f;
#pragma unroll 8
        for (int j = 0; j < 128; ++j) a += wr_[j] * F.kv_norm_w()[j] * wu[j * 64];
        const int n = 512 + (idx < 64 ? 0 : 32) + (d < 32 ? d : 128 + d - 32);
        F.WIN()[(size_t)n * DM + k] = (bf16)(pkbf(F.norm1_w()[k] * a, 0.f) & 0xffffu);
    }
    for (int m = gw; m < MTOK; m += NGW) {
        const f32x4* xr = (const f32x4*)(F.x() + (size_t)m * DM) + lane;
        f32x4 v[4]; float s = 0.f;
#pragma unroll
        for (int j = 0; j < 4; ++j) { v[j] = xr[64 * j]; s += pg8::dot4(v[j]); }
        const float rr = 1.0f / sqrtf(wave_sum(s) * (1.0f / DM) + 1e-6f);
        v2u* o8 = (v2u*)(F.XB() + (size_t)m * DM) + lane;
#pragma unroll
        for (int j = 0; j < 4; ++j) o8[64 * j] = (v2u){pkbf(v[j][0] * rr, v[j][1] * rr), pkbf(v[j][2] * rr, v[j][3] * rr)};
    }
    const int gt = F.vcu * NTHR + F.tid, NGT = F.G * NTHR;
    for (int i = gt; i < SEQ * 32; i += NGT) { const int pos = i >> 5, j = i & 31;
        const float inv = powf(10000.0f, -(float)j / 32.0f), ang = (float)pos * inv;
        F.COS()[i] = cosf(ang); F.SIN()[i] = sinf(ang); }
    for (int i = gt; i < 8 * 256; i += NGT) { const int h = i >> 8, rel = (i & 255) - 191;
        float mq = 0.f, mk = 0.f, mb = 0.f;
        for (int j = 0; j < 64; ++j) { mq = fmaxf(mq, fabsf(F.q_norm_w()[j])); mk = fmaxf(mk, fabsf(F.k_norm_w()[j])); }
        for (int j = 0; j < 256; ++j) mb = fmaxf(mb, fabsf(F.rel_bias()[j]));
        const float bound = 8.0f * mq * mk + mb;
        F.BT()[i] = (F.rel_bias()[t5_bucket(rel) * 8 + h] - bound) * 1.4426950408889634f; }
}

#ifndef MIXREP
#define MIXREP 0
#endif
typedef float f32x4_t __attribute__((ext_vector_type(4)));
typedef float f32x2v __attribute__((ext_vector_type(2)));
__device__ __forceinline__ void idx_round(const Frame& F, int b, int c, int rq, LAS unsigned char* lds) {
    const int w = F.wave, lane = F.lane, q = lane & 15, g = lane >> 4;
    const size_t rowq = (size_t)b * SEQ + 64 * c + 16 * rq + q;
    bf16x8 bq[4];
#pragma unroll
    for (int h = 0; h < 4; ++h) bq[h] = *(const bf16x8*)(F.IQ() + rowq * 128 + 32 * h + 8 * g);
    const f32x4 wv = *(const f32x4*)(F.IW() + rowq * 4) * (0.5f * 0.17677669529663687f);
    const int nkb = 4 * (c + 1);
    const bf16* kp = F.IK() + ((size_t)b * SEQ + q) * 32 + 8 * g;
    LAS float* dst = (LAS float*)(lds + P2_SC) + q * SCW + 4 * g;
    int kb = w; bf16x8 a = *(const bf16x8*)(kp + (size_t)kb * 512);
    for (; kb < nkb; kb += 8) {
        bf16x8 an = a; if (kb + 8 < nkb) an = *(const bf16x8*)(kp + (size_t)(kb + 8) * 512);
        f32x4 sc = {0.f, 0.f, 0.f, 0.f};
#pragma unroll
        for (int h = 0; h < 4; ++h) {
            const f32x4 d = __builtin_amdgcn_mfma_f32_16x16x32_bf16(a, bq[h], (f32x4){0.f, 0.f, 0.f, 0.f}, 0, 0, 0);
#pragma unroll
            for (int i = 0; i < 4; ++i) sc[i] += wv[h] * fmaxf(d[i], 0.f);
        }
        *(LAS f32x4*)(dst + 16 * kb) = (f32x4){sc[0] + 0.f, sc[1] + 0.f, sc[2] + 0.f, sc[3] + 0.f};
        a = an;
    }
}
__device__ __forceinline__ int wave_sum_i(int v) {
    v += __builtin_amdgcn_update_dpp(0, v, 0xB1, 0xF, 0xF, false);
    v += __builtin_amdgcn_update_dpp(0, v, 0x4E, 0xF, 0xF, false);
    v += __builtin_amdgcn_update_dpp(0, v, 0x141, 0xF, 0xF, false);
    v += __builtin_amdgcn_update_dpp(0, v, 0x140, 0xF, 0xF, false);
    return (__builtin_amdgcn_readlane(v, 0) + __builtin_amdgcn_readlane(v, 16)) + (__builtin_amdgcn_readlane(v, 32) + __builtin_amdgcn_readlane(v, 48));
}
__device__ __forceinline__ unsigned sortable(float f) { const unsigned bits = __float_as_uint(f); return bits ^ ((unsigned)((int)bits >> 31) | 0x80000000u); }
template <int NJ>
__device__ __forceinline__ void mask_words(const unsigned (&u)[NJ], unsigned prefix, bool exact, LAS unsigned long long* mrow, int nj, int lane) {
    unsigned long long mv = 0ull;
    if (exact) {
#pragma unroll
        for (int j = 0; j < NJ; ++j) { const unsigned long long sel = __ballot(u[j] >= prefix); if (lane == j) mv = sel; }
    } else {
        int ngt = 0;
#pragma unroll
        for (int j = 0; j < NJ; ++j) ngt += __popcll(__ballot(u[j] > prefix));
        int need = 256 - ngt;
#pragma unroll
        for (int j = 0; j < NJ; ++j) {
            const unsigned long long eq = __ballot(u[j] == prefix);
            const int rank = (int)__builtin_amdgcn_mbcnt_hi((unsigned)(eq >> 32), __builtin_amdgcn_mbcnt_lo((unsigned)eq, 0u));
            const unsigned long long sel = __ballot(u[j] > prefix || (u[j] == prefix && rank < need));
            need -= __popcll(eq);
            if (lane == j) mv = sel;
        }
    }
    if (lane < nj) mrow[lane] = mv;
}
template <int NJ>
__device__ __forceinline__ void select_row(const LAS float* row, LAS unsigned long long* mrow, int nj, int lane) {
    static_assert(NJ % 4 == 0, "groups of four");
    unsigned u[NJ];
#pragma unroll
    for (int j = 0; j < NJ; ++j) { float v = row[64 * j + lane]; asm volatile("" : "+v"(v)); u[j] = (j < nj) ? sortable(v) : 0u; }
    unsigned prefix = 0u; bool exact = false;
#pragma unroll 1
    for (int bit = 31; bit >= 0; --bit) {
        const unsigned trial = prefix | (1u << bit); int c0 = 0, c1 = 0, c2 = 0, c3 = 0;
#pragma unroll
        for (int j = 0; j < NJ; j += 4) {
            unsigned long long m0, m1, m2, m3;
            asm volatile("v_cmp_le_u32_e64 %4, %12, %8\n\tv_cmp_le_u32_e64 %5, %12, %9\n\tv_cmp_le_u32_e64 %6, %12, %10\n\tv_cmp_le_u32_e64 %7, %12, %11\n\t"
                         "v_addc_co_u32_e64 %0, %4, 0, %0, %4\n\tv_addc_co_u32_e64 %1, %5, 0, %1, %5\n\tv_addc_co_u32_e64 %2, %6, 0, %2, %6\n\tv_addc_co_u32_e64 %3, %7, 0, %3, %7"
                         : "+v"(c0), "+v"(c1), "+v"(c2), "+v"(c3), "=&s"(m0), "=&s"(m1), "=&s"(m2), "=&s"(m3) : "v"(u[j]), "v"(u[j + 1]), "v"(u[j + 2]), "v"(u[j + 3]), "s"(trial));
        }
        const int cnt = wave_sum_i((c0 + c1) + (c2 + c3));
        if (cnt >= 256) prefix = trial;
        if (cnt == 256) { exact = true; break; }
    }
    mask_words<NJ>(u, prefix, exact, mrow, nj, lane);
}
template <int S, unsigned M>
__device__ __forceinline__ void tr_stage(unsigned (&A)[32]) {
#pragma unroll
    for (int k = 0; k < 32; ++k) if (!(k & S)) { const unsigned a = A[k], b = A[k + S]; A[k] = (a & M) | ((b & M) << S); A[k + S] = ((a >> S) & M) | (b & ~M); }
}
__device__ __forceinline__ void planes_finish(unsigned gt, unsigned alive, int G, bool done, LAS unsigned long long* mrow, int nj, int lane) {
    unsigned sel = gt | alive;
    if (!done) {
        int need = 256 - G; unsigned ts = 0u;
#pragma unroll
        for (int j = 0; j < 32; ++j) {
            const bool mine = (alive >> j) & 1u; const unsigned long long eq = __ballot(mine);
            const int rank = (int)__builtin_amdgcn_mbcnt_hi((unsigned)(eq >> 32), __builtin_amdgcn_mbcnt_lo((unsigned)eq, 0u));
            ts |= (mine && rank < need) ? (1u << j) : 0u; need -= __popcll(eq);
        }
        sel = gt | ts;
    }
    unsigned long long mv = 0ull;
#pragma unroll
    for (int j = 0; j < 32; ++j) { const unsigned long long w = __ballot((sel >> j) & 1u); if (lane == j) mv = w; }
    if (lane < nj) mrow[lane] = mv;
}
__device__ __forceinline__ void select_rows_planes2(const LAS float* rowa, const LAS float* rowb, LAS unsigned long long* mrowa, LAS unsigned long long* mrowb, int nj, int lane) {
    unsigned A[32], B[32];
#pragma unroll
    for (int j = 0; j < 32; ++j) { float va = rowa[64 * j + lane], vb = rowb[64 * j + lane]; asm volatile("" : "+v"(va), "+v"(vb)); A[j] = (j < nj) ? sortable(va) : 0u; B[j] = (j < nj) ? sortable(vb) : 0u; }
    tr_stage<16, 0x0000FFFFu>(A); tr_stage<8, 0x00FF00FFu>(A); tr_stage<4, 0x0F0F0F0Fu>(A); tr_stage<2, 0x33333333u>(A); tr_stage<1, 0x55555555u>(A);
    tr_stage<16, 0x0000FFFFu>(B); tr_stage<8, 0x00FF00FFu>(B); tr_stage<4, 0x0F0F0F0Fu>(B); tr_stage<2, 0x33333333u>(B); tr_stage<1, 0x55555555u>(B);
    unsigned alivea = 0xFFFFFFFFu, gta = 0u, aliveb = 0xFFFFFFFFu, gtb = 0u; int Ga = 0, Aa = 2048, Gb = 0, Ab = 2048; bool donea = false, doneb = false;
#pragma unroll
    for (int b = 31; b >= 0; --b) {
        if (!(donea && doneb)) {
            const unsigned onesa = alivea & A[b], onesb = aliveb & B[b];
            const int both = wave_sum_i(__builtin_popcount(onesa) | (__builtin_popcount(onesb) << 16)), C1a = both & 0xffff, C1b = both >> 16;
            if (!donea) {
                if (Ga + C1a >= 256) { alivea = onesa; Aa = C1a; } else { Ga += C1a; gta |= onesa; alivea &= ~A[b]; Aa -= C1a; }
                donea = (Ga + Aa == 256);
            }
            if (!doneb) {
                if (Gb + C1b >= 256) { aliveb = onesb; Ab = C1b; } else { Gb += C1b; gtb |= onesb; aliveb &= ~B[b]; Ab -= C1b; }
                doneb = (Gb + Ab == 256);
            }
        }
    }
    planes_finish(gta, alivea, Ga, donea, mrowa, nj, lane);
    planes_finish(gtb, aliveb, Gb, doneb, mrowb, nj, lane);
}
constexpr int AT_K = 0, AT_V = 16384, AT_BT = 32768, AT_WS = 40960, AT_OST = 0, AT_Q = 43008;
static_assert(AT_Q + 65536 <= P2_MASK && AT_OST + 8 * 4608 <= AT_WS, "attention LDS map");
__device__ __forceinline__ bf16x8 pk16(const f32x16& v, int o) { return __builtin_bit_cast(bf16x8, (v4u){pkbf(v[o], v[o + 1]), pkbf(v[o + 2], v[o + 3]), pkbf(v[o + 4], v[o + 5]), pkbf(v[o + 6], v[o + 7])}); }
template <bool MASK, bool NEAR>
__device__ __forceinline__ void attn_soft(f32x16& p0, f32x16& p1, f32x2v& lacc, bf16x8 (&pa)[4], const LAS float* bt, unsigned long long mw, int hi) {
#pragma unroll
    for (int i = 0; i < 16; ++i) { p0[i] = __builtin_amdgcn_exp2f(p0[i]); p1[i] = __builtin_amdgcn_exp2f(p1[i]); }
    if (MASK) {
        const unsigned long long ws_ = mw >> (4 * hi); const int lo = (int)(unsigned)ws_, hh = (int)(unsigned)(ws_ >> 32);
#define MSK_(i) { int m0_, m1_; asm("v_bfe_i32 %0, %1, %2, 1" : "=v"(m0_) : "v"(lo), "n"(((i) & 3) + 8 * ((i) >> 2))); asm("v_bfe_i32 %0, %1, %2, 1" : "=v"(m1_) : "v"(hh), "n"(((i) & 3) + 8 * ((i) >> 2))); \
            p0[i] = __uint_as_float(__float_as_uint(p0[i]) & (unsigned)m0_); p1[i] = __uint_as_float(__float_as_uint(p1[i]) & (unsigned)m1_); }
        MSK_(0) MSK_(1) MSK_(2) MSK_(3) MSK_(4) MSK_(5) MSK_(6) MSK_(7) MSK_(8) MSK_(9) MSK_(10) MSK_(11) MSK_(12) MSK_(13) MSK_(14) MSK_(15)
#undef MSK_
    }
#pragma unroll
    for (int i = 0; i < 16; i += 2) { lacc += (f32x2v){p0[i], p0[i + 1]}; lacc += (f32x2v){p1[i], p1[i + 1]}; }
    pa[0] = pk16(p0, 0); pa[1] = pk16(p0, 8); pa[2] = pk16(p1, 0); pa[3] = pk16(p1, 8);
}
__device__ __forceinline__ void attn_pv(f32x16& o0, f32x16& o1, const bf16x8 (&pa)[4], const LAS unsigned char* Vb) {
#pragma unroll
    for (int ks = 0; ks < 4; ++ks) {
        o0 = __builtin_amdgcn_mfma_f32_32x32x16_bf16(pa[ks], cat8(vtr(Vb + ks * 1024), vtr(Vb + ks * 1024 + 512)), o0, 0, 0, 0);
        o1 = __builtin_amdgcn_mfma_f32_32x32x16_bf16(pa[ks], cat8(vtr(Vb + 4096 + ks * 1024), vtr(Vb + 4096 + ks * 1024 + 512)), o1, 0, 0, 0);
    }
}
template <bool MASK, bool NEAR>
__device__ __forceinline__ void attn_tile(f32x16& oa0, f32x16& oa1, f32x16& ob0, f32x16& ob1, f32x2v& la, f32x2v& lb, const LAS unsigned char* Qb,
                                          const LAS unsigned char* Kb, const LAS unsigned char* Vb, const LAS float* bt, float ci, unsigned long long mwa, unsigned long long mwb, int hi) {
    f32x16 a0, a1, b0, b1;
#pragma unroll
    for (int i = 0; i < 16; ++i) {
        if (NEAR) { a0[i] = bt[(i & 3) + 8 * (i >> 2)]; a1[i] = bt[32 + (i & 3) + 8 * (i >> 2)]; b0[i] = bt[(i & 3) + 8 * (i >> 2) - 32]; b1[i] = bt[(i & 3) + 8 * (i >> 2)]; }
        else { a0[i] = ci; a1[i] = ci; b0[i] = ci; b1[i] = ci; }
    }
#pragma unroll
    for (int d0 = 0; d0 < 4; ++d0) { const bf16x8 k0 = *(const LAS bf16x8*)(Kb + d0 * 2048), k1 = *(const LAS bf16x8*)(Kb + d0 * 2048 + 512);
        const bf16x8 qf = *(const LAS bf16x8*)(Qb + d0 * 1024);
        a0 = __builtin_amdgcn_mfma_f32_32x32x16_bf16(k0, qf, a0, 0, 0, 0); a1 = __builtin_amdgcn_mfma_f32_32x32x16_bf16(k1, qf, a1, 0, 0, 0); }
    const LAS unsigned char* Kb2 = Kb; asm volatile("" : "+v"(Kb2));
#pragma unroll
    for (int d0 = 0; d0 < 4; ++d0) { const bf16x8 k0 = *(const LAS bf16x8*)(Kb2 + d0 * 2048), k1 = *(const LAS bf16x8*)(Kb2 + d0 * 2048 + 512);
        const bf16x8 qf = *(const LAS bf16x8*)(Qb + 4096 + d0 * 1024);
        b0 = __builtin_amdgcn_mfma_f32_32x32x16_bf16(k0, qf, b0, 0, 0, 0); b1 = __builtin_amdgcn_mfma_f32_32x32x16_bf16(k1, qf, b1, 0, 0, 0); }
    bf16x8 pa[4], pb[4];
    attn_soft<MASK, NEAR>(a0, a1, la, pa, bt, mwa, hi);
    attn_pv(oa0, oa1, pa, Vb);
    attn_soft<MASK, NEAR>(b0, b1, lb, pb, bt - 32, mwb, hi);
    attn_pv(ob0, ob1, pb, Vb);
}
__device__ __forceinline__ void attn_store(const f32x16& o0, const f32x16& o1, f32x2v lacc, bf16* obase, LAS unsigned char* stg, LAS float* wsf, int lane) {
    const int r = lane & 31, hi = lane >> 5;
    float lsum = lacc[0] + lacc[1];
    lsum += __shfl_xor(lsum, 32);
    if (hi == 0) wsf[r] = lsum;
    LDS_WAIT(); asm volatile("" ::: "memory");
    LAS unsigned short* st = (LAS unsigned short*)stg;
#pragma unroll
    for (int i = 0; i < 16; ++i) {
        const int q = crow(i, hi); const float rl = 1.0f / wsf[q];
        st[q * 72 + r] = (unsigned short)(pkbf(o0[i] * rl, 0.f) & 0xffffu); st[q * 72 + 32 + r] = (unsigned short)(pkbf(o1[i] * rl, 0.f) & 0xffffu);
    }
    LDS_WAIT(); asm volatile("" ::: "memory");
#pragma unroll
    for (int k = 0; k < 4; ++k) { const int row = 8 * k + (lane >> 3), ch = lane & 7;
        const v4u v = *(const LAS v4u*)(stg + row * 144 + ch * 16); *(v4u*)(obase + (size_t)row * DM + ch * 8) = v; }
    LDS_WAIT(); asm volatile("" ::: "memory");
}
template <bool MASK>
__device__ __forceinline__ void attn_chunk(const Frame& F, int b, int c, LAS unsigned char* lds) {
    const int wid = F.wave, lane = F.lane, r = lane & 31, hi = lane >> 5;
    const size_t rowbase = (size_t)b * SEQ; const int q0 = 64 * c, nt = c + 1;
    const LAS unsigned char* Qb = lds + AT_Q + wid * 8192 + lane * 16;
#pragma unroll
    for (int d0 = 0; d0 < 4; ++d0) {
        *(LAS bf16x8*)(lds + AT_Q + wid * 8192 + d0 * 1024 + lane * 16) = *(const bf16x8*)(F.QA() + (rowbase + q0 + r) * 512 + wid * 64 + 16 * d0 + 8 * hi);
        *(LAS bf16x8*)(lds + AT_Q + wid * 8192 + 4096 + d0 * 1024 + lane * 16) = *(const bf16x8*)(F.QA() + (rowbase + q0 + 32 + r) * 512 + wid * 64 + 16 * d0 + 8 * hi); }
    const LAS float* BT = (const LAS float*)(lds + AT_BT) + wid * 256;
    const float farc = BT[0];
    const bf16* ksrc = F.KA() + (rowbase + lane) * 64 + 8 * wid;
    const bf16* vsrc = F.VA() + (rowbase + 16 * (wid & 3) + (lane >> 2)) * 64 + (wid >> 2) * 32 + (lane & 3) * 8;
    const LAS unsigned long long* mrow = (const LAS unsigned long long*)(lds + P2_MASK) + r * 32;
    const int voff = ((lane >> 4) & 1) * 32 + (lane & 3) * 8 + (4 * hi + ((lane & 15) >> 2)) * 64;
    f32x16 oa0, oa1, ob0, ob1; f32x2v la = {0.f, 0.f}, lb = {0.f, 0.f};
#pragma unroll
    for (int i = 0; i < 16; ++i) { oa0[i] = 0.f; oa1[i] = 0.f; ob0[i] = 0.f; ob1[i] = 0.f; }
    __builtin_amdgcn_global_load_lds((const unsigned*)ksrc, (LAS unsigned*)(lds + AT_K + wid * 1024), 16, 0, 0);
    __builtin_amdgcn_global_load_lds((const unsigned*)vsrc, (LAS unsigned*)(lds + AT_V + wid * 1024), 16, 0, 0);
    asm volatile("s_waitcnt vmcnt(0)" ::: "memory");
    __syncthreads();
    const int nfar = c >= 2 ? c - 2 : 0;
#pragma unroll 1
    for (int t = 0; t < nt; ++t) {
        const int cur = (t & 1) * 8192, nxt = 8192 - cur, tn = t + 1 < nt ? t + 1 : t;
        __builtin_amdgcn_global_load_lds((const unsigned*)(ksrc + (size_t)tn * 64 * 64), (LAS unsigned*)(lds + AT_K + nxt + wid * 1024), 16, 0, 0);
        __builtin_amdgcn_global_load_lds((const unsigned*)(vsrc + (size_t)tn * 64 * 64), (LAS unsigned*)(lds + AT_V + nxt + wid * 1024), 16, 0, 0);
        unsigned long long mwa = 0ull, mwb = 0ull;
        if (MASK) { mwa = mrow[t]; mwb = mrow[32 * 32 + t]; }
        const LAS unsigned char* Kb = lds + AT_K + cur + hi * 1024 + r * 16; const LAS unsigned char* Vb = lds + AT_V + cur + voff;
        const LAS float* bt = BT + (64 * (t - c) + 191 - r + 4 * hi);
        if (t < nfar) attn_tile<MASK, false>(oa0, oa1, ob0, ob1, la, lb, Qb, Kb, Vb, bt, farc, mwa, mwb, hi);
        else attn_tile<MASK, true>(oa0, oa1, ob0, ob1, la, lb, Qb, Kb, Vb, bt, 0.f, mwa, mwb, hi);
        asm volatile("s_waitcnt vmcnt(0)" ::: "memory");
        __syncthreads();
    }
    LAS float* wsf = (LAS float*)(lds + AT_WS) + wid * 64; LAS unsigned char* stg = lds + AT_OST + wid * 4608;
    attn_store(oa0, oa1, la, F.MIX() + (rowbase + q0) * DM + wid * 64, stg, wsf, lane);
    attn_store(ob0, ob1, lb, F.MIX() + (rowbase + q0 + 32) * DM + wid * 64, stg, wsf, lane);
}
__device__ __forceinline__ void attn_unit(const Frame& F, int b, int c, LAS unsigned char* lds) {
    if (c >= 4) {
        const int nj = c + 1;
        for (int rq = 0; rq < ((MIXREP & 2) ? 8 : 4); ++rq) {
            idx_round(F, b, c, rq & 3, lds);
            __syncthreads();
            {
                const int ql = 2 * F.wave;
                const LAS float* row = (const LAS float*)(lds + P2_SC) + ql * SCW; LAS unsigned long long* mrow = (LAS unsigned long long*)(lds + P2_MASK) + (16 * (rq & 3) + ql) * 32;
                if (nj <= 8) { select_row<8>(row, mrow, nj, F.lane); select_row<8>(row + SCW, mrow + 32, nj, F.lane); }
                else select_rows_planes2(row, row + SCW, mrow, mrow + 32, nj, F.lane);
            }
            __syncthreads();
        }
    }
    { const f32x4 v = *(const f32x4*)(F.BT() + F.tid * 4); *(LAS f32x4*)(lds + AT_BT + F.tid * 16) = v; }
    __syncthreads();
    if (c >= 4) attn_chunk<true>(F, b, c, lds); else attn_chunk<false>(F, b, c, lds);
}

constexpr int RT_TAB = 131072;
__device__ __forceinline__ void ret_stage(const bf16* vsrc, const bf16* ksrc, LAS unsigned char* region) {
#pragma unroll
    for (int k = 0; k < 8; ++k) {
        const size_t o = (size_t)(16 * (k & 3)) * 512 + 32 * (k >> 2);
        __builtin_amdgcn_global_load_lds((const unsigned*)(vsrc + o), (LAS unsigned*)(region + k * 1024), 16, 0, 0);
        __builtin_amdgcn_global_load_lds((const unsigned*)(ksrc + o), (LAS unsigned*)(region + 8192 + k * 1024), 16, 0, 0);
    }
}
__device__ __forceinline__ void ret_kv(f32x16 (&T)[2][2], const LAS unsigned char* img) {
#pragma unroll
    for (int ks = 0; ks < 4; ++ks) {
        const bf16x8 k0 = cat8(vtr(img + 8192 + ks * 1024), vtr(img + 8192 + ks * 1024 + 512)), k1 = cat8(vtr(img + 8192 + 4096 + ks * 1024), vtr(img + 8192 + 4096 + ks * 1024 + 512));
        const bf16x8 v0 = cat8(vtr(img + ks * 1024), vtr(img + ks * 1024 + 512)), v1 = cat8(vtr(img + 4096 + ks * 1024), vtr(img + 4096 + ks * 1024 + 512));
        T[0][0] = __builtin_amdgcn_mfma_f32_32x32x16_bf16(k0, v0, T[0][0], 0, 0, 0); T[0][1] = __builtin_amdgcn_mfma_f32_32x32x16_bf16(k0, v1, T[0][1], 0, 0, 0);
        T[1][0] = __builtin_amdgcn_mfma_f32_32x32x16_bf16(k1, v0, T[1][0], 0, 0, 0); T[1][1] = __builtin_amdgcn_mfma_f32_32x32x16_bf16(k1, v1, T[1][1], 0, 0, 0);
    }
}
__device__ __forceinline__ void ret_unit(const Frame& F, int b, int h, LAS unsigned char* lds) {
    const int lane = F.lane, w = F.wave, r = lane & 31, hi = lane >> 5;
    const float gam = 1.0f - exp2f(-5.0f - (float)h), lg2 = log2f(gam), cd = exp2f(64.0f * lg2), cd4 = exp2f(256.0f * lg2);
    LAS unsigned char* region = lds + w * 16384;
    const LAS unsigned char* img = region + ((lane >> 4) & 1) * 32 + (lane & 3) * 8 + (4 * hi + ((lane & 15) >> 2)) * 64;
    LAS float* tab = (LAS float*)(lds + RT_TAB);
    __syncthreads();
    if (F.tid < 128) tab[F.tid] = F.tid < 64 ? F.ret_gn_w()[h * 64 + F.tid] : F.ret_gn_b()[h * 64 + F.tid - 64];
    const size_t hbase = (size_t)b * SEQ * 512 + h * 64;
    const size_t stg = hbase + (size_t)(lane >> 2) * 512 + (lane & 3) * 8;
    f32x16 T[2][2];
#pragma unroll
    for (int i = 0; i < 16; ++i) { T[0][0][i] = 0.f; T[0][1][i] = 0.f; T[1][0][i] = 0.f; T[1][1][i] = 0.f; }
#pragma unroll 1
    for (int i = 0; i < 4; ++i) {
        const size_t co = (size_t)(4 * w + i) * 64 * 512;
        ret_stage(F.VB() + stg + co, F.KB() + stg + co, region);
        if (i) {
#pragma unroll
            for (int k = 0; k < 16; ++k) { T[0][0][k] *= cd; T[0][1][k] *= cd; T[1][0][k] *= cd; T[1][1][k] *= cd; }
        }
        asm volatile("s_waitcnt vmcnt(0)" ::: "memory");
        ret_kv(T, img);
        LDS_WAIT();
    }
#pragma unroll
    for (int eb = 0; eb < 2; ++eb)
#pragma unroll
        for (int db = 0; db < 2; ++db)
#pragma unroll
            for (int g = 0; g < 4; ++g) *(LAS f32x4*)(region + ((eb * 2 + db) * 4 + g) * 1024 + lane * 16) = (f32x4){T[eb][db][4 * g], T[eb][db][4 * g + 1], T[eb][db][4 * g + 2], T[eb][db][4 * g + 3]};
    __syncthreads();
#pragma unroll
    for (int i = 0; i < 16; ++i) { T[0][0][i] = 0.f; T[0][1][i] = 0.f; T[1][0][i] = 0.f; T[1][1][i] = 0.f; }
#pragma unroll 1
    for (int wp = 0; wp < w; ++wp) {
        const LAS unsigned char* src = lds + wp * 16384 + lane * 16;
#pragma unroll
        for (int eb = 0; eb < 2; ++eb)
#pragma unroll
            for (int db = 0; db < 2; ++db)
#pragma unroll
                for (int g = 0; g < 4; ++g) { const f32x4 v = *(const LAS f32x4*)(src + ((eb * 2 + db) * 4 + g) * 1024);
                    T[eb][db][4 * g] = T[eb][db][4 * g] * cd4 + v[0]; T[eb][db][4 * g + 1] = T[eb][db][4 * g + 1] * cd4 + v[1]; T[eb][db][4 * g + 2] = T[eb][db][4 * g + 2] * cd4 + v[2]; T[eb][db][4 * g + 3] = T[eb][db][4 * g + 3] * cd4 + v[3]; }
    }
    __syncthreads();
#pragma unroll 1
    for (int i = 0; i < 4; ++i) {
        const int n = 4 * w + i; const size_t co = (size_t)n * 64 * 512;
        ret_stage(F.VB() + stg + co, F.KB() + stg + co, region);
#pragma unroll
        for (int k = 0; k < 16; ++k) { T[0][0][k] *= cd; T[0][1][k] *= cd; T[1][0][k] *= cd; T[1][1][k] *= cd; }
        const bf16* qrow = F.QB() + hbase + co + (size_t)r * 512 + 8 * hi;
        const bf16* krow = F.KB() + hbase + co + (size_t)r * 512 + 8 * hi;
#pragma unroll 1
        for (int ib = 0; ib < 2; ++ib) {
            bf16x8 qf[4], kf[4];
#pragma unroll
            for (int s = 0; s < 4; ++s) { qf[s] = *(const bf16x8*)(qrow + (size_t)(32 * ib) * 512 + 16 * s); kf[s] = *(const bf16x8*)(krow + 16 * s); }
            const size_t tok = (size_t)b * SEQ + 64 * n + 32 * ib + r;
            const bf16* grow = F.GB() + tok * 512 + h * 64 + 4 * hi;
            v2u gq[2][4];
#pragma unroll
            for (int db = 0; db < 2; ++db)
#pragma unroll
                for (int g = 0; g < 4; ++g) gq[db][g] = *(const v2u*)(grow + 32 * db + 8 * g);
            f32x16 s0, s1;
#pragma unroll
            for (int k = 0; k < 16; ++k) { s0[k] = 0.f; s1[k] = 0.f; }
#pragma unroll
            for (int s = 0; s < 4; ++s) s0 = __builtin_amdgcn_mfma_f32_32x32x16_bf16(kf[s], qf[s], s0, 0, 0, 0);
            if (ib == 1) {
#pragma unroll
                for (int s = 0; s < 4; ++s) kf[s] = *(const bf16x8*)(krow + (size_t)32 * 512 + 16 * s);
#pragma unroll
                for (int s = 0; s < 4; ++s) s1 = __builtin_amdgcn_mfma_f32_32x32x16_bf16(kf[s], qf[s], s1, 0, 0, 0);
#pragma unroll
                for (int k = 0; k < 16; ++k) s1[k] = (r >= crow(k, hi)) ? s1[k] : 0.f;
            } else {
#pragma unroll
                for (int k = 0; k < 16; ++k) s0[k] = (r >= crow(k, hi)) ? s0[k] : 0.f;
            }
#pragma unroll
            for (int s = 0; s < 4; ++s) {
                v4u q4 = __builtin_bit_cast(v4u, qf[s]);
                auto x0 = __builtin_amdgcn_permlane32_swap(q4[0], q4[2], false, false); auto x1 = __builtin_amdgcn_permlane32_swap(q4[1], q4[3], false, false);
                q4[0] = x0[0]; q4[2] = x0[1]; q4[1] = x1[0]; q4[3] = x1[1];
                qf[s] = __builtin_bit_cast(bf16x8, q4);
            }
            asm volatile("s_waitcnt vmcnt(0)" ::: "memory");
            f32x16 y0, y1;
#pragma unroll
            for (int k = 0; k < 16; ++k) { y0[k] = 0.f; y1[k] = 0.f; }
#pragma unroll
            for (int eb = 0; eb < 2; ++eb)
#pragma unroll
                for (int s2 = 0; s2 < 2; ++s2) {
                    y0 = __builtin_amdgcn_mfma_f32_32x32x16_bf16(pk16(T[eb][0], 8 * s2), qf[2 * eb + s2], y0, 0, 0, 0);
                    y1 = __builtin_amdgcn_mfma_f32_32x32x16_bf16(pk16(T[eb][1], 8 * s2), qf[2 * eb + s2], y1, 0, 0, 0);
                }
#pragma unroll
            for (int ks = 0; ks < 2; ++ks) {
                const bf16x8 pb = pk16(s0, 8 * ks);
                y0 = __builtin_amdgcn_mfma_f32_32x32x16_bf16(cat8(vtr(img + ks * 1024), vtr(img + ks * 1024 + 512)), pb, y0, 0, 0, 0);
                y1 = __builtin_amdgcn_mfma_f32_32x32x16_bf16(cat8(vtr(img + 4096 + ks * 1024), vtr(img + 4096 + ks * 1024 + 512)), pb, y1, 0, 0, 0);
            }
            if (ib == 1) {
#pragma unroll
                for (int ks = 0; ks < 2; ++ks) {
                    const bf16x8 pb = pk16(s1, 8 * ks);
                    y0 = __builtin_amdgcn_mfma_f32_32x32x16_bf16(cat8(vtr(img + (2 + ks) * 1024), vtr(img + (2 + ks) * 1024 + 512)), pb, y0, 0, 0, 0);
                    y1 = __builtin_amdgcn_mfma_f32_32x32x16_bf16(cat8(vtr(img + 4096 + (2 + ks) * 1024), vtr(img + 4096 + (2 + ks) * 1024 + 512)), pb, y1, 0, 0, 0);
                }
            }
            float sm = 0.f;
#pragma unroll
            for (int k = 0; k < 16; ++k) sm += y0[k] + y1[k];
            sm += __shfl_xor(sm, 32);
            const float mean = sm * (1.0f / 64.0f); float vr = 0.f;
#pragma unroll
            for (int k = 0; k < 16; ++k) { y0[k] -= mean; y1[k] -= mean; vr += y0[k] * y0[k] + y1[k] * y1[k]; }
            vr += __shfl_xor(vr, 32);
            const float rstd = 1.0f / sqrtf(vr * (1.0f / 64.0f) + 1e-5f);
            bf16* orow = F.MIX() + tok * DM + 512 + h * 64 + 4 * hi;
#pragma unroll
            for (int g = 0; g < 4; ++g) {
                const f32x4 w0 = *(const LAS f32x4*)(tab + 8 * g + 4 * hi), b0 = *(const LAS f32x4*)(tab + 64 + 8 * g + 4 * hi), w1 = *(const LAS f32x4*)(tab + 32 + 8 * g + 4 * hi), b1 = *(const LAS f32x4*)(tab + 96 + 8 * g + 4 * hi);
                const v2u g0 = gq[0][g], g1 = gq[1][g];
                *(v2u*)(orow + 8 * g) = (v2u){pkbf((y0[4 * g] * rstd * w0[0] + b0[0]) * bflo(g0[0]), (y0[4 * g + 1] * rstd * w0[1] + b0[1]) * bfhi(g0[0])),
                                              pkbf((y0[4 * g + 2] * rstd * w0[2] + b0[2]) * bflo(g0[1]), (y0[4 * g + 3] * rstd * w0[3] + b0[3]) * bfhi(g0[1]))};
                *(v2u*)(orow + 32 + 8 * g) = (v2u){pkbf((y1[4 * g] * rstd * w1[0] + b1[0]) * bflo(g1[0]), (y1[4 * g + 1] * rstd * w1[1] + b1[1]) * bfhi(g1[0])),
                                                   pkbf((y1[4 * g + 2] * rstd * w1[2] + b1[2]) * bflo(g1[1]), (y1[4 * g + 3] * rstd * w1[3] + b1[3]) * bfhi(g1[1]))};
            }
        }
        ret_kv(T, img);
        LDS_WAIT();
    }
}
#ifndef RETREP
#define RETREP 1
#endif
#ifndef ATTREP
#define ATTREP 1
#endif
constexpr int N_RET = BATCH * 8 * RETREP, N_ATT = BATCH * 32 * ATTREP, N_MIX = N_RET + N_ATT;
__device__ __forceinline__ void p2_mixers(Frame& F) {
    volatile LAS unsigned* misc = (volatile LAS unsigned*)(F.lds + MISC_OFF);
    for (;;) {
        __syncthreads();
        if (F.tid == 0) misc[0] = __hip_atomic_fetch_add(F.ctl, 1u, __ATOMIC_RELAXED, __HIP_MEMORY_SCOPE_AGENT);
        __syncthreads();
        const int u = (int)misc[0];
        if (u >= N_MIX) break;
        { int w_ = F.wave; asm volatile("" : "+s"(w_)); F.wave = w_; int l_ = lane_id(); asm volatile("" : "+v"(l_)); F.lane = l_; F.tid = w_ * 64 + l_; }
        if (u < N_RET) { const int ru = u / RETREP; ret_unit(F, ru >> 3, ru & 7, F.lds); }
        else { const int a = (u - N_RET) / ATTREP; attn_unit(F, a & 31, 31 - (a >> 5), F.lds); }
    }
}

typedef __attribute__((address_space(1))) unsigned gu32;
#define XB_TMO      128
#define XB_XCNT(j)  (256  + 64 * (j))
#define XB_XSUB(j)  (1280 + 64 * (j))
#define XB_XGEN(j)  (2304 + 64 * (j))
#define XB_TOP      3328
#define XB_TOPGEN   3392
#define XCD_BAR_WORDS 3456
#define XB_SPIN_CAP (1u << 18)

__device__ __forceinline__ unsigned xb_ld(unsigned* p)              { return __hip_atomic_load(p, __ATOMIC_RELAXED, __HIP_MEMORY_SCOPE_AGENT); }
__device__ __forceinline__ unsigned xb_add(unsigned* p, unsigned v) { return __hip_atomic_fetch_add(p, v, __ATOMIC_RELAXED, __HIP_MEMORY_SCOPE_AGENT); }
__device__ __forceinline__ unsigned xb_xcc_id() { return (unsigned)__builtin_amdgcn_s_getreg((3 << 11) | 20) & 0xFu; }
#define XB_SPIN(cond, bar) do { unsigned _sp = 0; while (cond) { __builtin_amdgcn_s_sleep(1); \
    if ((++_sp & 255u) == 0u) { if (xb_ld(&(bar)[XB_TMO])) break; if (_sp > XB_SPIN_CAP) { atomicAdd(&(bar)[XB_TMO], 1u); break; } } } } while (0)

struct XcdBarrier {
    unsigned* bar; unsigned x; int wv;
    volatile LAS unsigned* st;
};

__device__ __forceinline__ XcdBarrier xcd_barrier_post(unsigned* bar, volatile LAS unsigned* st, int wv_) {
    XcdBarrier b; b.bar = bar; b.x = xb_xcc_id(); b.st = st; b.wv = 0;
    if (wv_ == 0 && lane_id() == 0) (void)xb_add(&bar[XB_XCNT(b.x)], 1u);
    return b;
}
__device__ __forceinline__ void xcd_barrier_complete(unsigned* bar, unsigned x, unsigned& nloc, unsigned& nx) {
    const unsigned G = gridDim.x * gridDim.y * gridDim.z;
    unsigned sum, cnt, mine, sp = 0u;
    for (;;) {
        sum = 0u; cnt = 0u; mine = 0u;
#pragma unroll
        for (unsigned j = 0; j < 16; ++j) { const unsigned c = xb_ld(&bar[XB_XCNT(j)]); sum += c; cnt += (c > 0u) ? 1u : 0u; mine = (j == x) ? c : mine; }
        if (sum == G) break;
        __builtin_amdgcn_s_sleep(1);
        if ((++sp & 255u) == 0u) { if (xb_ld(&bar[XB_TMO])) break; if (sp > XB_SPIN_CAP) { atomicAdd(&bar[XB_TMO], 1u); break; } }
    }
    nloc = mine > 0u ? mine : 1u; nx = cnt > 0u ? cnt : 1u;
}

__device__ __forceinline__ void xcd_barrier(const XcdBarrier& b) {
    asm volatile("s_waitcnt vmcnt(0)" ::: "memory");
    __syncthreads();
    if (b.wv == 0 && lane_id() == 0) {
        unsigned* bar = b.bar;
        __builtin_amdgcn_s_waitcnt(0);
        unsigned nloc = b.st[0], nx = b.st[1];
        if (nloc == 0u) { xcd_barrier_complete(bar, b.x, nloc, nx); b.st[0] = nloc; b.st[1] = nx; }
        const unsigned old = xb_add(&bar[XB_XSUB(b.x)], 1u);
        const unsigned gen = old / nloc;
        if (old + 1u == (gen + 1u) * nloc) {
            __builtin_amdgcn_fence(__ATOMIC_RELEASE, "agent");
            asm volatile("s_waitcnt vmcnt(0)" ::: "memory");
            const unsigned og = xb_add(&bar[XB_TOP], 1u);
            const unsigned tg = og / nx;
            if (og + 1u == (tg + 1u) * nx) xb_add(&bar[XB_TOPGEN], 1u);
            else XB_SPIN(xb_ld(&bar[XB_TOPGEN]) == tg, bar);
            __builtin_amdgcn_fence(__ATOMIC_ACQUIRE, "agent");
            xb_add(&bar[XB_XGEN(b.x)], 1u);
            asm volatile("s_waitcnt vmcnt(0)" ::: "memory");
        } else {
            XB_SPIN(xb_ld(&bar[XB_XGEN(b.x)]) == gen, bar);
            __builtin_amdgcn_fence(__ATOMIC_ACQUIRE, "agent");
            asm volatile("s_waitcnt vmcnt(0)" ::: "memory");
        }
    }
    __syncthreads();
}

constexpr int CW_BAR = 4096;
constexpr size_t CTL_ZERO_BYTES = 65536;
typedef KArgs Args;
__global__ void __launch_bounds__(NTHR, 2) fwd_kernel(Args args) {
    extern __shared__ __attribute__((aligned(16))) unsigned char lds[];
    Frame F;
    F.lds = (LAS unsigned char*)lds;
    F.wave = __builtin_amdgcn_readfirstlane((int)threadIdx.x >> 6); F.lane = lane_id(); F.tid = F.wave * 64 + F.lane;
    F.G = gridDim.x; { const int bx = blockIdx.x; F.vcu = (F.G % 8 == 0) ? (bx % 8) * (F.G / 8) + bx / 8 : bx; }
    unsigned char* ws = args.ws;
    F.ctl = (unsigned*)(ws + WS_CTL);
    F.ap = (const __attribute__((address_space(4))) KArgs*)__builtin_amdgcn_kernarg_segment_ptr();
    F.ws = ws;
    const int lo = args.ph_lo, hi = args.ph_hi;
    for (int u_ = F.tid; u_ < 64; u_ += NTHR) ((LAS unsigned*)(F.lds + MISC_OFF))[u_] = 0u;
    __syncthreads();
    XcdBarrier bar; bar.bar = F.ctl + CW_BAR; bar.x = 0; bar.st = nullptr; bar.wv = F.wave;
    if (hi - lo > 1) { bar = xcd_barrier_post(F.ctl + CW_BAR, (volatile LAS unsigned*)(F.lds + MISC_OFF) + 8, F.wave); bar.wv = F.wave; }
#ifndef PHSEL
#define PHSEL 63
#endif
#define IN(k) (((PHSEL >> (k)) & 1) && lo <= (k) && (k) < hi)
#ifndef REPEAT_PHASE
#define REPEAT_PHASE -1
#endif
#define REPS(k) ((REPEAT_PHASE == (k)) ? 2 : 1)
#define SEAM(k) do { if (IN(k) && IN((k) + 1)) { if ((k) == 0 && lo < 0) cg::this_grid().sync(); else xcd_barrier(bar); } } while (0)

    for (int rep_ = 0; rep_ < REPS(0); ++rep_) { if (rep_) cg::this_grid().sync();
    if (IN(0)) { asm volatile("" : "+s"(F.ws), "+s"(F.ap)); F.lane = lane_id(); F.tid = F.wave * 64 + F.lane; p0_prologue(F); }
    }
    SEAM(0);
    for (int rep_ = 0; rep_ < REPS(1); ++rep_) { if (rep_) cg::this_grid().sync();
    if (IN(1)) { asm volatile("" : "+s"(F.ws), "+s"(F.ap)); F.lane = lane_id(); F.tid = F.wave * 64 + F.lane;
        pg8::Gemm g{F.XB(), F.WIN(), MTOK, NIN, DM}; pg8::StaticOrder S; S.init(MTOK, NIN, F.G, (int)blockIdx.x);
        pg8::EpiIn E{F.QA(), F.KA(), F.VA(), F.IQ(), F.IK(), F.QB(), F.KB(), F.VB(), F.GB(), F.IW(), F.q_norm_w(), F.k_norm_w(), F.COS(), F.SIN(), (LAS float*)(F.lds + XCH_OFF)};
        pg8::gemm_phase<pg8::EpiIn, pg8::StaticOrder, true, true>(F.lds, g, S, E, F.wave);
    }
    }
    SEAM(1);
    for (int rep_ = 0; rep_ < REPS(2); ++rep_) { if (rep_) { cg::this_grid().sync(); if (blockIdx.x == 0 && F.tid == 0) F.ctl[0] = 0u; cg::this_grid().sync(); }
    if (IN(2)) { asm volatile("" : "+s"(F.ws), "+s"(F.ap)); F.lane = lane_id(); F.tid = F.wave * 64 + F.lane; p2_mixers(F); }
    }
    SEAM(2);
    for (int rep_ = 0; rep_ < REPS(3); ++rep_) { if (rep_) cg::this_grid().sync();
    if (IN(3)) { asm volatile("" : "+s"(F.ws), "+s"(F.ap)); F.lane = lane_id(); F.tid = F.wave * 64 + F.lane;
        pg8::Gemm g{F.MIX(), F.WOUT(), MTOK, DM, DM}; pg8::PanelOrder S{(int)blockIdx.x, 4};
        pg8::EpiOut E{F.x(), F.XB(), {0.f, 0.f, 0.f, 0.f, 0.f, 0.f, 0.f, 0.f}};
        if ((int)blockIdx.x < MTOK / 256) {
            pg8::gemm_phase<pg8::EpiOut, pg8::PanelOrder, true, true>(F.lds, g, S, E, F.wave);
            const int wr = F.wave >> 2, wc = F.wave & 3, fr = F.lane & 15, fq = F.lane >> 4;
            LAS float* P = (LAS float*)(F.lds + XCH_OFF);
#pragma unroll
            for (int k = 0; k < 8; ++k) { float s = E.ss[k]; s += __shfl_xor(s, 16); s += __shfl_xor(s, 32);
                if (fq == 0) P[((k >> 2) * 128 + wr * 64 + (k & 3) * 16 + fr) * 4 + wc] = s; }
            __syncthreads();
            if (F.tid < 256) { const f32x4 p = *(const LAS f32x4*)(P + F.tid * 4);
                F.R2()[(size_t)blockIdx.x * 256 + F.tid] = 1.0f / sqrtf(((p[0] + p[1]) + (p[2] + p[3])) * (1.0f / DM) + 1e-6f); }
        }
    }
    }
    SEAM(3);
    for (int rep_ = 0; rep_ < REPS(4); ++rep_) { if (rep_) cg::this_grid().sync();
    if (IN(4)) { asm volatile("" : "+s"(F.ws), "+s"(F.ap)); F.lane = lane_id(); F.tid = F.wave * 64 + F.lane;
        pg8::Gemm g{F.XB(), F.WGU(), MTOK, NGU, DM}; pg8::StaticOrder S; S.init(MTOK, NGU, F.G, (int)blockIdx.x);
        pg8::EpiGU E{F.R2(), F.ACT(), {0.f, 0.f, 0.f, 0.f}, {0.f, 0.f, 0.f, 0.f}, {0.f, 0.f, 0.f, 0.f}, {0.f, 0.f, 0.f, 0.f}};
        pg8::gemm_phase<pg8::EpiGU, pg8::StaticOrder, true, true>(F.lds, g, S, E, F.wave);
    }
    }
    SEAM(4);
    for (int rep_ = 0; rep_ < REPS(5); ++rep_) { if (rep_) cg::this_grid().sync();
    if (IN(5)) { asm volatile("" : "+s"(F.ws), "+s"(F.ap)); F.lane = lane_id(); F.tid = F.wave * 64 + F.lane;
        pg8::Gemm g{F.ACT(), F.WDN(), MTOK, DM, FF}; pg8::StaticOrder S; S.init(MTOK, DM, F.G, (int)blockIdx.x);
        pg8::EpiDown E{F.XB(), F.out()};
        pg8::gemm_phase<pg8::EpiDown, pg8::StaticOrder, true, true>(F.lds, g, S, E, F.wave);
    }
    }
#undef IN
#undef SEAM
}

extern "C" void kernel_launch(void* const* d_in, const int* in_sizes, int n_in, void* d_out, int out_size, void* d_ws, size_t ws_size, hipStream_t stream) {
    static int grid = 0;
    if (grid == 0) {
        if (n_in != 16 || in_sizes[0] != MTOK * DM || out_size != MTOK * DM || ws_size < WS_END) {
            fprintf(stderr, "kernel_launch: unexpected problem (n_in %d, in0 %d, out %d, ws %zu); nothing launched\n", n_in, n_in > 0 ? in_sizes[0] : -1, out_size, ws_size); grid = -1; return; }
        int dev = 0, cus = 0, per_cu = 0;
        if (hipGetDevice(&dev) != hipSuccess || hipDeviceGetAttribute(&cus, hipDeviceAttributeMultiprocessorCount, dev) != hipSuccess) { grid = -1; return; }
        if (hipFuncSetAttribute((const void*)fwd_kernel, hipFuncAttributeMaxDynamicSharedMemorySize, LDS_BYTES) != hipSuccess) { fprintf(stderr, "kernel_launch: hipFuncSetAttribute failed\n"); grid = -1; return; }
        if (hipOccupancyMaxActiveBlocksPerMultiprocessor(&per_cu, (const void*)fwd_kernel, NTHR, LDS_BYTES) != hipSuccess || per_cu < 1) { fprintf(stderr, "kernel_launch: occupancy query says %d blocks per CU\n", per_cu); (void)hipGetLastError(); grid = -1; return; }
        grid = cus;
        if (grid != 256) fprintf(stderr, "kernel_launch: %d CUs; this kernel is laid out for 256\n", grid);
    }
    if (grid < 0) return;
    if (hipMemsetAsync((char*)d_ws + WS_CTL, 0, CTL_ZERO_BYTES, stream) != hipSuccess) { fprintf(stderr, "kernel_launch: memset failed\n"); return; }
    Args a{};
    for (int i = 0; i < 16; ++i) a.in[i] = (const float*)d_in[i];
    a.out = (float*)d_out; a.ws = (unsigned char*)d_ws;
#if MK_N_LAUNCHES == 1
    a.ph_lo = 0; a.ph_hi = N_PHASES;
    void* kargs[] = {&a};
    hipError_t e = hipLaunchCooperativeKernel((const void*)fwd_kernel, dim3(grid), dim3(NTHR), kargs, LDS_BYTES, stream);
    if (e != hipSuccess) fprintf(stderr, "kernel_launch: cooperative launch failed: %s (grid %d)\n", hipGetErrorString(e), grid);
#else
    for (int p = 0; p < N_PHASES; ++p) { a.ph_lo = p; a.ph_hi = p + 1; hipLaunchKernelGGL(fwd_kernel, dim3(grid), dim3(NTHR), LDS_BYTES, stream, a); }
#endif
}
```

```cpp
#include <hip/hip_runtime.h>
#include <hip/hip_cooperative_groups.h>
#include <cstdio>
#include <cstdint>
namespace cg = cooperative_groups;
namespace pg8 {
#define PG8_LAS __attribute__((address_space(3)))
typedef unsigned short bf16_t;
typedef short bf16x8 __attribute__((ext_vector_type(8)));
typedef float f32x4 __attribute__((ext_vector_type(4)));
typedef unsigned u32x4 __attribute__((ext_vector_type(4)));
constexpr int BM = 256, BK = 64, HALF = 128, HTB = HALF * BK * 2  , STAGE_BYTES = 8 * HTB, NXCD = 8, WGM = 8;

__host__ __device__ __forceinline__ int lds_byte(int r, int c) { const int st = (r >> 4) * 2 + (c >> 5), rr = r & 15, cc = c & 31, ob = rr * 64 + cc * 2; return st * 1024 + (ob ^ (((ob >> 9) & 1) << 5)); }
__host__ __device__ __forceinline__ void stage_rc(int b, int& R, int& C) { const int st = b / 1024, sb = b % 1024, swz = sb ^ (((sb >> 9) & 1) << 5); R = (st >> 1) * 16 + swz / 64; C = (st & 1) * 32 + (swz % 64) / 2; }
__host__ __device__ __forceinline__ int perm32(int rho) { const int n = rho >> 4, i = rho & 15; return 8 * (i >> 2) + 4 * n + (i & 3); }

struct Unit { int pm, pn; };
struct Gemm { const bf16_t* A; const bf16_t* Bt; int M, N, K; };

struct StaticOrder {
    int nM, nN, nwg, G, c;
    __host__ __device__ void init(int M, int N, int G_, int c_) { nM = M / BM; nN = N / BM; nwg = nM * nN; G = G_; c = c_; }
    __host__ __device__ bool next(int i, Unit& u) const {
        const long L = (long)i * G + c; if (L >= nwg) return false;
        int wgid = (int)L; { const int q = nwg / NXCD, r = nwg % NXCD, xcd = wgid % NXCD, off = wgid / NXCD; wgid = (xcd < r ? xcd * (q + 1) : r * (q + 1) + (xcd - r) * q) + off; }
        const int nig = WGM * nN, gid = wgid / nig, fm = gid * WGM, gsz = (nM - fm) < WGM ? (nM - fm) : WGM;
        u.pm = fm + ((wgid % nig) % gsz); u.pn = (wgid % nig) / gsz; return true;
    }
    __device__ __forceinline__ void a_ready(const Unit&) const {}
    __device__ __forceinline__ void done(const Unit&) const {}
};

__device__ __forceinline__ unsigned cvt_pk_bf16(float lo, float hi) { unsigned r; asm volatile("v_cvt_pk_bf16_f32 %0, %1, %2" : "=v"(r) : "v"(lo), "v"(hi)); return r; }
typedef float f32x2 __attribute__((ext_vector_type(2)));
typedef __bf16 bf16x2_t __attribute__((ext_vector_type(2)));
typedef unsigned u32x2 __attribute__((ext_vector_type(2)));
__device__ __forceinline__ unsigned pkbf(float lo, float hi) { f32x2 v = {lo, hi}; bf16x2_t b = __builtin_convertvector(v, bf16x2_t); return __builtin_bit_cast(unsigned, b); }
__device__ __forceinline__ u32x4 pk8(f32x4 a, f32x4 b) { return (u32x4){pkbf(a[0], a[1]), pkbf(a[2], a[3]), pkbf(b[0], b[1]), pkbf(b[2], b[3])}; }
__device__ __forceinline__ float dot4(f32x4 a) { return (a[0] * a[0] + a[1] * a[1]) + (a[2] * a[2] + a[3] * a[3]); }
__device__ __forceinline__ float sum4(f32x4 a) { return (a[0] + a[1]) + (a[2] + a[3]); }
__device__ __forceinline__ float silu1(float v) { return v * __builtin_amdgcn_rcpf(1.0f + __builtin_amdgcn_exp2f(-1.4426950408889634f * v)); }
__device__ __forceinline__ f32x4 silu4(f32x4 v) { return (f32x4){silu1(v[0]), silu1(v[1]), silu1(v[2]), silu1(v[3])}; }
constexpr float RMS_EPS_F = 1e-6f;
constexpr float QSCALE = 0.125f * 1.4426950408889634f;

struct EpiIn {
    static constexpr bool PERM = true, AFTER_DRAIN = false;
    bf16_t *QA, *KA, *VA, *IQ, *IK, *QB, *KB, *VB, *GB; float* IW;
    const float *qnw, *knw;
    PG8_LAS float* xch;
    __device__ __forceinline__ void prefetch(const Unit&, int, int) {}
    __device__ __forceinline__ void advance() {}
    __device__ __forceinline__ void operator()(const f32x4 (&acc)[2][2][4][2], const Unit& u, int wr, int wc, int fr, int fq) {
        asm volatile("" : "+v"(fr), "+v"(fq));
        const int row0 = u.pm * BM + wr * 64 + fr, pn = u.pn;
        if (pn < 2) {
            const int head = 4 * pn + wc;
            const f32x4 w0 = *(const f32x4*)(qnw + 8 * fq), w1 = *(const f32x4*)(qnw + 8 * fq + 4), w2 = *(const f32x4*)(qnw + 32 + 8 * fq), w3 = *(const f32x4*)(qnw + 36 + 8 * fq);
#pragma unroll
            for (int ai = 0; ai < 2; ++ai)
#pragma unroll
                for (int m = 0; m < 4; ++m) {
                    f32x4 a0 = acc[ai][0][m][0], a1 = acc[ai][0][m][1], b0 = acc[ai][1][m][0], b1 = acc[ai][1][m][1];
                    float ss = (dot4(a0) + dot4(a1)) + (dot4(b0) + dot4(b1));
                    ss += __shfl_xor(ss, 16); ss += __shfl_xor(ss, 32);
                    const float rs = QSCALE / sqrtf(ss * (1.0f / 64.0f) + RMS_EPS_F);
                    bf16_t* p = QA + (size_t)(row0 + ai * HALF + m * 16) * 512 + head * 64 + 8 * fq;
                    *(u32x4*)p = pk8(a0 * w0 * rs, a1 * w1 * rs); *(u32x4*)(p + 32) = pk8(b0 * w2 * rs, b1 * w3 * rs);
                }
        } else if (pn == 2) {
            if (wc >= 2) {
#pragma unroll
                for (int ai = 0; ai < 2; ++ai)
#pragma unroll
                    for (int m = 0; m < 4; ++m) {
                        float ss = (dot4(acc[ai][0][m][0]) + dot4(acc[ai][0][m][1])) + (dot4(acc[ai][1][m][0]) + dot4(acc[ai][1][m][1]));
                        ss += __shfl_xor(ss, 16); ss += __shfl_xor(ss, 32);
                        if (fq == 0) xch[(ai * HALF + wr * 64 + m * 16 + fr) * 2 + (wc - 2)] = ss;
                    }
            }
            asm volatile("s_waitcnt lgkmcnt(0)" ::: "memory"); __builtin_amdgcn_s_barrier(); asm volatile("" ::: "memory");
            if (wc < 2) {
                const f32x4 w0 = *(const f32x4*)(knw + 8 * fq), w1 = *(const f32x4*)(knw + 8 * fq + 4), w2 = *(const f32x4*)(knw + 32 + 8 * fq), w3 = *(const f32x4*)(knw + 36 + 8 * fq);
#pragma unroll
                for (int ai = 0; ai < 2; ++ai)
#pragma unroll
                    for (int m = 0; m < 4; ++m) {
                        const int rl = ai * HALF + wr * 64 + m * 16 + fr;
                        const f32x2 pr = *(const PG8_LAS f32x2*)(xch + rl * 2);
                        const float rc = 1.0f / sqrtf((pr[0] + pr[1]) * (1.0f / 128.0f) + RMS_EPS_F);
                        f32x4 a0 = acc[ai][0][m][0] * rc, a1 = acc[ai][0][m][1] * rc, b0 = acc[ai][1][m][0] * rc, b1 = acc[ai][1][m][1] * rc;
                        const size_t row = (size_t)(row0 + ai * HALF + m * 16);
                        if (wc == 0) {
                            float ss = (dot4(a0) + dot4(a1)) + (dot4(b0) + dot4(b1));
                            ss += __shfl_xor(ss, 16); ss += __shfl_xor(ss, 32);
                            const float rs = 1.0f / sqrtf(ss * (1.0f / 64.0f) + RMS_EPS_F);
                            bf16_t* p = KA + row * 64 + 8 * fq;
                            *(u32x4*)p = pk8(a0 * w0 * rs, a1 * w1 * rs); *(u32x4*)(p + 32) = pk8(b0 * w2 * rs, b1 * w3 * rs);
                        } else {
                            bf16_t* p = VA + row * 64 + 8 * fq;
                            *(u32x4*)p = pk8(a0, a1); *(u32x4*)(p + 32) = pk8(b0, b1);
                        }
                    }
            }
        } else if (pn == 3) {
#pragma unroll
            for (int ai = 0; ai < 2; ++ai)
#pragma unroll
                for (int m = 0; m < 4; ++m) {
                    const size_t row = (size_t)(row0 + ai * HALF + m * 16);
                    *(u32x4*)(IQ + row * 128 + 32 * wc + 8 * fq) = pk8(acc[ai][0][m][0], acc[ai][0][m][1]);
                    if (wc == 0) *(u32x4*)(IK + row * 32 + 8 * fq) = pk8(acc[ai][1][m][0], acc[ai][1][m][1]);
                    if (wc == 1 && fq == 0) *(f32x4*)(IW + row * 4) = acc[ai][1][m][0];
                }
        } else if (pn < 8) {
            const int head = 4 * (pn & 1) + wc; bf16_t* dst = pn < 6 ? QB : KB;
            const float lg2 = __log2f(1.0f - __builtin_amdgcn_exp2f(-5.0f - (float)head));
            f32x4 iv0, iv1;
#pragma unroll
            for (int i = 0; i < 4; ++i) { iv0[i] = __builtin_amdgcn_exp2f(-(float)(8 * fq + i) * (13.287712379549449f / 32.0f)) * 0.15915494309189535f; iv1[i] = __builtin_amdgcn_exp2f(-(float)(8 * fq + 4 + i) * (13.287712379549449f / 32.0f)) * 0.15915494309189535f; }
#pragma unroll
            for (int ai = 0; ai < 2; ++ai)
#pragma unroll
                for (int m = 0; m < 4; ++m) {
                    const int row = row0 + ai * HALF + m * 16, pos = row & 2047; const float fp = (float)pos;
                    const float sc = pn < 6 ? __builtin_amdgcn_exp2f((float)(pos & 63) * lg2) : 0.125f * __builtin_amdgcn_exp2f(-(float)(pos & 63) * lg2);
                    f32x4 c0, c1, s0, s1;
#pragma unroll
                    for (int i = 0; i < 4; ++i) {
                        const float r0 = __builtin_amdgcn_fractf(fp * iv0[i]), r1 = __builtin_amdgcn_fractf(fp * iv1[i]);
                        c0[i] = __builtin_amdgcn_cosf(r0) * sc; s0[i] = __builtin_amdgcn_sinf(r0) * sc; c1[i] = __builtin_amdgcn_cosf(r1) * sc; s1[i] = __builtin_amdgcn_sinf(r1) * sc;
                    }
                    const f32x4 a0 = acc[ai][0][m][0], a1 = acc[ai][0][m][1], b0 = acc[ai][1][m][0], b1 = acc[ai][1][m][1];
                    bf16_t* p = dst + (size_t)row * 512 + head * 64 + 8 * fq;
                    *(u32x4*)p = pk8(a0 * c0 - b0 * s0, a1 * c1 - b1 * s1); *(u32x4*)(p + 32) = pk8(a0 * s0 + b0 * c0, a1 * s1 + b1 * c1);
                }
        } else {
            const int head = 4 * (pn & 1) + wc; bf16_t* dst = pn < 10 ? VB : GB; const bool act = pn >= 10;
#pragma unroll
            for (int ai = 0; ai < 2; ++ai)
#pragma unroll
                for (int m = 0; m < 4; ++m) {
                    f32x4 a0 = acc[ai][0][m][0], a1 = acc[ai][0][m][1], b0 = acc[ai][1][m][0], b1 = acc[ai][1][m][1];
                    if (act) { a0 = silu4(a0); a1 = silu4(a1); b0 = silu4(b0); b1 = silu4(b1); }
                    bf16_t* p = dst + (size_t)(row0 + ai * HALF + m * 16) * 512 + head * 64 + 8 * fq;
                    *(u32x4*)p = pk8(a0, a1); *(u32x4*)(p + 32) = pk8(b0, b1);
                }
        }
    }
};

struct EpiOut {
    static constexpr bool PERM = true, AFTER_DRAIN = false;
    const float* rms; bf16_t* x1b; float ss[8];
    __device__ __forceinline__ void prefetch(const Unit&, int, int) {}
    __device__ __forceinline__ void advance() {}
    __device__ __forceinline__ void operator()(const f32x4 (&acc)[2][2][4][2], const Unit& u, int wr, int wc, int fr, int fq) {
        asm volatile("" : "+v"(fr), "+v"(fq));
        const int row0 = u.pm * BM + wr * 64 + fr, col0 = u.pn * BM + wc * 32 + 8 * fq;
#pragma unroll
        for (int ai = 0; ai < 2; ++ai)
#pragma unroll
            for (int m = 0; m < 4; ++m) {
                const int row = row0 + ai * HALF + m * 16; const size_t off = (size_t)row * 1024 + col0; const float rm = rms[row]; float s = 0.f;
#pragma unroll
                for (int bj = 0; bj < 2; ++bj) {
                    const u32x4 xv = *(const u32x4*)(x1b + off + bj * HALF);
                    const f32x4 x0 = {__uint_as_float(xv[0] << 16), __uint_as_float(xv[0] & 0xffff0000u), __uint_as_float(xv[1] << 16), __uint_as_float(xv[1] & 0xffff0000u)};
                    const f32x4 x1 = {__uint_as_float(xv[2] << 16), __uint_as_float(xv[2] & 0xffff0000u), __uint_as_float(xv[3] << 16), __uint_as_float(xv[3] & 0xffff0000u)};
                    const f32x4 r0 = x0 * rm + acc[ai][bj][m][0], r1 = x1 * rm + acc[ai][bj][m][1];
                    *(u32x4*)(x1b + off + bj * HALF) = pk8(r0, r1);
                    s += dot4(r0) + dot4(r1);
                }
                ss[ai * 4 + m] += s;
            }
    }
};

struct EpiGU {
    static constexpr bool PERM = true, AFTER_DRAIN = false;
    const float* r2; bf16_t* act; f32x4 rc0, rc1, rn0, rn1;
    __device__ __forceinline__ void prefetch(const Unit& u, int wr, int fr) {
        const float* p = r2 + u.pm * BM + wr * 64 + fr;
        rn0 = (f32x4){p[0], p[16], p[32], p[48]}; rn1 = (f32x4){p[HALF], p[HALF + 16], p[HALF + 32], p[HALF + 48]};
    }
    __device__ __forceinline__ void advance() { rc0 = rn0; rc1 = rn1; }
    __device__ __forceinline__ void operator()(const f32x4 (&acc)[2][2][4][2], const Unit& u, int wr, int wc, int fr, int fq) {
        asm volatile("" : "+v"(fr), "+v"(fq));
        const int row0 = u.pm * BM + wr * 64 + fr, col0 = u.pn * HALF + wc * 32 + 8 * fq;
#pragma unroll
        for (int ai = 0; ai < 2; ++ai)
#pragma unroll
            for (int m = 0; m < 4; ++m) {
                const int row = row0 + ai * HALF + m * 16; const float rr = ai ? rc1[m] : rc0[m];
                const f32x4 g0 = acc[ai][0][m][0] * rr, g1 = acc[ai][0][m][1] * rr, u0 = acc[ai][1][m][0] * rr, u1 = acc[ai][1][m][1] * rr;
                *(u32x4*)(act + (size_t)row * 2816 + col0) = pk8(silu4(g0) * u0, silu4(g1) * u1);
            }
    }
};

struct EpiDown {
    static constexpr bool PERM = true, AFTER_DRAIN = false;
    const bf16_t* x1b; float* out;
    __device__ __forceinline__ void prefetch(const Unit&, int, int) {}
    __device__ __forceinline__ void advance() {}
    __device__ __forceinline__ void operator()(const f32x4 (&acc)[2][2][4][2], const Unit& u, int wr, int wc, int fr, int fq) {
        asm volatile("" : "+v"(fr), "+v"(fq));
        const int row0 = u.pm * BM + wr * 64 + fr, col0 = u.pn * BM + wc * 32 + 8 * fq;
#pragma unroll
        for (int ai = 0; ai < 2; ++ai)
#pragma unroll
            for (int m = 0; m < 4; ++m) {
                const size_t off = (size_t)(row0 + ai * HALF + m * 16) * 1024 + col0;
#pragma unroll
                for (int bj = 0; bj < 2; ++bj) {
                    const u32x4 xv = *(const u32x4*)(x1b + off + bj * HALF);
                    const f32x4 x0 = {__uint_as_float(xv[0] << 16), __uint_as_float(xv[0] & 0xffff0000u), __uint_as_float(xv[1] << 16), __uint_as_float(xv[1] & 0xffff0000u)};
                    const f32x4 x1 = {__uint_as_float(xv[2] << 16), __uint_as_float(xv[2] & 0xffff0000u), __uint_as_float(xv[3] << 16), __uint_as_float(xv[3] & 0xffff0000u)};
                    *(f32x4*)(out + off + bj * HALF) = x0 + acc[ai][bj][m][0]; *(f32x4*)(out + off + bj * HALF + 4) = x1 + acc[ai][bj][m][1];
                }
            }
    }
};

struct PanelOrder {
    int pm, ntn;
    __device__ __forceinline__ bool next(int i, Unit& u) const { if (i >= ntn) return false; u.pm = pm; u.pn = i; return true; }
    __device__ __forceinline__ void a_ready(const Unit&) const {}
    __device__ __forceinline__ void done(const Unit&) const {}
};

template <class Epi, class Sched, bool ALIGN_EPI = false, bool SP2 = false>
__device__ __forceinline__ void gemm_phase(PG8_LAS unsigned char* lds, const Gemm g, const Sched& S, Epi& E, int wave_in) {
    unsigned ones_ = ~0u; asm volatile("" : "+s"(ones_)); int tid_ = wave_in * 64 + (int)__builtin_amdgcn_mbcnt_hi(ones_, __builtin_amdgcn_mbcnt_lo(ones_, 0u));
    const int tid = tid_, wid = __builtin_amdgcn_readfirstlane(tid >> 6), lane = tid & 63, wr = wid >> 2, wc = wid & 3, fr = lane & 15, fq = lane >> 4;
    const int K = g.K, nt = K / BK;
    unsigned voffA[2], voffB[2];
#pragma unroll
    for (int i = 0; i < 2; ++i) { int R, C; stage_rc(tid * 16 + i * 8192, R, C); const int Rb = Epi::PERM ? ((R & ~31) + perm32(R & 31)) : R;
        voffA[i] = (unsigned)(R * K + C) * 2u; voffB[i] = (unsigned)(Rb * K + C) * 2u; }
    const size_t kstep = (size_t)(BK * 2);
    const size_t hstep = (size_t)HALF * K * 2;
    const size_t tstep = 2 * hstep;
    const unsigned ldsw = (unsigned)wid * 1024u;
    const int aoff = lds_byte(wr * 64 + fr, fq * 8), boff = lds_byte(wc * 32 + fr, fq * 8);
#define PG8_SA(b, h) (((b) * 2 + (h)) * HTB)
#define PG8_SB(b, h) ((4 + (b) * 2 + (h)) * HTB)
#define PG8_STAGE(bufoff, gbase, voff) do { _Pragma("unroll") for (int _i = 0; _i < 2; ++_i) \
        __builtin_amdgcn_global_load_lds((const unsigned*)((const char*)(gbase) + (voff)[_i]), (PG8_LAS unsigned*)(lds + (bufoff) + ldsw + _i * 8192), 16, 0, 0); } while (0)
#define PG8_LDA(dst, b, h) do { _Pragma("unroll") for (int m = 0; m < 4; ++m) _Pragma("unroll") for (int k = 0; k < 2; ++k) dst[m][k] = *(const PG8_LAS bf16x8*)(lds + PG8_SA(b, h) + aoff + m * 2048 + k * 1024); } while (0)
#define PG8_LDB(dst, b, h) do { _Pragma("unroll") for (int n = 0; n < 2; ++n) _Pragma("unroll") for (int k = 0; k < 2; ++k) dst[n][k] = *(const PG8_LAS bf16x8*)(lds + PG8_SB(b, h) + boff + n * 2048 + k * 1024); } while (0)
#define PG8_MMA(ai, bj, At, Bt) do { __builtin_amdgcn_s_setprio(1); _Pragma("unroll") for (int m = 0; m < 4; ++m) _Pragma("unroll") for (int n = 0; n < 2; ++n) _Pragma("unroll") for (int k = 0; k < 2; ++k) \
        acc[ai][bj][m][n] = __builtin_amdgcn_mfma_f32_16x16x32_bf16(Bt[n][k], At[m][k], acc[ai][bj][m][n], 0, 0, 0); __builtin_amdgcn_s_setprio(0); } while (0)
#define PG8_WAIT_V(n) asm volatile("s_waitcnt vmcnt(" #n ")" ::: "memory")
#define PG8_WAIT_L(n) asm volatile("s_waitcnt lgkmcnt(" #n ")" ::: "memory")
#define PG8_BAR __builtin_amdgcn_s_barrier()
#define PG8_SCHED __builtin_amdgcn_sched_barrier(0)
    Unit cur, nxt; int ui = 0;
    if (!S.next(0, cur)) return;
    E.prefetch(cur, wr, fr); E.advance();
    f32x4 acc[2][2][4][2];
#pragma unroll
    for (int a = 0; a < 2; ++a)
#pragma unroll
        for (int b = 0; b < 2; ++b)
#pragma unroll
            for (int m = 0; m < 4; ++m)
#pragma unroll
                for (int n = 0; n < 2; ++n) acc[a][b][m][n] = (f32x4){0.f, 0.f, 0.f, 0.f};
    bf16x8 At[4][2], B0[2][2], B1[2][2];
    const char* cA = (const char*)g.A + (size_t)cur.pm * tstep; const char* cB = (const char*)g.Bt + (size_t)cur.pn * tstep;
    S.a_ready(cur);
    if constexpr (SP2) {
        PG8_STAGE(PG8_SB(0, 0), cB, voffB); PG8_STAGE(PG8_SB(0, 1), cB + hstep, voffB); PG8_STAGE(PG8_SA(0, 0), cA, voffA); PG8_STAGE(PG8_SA(0, 1), cA + hstep, voffA);
        if (wr == 1) PG8_BAR;
        PG8_WAIT_V(2); PG8_BAR;
        PG8_STAGE(PG8_SB(1, 0), cB + kstep, voffB); PG8_STAGE(PG8_SA(1, 0), cA + kstep, voffA); PG8_STAGE(PG8_SB(1, 1), cB + hstep + kstep, voffB);
        PG8_WAIT_V(6); PG8_BAR;
    } else {
        PG8_STAGE(PG8_SB(0, 0), cB, voffB); PG8_STAGE(PG8_SA(0, 0), cA, voffA); PG8_STAGE(PG8_SB(0, 1), cB + hstep, voffB); PG8_STAGE(PG8_SA(0, 1), cA + hstep, voffA);
        if (wr == 1) PG8_BAR;
        PG8_WAIT_V(4); PG8_BAR;
        PG8_STAGE(PG8_SB(1, 0), cB + kstep, voffB); PG8_STAGE(PG8_SA(1, 0), cA + kstep, voffA); PG8_STAGE(PG8_SB(1, 1), cB + hstep + kstep, voffB);
        PG8_WAIT_V(6); PG8_BAR;
    }
    for (;;) {
        const bool has_next = S.next(ui + 1, nxt);
        const char* nA = has_next ? (const char*)g.A + (size_t)nxt.pm * tstep : cA; const char* nB = has_next ? (const char*)g.Bt + (size_t)nxt.pn * tstep : cB;
        for (int t = 0; t < nt; t += 2) {
            const bool last = (t == nt - 2);
            const char* a1 = cA + (size_t)(t + 1) * kstep;
            const char* a2 = last ? nA : cA + (size_t)(t + 2) * kstep; const char* b2 = last ? nB : cB + (size_t)(t + 2) * kstep;
            const char* a3 = a2 + kstep; const char* b3 = b2 + kstep;
            if (last && has_next) { S.a_ready(nxt); E.prefetch(nxt, wr, fr); }
            if constexpr (SP2) {
            PG8_LDB(B0, 0, 0); PG8_LDB(B1, 0, 1); PG8_SCHED; PG8_LDA(At, 0, 0); PG8_STAGE(PG8_SA(1, 1), a1 + hstep, voffA);
            PG8_WAIT_V(8); PG8_WAIT_L(0); PG8_BAR; PG8_MMA(0, 0, At, B0); PG8_MMA(0, 1, At, B1); PG8_BAR; PG8_SCHED;
            PG8_LDA(At, 0, 1); PG8_STAGE(PG8_SB(0, 0), b2, voffB); PG8_STAGE(PG8_SB(0, 1), b2 + hstep, voffB); PG8_STAGE(PG8_SA(0, 0), a2, voffA);
            PG8_WAIT_V(8); PG8_WAIT_L(0); PG8_BAR; PG8_MMA(1, 0, At, B0); PG8_MMA(1, 1, At, B1); PG8_BAR; PG8_SCHED;
            PG8_LDB(B0, 1, 0); PG8_LDB(B1, 1, 1); PG8_SCHED; PG8_LDA(At, 1, 0); PG8_STAGE(PG8_SA(0, 1), a2 + hstep, voffA);
            PG8_WAIT_V(8); PG8_WAIT_L(0); PG8_BAR; PG8_MMA(0, 0, At, B0); PG8_MMA(0, 1, At, B1); PG8_BAR; PG8_SCHED;
            PG8_LDA(At, 1, 1); PG8_STAGE(PG8_SB(1, 0), b3, voffB); PG8_STAGE(PG8_SB(1, 1), b3 + hstep, voffB); PG8_STAGE(PG8_SA(1, 0), a3, voffA);
            PG8_WAIT_V(8); PG8_WAIT_L(0); PG8_BAR; PG8_MMA(1, 0, At, B0); PG8_MMA(1, 1, At, B1); PG8_BAR; PG8_SCHED;
            } else {
            PG8_LDB(B0, 0, 0); PG8_SCHED; PG8_LDA(At, 0, 0); PG8_STAGE(PG8_SA(1, 1), a1 + hstep, voffA);
            PG8_WAIT_L(8); PG8_BAR; PG8_WAIT_L(0); PG8_MMA(0, 0, At, B0); PG8_BAR; PG8_SCHED;
            PG8_LDB(B1, 0, 1); PG8_STAGE(PG8_SB(0, 0), b2, voffB);
            PG8_BAR; PG8_WAIT_L(0); PG8_MMA(0, 1, At, B1); PG8_BAR;
            PG8_LDA(At, 0, 1); PG8_STAGE(PG8_SA(0, 0), a2, voffA);
            PG8_BAR; PG8_WAIT_L(0); PG8_MMA(1, 0, At, B0); PG8_BAR; PG8_SCHED;
            PG8_STAGE(PG8_SB(0, 1), b2 + hstep, voffB);
            PG8_WAIT_V(6); PG8_BAR; PG8_MMA(1, 1, At, B1); PG8_BAR;
            PG8_LDB(B0, 1, 0); PG8_SCHED; PG8_LDA(At, 1, 0); PG8_STAGE(PG8_SA(0, 1), a2 + hstep, voffA);
            PG8_WAIT_L(8); PG8_BAR; PG8_WAIT_L(0); PG8_MMA(0, 0, At, B0); PG8_BAR; PG8_SCHED;
            PG8_LDB(B1, 1, 1); PG8_STAGE(PG8_SB(1, 0), b3, voffB);
            PG8_BAR; PG8_WAIT_L(0); PG8_MMA(0, 1, At, B1); PG8_BAR;
            PG8_LDA(At, 1, 1); PG8_STAGE(PG8_SA(1, 0), a3, voffA);
            PG8_BAR; PG8_WAIT_L(0); PG8_MMA(1, 0, At, B0); PG8_BAR; PG8_SCHED;
            PG8_STAGE(PG8_SB(1, 1), b3 + hstep, voffB);
            PG8_WAIT_V(6); PG8_BAR; PG8_MMA(1, 1, At, B1); PG8_BAR;
            }
        }
        if constexpr (ALIGN_EPI) { if (wr == 0) PG8_BAR; }
        if constexpr (!Epi::AFTER_DRAIN) { E(acc, cur, wr, wc, fr, fq); E.advance(); S.done(cur); }
        if (!has_next) break;
#pragma unroll
        for (int a = 0; a < 2; ++a)
#pragma unroll
            for (int b = 0; b < 2; ++b)
#pragma unroll
                for (int m = 0; m < 4; ++m)
#pragma unroll
                    for (int n = 0; n < 2; ++n) acc[a][b][m][n] = (f32x4){0.f, 0.f, 0.f, 0.f};
        cur = nxt; cA = nA; cB = nB; ++ui;
        if constexpr (ALIGN_EPI) { if (wr == 1) PG8_BAR; }
    }
    PG8_WAIT_V(0);
    if constexpr (!ALIGN_EPI) { if (wr == 0) PG8_BAR; }
    PG8_BAR;
    (void)lane;
#undef PG8_SA
#undef PG8_SB
#undef PG8_STAGE
#undef PG8_LDA
#undef PG8_LDB
#undef PG8_MMA
#undef PG8_WAIT_V
#undef PG8_WAIT_L
#undef PG8_BAR
#undef PG8_SCHED
}
}

constexpr int BATCH = 32, SEQ = 2048, DM = 1024, MTOK = BATCH * SEQ;
constexpr int INW = 2852, NIN = 3072, FF = 2816, NGU = 2 * FF;
constexpr int NWAVES = 8, NTHR = 512;
#ifndef MK_N_LAUNCHES
#define MK_N_LAUNCHES 1
#endif
constexpr int N_PHASES = 6;
constexpr size_t MiB = 1u << 20;
constexpr size_t WS_CTL = 0;
constexpr size_t WS_COS = 1 * MiB, WS_SIN = WS_COS + 256 * 1024;
constexpr size_t WS_BT = WS_SIN + 256 * 1024;
constexpr size_t WS_R2 = 2 * MiB, WS_RMS = 2 * MiB + 512 * 1024;
constexpr size_t WS_WIN = 4 * MiB, WS_WOUT = 10 * MiB, WS_WGU = 12 * MiB, WS_WDN = 23 * MiB;
constexpr size_t WS_XB = 32 * MiB;
constexpr size_t WS_MIX = 160 * MiB;
constexpr size_t WS_QA = 288 * MiB, WS_QB = 352 * MiB, WS_KB = 416 * MiB, WS_VB = 480 * MiB, WS_GB = 544 * MiB;
constexpr size_t WS_KA = 608 * MiB, WS_VA = 616 * MiB;
constexpr size_t WS_IQ = 624 * MiB;
constexpr size_t WS_ACT = 288 * MiB;
constexpr size_t WS_IK = 640 * MiB, WS_IW = 644 * MiB;
constexpr size_t WS_MASK = 648 * MiB;
constexpr size_t WS_SCR = 672 * MiB;
constexpr size_t WS_END = 800 * MiB;
static_assert(WS_ACT + (size_t)MTOK * FF * 2 <= WS_IK && WS_IQ + (size_t)MTOK * 128 * 2 <= WS_IK && WS_WDN + (size_t)DM * FF * 2 <= WS_XB && WS_WGU + (size_t)NGU * DM * 2 <= WS_WDN, "d_ws map");
constexpr int RING_BYTES = 131072;
constexpr int XCH_OFF = RING_BYTES;
constexpr int P2_SC = 0, SCW = 2052;
constexpr int P2_MASK = 132096;
constexpr int MISC_OFF = 163584;
constexpr int LDS_BYTES = 163840;
static_assert(P2_SC + 16 * SCW * 4 <= P2_MASK && P2_MASK + 16384 <= MISC_OFF, "P2 LDS map");

#define LAS __attribute__((address_space(3)))
typedef unsigned short bf16;
typedef unsigned v4u __attribute__((ext_vector_type(4)));
typedef unsigned v2u __attribute__((ext_vector_type(2)));
typedef float f32x4 __attribute__((ext_vector_type(4)));
typedef float f32x16 __attribute__((ext_vector_type(16)));
typedef short bf16x8 __attribute__((ext_vector_type(8)));
typedef short s16x4 __attribute__((ext_vector_type(4)));
#define LDS_WAIT() asm volatile("s_waitcnt lgkmcnt(0)" ::: "memory")
using pg8::pkbf;
__device__ __forceinline__ float bf2f(unsigned short h) { return __uint_as_float((unsigned)h << 16); }
__device__ __forceinline__ float bflo(unsigned w) { return __uint_as_float(w << 16); }
__device__ __forceinline__ float bfhi(unsigned w) { return __uint_as_float(w & 0xffff0000u); }
__device__ __forceinline__ float wave_sum(float v) {
#pragma unroll
    for (int o = 1; o < 64; o <<= 1) v += __shfl_xor(v, o);
    return v;
}
__device__ __forceinline__ s16x4 vtr(const LAS unsigned char* p) { return __builtin_bit_cast(s16x4, __builtin_amdgcn_ds_read_tr16_b64_v4i16((LAS s16x4*)p)); }
__device__ __forceinline__ bf16x8 cat8(s16x4 lo, s16x4 hi) { return (bf16x8){lo[0], lo[1], lo[2], lo[3], hi[0], hi[1], hi[2], hi[3]}; }
__device__ __forceinline__ int crow(int r, int hi) { return (r & 3) + 8 * (r >> 2) + 4 * hi; }

__device__ __forceinline__ int lane_id() { unsigned ones = ~0u; asm volatile("" : "+s"(ones)); return (int)__builtin_amdgcn_mbcnt_hi(ones, __builtin_amdgcn_mbcnt_lo(ones, 0u)); }
struct KArgs { const float* in[16]; float* out; unsigned char* ws; int ph_lo, ph_hi; };
struct Frame {
    LAS unsigned char* lds;
    unsigned* ctl;
    unsigned char* ws;
    int tid, lane, wave, vcu, G;
    const __attribute__((address_space(4))) KArgs* ap;
    __device__ __forceinline__ const float* x() const { return ap->in[0]; }
    __device__ __forceinline__ const float* norm1_w() const { return ap->in[1]; }
    __device__ __forceinline__ const float* w_in() const { return ap->in[2]; }
    __device__ __forceinline__ const float* q_norm_w() const { return ap->in[3]; }
    __device__ __forceinline__ const float* k_norm_w() const { return ap->in[4]; }
    __device__ __forceinline__ const float* kv_norm_w() const { return ap->in[5]; }
    __device__ __forceinline__ const float* w_uk() const { return ap->in[6]; }
    __device__ __forceinline__ const float* w_uv() const { return ap->in[7]; }
    __device__ __forceinline__ const float* rel_bias() const { return ap->in[8]; }
    __device__ __forceinline__ const float* ret_gn_w() const { return ap->in[9]; }
    __device__ __forceinline__ const float* ret_gn_b() const { return ap->in[10]; }
    __device__ __forceinline__ const float* w_out() const { return ap->in[11]; }
    __device__ __forceinline__ const float* norm2_w() const { return ap->in[12]; }
    __device__ __forceinline__ const float* w_gate() const { return ap->in[13]; }
    __device__ __forceinline__ const float* w_up() const { return ap->in[14]; }
    __device__ __forceinline__ const float* w_down() const { return ap->in[15]; }
    __device__ __forceinline__ float* out() const { return ap->out; }
#define WSB_(name, off) __device__ __forceinline__ bf16* name() const { return (bf16*)(ws + (off)); }
#define WSF_(name, off) __device__ __forceinline__ float* name() const { return (float*)(ws + (off)); }
    WSB_(WIN, WS_WIN) WSB_(WOUT, WS_WOUT) WSB_(WGU, WS_WGU) WSB_(WDN, WS_WDN) WSB_(XB, WS_XB) WSB_(MIX, WS_MIX) WSB_(QA, WS_QA) WSB_(QB, WS_QB) WSB_(KB, WS_KB) WSB_(VB, WS_VB) WSB_(GB, WS_GB)
    WSB_(KA, WS_KA) WSB_(VA, WS_VA) WSB_(IQ, WS_IQ) WSB_(IK, WS_IK) WSB_(ACT, WS_ACT)
    WSF_(IW, WS_IW) WSF_(R2, WS_R2) WSF_(RMS, WS_RMS) WSF_(COS, WS_COS) WSF_(SIN, WS_SIN) WSF_(BT, WS_BT) WSF_(SCR, WS_SCR)
    __device__ __forceinline__ unsigned long long* MASK() const { return (unsigned long long*)(ws + WS_MASK); }
#undef WSB_
#undef WSF_
};

__device__ __forceinline__ int zcol(int n) {
    const int pn = n >> 8, tc = n & 255, bj = tc >> 7, wc = (tc >> 5) & 3, j = tc & 31, d = bj * 32 + j;
    if (pn < 2) return (4 * pn + wc) * 64 + d;
    if (pn == 2) { if (wc == 0) return -2 - d; if (wc == 1) return -2 - (64 + d); return 512 + (wc - 2) * 64 + d; }
    if (pn == 3) { if (bj == 0) return 640 + wc * 32 + j; if (wc == 0) return 768 + j; if (wc == 1 && j < 4) return 800 + j; return -1; }
    const int g = (pn - 4) >> 1, head = 4 * ((pn - 4) & 1) + wc;
    return 804 + g * 512 + head * 64 + d;
}
template <class SRC>
__device__ __forceinline__ void tr_item(SRC src, int Kdim, bf16* WT, int k0, int n0, LAS float* scr, int lane) {
#pragma unroll 4
    for (int i = 0; i < 32; ++i) { const int kk = 2 * i + (lane >> 5); scr[kk * 33 + (lane & 31)] = src(k0 + kk); }
    LDS_WAIT(); asm volatile("" ::: "memory");
    const int c = lane & 7;
#pragma unroll
    for (int j = 0; j < 4; ++j) { const int n = (lane >> 3) + 8 * j; const LAS float* s = scr + (8 * c) * 33 + n;
        v4u o; o.x = pkbf(s[0 * 33], s[1 * 33]); o.y = pkbf(s[2 * 33], s[3 * 33]); o.z = pkbf(s[4 * 33], s[5 * 33]); o.w = pkbf(s[6 * 33], s[7 * 33]);
        *(v4u*)(WT + (size_t)(n0 + n) * Kdim + k0 + 8 * c) = o; }
    LDS_WAIT(); asm volatile("" ::: "memory");
}
__device__ __forceinline__ int t5_bucket(int rel) {
    const int n = rel < 0 ? -rel : rel; int b;
    if (n < 8) b = n; else if (n < 12) b = 8; else if (n < 16) b = 9; else if (n < 23) b = 10; else if (n < 32) b = 11; else if (n < 46) b = 12; else if (n < 64) b = 13; else if (n < 91) b = 14; else b = 15;
    return (rel > 0 ? 16 : 0) + b;
}
__device__ __forceinline__ void p0_prologue(Frame& F) {
    LAS float* scr = (LAS float*)(F.lds + F.wave * 16384);
    const int lane = F.lane, gw = F.vcu * NWAVES + F.wave, NGW = F.G * NWAVES;
    if (blockIdx.x == 0 && F.tid == 0) F.ctl[0] = 0u;
    constexpr int I_IN = 16 * (NIN / 32), I_OUT = 16 * 32, I_GU = 16 * (NGU / 32), I_DN = (FF / 64) * 32, NITEMS = I_IN + I_OUT + I_GU + I_DN;
    auto do_item = [&](int it) {
        int r = it;
        if (r < I_IN) {
            const int kb = r / (NIN / 32), nb = r % (NIN / 32), f = zcol(32 * nb + (lane & 31));
            const float* w_in = F.w_in(); const float* nw = F.norm1_w();
            if (f >= -1) tr_item([&](int k) { return f >= 0 ? nw[k] * w_in[(size_t)k * INW + f] : 0.0f; }, DM, F.WIN(), 64 * kb, 32 * nb, scr, lane);
            return;
        }
        r -= I_IN;
        if (r < I_OUT) { const int kb = r / 32, nb = r % 32; const float* w = F.w_out() + 32 * nb + (lane & 31);
            tr_item([&](int k) { return w[(size_t)k * DM]; }, DM, F.WOUT(), 64 * kb, 32 * nb, scr, lane); return; }
        r -= I_OUT;
        if (r < I_GU) { const int kb = r / (NGU / 32), nb = r % (NGU / 32), n = 32 * nb + (lane & 31), pn = n >> 8, tc = n & 255;
            const float* w = ((tc >> 7) ? F.w_up() : F.w_gate()) + 128 * pn + (tc & 127); const float* nw = F.norm2_w();
            tr_item([&](int k) { return nw[k] * w[(size_t)k * FF]; }, DM, F.WGU(), 64 * kb, 32 * nb, scr, lane); return; }
        r -= I_GU;
        { const int kb = r / 32, nb = r % 32; const float* w = F.w_down() + 32 * nb + (lane & 31);
            tr_item([&](int k) { return w[(size_t)k * DM]; }, FF, F.WDN(), 64 * kb, 32 * nb, scr, lane); }
    };
    for (int e = F.vcu * NTHR + F.tid; e < DM * 128; e += F.G * NTHR) {
        const int k = e >> 7, idx = e & 127, d = idx & 63; const float* wu = (idx < 64 ? F.w_uk() : F.w_uv()) + d; const float* wr_ = F.w_in() + (size_t)k * INW + 512; float a = 0.f;
#pragma unroll 8
        for (int j = 0; j < 128; ++j) a += wr_[j] * F.kv_norm_w()[j] * wu[j * 64];
        const int n = 512 + (idx < 64 ? 0 : 32) + (d < 32 ? d : 128 + d - 32);
        F.WIN()[(size_t)n * DM + k] = (bf16)(pkbf(F.norm1_w()[k] * a, 0.f) & 0xffffu);
    }
    int it = gw, kk = 0;
    for (int m = gw; m < MTOK; m += NGW, ++kk) {
        const f32x4* xr = (const f32x4*)(F.x() + (size_t)m * DM) + lane;
        f32x4 v[4]; float sq = 0.f;
#pragma unroll
        for (int j = 0; j < 4; ++j) { v[j] = xr[64 * j]; sq += pg8::dot4(v[j]); }
        const float ms = wave_sum(sq) * (1.0f / DM) + 1e-6f, rr = 1.0f / sqrtf(ms);
        v2u* o8 = (v2u*)(F.XB() + (size_t)m * DM) + lane;
#pragma unroll
        for (int j = 0; j < 4; ++j) o8[64 * j] = (v2u){pkbf(v[j][0] * rr, v[j][1] * rr), pkbf(v[j][2] * rr, v[j][3] * rr)};
        if (lane == 0) F.RMS()[m] = sqrtf(ms);
        if ((kk & 7) == 3 && it < NITEMS) { do_item(it); it += NGW; }
    }
    for (; it < NITEMS; it += NGW) do_item(it);
    const int gt = F.vcu * NTHR + F.tid, NGT = F.G * NTHR;
    for (int i = gt; i < 8 * 256; i += NGT) { const int h = i >> 8, rel = (i & 255) - 191;
        F.BT()[i] = (F.rel_bias()[t5_bucket(rel) * 8 + h] - F.rel_bias()[15 * 8 + h]) * 1.4426950408889634f; }
}

#ifndef PLANES
#define PLANES 1
#endif
#ifndef MIXREP
#define MIXREP 0
#endif
typedef float f32x4_t __attribute__((ext_vector_type(4)));
typedef float f32x2v __attribute__((ext_vector_type(2)));
__device__ __forceinline__ void idx_round(const Frame& F, int b, int c, int rq, LAS unsigned char* lds) {
    const int w = F.wave, lane = F.lane, q = lane & 15, g = lane >> 4;
    const size_t rowq = (size_t)b * SEQ + 64 * c + 16 * rq + q;
    bf16x8 bq[4];
#pragma unroll
    for (int h = 0; h < 4; ++h) bq[h] = *(const bf16x8*)(F.IQ() + rowq * 128 + 32 * h + 8 * g);
    const f32x4 wv = *(const f32x4*)(F.IW() + rowq * 4) * (0.5f * 0.17677669529663687f);
    const int nkb = 4 * (c + 1);
    const bf16* kp = F.IK() + ((size_t)b * SEQ + q) * 32 + 8 * g;
    LAS float* dst = (LAS float*)(lds + P2_SC) + q * SCW + 4 * g;
    int kb = w; bf16x8 a = *(const bf16x8*)(kp + (size_t)kb * 512);
    for (; kb < nkb; kb += 8) {
        bf16x8 an = a; if (kb + 8 < nkb) an = *(const bf16x8*)(kp + (size_t)(kb + 8) * 512);
        f32x4 sc = {0.f, 0.f, 0.f, 0.f};
#pragma unroll
        for (int h = 0; h < 4; ++h) {
            const f32x4 d = __builtin_amdgcn_mfma_f32_16x16x32_bf16(a, bq[h], (f32x4){0.f, 0.f, 0.f, 0.f}, 0, 0, 0);
#pragma unroll
            for (int i = 0; i < 4; ++i) sc[i] += wv[h] * fmaxf(d[i], 0.f);
        }
        *(LAS f32x4*)(dst + 16 * kb) = (f32x4){sc[0] + 0.f, sc[1] + 0.f, sc[2] + 0.f, sc[3] + 0.f};
        a = an;
    }
}
__device__ __forceinline__ int wave_sum_i(int v) {
    v += __builtin_amdgcn_update_dpp(0, v, 0xB1, 0xF, 0xF, false);
    v += __builtin_amdgcn_update_dpp(0, v, 0x4E, 0xF, 0xF, false);
    v += __builtin_amdgcn_update_dpp(0, v, 0x141, 0xF, 0xF, false);
    v += __builtin_amdgcn_update_dpp(0, v, 0x140, 0xF, 0xF, false);
    return (__builtin_amdgcn_readlane(v, 0) + __builtin_amdgcn_readlane(v, 16)) + (__builtin_amdgcn_readlane(v, 32) + __builtin_amdgcn_readlane(v, 48));
}
__device__ __forceinline__ unsigned sortable(float f) { const unsigned bits = __float_as_uint(f); return bits ^ ((unsigned)((int)bits >> 31) | 0x80000000u); }
template <int NJ>
__device__ __forceinline__ void mask_words(const unsigned (&u)[NJ], unsigned prefix, bool exact, LAS unsigned long long* mrow, int nj, int lane) {
    unsigned long long mv = 0ull;
    if (exact) {
#pragma unroll
        for (int j = 0; j < NJ; ++j) { const unsigned long long sel = __ballot(u[j] >= prefix); if (lane == j) mv = sel; }
    } else {
        int ngt = 0;
#pragma unroll
        for (int j = 0; j < NJ; ++j) ngt += __popcll(__ballot(u[j] > prefix));
        int need = 256 - ngt;
#pragma unroll
        for (int j = 0; j < NJ; ++j) {
            const unsigned long long eq = __ballot(u[j] == prefix);
            const int rank = (int)__builtin_amdgcn_mbcnt_hi((unsigned)(eq >> 32), __builtin_amdgcn_mbcnt_lo((unsigned)eq, 0u));
            const unsigned long long sel = __ballot(u[j] > prefix || (u[j] == prefix && rank < need));
            need -= __popcll(eq);
            if (lane == j) mv = sel;
        }
    }
    if (lane < nj) mrow[lane] = mv;
}
template <int NJ>
__device__ __forceinline__ void select_row(const LAS float* row, LAS unsigned long long* mrow, int nj, int lane) {
    static_assert(NJ % 4 == 0, "groups of four");
    unsigned u[NJ];
#pragma unroll
    for (int j = 0; j < NJ; ++j) { float v = row[64 * j + lane]; asm volatile("" : "+v"(v)); u[j] = (j < nj) ? sortable(v) : 0u; }
    unsigned prefix = 0u; bool exact = false;
#pragma unroll 1
    for (int bit = 31; bit >= 0; --bit) {
        const unsigned trial = prefix | (1u << bit); int c0 = 0, c1 = 0, c2 = 0, c3 = 0;
#pragma unroll
        for (int j = 0; j < NJ; j += 4) {
            unsigned long long m0, m1, m2, m3;
            asm volatile("v_cmp_le_u32_e64 %4, %12, %8\n\tv_cmp_le_u32_e64 %5, %12, %9\n\tv_cmp_le_u32_e64 %6, %12, %10\n\tv_cmp_le_u32_e64 %7, %12, %11\n\t"
                         "v_addc_co_u32_e64 %0, %4, 0, %0, %4\n\tv_addc_co_u32_e64 %1, %5, 0, %1, %5\n\tv_addc_co_u32_e64 %2, %6, 0, %2, %6\n\tv_addc_co_u32_e64 %3, %7, 0, %3, %7"
                         : "+v"(c0), "+v"(c1), "+v"(c2), "+v"(c3), "=&s"(m0), "=&s"(m1), "=&s"(m2), "=&s"(m3) : "v"(u[j]), "v"(u[j + 1]), "v"(u[j + 2]), "v"(u[j + 3]), "s"(trial));
        }
        const int cnt = wave_sum_i((c0 + c1) + (c2 + c3));
        if (cnt >= 256) prefix = trial;
        if (cnt == 256) { exact = true; break; }
    }
    mask_words<NJ>(u, prefix, exact, mrow, nj, lane);
}
template <int S, unsigned M>
__device__ __forceinline__ void tr_stage(unsigned (&A)[32]) {
#pragma unroll
    for (int k = 0; k < 32; ++k) if (!(k & S)) { const unsigned a = A[k], b = A[k + S]; A[k] = (a & M) | ((b & M) << S); A[k + S] = ((a >> S) & M) | (b & ~M); }
}
__device__ __forceinline__ void planes_finish(unsigned gt, unsigned alive, int G, bool done, LAS unsigned long long* mrow, int nj, int lane) {
    unsigned sel = gt | alive;
    if (!done) {
        int need = 256 - G; unsigned ts = 0u;
#pragma unroll
        for (int j = 0; j < 32; ++j) {
            const bool mine = (alive >> j) & 1u; const unsigned long long eq = __ballot(mine);
            const int rank = (int)__builtin_amdgcn_mbcnt_hi((unsigned)(eq >> 32), __builtin_amdgcn_mbcnt_lo((unsigned)eq, 0u));
            ts |= (mine && rank < need) ? (1u << j) : 0u; need -= __popcll(eq);
        }
        sel = gt | ts;
    }
    unsigned long long mv = 0ull;
#pragma unroll
    for (int j = 0; j < 32; ++j) { const unsigned long long w = __ballot((sel >> j) & 1u); if (lane == j) mv = w; }
    if (lane < nj) mrow[lane] = mv;
}
__device__ __forceinline__ void select_rows_planes2(const LAS float* rowa, const LAS float* rowb, LAS unsigned long long* mrowa, LAS unsigned long long* mrowb, int nj, int lane) {
    unsigned A[32], B[32];
#pragma unroll
    for (int j = 0; j < 32; ++j) { float va = rowa[64 * j + lane], vb = rowb[64 * j + lane]; asm volatile("" : "+v"(va), "+v"(vb)); A[j] = (j < nj) ? sortable(va) : 0u; B[j] = (j < nj) ? sortable(vb) : 0u; }
    tr_stage<16, 0x0000FFFFu>(A); tr_stage<8, 0x00FF00FFu>(A); tr_stage<4, 0x0F0F0F0Fu>(A); tr_stage<2, 0x33333333u>(A); tr_stage<1, 0x55555555u>(A);
    tr_stage<16, 0x0000FFFFu>(B); tr_stage<8, 0x00FF00FFu>(B); tr_stage<4, 0x0F0F0F0Fu>(B); tr_stage<2, 0x33333333u>(B); tr_stage<1, 0x55555555u>(B);
#pragma unroll
    for (int j = 0; j < 32; ++j) asm volatile("" : "+v"(A[j]), "+v"(B[j]));
    unsigned alivea = 0xFFFFFFFFu, gta = 0u, aliveb = 0xFFFFFFFFu, gtb = 0u; int Ga = 0, Aa = 2048, Gb = 0, Ab = 2048; bool donea = false, doneb = false;
#pragma unroll
    for (int b = 31; b >= 0; --b) {
        if (!(donea && doneb)) {
            const unsigned onesa = alivea & A[b], onesb = aliveb & B[b];
            const int both = wave_sum_i(__builtin_popcount(onesa) | (__builtin_popcount(onesb) << 16)), C1a = both & 0xffff, C1b = both >> 16;
            if (!donea) {
                if (Ga + C1a >= 256) { alivea = onesa; Aa = C1a; } else { Ga += C1a; gta |= onesa; alivea &= ~A[b]; Aa -= C1a; }
                donea = (Ga + Aa == 256);
            }
            if (!doneb) {
                if (Gb + C1b >= 256) { aliveb = onesb; Ab = C1b; } else { Gb += C1b; gtb |= onesb; aliveb &= ~B[b]; Ab -= C1b; }
                doneb = (Gb + Ab == 256);
            }
        }
    }
    planes_finish(gta, alivea, Ga, donea, mrowa, nj, lane);
    planes_finish(gtb, aliveb, Gb, doneb, mrowb, nj, lane);
}
constexpr int AT_K = 0, AT_V = 16384, AT_BT = 32768, AT_WS = 40960, AT_OST = 0, AT_Q = 43008;
static_assert(AT_Q + 65536 <= P2_MASK && AT_OST + 8 * 4608 <= AT_WS, "attention LDS map");
__device__ __forceinline__ bf16x8 pk16(const f32x16& v, int o) { return __builtin_bit_cast(bf16x8, (v4u){pkbf(v[o], v[o + 1]), pkbf(v[o + 2], v[o + 3]), pkbf(v[o + 4], v[o + 5]), pkbf(v[o + 6], v[o + 7])}); }
template <bool MASK, bool NEAR>
__device__ __forceinline__ void attn_soft(f32x16& p0, f32x16& p1, f32x2v& lacc, bf16x8 (&pa)[4], const LAS float* bt, unsigned long long mw, int hi) {
#pragma unroll
    for (int i = 0; i < 16; ++i) { p0[i] = __builtin_amdgcn_exp2f(p0[i]); p1[i] = __builtin_amdgcn_exp2f(p1[i]); }
    if (MASK) {
        const unsigned long long ws_ = mw >> (4 * hi); const int lo = (int)(unsigned)ws_, hh = (int)(unsigned)(ws_ >> 32);
#define MSK_(i) { int m0_, m1_; asm("v_bfe_i32 %0, %1, %2, 1" : "=v"(m0_) : "v"(lo), "n"(((i) & 3) + 8 * ((i) >> 2))); asm("v_bfe_i32 %0, %1, %2, 1" : "=v"(m1_) : "v"(hh), "n"(((i) & 3) + 8 * ((i) >> 2))); \
            p0[i] = __uint_as_float(__float_as_uint(p0[i]) & (unsigned)m0_); p1[i] = __uint_as_float(__float_as_uint(p1[i]) & (unsigned)m1_); }
        MSK_(0) MSK_(1) MSK_(2) MSK_(3) MSK_(4) MSK_(5) MSK_(6) MSK_(7) MSK_(8) MSK_(9) MSK_(10) MSK_(11) MSK_(12) MSK_(13) MSK_(14) MSK_(15)
#undef MSK_
    }
#pragma unroll
    for (int i = 0; i < 16; i += 2) { lacc += (f32x2v){p0[i], p0[i + 1]}; lacc += (f32x2v){p1[i], p1[i + 1]}; }
    pa[0] = pk16(p0, 0); pa[1] = pk16(p0, 8); pa[2] = pk16(p1, 0); pa[3] = pk16(p1, 8);
}
__device__ __forceinline__ void attn_pv(f32x16& o0, f32x16& o1, const bf16x8 (&pa)[4], const LAS unsigned char* Vb) {
#pragma unroll
    for (int ks = 0; ks < 4; ++ks) {
        o0 = __builtin_amdgcn_mfma_f32_32x32x16_bf16(pa[ks], cat8(vtr(Vb + ks * 1024), vtr(Vb + ks * 1024 + 512)), o0, 0, 0, 0);
        o1 = __builtin_amdgcn_mfma_f32_32x32x16_bf16(pa[ks], cat8(vtr(Vb + 4096 + ks * 1024), vtr(Vb + 4096 + ks * 1024 + 512)), o1, 0, 0, 0);
    }
}
template <bool MASK, bool NEAR>
__device__ __forceinline__ void attn_tile(f32x16& oa0, f32x16& oa1, f32x16& ob0, f32x16& ob1, f32x2v& la, f32x2v& lb, const LAS unsigned char* Qb,
                                          const LAS unsigned char* Kb, const LAS unsigned char* Vb, const LAS float* bt, unsigned long long mwa, unsigned long long mwb, int hi) {
    f32x16 a0, a1, b0, b1;
#pragma unroll
    for (int i = 0; i < 16; ++i) {
        if (NEAR) { a0[i] = bt[(i & 3) + 8 * (i >> 2)]; a1[i] = bt[32 + (i & 3) + 8 * (i >> 2)]; b0[i] = bt[(i & 3) + 8 * (i >> 2) - 32]; b1[i] = bt[(i & 3) + 8 * (i >> 2)]; }
        else { a0[i] = 0.f; a1[i] = 0.f; b0[i] = 0.f; b1[i] = 0.f; }
    }
#pragma unroll
    for (int d0 = 0; d0 < 4; ++d0) { const bf16x8 k0 = *(const LAS bf16x8*)(Kb + d0 * 2048), k1 = *(const LAS bf16x8*)(Kb + d0 * 2048 + 512); const bf16x8 qf = *(const LAS bf16x8*)(Qb + d0 * 1024);
        a0 = __builtin_amdgcn_mfma_f32_32x32x16_bf16(k0, qf, a0, 0, 0, 0); a1 = __builtin_amdgcn_mfma_f32_32x32x16_bf16(k1, qf, a1, 0, 0, 0); }
    const LAS unsigned char* Kb2 = Kb; asm volatile("" : "+v"(Kb2));
#pragma unroll
    for (int d0 = 0; d0 < 4; ++d0) { const bf16x8 k0 = *(const LAS bf16x8*)(Kb2 + d0 * 2048), k1 = *(const LAS bf16x8*)(Kb2 + d0 * 2048 + 512); const bf16x8 qf = *(const LAS bf16x8*)(Qb + 4096 + d0 * 1024);
        b0 = __builtin_amdgcn_mfma_f32_32x32x16_bf16(k0, qf, b0, 0, 0, 0); b1 = __builtin_amdgcn_mfma_f32_32x32x16_bf16(k1, qf, b1, 0, 0, 0); }
    bf16x8 pa[4], pb[4];
    attn_soft<MASK, NEAR>(a0, a1, la, pa, bt, mwa, hi);
    attn_pv(oa0, oa1, pa, Vb);
    attn_soft<MASK, NEAR>(b0, b1, lb, pb, bt - 32, mwb, hi);
    attn_pv(ob0, ob1, pb, Vb);
}
__device__ __forceinline__ void attn_store(const f32x16& o0, const f32x16& o1, f32x2v lacc, bf16* obase, LAS unsigned char* stg, LAS float* wsf, int lane) {
    const int r = lane & 31, hi = lane >> 5;
    float lsum = lacc[0] + lacc[1];
    lsum += __shfl_xor(lsum, 32);
    if (hi == 0) wsf[r] = lsum;
    LDS_WAIT(); asm volatile("" ::: "memory");
    LAS unsigned short* st = (LAS unsigned short*)stg;
#pragma unroll
    for (int i = 0; i < 16; ++i) {
        const int q = crow(i, hi); const float rl = 1.0f / wsf[q];
        st[q * 72 + r] = (unsigned short)(pkbf(o0[i] * rl, 0.f) & 0xffffu); st[q * 72 + 32 + r] = (unsigned short)(pkbf(o1[i] * rl, 0.f) & 0xffffu);
    }
    LDS_WAIT(); asm volatile("" ::: "memory");
#pragma unroll
    for (int k = 0; k < 4; ++k) { const int row = 8 * k + (lane >> 3), ch = lane & 7;
        const v4u v = *(const LAS v4u*)(stg + row * 144 + ch * 16); *(v4u*)(obase + (size_t)row * DM + ch * 8) = v; }
    LDS_WAIT(); asm volatile("" ::: "memory");
}
template <bool MASK>
__device__ __forceinline__ void attn_chunk(const Frame& F, int b, int c, LAS unsigned char* lds) {
    const int wid = F.wave, lane = F.lane, r = lane & 31, hi = lane >> 5;
    const size_t rowbase = (size_t)b * SEQ; const int q0 = 64 * c, nt = c + 1;
    const LAS unsigned char* Qb = lds + AT_Q + wid * 8192 + lane * 16;
#pragma unroll
    for (int d0 = 0; d0 < 4; ++d0) {
        *(LAS bf16x8*)(lds + AT_Q + wid * 8192 + d0 * 1024 + lane * 16) = *(const bf16x8*)(F.QA() + (rowbase + q0 + r) * 512 + wid * 64 + 16 * d0 + 8 * hi);
        *(LAS bf16x8*)(lds + AT_Q + wid * 8192 + 4096 + d0 * 1024 + lane * 16) = *(const bf16x8*)(F.QA() + (rowbase + q0 + 32 + r) * 512 + wid * 64 + 16 * d0 + 8 * hi); }
    const LAS float* BT = (const LAS float*)(lds + AT_BT) + wid * 256;
    const bf16* ksrc = F.KA() + (rowbase + lane) * 64 + 8 * wid;
    const bf16* vsrc = F.VA() + (rowbase + 16 * (wid & 3) + (lane >> 2)) * 64 + (wid >> 2) * 32 + (lane & 3) * 8;
    const LAS unsigned long long* mrow = (const LAS unsigned long long*)(lds + P2_MASK) + r * 32;
    const int voff = ((lane >> 4) & 1) * 32 + (lane & 3) * 8 + (4 * hi + ((lane & 15) >> 2)) * 64;
    f32x16 oa0, oa1, ob0, ob1; f32x2v la = {0.f, 0.f}, lb = {0.f, 0.f};
#pragma unroll
    for (int i = 0; i < 16; ++i) { oa0[i] = 0.f; oa1[i] = 0.f; ob0[i] = 0.f; ob1[i] = 0.f; }
    __builtin_amdgcn_global_load_lds((const unsigned*)ksrc, (LAS unsigned*)(lds + AT_K + wid * 1024), 16, 0, 0);
    __builtin_amdgcn_global_load_lds((const unsigned*)vsrc, (LAS unsigned*)(lds + AT_V + wid * 1024), 16, 0, 0);
    asm volatile("s_waitcnt vmcnt(0)" ::: "memory");
    __syncthreads();
    const int nfar = c >= 2 ? c - 2 : 0;
#pragma unroll 1
    for (int t = 0; t < nt; ++t) {
        const int cur = (t & 1) * 8192, nxt = 8192 - cur, tn = t + 1 < nt ? t + 1 : t;
        __builtin_amdgcn_global_load_lds((const unsigned*)(ksrc + (size_t)tn * 64 * 64), (LAS unsigned*)(lds + AT_K + nxt + wid * 1024), 16, 0, 0);
        __builtin_amdgcn_global_load_lds((const unsigned*)(vsrc + (size_t)tn * 64 * 64), (LAS unsigned*)(lds + AT_V + nxt + wid * 1024), 16, 0, 0);
        unsigned long long mwa = 0ull, mwb = 0ull;
        if (MASK) { mwa = mrow[t]; mwb = mrow[32 * 32 + t]; }
        const LAS unsigned char* Kb = lds + AT_K + cur + hi * 1024 + r * 16; const LAS unsigned char* Vb = lds + AT_V + cur + voff;
        const LAS float* bt = BT + (64 * (t - c) + 191 - r + 4 * hi);
        if (t < nfar) attn_tile<MASK, false>(oa0, oa1, ob0, ob1, la, lb, Qb, Kb, Vb, bt, mwa, mwb, hi);
        else attn_tile<MASK, true>(oa0, oa1, ob0, ob1, la, lb, Qb, Kb, Vb, bt, mwa, mwb, hi);
        asm volatile("s_waitcnt vmcnt(0)" ::: "memory");
        __syncthreads();
    }
    LAS float* wsf = (LAS float*)(lds + AT_WS) + wid * 64; LAS unsigned char* stg = lds + AT_OST + wid * 4608;
    attn_store(oa0, oa1, la, F.MIX() + (rowbase + q0) * DM + wid * 64, stg, wsf, lane);
    attn_store(ob0, ob1, lb, F.MIX() + (rowbase + q0 + 32) * DM + wid * 64, stg, wsf, lane);
}
__device__ __forceinline__ void attn_unit(const Frame& F, int b, int c, LAS unsigned char* lds) {
    if (c >= 4) {
        const int nj = c + 1;
        for (int rq = 0; rq < ((MIXREP & 2) ? 8 : 4); ++rq) {
            idx_round(F, b, c, rq & 3, lds);
            __syncthreads();
            {
                const int ql = 2 * F.wave;
                const LAS float* row = (const LAS float*)(lds + P2_SC) + ql * SCW; LAS unsigned long long* mrow = (LAS unsigned long long*)(lds + P2_MASK) + (16 * (rq & 3) + ql) * 32;
                if (nj <= 8) { select_row<8>(row, mrow, nj, F.lane); select_row<8>(row + SCW, mrow + 32, nj, F.lane); }
                else { if (PLANES) select_rows_planes2(row, row + SCW, mrow, mrow + 32, nj, F.lane); else { select_row<32>(row, mrow, nj, F.lane); select_row<32>(row + SCW, mrow + 32, nj, F.lane); } }
            }
            __syncthreads();
        }
    }
    { const f32x4 v = *(const f32x4*)(F.BT() + F.tid * 4); *(LAS f32x4*)(lds + AT_BT + F.tid * 16) = v; }
    __syncthreads();
    if (c >= 4) attn_chunk<true>(F, b, c, lds); else attn_chunk<false>(F, b, c, lds);
}

constexpr int RT_TAB = 131072;
__device__ __forceinline__ void ret_stage(const bf16* vsrc, const bf16* ksrc, LAS unsigned char* region) {
#pragma unroll
    for (int k = 0; k < 8; ++k) {
        const size_t o = (size_t)(16 * (k & 3)) * 512 + 32 * (k >> 2);
        __builtin_amdgcn_global_load_lds((const unsigned*)(vsrc + o), (LAS unsigned*)(region + k * 1024), 16, 0, 0);
        __builtin_amdgcn_global_load_lds((const unsigned*)(ksrc + o), (LAS unsigned*)(region + 8192 + k * 1024), 16, 0, 0);
    }
}
__device__ __forceinline__ void ret_kv(f32x16 (&T)[2][2], const LAS unsigned char* img) {
#pragma unroll
    for (int ks = 0; ks < 4; ++ks) {
        const bf16x8 k0 = cat8(vtr(img + 8192 + ks * 1024), vtr(img + 8192 + ks * 1024 + 512)), k1 = cat8(vtr(img + 8192 + 4096 + ks * 1024), vtr(img + 8192 + 4096 + ks * 1024 + 512));
        const bf16x8 v0 = cat8(vtr(img + ks * 1024), vtr(img + ks * 1024 + 512)), v1 = cat8(vtr(img + 4096 + ks * 1024), vtr(img + 4096 + ks * 1024 + 512));
        T[0][0] = __builtin_amdgcn_mfma_f32_32x32x16_bf16(k0, v0, T[0][0], 0, 0, 0); T[0][1] = __builtin_amdgcn_mfma_f32_32x32x16_bf16(k0, v1, T[0][1], 0, 0, 0);
        T[1][0] = __builtin_amdgcn_mfma_f32_32x32x16_bf16(k1, v0, T[1][0], 0, 0, 0); T[1][1] = __builtin_amdgcn_mfma_f32_32x32x16_bf16(k1, v1, T[1][1], 0, 0, 0);
    }
}
__device__ __forceinline__ void ret_unit(const Frame& F, int b, int h, LAS unsigned char* lds) {
    const int lane = F.lane, w = F.wave, r = lane & 31, hi = lane >> 5;
    const float gam = 1.0f - exp2f(-5.0f - (float)h), lg2 = log2f(gam), cd = exp2f(64.0f * lg2), cd4 = exp2f(256.0f * lg2);
    LAS unsigned char* region = lds + w * 16384;
    const LAS unsigned char* img = region + ((lane >> 4) & 1) * 32 + (lane & 3) * 8 + (4 * hi + ((lane & 15) >> 2)) * 64;
    LAS float* tab = (LAS float*)(lds + RT_TAB);
    __syncthreads();
    if (F.tid < 128) tab[F.tid] = F.tid < 64 ? F.ret_gn_w()[h * 64 + F.tid] : F.ret_gn_b()[h * 64 + F.tid - 64];
    const size_t hbase = (size_t)b * SEQ * 512 + h * 64;
    const size_t stg = hbase + (size_t)(lane >> 2) * 512 + (lane & 3) * 8;
    f32x16 T[2][2];
#pragma unroll
    for (int i = 0; i < 16; ++i) { T[0][0][i] = 0.f; T[0][1][i] = 0.f; T[1][0][i] = 0.f; T[1][1][i] = 0.f; }
#pragma unroll 1
    for (int i = 0; i < 4; ++i) {
        const size_t co = (size_t)(4 * w + i) * 64 * 512;
        ret_stage(F.VB() + stg + co, F.KB() + stg + co, region);
        if (i) {
#pragma unroll
            for (int k = 0; k < 16; ++k) { T[0][0][k] *= cd; T[0][1][k] *= cd; T[1][0][k] *= cd; T[1][1][k] *= cd; }
        }
        asm volatile("s_waitcnt vmcnt(0)" ::: "memory");
        ret_kv(T, img);
        LDS_WAIT();
    }
#pragma unroll
    for (int eb = 0; eb < 2; ++eb)
#pragma unroll
        for (int db = 0; db < 2; ++db)
#pragma unroll
            for (int g = 0; g < 4; ++g) *(LAS f32x4*)(region + ((eb * 2 + db) * 4 + g) * 1024 + lane * 16) = (f32x4){T[eb][db][4 * g], T[eb][db][4 * g + 1], T[eb][db][4 * g + 2], T[eb][db][4 * g + 3]};
    __syncthreads();
#pragma unroll
    for (int i = 0; i < 16; ++i) { T[0][0][i] = 0.f; T[0][1][i] = 0.f; T[1][0][i] = 0.f; T[1][1][i] = 0.f; }
#pragma unroll 1
    for (int wp = 0; wp < w; ++wp) {
        const LAS unsigned char* src = lds + wp * 16384 + lane * 16;
#pragma unroll
        for (int eb = 0; eb < 2; ++eb)
#pragma unroll
            for (int db = 0; db < 2; ++db)
#pragma unroll
                for (int g = 0; g < 4; ++g) { const f32x4 v = *(const LAS f32x4*)(src + ((eb * 2 + db) * 4 + g) * 1024);
                    T[eb][db][4 * g] = T[eb][db][4 * g] * cd4 + v[0]; T[eb][db][4 * g + 1] = T[eb][db][4 * g + 1] * cd4 + v[1]; T[eb][db][4 * g + 2] = T[eb][db][4 * g + 2] * cd4 + v[2]; T[eb][db][4 * g + 3] = T[eb][db][4 * g + 3] * cd4 + v[3]; }
    }
    __syncthreads();
#pragma unroll 1
    for (int i = 0; i < 4; ++i) {
        const int n = 4 * w + i; const size_t co = (size_t)n * 64 * 512;
        ret_stage(F.VB() + stg + co, F.KB() + stg + co, region);
#pragma unroll
        for (int k = 0; k < 16; ++k) { T[0][0][k] *= cd; T[0][1][k] *= cd; T[1][0][k] *= cd; T[1][1][k] *= cd; }
        const bf16* qrow = F.QB() + hbase + co + (size_t)r * 512 + 8 * hi;
        const bf16* krow = F.KB() + hbase + co + (size_t)r * 512 + 8 * hi;
#pragma unroll 1
        for (int ib = 0; ib < 2; ++ib) {
            bf16x8 qf[4], kf[4];
#pragma unroll
            for (int s = 0; s < 4; ++s) { qf[s] = *(const bf16x8*)(qrow + (size_t)(32 * ib) * 512 + 16 * s); kf[s] = *(const bf16x8*)(krow + 16 * s); }
            const size_t tok = (size_t)b * SEQ + 64 * n + 32 * ib + r;
            const bf16* grow = F.GB() + tok * 512 + h * 64 + 4 * hi;
            v2u gq[2][4];
#pragma unroll
            for (int db = 0; db < 2; ++db)
#pragma unroll
                for (int g = 0; g < 4; ++g) gq[db][g] = *(const v2u*)(grow + 32 * db + 8 * g);
            f32x16 s0, s1;
#pragma unroll
            for (int k = 0; k < 16; ++k) { s0[k] = 0.f; s1[k] = 0.f; }
#pragma unroll
            for (int s = 0; s < 4; ++s) s0 = __builtin_amdgcn_mfma_f32_32x32x16_bf16(kf[s], qf[s], s0, 0, 0, 0);
            if (ib == 1) {
#pragma unroll
                for (int s = 0; s < 4; ++s) kf[s] = *(const bf16x8*)(krow + (size_t)32 * 512 + 16 * s);
#pragma unroll
                for (int s = 0; s < 4; ++s) s1 = __builtin_amdgcn_mfma_f32_32x32x16_bf16(kf[s], qf[s], s1, 0, 0, 0);
#pragma unroll
                for (int k = 0; k < 16; ++k) s1[k] = (r >= crow(k, hi)) ? s1[k] : 0.f;
            } else {
#pragma unroll
                for (int k = 0; k < 16; ++k) s0[k] = (r >= crow(k, hi)) ? s0[k] : 0.f;
            }
#pragma unroll
            for (int s = 0; s < 4; ++s) {
                v4u q4 = __builtin_bit_cast(v4u, qf[s]);
                auto x0 = __builtin_amdgcn_permlane32_swap(q4[0], q4[2], false, false); auto x1 = __builtin_amdgcn_permlane32_swap(q4[1], q4[3], false, false);
                q4[0] = x0[0]; q4[2] = x0[1]; q4[1] = x1[0]; q4[3] = x1[1];
                qf[s] = __builtin_bit_cast(bf16x8, q4);
            }
            asm volatile("s_waitcnt vmcnt(0)" ::: "memory");
            f32x16 y0, y1;
#pragma unroll
            for (int k = 0; k < 16; ++k) { y0[k] = 0.f; y1[k] = 0.f; }
#pragma unroll
            for (int eb = 0; eb < 2; ++eb)
#pragma unroll
                for (int s2 = 0; s2 < 2; ++s2) {
                    y0 = __builtin_amdgcn_mfma_f32_32x32x16_bf16(pk16(T[eb][0], 8 * s2), qf[2 * eb + s2], y0, 0, 0, 0);
                    y1 = __builtin_amdgcn_mfma_f32_32x32x16_bf16(pk16(T[eb][1], 8 * s2), qf[2 * eb + s2], y1, 0, 0, 0);
                }
#pragma unroll
            for (int ks = 0; ks < 2; ++ks) {
                const bf16x8 pb = pk16(s0, 8 * ks);
                y0 = __builtin_amdgcn_mfma_f32_32x32x16_bf16(cat8(vtr(img + ks * 1024), vtr(img + ks * 1024 + 512)), pb, y0, 0, 0, 0);
                y1 = __builtin_amdgcn_mfma_f32_32x32x16_bf16(cat8(vtr(img + 4096 + ks * 1024), vtr(img + 4096 + ks * 1024 + 512)), pb, y1, 0, 0, 0);
            }
            if (ib == 1) {
#pragma unroll
                for (int ks = 0; ks < 2; ++ks) {
                    const bf16x8 pb = pk16(s1, 8 * ks);
                    y0 = __builtin_amdgcn_mfma_f32_32x32x16_bf16(cat8(vtr(img + (2 + ks) * 1024), vtr(img + (2 + ks) * 1024 + 512)), pb, y0, 0, 0, 0);
                    y1 = __builtin_amdgcn_mfma_f32_32x32x16_bf16(cat8(vtr(img + 4096 + (2 + ks) * 1024), vtr(img + 4096 + (2 + ks) * 1024 + 512)), pb, y1, 0, 0, 0);
                }
            }
            float sm = 0.f;
#pragma unroll
            for (int k = 0; k < 16; ++k) sm += y0[k] + y1[k];
            sm += __shfl_xor(sm, 32);
            const float mean = sm * (1.0f / 64.0f); float vr = 0.f;
#pragma unroll
            for (int k = 0; k < 16; ++k) { y0[k] -= mean; y1[k] -= mean; vr += y0[k] * y0[k] + y1[k] * y1[k]; }
            vr += __shfl_xor(vr, 32);
            const float rstd = 1.0f / sqrtf(vr * (1.0f / 64.0f) + 1e-5f);
            bf16* orow = F.MIX() + tok * DM + 512 + h * 64 + 4 * hi;
#pragma unroll
            for (int g = 0; g < 4; ++g) {
                const f32x4 w0 = *(const LAS f32x4*)(tab + 8 * g + 4 * hi), b0 = *(const LAS f32x4*)(tab + 64 + 8 * g + 4 * hi), w1 = *(const LAS f32x4*)(tab + 32 + 8 * g + 4 * hi), b1 = *(const LAS f32x4*)(tab + 96 + 8 * g + 4 * hi);
                const v2u g0 = gq[0][g], g1 = gq[1][g];
                *(v2u*)(orow + 8 * g) = (v2u){pkbf((y0[4 * g] * rstd * w0[0] + b0[0]) * bflo(g0[0]), (y0[4 * g + 1] * rstd * w0[1] + b0[1]) * bfhi(g0[0])),
                                              pkbf((y0[4 * g + 2] * rstd * w0[2] + b0[2]) * bflo(g0[1]), (y0[4 * g + 3] * rstd * w0[3] + b0[3]) * bfhi(g0[1]))};
                *(v2u*)(orow + 32 + 8 * g) = (v2u){pkbf((y1[4 * g] * rstd * w1[0] + b1[0]) * bflo(g1[0]), (y1[4 * g + 1] * rstd * w1[1] + b1[1]) * bfhi(g1[0])),
                                                   pkbf((y1[4 * g + 2] * rstd * w1[2] + b1[2]) * bflo(g1[1]), (y1[4 * g + 3] * rstd * w1[3] + b1[3]) * bfhi(g1[1]))};
            }
        }
        ret_kv(T, img);
        LDS_WAIT();
    }
}
#ifndef RETREP
#define RETREP 1
#endif
#ifndef ATTREP
#define ATTREP 1
#endif
constexpr int N_RET = BATCH * 8 * RETREP, N_ATT = BATCH * 32 * ATTREP, N_MIX = N_RET + N_ATT;
__device__ __forceinline__ void p2_mixers(Frame& F) {
    for (;;) {
        int mo_ = MISC_OFF; asm volatile("" : "+s"(mo_));
        volatile LAS unsigned* misc = (volatile LAS unsigned*)(F.lds + mo_);
        __syncthreads();
        if (F.tid == 0) misc[0] = __hip_atomic_fetch_add(F.ctl, 1u, __ATOMIC_RELAXED, __HIP_MEMORY_SCOPE_AGENT);
        __syncthreads();
        const int u = (int)misc[0];
        if (u >= N_MIX) break;
        { int w_ = F.wave; asm volatile("" : "+s"(w_)); F.wave = w_; int l_ = lane_id(); asm volatile("" : "+v"(l_)); F.lane = l_; F.tid = w_ * 64 + l_; }
        constexpr int N_HEAD = 256 * ATTREP;
        if (u < N_HEAD) { const int a = u / ATTREP; attn_unit(F, a & 31, 31 - (a >> 5), F.lds); }
        else if (u < N_HEAD + N_RET) { const int ru = (u - N_HEAD) / RETREP; ret_unit(F, ru >> 3, ru & 7, F.lds); }
        else { const int a = (u - N_RET) / ATTREP; attn_unit(F, a & 31, 31 - (a >> 5), F.lds); }
    }
}

typedef __attribute__((address_space(1))) unsigned gu32;
#define XB_TMO      128
#define XB_XCNT(j)  (256  + 64 * (j))
#define XB_XSUB(j)  (1280 + 64 * (j))
#define XB_XGEN(j)  (2304 + 64 * (j))
#define XB_TOP      3328
#define XB_TOPGEN   3392
#define XCD_BAR_WORDS 3456
#define XB_SPIN_CAP (1u << 18)

__device__ __forceinline__ unsigned xb_ld(unsigned* p)              { return __hip_atomic_load(p, __ATOMIC_RELAXED, __HIP_MEMORY_SCOPE_AGENT); }
__device__ __forceinline__ unsigned xb_add(unsigned* p, unsigned v) { return __hip_atomic_fetch_add(p, v, __ATOMIC_RELAXED, __HIP_MEMORY_SCOPE_AGENT); }
__device__ __forceinline__ unsigned xb_xcc_id() { return (unsigned)__builtin_amdgcn_s_getreg((3 << 11) | 20) & 0xFu; }
#define XB_SPIN(cond, bar) do { unsigned _sp = 0; while (cond) { __builtin_amdgcn_s_sleep(1); \
    if ((++_sp & 255u) == 0u) { if (xb_ld(&(bar)[XB_TMO])) break; if (_sp > XB_SPIN_CAP) { atomicAdd(&(bar)[XB_TMO], 1u); break; } } } } while (0)

struct XcdBarrier {
    unsigned* bar; unsigned x; int wv;
    volatile LAS unsigned* st;
};

__device__ __forceinline__ XcdBarrier xcd_barrier_post(unsigned* bar, volatile LAS unsigned* st, int wv_) {
    XcdBarrier b; b.bar = bar; b.x = xb_xcc_id(); b.st = st; b.wv = 0;
    if (wv_ == 0 && lane_id() == 0) (void)xb_add(&bar[XB_XCNT(b.x)], 1u);
    return b;
}
__device__ __forceinline__ void xcd_barrier_complete(unsigned* bar, unsigned x, unsigned& nloc, unsigned& nx) {
    const unsigned G = gridDim.x * gridDim.y * gridDim.z;
    unsigned sum, cnt, mine, sp = 0u;
    for (;;) {
        sum = 0u; cnt = 0u; mine = 0u;
#pragma unroll
        for (unsigned j = 0; j < 16; ++j) { const unsigned c = xb_ld(&bar[XB_XCNT(j)]); sum += c; cnt += (c > 0u) ? 1u : 0u; mine = (j == x) ? c : mine; }
        if (sum == G) break;
        __builtin_amdgcn_s_sleep(1);
        if ((++sp & 255u) == 0u) { if (xb_ld(&bar[XB_TMO])) break; if (sp > XB_SPIN_CAP) { atomicAdd(&bar[XB_TMO], 1u); break; } }
    }
    nloc = mine > 0u ? mine : 1u; nx = cnt > 0u ? cnt : 1u;
}

__device__ __forceinline__ void xcd_barrier(const XcdBarrier& b) {
    asm volatile("s_waitcnt vmcnt(0)" ::: "memory");
    __syncthreads();
    if (b.wv == 0 && lane_id() == 0) {
        unsigned* bar = b.bar;
        __builtin_amdgcn_s_waitcnt(0);
        unsigned nloc = b.st[0], nx = b.st[1];
        if (nloc == 0u) { xcd_barrier_complete(bar, b.x, nloc, nx); b.st[0] = nloc; b.st[1] = nx; }
        const unsigned old = xb_add(&bar[XB_XSUB(b.x)], 1u);
        const unsigned gen = old / nloc;
        if (old + 1u == (gen + 1u) * nloc) {
            __builtin_amdgcn_fence(__ATOMIC_RELEASE, "agent");
            asm volatile("s_waitcnt vmcnt(0)" ::: "memory");
            const unsigned og = xb_add(&bar[XB_TOP], 1u);
            const unsigned tg = og / nx;
            if (og + 1u == (tg + 1u) * nx) xb_add(&bar[XB_TOPGEN], 1u);
            else XB_SPIN(xb_ld(&bar[XB_TOPGEN]) == tg, bar);
            __builtin_amdgcn_fence(__ATOMIC_ACQUIRE, "agent");
            xb_add(&bar[XB_XGEN(b.x)], 1u);
            asm volatile("s_waitcnt vmcnt(0)" ::: "memory");
        } else {
            XB_SPIN(xb_ld(&bar[XB_XGEN(b.x)]) == gen, bar);
            __builtin_amdgcn_fence(__ATOMIC_ACQUIRE, "agent");
            asm volatile("s_waitcnt vmcnt(0)" ::: "memory");
        }
    }
    __syncthreads();
}

constexpr int CW_BAR = 4096;
constexpr size_t CTL_ZERO_BYTES = 65536;
typedef KArgs Args;
__global__ void __launch_bounds__(NTHR, 2) fwd_kernel(Args args) {
    extern __shared__ __attribute__((aligned(16))) unsigned char lds[];
    Frame F;
    F.lds = (LAS unsigned char*)lds;
    F.wave = __builtin_amdgcn_readfirstlane((int)threadIdx.x >> 6); F.lane = lane_id(); F.tid = F.wave * 64 + F.lane;
    F.G = gridDim.x; { const int bx = blockIdx.x; F.vcu = (F.G % 8 == 0) ? (bx % 8) * (F.G / 8) + bx / 8 : bx; }
    unsigned char* ws = args.ws;
    F.ctl = (unsigned*)(ws + WS_CTL);
    F.ap = (const __attribute__((address_space(4))) KArgs*)__builtin_amdgcn_kernarg_segment_ptr();
    F.ws = ws;
    const int lo = args.ph_lo, hi = args.ph_hi;
    for (int u_ = F.tid; u_ < 64; u_ += NTHR) ((LAS unsigned*)(F.lds + MISC_OFF))[u_] = 0u;
    __syncthreads();
    XcdBarrier bar; bar.bar = F.ctl + CW_BAR; bar.x = 0; bar.st = nullptr; bar.wv = F.wave;
    if (hi - lo > 1) { bar = xcd_barrier_post(F.ctl + CW_BAR, (volatile LAS unsigned*)(F.lds + MISC_OFF) + 8, F.wave); bar.wv = F.wave; }
#ifndef PHSEL
#define PHSEL 63
#endif
#define IN(k) (((PHSEL >> (k)) & 1) && lo <= (k) && (k) < hi)
#ifndef REPEAT_PHASE
#define REPEAT_PHASE -1
#endif
#define REPS(k) ((REPEAT_PHASE == (k)) ? 2 : 1)
#define SEAM(k) do { if (IN(k) && IN((k) + 1)) { if ((k) == 0 && lo < 0) cg::this_grid().sync(); else xcd_barrier(bar); } } while (0)

    for (int rep_ = 0; rep_ < REPS(0); ++rep_) { if (rep_) cg::this_grid().sync();
    if (IN(0)) { asm volatile("" : "+s"(F.ws), "+s"(F.ap)); F.lane = lane_id(); F.tid = F.wave * 64 + F.lane; p0_prologue(F); }
    }
    SEAM(0);
    for (int rep_ = 0; rep_ < REPS(1); ++rep_) { if (rep_) cg::this_grid().sync();
    if (IN(1)) { asm volatile("" : "+s"(F.ws), "+s"(F.ap)); F.lane = lane_id(); F.tid = F.wave * 64 + F.lane;
        pg8::Gemm g{F.XB(), F.WIN(), MTOK, NIN, DM}; pg8::StaticOrder S; S.init(MTOK, NIN, F.G, (int)blockIdx.x);
        pg8::EpiIn E{F.QA(), F.KA(), F.VA(), F.IQ(), F.IK(), F.QB(), F.KB(), F.VB(), F.GB(), F.IW(), F.q_norm_w(), F.k_norm_w(), (LAS float*)(F.lds + XCH_OFF)};
        pg8::gemm_phase<pg8::EpiIn, pg8::StaticOrder, true, true>(F.lds, g, S, E, F.wave);
    }
    }
    SEAM(1);
    for (int rep_ = 0; rep_ < REPS(2); ++rep_) { if (rep_) { cg::this_grid().sync(); if (blockIdx.x == 0 && F.tid == 0) F.ctl[0] = 0u; cg::this_grid().sync(); }
    if (IN(2)) { asm volatile("" : "+s"(F.ws), "+s"(F.ap)); F.lane = lane_id(); F.tid = F.wave * 64 + F.lane; p2_mixers(F); }
    }
    SEAM(2);
    for (int rep_ = 0; rep_ < REPS(3); ++rep_) { if (rep_) cg::this_grid().sync();
    if (IN(3)) { asm volatile("" : "+s"(F.ws), "+s"(F.ap)); F.lane = lane_id(); F.tid = F.wave * 64 + F.lane;
        pg8::Gemm g{F.MIX(), F.WOUT(), MTOK, DM, DM}; pg8::PanelOrder S{(int)blockIdx.x, 4};
        pg8::EpiOut E{F.RMS(), F.XB(), {0.f, 0.f, 0.f, 0.f, 0.f, 0.f, 0.f, 0.f}};
        if ((int)blockIdx.x < MTOK / 256) {
            pg8::gemm_phase<pg8::EpiOut, pg8::PanelOrder, true, true>(F.lds, g, S, E, F.wave);
            const int wr = F.wave >> 2, wc = F.wave & 3, fr = F.lane & 15, fq = F.lane >> 4;
            LAS float* P = (LAS float*)(F.lds + XCH_OFF);
#pragma unroll
            for (int k = 0; k < 8; ++k) { float s = E.ss[k]; s += __shfl_xor(s, 16); s += __shfl_xor(s, 32);
                if (fq == 0) P[((k >> 2) * 128 + wr * 64 + (k & 3) * 16 + fr) * 4 + wc] = s; }
            __syncthreads();
            if (F.tid < 256) { const f32x4 p = *(const LAS f32x4*)(P + F.tid * 4);
                F.R2()[(size_t)blockIdx.x * 256 + F.tid] = 1.0f / sqrtf(((p[0] + p[1]) + (p[2] + p[3])) * (1.0f / DM) + 1e-6f); }
        }
    }
    }
    SEAM(3);
    for (int rep_ = 0; rep_ < REPS(4); ++rep_) { if (rep_) cg::this_grid().sync();
    if (IN(4)) { asm volatile("" : "+s"(F.ws), "+s"(F.ap)); F.lane = lane_id(); F.tid = F.wave * 64 + F.lane;
        pg8::Gemm g{F.XB(), F.WGU(), MTOK, NGU, DM}; pg8::StaticOrder S; S.init(MTOK, NGU, F.G, (int)blockIdx.x);
        pg8::EpiGU E{F.R2(), F.ACT(), {0.f, 0.f, 0.f, 0.f}, {0.f, 0.f, 0.f, 0.f}, {0.f, 0.f, 0.f, 0.f}, {0.f, 0.f, 0.f, 0.f}};
        pg8::gemm_phase<pg8::EpiGU, pg8::StaticOrder, true, true>(F.lds, g, S, E, F.wave);
    }
    }
    SEAM(4);
    for (int rep_ = 0; rep_ < REPS(5); ++rep_) { if (rep_) cg::this_grid().sync();
    if (IN(5)) { asm volatile("" : "+s"(F.ws), "+s"(F.ap)); F.lane = lane_id(); F.tid = F.wave * 64 + F.lane;
        pg8::Gemm g{F.ACT(), F.WDN(), MTOK, DM, FF}; pg8::StaticOrder S; S.init(MTOK, DM, F.G, (int)blockIdx.x);
        pg8::EpiDown E{F.XB(), F.out()};
        pg8::gemm_phase<pg8::EpiDown, pg8::StaticOrder, true, true>(F.lds, g, S, E, F.wave);
    }
    }
#undef IN
#undef SEAM
}

extern "C" void kernel_launch(void* const* d_in, const int* in_sizes, int n_in, void* d_out, int out_size, void* d_ws, size_t ws_size, hipStream_t stream) {
    static int grid = 0;
    if (grid == 0) {
        if (n_in != 16 || in_sizes[0] != MTOK * DM || out_size != MTOK * DM || ws_size < WS_END) {
            fprintf(stderr, "kernel_launch: unexpected problem (n_in %d, in0 %d, out %d, ws %zu); nothing launched\n", n_in, n_in > 0 ? in_sizes[0] : -1, out_size, ws_size); grid = -1; return; }
        int dev = 0, cus = 0, per_cu = 0;
        if (hipGetDevice(&dev) != hipSuccess || hipDeviceGetAttribute(&cus, hipDeviceAttributeMultiprocessorCount, dev) != hipSuccess) { grid = -1; return; }
        if (hipFuncSetAttribute((const void*)fwd_kernel, hipFuncAttributeMaxDynamicSharedMemorySize, LDS_BYTES) != hipSuccess) { fprintf(stderr, "kernel_launch: hipFuncSetAttribute failed\n"); grid = -1; return; }
        if (hipOccupancyMaxActiveBlocksPerMultiprocessor(&per_cu, (const void*)fwd_kernel, NTHR, LDS_BYTES) != hipSuccess || per_cu < 1) { fprintf(stderr, "kernel_launch: occupancy query says %d blocks per CU\n", per_cu); (void)hipGetLastError(); grid = -1; return; }
        grid = cus;
        if (grid != 256) fprintf(stderr, "kernel_launch: %d CUs; this kernel is laid out for 256\n", grid);
    }
    if (grid < 0) return;
    if (hipMemsetAsync((char*)d_ws + WS_CTL, 0, CTL_ZERO_BYTES, stream) != hipSuccess) { fprintf(stderr, "kernel_launch: memset failed\n"); return; }
    Args a{};
    for (int i = 0; i < 16; ++i) a.in[i] = (const float*)d_in[i];
    a.out = (float*)d_out; a.ws = (unsigned char*)d_ws;
#if MK_N_LAUNCHES == 1
    a.ph_lo = 0; a.ph_hi = N_PHASES;
    void* kargs[] = {&a};
    hipError_t e = hipLaunchCooperativeKernel((const void*)fwd_kernel, dim3(grid), dim3(NTHR), kargs, LDS_BYTES, stream);
    if (e != hipSuccess) fprintf(stderr, "kernel_launch: cooperative launch failed: %s (grid %d)\n", hipGetErrorString(e), grid);
#else
    for (int p = 0; p < N_PHASES; ++p) { a.ph_lo = p; a.ph_hi = p + 1; hipLaunchKernelGGL(fwd_kernel, dim3(grid), dim3(NTHR), LDS_BYTES, stream, a); }
#endif
}
```

```cpp
#include <hip/hip_runtime.h>
#include <hip/hip_cooperative_groups.h>
#include <cstdio>
#include <cstdint>
namespace cg = cooperative_groups;
namespace pg8 {
#define PG8_LAS __attribute__((address_space(3)))
typedef unsigned short bf16_t;
typedef short bf16x8 __attribute__((ext_vector_type(8)));
typedef float f32x4 __attribute__((ext_vector_type(4)));
typedef unsigned u32x4 __attribute__((ext_vector_type(4)));
constexpr int BM = 256, BK = 64, HALF = 128, HTB = HALF * BK * 2  , STAGE_BYTES = 8 * HTB, NXCD = 8, WGM = 8;

__host__ __device__ __forceinline__ int lds_byte(int r, int c) { const int st = (r >> 4) * 2 + (c >> 5), rr = r & 15, cc = c & 31, ob = rr * 64 + cc * 2; return st * 1024 + (ob ^ (((ob >> 9) & 1) << 5)); }
__host__ __device__ __forceinline__ void stage_rc(int b, int& R, int& C) { const int st = b / 1024, sb = b % 1024, swz = sb ^ (((sb >> 9) & 1) << 5); R = (st >> 1) * 16 + swz / 64; C = (st & 1) * 32 + (swz % 64) / 2; }
__host__ __device__ __forceinline__ int perm32(int rho) { const int n = rho >> 4, i = rho & 15; return 8 * (i >> 2) + 4 * n + (i & 3); }

struct Unit { int pm, pn; };
struct Gemm { const bf16_t* A; const bf16_t* Bt; int M, N, K; };

struct StaticOrder {
    int nM, nN, nwg, G, c;
    __host__ __device__ void init(int M, int N, int G_, int c_) { nM = M / BM; nN = N / BM; nwg = nM * nN; G = G_; c = c_; }
    __host__ __device__ bool next(int i, Unit& u) const {
        const long L = (long)i * G + c; if (L >= nwg) return false;
        int wgid = (int)L; { const int q = nwg / NXCD, r = nwg % NXCD, xcd = wgid % NXCD, off = wgid / NXCD; wgid = (xcd < r ? xcd * (q + 1) : r * (q + 1) + (xcd - r) * q) + off; }
        const int nig = WGM * nN, gid = wgid / nig, fm = gid * WGM, gsz = (nM - fm) < WGM ? (nM - fm) : WGM;
        u.pm = fm + ((wgid % nig) % gsz); u.pn = (wgid % nig) / gsz; return true;
    }
    __device__ __forceinline__ void a_ready(const Unit&) const {}
    __device__ __forceinline__ void done(const Unit&) const {}
};

__device__ __forceinline__ unsigned cvt_pk_bf16(float lo, float hi) { unsigned r; asm volatile("v_cvt_pk_bf16_f32 %0, %1, %2" : "=v"(r) : "v"(lo), "v"(hi)); return r; }
typedef float f32x2 __attribute__((ext_vector_type(2)));
typedef __bf16 bf16x2_t __attribute__((ext_vector_type(2)));
typedef unsigned u32x2 __attribute__((ext_vector_type(2)));
__device__ __forceinline__ unsigned pkbf(float lo, float hi) { f32x2 v = {lo, hi}; bf16x2_t b = __builtin_convertvector(v, bf16x2_t); return __builtin_bit_cast(unsigned, b); }
__device__ __forceinline__ u32x4 pk8(f32x4 a, f32x4 b) { return (u32x4){pkbf(a[0], a[1]), pkbf(a[2], a[3]), pkbf(b[0], b[1]), pkbf(b[2], b[3])}; }
__device__ __forceinline__ float dot4(f32x4 a) { return (a[0] * a[0] + a[1] * a[1]) + (a[2] * a[2] + a[3] * a[3]); }
__device__ __forceinline__ float sum4(f32x4 a) { return (a[0] + a[1]) + (a[2] + a[3]); }
__device__ __forceinline__ float silu1(float v) { return v * __builtin_amdgcn_rcpf(1.0f + __builtin_amdgcn_exp2f(-1.4426950408889634f * v)); }
__device__ __forceinline__ f32x4 silu4(f32x4 v) { return (f32x4){silu1(v[0]), silu1(v[1]), silu1(v[2]), silu1(v[3])}; }
constexpr float RMS_EPS_F = 1e-6f;
constexpr float QSCALE = 0.125f * 1.4426950408889634f;

struct EpiIn {
    static constexpr bool PERM = true, AFTER_DRAIN = false;
    bf16_t *QA, *KA, *VA, *IQ, *IK, *QB, *KB, *VB, *GB; float* IW;
    const float *qnw, *knw;
    PG8_LAS float* xch;
    __device__ __forceinline__ void prefetch(const Unit&, int, int) {}
    __device__ __forceinline__ void advance() {}
    __device__ __forceinline__ void operator()(const f32x4 (&acc)[2][2][4][2], const Unit& u, int wr, int wc, int fr, int fq) {
        asm volatile("" : "+v"(fr), "+v"(fq));
        const int row0 = u.pm * BM + wr * 64 + fr, pn = u.pn;
        if (pn < 2) {
            const int head = 4 * pn + wc;
            const f32x4 w0 = *(const f32x4*)(qnw + 8 * fq), w1 = *(const f32x4*)(qnw + 8 * fq + 4), w2 = *(const f32x4*)(qnw + 32 + 8 * fq), w3 = *(const f32x4*)(qnw + 36 + 8 * fq);
#pragma unroll
            for (int ai = 0; ai < 2; ++ai)
#pragma unroll
                for (int m = 0; m < 4; ++m) {
                    f32x4 a0 = acc[ai][0][m][0], a1 = acc[ai][0][m][1], b0 = acc[ai][1][m][0], b1 = acc[ai][1][m][1];
                    float ss = (dot4(a0) + dot4(a1)) + (dot4(b0) + dot4(b1));
                    ss += __shfl_xor(ss, 16); ss += __shfl_xor(ss, 32);
                    const float rs = QSCALE / sqrtf(ss * (1.0f / 64.0f) + RMS_EPS_F);
                    bf16_t* p = QA + (size_t)(row0 + ai * HALF + m * 16) * 512 + head * 64 + 8 * fq;
                    *(u32x4*)p = pk8(a0 * w0 * rs, a1 * w1 * rs); *(u32x4*)(p + 32) = pk8(b0 * w2 * rs, b1 * w3 * rs);
                }
        } else if (pn == 2) {
            if (wc >= 2) {
#pragma unroll
                for (int ai = 0; ai < 2; ++ai)
#pragma unroll
                    for (int m = 0; m < 4; ++m) {
                        float ss = (dot4(acc[ai][0][m][0]) + dot4(acc[ai][0][m][1])) + (dot4(acc[ai][1][m][0]) + dot4(acc[ai][1][m][1]));
                        ss += __shfl_xor(ss, 16); ss += __shfl_xor(ss, 32);
                        if (fq == 0) xch[(ai * HALF + wr * 64 + m * 16 + fr) * 2 + (wc - 2)] = ss;
                    }
            }
            asm volatile("s_waitcnt lgkmcnt(0)" ::: "memory"); __builtin_amdgcn_s_barrier(); asm volatile("" ::: "memory");
            if (wc < 2) {
                const f32x4 w0 = *(const f32x4*)(knw + 8 * fq), w1 = *(const f32x4*)(knw + 8 * fq + 4), w2 = *(const f32x4*)(knw + 32 + 8 * fq), w3 = *(const f32x4*)(knw + 36 + 8 * fq);
#pragma unroll
                for (int ai = 0; ai < 2; ++ai)
#pragma unroll
                    for (int m = 0; m < 4; ++m) {
                        const int rl = ai * HALF + wr * 64 + m * 16 + fr;
                        const f32x2 pr = *(const PG8_LAS f32x2*)(xch + rl * 2);
                        const float rc = 1.0f / sqrtf((pr[0] + pr[1]) * (1.0f / 128.0f) + RMS_EPS_F);
                        f32x4 a0 = acc[ai][0][m][0] * rc, a1 = acc[ai][0][m][1] * rc, b0 = acc[ai][1][m][0] * rc, b1 = acc[ai][1][m][1] * rc;
                        const size_t row = (size_t)(row0 + ai * HALF + m * 16);
                        if (wc == 0) {
                            float ss = (dot4(a0) + dot4(a1)) + (dot4(b0) + dot4(b1));
                            ss += __shfl_xor(ss, 16); ss += __shfl_xor(ss, 32);
                            const float rs = 1.0f / sqrtf(ss * (1.0f / 64.0f) + RMS_EPS_F);
                            bf16_t* p = KA + row * 64 + 8 * fq;
                            *(u32x4*)p = pk8(a0 * w0 * rs, a1 * w1 * rs); *(u32x4*)(p + 32) = pk8(b0 * w2 * rs, b1 * w3 * rs);
                        } else {
                            bf16_t* p = VA + row * 64 + 8 * fq;
                            *(u32x4*)p = pk8(a0, a1); *(u32x4*)(p + 32) = pk8(b0, b1);
                        }
                    }
            }
        } else if (pn == 3) {
#pragma unroll
            for (int ai = 0; ai < 2; ++ai)
#pragma unroll
                for (int m = 0; m < 4; ++m) {
                    const size_t row = (size_t)(row0 + ai * HALF + m * 16);
                    *(u32x4*)(IQ + row * 128 + 32 * wc + 8 * fq) = pk8(acc[ai][0][m][0], acc[ai][0][m][1]);
                    if (wc == 0) *(u32x4*)(IK + row * 32 + 8 * fq) = pk8(acc[ai][1][m][0], acc[ai][1][m][1]);
                    if (wc == 1 && fq == 0) *(f32x4*)(IW + row * 4) = acc[ai][1][m][0];
                }
        } else if (pn < 8) {
            const int head = 4 * (pn & 1) + wc; bf16_t* dst = pn < 6 ? QB : KB;
            const float lg2 = __log2f(1.0f - __builtin_amdgcn_exp2f(-5.0f - (float)head));
            f32x4 iv0, iv1;
#pragma unroll
            for (int i = 0; i < 4; ++i) { iv0[i] = __builtin_amdgcn_exp2f(-(float)(8 * fq + i) * (13.287712379549449f / 32.0f)) * 0.15915494309189535f; iv1[i] = __builtin_amdgcn_exp2f(-(float)(8 * fq + 4 + i) * (13.287712379549449f / 32.0f)) * 0.15915494309189535f; }
#pragma unroll
            for (int ai = 0; ai < 2; ++ai)
#pragma unroll
                for (int m = 0; m < 4; ++m) {
                    const int row = row0 + ai * HALF + m * 16, pos = row & 2047; const float fp = (float)pos;
                    const float sc = pn < 6 ? __builtin_amdgcn_exp2f((float)(pos & 63) * lg2) : 0.125f * __builtin_amdgcn_exp2f(-(float)(pos & 63) * lg2);
                    f32x4 c0, c1, s0, s1;
#pragma unroll
                    for (int i = 0; i < 4; ++i) {
                        const float r0 = __builtin_amdgcn_fractf(fp * iv0[i]), r1 = __builtin_amdgcn_fractf(fp * iv1[i]);
                        c0[i] = __builtin_amdgcn_cosf(r0) * sc; s0[i] = __builtin_amdgcn_sinf(r0) * sc; c1[i] = __builtin_amdgcn_cosf(r1) * sc; s1[i] = __builtin_amdgcn_sinf(r1) * sc;
                    }
                    const f32x4 a0 = acc[ai][0][m][0], a1 = acc[ai][0][m][1], b0 = acc[ai][1][m][0], b1 = acc[ai][1][m][1];
                    bf16_t* p = dst + (size_t)row * 512 + head * 64 + 8 * fq;
                    *(u32x4*)p = pk8(a0 * c0 - b0 * s0, a1 * c1 - b1 * s1); *(u32x4*)(p + 32) = pk8(a0 * s0 + b0 * c0, a1 * s1 + b1 * c1);
                }
        } else {
            const int head = 4 * (pn & 1) + wc; bf16_t* dst = pn < 10 ? VB : GB; const bool act = pn >= 10;
#pragma unroll
            for (int ai = 0; ai < 2; ++ai)
#pragma unroll
                for (int m = 0; m < 4; ++m) {
                    f32x4 a0 = acc[ai][0][m][0], a1 = acc[ai][0][m][1], b0 = acc[ai][1][m][0], b1 = acc[ai][1][m][1];
                    if (act) { a0 = silu4(a0); a1 = silu4(a1); b0 = silu4(b0); b1 = silu4(b1); }
                    bf16_t* p = dst + (size_t)(row0 + ai * HALF + m * 16) * 512 + head * 64 + 8 * fq;
                    *(u32x4*)p = pk8(a0, a1); *(u32x4*)(p + 32) = pk8(b0, b1);
                }
        }
    }
};

struct EpiOut {
    static constexpr bool PERM = true, AFTER_DRAIN = false;
    const float* rms; bf16_t* x1b; float ss[8];
    __device__ __forceinline__ void prefetch(const Unit&, int, int) {}
    __device__ __forceinline__ void advance() {}
    __device__ __forceinline__ void operator()(const f32x4 (&acc)[2][2][4][2], const Unit& u, int wr, int wc, int fr, int fq) {
        asm volatile("" : "+v"(fr), "+v"(fq));
        const int row0 = u.pm * BM + wr * 64 + fr, col0 = u.pn * BM + wc * 32 + 8 * fq;
#pragma unroll
        for (int ai = 0; ai < 2; ++ai)
#pragma unroll
            for (int m = 0; m < 4; ++m) {
                const int row = row0 + ai * HALF + m * 16; const size_t off = (size_t)row * 1024 + col0; const float rm = rms[row]; float s = 0.f;
#pragma unroll
                for (int bj = 0; bj < 2; ++bj) {
                    const u32x4 xv = *(const u32x4*)(x1b + off + bj * HALF);
                    const f32x4 x0 = {__uint_as_float(xv[0] << 16), __uint_as_float(xv[0] & 0xffff0000u), __uint_as_float(xv[1] << 16), __uint_as_float(xv[1] & 0xffff0000u)};
                    const f32x4 x1 = {__uint_as_float(xv[2] << 16), __uint_as_float(xv[2] & 0xffff0000u), __uint_as_float(xv[3] << 16), __uint_as_float(xv[3] & 0xffff0000u)};
                    const f32x4 r0 = x0 * rm + acc[ai][bj][m][0], r1 = x1 * rm + acc[ai][bj][m][1];
                    *(u32x4*)(x1b + off + bj * HALF) = pk8(r0, r1);
                    s += dot4(r0) + dot4(r1);
                }
                ss[ai * 4 + m] += s;
            }
    }
};

struct EpiGU {
    static constexpr bool PERM = true, AFTER_DRAIN = false;
    const float* r2; bf16_t* act; f32x4 rc0, rc1, rn0, rn1; unsigned long long tepi;
    __device__ __forceinline__ void prefetch(const Unit& u, int wr, int fr) {
        const float* p = r2 + u.pm * BM + wr * 64 + fr;
        rn0 = (f32x4){p[0], p[16], p[32], p[48]}; rn1 = (f32x4){p[HALF], p[HALF + 16], p[HALF + 32], p[HALF + 48]};
    }
    __device__ __forceinline__ void advance() { rc0 = rn0; rc1 = rn1; }
    __device__ __forceinline__ void operator()(const f32x4 (&acc)[2][2][4][2], const Unit& u, int wr, int wc, int fr, int fq) {
#ifdef PROBE_TIMER
        const unsigned long long te0_ = __builtin_amdgcn_s_memtime();
#endif
        asm volatile("" : "+v"(fr), "+v"(fq));
        const int row0 = u.pm * BM + wr * 64 + fr, col0 = u.pn * HALF + wc * 32 + 8 * fq;
#pragma unroll
        for (int ai = 0; ai < 2; ++ai)
#pragma unroll
            for (int m = 0; m < 4; ++m) {
                const int row = row0 + ai * HALF + m * 16; const float rr = ai ? rc1[m] : rc0[m];
                const f32x4 g0 = acc[ai][0][m][0] * rr, g1 = acc[ai][0][m][1] * rr, u0 = acc[ai][1][m][0] * rr, u1 = acc[ai][1][m][1] * rr;
                *(u32x4*)(act + (size_t)row * 2816 + col0) = pk8(silu4(g0) * u0, silu4(g1) * u1);
            }
#ifdef PROBE_TIMER
        asm volatile("s_waitcnt vmcnt(0)" ::: "memory"); tepi += __builtin_amdgcn_s_memtime() - te0_;
#endif
    }
};

struct EpiDown {
    static constexpr bool PERM = true, AFTER_DRAIN = false;
    const bf16_t* x1b; float* out;
    __device__ __forceinline__ void prefetch(const Unit&, int, int) {}
    __device__ __forceinline__ void advance() {}
    __device__ __forceinline__ void operator()(const f32x4 (&acc)[2][2][4][2], const Unit& u, int wr, int wc, int fr, int fq) {
        asm volatile("" : "+v"(fr), "+v"(fq));
        const int row0 = u.pm * BM + wr * 64 + fr, col0 = u.pn * BM + wc * 32 + 8 * fq;
#pragma unroll
        for (int ai = 0; ai < 2; ++ai)
#pragma unroll
            for (int m = 0; m < 4; ++m) {
                const size_t off = (size_t)(row0 + ai * HALF + m * 16) * 1024 + col0;
#pragma unroll
                for (int bj = 0; bj < 2; ++bj) {
                    const u32x4 xv = *(const u32x4*)(x1b + off + bj * HALF);
                    const f32x4 x0 = {__uint_as_float(xv[0] << 16), __uint_as_float(xv[0] & 0xffff0000u), __uint_as_float(xv[1] << 16), __uint_as_float(xv[1] & 0xffff0000u)};
                    const f32x4 x1 = {__uint_as_float(xv[2] << 16), __uint_as_float(xv[2] & 0xffff0000u), __uint_as_float(xv[3] << 16), __uint_as_float(xv[3] & 0xffff0000u)};
                    *(f32x4*)(out + off + bj * HALF) = x0 + acc[ai][bj][m][0]; *(f32x4*)(out + off + bj * HALF + 4) = x1 + acc[ai][bj][m][1];
                }
            }
    }
};

struct PanelOrder {
    int pm, ntn;
    __device__ __forceinline__ bool next(int i, Unit& u) const { if (i >= ntn) return false; u.pm = pm; u.pn = i; return true; }
    __device__ __forceinline__ void a_ready(const Unit&) const {}
    __device__ __forceinline__ void done(const Unit&) const {}
};

template <class Epi, class Sched, bool ALIGN_EPI = false, bool SP2 = false>
__device__ __forceinline__ void gemm_phase(PG8_LAS unsigned char* lds, const Gemm g, const Sched& S, Epi& E, int wave_in) {
    unsigned ones_ = ~0u; asm volatile("" : "+s"(ones_)); int tid_ = wave_in * 64 + (int)__builtin_amdgcn_mbcnt_hi(ones_, __builtin_amdgcn_mbcnt_lo(ones_, 0u));
    const int tid = tid_, wid = __builtin_amdgcn_readfirstlane(tid >> 6), lane = tid & 63, wr = wid >> 2, wc = wid & 3, fr = lane & 15, fq = lane >> 4;
    const int K = g.K, nt = K / BK;
    unsigned voffA[2], voffB[2];
#pragma unroll
    for (int i = 0; i < 2; ++i) { int R, C; stage_rc(tid * 16 + i * 8192, R, C); const int Rb = Epi::PERM ? ((R & ~31) + perm32(R & 31)) : R;
        voffA[i] = (unsigned)(R * K + C) * 2u; voffB[i] = (unsigned)(Rb * K + C) * 2u; }
    const size_t kstep = (size_t)(BK * 2);
    const size_t hstep = (size_t)HALF * K * 2;
    const size_t tstep = 2 * hstep;
    const unsigned ldsw = (unsigned)wid * 1024u;
    const int aoff = lds_byte(wr * 64 + fr, fq * 8), boff = lds_byte(wc * 32 + fr, fq * 8);
#define PG8_SA(b, h) (((b) * 2 + (h)) * HTB)
#define PG8_SB(b, h) ((4 + (b) * 2 + (h)) * HTB)
#define PG8_STAGE(bufoff, gbase, voff) do { _Pragma("unroll") for (int _i = 0; _i < 2; ++_i) \
        __builtin_amdgcn_global_load_lds((const unsigned*)((const char*)(gbase) + (voff)[_i]), (PG8_LAS unsigned*)(lds + (bufoff) + ldsw + _i * 8192), 16, 0, 0); } while (0)
#define PG8_LDA(dst, b, h) do { _Pragma("unroll") for (int m = 0; m < 4; ++m) _Pragma("unroll") for (int k = 0; k < 2; ++k) dst[m][k] = *(const PG8_LAS bf16x8*)(lds + PG8_SA(b, h) + aoff + m * 2048 + k * 1024); } while (0)
#define PG8_LDB(dst, b, h) do { _Pragma("unroll") for (int n = 0; n < 2; ++n) _Pragma("unroll") for (int k = 0; k < 2; ++k) dst[n][k] = *(const PG8_LAS bf16x8*)(lds + PG8_SB(b, h) + boff + n * 2048 + k * 1024); } while (0)
#define PG8_MMA(ai, bj, At, Bt) do { __builtin_amdgcn_s_setprio(1); _Pragma("unroll") for (int m = 0; m < 4; ++m) _Pragma("unroll") for (int n = 0; n < 2; ++n) _Pragma("unroll") for (int k = 0; k < 2; ++k) \
        acc[ai][bj][m][n] = __builtin_amdgcn_mfma_f32_16x16x32_bf16(Bt[n][k], At[m][k], acc[ai][bj][m][n], 0, 0, 0); __builtin_amdgcn_s_setprio(0); } while (0)
#define PG8_WAIT_V(n) asm volatile("s_waitcnt vmcnt(" #n ")" ::: "memory")
#define PG8_WAIT_L(n) asm volatile("s_waitcnt lgkmcnt(" #n ")" ::: "memory")
#define PG8_BAR __builtin_amdgcn_s_barrier()
#define PG8_SCHED __builtin_amdgcn_sched_barrier(0)
    Unit cur, nxt; int ui = 0;
    if (!S.next(0, cur)) return;
    E.prefetch(cur, wr, fr); E.advance();
    f32x4 acc[2][2][4][2];
#pragma unroll
    for (int a = 0; a < 2; ++a)
#pragma unroll
        for (int b = 0; b < 2; ++b)
#pragma unroll
            for (int m = 0; m < 4; ++m)
#pragma unroll
                for (int n = 0; n < 2; ++n) acc[a][b][m][n] = (f32x4){0.f, 0.f, 0.f, 0.f};
    bf16x8 At[4][2], B0[2][2], B1[2][2];
    const char* cA = (const char*)g.A + (size_t)cur.pm * tstep; const char* cB = (const char*)g.Bt + (size_t)cur.pn * tstep;
    S.a_ready(cur);
    if constexpr (SP2) {
        PG8_STAGE(PG8_SB(0, 0), cB, voffB); PG8_STAGE(PG8_SB(0, 1), cB + hstep, voffB); PG8_STAGE(PG8_SA(0, 0), cA, voffA); PG8_STAGE(PG8_SA(0, 1), cA + hstep, voffA);
        if (wr == 1) PG8_BAR;
        PG8_WAIT_V(2); PG8_BAR;
        PG8_STAGE(PG8_SB(1, 0), cB + kstep, voffB); PG8_STAGE(PG8_SA(1, 0), cA + kstep, voffA); PG8_STAGE(PG8_SB(1, 1), cB + hstep + kstep, voffB);
        PG8_WAIT_V(6); PG8_BAR;
    } else {
        PG8_STAGE(PG8_SB(0, 0), cB, voffB); PG8_STAGE(PG8_SA(0, 0), cA, voffA); PG8_STAGE(PG8_SB(0, 1), cB + hstep, voffB); PG8_STAGE(PG8_SA(0, 1), cA + hstep, voffA);
        if (wr == 1) PG8_BAR;
        PG8_WAIT_V(4); PG8_BAR;
        PG8_STAGE(PG8_SB(1, 0), cB + kstep, voffB); PG8_STAGE(PG8_SA(1, 0), cA + kstep, voffA); PG8_STAGE(PG8_SB(1, 1), cB + hstep + kstep, voffB);
        PG8_WAIT_V(6); PG8_BAR;
    }
    for (;;) {
        const bool has_next = S.next(ui + 1, nxt);
        const char* nA = has_next ? (const char*)g.A + (size_t)nxt.pm * tstep : cA; const char* nB = has_next ? (const char*)g.Bt + (size_t)nxt.pn * tstep : cB;
        for (int t = 0; t < nt; t += 2) {
            const bool last = (t == nt - 2);
            const char* a1 = cA + (size_t)(t + 1) * kstep;
            const char* a2 = last ? nA : cA + (size_t)(t + 2) * kstep; const char* b2 = last ? nB : cB + (size_t)(t + 2) * kstep;
            const char* a3 = a2 + kstep; const char* b3 = b2 + kstep;
            if (last && has_next) { S.a_ready(nxt); E.prefetch(nxt, wr, fr); }
            if constexpr (SP2) {
            PG8_LDB(B0, 0, 0); PG8_LDB(B1, 0, 1); PG8_SCHED; PG8_LDA(At, 0, 0); PG8_STAGE(PG8_SA(1, 1), a1 + hstep, voffA);
            PG8_WAIT_V(8); PG8_WAIT_L(0); PG8_BAR; PG8_MMA(0, 0, At, B0); PG8_MMA(0, 1, At, B1); PG8_BAR; PG8_SCHED;
            PG8_LDA(At, 0, 1); PG8_STAGE(PG8_SB(0, 0), b2, voffB); PG8_STAGE(PG8_SB(0, 1), b2 + hstep, voffB); PG8_STAGE(PG8_SA(0, 0), a2, voffA);
            PG8_WAIT_V(8); PG8_WAIT_L(0); PG8_BAR; PG8_MMA(1, 0, At, B0); PG8_MMA(1, 1, At, B1); PG8_BAR; PG8_SCHED;
            PG8_LDB(B0, 1, 0); PG8_LDB(B1, 1, 1); PG8_SCHED; PG8_LDA(At, 1, 0); PG8_STAGE(PG8_SA(0, 1), a2 + hstep, voffA);
            PG8_WAIT_V(8); PG8_WAIT_L(0); PG8_BAR; PG8_MMA(0, 0, At, B0); PG8_MMA(0, 1, At, B1); PG8_BAR; PG8_SCHED;
            PG8_LDA(At, 1, 1); PG8_STAGE(PG8_SB(1, 0), b3, voffB); PG8_STAGE(PG8_SB(1, 1), b3 + hstep, voffB); PG8_STAGE(PG8_SA(1, 0), a3, voffA);
            PG8_WAIT_V(8); PG8_WAIT_L(0); PG8_BAR; PG8_MMA(1, 0, At, B0); PG8_MMA(1, 1, At, B1); PG8_BAR; PG8_SCHED;
            } else {
            PG8_LDB(B0, 0, 0); PG8_SCHED; PG8_LDA(At, 0, 0); PG8_STAGE(PG8_SA(1, 1), a1 + hstep, voffA);
            PG8_WAIT_L(8); PG8_BAR; PG8_WAIT_L(0); PG8_MMA(0, 0, At, B0); PG8_BAR; PG8_SCHED;
            PG8_LDB(B1, 0, 1); PG8_STAGE(PG8_SB(0, 0), b2, voffB);
            PG8_BAR; PG8_WAIT_L(0); PG8_MMA(0, 1, At, B1); PG8_BAR;
            PG8_LDA(At, 0, 1); PG8_STAGE(PG8_SA(0, 0), a2, voffA);
            PG8_BAR; PG8_WAIT_L(0); PG8_MMA(1, 0, At, B0); PG8_BAR; PG8_SCHED;
            PG8_STAGE(PG8_SB(0, 1), b2 + hstep, voffB);
            PG8_WAIT_V(6); PG8_BAR; PG8_MMA(1, 1, At, B1); PG8_BAR;
            PG8_LDB(B0, 1, 0); PG8_SCHED; PG8_LDA(At, 1, 0); PG8_STAGE(PG8_SA(0, 1), a2 + hstep, voffA);
            PG8_WAIT_L(8); PG8_BAR; PG8_WAIT_L(0); PG8_MMA(0, 0, At, B0); PG8_BAR; PG8_SCHED;
            PG8_LDB(B1, 1, 1); PG8_STAGE(PG8_SB(1, 0), b3, voffB);
            PG8_BAR; PG8_WAIT_L(0); PG8_MMA(0, 1, At, B1); PG8_BAR;
            PG8_LDA(At, 1, 1); PG8_STAGE(PG8_SA(1, 0), a3, voffA);
            PG8_BAR; PG8_WAIT_L(0); PG8_MMA(1, 0, At, B0); PG8_BAR; PG8_SCHED;
            PG8_STAGE(PG8_SB(1, 1), b3 + hstep, voffB);
            PG8_WAIT_V(6); PG8_BAR; PG8_MMA(1, 1, At, B1); PG8_BAR;
            }
        }
        if constexpr (ALIGN_EPI) { if (wr == 0) PG8_BAR; }
        if constexpr (!Epi::AFTER_DRAIN) { E(acc, cur, wr, wc, fr, fq); E.advance(); S.done(cur); }
        if (!has_next) break;
#pragma unroll
        for (int a = 0; a < 2; ++a)
#pragma unroll
            for (int b = 0; b < 2; ++b)
#pragma unroll
                for (int m = 0; m < 4; ++m)
#pragma unroll
                    for (int n = 0; n < 2; ++n) acc[a][b][m][n] = (f32x4){0.f, 0.f, 0.f, 0.f};
        cur = nxt; cA = nA; cB = nB; ++ui;
        if constexpr (ALIGN_EPI) { if (wr == 1) PG8_BAR; }
    }
    PG8_WAIT_V(0);
    if constexpr (!ALIGN_EPI) { if (wr == 0) PG8_BAR; }
    PG8_BAR;
    (void)lane;
#undef PG8_SA
#undef PG8_SB
#undef PG8_STAGE
#undef PG8_LDA
#undef PG8_LDB
#undef PG8_MMA
#undef PG8_WAIT_V
#undef PG8_WAIT_L
#undef PG8_BAR
#undef PG8_SCHED
}
}

constexpr int BATCH = 32, SEQ = 2048, DM = 1024, MTOK = BATCH * SEQ;
constexpr int INW = 2852, NIN = 3072, FF = 2816, NGU = 2 * FF;
constexpr int NWAVES = 8, NTHR = 512;
#ifndef MK_N_LAUNCHES
#define MK_N_LAUNCHES 1
#endif
constexpr int N_PHASES = 6;
constexpr size_t MiB = 1u << 20;
constexpr size_t WS_CTL = 0;
constexpr size_t WS_COS = 1 * MiB, WS_SIN = WS_COS + 256 * 1024;
constexpr size_t WS_BT = WS_SIN + 256 * 1024;
constexpr size_t WS_R2 = 2 * MiB, WS_RMS = 2 * MiB + 512 * 1024;
constexpr size_t WS_WIN = 4 * MiB, WS_WOUT = 10 * MiB, WS_WGU = 12 * MiB, WS_WDN = 23 * MiB;
constexpr size_t WS_XB = 32 * MiB;
constexpr size_t WS_MIX = 160 * MiB;
constexpr size_t WS_QA = 288 * MiB, WS_QB = 352 * MiB, WS_KB = 416 * MiB, WS_VB = 480 * MiB, WS_GB = 544 * MiB;
constexpr size_t WS_KA = 608 * MiB, WS_VA = 616 * MiB;
constexpr size_t WS_IQ = 624 * MiB;
constexpr size_t WS_ACT = 288 * MiB;
constexpr size_t WS_IK = 640 * MiB, WS_IW = 644 * MiB;
constexpr size_t WS_MASK = 648 * MiB;
constexpr size_t WS_SCR = 672 * MiB;
constexpr size_t WS_END = 800 * MiB;
static_assert(WS_ACT + (size_t)MTOK * FF * 2 <= WS_IK && WS_IQ + (size_t)MTOK * 128 * 2 <= WS_IK && WS_WDN + (size_t)DM * FF * 2 <= WS_XB && WS_WGU + (size_t)NGU * DM * 2 <= WS_WDN, "d_ws map");
constexpr int RING_BYTES = 131072;
constexpr int XCH_OFF = RING_BYTES;
constexpr int P2_SC = 0, SCW = 2052;
constexpr int P2_MASK = 132096;
constexpr int MISC_OFF = 163584;
constexpr int LDS_BYTES = 163840;
static_assert(P2_SC + 16 * SCW * 4 <= P2_MASK && P2_MASK + 16384 <= MISC_OFF, "P2 LDS map");

#define LAS __attribute__((address_space(3)))
typedef unsigned short bf16;
typedef unsigned v4u __attribute__((ext_vector_type(4)));
typedef unsigned v2u __attribute__((ext_vector_type(2)));
typedef float f32x4 __attribute__((ext_vector_type(4)));
typedef float f32x16 __attribute__((ext_vector_type(16)));
typedef short bf16x8 __attribute__((ext_vector_type(8)));
typedef short s16x4 __attribute__((ext_vector_type(4)));
#define LDS_WAIT() asm volatile("s_waitcnt lgkmcnt(0)" ::: "memory")
using pg8::pkbf;
__device__ __forceinline__ float bf2f(unsigned short h) { return __uint_as_float((unsigned)h << 16); }
__device__ __forceinline__ float bflo(unsigned w) { return __uint_as_float(w << 16); }
__device__ __forceinline__ float bfhi(unsigned w) { return __uint_as_float(w & 0xffff0000u); }
__device__ __forceinline__ float wave_sum(float v) {
#pragma unroll
    for (int o = 1; o < 64; o <<= 1) v += __shfl_xor(v, o);
    return v;
}
__device__ __forceinline__ s16x4 vtr(const LAS unsigned char* p) { return __builtin_bit_cast(s16x4, __builtin_amdgcn_ds_read_tr16_b64_v4i16((LAS s16x4*)p)); }
__device__ __forceinline__ bf16x8 cat8(s16x4 lo, s16x4 hi) { return (bf16x8){lo[0], lo[1], lo[2], lo[3], hi[0], hi[1], hi[2], hi[3]}; }
__device__ __forceinline__ int crow(int r, int hi) { return (r & 3) + 8 * (r >> 2) + 4 * hi; }

__device__ __forceinline__ int lane_id() { unsigned ones = ~0u; asm volatile("" : "+s"(ones)); return (int)__builtin_amdgcn_mbcnt_hi(ones, __builtin_amdgcn_mbcnt_lo(ones, 0u)); }
struct KArgs { const float* in[16]; float* out; unsigned char* ws; int ph_lo, ph_hi; };
struct Frame {
    LAS unsigned char* lds;
    unsigned* ctl;
    unsigned char* ws;
    int tid, lane, wave, vcu, G;
    const __attribute__((address_space(4))) KArgs* ap;
    __device__ __forceinline__ const float* x() const { return ap->in[0]; }
    __device__ __forceinline__ const float* norm1_w() const { return ap->in[1]; }
    __device__ __forceinline__ const float* w_in() const { return ap->in[2]; }
    __device__ __forceinline__ const float* q_norm_w() const { return ap->in[3]; }
    __device__ __forceinline__ const float* k_norm_w() const { return ap->in[4]; }
    __device__ __forceinline__ const float* kv_norm_w() const { return ap->in[5]; }
    __device__ __forceinline__ const float* w_uk() const { return ap->in[6]; }
    __device__ __forceinline__ const float* w_uv() const { return ap->in[7]; }
    __device__ __forceinline__ const float* rel_bias() const { return ap->in[8]; }
    __device__ __forceinline__ const float* ret_gn_w() const { return ap->in[9]; }
    __device__ __forceinline__ const float* ret_gn_b() const { return ap->in[10]; }
    __device__ __forceinline__ const float* w_out() const { return ap->in[11]; }
    __device__ __forceinline__ const float* norm2_w() const { return ap->in[12]; }
    __device__ __forceinline__ const float* w_gate() const { return ap->in[13]; }
    __device__ __forceinline__ const float* w_up() const { return ap->in[14]; }
    __device__ __forceinline__ const float* w_down() const { return ap->in[15]; }
    __device__ __forceinline__ float* out() const { return ap->out; }
#define WSB_(name, off) __device__ __forceinline__ bf16* name() const { return (bf16*)(ws + (off)); }
#define WSF_(name, off) __device__ __forceinline__ float* name() const { return (float*)(ws + (off)); }
    WSB_(WIN, WS_WIN) WSB_(WOUT, WS_WOUT) WSB_(WGU, WS_WGU) WSB_(WDN, WS_WDN) WSB_(XB, WS_XB) WSB_(MIX, WS_MIX) WSB_(QA, WS_QA) WSB_(QB, WS_QB) WSB_(KB, WS_KB) WSB_(VB, WS_VB) WSB_(GB, WS_GB)
    WSB_(KA, WS_KA) WSB_(VA, WS_VA) WSB_(IQ, WS_IQ) WSB_(IK, WS_IK) WSB_(ACT, WS_ACT)
    WSF_(IW, WS_IW) WSF_(R2, WS_R2) WSF_(RMS, WS_RMS) WSF_(COS, WS_COS) WSF_(SIN, WS_SIN) WSF_(BT, WS_BT) WSF_(SCR, WS_SCR)
    __device__ __forceinline__ unsigned long long* MASK() const { return (unsigned long long*)(ws + WS_MASK); }
#undef WSB_
#undef WSF_
};

__device__ __forceinline__ int zcol(int n) {
    const int pn = n >> 8, tc = n & 255, bj = tc >> 7, wc = (tc >> 5) & 3, j = tc & 31, d = bj * 32 + j;
    if (pn < 2) return (4 * pn + wc) * 64 + d;
    if (pn == 2) { if (wc == 0) return -2 - d; if (wc == 1) return -2 - (64 + d); return 512 + (wc - 2) * 64 + d; }
    if (pn == 3) { if (bj == 0) return 640 + wc * 32 + j; if (wc == 0) return 768 + j; if (wc == 1 && j < 4) return 800 + j; return -1; }
    const int g = (pn - 4) >> 1, head = 4 * ((pn - 4) & 1) + wc;
    return 804 + g * 512 + head * 64 + d;
}
template <class SRC>
__device__ __forceinline__ void tr_item(SRC src, int Kdim, bf16* WT, int k0, int n0, LAS float* scr, int lane) {
#pragma unroll 4
    for (int i = 0; i < 32; ++i) { const int kk = 2 * i + (lane >> 5); scr[kk * 33 + (lane & 31)] = src(k0 + kk); }
    LDS_WAIT(); asm volatile("" ::: "memory");
    const int c = lane & 7;
#pragma unroll
    for (int j = 0; j < 4; ++j) { const int n = (lane >> 3) + 8 * j; const LAS float* s = scr + (8 * c) * 33 + n;
        v4u o; o.x = pkbf(s[0 * 33], s[1 * 33]); o.y = pkbf(s[2 * 33], s[3 * 33]); o.z = pkbf(s[4 * 33], s[5 * 33]); o.w = pkbf(s[6 * 33], s[7 * 33]);
        *(v4u*)(WT + (size_t)(n0 + n) * Kdim + k0 + 8 * c) = o; }
    LDS_WAIT(); asm volatile("" ::: "memory");
}
__device__ __forceinline__ int t5_bucket(int rel) {
    const int n = rel < 0 ? -rel : rel; int b;
    if (n < 8) b = n; else if (n < 12) b = 8; else if (n < 16) b = 9; else if (n < 23) b = 10; else if (n < 32) b = 11; else if (n < 46) b = 12; else if (n < 64) b = 13; else if (n < 91) b = 14; else b = 15;
    return (rel > 0 ? 16 : 0) + b;
}
__device__ __forceinline__ void p0_prologue(Frame& F) {
    LAS float* scr = (LAS float*)(F.lds + F.wave * 16384);
    const int lane = F.lane, gw = F.vcu * NWAVES + F.wave, NGW = F.G * NWAVES;
    if (blockIdx.x == 0 && F.tid == 0) F.ctl[0] = 0u;
    constexpr int I_IN = 16 * (NIN / 32), I_OUT = 16 * 32, I_GU = 16 * (NGU / 32), I_DN = (FF / 64) * 32, NITEMS = I_IN + I_OUT + I_GU + I_DN;
    auto do_item = [&](int it) {
        int r = it;
        if (r < I_IN) {
            const int kb = r / (NIN / 32), nb = r % (NIN / 32), f = zcol(32 * nb + (lane & 31));
            const float* w_in = F.w_in(); const float* nw = F.norm1_w();
            if (f >= -1) tr_item([&](int k) { return f >= 0 ? nw[k] * w_in[(size_t)k * INW + f] : 0.0f; }, DM, F.WIN(), 64 * kb, 32 * nb, scr, lane);
            return;
        }
        r -= I_IN;
        if (r < I_OUT) { const int kb = r / 32, nb = r % 32; const float* w = F.w_out() + 32 * nb + (lane & 31);
            tr_item([&](int k) { return w[(size_t)k * DM]; }, DM, F.WOUT(), 64 * kb, 32 * nb, scr, lane); return; }
        r -= I_OUT;
        if (r < I_GU) { const int kb = r / (NGU / 32), nb = r % (NGU / 32), n = 32 * nb + (lane & 31), pn = n >> 8, tc = n & 255;
            const float* w = ((tc >> 7) ? F.w_up() : F.w_gate()) + 128 * pn + (tc & 127); const float* nw = F.norm2_w();
            tr_item([&](int k) { return nw[k] * w[(size_t)k * FF]; }, DM, F.WGU(), 64 * kb, 32 * nb, scr, lane); return; }
        r -= I_GU;
        { const int kb = r / 32, nb = r % 32; const float* w = F.w_down() + 32 * nb + (lane & 31);
            tr_item([&](int k) { return w[(size_t)k * DM]; }, FF, F.WDN(), 64 * kb, 32 * nb, scr, lane); }
    };
    for (int e = F.vcu * NTHR + F.tid; e < DM * 128; e += F.G * NTHR) {
        const int k = e >> 7, idx = e & 127, d = idx & 63; const float* wu = (idx < 64 ? F.w_uk() : F.w_uv()) + d; const float* wr_ = F.w_in() + (size_t)k * INW + 512; float a = 0.f;
#pragma unroll 8
        for (int j = 0; j < 128; ++j) a += wr_[j] * F.kv_norm_w()[j] * wu[j * 64];
        const int n = 512 + (idx < 64 ? 0 : 32) + (d < 32 ? d : 128 + d - 32);
        F.WIN()[(size_t)n * DM + k] = (bf16)(pkbf(F.norm1_w()[k] * a, 0.f) & 0xffffu);
    }
    int it = gw, kk = 0;
    for (int m = gw; m < MTOK; m += NGW, ++kk) {
        const f32x4* xr = (const f32x4*)(F.x() + (size_t)m * DM) + lane;
        f32x4 v[4]; float sq = 0.f;
#pragma unroll
        for (int j = 0; j < 4; ++j) { v[j] = xr[64 * j]; sq += pg8::dot4(v[j]); }
        const float ms = wave_sum(sq) * (1.0f / DM) + 1e-6f, rr = 1.0f / sqrtf(ms);
        v2u* o8 = (v2u*)(F.XB() + (size_t)m * DM) + lane;
#pragma unroll
        for (int j = 0; j < 4; ++j) o8[64 * j] = (v2u){pkbf(v[j][0] * rr, v[j][1] * rr), pkbf(v[j][2] * rr, v[j][3] * rr)};
        if (lane == 0) F.RMS()[m] = sqrtf(ms);
        if ((kk & 7) == 3 && it < NITEMS) { do_item(it); it += NGW; }
    }
    for (; it < NITEMS; it += NGW) do_item(it);
    const int gt = F.vcu * NTHR + F.tid, NGT = F.G * NTHR;
    for (int i = gt; i < 8 * 256; i += NGT) { const int h = i >> 8, rel = (i & 255) - 191;
        F.BT()[i] = (F.rel_bias()[t5_bucket(rel) * 8 + h] - F.rel_bias()[15 * 8 + h]) * 1.4426950408889634f; }
}

#ifndef PLANES
#define PLANES 1
#endif
#ifndef MIXREP
#define MIXREP 0
#endif
typedef float f32x4_t __attribute__((ext_vector_type(4)));
typedef float f32x2v __attribute__((ext_vector_type(2)));
__device__ __forceinline__ void idx_round(const Frame& F, int b, int c, int rq, LAS unsigned char* lds) {
    const int w = F.wave, lane = F.lane, q = lane & 15, g = lane >> 4;
    const size_t rowq = (size_t)b * SEQ + 64 * c + 16 * rq + q;
    bf16x8 bq[4];
#pragma unroll
    for (int h = 0; h < 4; ++h) bq[h] = *(const bf16x8*)(F.IQ() + rowq * 128 + 32 * h + 8 * g);
    const f32x4 wv = *(const f32x4*)(F.IW() + rowq * 4) * (0.5f * 0.17677669529663687f);
    const int nkb = 4 * (c + 1);
    const bf16* kp = F.IK() + ((size_t)b * SEQ + q) * 32 + 8 * g;
    LAS float* dst = (LAS float*)(lds + P2_SC) + q * SCW + 4 * g;
    int kb = w; bf16x8 a = *(const bf16x8*)(kp + (size_t)kb * 512);
    for (; kb < nkb; kb += 8) {
        bf16x8 an = a; if (kb + 8 < nkb) an = *(const bf16x8*)(kp + (size_t)(kb + 8) * 512);
        f32x4 sc = {0.f, 0.f, 0.f, 0.f};
#pragma unroll
        for (int h = 0; h < 4; ++h) {
            const f32x4 d = __builtin_amdgcn_mfma_f32_16x16x32_bf16(a, bq[h], (f32x4){0.f, 0.f, 0.f, 0.f}, 0, 0, 0);
#pragma unroll
            for (int i = 0; i < 4; ++i) sc[i] += wv[h] * fmaxf(d[i], 0.f);
        }
        *(LAS f32x4*)(dst + 16 * kb) = (f32x4){sc[0] + 0.f, sc[1] + 0.f, sc[2] + 0.f, sc[3] + 0.f};
        a = an;
    }
}
__device__ __forceinline__ int wave_sum_i(int v) {
    v += __builtin_amdgcn_update_dpp(0, v, 0xB1, 0xF, 0xF, false);
    v += __builtin_amdgcn_update_dpp(0, v, 0x4E, 0xF, 0xF, false);
    v += __builtin_amdgcn_update_dpp(0, v, 0x141, 0xF, 0xF, false);
    v += __builtin_amdgcn_update_dpp(0, v, 0x140, 0xF, 0xF, false);
    return (__builtin_amdgcn_readlane(v, 0) + __builtin_amdgcn_readlane(v, 16)) + (__builtin_amdgcn_readlane(v, 32) + __builtin_amdgcn_readlane(v, 48));
}
__device__ __forceinline__ unsigned sortable(float f) { const unsigned bits = __float_as_uint(f); return bits ^ ((unsigned)((int)bits >> 31) | 0x80000000u); }
template <int NJ>
__device__ __forceinline__ void mask_words(const unsigned (&u)[NJ], unsigned prefix, bool exact, LAS unsigned long long* mrow, int nj, int lane) {
    unsigned long long mv = 0ull;
    if (exact) {
#pragma unroll
        for (int j = 0; j < NJ; ++j) { const unsigned long long sel = __ballot(u[j] >= prefix); if (lane == j) mv = sel; }
    } else {
        int ngt = 0;
#pragma unroll
        for (int j = 0; j < NJ; ++j) ngt += __popcll(__ballot(u[j] > prefix));
        int need = 256 - ngt;
#pragma unroll
        for (int j = 0; j < NJ; ++j) {
            const unsigned long long eq = __ballot(u[j] == prefix);
            const int rank = (int)__builtin_amdgcn_mbcnt_hi((unsigned)(eq >> 32), __builtin_amdgcn_mbcnt_lo((unsigned)eq, 0u));
            const unsigned long long sel = __ballot(u[j] > prefix || (u[j] == prefix && rank < need));
            need -= __popcll(eq);
            if (lane == j) mv = sel;
        }
    }
    if (lane < nj) mrow[lane] = mv;
}
template <int NJ>
__device__ __forceinline__ void select_row(const LAS float* row, LAS unsigned long long* mrow, int nj, int lane) {
    static_assert(NJ % 4 == 0, "groups of four");
    unsigned u[NJ];
#pragma unroll
    for (int j = 0; j < NJ; ++j) { float v = row[64 * j + lane]; asm volatile("" : "+v"(v)); u[j] = (j < nj) ? sortable(v) : 0u; }
    unsigned prefix = 0u; bool exact = false;
#pragma unroll 1
    for (int bit = 31; bit >= 0; --bit) {
        const unsigned trial = prefix | (1u << bit); int c0 = 0, c1 = 0, c2 = 0, c3 = 0;
#pragma unroll
        for (int j = 0; j < NJ; j += 4) {
            unsigned long long m0, m1, m2, m3;
            asm volatile("v_cmp_le_u32_e64 %4, %12, %8\n\tv_cmp_le_u32_e64 %5, %12, %9\n\tv_cmp_le_u32_e64 %6, %12, %10\n\tv_cmp_le_u32_e64 %7, %12, %11\n\t"
                         "v_addc_co_u32_e64 %0, %4, 0, %0, %4\n\tv_addc_co_u32_e64 %1, %5, 0, %1, %5\n\tv_addc_co_u32_e64 %2, %6, 0, %2, %6\n\tv_addc_co_u32_e64 %3, %7, 0, %3, %7"
                         : "+v"(c0), "+v"(c1), "+v"(c2), "+v"(c3), "=&s"(m0), "=&s"(m1), "=&s"(m2), "=&s"(m3) : "v"(u[j]), "v"(u[j + 1]), "v"(u[j + 2]), "v"(u[j + 3]), "s"(trial));
        }
        const int cnt = wave_sum_i((c0 + c1) + (c2 + c3));
        if (cnt >= 256) prefix = trial;
        if (cnt == 256) { exact = true; break; }
    }
    mask_words<NJ>(u, prefix, exact, mrow, nj, lane);
}
template <int S, unsigned M>
__device__ __forceinline__ void tr_stage(unsigned (&A)[32]) {
#pragma unroll
    for (int k = 0; k < 32; ++k) if (!(k & S)) { const unsigned a = A[k], b = A[k + S]; A[k] = (a & M) | ((b & M) << S); A[k + S] = ((a >> S) & M) | (b & ~M); }
}
__device__ __forceinline__ void tr_bytes(unsigned (&A)[32]) {
#pragma unroll
    for (int k = 0; k < 16; ++k) { const unsigned a = A[k], b = A[k + 16];
        A[k] = __builtin_amdgcn_perm(b, a, 0x05040100u);
        A[k + 16] = __builtin_amdgcn_perm(b, a, 0x07060302u); }
#pragma unroll
    for (int k = 0; k < 32; ++k) if (!(k & 8)) { const unsigned a = A[k], b = A[k + 8];
        A[k] = __builtin_amdgcn_perm(b, a, 0x06020400u);
        A[k + 8] = __builtin_amdgcn_perm(b, a, 0x07030501u); }
}
__device__ __forceinline__ void planes_finish(unsigned gt, unsigned alive, int G, bool done, LAS unsigned long long* mrow, int nj, int lane) {
    unsigned sel = gt | alive;
    if (!done) {
        int need = 256 - G; unsigned ts = 0u;
#pragma unroll
        for (int j = 0; j < 32; ++j) {
            const bool mine = (alive >> j) & 1u; const unsigned long long eq = __ballot(mine);
            const int rank = (int)__builtin_amdgcn_mbcnt_hi((unsigned)(eq >> 32), __builtin_amdgcn_mbcnt_lo((unsigned)eq, 0u));
            ts |= (mine && rank < need) ? (1u << j) : 0u; need -= __popcll(eq);
        }
        sel = gt | ts;
    }
    unsigned long long mv = 0ull;
#pragma unroll
    for (int j = 0; j < 32; ++j) { const unsigned long long w = __ballot((sel >> j) & 1u); if (lane == j) mv = w; }
    if (lane < nj) mrow[lane] = mv;
}
__device__ __forceinline__ void select_rows_planes2(const LAS float* rowa, const LAS float* rowb, LAS unsigned long long* mrowa, LAS unsigned long long* mrowb, int nj, int lane) {
    unsigned A[32], B[32];
#pragma unroll
    for (int j = 0; j < 32; ++j) { float va = rowa[64 * j + lane], vb = rowb[64 * j + lane]; asm volatile("" : "+v"(va), "+v"(vb)); A[j] = (j < nj) ? sortable(va) : 0u; B[j] = (j < nj) ? sortable(vb) : 0u; }
    tr_bytes(A); tr_stage<4, 0x0F0F0F0Fu>(A); tr_stage<2, 0x33333333u>(A); tr_stage<1, 0x55555555u>(A);
    tr_bytes(B); tr_stage<4, 0x0F0F0F0Fu>(B); tr_stage<2, 0x33333333u>(B); tr_stage<1, 0x55555555u>(B);
#pragma unroll
    for (int j = 0; j < 32; ++j) asm volatile("" : "+v"(A[j]), "+v"(B[j]));
    unsigned alivea = 0xFFFFFFFFu, gta = 0u, aliveb = 0xFFFFFFFFu, gtb = 0u; int Ga = 0, Aa = 2048, Gb = 0, Ab = 2048; bool donea = false, doneb = false;
#pragma unroll
    for (int b = 31; b >= 0; --b) {
        if (!(donea && doneb)) {
            const unsigned onesa = alivea & A[b], onesb = aliveb & B[b];
            const int both = wave_sum_i(__builtin_popcount(onesa) | (__builtin_popcount(onesb) << 16)), C1a = both & 0xffff, C1b = both >> 16;
            if (!donea) {
                if (Ga + C1a >= 256) { alivea = onesa; Aa = C1a; } else { Ga += C1a; gta |= onesa; alivea &= ~A[b]; Aa -= C1a; }
                donea = (Ga + Aa == 256);
            }
            if (!doneb) {
                if (Gb + C1b >= 256) { aliveb = onesb; Ab = C1b; } else { Gb += C1b; gtb |= onesb; aliveb &= ~B[b]; Ab -= C1b; }
                doneb = (Gb + Ab == 256);
            }
        }
    }
    planes_finish(gta, alivea, Ga, donea, mrowa, nj, lane);
    planes_finish(gtb, aliveb, Gb, doneb, mrowb, nj, lane);
}
constexpr int AT_K = 0, AT_V = 16384, AT_BT = 32768, AT_WS = 40960, AT_OST = 0, AT_Q = 43008;
static_assert(AT_Q + 65536 <= P2_MASK && AT_OST + 8 * 4608 <= AT_WS, "attention LDS map");
__device__ __forceinline__ bf16x8 pk16(const f32x16& v, int o) { return __builtin_bit_cast(bf16x8, (v4u){pkbf(v[o], v[o + 1]), pkbf(v[o + 2], v[o + 3]), pkbf(v[o + 4], v[o + 5]), pkbf(v[o + 6], v[o + 7])}); }
template <bool MASK, bool NEAR>
__device__ __forceinline__ void attn_soft(f32x16& p0, f32x16& p1, f32x2v& lacc, bf16x8 (&pa)[4], const LAS float* bt, unsigned long long mw, int hi) {
#pragma unroll
    for (int i = 0; i < 16; ++i) { p0[i] = __builtin_amdgcn_exp2f(p0[i]); p1[i] = __builtin_amdgcn_exp2f(p1[i]); }
    if (MASK) {
        const unsigned long long ws_ = mw >> (4 * hi); const int lo = (int)(unsigned)ws_, hh = (int)(unsigned)(ws_ >> 32);
#define MSK_(i) { int m0_, m1_; asm("v_bfe_i32 %0, %1, %2, 1" : "=v"(m0_) : "v"(lo), "n"(((i) & 3) + 8 * ((i) >> 2))); asm("v_bfe_i32 %0, %1, %2, 1" : "=v"(m1_) : "v"(hh), "n"(((i) & 3) + 8 * ((i) >> 2))); \
            p0[i] = __uint_as_float(__float_as_uint(p0[i]) & (unsigned)m0_); p1[i] = __uint_as_float(__float_as_uint(p1[i]) & (unsigned)m1_); }
        MSK_(0) MSK_(1) MSK_(2) MSK_(3) MSK_(4) MSK_(5) MSK_(6) MSK_(7) MSK_(8) MSK_(9) MSK_(10) MSK_(11) MSK_(12) MSK_(13) MSK_(14) MSK_(15)
#undef MSK_
    }
#pragma unroll
    for (int i = 0; i < 16; i += 2) { lacc += (f32x2v){p0[i], p0[i + 1]}; lacc += (f32x2v){p1[i], p1[i + 1]}; }
    pa[0] = pk16(p0, 0); pa[1] = pk16(p0, 8); pa[2] = pk16(p1, 0); pa[3] = pk16(p1, 8);
}
__device__ __forceinline__ void attn_pv(f32x16& o0, f32x16& o1, const bf16x8 (&pa)[4], const LAS unsigned char* Vb) {
#pragma unroll
    for (int ks = 0; ks < 4; ++ks) {
        o0 = __builtin_amdgcn_mfma_f32_32x32x16_bf16(pa[ks], cat8(vtr(Vb + ks * 1024), vtr(Vb + ks * 1024 + 512)), o0, 0, 0, 0);
        o1 = __builtin_amdgcn_mfma_f32_32x32x16_bf16(pa[ks], cat8(vtr(Vb + 4096 + ks * 1024), vtr(Vb + 4096 + ks * 1024 + 512)), o1, 0, 0, 0);
    }
}
template <bool MASK, bool NEAR>
__device__ __forceinline__ void attn_tile(f32x16& oa0, f32x16& oa1, f32x16& ob0, f32x16& ob1, f32x2v& la, f32x2v& lb, const LAS unsigned char* Qb,
                                          const LAS unsigned char* Kb, const LAS unsigned char* Vb, const LAS float* bt, unsigned long long mwa, unsigned long long mwb, int hi) {
    f32x16 a0, a1, b0, b1;
#pragma unroll
    for (int i = 0; i < 16; ++i) {
        if (NEAR) { a0[i] = bt[(i & 3) + 8 * (i >> 2)]; a1[i] = bt[32 + (i & 3) + 8 * (i >> 2)]; b0[i] = bt[(i & 3) + 8 * (i >> 2) - 32]; b1[i] = bt[(i & 3) + 8 * (i >> 2)]; }
        else { a0[i] = 0.f; a1[i] = 0.f; b0[i] = 0.f; b1[i] = 0.f; }
    }
#pragma unroll
    for (int d0 = 0; d0 < 4; ++d0) { const bf16x8 k0 = *(const LAS bf16x8*)(Kb + d0 * 2048), k1 = *(const LAS bf16x8*)(Kb + d0 * 2048 + 512); const bf16x8 qf = *(const LAS bf16x8*)(Qb + d0 * 1024);
        a0 = __builtin_amdgcn_mfma_f32_32x32x16_bf16(k0, qf, a0, 0, 0, 0); a1 = __builtin_amdgcn_mfma_f32_32x32x16_bf16(k1, qf, a1, 0, 0, 0); }
    const LAS unsigned char* Kb2 = Kb; asm volatile("" : "+v"(Kb2));
#pragma unroll
    for (int d0 = 0; d0 < 4; ++d0) { const bf16x8 k0 = *(const LAS bf16x8*)(Kb2 + d0 * 2048), k1 = *(const LAS bf16x8*)(Kb2 + d0 * 2048 + 512); const bf16x8 qf = *(const LAS bf16x8*)(Qb + 4096 + d0 * 1024);
        b0 = __builtin_amdgcn_mfma_f32_32x32x16_bf16(k0, qf, b0, 0, 0, 0); b1 = __builtin_amdgcn_mfma_f32_32x32x16_bf16(k1, qf, b1, 0, 0, 0); }
    bf16x8 pa[4], pb[4];
    attn_soft<MASK, NEAR>(a0, a1, la, pa, bt, mwa, hi);
    attn_pv(oa0, oa1, pa, Vb);
    attn_soft<MASK, NEAR>(b0, b1, lb, pb, bt - 32, mwb, hi);
    attn_pv(ob0, ob1, pb, Vb);
}
__device__ __forceinline__ void attn_store(const f32x16& o0, const f32x16& o1, f32x2v lacc, bf16* obase, LAS unsigned char* stg, LAS float* wsf, int lane) {
    const int r = lane & 31, hi = lane >> 5;
    float lsum = lacc[0] + lacc[1];
    lsum += __shfl_xor(lsum, 32);
    if (hi == 0) wsf[r] = lsum;
    LDS_WAIT(); asm volatile("" ::: "memory");
    LAS unsigned short* st = (LAS unsigned short*)stg;
#pragma unroll
    for (int i = 0; i < 16; ++i) {
        const int q = crow(i, hi); const float rl = 1.0f / wsf[q];
        st[q * 72 + r] = (unsigned short)(pkbf(o0[i] * rl, 0.f) & 0xffffu); st[q * 72 + 32 + r] = (unsigned short)(pkbf(o1[i] * rl, 0.f) & 0xffffu);
    }
    LDS_WAIT(); asm volatile("" ::: "memory");
#pragma unroll
    for (int k = 0; k < 4; ++k) { const int row = 8 * k + (lane >> 3), ch = lane & 7;
        const v4u v = *(const LAS v4u*)(stg + row * 144 + ch * 16); *(v4u*)(obase + (size_t)row * DM + ch * 8) = v; }
    LDS_WAIT(); asm volatile("" ::: "memory");
}
template <bool MASK>
__device__ __forceinline__ void attn_chunk(const Frame& F, int b, int c, LAS unsigned char* lds) {
    const int wid = F.wave, lane = F.lane, r = lane & 31, hi = lane >> 5;
    const size_t rowbase = (size_t)b * SEQ; const int q0 = 64 * c, nt = c + 1;
    const LAS unsigned char* Qb = lds + AT_Q + wid * 8192 + lane * 16;
#pragma unroll
    for (int d0 = 0; d0 < 4; ++d0) {
        *(LAS bf16x8*)(lds + AT_Q + wid * 8192 + d0 * 1024 + lane * 16) = *(const bf16x8*)(F.QA() + (rowbase + q0 + r) * 512 + wid * 64 + 16 * d0 + 8 * hi);
        *(LAS bf16x8*)(lds + AT_Q + wid * 8192 + 4096 + d0 * 1024 + lane * 16) = *(const bf16x8*)(F.QA() + (rowbase + q0 + 32 + r) * 512 + wid * 64 + 16 * d0 + 8 * hi); }
    const LAS float* BT = (const LAS float*)(lds + AT_BT) + wid * 256;
    const bf16* ksrc = F.KA() + (rowbase + lane) * 64 + 8 * wid;
    const bf16* vsrc = F.VA() + (rowbase + 16 * (wid & 3) + (lane >> 2)) * 64 + (wid >> 2) * 32 + (lane & 3) * 8;
    const LAS unsigned long long* mrow = (const LAS unsigned long long*)(lds + P2_MASK) + r * 32;
    const int voff = ((lane >> 4) & 1) * 32 + (lane & 3) * 8 + (4 * hi + ((lane & 15) >> 2)) * 64;
    f32x16 oa0, oa1, ob0, ob1; f32x2v la = {0.f, 0.f}, lb = {0.f, 0.f};
#pragma unroll
    for (int i = 0; i < 16; ++i) { oa0[i] = 0.f; oa1[i] = 0.f; ob0[i] = 0.f; ob1[i] = 0.f; }
    __builtin_amdgcn_global_load_lds((const unsigned*)ksrc, (LAS unsigned*)(lds + AT_K + wid * 1024), 16, 0, 0);
    __builtin_amdgcn_global_load_lds((const unsigned*)vsrc, (LAS unsigned*)(lds + AT_V + wid * 1024), 16, 0, 0);
    asm volatile("s_waitcnt vmcnt(0)" ::: "memory");
    __syncthreads();
    const int nfar = c >= 2 ? c - 2 : 0;
#pragma unroll 1
    for (int t = 0; t < nt; ++t) {
        const int cur = (t & 1) * 8192, nxt = 8192 - cur, tn = t + 1 < nt ? t + 1 : t;
        __builtin_amdgcn_global_load_lds((const unsigned*)(ksrc + (size_t)tn * 64 * 64), (LAS unsigned*)(lds + AT_K + nxt + wid * 1024), 16, 0, 0);
        __builtin_amdgcn_global_load_lds((const unsigned*)(vsrc + (size_t)tn * 64 * 64), (LAS unsigned*)(lds + AT_V + nxt + wid * 1024), 16, 0, 0);
        unsigned long long mwa = 0ull, mwb = 0ull;
        if (MASK) { mwa = mrow[t]; mwb = mrow[32 * 32 + t]; }
        const LAS unsigned char* Kb = lds + AT_K + cur + hi * 1024 + r * 16; const LAS unsigned char* Vb = lds + AT_V + cur + voff;
        const LAS float* bt = BT + (64 * (t - c) + 191 - r + 4 * hi);
        if (t < nfar) attn_tile<MASK, false>(oa0, oa1, ob0, ob1, la, lb, Qb, Kb, Vb, bt, mwa, mwb, hi);
        else attn_tile<MASK, true>(oa0, oa1, ob0, ob1, la, lb, Qb, Kb, Vb, bt, mwa, mwb, hi);
        asm volatile("s_waitcnt vmcnt(0)" ::: "memory");
        __syncthreads();
    }
    LAS float* wsf = (LAS float*)(lds + AT_WS) + wid * 64; LAS unsigned char* stg = lds + AT_OST + wid * 4608;
    attn_store(oa0, oa1, la, F.MIX() + (rowbase + q0) * DM + wid * 64, stg, wsf, lane);
    attn_store(ob0, ob1, lb, F.MIX() + (rowbase + q0 + 32) * DM + wid * 64, stg, wsf, lane);
}
__device__ __forceinline__ void attn_unit(const Frame& F, int b, int c, LAS unsigned char* lds) {
    if (c >= 4) {
        const int nj = c + 1;
        for (int rq = 0; rq < ((MIXREP & 2) ? 8 : 4); ++rq) {
            idx_round(F, b, c, rq & 3, lds);
            __syncthreads();
            {
                const int ql = 2 * F.wave;
                const LAS float* row = (const LAS float*)(lds + P2_SC) + ql * SCW; LAS unsigned long long* mrow = (LAS unsigned long long*)(lds + P2_MASK) + (16 * (rq & 3) + ql) * 32;
                if (nj <= 8) { select_row<8>(row, mrow, nj, F.lane); select_row<8>(row + SCW, mrow + 32, nj, F.lane); }
                else { if (PLANES) select_rows_planes2(row, row + SCW, mrow, mrow + 32, nj, F.lane); else { select_row<32>(row, mrow, nj, F.lane); select_row<32>(row + SCW, mrow + 32, nj, F.lane); } }
            }
            __syncthreads();
        }
    }
    { const f32x4 v = *(const f32x4*)(F.BT() + F.tid * 4); *(LAS f32x4*)(lds + AT_BT + F.tid * 16) = v; }
    __syncthreads();
    if (c >= 4) attn_chunk<true>(F, b, c, lds); else attn_chunk<false>(F, b, c, lds);
}

constexpr int RT_TAB = 131072;
__device__ __forceinline__ void ret_stage(const bf16* vsrc, const bf16* ksrc, LAS unsigned char* region) {
#pragma unroll
    for (int k = 0; k < 8; ++k) {
        const size_t o = (size_t)(16 * (k & 3)) * 512 + 32 * (k >> 2);
        __builtin_amdgcn_global_load_lds((const unsigned*)(vsrc + o), (LAS unsigned*)(region + k * 1024), 16, 0, 0);
        __builtin_amdgcn_global_load_lds((const unsigned*)(ksrc + o), (LAS unsigned*)(region + 8192 + k * 1024), 16, 0, 0);
    }
}
__device__ __forceinline__ void ret_kv(f32x16 (&T)[2][2], const LAS unsigned char* img) {
#pragma unroll
    for (int ks = 0; ks < 4; ++ks) {
        const bf16x8 k0 = cat8(vtr(img + 8192 + ks * 1024), vtr(img + 8192 + ks * 1024 + 512)), k1 = cat8(vtr(img + 8192 + 4096 + ks * 1024), vtr(img + 8192 + 4096 + ks * 1024 + 512));
        const bf16x8 v0 = cat8(vtr(img + ks * 1024), vtr(img + ks * 1024 + 512)), v1 = cat8(vtr(img + 4096 + ks * 1024), vtr(img + 4096 + ks * 1024 + 512));
        T[0][0] = __builtin_amdgcn_mfma_f32_32x32x16_bf16(k0, v0, T[0][0], 0, 0, 0); T[0][1] = __builtin_amdgcn_mfma_f32_32x32x16_bf16(k0, v1, T[0][1], 0, 0, 0);
        T[1][0] = __builtin_amdgcn_mfma_f32_32x32x16_bf16(k1, v0, T[1][0], 0, 0, 0); T[1][1] = __builtin_amdgcn_mfma_f32_32x32x16_bf16(k1, v1, T[1][1], 0, 0, 0);
    }
}
__device__ __forceinline__ void ret_unit(const Frame& F, int b, int h, LAS unsigned char* lds) {
    const int lane = F.lane, w = F.wave, r = lane & 31, hi = lane >> 5;
    const float gam = 1.0f - exp2f(-5.0f - (float)h), lg2 = log2f(gam), cd = exp2f(64.0f * lg2), cd4 = exp2f(256.0f * lg2);
    LAS unsigned char* region = lds + w * 16384;
    const LAS unsigned char* img = region + ((lane >> 4) & 1) * 32 + (lane & 3) * 8 + (4 * hi + ((lane & 15) >> 2)) * 64;
    LAS float* tab = (LAS float*)(lds + RT_TAB);
    __syncthreads();
    if (F.tid < 128) tab[F.tid] = F.tid < 64 ? F.ret_gn_w()[h * 64 + F.tid] : F.ret_gn_b()[h * 64 + F.tid - 64];
    const size_t hbase = (size_t)b * SEQ * 512 + h * 64;
    const size_t stg = hbase + (size_t)(lane >> 2) * 512 + (lane & 3) * 8;
    f32x16 T[2][2];
#pragma unroll
    for (int i = 0; i < 16; ++i) { T[0][0][i] = 0.f; T[0][1][i] = 0.f; T[1][0][i] = 0.f; T[1][1][i] = 0.f; }
#pragma unroll 1
    for (int i = 0; i < 4; ++i) {
        const size_t co = (size_t)(4 * w + i) * 64 * 512;
        ret_stage(F.VB() + stg + co, F.KB() + stg + co, region);
        if (i) {
#pragma unroll
            for (int k = 0; k < 16; ++k) { T[0][0][k] *= cd; T[0][1][k] *= cd; T[1][0][k] *= cd; T[1][1][k] *= cd; }
        }
        asm volatile("s_waitcnt vmcnt(0)" ::: "memory");
        ret_kv(T, img);
        LDS_WAIT();
    }
#pragma unroll
    for (int eb = 0; eb < 2; ++eb)
#pragma unroll
        for (int db = 0; db < 2; ++db)
#pragma unroll
            for (int g = 0; g < 4; ++g) *(LAS f32x4*)(region + ((eb * 2 + db) * 4 + g) * 1024 + lane * 16) = (f32x4){T[eb][db][4 * g], T[eb][db][4 * g + 1], T[eb][db][4 * g + 2], T[eb][db][4 * g + 3]};
    __syncthreads();
#pragma unroll
    for (int i = 0; i < 16; ++i) { T[0][0][i] = 0.f; T[0][1][i] = 0.f; T[1][0][i] = 0.f; T[1][1][i] = 0.f; }
#pragma unroll 1
    for (int wp = 0; wp < w; ++wp) {
        const LAS unsigned char* src = lds + wp * 16384 + lane * 16;
#pragma unroll
        for (int eb = 0; eb < 2; ++eb)
#pragma unroll
            for (int db = 0; db < 2; ++db)
#pragma unroll
                for (int g = 0; g < 4; ++g) { const f32x4 v = *(const LAS f32x4*)(src + ((eb * 2 + db) * 4 + g) * 1024);
                    T[eb][db][4 * g] = T[eb][db][4 * g] * cd4 + v[0]; T[eb][db][4 * g + 1] = T[eb][db][4 * g + 1] * cd4 + v[1]; T[eb][db][4 * g + 2] = T[eb][db][4 * g + 2] * cd4 + v[2]; T[eb][db][4 * g + 3] = T[eb][db][4 * g + 3] * cd4 + v[3]; }
    }
    __syncthreads();
#pragma unroll 1
    for (int i = 0; i < 4; ++i) {
        const int n = 4 * w + i; const size_t co = (size_t)n * 64 * 512;
        ret_stage(F.VB() + stg + co, F.KB() + stg + co, region);
#pragma unroll
        for (int k = 0; k < 16; ++k) { T[0][0][k] *= cd; T[0][1][k] *= cd; T[1][0][k] *= cd; T[1][1][k] *= cd; }
        const bf16* qrow = F.QB() + hbase + co + (size_t)r * 512 + 8 * hi;
        const bf16* krow = F.KB() + hbase + co + (size_t)r * 512 + 8 * hi;
#pragma unroll 1
        for (int ib = 0; ib < 2; ++ib) {
            bf16x8 qf[4], kf[4];
#pragma unroll
            for (int s = 0; s < 4; ++s) { qf[s] = *(const bf16x8*)(qrow + (size_t)(32 * ib) * 512 + 16 * s); kf[s] = *(const bf16x8*)(krow + 16 * s); }
            const size_t tok = (size_t)b * SEQ + 64 * n + 32 * ib + r;
            const bf16* grow = F.GB() + tok * 512 + h * 64 + 4 * hi;
            v2u gq[2][4];
#pragma unroll
            for (int db = 0; db < 2; ++db)
#pragma unroll
                for (int g = 0; g < 4; ++g) gq[db][g] = *(const v2u*)(grow + 32 * db + 8 * g);
            f32x16 s0, s1;
#pragma unroll
            for (int k = 0; k < 16; ++k) { s0[k] = 0.f; s1[k] = 0.f; }
#pragma unroll
            for (int s = 0; s < 4; ++s) s0 = __builtin_amdgcn_mfma_f32_32x32x16_bf16(kf[s], qf[s], s0, 0, 0, 0);
            if (ib == 1) {
#pragma unroll
                for (int s = 0; s < 4; ++s) kf[s] = *(const bf16x8*)(krow + (size_t)32 * 512 + 16 * s);
#pragma unroll
                for (int s = 0; s < 4; ++s) s1 = __builtin_amdgcn_mfma_f32_32x32x16_bf16(kf[s], qf[s], s1, 0, 0, 0);
#pragma unroll
                for (int k = 0; k < 16; ++k) s1[k] = (r >= crow(k, hi)) ? s1[k] : 0.f;
            } else {
#pragma unroll
                for (int k = 0; k < 16; ++k) s0[k] = (r >= crow(k, hi)) ? s0[k] : 0.f;
            }
#pragma unroll
            for (int s = 0; s < 4; ++s) {
                v4u q4 = __builtin_bit_cast(v4u, qf[s]);
                auto x0 = __builtin_amdgcn_permlane32_swap(q4[0], q4[2], false, false); auto x1 = __builtin_amdgcn_permlane32_swap(q4[1], q4[3], false, false);
                q4[0] = x0[0]; q4[2] = x0[1]; q4[1] = x1[0]; q4[3] = x1[1];
                qf[s] = __builtin_bit_cast(bf16x8, q4);
            }
            asm volatile("s_waitcnt vmcnt(0)" ::: "memory");
            f32x16 y0, y1;
#pragma unroll
            for (int k = 0; k < 16; ++k) { y0[k] = 0.f; y1[k] = 0.f; }
#pragma unroll
            for (int eb = 0; eb < 2; ++eb)
#pragma unroll
                for (int s2 = 0; s2 < 2; ++s2) {
                    y0 = __builtin_amdgcn_mfma_f32_32x32x16_bf16(pk16(T[eb][0], 8 * s2), qf[2 * eb + s2], y0, 0, 0, 0);
                    y1 = __builtin_amdgcn_mfma_f32_32x32x16_bf16(pk16(T[eb][1], 8 * s2), qf[2 * eb + s2], y1, 0, 0, 0);
                }
#pragma unroll
            for (int ks = 0; ks < 2; ++ks) {
                const bf16x8 pb = pk16(s0, 8 * ks);
                y0 = __builtin_amdgcn_mfma_f32_32x32x16_bf16(cat8(vtr(img + ks * 1024), vtr(img + ks * 1024 + 512)), pb, y0, 0, 0, 0);
                y1 = __builtin_amdgcn_mfma_f32_32x32x16_bf16(cat8(vtr(img + 4096 + ks * 1024), vtr(img + 4096 + ks * 1024 + 512)), pb, y1, 0, 0, 0);
            }
            if (ib == 1) {
#pragma unroll
                for (int ks = 0; ks < 2; ++ks) {
                    const bf16x8 pb = pk16(s1, 8 * ks);
                    y0 = __builtin_amdgcn_mfma_f32_32x32x16_bf16(cat8(vtr(img + (2 + ks) * 1024), vtr(img + (2 + ks) * 1024 + 512)), pb, y0, 0, 0, 0);
                    y1 = __builtin_amdgcn_mfma_f32_32x32x16_bf16(cat8(vtr(img + 4096 + (2 + ks) * 1024), vtr(img + 4096 + (2 + ks) * 1024 + 512)), pb, y1, 0, 0, 0);
                }
            }
            float sm = 0.f;
#pragma unroll
            for (int k = 0; k < 16; ++k) sm += y0[k] + y1[k];
            sm += __shfl_xor(sm, 32);
            const float mean = sm * (1.0f / 64.0f); float vr = 0.f;
#pragma unroll
            for (int k = 0; k < 16; ++k) { y0[k] -= mean; y1[k] -= mean; vr += y0[k] * y0[k] + y1[k] * y1[k]; }
            vr += __shfl_xor(vr, 32);
            const float rstd = 1.0f / sqrtf(vr * (1.0f / 64.0f) + 1e-5f);
            bf16* orow = F.MIX() + tok * DM + 512 + h * 64 + 4 * hi;
#pragma unroll
            for (int g = 0; g < 4; ++g) {
                const f32x4 w0 = *(const LAS f32x4*)(tab + 8 * g + 4 * hi), b0 = *(const LAS f32x4*)(tab + 64 + 8 * g + 4 * hi), w1 = *(const LAS f32x4*)(tab + 32 + 8 * g + 4 * hi), b1 = *(const LAS f32x4*)(tab + 96 + 8 * g + 4 * hi);
                const v2u g0 = gq[0][g], g1 = gq[1][g];
                *(v2u*)(orow + 8 * g) = (v2u){pkbf((y0[4 * g] * rstd * w0[0] + b0[0]) * bflo(g0[0]), (y0[4 * g + 1] * rstd * w0[1] + b0[1]) * bfhi(g0[0])),
                                              pkbf((y0[4 * g + 2] * rstd * w0[2] + b0[2]) * bflo(g0[1]), (y0[4 * g + 3] * rstd * w0[3] + b0[3]) * bfhi(g0[1]))};
                *(v2u*)(orow + 32 + 8 * g) = (v2u){pkbf((y1[4 * g] * rstd * w1[0] + b1[0]) * bflo(g1[0]), (y1[4 * g + 1] * rstd * w1[1] + b1[1]) * bfhi(g1[0])),
                                                   pkbf((y1[4 * g + 2] * rstd * w1[2] + b1[2]) * bflo(g1[1]), (y1[4 * g + 3] * rstd * w1[3] + b1[3]) * bfhi(g1[1]))};
            }
        }
        ret_kv(T, img);
        LDS_WAIT();
    }
}
#ifndef GEMM_ALIGN
#define GEMM_ALIGN true
#endif
#ifndef GEMM_SP2
#define GEMM_SP2 true
#endif
#ifndef RETREP
#define RETREP 1
#endif
#ifndef ATTREP
#define ATTREP 1
#endif
constexpr int N_RET = BATCH * 8 * RETREP, N_ATT = BATCH * 32 * ATTREP, N_MIX = N_RET + N_ATT;
__device__ __forceinline__ void p2_mixers(Frame& F) {
    for (;;) {
        int mo_ = MISC_OFF; asm volatile("" : "+s"(mo_));
        volatile LAS unsigned* misc = (volatile LAS unsigned*)(F.lds + mo_);
        __syncthreads();
        if (F.tid == 0) misc[0] = __hip_atomic_fetch_add(F.ctl, 1u, __ATOMIC_RELAXED, __HIP_MEMORY_SCOPE_AGENT);
        __syncthreads();
        const int u = (int)misc[0];
        if (u >= N_MIX) break;
        { int w_ = F.wave; asm volatile("" : "+s"(w_)); F.wave = w_; int l_ = lane_id(); asm volatile("" : "+v"(l_)); F.lane = l_; F.tid = w_ * 64 + l_; }
        constexpr int N_HEAD = 256 * ATTREP;
        if (u < N_HEAD) { const int a = u / ATTREP; attn_unit(F, a & 31, 31 - (a >> 5), F.lds); }
        else if (u < N_HEAD + N_RET) { const int ru = (u - N_HEAD) / RETREP; ret_unit(F, ru >> 3, ru & 7, F.lds); }
        else { const int a = (u - N_RET) / ATTREP; attn_unit(F, a & 31, 31 - (a >> 5), F.lds); }
    }
}

typedef __attribute__((address_space(1))) unsigned gu32;
#define XB_TMO      128
#define XB_XCNT(j)  (256  + 64 * (j))
#define XB_XSUB(j)  (1280 + 64 * (j))
#define XB_XGEN(j)  (2304 + 64 * (j))
#define XB_TOP      3328
#define XB_TOPGEN   3392
#define XCD_BAR_WORDS 3456
#define XB_SPIN_CAP (1u << 18)

__device__ __forceinline__ unsigned xb_ld(unsigned* p)              { return __hip_atomic_load(p, __ATOMIC_RELAXED, __HIP_MEMORY_SCOPE_AGENT); }
__device__ __forceinline__ unsigned xb_add(unsigned* p, unsigned v) { return __hip_atomic_fetch_add(p, v, __ATOMIC_RELAXED, __HIP_MEMORY_SCOPE_AGENT); }
__device__ __forceinline__ unsigned xb_xcc_id() { return (unsigned)__builtin_amdgcn_s_getreg((3 << 11) | 20) & 0xFu; }
#define XB_SPIN(cond, bar) do { unsigned _sp = 0; while (cond) { __builtin_amdgcn_s_sleep(1); \
    if ((++_sp & 255u) == 0u) { if (xb_ld(&(bar)[XB_TMO])) break; if (_sp > XB_SPIN_CAP) { atomicAdd(&(bar)[XB_TMO], 1u); break; } } } } while (0)

struct XcdBarrier {
    unsigned* bar; unsigned x; int wv;
    volatile LAS unsigned* st;
};

__device__ __forceinline__ XcdBarrier xcd_barrier_post(unsigned* bar, volatile LAS unsigned* st, int wv_) {
    XcdBarrier b; b.bar = bar; b.x = xb_xcc_id(); b.st = st; b.wv = 0;
    if (wv_ == 0 && lane_id() == 0) (void)xb_add(&bar[XB_XCNT(b.x)], 1u);
    return b;
}
__device__ __forceinline__ void xcd_barrier_complete(unsigned* bar, unsigned x, unsigned& nloc, unsigned& nx) {
    const unsigned G = gridDim.x * gridDim.y * gridDim.z;
    unsigned sum, cnt, mine, sp = 0u;
    for (;;) {
        sum = 0u; cnt = 0u; mine = 0u;
#pragma unroll
        for (unsigned j = 0; j < 16; ++j) { const unsigned c = xb_ld(&bar[XB_XCNT(j)]); sum += c; cnt += (c > 0u) ? 1u : 0u; mine = (j == x) ? c : mine; }
        if (sum == G) break;
        __builtin_amdgcn_s_sleep(1);
        if ((++sp & 255u) == 0u) { if (xb_ld(&bar[XB_TMO])) break; if (sp > XB_SPIN_CAP) { atomicAdd(&bar[XB_TMO], 1u); break; } }
    }
    nloc = mine > 0u ? mine : 1u; nx = cnt > 0u ? cnt : 1u;
}

__device__ __forceinline__ void xcd_barrier(const XcdBarrier& b) {
    asm volatile("s_waitcnt vmcnt(0)" ::: "memory");
    __syncthreads();
    if (b.wv == 0 && lane_id() == 0) {
        unsigned* bar = b.bar;
        __builtin_amdgcn_s_waitcnt(0);
        unsigned nloc = b.st[0], nx = b.st[1];
        if (nloc == 0u) { xcd_barrier_complete(bar, b.x, nloc, nx); b.st[0] = nloc; b.st[1] = nx; }
        const unsigned old = xb_add(&bar[XB_XSUB(b.x)], 1u);
        const unsigned gen = old / nloc;
        if (old + 1u == (gen + 1u) * nloc) {
            __builtin_amdgcn_fence(__ATOMIC_RELEASE, "agent");
            asm volatile("s_waitcnt vmcnt(0)" ::: "memory");
            const unsigned og = xb_add(&bar[XB_TOP], 1u);
            const unsigned tg = og / nx;
            if (og + 1u == (tg + 1u) * nx) xb_add(&bar[XB_TOPGEN], 1u);
            else XB_SPIN(xb_ld(&bar[XB_TOPGEN]) == tg, bar);
            __builtin_amdgcn_fence(__ATOMIC_ACQUIRE, "agent");
            xb_add(&bar[XB_XGEN(b.x)], 1u);
            asm volatile("s_waitcnt vmcnt(0)" ::: "memory");
        } else {
            XB_SPIN(xb_ld(&bar[XB_XGEN(b.x)]) == gen, bar);
            __builtin_amdgcn_fence(__ATOMIC_ACQUIRE, "agent");
            asm volatile("s_waitcnt vmcnt(0)" ::: "memory");
        }
    }
    __syncthreads();
}

constexpr int CW_BAR = 4096;
constexpr size_t CTL_ZERO_BYTES = 65536;
typedef KArgs Args;
__global__ void __launch_bounds__(NTHR, 2) fwd_kernel(Args args) {
    extern __shared__ __attribute__((aligned(16))) unsigned char lds[];
    Frame F;
    F.lds = (LAS unsigned char*)lds;
    F.wave = __builtin_amdgcn_readfirstlane((int)threadIdx.x >> 6); F.lane = lane_id(); F.tid = F.wave * 64 + F.lane;
    F.G = gridDim.x; { const int bx = blockIdx.x; F.vcu = (F.G % 8 == 0) ? (bx % 8) * (F.G / 8) + bx / 8 : bx; }
    unsigned char* ws = args.ws;
    F.ctl = (unsigned*)(ws + WS_CTL);
    F.ap = (const __attribute__((address_space(4))) KArgs*)__builtin_amdgcn_kernarg_segment_ptr();
    F.ws = ws;
    const int lo = args.ph_lo, hi = args.ph_hi;
    for (int u_ = F.tid; u_ < 64; u_ += NTHR) ((LAS unsigned*)(F.lds + MISC_OFF))[u_] = 0u;
    __syncthreads();
    XcdBarrier bar; bar.bar = F.ctl + CW_BAR; bar.x = 0; bar.st = nullptr; bar.wv = F.wave;
    if (hi - lo > 1) { bar = xcd_barrier_post(F.ctl + CW_BAR, (volatile LAS unsigned*)(F.lds + MISC_OFF) + 8, F.wave); bar.wv = F.wave; }
#ifndef PHSEL
#define PHSEL 63
#endif
#define IN(k) (((PHSEL >> (k)) & 1) && lo <= (k) && (k) < hi)
#ifndef REPEAT_PHASE
#define REPEAT_PHASE -1
#endif
#define REPS(k) ((REPEAT_PHASE == (k)) ? 2 : 1)
#define SEAM(k) do { if (IN(k) && IN((k) + 1)) { if ((k) == 0 && lo < 0) cg::this_grid().sync(); else xcd_barrier(bar); } } while (0)

    for (int rep_ = 0; rep_ < REPS(0); ++rep_) { if (rep_) cg::this_grid().sync();
    if (IN(0)) { asm volatile("" : "+s"(F.ws), "+s"(F.ap)); F.lane = lane_id(); F.tid = F.wave * 64 + F.lane; p0_prologue(F); }
    }
    SEAM(0);
    for (int rep_ = 0; rep_ < REPS(1); ++rep_) { if (rep_) cg::this_grid().sync();
    if (IN(1)) { asm volatile("" : "+s"(F.ws), "+s"(F.ap)); F.lane = lane_id(); F.tid = F.wave * 64 + F.lane;
        pg8::Gemm g{F.XB(), F.WIN(), MTOK, NIN, DM}; pg8::StaticOrder S; S.init(MTOK, NIN, F.G, (int)blockIdx.x);
        pg8::EpiIn E{F.QA(), F.KA(), F.VA(), F.IQ(), F.IK(), F.QB(), F.KB(), F.VB(), F.GB(), F.IW(), F.q_norm_w(), F.k_norm_w(), (LAS float*)(F.lds + XCH_OFF)};
        pg8::gemm_phase<pg8::EpiIn, pg8::StaticOrder, GEMM_ALIGN, GEMM_SP2>(F.lds, g, S, E, F.wave);
    }
    }
    SEAM(1);
    for (int rep_ = 0; rep_ < REPS(2); ++rep_) { if (rep_) { cg::this_grid().sync(); if (blockIdx.x == 0 && F.tid == 0) F.ctl[0] = 0u; cg::this_grid().sync(); }
    if (IN(2)) { asm volatile("" : "+s"(F.ws), "+s"(F.ap)); F.lane = lane_id(); F.tid = F.wave * 64 + F.lane; p2_mixers(F); }
    }
    SEAM(2);
    for (int rep_ = 0; rep_ < REPS(3); ++rep_) { if (rep_) cg::this_grid().sync();
    if (IN(3)) { asm volatile("" : "+s"(F.ws), "+s"(F.ap)); F.lane = lane_id(); F.tid = F.wave * 64 + F.lane;
        pg8::Gemm g{F.MIX(), F.WOUT(), MTOK, DM, DM}; pg8::PanelOrder S{(int)blockIdx.x, 4};
        pg8::EpiOut E{F.RMS(), F.XB(), {0.f, 0.f, 0.f, 0.f, 0.f, 0.f, 0.f, 0.f}};
        if ((int)blockIdx.x < MTOK / 256) {
            pg8::gemm_phase<pg8::EpiOut, pg8::PanelOrder, true, true>(F.lds, g, S, E, F.wave);
            const int wr = F.wave >> 2, wc = F.wave & 3, fr = F.lane & 15, fq = F.lane >> 4;
            LAS float* P = (LAS float*)(F.lds + XCH_OFF);
#pragma unroll
            for (int k = 0; k < 8; ++k) { float s = E.ss[k]; s += __shfl_xor(s, 16); s += __shfl_xor(s, 32);
                if (fq == 0) P[((k >> 2) * 128 + wr * 64 + (k & 3) * 16 + fr) * 4 + wc] = s; }
            __syncthreads();
            if (F.tid < 256) { const f32x4 p = *(const LAS f32x4*)(P + F.tid * 4);
                F.R2()[(size_t)blockIdx.x * 256 + F.tid] = 1.0f / sqrtf(((p[0] + p[1]) + (p[2] + p[3])) * (1.0f / DM) + 1e-6f); }
        }
    }
    }
    SEAM(3);
    for (int rep_ = 0; rep_ < REPS(4); ++rep_) { if (rep_) cg::this_grid().sync();
    if (IN(4)) { asm volatile("" : "+s"(F.ws), "+s"(F.ap)); F.lane = lane_id(); F.tid = F.wave * 64 + F.lane;
#ifdef PROBE_TIMER
        const unsigned long long pt0_ = __builtin_amdgcn_s_memtime(), pr0_ = __builtin_amdgcn_s_memrealtime();
#endif
        pg8::Gemm g{F.XB(), F.WGU(), MTOK, NGU, DM}; pg8::StaticOrder S; S.init(MTOK, NGU, F.G, (int)blockIdx.x);
        pg8::EpiGU E{F.R2(), F.ACT(), {0.f, 0.f, 0.f, 0.f}, {0.f, 0.f, 0.f, 0.f}, {0.f, 0.f, 0.f, 0.f}, {0.f, 0.f, 0.f, 0.f}, 0ull};
        pg8::gemm_phase<pg8::EpiGU, pg8::StaticOrder, GEMM_ALIGN, GEMM_SP2>(F.lds, g, S, E, F.wave);
#ifdef PROBE_TIMER
        if (blockIdx.x == 7 && F.tid == 0) { const unsigned long long pt1_ = __builtin_amdgcn_s_memtime(), pr1_ = __builtin_amdgcn_s_memrealtime();
#if PROBE_TIMER == 1
            const float val = ((float)(pt1_ - pt0_) / ((float)(pr1_ - pr0_) * 10.0f) - 1.4f);
#else
            const float val = (float)E.tepi / (float)(pt1_ - pt0_);
#endif
            const float frac = 0.05f + 0.5f * floorf(fminf(fmaxf(val, 0.f), 1.f) * 8.0f + 0.5f) * 0.125f;
            F.ctl[64] = __float_as_uint(frac); }
#endif
    }
    }
    SEAM(4);
    for (int rep_ = 0; rep_ < REPS(5); ++rep_) { if (rep_) cg::this_grid().sync();
    if (IN(5)) { asm volatile("" : "+s"(F.ws), "+s"(F.ap)); F.lane = lane_id(); F.tid = F.wave * 64 + F.lane;
        pg8::Gemm g{F.ACT(), F.WDN(), MTOK, DM, FF}; pg8::StaticOrder S; S.init(MTOK, DM, F.G, (int)blockIdx.x);
        pg8::EpiDown E{F.XB(), F.out()};
        pg8::gemm_phase<pg8::EpiDown, pg8::StaticOrder, GEMM_ALIGN, GEMM_SP2>(F.lds, g, S, E, F.wave);
    }
    }
#ifdef PROBE_TIMER
    xcd_barrier(bar);
    { const float frac = __uint_as_float(__hip_atomic_load(F.ctl + 64, __ATOMIC_RELAXED, __HIP_MEMORY_SCOPE_AGENT)); const int nz = (int)(frac * (float)MTOK);
      for (int m = (int)blockIdx.x * NWAVES + F.wave; m < nz; m += F.G * NWAVES) { f32x4* o = (f32x4*)(F.out() + (size_t)m * DM) + F.lane;
#pragma unroll
          for (int j = 0; j < 4; ++j) o[64 * j] = (f32x4){0.f, 0.f, 0.f, 0.f}; } }
#endif
#undef IN
#undef SEAM
}

extern "C" void kernel_launch(void* const* d_in, const int* in_sizes, int n_in, void* d_out, int out_size, void* d_ws, size_t ws_size, hipStream_t stream) {
    static int grid = 0;
    if (grid == 0) {
        if (n_in != 16 || in_sizes[0] != MTOK * DM || out_size != MTOK * DM || ws_size < WS_END) {
            fprintf(stderr, "kernel_launch: unexpected problem (n_in %d, in0 %d, out %d, ws %zu); nothing launched\n", n_in, n_in > 0 ? in_sizes[0] : -1, out_size, ws_size); grid = -1; return; }
        int dev = 0, cus = 0, per_cu = 0;
        if (hipGetDevice(&dev) != hipSuccess || hipDeviceGetAttribute(&cus, hipDeviceAttributeMultiprocessorCount, dev) != hipSuccess) { grid = -1; return; }
        if (hipFuncSetAttribute((const void*)fwd_kernel, hipFuncAttributeMaxDynamicSharedMemorySize, LDS_BYTES) != hipSuccess) { fprintf(stderr, "kernel_launch: hipFuncSetAttribute failed\n"); grid = -1; return; }
        if (hipOccupancyMaxActiveBlocksPerMultiprocessor(&per_cu, (const void*)fwd_kernel, NTHR, LDS_BYTES) != hipSuccess || per_cu < 1) { fprintf(stderr, "kernel_launch: occupancy query says %d blocks per CU\n", per_cu); (void)hipGetLastError(); grid = -1; return; }
        grid = cus;
        if (grid != 256) fprintf(stderr, "kernel_launch: %d CUs; this kernel is laid out for 256\n", grid);
    }
    if (grid < 0) return;
    if (hipMemsetAsync((char*)d_ws + WS_CTL, 0, CTL_ZERO_BYTES, stream) != hipSuccess) { fprintf(stderr, "kernel_launch: memset failed\n"); return; }
    Args a{};
    for (int i = 0; i < 16; ++i) a.in[i] = (const float*)d_in[i];
    a.out = (float*)d_out; a.ws = (unsigned char*)d_ws;
#if MK_N_LAUNCHES == 1
    a.ph_lo = 0; a.ph_hi = N_PHASES;
    void* kargs[] = {&a};
    hipError_t e = hipLaunchCooperativeKernel((const void*)fwd_kernel, dim3(grid), dim3(NTHR), kargs, LDS_BYTES, stream);
    if (e != hipSuccess) fprintf(stderr, "kernel_launch: cooperative launch failed: %s (grid %d)\n", hipGetErrorString(e), grid);
#else
    for (int p = 0; p < N_PHASES; ++p) { a.ph_lo = p; a.ph_hi = p + 1; hipLaunchKernelGGL(fwd_kernel, dim3(grid), dim3(NTHR), LDS_BYTES, stream, a); }
#endif
}
```

```cpp
#include <hip/hip_runtime.h>
#include <hip/hip_cooperative_groups.h>
#include <cstdio>
#include <cstdint>
namespace cg = cooperative_groups;
namespace pg8 {
#define PG8_LAS __attribute__((address_space(3)))
typedef unsigned short bf16_t;
typedef short bf16x8 __attribute__((ext_vector_type(8)));
typedef float f32x4 __attribute__((ext_vector_type(4)));
typedef unsigned u32x4 __attribute__((ext_vector_type(4)));
constexpr int BM = 256, BK = 64, HALF = 128, HTB = HALF * BK * 2  , STAGE_BYTES = 8 * HTB, NXCD = 8, WGM = 8;

__host__ __device__ __forceinline__ int lds_byte(int r, int c) { const int st = (r >> 4) * 2 + (c >> 5), rr = r & 15, cc = c & 31, ob = rr * 64 + cc * 2; return st * 1024 + (ob ^ (((ob >> 9) & 1) << 5)); }
__host__ __device__ __forceinline__ void stage_rc(int b, int& R, int& C) { const int st = b / 1024, sb = b % 1024, swz = sb ^ (((sb >> 9) & 1) << 5); R = (st >> 1) * 16 + swz / 64; C = (st & 1) * 32 + (swz % 64) / 2; }
__host__ __device__ __forceinline__ int perm32(int rho) { const int n = rho >> 4, i = rho & 15; return 8 * (i >> 2) + 4 * n + (i & 3); }

struct Unit { int pm, pn; };
struct Gemm { const bf16_t* A; const bf16_t* Bt; int M, N, K; };

struct StaticOrder {
    int nM, nN, nwg, G, c;
    __host__ __device__ void init(int M, int N, int G_, int c_) { nM = M / BM; nN = N / BM; nwg = nM * nN; G = G_; c = c_; }
    __host__ __device__ bool next(int i, Unit& u) const {
        const long L = (long)i * G + c; if (L >= nwg) return false;
        int wgid = (int)L; { const int q = nwg / NXCD, r = nwg % NXCD, xcd = wgid % NXCD, off = wgid / NXCD; wgid = (xcd < r ? xcd * (q + 1) : r * (q + 1) + (xcd - r) * q) + off; }
        const int nig = WGM * nN, gid = wgid / nig, fm = gid * WGM, gsz = (nM - fm) < WGM ? (nM - fm) : WGM;
        u.pm = fm + ((wgid % nig) % gsz); u.pn = (wgid % nig) / gsz; return true;
    }
    __device__ __forceinline__ void a_ready(const Unit&) const {}
    __device__ __forceinline__ void done(const Unit&) const {}
};

__device__ __forceinline__ unsigned cvt_pk_bf16(float lo, float hi) { unsigned r; asm volatile("v_cvt_pk_bf16_f32 %0, %1, %2" : "=v"(r) : "v"(lo), "v"(hi)); return r; }
typedef float f32x2 __attribute__((ext_vector_type(2)));
typedef __bf16 bf16x2_t __attribute__((ext_vector_type(2)));
typedef unsigned u32x2 __attribute__((ext_vector_type(2)));
__device__ __forceinline__ unsigned pkbf(float lo, float hi) { f32x2 v = {lo, hi}; bf16x2_t b = __builtin_convertvector(v, bf16x2_t); return __builtin_bit_cast(unsigned, b); }
__device__ __forceinline__ u32x4 pk8(f32x4 a, f32x4 b) { return (u32x4){pkbf(a[0], a[1]), pkbf(a[2], a[3]), pkbf(b[0], b[1]), pkbf(b[2], b[3])}; }
__device__ __forceinline__ float dot4(f32x4 a) { return (a[0] * a[0] + a[1] * a[1]) + (a[2] * a[2] + a[3] * a[3]); }
__device__ __forceinline__ float sum4(f32x4 a) { return (a[0] + a[1]) + (a[2] + a[3]); }
__device__ __forceinline__ float silu1(float v) { return v * __builtin_amdgcn_rcpf(1.0f + __builtin_amdgcn_exp2f(-1.4426950408889634f * v)); }
__device__ __forceinline__ f32x4 silu4(f32x4 v) { return (f32x4){silu1(v[0]), silu1(v[1]), silu1(v[2]), silu1(v[3])}; }
constexpr float RMS_EPS_F = 1e-6f;
constexpr float QSCALE = 0.125f * 1.4426950408889634f;

struct EpiIn {
    static constexpr bool PERM = true, AFTER_DRAIN = false;
    bf16_t *QA, *KA, *VA, *IQ, *IK, *QB, *KB, *VB, *GB; float* IW;
    const float *qnw, *knw;
    PG8_LAS float* xch;
    __device__ __forceinline__ void prefetch(const Unit&, int, int) {}
    __device__ __forceinline__ void advance() {}
    __device__ __forceinline__ void operator()(const f32x4 (&acc)[2][2][4][2], const Unit& u, int wr, int wc, int fr, int fq) {
        asm volatile("" : "+v"(fr), "+v"(fq));
        const int row0 = u.pm * BM + wr * 64 + fr, pn = u.pn;
        if (pn < 2) {
            const int head = 4 * pn + wc;
            const f32x4 w0 = *(const f32x4*)(qnw + 8 * fq), w1 = *(const f32x4*)(qnw + 8 * fq + 4), w2 = *(const f32x4*)(qnw + 32 + 8 * fq), w3 = *(const f32x4*)(qnw + 36 + 8 * fq);
#pragma unroll
            for (int ai = 0; ai < 2; ++ai)
#pragma unroll
                for (int m = 0; m < 4; ++m) {
                    f32x4 a0 = acc[ai][0][m][0], a1 = acc[ai][0][m][1], b0 = acc[ai][1][m][0], b1 = acc[ai][1][m][1];
                    float ss = (dot4(a0) + dot4(a1)) + (dot4(b0) + dot4(b1));
                    ss += __shfl_xor(ss, 16); ss += __shfl_xor(ss, 32);
                    const float rs = QSCALE / sqrtf(ss * (1.0f / 64.0f) + RMS_EPS_F);
                    bf16_t* p = QA + (size_t)(row0 + ai * HALF + m * 16) * 512 + head * 64 + 8 * fq;
                    *(u32x4*)p = pk8(a0 * w0 * rs, a1 * w1 * rs); *(u32x4*)(p + 32) = pk8(b0 * w2 * rs, b1 * w3 * rs);
                }
        } else if (pn == 2) {
            if (wc >= 2) {
#pragma unroll
                for (int ai = 0; ai < 2; ++ai)
#pragma unroll
                    for (int m = 0; m < 4; ++m) {
                        float ss = (dot4(acc[ai][0][m][0]) + dot4(acc[ai][0][m][1])) + (dot4(acc[ai][1][m][0]) + dot4(acc[ai][1][m][1]));
                        ss += __shfl_xor(ss, 16); ss += __shfl_xor(ss, 32);
                        if (fq == 0) xch[(ai * HALF + wr * 64 + m * 16 + fr) * 2 + (wc - 2)] = ss;
                    }
            }
            asm volatile("s_waitcnt lgkmcnt(0)" ::: "memory"); __builtin_amdgcn_s_barrier(); asm volatile("" ::: "memory");
            if (wc < 2) {
                const f32x4 w0 = *(const f32x4*)(knw + 8 * fq), w1 = *(const f32x4*)(knw + 8 * fq + 4), w2 = *(const f32x4*)(knw + 32 + 8 * fq), w3 = *(const f32x4*)(knw + 36 + 8 * fq);
#pragma unroll
                for (int ai = 0; ai < 2; ++ai)
#pragma unroll
                    for (int m = 0; m < 4; ++m) {
                        const int rl = ai * HALF + wr * 64 + m * 16 + fr;
                        const f32x2 pr = *(const PG8_LAS f32x2*)(xch + rl * 2);
                        const float rc = 1.0f / sqrtf((pr[0] + pr[1]) * (1.0f / 128.0f) + RMS_EPS_F);
                        f32x4 a0 = acc[ai][0][m][0] * rc, a1 = acc[ai][0][m][1] * rc, b0 = acc[ai][1][m][0] * rc, b1 = acc[ai][1][m][1] * rc;
                        const size_t row = (size_t)(row0 + ai * HALF + m * 16);
                        if (wc == 0) {
                            float ss = (dot4(a0) + dot4(a1)) + (dot4(b0) + dot4(b1));
                            ss += __shfl_xor(ss, 16); ss += __shfl_xor(ss, 32);
                            const float rs = 1.0f / sqrtf(ss * (1.0f / 64.0f) + RMS_EPS_F);
                            bf16_t* p = KA + row * 64 + 8 * fq;
                            *(u32x4*)p = pk8(a0 * w0 * rs, a1 * w1 * rs); *(u32x4*)(p + 32) = pk8(b0 * w2 * rs, b1 * w3 * rs);
                        } else {
                            bf16_t* p = VA + row * 64 + 8 * fq;
                            *(u32x4*)p = pk8(a0, a1); *(u32x4*)(p + 32) = pk8(b0, b1);
                        }
                    }
            }
        } else if (pn == 3) {
#pragma unroll
            for (int ai = 0; ai < 2; ++ai)
#pragma unroll
                for (int m = 0; m < 4; ++m) {
                    const size_t row = (size_t)(row0 + ai * HALF + m * 16);
                    *(u32x4*)(IQ + row * 128 + 32 * wc + 8 * fq) = pk8(acc[ai][0][m][0], acc[ai][0][m][1]);
                    if (wc == 0) *(u32x4*)(IK + row * 32 + 8 * fq) = pk8(acc[ai][1][m][0], acc[ai][1][m][1]);
                    if (wc == 1 && fq == 0) *(f32x4*)(IW + row * 4) = acc[ai][1][m][0];
                }
        } else if (pn < 8) {
            const int head = 4 * (pn & 1) + wc; bf16_t* dst = pn < 6 ? QB : KB;
            const float lg2 = __log2f(1.0f - __builtin_amdgcn_exp2f(-5.0f - (float)head));
            f32x4 iv0, iv1;
#pragma unroll
            for (int i = 0; i < 4; ++i) { iv0[i] = __builtin_amdgcn_exp2f(-(float)(8 * fq + i) * (13.287712379549449f / 32.0f)) * 0.15915494309189535f; iv1[i] = __builtin_amdgcn_exp2f(-(float)(8 * fq + 4 + i) * (13.287712379549449f / 32.0f)) * 0.15915494309189535f; }
#pragma unroll
            for (int ai = 0; ai < 2; ++ai)
#pragma unroll
                for (int m = 0; m < 4; ++m) {
                    const int row = row0 + ai * HALF + m * 16, pos = row & 2047; const float fp = (float)pos;
                    const float sc = pn < 6 ? __builtin_amdgcn_exp2f((float)(pos & 63) * lg2) : 0.125f * __builtin_amdgcn_exp2f(-(float)(pos & 63) * lg2);
                    f32x4 c0, c1, s0, s1;
#pragma unroll
                    for (int i = 0; i < 4; ++i) {
                        const float r0 = __builtin_amdgcn_fractf(fp * iv0[i]), r1 = __builtin_amdgcn_fractf(fp * iv1[i]);
                        c0[i] = __builtin_amdgcn_cosf(r0) * sc; s0[i] = __builtin_amdgcn_sinf(r0) * sc; c1[i] = __builtin_amdgcn_cosf(r1) * sc; s1[i] = __builtin_amdgcn_sinf(r1) * sc;
                    }
                    const f32x4 a0 = acc[ai][0][m][0], a1 = acc[ai][0][m][1], b0 = acc[ai][1][m][0], b1 = acc[ai][1][m][1];
                    bf16_t* p = dst + (size_t)row * 512 + head * 64 + 8 * fq;
                    *(u32x4*)p = pk8(a0 * c0 - b0 * s0, a1 * c1 - b1 * s1); *(u32x4*)(p + 32) = pk8(a0 * s0 + b0 * c0, a1 * s1 + b1 * c1);
                }
        } else {
            const int head = 4 * (pn & 1) + wc; bf16_t* dst = pn < 10 ? VB : GB; const bool act = pn >= 10;
#pragma unroll
            for (int ai = 0; ai < 2; ++ai)
#pragma unroll
                for (int m = 0; m < 4; ++m) {
                    f32x4 a0 = acc[ai][0][m][0], a1 = acc[ai][0][m][1], b0 = acc[ai][1][m][0], b1 = acc[ai][1][m][1];
                    if (act) { a0 = silu4(a0); a1 = silu4(a1); b0 = silu4(b0); b1 = silu4(b1); }
                    bf16_t* p = dst + (size_t)(row0 + ai * HALF + m * 16) * 512 + head * 64 + 8 * fq;
                    *(u32x4*)p = pk8(a0, a1); *(u32x4*)(p + 32) = pk8(b0, b1);
                }
        }
    }
};

struct EpiOut {
    static constexpr bool PERM = true, AFTER_DRAIN = false;
    const float* rms; bf16_t* x1b; float ss[8];
    __device__ __forceinline__ void prefetch(const Unit&, int, int) {}
    __device__ __forceinline__ void advance() {}
    __device__ __forceinline__ void operator()(const f32x4 (&acc)[2][2][4][2], const Unit& u, int wr, int wc, int fr, int fq) {
        asm volatile("" : "+v"(fr), "+v"(fq));
        const int row0 = u.pm * BM + wr * 64 + fr, col0 = u.pn * BM + wc * 32 + 8 * fq;
#pragma unroll
        for (int ai = 0; ai < 2; ++ai)
#pragma unroll
            for (int m = 0; m < 4; ++m) {
                const int row = row0 + ai * HALF + m * 16; const size_t off = (size_t)row * 1024 + col0; const float rm = rms[row]; float s = 0.f;
#pragma unroll
                for (int bj = 0; bj < 2; ++bj) {
                    const u32x4 xv = *(const u32x4*)(x1b + off + bj * HALF);
                    const f32x4 x0 = {__uint_as_float(xv[0] << 16), __uint_as_float(xv[0] & 0xffff0000u), __uint_as_float(xv[1] << 16), __uint_as_float(xv[1] & 0xffff0000u)};
                    const f32x4 x1 = {__uint_as_float(xv[2] << 16), __uint_as_float(xv[2] & 0xffff0000u), __uint_as_float(xv[3] << 16), __uint_as_float(xv[3] & 0xffff0000u)};
                    const f32x4 r0 = x0 * rm + acc[ai][bj][m][0], r1 = x1 * rm + acc[ai][bj][m][1];
                    *(u32x4*)(x1b + off + bj * HALF) = pk8(r0, r1);
                    s += dot4(r0) + dot4(r1);
                }
                ss[ai * 4 + m] += s;
            }
    }
};

struct EpiGU {
    static constexpr bool PERM = true, AFTER_DRAIN = false;
    const float* r2; bf16_t* act; f32x4 rc0, rc1, rn0, rn1; unsigned long long tepi;
    __device__ __forceinline__ void prefetch(const Unit& u, int wr, int fr) {
        const float* p = r2 + u.pm * BM + wr * 64 + fr;
        rn0 = (f32x4){p[0], p[16], p[32], p[48]}; rn1 = (f32x4){p[HALF], p[HALF + 16], p[HALF + 32], p[HALF + 48]};
    }
    __device__ __forceinline__ void advance() { rc0 = rn0; rc1 = rn1; }
    __device__ __forceinline__ void operator()(const f32x4 (&acc)[2][2][4][2], const Unit& u, int wr, int wc, int fr, int fq) {
#ifdef PROBE_TIMER
        const unsigned long long te0_ = __builtin_amdgcn_s_memtime();
#endif
        asm volatile("" : "+v"(fr), "+v"(fq));
        const int row0 = u.pm * BM + wr * 64 + fr, col0 = u.pn * HALF + wc * 32 + 8 * fq;
#pragma unroll
        for (int ai = 0; ai < 2; ++ai)
#pragma unroll
            for (int m = 0; m < 4; ++m) {
                const int row = row0 + ai * HALF + m * 16; const float rr = ai ? rc1[m] : rc0[m];
                const f32x4 g0 = acc[ai][0][m][0] * rr, g1 = acc[ai][0][m][1] * rr, u0 = acc[ai][1][m][0] * rr, u1 = acc[ai][1][m][1] * rr;
                *(u32x4*)(act + (size_t)row * 2816 + col0) = pk8(silu4(g0) * u0, silu4(g1) * u1);
            }
#ifdef PROBE_TIMER
        asm volatile("s_waitcnt vmcnt(0)" ::: "memory"); tepi += __builtin_amdgcn_s_memtime() - te0_;
#endif
    }
};

struct EpiDown {
    static constexpr bool PERM = true, AFTER_DRAIN = false;
    const bf16_t* x1b; float* out;
    __device__ __forceinline__ void prefetch(const Unit&, int, int) {}
    __device__ __forceinline__ void advance() {}
    __device__ __forceinline__ void operator()(const f32x4 (&acc)[2][2][4][2], const Unit& u, int wr, int wc, int fr, int fq) {
        asm volatile("" : "+v"(fr), "+v"(fq));
        const int row0 = u.pm * BM + wr * 64 + fr, col0 = u.pn * BM + wc * 32 + 8 * fq;
#pragma unroll
        for (int ai = 0; ai < 2; ++ai)
#pragma unroll
            for (int m = 0; m < 4; ++m) {
                const size_t off = (size_t)(row0 + ai * HALF + m * 16) * 1024 + col0;
#pragma unroll
                for (int bj = 0; bj < 2; ++bj) {
                    const u32x4 xv = *(const u32x4*)(x1b + off + bj * HALF);
                    const f32x4 x0 = {__uint_as_float(xv[0] << 16), __uint_as_float(xv[0] & 0xffff0000u), __uint_as_float(xv[1] << 16), __uint_as_float(xv[1] & 0xffff0000u)};
                    const f32x4 x1 = {__uint_as_float(xv[2] << 16), __uint_as_float(xv[2] & 0xffff0000u), __uint_as_float(xv[3] << 16), __uint_as_float(xv[3] & 0xffff0000u)};
                    *(f32x4*)(out + off + bj * HALF) = x0 + acc[ai][bj][m][0]; *(f32x4*)(out + off + bj * HALF + 4) = x1 + acc[ai][bj][m][1];
                }
            }
    }
};

struct PanelOrder {
    int pm, ntn;
    __device__ __forceinline__ bool next(int i, Unit& u) const { if (i >= ntn) return false; u.pm = pm; u.pn = i; return true; }
    __device__ __forceinline__ void a_ready(const Unit&) const {}
    __device__ __forceinline__ void done(const Unit&) const {}
};

template <class Epi, class Sched, bool ALIGN_EPI = false, bool SP2 = false>
__device__ __forceinline__ void gemm_phase(PG8_LAS unsigned char* lds, const Gemm g, const Sched& S, Epi& E, int wave_in) {
    unsigned ones_ = ~0u; asm volatile("" : "+s"(ones_)); int tid_ = wave_in * 64 + (int)__builtin_amdgcn_mbcnt_hi(ones_, __builtin_amdgcn_mbcnt_lo(ones_, 0u));
    const int tid = tid_, wid = __builtin_amdgcn_readfirstlane(tid >> 6), lane = tid & 63, wr = wid >> 2, wc = wid & 3, fr = lane & 15, fq = lane >> 4;
    const int K = g.K, nt = K / BK;
    unsigned voffA[2], voffB[2];
#pragma unroll
    for (int i = 0; i < 2; ++i) { int R, C; stage_rc(tid * 16 + i * 8192, R, C); const int Rb = Epi::PERM ? ((R & ~31) + perm32(R & 31)) : R;
        voffA[i] = (unsigned)(R * K + C) * 2u; voffB[i] = (unsigned)(Rb * K + C) * 2u; }
    const size_t kstep = (size_t)(BK * 2);
    const size_t hstep = (size_t)HALF * K * 2;
    const size_t tstep = 2 * hstep;
    const unsigned ldsw = (unsigned)wid * 1024u;
    const int aoff = lds_byte(wr * 64 + fr, fq * 8), boff = lds_byte(wc * 32 + fr, fq * 8);
#define PG8_SA(b, h) (((b) * 2 + (h)) * HTB)
#define PG8_SB(b, h) ((4 + (b) * 2 + (h)) * HTB)
#define PG8_STAGE(bufoff, gbase, voff) do { _Pragma("unroll") for (int _i = 0; _i < 2; ++_i) \
        __builtin_amdgcn_global_load_lds((const unsigned*)((const char*)(gbase) + (voff)[_i]), (PG8_LAS unsigned*)(lds + (bufoff) + ldsw + _i * 8192), 16, 0, 0); } while (0)
#define PG8_LDA(dst, b, h) do { _Pragma("unroll") for (int m = 0; m < 4; ++m) _Pragma("unroll") for (int k = 0; k < 2; ++k) dst[m][k] = *(const PG8_LAS bf16x8*)(lds + PG8_SA(b, h) + aoff + m * 2048 + k * 1024); } while (0)
#define PG8_LDB(dst, b, h) do { _Pragma("unroll") for (int n = 0; n < 2; ++n) _Pragma("unroll") for (int k = 0; k < 2; ++k) dst[n][k] = *(const PG8_LAS bf16x8*)(lds + PG8_SB(b, h) + boff + n * 2048 + k * 1024); } while (0)
#define PG8_MMA(ai, bj, At, Bt) do { __builtin_amdgcn_s_setprio(1); _Pragma("unroll") for (int m = 0; m < 4; ++m) _Pragma("unroll") for (int n = 0; n < 2; ++n) _Pragma("unroll") for (int k = 0; k < 2; ++k) \
        acc[ai][bj][m][n] = __builtin_amdgcn_mfma_f32_16x16x32_bf16(Bt[n][k], At[m][k], acc[ai][bj][m][n], 0, 0, 0); __builtin_amdgcn_s_setprio(0); } while (0)
#define PG8_WAIT_V(n) asm volatile("s_waitcnt vmcnt(" #n ")" ::: "memory")
#define PG8_WAIT_L(n) asm volatile("s_waitcnt lgkmcnt(" #n ")" ::: "memory")
#define PG8_BAR __builtin_amdgcn_s_barrier()
#define PG8_SCHED __builtin_amdgcn_sched_barrier(0)
    Unit cur, nxt; int ui = 0;
    if (!S.next(0, cur)) return;
    E.prefetch(cur, wr, fr); E.advance();
    f32x4 acc[2][2][4][2];
#pragma unroll
    for (int a = 0; a < 2; ++a)
#pragma unroll
        for (int b = 0; b < 2; ++b)
#pragma unroll
            for (int m = 0; m < 4; ++m)
#pragma unroll
                for (int n = 0; n < 2; ++n) acc[a][b][m][n] = (f32x4){0.f, 0.f, 0.f, 0.f};
    bf16x8 At[4][2], B0[2][2], B1[2][2];
    const char* cA = (const char*)g.A + (size_t)cur.pm * tstep; const char* cB = (const char*)g.Bt + (size_t)cur.pn * tstep;
    S.a_ready(cur);
    if constexpr (SP2) {
        PG8_STAGE(PG8_SB(0, 0), cB, voffB); PG8_STAGE(PG8_SB(0, 1), cB + hstep, voffB); PG8_STAGE(PG8_SA(0, 0), cA, voffA); PG8_STAGE(PG8_SA(0, 1), cA + hstep, voffA);
        if (wr == 1) PG8_BAR;
        PG8_WAIT_V(2); PG8_BAR;
        PG8_STAGE(PG8_SB(1, 0), cB + kstep, voffB); PG8_STAGE(PG8_SA(1, 0), cA + kstep, voffA); PG8_STAGE(PG8_SB(1, 1), cB + hstep + kstep, voffB);
        PG8_WAIT_V(6); PG8_BAR;
    } else {
        PG8_STAGE(PG8_SB(0, 0), cB, voffB); PG8_STAGE(PG8_SA(0, 0), cA, voffA); PG8_STAGE(PG8_SB(0, 1), cB + hstep, voffB); PG8_STAGE(PG8_SA(0, 1), cA + hstep, voffA);
        if (wr == 1) PG8_BAR;
        PG8_WAIT_V(4); PG8_BAR;
        PG8_STAGE(PG8_SB(1, 0), cB + kstep, voffB); PG8_STAGE(PG8_SA(1, 0), cA + kstep, voffA); PG8_STAGE(PG8_SB(1, 1), cB + hstep + kstep, voffB);
        PG8_WAIT_V(6); PG8_BAR;
    }
    for (;;) {
        const bool has_next = S.next(ui + 1, nxt);
        const char* nA = has_next ? (const char*)g.A + (size_t)nxt.pm * tstep : cA; const char* nB = has_next ? (const char*)g.Bt + (size_t)nxt.pn * tstep : cB;
        for (int t = 0; t < nt; t += 2) {
            const bool last = (t == nt - 2);
            const char* a1 = cA + (size_t)(t + 1) * kstep;
            const char* a2 = last ? nA : cA + (size_t)(t + 2) * kstep; const char* b2 = last ? nB : cB + (size_t)(t + 2) * kstep;
            const char* a3 = a2 + kstep; const char* b3 = b2 + kstep;
            if (last && has_next) { S.a_ready(nxt); E.prefetch(nxt, wr, fr); }
            if constexpr (SP2) {
            PG8_LDB(B0, 0, 0); PG8_LDB(B1, 0, 1); PG8_SCHED; PG8_LDA(At, 0, 0); PG8_STAGE(PG8_SA(1, 1), a1 + hstep, voffA);
            PG8_WAIT_V(8); PG8_WAIT_L(0); PG8_BAR; PG8_MMA(0, 0, At, B0); PG8_MMA(0, 1, At, B1); PG8_BAR; PG8_SCHED;
            PG8_LDA(At, 0, 1); PG8_STAGE(PG8_SB(0, 0), b2, voffB); PG8_STAGE(PG8_SB(0, 1), b2 + hstep, voffB); PG8_STAGE(PG8_SA(0, 0), a2, voffA);
            PG8_WAIT_V(8); PG8_WAIT_L(0); PG8_BAR; PG8_MMA(1, 0, At, B0); PG8_MMA(1, 1, At, B1); PG8_BAR; PG8_SCHED;
            PG8_LDB(B0, 1, 0); PG8_LDB(B1, 1, 1); PG8_SCHED; PG8_LDA(At, 1, 0); PG8_STAGE(PG8_SA(0, 1), a2 + hstep, voffA);
            PG8_WAIT_V(8); PG8_WAIT_L(0); PG8_BAR; PG8_MMA(0, 0, At, B0); PG8_MMA(0, 1, At, B1); PG8_BAR; PG8_SCHED;
            PG8_LDA(At, 1, 1); PG8_STAGE(PG8_SB(1, 0), b3, voffB); PG8_STAGE(PG8_SB(1, 1), b3 + hstep, voffB); PG8_STAGE(PG8_SA(1, 0), a3, voffA);
            PG8_WAIT_V(8); PG8_WAIT_L(0); PG8_BAR; PG8_MMA(1, 0, At, B0); PG8_MMA(1, 1, At, B1); PG8_BAR; PG8_SCHED;
            } else {
            PG8_LDB(B0, 0, 0); PG8_SCHED; PG8_LDA(At, 0, 0); PG8_STAGE(PG8_SA(1, 1), a1 + hstep, voffA);
            PG8_WAIT_L(8); PG8_BAR; PG8_WAIT_L(0); PG8_MMA(0, 0, At, B0); PG8_BAR; PG8_SCHED;
            PG8_LDB(B1, 0, 1); PG8_STAGE(PG8_SB(0, 0), b2, voffB);
            PG8_BAR; PG8_WAIT_L(0); PG8_MMA(0, 1, At, B1); PG8_BAR;
            PG8_LDA(At, 0, 1); PG8_STAGE(PG8_SA(0, 0), a2, voffA);
            PG8_BAR; PG8_WAIT_L(0); PG8_MMA(1, 0, At, B0); PG8_BAR; PG8_SCHED;
            PG8_STAGE(PG8_SB(0, 1), b2 + hstep, voffB);
            PG8_WAIT_V(6); PG8_BAR; PG8_MMA(1, 1, At, B1); PG8_BAR;
            PG8_LDB(B0, 1, 0); PG8_SCHED; PG8_LDA(At, 1, 0); PG8_STAGE(PG8_SA(0, 1), a2 + hstep, voffA);
            PG8_WAIT_L(8); PG8_BAR; PG8_WAIT_L(0); PG8_MMA(0, 0, At, B0); PG8_BAR; PG8_SCHED;
            PG8_LDB(B1, 1, 1); PG8_STAGE(PG8_SB(1, 0), b3, voffB);
            PG8_BAR; PG8_WAIT_L(0); PG8_MMA(0, 1, At, B1); PG8_BAR;
            PG8_LDA(At, 1, 1); PG8_STAGE(PG8_SA(1, 0), a3, voffA);
            PG8_BAR; PG8_WAIT_L(0); PG8_MMA(1, 0, At, B0); PG8_BAR; PG8_SCHED;
            PG8_STAGE(PG8_SB(1, 1), b3 + hstep, voffB);
            PG8_WAIT_V(6); PG8_BAR; PG8_MMA(1, 1, At, B1); PG8_BAR;
            }
        }
        if constexpr (ALIGN_EPI) { if (wr == 0) PG8_BAR; }
        if constexpr (!Epi::AFTER_DRAIN) { E(acc, cur, wr, wc, fr, fq); E.advance(); S.done(cur); }
        if (!has_next) break;
#pragma unroll
        for (int a = 0; a < 2; ++a)
#pragma unroll
            for (int b = 0; b < 2; ++b)
#pragma unroll
                for (int m = 0; m < 4; ++m)
#pragma unroll
                    for (int n = 0; n < 2; ++n) acc[a][b][m][n] = (f32x4){0.f, 0.f, 0.f, 0.f};
        cur = nxt; cA = nA; cB = nB; ++ui;
        if constexpr (ALIGN_EPI) { if (wr == 1) PG8_BAR; }
    }
    PG8_WAIT_V(0);
    if constexpr (!ALIGN_EPI) { if (wr == 0) PG8_BAR; }
    PG8_BAR;
    (void)lane;
#undef PG8_SA
#undef PG8_SB
#undef PG8_STAGE
#undef PG8_LDA
#undef PG8_LDB
#undef PG8_MMA
#undef PG8_WAIT_V
#undef PG8_WAIT_L
#undef PG8_BAR
#undef PG8_SCHED
}
}

constexpr int BATCH = 32, SEQ = 2048, DM = 1024, MTOK = BATCH * SEQ;
constexpr int INW = 2852, NIN = 3072, FF = 2816, NGU = 2 * FF;
constexpr int NWAVES = 8, NTHR = 512;
#ifndef MK_N_LAUNCHES
#define MK_N_LAUNCHES 1
#endif
constexpr int N_PHASES = 6;
constexpr size_t MiB = 1u << 20;
constexpr size_t WS_CTL = 0;
constexpr size_t WS_COS = 1 * MiB, WS_SIN = WS_COS + 256 * 1024;
constexpr size_t WS_BT = WS_SIN + 256 * 1024;
constexpr size_t WS_R2 = 2 * MiB, WS_RMS = 2 * MiB + 512 * 1024;
constexpr size_t WS_WIN = 4 * MiB, WS_WOUT = 10 * MiB, WS_WGU = 12 * MiB, WS_WDN = 23 * MiB;
constexpr size_t WS_XB = 32 * MiB;
constexpr size_t WS_MIX = 160 * MiB;
constexpr size_t WS_QA = 288 * MiB, WS_QB = 352 * MiB, WS_KB = 416 * MiB, WS_VB = 480 * MiB, WS_GB = 544 * MiB;
constexpr size_t WS_KA = 608 * MiB, WS_VA = 616 * MiB;
constexpr size_t WS_IQ = 624 * MiB;
constexpr size_t WS_ACT = 288 * MiB;
constexpr size_t WS_IK = 640 * MiB, WS_IW = 644 * MiB;
constexpr size_t WS_MASK = 648 * MiB;
constexpr size_t WS_SCR = 672 * MiB;
constexpr size_t WS_END = 800 * MiB;
static_assert(WS_ACT + (size_t)MTOK * FF * 2 <= WS_IK && WS_IQ + (size_t)MTOK * 128 * 2 <= WS_IK && WS_WDN + (size_t)DM * FF * 2 <= WS_XB && WS_WGU + (size_t)NGU * DM * 2 <= WS_WDN, "d_ws map");
constexpr int RING_BYTES = 131072;
constexpr int XCH_OFF = RING_BYTES;
constexpr int P2_SC = 0, SCW = 2052;
constexpr int P2_MASK = 132096;
constexpr int MISC_OFF = 163584;
constexpr int LDS_BYTES = 163840;
static_assert(P2_SC + 16 * SCW * 4 <= P2_MASK && P2_MASK + 16384 <= MISC_OFF, "P2 LDS map");

#define LAS __attribute__((address_space(3)))
typedef unsigned short bf16;
typedef unsigned v4u __attribute__((ext_vector_type(4)));
typedef unsigned v2u __attribute__((ext_vector_type(2)));
typedef float f32x4 __attribute__((ext_vector_type(4)));
typedef float f32x16 __attribute__((ext_vector_type(16)));
typedef short bf16x8 __attribute__((ext_vector_type(8)));
typedef short s16x4 __attribute__((ext_vector_type(4)));
#define LDS_WAIT() asm volatile("s_waitcnt lgkmcnt(0)" ::: "memory")
using pg8::pkbf;
__device__ __forceinline__ float bf2f(unsigned short h) { return __uint_as_float((unsigned)h << 16); }
__device__ __forceinline__ float bflo(unsigned w) { return __uint_as_float(w << 16); }
__device__ __forceinline__ float bfhi(unsigned w) { return __uint_as_float(w & 0xffff0000u); }
__device__ __forceinline__ float wave_sum(float v) {
#pragma unroll
    for (int o = 1; o < 64; o <<= 1) v += __shfl_xor(v, o);
    return v;
}
__device__ __forceinline__ s16x4 vtr(const LAS unsigned char* p) { return __builtin_bit_cast(s16x4, __builtin_amdgcn_ds_read_tr16_b64_v4i16((LAS s16x4*)p)); }
__device__ __forceinline__ bf16x8 cat8(s16x4 lo, s16x4 hi) { return (bf16x8){lo[0], lo[1], lo[2], lo[3], hi[0], hi[1], hi[2], hi[3]}; }
__device__ __forceinline__ int crow(int r, int hi) { return (r & 3) + 8 * (r >> 2) + 4 * hi; }

__device__ __forceinline__ int lane_id() { unsigned ones = ~0u; asm volatile("" : "+s"(ones)); return (int)__builtin_amdgcn_mbcnt_hi(ones, __builtin_amdgcn_mbcnt_lo(ones, 0u)); }
struct KArgs { const float* in[16]; float* out; unsigned char* ws; int ph_lo, ph_hi; };
struct Frame {
    LAS unsigned char* lds;
    unsigned* ctl;
    unsigned char* ws;
    int tid, lane, wave, vcu, G;
    const __attribute__((address_space(4))) KArgs* ap;
    __device__ __forceinline__ const float* x() const { return ap->in[0]; }
    __device__ __forceinline__ const float* norm1_w() const { return ap->in[1]; }
    __device__ __forceinline__ const float* w_in() const { return ap->in[2]; }
    __device__ __forceinline__ const float* q_norm_w() const { return ap->in[3]; }
    __device__ __forceinline__ const float* k_norm_w() const { return ap->in[4]; }
    __device__ __forceinline__ const float* kv_norm_w() const { return ap->in[5]; }
    __device__ __forceinline__ const float* w_uk() const { return ap->in[6]; }
    __device__ __forceinline__ const float* w_uv() const { return ap->in[7]; }
    __device__ __forceinline__ const float* rel_bias() const { return ap->in[8]; }
    __device__ __forceinline__ const float* ret_gn_w() const { return ap->in[9]; }
    __device__ __forceinline__ const float* ret_gn_b() const { return ap->in[10]; }
    __device__ __forceinline__ const float* w_out() const { return ap->in[11]; }
    __device__ __forceinline__ const float* norm2_w() const { return ap->in[12]; }
    __device__ __forceinline__ const float* w_gate() const { return ap->in[13]; }
    __device__ __forceinline__ const float* w_up() const { return ap->in[14]; }
    __device__ __forceinline__ const float* w_down() const { return ap->in[15]; }
    __device__ __forceinline__ float* out() const { return ap->out; }
#define WSB_(name, off) __device__ __forceinline__ bf16* name() const { return (bf16*)(ws + (off)); }
#define WSF_(name, off) __device__ __forceinline__ float* name() const { return (float*)(ws + (off)); }
    WSB_(WIN, WS_WIN) WSB_(WOUT, WS_WOUT) WSB_(WGU, WS_WGU) WSB_(WDN, WS_WDN) WSB_(XB, WS_XB) WSB_(MIX, WS_MIX) WSB_(QA, WS_QA) WSB_(QB, WS_QB) WSB_(KB, WS_KB) WSB_(VB, WS_VB) WSB_(GB, WS_GB)
    WSB_(KA, WS_KA) WSB_(VA, WS_VA) WSB_(IQ, WS_IQ) WSB_(IK, WS_IK) WSB_(ACT, WS_ACT)
    WSF_(IW, WS_IW) WSF_(R2, WS_R2) WSF_(RMS, WS_RMS) WSF_(COS, WS_COS) WSF_(SIN, WS_SIN) WSF_(BT, WS_BT) WSF_(SCR, WS_SCR)
    __device__ __forceinline__ unsigned long long* MASK() const { return (unsigned long long*)(ws + WS_MASK); }
#undef WSB_
#undef WSF_
};

__device__ __forceinline__ int zcol(int n) {
    const int pn = n >> 8, tc = n & 255, bj = tc >> 7, wc = (tc >> 5) & 3, j = tc & 31, d = bj * 32 + j;
    if (pn < 2) return (4 * pn + wc) * 64 + d;
    if (pn == 2) { if (wc == 0) return -2 - d; if (wc == 1) return -2 - (64 + d); return 512 + (wc - 2) * 64 + d; }
    if (pn == 3) { if (bj == 0) return 640 + wc * 32 + j; if (wc == 0) return 768 + j; if (wc == 1 && j < 4) return 800 + j; return -1; }
    const int g = (pn - 4) >> 1, head = 4 * ((pn - 4) & 1) + wc;
    return 804 + g * 512 + head * 64 + d;
}
template <class SRC>
__device__ __forceinline__ void tr_item(SRC src, int Kdim, bf16* WT, int k0, int n0, LAS float* scr, int lane) {
#pragma unroll 4
    for (int i = 0; i < 32; ++i) { const int kk = 2 * i + (lane >> 5); scr[kk * 33 + (lane & 31)] = src(k0 + kk); }
    LDS_WAIT(); asm volatile("" ::: "memory");
    const int c = lane & 7;
#pragma unroll
    for (int j = 0; j < 4; ++j) { const int n = (lane >> 3) + 8 * j; const LAS float* s = scr + (8 * c) * 33 + n;
        v4u o; o.x = pkbf(s[0 * 33], s[1 * 33]); o.y = pkbf(s[2 * 33], s[3 * 33]); o.z = pkbf(s[4 * 33], s[5 * 33]); o.w = pkbf(s[6 * 33], s[7 * 33]);
        *(v4u*)(WT + (size_t)(n0 + n) * Kdim + k0 + 8 * c) = o; }
    LDS_WAIT(); asm volatile("" ::: "memory");
}
__device__ __forceinline__ int t5_bucket(int rel) {
    const int n = rel < 0 ? -rel : rel; int b;
    if (n < 8) b = n; else if (n < 12) b = 8; else if (n < 16) b = 9; else if (n < 23) b = 10; else if (n < 32) b = 11; else if (n < 46) b = 12; else if (n < 64) b = 13; else if (n < 91) b = 14; else b = 15;
    return (rel > 0 ? 16 : 0) + b;
}
__device__ __forceinline__ void p0_prologue(Frame& F) {
    LAS float* scr = (LAS float*)(F.lds + F.wave * 16384);
    const int lane = F.lane, gw = F.vcu * NWAVES + F.wave, NGW = F.G * NWAVES;
    if (blockIdx.x == 0 && F.tid == 0) F.ctl[0] = 0u;
    constexpr int I_IN = 16 * (NIN / 32), I_OUT = 16 * 32, I_GU = 16 * (NGU / 32), I_DN = (FF / 64) * 32, NITEMS = I_IN + I_OUT + I_GU + I_DN;
    auto do_item = [&](int it) {
        int r = it;
        if (r < I_IN) {
            const int kb = r / (NIN / 32), nb = r % (NIN / 32), f = zcol(32 * nb + (lane & 31));
            const float* w_in = F.w_in(); const float* nw = F.norm1_w();
            if (f >= -1) tr_item([&](int k) { return f >= 0 ? nw[k] * w_in[(size_t)k * INW + f] : 0.0f; }, DM, F.WIN(), 64 * kb, 32 * nb, scr, lane);
            return;
        }
        r -= I_IN;
        if (r < I_OUT) { const int kb = r / 32, nb = r % 32; const float* w = F.w_out() + 32 * nb + (lane & 31);
            tr_item([&](int k) { return w[(size_t)k * DM]; }, DM, F.WOUT(), 64 * kb, 32 * nb, scr, lane); return; }
        r -= I_OUT;
        if (r < I_GU) { const int kb = r / (NGU / 32), nb = r % (NGU / 32), n = 32 * nb + (lane & 31), pn = n >> 8, tc = n & 255;
            const float* w = ((tc >> 7) ? F.w_up() : F.w_gate()) + 128 * pn + (tc & 127); const float* nw = F.norm2_w();
            tr_item([&](int k) { return nw[k] * w[(size_t)k * FF]; }, DM, F.WGU(), 64 * kb, 32 * nb, scr, lane); return; }
        r -= I_GU;
        { const int kb = r / 32, nb = r % 32; const float* w = F.w_down() + 32 * nb + (lane & 31);
            tr_item([&](int k) { return w[(size_t)k * DM]; }, FF, F.WDN(), 64 * kb, 32 * nb, scr, lane); }
    };
    for (int e = F.vcu * NTHR + F.tid; e < DM * 128; e += F.G * NTHR) {
        const int k = e >> 7, idx = e & 127, d = idx & 63; const float* wu = (idx < 64 ? F.w_uk() : F.w_uv()) + d; const float* wr_ = F.w_in() + (size_t)k * INW + 512; float a = 0.f;
#pragma unroll 8
        for (int j = 0; j < 128; ++j) a += wr_[j] * F.kv_norm_w()[j] * wu[j * 64];
        const int n = 512 + (idx < 64 ? 0 : 32) + (d < 32 ? d : 128 + d - 32);
        F.WIN()[(size_t)n * DM + k] = (bf16)(pkbf(F.norm1_w()[k] * a, 0.f) & 0xffffu);
    }
    int it = gw, kk = 0;
    for (int m = gw; m < MTOK; m += NGW, ++kk) {
        const f32x4* xr = (const f32x4*)(F.x() + (size_t)m * DM) + lane;
        f32x4 v[4]; float sq = 0.f;
#pragma unroll
        for (int j = 0; j < 4; ++j) { v[j] = xr[64 * j]; sq += pg8::dot4(v[j]); }
        const float ms = wave_sum(sq) * (1.0f / DM) + 1e-6f, rr = 1.0f / sqrtf(ms);
        v2u* o8 = (v2u*)(F.XB() + (size_t)m * DM) + lane;
#pragma unroll
        for (int j = 0; j < 4; ++j) o8[64 * j] = (v2u){pkbf(v[j][0] * rr, v[j][1] * rr), pkbf(v[j][2] * rr, v[j][3] * rr)};
        if (lane == 0) F.RMS()[m] = sqrtf(ms);
        if ((kk & 7) == 3 && it < NITEMS) { do_item(it); it += NGW; }
    }
    for (; it < NITEMS; it += NGW) do_item(it);
    const int gt = F.vcu * NTHR + F.tid, NGT = F.G * NTHR;
    for (int i = gt; i < 8 * 256; i += NGT) { const int h = i >> 8, rel = (i & 255) - 191;
        F.BT()[i] = (F.rel_bias()[t5_bucket(rel) * 8 + h] - F.rel_bias()[15 * 8 + h]) * 1.4426950408889634f; }
}

#ifndef PLANES
#define PLANES 1
#endif
#ifndef MIXREP
#define MIXREP 0
#endif
typedef float f32x4_t __attribute__((ext_vector_type(4)));
typedef float f32x2v __attribute__((ext_vector_type(2)));
struct IdxOps { bf16x8 bq[4]; f32x4 wv; bf16x8 a0; };
__device__ __forceinline__ void idx_fetch(IdxOps& o, const Frame& F, int b, int c, int rq) {
    const int w = F.wave, lane = F.lane, q = lane & 15, g = lane >> 4;
    const size_t rowq = (size_t)b * SEQ + 64 * c + 16 * rq + q;
#pragma unroll
    for (int h = 0; h < 4; ++h) o.bq[h] = *(const bf16x8*)(F.IQ() + rowq * 128 + 32 * h + 8 * g);
    o.wv = *(const f32x4*)(F.IW() + rowq * 4) * (0.5f * 0.17677669529663687f);
    o.a0 = *(const bf16x8*)(F.IK() + ((size_t)b * SEQ + q) * 32 + 8 * g + (size_t)w * 512);
}
__device__ __forceinline__ void idx_round(const IdxOps& o, const Frame& F, int b, int c, LAS unsigned char* lds) {
    const int w = F.wave, lane = F.lane, q = lane & 15, g = lane >> 4;
    const int nkb = 4 * (c + 1);
    const bf16* kp = F.IK() + ((size_t)b * SEQ + q) * 32 + 8 * g;
    LAS float* dst = (LAS float*)(lds + P2_SC) + q * SCW + 4 * g;
    int kb = w; bf16x8 a = o.a0;
    for (; kb < nkb; kb += 8) {
        bf16x8 an = a; if (kb + 8 < nkb) an = *(const bf16x8*)(kp + (size_t)(kb + 8) * 512);
        f32x4 sc = {0.f, 0.f, 0.f, 0.f};
#pragma unroll
        for (int h = 0; h < 4; ++h) {
            const f32x4 d = __builtin_amdgcn_mfma_f32_16x16x32_bf16(a, o.bq[h], (f32x4){0.f, 0.f, 0.f, 0.f}, 0, 0, 0);
#pragma unroll
            for (int i = 0; i < 4; ++i) sc[i] += o.wv[h] * fmaxf(d[i], 0.f);
        }
        *(LAS f32x4*)(dst + 16 * kb) = (f32x4){sc[0] + 0.f, sc[1] + 0.f, sc[2] + 0.f, sc[3] + 0.f};
        a = an;
    }
}
__device__ __forceinline__ int wave_sum_i(int v) {
    v += __builtin_amdgcn_update_dpp(0, v, 0xB1, 0xF, 0xF, false);
    v += __builtin_amdgcn_update_dpp(0, v, 0x4E, 0xF, 0xF, false);
    v += __builtin_amdgcn_update_dpp(0, v, 0x141, 0xF, 0xF, false);
    v += __builtin_amdgcn_update_dpp(0, v, 0x140, 0xF, 0xF, false);
    return (__builtin_amdgcn_readlane(v, 0) + __builtin_amdgcn_readlane(v, 16)) + (__builtin_amdgcn_readlane(v, 32) + __builtin_amdgcn_readlane(v, 48));
}
__device__ __forceinline__ unsigned sortable(float f) { const unsigned bits = __float_as_uint(f); return bits ^ ((unsigned)((int)bits >> 31) | 0x80000000u); }
template <int NJ>
__device__ __forceinline__ void mask_words(const unsigned (&u)[NJ], unsigned prefix, bool exact, LAS unsigned long long* mrow, int nj, int lane) {
    unsigned long long mv = 0ull;
    if (exact) {
#pragma unroll
        for (int j = 0; j < NJ; ++j) { const unsigned long long sel = __ballot(u[j] >= prefix); if (lane == j) mv = sel; }
    } else {
        int ngt = 0;
#pragma unroll
        for (int j = 0; j < NJ; ++j) ngt += __popcll(__ballot(u[j] > prefix));
        int need = 256 - ngt;
#pragma unroll
        for (int j = 0; j < NJ; ++j) {
            const unsigned long long eq = __ballot(u[j] == prefix);
            const int rank = (int)__builtin_amdgcn_mbcnt_hi((unsigned)(eq >> 32), __builtin_amdgcn_mbcnt_lo((unsigned)eq, 0u));
            const unsigned long long sel = __ballot(u[j] > prefix || (u[j] == prefix && rank < need));
            need -= __popcll(eq);
            if (lane == j) mv = sel;
        }
    }
    if (lane < nj) mrow[lane] = mv;
}
template <int NJ>
__device__ __forceinline__ void select_row(const LAS float* row, LAS unsigned long long* mrow, int nj, int lane) {
    static_assert(NJ % 4 == 0, "groups of four");
    unsigned u[NJ];
#pragma unroll
    for (int j = 0; j < NJ; ++j) { float v = row[64 * j + lane]; asm volatile("" : "+v"(v)); u[j] = (j < nj) ? sortable(v) : 0u; }
    unsigned prefix = 0u; bool exact = false;
#pragma unroll 1
    for (int bit = 31; bit >= 0; --bit) {
        const unsigned trial = prefix | (1u << bit); int c0 = 0, c1 = 0, c2 = 0, c3 = 0;
#pragma unroll
        for (int j = 0; j < NJ; j += 4) {
            unsigned long long m0, m1, m2, m3;
            asm volatile("v_cmp_le_u32_e64 %4, %12, %8\n\tv_cmp_le_u32_e64 %5, %12, %9\n\tv_cmp_le_u32_e64 %6, %12, %10\n\tv_cmp_le_u32_e64 %7, %12, %11\n\t"
                         "v_addc_co_u32_e64 %0, %4, 0, %0, %4\n\tv_addc_co_u32_e64 %1, %5, 0, %1, %5\n\tv_addc_co_u32_e64 %2, %6, 0, %2, %6\n\tv_addc_co_u32_e64 %3, %7, 0, %3, %7"
                         : "+v"(c0), "+v"(c1), "+v"(c2), "+v"(c3), "=&s"(m0), "=&s"(m1), "=&s"(m2), "=&s"(m3) : "v"(u[j]), "v"(u[j + 1]), "v"(u[j + 2]), "v"(u[j + 3]), "s"(trial));
        }
        const int cnt = wave_sum_i((c0 + c1) + (c2 + c3));
        if (cnt >= 256) prefix = trial;
        if (cnt == 256) { exact = true; break; }
    }
    mask_words<NJ>(u, prefix, exact, mrow, nj, lane);
}
template <int S, unsigned M>
__device__ __forceinline__ void tr_stage(unsigned (&A)[32]) {
#pragma unroll
    for (int k = 0; k < 32; ++k) if (!(k & S)) { const unsigned a = A[k], b = A[k + S]; A[k] = (a & M) | ((b & M) << S); A[k + S] = ((a >> S) & M) | (b & ~M); }
}
__device__ __forceinline__ void tr_bytes(unsigned (&A)[32]) {
#pragma unroll
    for (int k = 0; k < 16; ++k) { const unsigned a = A[k], b = A[k + 16];
        A[k] = __builtin_amdgcn_perm(b, a, 0x05040100u);
        A[k + 16] = __builtin_amdgcn_perm(b, a, 0x07060302u); }
#pragma unroll
    for (int k = 0; k < 32; ++k) if (!(k & 8)) { const unsigned a = A[k], b = A[k + 8];
        A[k] = __builtin_amdgcn_perm(b, a, 0x06020400u);
        A[k + 8] = __builtin_amdgcn_perm(b, a, 0x07030501u); }
}
__device__ __forceinline__ void planes_finish(unsigned gt, unsigned alive, int G, bool done, LAS unsigned long long* mrow, int nj, int lane) {
    unsigned sel = gt | alive;
    if (!done) {
        int need = 256 - G; unsigned ts = 0u;
#pragma unroll
        for (int j = 0; j < 32; ++j) {
            const bool mine = (alive >> j) & 1u; const unsigned long long eq = __ballot(mine);
            const int rank = (int)__builtin_amdgcn_mbcnt_hi((unsigned)(eq >> 32), __builtin_amdgcn_mbcnt_lo((unsigned)eq, 0u));
            ts |= (mine && rank < need) ? (1u << j) : 0u; need -= __popcll(eq);
        }
        sel = gt | ts;
    }
    unsigned long long mv = 0ull;
#pragma unroll
    for (int j = 0; j < 32; ++j) { const unsigned long long w = __ballot((sel >> j) & 1u); if (lane == j) mv = w; }
    if (lane < nj) mrow[lane] = mv;
}
__device__ __forceinline__ void select_rows_planes2(const LAS float* rowa, const LAS float* rowb, LAS unsigned long long* mrowa, LAS unsigned long long* mrowb, int nj, int lane) {
    unsigned A[32], B[32];
#pragma unroll
    for (int j = 0; j < 32; ++j) { float va = rowa[64 * j + lane], vb = rowb[64 * j + lane]; asm volatile("" : "+v"(va), "+v"(vb)); A[j] = (j < nj) ? sortable(va) : 0u; B[j] = (j < nj) ? sortable(vb) : 0u; }
    tr_bytes(A); tr_stage<4, 0x0F0F0F0Fu>(A); tr_stage<2, 0x33333333u>(A); tr_stage<1, 0x55555555u>(A);
    tr_bytes(B); tr_stage<4, 0x0F0F0F0Fu>(B); tr_stage<2, 0x33333333u>(B); tr_stage<1, 0x55555555u>(B);
#pragma unroll
    for (int j = 0; j < 32; ++j) asm volatile("" : "+v"(A[j]), "+v"(B[j]));
    unsigned alivea = 0xFFFFFFFFu, gta = 0u, aliveb = 0xFFFFFFFFu, gtb = 0u; int Ga = 0, Aa = 2048, Gb = 0, Ab = 2048; bool donea = false, doneb = false;
#pragma unroll
    for (int b = 31; b >= 0; --b) {
        if (!(donea && doneb)) {
            const unsigned onesa = alivea & A[b], onesb = aliveb & B[b];
            const int both = wave_sum_i(__builtin_popcount(onesa) | (__builtin_popcount(onesb) << 16)), C1a = both & 0xffff, C1b = both >> 16;
            if (!donea) {
                if (Ga + C1a >= 256) { alivea = onesa; Aa = C1a; } else { Ga += C1a; gta |= onesa; alivea &= ~A[b]; Aa -= C1a; }
                donea = (Ga + Aa == 256);
            }
            if (!doneb) {
                if (Gb + C1b >= 256) { aliveb = onesb; Ab = C1b; } else { Gb += C1b; gtb |= onesb; aliveb &= ~B[b]; Ab -= C1b; }
                doneb = (Gb + Ab == 256);
            }
        }
    }
    planes_finish(gta, alivea, Ga, donea, mrowa, nj, lane);
    planes_finish(gtb, aliveb, Gb, doneb, mrowb, nj, lane);
}
constexpr int AT_K = 0, AT_V = 16384, AT_BT = 32768, AT_WS = 40960, AT_OST = 0, AT_Q = 43008;
static_assert(AT_Q + 65536 <= P2_MASK && AT_OST + 8 * 4608 <= AT_WS, "attention LDS map");
__device__ __forceinline__ bf16x8 pk16(const f32x16& v, int o) { return __builtin_bit_cast(bf16x8, (v4u){pkbf(v[o], v[o + 1]), pkbf(v[o + 2], v[o + 3]), pkbf(v[o + 4], v[o + 5]), pkbf(v[o + 6], v[o + 7])}); }
template <bool MASK, bool NEAR>
__device__ __forceinline__ void attn_soft(f32x16& p0, f32x16& p1, f32x2v& lacc, bf16x8 (&pa)[4], const LAS float* bt, unsigned long long mw, int hi) {
#pragma unroll
    for (int i = 0; i < 16; ++i) { p0[i] = __builtin_amdgcn_exp2f(p0[i]); p1[i] = __builtin_amdgcn_exp2f(p1[i]); }
    if (MASK) {
        const unsigned long long ws_ = mw >> (4 * hi); const int lo = (int)(unsigned)ws_, hh = (int)(unsigned)(ws_ >> 32);
#define MSK_(i) { int m0_, m1_; asm("v_bfe_i32 %0, %1, %2, 1" : "=v"(m0_) : "v"(lo), "n"(((i) & 3) + 8 * ((i) >> 2))); asm("v_bfe_i32 %0, %1, %2, 1" : "=v"(m1_) : "v"(hh), "n"(((i) & 3) + 8 * ((i) >> 2))); \
            p0[i] = __uint_as_float(__float_as_uint(p0[i]) & (unsigned)m0_); p1[i] = __uint_as_float(__float_as_uint(p1[i]) & (unsigned)m1_); }
        MSK_(0) MSK_(1) MSK_(2) MSK_(3) MSK_(4) MSK_(5) MSK_(6) MSK_(7) MSK_(8) MSK_(9) MSK_(10) MSK_(11) MSK_(12) MSK_(13) MSK_(14) MSK_(15)
#undef MSK_
    }
#pragma unroll
    for (int i = 0; i < 16; i += 2) { lacc += (f32x2v){p0[i], p0[i + 1]}; lacc += (f32x2v){p1[i], p1[i + 1]}; }
    pa[0] = pk16(p0, 0); pa[1] = pk16(p0, 8); pa[2] = pk16(p1, 0); pa[3] = pk16(p1, 8);
}
__device__ __forceinline__ void attn_pv(f32x16& o0, f32x16& o1, const bf16x8 (&pa)[4], const LAS unsigned char* Vb) {
#pragma unroll
    for (int ks = 0; ks < 4; ++ks) {
        o0 = __builtin_amdgcn_mfma_f32_32x32x16_bf16(pa[ks], cat8(vtr(Vb + ks * 1024), vtr(Vb + ks * 1024 + 512)), o0, 0, 0, 0);
        o1 = __builtin_amdgcn_mfma_f32_32x32x16_bf16(pa[ks], cat8(vtr(Vb + 4096 + ks * 1024), vtr(Vb + 4096 + ks * 1024 + 512)), o1, 0, 0, 0);
    }
}
template <bool MASK, bool NEAR>
__device__ __forceinline__ void attn_tile(f32x16& oa0, f32x16& oa1, f32x16& ob0, f32x16& ob1, f32x2v& la, f32x2v& lb, const LAS unsigned char* Qb,
                                          const LAS unsigned char* Kb, const LAS unsigned char* Vb, const LAS float* bt, unsigned long long mwa, unsigned long long mwb, int hi) {
    f32x16 a0, a1, b0, b1;
#pragma unroll
    for (int i = 0; i < 16; ++i) {
        if (NEAR) { a0[i] = bt[(i & 3) + 8 * (i >> 2)]; a1[i] = bt[32 + (i & 3) + 8 * (i >> 2)]; b0[i] = bt[(i & 3) + 8 * (i >> 2) - 32]; b1[i] = bt[(i & 3) + 8 * (i >> 2)]; }
        else { a0[i] = 0.f; a1[i] = 0.f; b0[i] = 0.f; b1[i] = 0.f; }
    }
#pragma unroll
    for (int d0 = 0; d0 < 4; ++d0) { const bf16x8 k0 = *(const LAS bf16x8*)(Kb + d0 * 2048), k1 = *(const LAS bf16x8*)(Kb + d0 * 2048 + 512); const bf16x8 qf = *(const LAS bf16x8*)(Qb + d0 * 1024);
        a0 = __builtin_amdgcn_mfma_f32_32x32x16_bf16(k0, qf, a0, 0, 0, 0); a1 = __builtin_amdgcn_mfma_f32_32x32x16_bf16(k1, qf, a1, 0, 0, 0); }
    const LAS unsigned char* Kb2 = Kb; asm volatile("" : "+v"(Kb2));
#pragma unroll
    for (int d0 = 0; d0 < 4; ++d0) { const bf16x8 k0 = *(const LAS bf16x8*)(Kb2 + d0 * 2048), k1 = *(const LAS bf16x8*)(Kb2 + d0 * 2048 + 512); const bf16x8 qf = *(const LAS bf16x8*)(Qb + 4096 + d0 * 1024);
        b0 = __builtin_amdgcn_mfma_f32_32x32x16_bf16(k0, qf, b0, 0, 0, 0); b1 = __builtin_amdgcn_mfma_f32_32x32x16_bf16(k1, qf, b1, 0, 0, 0); }
    bf16x8 pa[4], pb[4];
    attn_soft<MASK, NEAR>(a0, a1, la, pa, bt, mwa, hi);
    attn_pv(oa0, oa1, pa, Vb);
    attn_soft<MASK, NEAR>(b0, b1, lb, pb, bt - 32, mwb, hi);
    attn_pv(ob0, ob1, pb, Vb);
}
__device__ __forceinline__ void attn_store(const f32x16& o0, const f32x16& o1, f32x2v lacc, bf16* obase, LAS unsigned char* stg, LAS float* wsf, int lane) {
    const int r = lane & 31, hi = lane >> 5;
    float lsum = lacc[0] + lacc[1];
    lsum += __shfl_xor(lsum, 32);
    if (hi == 0) wsf[r] = lsum;
    LDS_WAIT(); asm volatile("" ::: "memory");
    LAS unsigned short* st = (LAS unsigned short*)stg;
#pragma unroll
    for (int i = 0; i < 16; ++i) {
        const int q = crow(i, hi); const float rl = 1.0f / wsf[q];
        st[q * 72 + r] = (unsigned short)(pkbf(o0[i] * rl, 0.f) & 0xffffu); st[q * 72 + 32 + r] = (unsigned short)(pkbf(o1[i] * rl, 0.f) & 0xffffu);
    }
    LDS_WAIT(); asm volatile("" ::: "memory");
#pragma unroll
    for (int k = 0; k < 4; ++k) { const int row = 8 * k + (lane >> 3), ch = lane & 7;
        const v4u v = *(const LAS v4u*)(stg + row * 144 + ch * 16); *(v4u*)(obase + (size_t)row * DM + ch * 8) = v; }
    LDS_WAIT(); asm volatile("" ::: "memory");
}
template <bool MASK>
__device__ __forceinline__ void attn_chunk(const Frame& F, int b, int c, LAS unsigned char* lds) {
    const int wid = F.wave, lane = F.lane, r = lane & 31, hi = lane >> 5;
    const size_t rowbase = (size_t)b * SEQ; const int q0 = 64 * c, nt = c + 1;
    const LAS unsigned char* Qb = lds + AT_Q + wid * 8192 + lane * 16;
#pragma unroll
    for (int d0 = 0; d0 < 4; ++d0) {
        *(LAS bf16x8*)(lds + AT_Q + wid * 8192 + d0 * 1024 + lane * 16) = *(const bf16x8*)(F.QA() + (rowbase + q0 + r) * 512 + wid * 64 + 16 * d0 + 8 * hi);
        *(LAS bf16x8*)(lds + AT_Q + wid * 8192 + 4096 + d0 * 1024 + lane * 16) = *(const bf16x8*)(F.QA() + (rowbase + q0 + 32 + r) * 512 + wid * 64 + 16 * d0 + 8 * hi); }
    const LAS float* BT = (const LAS float*)(lds + AT_BT) + wid * 256;
    const bf16* ksrc = F.KA() + (rowbase + lane) * 64 + 8 * wid;
    const bf16* vsrc = F.VA() + (rowbase + 16 * (wid & 3) + (lane >> 2)) * 64 + (wid >> 2) * 32 + (lane & 3) * 8;
    const LAS unsigned long long* mrow = (const LAS unsigned long long*)(lds + P2_MASK) + r * 32;
    const int voff = ((lane >> 4) & 1) * 32 + (lane & 3) * 8 + (4 * hi + ((lane & 15) >> 2)) * 64;
    f32x16 oa0, oa1, ob0, ob1; f32x2v la = {0.f, 0.f}, lb = {0.f, 0.f};
#pragma unroll
    for (int i = 0; i < 16; ++i) { oa0[i] = 0.f; oa1[i] = 0.f; ob0[i] = 0.f; ob1[i] = 0.f; }
    __builtin_amdgcn_global_load_lds((const unsigned*)ksrc, (LAS unsigned*)(lds + AT_K + wid * 1024), 16, 0, 0);
    __builtin_amdgcn_global_load_lds((const unsigned*)vsrc, (LAS unsigned*)(lds + AT_V + wid * 1024), 16, 0, 0);
    asm volatile("s_waitcnt vmcnt(0)" ::: "memory");
    __syncthreads();
    const int nfar = c >= 2 ? c - 2 : 0;
#pragma unroll 1
    for (int t = 0; t < nt; ++t) {
        const int cur = (t & 1) * 8192, nxt = 8192 - cur, tn = t + 1 < nt ? t + 1 : t;
        __builtin_amdgcn_global_load_lds((const unsigned*)(ksrc + (size_t)tn * 64 * 64), (LAS unsigned*)(lds + AT_K + nxt + wid * 1024), 16, 0, 0);
        __builtin_amdgcn_global_load_lds((const unsigned*)(vsrc + (size_t)tn * 64 * 64), (LAS unsigned*)(lds + AT_V + nxt + wid * 1024), 16, 0, 0);
        unsigned long long mwa = 0ull, mwb = 0ull;
        if (MASK) { mwa = mrow[t]; mwb = mrow[32 * 32 + t]; }
        const LAS unsigned char* Kb = lds + AT_K + cur + hi * 1024 + r * 16; const LAS unsigned char* Vb = lds + AT_V + cur + voff;
        const LAS float* bt = BT + (64 * (t - c) + 191 - r + 4 * hi);
        if (t < nfar) attn_tile<MASK, false>(oa0, oa1, ob0, ob1, la, lb, Qb, Kb, Vb, bt, mwa, mwb, hi);
        else attn_tile<MASK, true>(oa0, oa1, ob0, ob1, la, lb, Qb, Kb, Vb, bt, mwa, mwb, hi);
        asm volatile("s_waitcnt vmcnt(0)" ::: "memory");
        __syncthreads();
    }
    LAS float* wsf = (LAS float*)(lds + AT_WS) + wid * 64; LAS unsigned char* stg = lds + AT_OST + wid * 4608;
    attn_store(oa0, oa1, la, F.MIX() + (rowbase + q0) * DM + wid * 64, stg, wsf, lane);
    attn_store(ob0, ob1, lb, F.MIX() + (rowbase + q0 + 32) * DM + wid * 64, stg, wsf, lane);
}
__device__ __forceinline__ void attn_unit(const Frame& F, int b, int c, LAS unsigned char* lds) {
    if (c >= 4) {
        const int nj = c + 1;
        IdxOps ops; idx_fetch(ops, F, b, c, 0);
        for (int rq = 0; rq < ((MIXREP & 2) ? 8 : 4); ++rq) {
            idx_round(ops, F, b, c, lds);
            idx_fetch(ops, F, b, c, (rq + 1) & 3);
            __syncthreads();
            {
                const int ql = 2 * F.wave;
                const LAS float* row = (const LAS float*)(lds + P2_SC) + ql * SCW; LAS unsigned long long* mrow = (LAS unsigned long long*)(lds + P2_MASK) + (16 * (rq & 3) + ql) * 32;
                if (nj <= 8) { select_row<8>(row, mrow, nj, F.lane); select_row<8>(row + SCW, mrow + 32, nj, F.lane); }
                else { if (PLANES) select_rows_planes2(row, row + SCW, mrow, mrow + 32, nj, F.lane); else { select_row<32>(row, mrow, nj, F.lane); select_row<32>(row + SCW, mrow + 32, nj, F.lane); } }
            }
            __syncthreads();
        }
    }
    { const f32x4 v = *(const f32x4*)(F.BT() + F.tid * 4); *(LAS f32x4*)(lds + AT_BT + F.tid * 16) = v; }
    __syncthreads();
    if (c >= 4) attn_chunk<true>(F, b, c, lds); else attn_chunk<false>(F, b, c, lds);
}

constexpr int RT_TAB = 131072;
__device__ __forceinline__ void ret_stage(const bf16* vsrc, const bf16* ksrc, LAS unsigned char* region) {
#pragma unroll
    for (int k = 0; k < 8; ++k) {
        const size_t o = (size_t)(16 * (k & 3)) * 512 + 32 * (k >> 2);
        __builtin_amdgcn_global_load_lds((const unsigned*)(vsrc + o), (LAS unsigned*)(region + k * 1024), 16, 0, 0);
        __builtin_amdgcn_global_load_lds((const unsigned*)(ksrc + o), (LAS unsigned*)(region + 8192 + k * 1024), 16, 0, 0);
    }
}
__device__ __forceinline__ void ret_kv(f32x16 (&T)[2][2], const LAS unsigned char* img) {
#pragma unroll
    for (int ks = 0; ks < 4; ++ks) {
        const bf16x8 k0 = cat8(vtr(img + 8192 + ks * 1024), vtr(img + 8192 + ks * 1024 + 512)), k1 = cat8(vtr(img + 8192 + 4096 + ks * 1024), vtr(img + 8192 + 4096 + ks * 1024 + 512));
        const bf16x8 v0 = cat8(vtr(img + ks * 1024), vtr(img + ks * 1024 + 512)), v1 = cat8(vtr(img + 4096 + ks * 1024), vtr(img + 4096 + ks * 1024 + 512));
        T[0][0] = __builtin_amdgcn_mfma_f32_32x32x16_bf16(k0, v0, T[0][0], 0, 0, 0); T[0][1] = __builtin_amdgcn_mfma_f32_32x32x16_bf16(k0, v1, T[0][1], 0, 0, 0);
        T[1][0] = __builtin_amdgcn_mfma_f32_32x32x16_bf16(k1, v0, T[1][0], 0, 0, 0); T[1][1] = __builtin_amdgcn_mfma_f32_32x32x16_bf16(k1, v1, T[1][1], 0, 0, 0);
    }
}
__device__ __forceinline__ void ret_unit(const Frame& F, int b, int h, LAS unsigned char* lds) {
    const int lane = F.lane, w = F.wave, r = lane & 31, hi = lane >> 5;
    const float gam = 1.0f - exp2f(-5.0f - (float)h), lg2 = log2f(gam), cd = exp2f(64.0f * lg2), cd4 = exp2f(256.0f * lg2);
    LAS unsigned char* region = lds + w * 16384;
    const LAS unsigned char* img = region + ((lane >> 4) & 1) * 32 + (lane & 3) * 8 + (4 * hi + ((lane & 15) >> 2)) * 64;
    LAS float* tab = (LAS float*)(lds + RT_TAB);
    __syncthreads();
    if (F.tid < 128) tab[F.tid] = F.tid < 64 ? F.ret_gn_w()[h * 64 + F.tid] : F.ret_gn_b()[h * 64 + F.tid - 64];
    const size_t hbase = (size_t)b * SEQ * 512 + h * 64;
    const size_t stg = hbase + (size_t)(lane >> 2) * 512 + (lane & 3) * 8;
    f32x16 T[2][2];
#pragma unroll
    for (int i = 0; i < 16; ++i) { T[0][0][i] = 0.f; T[0][1][i] = 0.f; T[1][0][i] = 0.f; T[1][1][i] = 0.f; }
#pragma unroll 1
    for (int i = 0; i < 4; ++i) {
        const size_t co = (size_t)(4 * w + i) * 64 * 512;
        ret_stage(F.VB() + stg + co, F.KB() + stg + co, region);
        if (i) {
#pragma unroll
            for (int k = 0; k < 16; ++k) { T[0][0][k] *= cd; T[0][1][k] *= cd; T[1][0][k] *= cd; T[1][1][k] *= cd; }
        }
        asm volatile("s_waitcnt vmcnt(0)" ::: "memory");
        ret_kv(T, img);
        LDS_WAIT();
    }
#pragma unroll
    for (int eb = 0; eb < 2; ++eb)
#pragma unroll
        for (int db = 0; db < 2; ++db)
#pragma unroll
            for (int g = 0; g < 4; ++g) *(LAS f32x4*)(region + ((eb * 2 + db) * 4 + g) * 1024 + lane * 16) = (f32x4){T[eb][db][4 * g], T[eb][db][4 * g + 1], T[eb][db][4 * g + 2], T[eb][db][4 * g + 3]};
    __syncthreads();
#pragma unroll
    for (int i = 0; i < 16; ++i) { T[0][0][i] = 0.f; T[0][1][i] = 0.f; T[1][0][i] = 0.f; T[1][1][i] = 0.f; }
#pragma unroll 1
    for (int wp = 0; wp < w; ++wp) {
        const LAS unsigned char* src = lds + wp * 16384 + lane * 16;
#pragma unroll
        for (int eb = 0; eb < 2; ++eb)
#pragma unroll
            for (int db = 0; db < 2; ++db)
#pragma unroll
                for (int g = 0; g < 4; ++g) { const f32x4 v = *(const LAS f32x4*)(src + ((eb * 2 + db) * 4 + g) * 1024);
                    T[eb][db][4 * g] = T[eb][db][4 * g] * cd4 + v[0]; T[eb][db][4 * g + 1] = T[eb][db][4 * g + 1] * cd4 + v[1]; T[eb][db][4 * g + 2] = T[eb][db][4 * g + 2] * cd4 + v[2]; T[eb][db][4 * g + 3] = T[eb][db][4 * g + 3] * cd4 + v[3]; }
    }
    __syncthreads();
#pragma unroll 1
    for (int i = 0; i < 4; ++i) {
        const int n = 4 * w + i; const size_t co = (size_t)n * 64 * 512;
        ret_stage(F.VB() + stg + co, F.KB() + stg + co, region);
#pragma unroll
        for (int k = 0; k < 16; ++k) { T[0][0][k] *= cd; T[0][1][k] *= cd; T[1][0][k] *= cd; T[1][1][k] *= cd; }
        const bf16* qrow = F.QB() + hbase + co + (size_t)r * 512 + 8 * hi;
        const bf16* krow = F.KB() + hbase + co + (size_t)r * 512 + 8 * hi;
#pragma unroll 1
        for (int ib = 0; ib < 2; ++ib) {
            bf16x8 qf[4], kf[4];
#pragma unroll
            for (int s = 0; s < 4; ++s) { qf[s] = *(const bf16x8*)(qrow + (size_t)(32 * ib) * 512 + 16 * s); kf[s] = *(const bf16x8*)(krow + 16 * s); }
            const size_t tok = (size_t)b * SEQ + 64 * n + 32 * ib + r;
            const bf16* grow = F.GB() + tok * 512 + h * 64 + 4 * hi;
            v2u gq[2][4];
#pragma unroll
            for (int db = 0; db < 2; ++db)
#pragma unroll
                for (int g = 0; g < 4; ++g) gq[db][g] = *(const v2u*)(grow + 32 * db + 8 * g);
            f32x16 s0, s1;
#pragma unroll
            for (int k = 0; k < 16; ++k) { s0[k] = 0.f; s1[k] = 0.f; }
#pragma unroll
            for (int s = 0; s < 4; ++s) s0 = __builtin_amdgcn_mfma_f32_32x32x16_bf16(kf[s], qf[s], s0, 0, 0, 0);
            if (ib == 1) {
#pragma unroll
                for (int s = 0; s < 4; ++s) kf[s] = *(const bf16x8*)(krow + (size_t)32 * 512 + 16 * s);
#pragma unroll
                for (int s = 0; s < 4; ++s) s1 = __builtin_amdgcn_mfma_f32_32x32x16_bf16(kf[s], qf[s], s1, 0, 0, 0);
#pragma unroll
                for (int k = 0; k < 16; ++k) s1[k] = (r >= crow(k, hi)) ? s1[k] : 0.f;
            } else {
#pragma unroll
                for (int k = 0; k < 16; ++k) s0[k] = (r >= crow(k, hi)) ? s0[k] : 0.f;
            }
#pragma unroll
            for (int s = 0; s < 4; ++s) {
                v4u q4 = __builtin_bit_cast(v4u, qf[s]);
                auto x0 = __builtin_amdgcn_permlane32_swap(q4[0], q4[2], false, false); auto x1 = __builtin_amdgcn_permlane32_swap(q4[1], q4[3], false, false);
                q4[0] = x0[0]; q4[2] = x0[1]; q4[1] = x1[0]; q4[3] = x1[1];
                qf[s] = __builtin_bit_cast(bf16x8, q4);
            }
            asm volatile("s_waitcnt vmcnt(0)" ::: "memory");
            f32x16 y0, y1;
#pragma unroll
            for (int k = 0; k < 16; ++k) { y0[k] = 0.f; y1[k] = 0.f; }
#pragma unroll
            for (int eb = 0; eb < 2; ++eb)
#pragma unroll
                for (int s2 = 0; s2 < 2; ++s2) {
                    y0 = __builtin_amdgcn_mfma_f32_32x32x16_bf16(pk16(T[eb][0], 8 * s2), qf[2 * eb + s2], y0, 0, 0, 0);
                    y1 = __builtin_amdgcn_mfma_f32_32x32x16_bf16(pk16(T[eb][1], 8 * s2), qf[2 * eb + s2], y1, 0, 0, 0);
                }
#pragma unroll
            for (int ks = 0; ks < 2; ++ks) {
                const bf16x8 pb = pk16(s0, 8 * ks);
                y0 = __builtin_amdgcn_mfma_f32_32x32x16_bf16(cat8(vtr(img + ks * 1024), vtr(img + ks * 1024 + 512)), pb, y0, 0, 0, 0);
                y1 = __builtin_amdgcn_mfma_f32_32x32x16_bf16(cat8(vtr(img + 4096 + ks * 1024), vtr(img + 4096 + ks * 1024 + 512)), pb, y1, 0, 0, 0);
            }
            if (ib == 1) {
#pragma unroll
                for (int ks = 0; ks < 2; ++ks) {
                    const bf16x8 pb = pk16(s1, 8 * ks);
                    y0 = __builtin_amdgcn_mfma_f32_32x32x16_bf16(cat8(vtr(img + (2 + ks) * 1024), vtr(img + (2 + ks) * 1024 + 512)), pb, y0, 0, 0, 0);
                    y1 = __builtin_amdgcn_mfma_f32_32x32x16_bf16(cat8(vtr(img + 4096 + (2 + ks) * 1024), vtr(img + 4096 + (2 + ks) * 1024 + 512)), pb, y1, 0, 0, 0);
                }
            }
            float sm = 0.f;
#pragma unroll
            for (int k = 0; k < 16; ++k) sm += y0[k] + y1[k];
            sm += __shfl_xor(sm, 32);
            const float mean = sm * (1.0f / 64.0f); float vr = 0.f;
#pragma unroll
            for (int k = 0; k < 16; ++k) { y0[k] -= mean; y1[k] -= mean; vr += y0[k] * y0[k] + y1[k] * y1[k]; }
            vr += __shfl_xor(vr, 32);
            const float rstd = 1.0f / sqrtf(vr * (1.0f / 64.0f) + 1e-5f);
            bf16* orow = F.MIX() + tok * DM + 512 + h * 64 + 4 * hi;
#pragma unroll
            for (int g = 0; g < 4; ++g) {
                const f32x4 w0 = *(const LAS f32x4*)(tab + 8 * g + 4 * hi), b0 = *(const LAS f32x4*)(tab + 64 + 8 * g + 4 * hi), w1 = *(const LAS f32x4*)(tab + 32 + 8 * g + 4 * hi), b1 = *(const LAS f32x4*)(tab + 96 + 8 * g + 4 * hi);
                const v2u g0 = gq[0][g], g1 = gq[1][g];
                *(v2u*)(orow + 8 * g) = (v2u){pkbf((y0[4 * g] * rstd * w0[0] + b0[0]) * bflo(g0[0]), (y0[4 * g + 1] * rstd * w0[1] + b0[1]) * bfhi(g0[0])),
                                              pkbf((y0[4 * g + 2] * rstd * w0[2] + b0[2]) * bflo(g0[1]), (y0[4 * g + 3] * rstd * w0[3] + b0[3]) * bfhi(g0[1]))};
                *(v2u*)(orow + 32 + 8 * g) = (v2u){pkbf((y1[4 * g] * rstd * w1[0] + b1[0]) * bflo(g1[0]), (y1[4 * g + 1] * rstd * w1[1] + b1[1]) * bfhi(g1[0])),
                                                   pkbf((y1[4 * g + 2] * rstd * w1[2] + b1[2]) * bflo(g1[1]), (y1[4 * g + 3] * rstd * w1[3] + b1[3]) * bfhi(g1[1]))};
            }
        }
        ret_kv(T, img);
        LDS_WAIT();
    }
}
#ifndef GEMM_ALIGN
#define GEMM_ALIGN true
#endif
#ifndef GEMM_SP2
#define GEMM_SP2 true
#endif
#ifndef RETREP
#define RETREP 1
#endif
#ifndef ATTREP
#define ATTREP 1
#endif
constexpr int N_RET = BATCH * 8 * RETREP, N_ATT = BATCH * 32 * ATTREP, N_MIX = N_RET + N_ATT;
__device__ __forceinline__ void p2_mixers(Frame& F) {
    for (;;) {
        int mo_ = MISC_OFF; asm volatile("" : "+s"(mo_));
        volatile LAS unsigned* misc = (volatile LAS unsigned*)(F.lds + mo_);
        __syncthreads();
        if (F.tid == 0) misc[0] = __hip_atomic_fetch_add(F.ctl, 1u, __ATOMIC_RELAXED, __HIP_MEMORY_SCOPE_AGENT);
        __syncthreads();
        const int u = (int)misc[0];
        if (u >= N_MIX) break;
        { int w_ = F.wave; asm volatile("" : "+s"(w_)); F.wave = w_; int l_ = lane_id(); asm volatile("" : "+v"(l_)); F.lane = l_; F.tid = w_ * 64 + l_; }
        constexpr int N_HEAD = 256 * ATTREP;
        if (u < N_HEAD) { const int a = u / ATTREP; attn_unit(F, a & 31, 31 - (a >> 5), F.lds); }
        else if (u < N_HEAD + N_RET) { const int ru = (u - N_HEAD) / RETREP; ret_unit(F, ru >> 3, ru & 7, F.lds); }
        else { const int a = (u - N_RET) / ATTREP; attn_unit(F, a & 31, 31 - (a >> 5), F.lds); }
    }
}

typedef __attribute__((address_space(1))) unsigned gu32;
#define XB_TMO      128
#define XB_XCNT(j)  (256  + 64 * (j))
#define XB_XSUB(j)  (1280 + 64 * (j))
#define XB_XGEN(j)  (2304 + 64 * (j))
#define XB_TOP      3328
#define XB_TOPGEN   3392
#define XCD_BAR_WORDS 3456
#define XB_SPIN_CAP (1u << 18)

__device__ __forceinline__ unsigned xb_ld(unsigned* p)              { return __hip_atomic_load(p, __ATOMIC_RELAXED, __HIP_MEMORY_SCOPE_AGENT); }
__device__ __forceinline__ unsigned xb_add(unsigned* p, unsigned v) { return __hip_atomic_fetch_add(p, v, __ATOMIC_RELAXED, __HIP_MEMORY_SCOPE_AGENT); }
__device__ __forceinline__ unsigned xb_xcc_id() { return (unsigned)__builtin_amdgcn_s_getreg((3 << 11) | 20) & 0xFu; }
#define XB_SPIN(cond, bar) do { unsigned _sp = 0; while (cond) { __builtin_amdgcn_s_sleep(1); \
    if ((++_sp & 255u) == 0u) { if (xb_ld(&(bar)[XB_TMO])) break; if (_sp > XB_SPIN_CAP) { atomicAdd(&(bar)[XB_TMO], 1u); break; } } } } while (0)

struct XcdBarrier {
    unsigned* bar; unsigned x; int wv;
    volatile LAS unsigned* st;
};

__device__ __forceinline__ XcdBarrier xcd_barrier_post(unsigned* bar, volatile LAS unsigned* st, int wv_) {
    XcdBarrier b; b.bar = bar; b.x = xb_xcc_id(); b.st = st; b.wv = 0;
    if (wv_ == 0 && lane_id() == 0) (void)xb_add(&bar[XB_XCNT(b.x)], 1u);
    return b;
}
__device__ __forceinline__ void xcd_barrier_complete(unsigned* bar, unsigned x, unsigned& nloc, unsigned& nx) {
    const unsigned G = gridDim.x * gridDim.y * gridDim.z;
    unsigned sum, cnt, mine, sp = 0u;
    for (;;) {
        sum = 0u; cnt = 0u; mine = 0u;
#pragma unroll
        for (unsigned j = 0; j < 16; ++j) { const unsigned c = xb_ld(&bar[XB_XCNT(j)]); sum += c; cnt += (c > 0u) ? 1u : 0u; mine = (j == x) ? c : mine; }
        if (sum == G) break;
        __builtin_amdgcn_s_sleep(1);
        if ((++sp & 255u) == 0u) { if (xb_ld(&bar[XB_TMO])) break; if (sp > XB_SPIN_CAP) { atomicAdd(&bar[XB_TMO], 1u); break; } }
    }
    nloc = mine > 0u ? mine : 1u; nx = cnt > 0u ? cnt : 1u;
}

__device__ __forceinline__ void xcd_barrier(const XcdBarrier& b) {
    asm volatile("s_waitcnt vmcnt(0)" ::: "memory");
    __syncthreads();
    if (b.wv == 0 && lane_id() == 0) {
        unsigned* bar = b.bar;
        __builtin_amdgcn_s_waitcnt(0);
        unsigned nloc = b.st[0], nx = b.st[1];
        if (nloc == 0u) { xcd_barrier_complete(bar, b.x, nloc, nx); b.st[0] = nloc; b.st[1] = nx; }
        const unsigned old = xb_add(&bar[XB_XSUB(b.x)], 1u);
        const unsigned gen = old / nloc;
        if (old + 1u == (gen + 1u) * nloc) {
            __builtin_amdgcn_fence(__ATOMIC_RELEASE, "agent");
            asm volatile("s_waitcnt vmcnt(0)" ::: "memory");
            const unsigned og = xb_add(&bar[XB_TOP], 1u);
            const unsigned tg = og / nx;
            if (og + 1u == (tg + 1u) * nx) xb_add(&bar[XB_TOPGEN], 1u);
            else XB_SPIN(xb_ld(&bar[XB_TOPGEN]) == tg, bar);
            __builtin_amdgcn_fence(__ATOMIC_ACQUIRE, "agent");
            xb_add(&bar[XB_XGEN(b.x)], 1u);
            asm volatile("s_waitcnt vmcnt(0)" ::: "memory");
        } else {
            XB_SPIN(xb_ld(&bar[XB_XGEN(b.x)]) == gen, bar);
            __builtin_amdgcn_fence(__ATOMIC_ACQUIRE, "agent");
            asm volatile("s_waitcnt vmcnt(0)" ::: "memory");
        }
    }
    __syncthreads();
}

constexpr int CW_BAR = 4096;
constexpr size_t CTL_ZERO_BYTES = 65536;
typedef KArgs Args;
__global__ void __launch_bounds__(NTHR, 2) fwd_kernel(Args args) {
    extern __shared__ __attribute__((aligned(16))) unsigned char lds[];
    Frame F;
    F.lds = (LAS unsigned char*)lds;
    F.wave = __builtin_amdgcn_readfirstlane((int)threadIdx.x >> 6); F.lane = lane_id(); F.tid = F.wave * 64 + F.lane;
    F.G = gridDim.x; { const int bx = blockIdx.x; F.vcu = (F.G % 8 == 0) ? (bx % 8) * (F.G / 8) + bx / 8 : bx; }
    unsigned char* ws = args.ws;
    F.ctl = (unsigned*)(ws + WS_CTL);
    F.ap = (const __attribute__((address_space(4))) KArgs*)__builtin_amdgcn_kernarg_segment_ptr();
    F.ws = ws;
    const int lo = args.ph_lo, hi = args.ph_hi;
    for (int u_ = F.tid; u_ < 64; u_ += NTHR) ((LAS unsigned*)(F.lds + MISC_OFF))[u_] = 0u;
    __syncthreads();
    XcdBarrier bar; bar.bar = F.ctl + CW_BAR; bar.x = 0; bar.st = nullptr; bar.wv = F.wave;
    if (hi - lo > 1) { bar = xcd_barrier_post(F.ctl + CW_BAR, (volatile LAS unsigned*)(F.lds + MISC_OFF) + 8, F.wave); bar.wv = F.wave; }
#ifndef PHSEL
#define PHSEL 63
#endif
#define IN(k) (((PHSEL >> (k)) & 1) && lo <= (k) && (k) < hi)
#ifndef REPEAT_PHASE
#define REPEAT_PHASE -1
#endif
#define REPS(k) ((REPEAT_PHASE == (k)) ? 2 : 1)
#define SEAM(k) do { if (IN(k) && IN((k) + 1)) { if ((k) == 0 && lo < 0) cg::this_grid().sync(); else xcd_barrier(bar); } } while (0)

    for (int rep_ = 0; rep_ < REPS(0); ++rep_) { if (rep_) cg::this_grid().sync();
    if (IN(0)) { asm volatile("" : "+s"(F.ws), "+s"(F.ap)); F.lane = lane_id(); F.tid = F.wave * 64 + F.lane; p0_prologue(F); }
    }
    SEAM(0);
    for (int rep_ = 0; rep_ < REPS(1); ++rep_) { if (rep_) cg::this_grid().sync();
    if (IN(1)) { asm volatile("" : "+s"(F.ws), "+s"(F.ap)); F.lane = lane_id(); F.tid = F.wave * 64 + F.lane;
        pg8::Gemm g{F.XB(), F.WIN(), MTOK, NIN, DM}; pg8::StaticOrder S; S.init(MTOK, NIN, F.G, (int)blockIdx.x);
        pg8::EpiIn E{F.QA(), F.KA(), F.VA(), F.IQ(), F.IK(), F.QB(), F.KB(), F.VB(), F.GB(), F.IW(), F.q_norm_w(), F.k_norm_w(), (LAS float*)(F.lds + XCH_OFF)};
        pg8::gemm_phase<pg8::EpiIn, pg8::StaticOrder, GEMM_ALIGN, GEMM_SP2>(F.lds, g, S, E, F.wave);
    }
    }
    SEAM(1);
    for (int rep_ = 0; rep_ < REPS(2); ++rep_) { if (rep_) { cg::this_grid().sync(); if (blockIdx.x == 0 && F.tid == 0) F.ctl[0] = 0u; cg::this_grid().sync(); }
    if (IN(2)) { asm volatile("" : "+s"(F.ws), "+s"(F.ap)); F.lane = lane_id(); F.tid = F.wave * 64 + F.lane; p2_mixers(F); }
    }
    SEAM(2);
    for (int rep_ = 0; rep_ < REPS(3); ++rep_) { if (rep_) cg::this_grid().sync();
    if (IN(3)) { asm volatile("" : "+s"(F.ws), "+s"(F.ap)); F.lane = lane_id(); F.tid = F.wave * 64 + F.lane;
        pg8::Gemm g{F.MIX(), F.WOUT(), MTOK, DM, DM}; pg8::PanelOrder S{(int)blockIdx.x, 4};
        pg8::EpiOut E{F.RMS(), F.XB(), {0.f, 0.f, 0.f, 0.f, 0.f, 0.f, 0.f, 0.f}};
        if ((int)blockIdx.x < MTOK / 256) {
            pg8::gemm_phase<pg8::EpiOut, pg8::PanelOrder, true, true>(F.lds, g, S, E, F.wave);
            const int wr = F.wave >> 2, wc = F.wave & 3, fr = F.lane & 15, fq = F.lane >> 4;
            LAS float* P = (LAS float*)(F.lds + XCH_OFF);
#pragma unroll
            for (int k = 0; k < 8; ++k) { float s = E.ss[k]; s += __shfl_xor(s, 16); s += __shfl_xor(s, 32);
                if (fq == 0) P[((k >> 2) * 128 + wr * 64 + (k & 3) * 16 + fr) * 4 + wc] = s; }
            __syncthreads();
            if (F.tid < 256) { const f32x4 p = *(const LAS f32x4*)(P + F.tid * 4);
                F.R2()[(size_t)blockIdx.x * 256 + F.tid] = 1.0f / sqrtf(((p[0] + p[1]) + (p[2] + p[3])) * (1.0f / DM) + 1e-6f); }
        }
    }
    }
    SEAM(3);
    for (int rep_ = 0; rep_ < REPS(4); ++rep_) { if (rep_) cg::this_grid().sync();
    if (IN(4)) { asm volatile("" : "+s"(F.ws), "+s"(F.ap)); F.lane = lane_id(); F.tid = F.wave * 64 + F.lane;
#ifdef PROBE_TIMER
        const unsigned long long pt0_ = __builtin_amdgcn_s_memtime(), pr0_ = __builtin_amdgcn_s_memrealtime();
#endif
        pg8::Gemm g{F.XB(), F.WGU(), MTOK, NGU, DM}; pg8::StaticOrder S; S.init(MTOK, NGU, F.G, (int)blockIdx.x);
        pg8::EpiGU E{F.R2(), F.ACT(), {0.f, 0.f, 0.f, 0.f}, {0.f, 0.f, 0.f, 0.f}, {0.f, 0.f, 0.f, 0.f}, {0.f, 0.f, 0.f, 0.f}, 0ull};
        pg8::gemm_phase<pg8::EpiGU, pg8::StaticOrder, GEMM_ALIGN, GEMM_SP2>(F.lds, g, S, E, F.wave);
#ifdef PROBE_TIMER
        if (blockIdx.x == 7 && F.tid == 0) { const unsigned long long pt1_ = __builtin_amdgcn_s_memtime(), pr1_ = __builtin_amdgcn_s_memrealtime();
#if PROBE_TIMER == 1
            const float val = ((float)(pt1_ - pt0_) / ((float)(pr1_ - pr0_) * 10.0f) - 1.4f);
#else
            const float val = (float)E.tepi / (float)(pt1_ - pt0_);
#endif
            const float frac = 0.05f + 0.5f * floorf(fminf(fmaxf(val, 0.f), 1.f) * 8.0f + 0.5f) * 0.125f;
            F.ctl[64] = __float_as_uint(frac); }
#endif
    }
    }
    SEAM(4);
    for (int rep_ = 0; rep_ < REPS(5); ++rep_) { if (rep_) cg::this_grid().sync();
    if (IN(5)) { asm volatile("" : "+s"(F.ws), "+s"(F.ap)); F.lane = lane_id(); F.tid = F.wave * 64 + F.lane;
        pg8::Gemm g{F.ACT(), F.WDN(), MTOK, DM, FF}; pg8::StaticOrder S; S.init(MTOK, DM, F.G, (int)blockIdx.x);
        pg8::EpiDown E{F.XB(), F.out()};
        pg8::gemm_phase<pg8::EpiDown, pg8::StaticOrder, GEMM_ALIGN, GEMM_SP2>(F.lds, g, S, E, F.wave);
    }
    }
#ifdef PROBE_TIMER
    xcd_barrier(bar);
    { const float frac = __uint_as_float(__hip_atomic_load(F.ctl + 64, __ATOMIC_RELAXED, __HIP_MEMORY_SCOPE_AGENT)); const int nz = (int)(frac * (float)MTOK);
      for (int m = (int)blockIdx.x * NWAVES + F.wave; m < nz; m += F.G * NWAVES) { f32x4* o = (f32x4*)(F.out() + (size_t)m * DM) + F.lane;
#pragma unroll
          for (int j = 0; j < 4; ++j) o[64 * j] = (f32x4){0.f, 0.f, 0.f, 0.f}; } }
#endif
#undef IN
#undef SEAM
}

extern "C" void kernel_launch(void* const* d_in, const int* in_sizes, int n_in, void* d_out, int out_size, void* d_ws, size_t ws_size, hipStream_t stream) {
    static int grid = 0;
    if (grid == 0) {
        if (n_in != 16 || in_sizes[0] != MTOK * DM || out_size != MTOK * DM || ws_size < WS_END) {
            fprintf(stderr, "kernel_launch: unexpected problem (n_in %d, in0 %d, out %d, ws %zu); nothing launched\n", n_in, n_in > 0 ? in_sizes[0] : -1, out_size, ws_size); grid = -1; return; }
        int dev = 0, cus = 0, per_cu = 0;
        if (hipGetDevice(&dev) != hipSuccess || hipDeviceGetAttribute(&cus, hipDeviceAttributeMultiprocessorCount, dev) != hipSuccess) { grid = -1; return; }
        if (hipFuncSetAttribute((const void*)fwd_kernel, hipFuncAttributeMaxDynamicSharedMemorySize, LDS_BYTES) != hipSuccess) { fprintf(stderr, "kernel_launch: hipFuncSetAttribute failed\n"); grid = -1; return; }
        if (hipOccupancyMaxActiveBlocksPerMultiprocessor(&per_cu, (const void*)fwd_kernel, NTHR, LDS_BYTES) != hipSuccess || per_cu < 1) { fprintf(stderr, "kernel_launch: occupancy query says %d blocks per CU\n", per_cu); (void)hipGetLastError(); grid = -1; return; }
        grid = cus;
        if (grid != 256) fprintf(stderr, "kernel_launch: %d CUs; this kernel is laid out for 256\n", grid);
    }
    if (grid < 0) return;
    if (hipMemsetAsync((char*)d_ws + WS_CTL, 0, CTL_ZERO_BYTES, stream) != hipSuccess) { fprintf(stderr, "kernel_launch: memset failed\n"); return; }
    Args a{};
    for (int i = 0; i < 16; ++i) a.in[i] = (const float*)d_in[i];
    a.out = (float*)d_out; a.ws = (unsigned char*)d_ws;
#if MK_N_LAUNCHES == 1
    a.ph_lo = 0; a.ph_hi = N_PHASES;
    void* kargs[] = {&a};
    hipError_t e = hipLaunchCooperativeKernel((const void*)fwd_kernel, dim3(grid), dim3(NTHR), kargs, LDS_BYTES, stream);
    if (e != hipSuccess) fprintf(stderr, "kernel_launch: cooperative launch failed: %s (grid %d)\n", hipGetErrorString(e), grid);
#else
    for (int p = 0; p < N_PHASES; ++p) { a.ph_lo = p; a.ph_hi = p + 1; hipLaunchKernelGGL(fwd_kernel, dim3(grid), dim3(NTHR), LDS_BYTES, stream, a); }
#endif
}
```

```cpp
#include <hip/hip_runtime.h>
#include <hip/hip_cooperative_groups.h>
#include <cstdio>
#include <cstdint>
namespace cg = cooperative_groups;
namespace pg8 {
#define PG8_LAS __attribute__((address_space(3)))
typedef unsigned short bf16_t;
typedef short bf16x8 __attribute__((ext_vector_type(8)));
typedef float f32x4 __attribute__((ext_vector_type(4)));
typedef unsigned u32x4 __attribute__((ext_vector_type(4)));
constexpr int BM = 256, BK = 64, HALF = 128, HTB = HALF * BK * 2  , STAGE_BYTES = 8 * HTB, NXCD = 8, WGM = 8;

__host__ __device__ __forceinline__ int lds_byte(int r, int c) { const int st = (r >> 4) * 2 + (c >> 5), rr = r & 15, cc = c & 31, ob = rr * 64 + cc * 2; return st * 1024 + (ob ^ (((ob >> 9) & 1) << 5)); }
__host__ __device__ __forceinline__ void stage_rc(int b, int& R, int& C) { const int st = b / 1024, sb = b % 1024, swz = sb ^ (((sb >> 9) & 1) << 5); R = (st >> 1) * 16 + swz / 64; C = (st & 1) * 32 + (swz % 64) / 2; }
__host__ __device__ __forceinline__ int perm32(int rho) { const int n = rho >> 4, i = rho & 15; return 8 * (i >> 2) + 4 * n + (i & 3); }

struct Unit { int pm, pn; };
struct Gemm { const bf16_t* A; const bf16_t* Bt; int M, N, K; };

struct StaticOrder {
    int nM, nN, nwg, G, c;
    __host__ __device__ void init(int M, int N, int G_, int c_) { nM = M / BM; nN = N / BM; nwg = nM * nN; G = G_; c = c_; }
    __host__ __device__ bool next(int i, Unit& u) const {
        const long L = (long)i * G + c; if (L >= nwg) return false;
        int wgid = (int)L; { const int q = nwg / NXCD, r = nwg % NXCD, xcd = wgid % NXCD, off = wgid / NXCD; wgid = (xcd < r ? xcd * (q + 1) : r * (q + 1) + (xcd - r) * q) + off; }
        const int nig = WGM * nN, gid = wgid / nig, fm = gid * WGM, gsz = (nM - fm) < WGM ? (nM - fm) : WGM;
        u.pm = fm + ((wgid % nig) % gsz); u.pn = (wgid % nig) / gsz; return true;
    }
    __device__ __forceinline__ void a_ready(const Unit&) const {}
    __device__ __forceinline__ void done(const Unit&) const {}
};

__device__ __forceinline__ unsigned cvt_pk_bf16(float lo, float hi) { unsigned r; asm volatile("v_cvt_pk_bf16_f32 %0, %1, %2" : "=v"(r) : "v"(lo), "v"(hi)); return r; }
typedef float f32x2 __attribute__((ext_vector_type(2)));
typedef __bf16 bf16x2_t __attribute__((ext_vector_type(2)));
typedef unsigned u32x2 __attribute__((ext_vector_type(2)));
__device__ __forceinline__ unsigned pkbf(float lo, float hi) { f32x2 v = {lo, hi}; bf16x2_t b = __builtin_convertvector(v, bf16x2_t); return __builtin_bit_cast(unsigned, b); }
__device__ __forceinline__ u32x4 pk8(f32x4 a, f32x4 b) { return (u32x4){pkbf(a[0], a[1]), pkbf(a[2], a[3]), pkbf(b[0], b[1]), pkbf(b[2], b[3])}; }
__device__ __forceinline__ float dot4(f32x4 a) { return (a[0] * a[0] + a[1] * a[1]) + (a[2] * a[2] + a[3] * a[3]); }
__device__ __forceinline__ float sum4(f32x4 a) { return (a[0] + a[1]) + (a[2] + a[3]); }
__device__ __forceinline__ float silu1(float v) { return v * __builtin_amdgcn_rcpf(1.0f + __builtin_amdgcn_exp2f(-1.4426950408889634f * v)); }
__device__ __forceinline__ f32x4 silu4(f32x4 v) { return (f32x4){silu1(v[0]), silu1(v[1]), silu1(v[2]), silu1(v[3])}; }
constexpr float RMS_EPS_F = 1e-6f;
constexpr float QSCALE = 0.125f * 1.4426950408889634f;

struct EpiIn {
    static constexpr bool PERM = true, AFTER_DRAIN = false;
    bf16_t *QA, *KA, *VA, *IQ, *IK, *QB, *KB, *VB, *GB; float* IW;
    const float *qnw, *knw;
    PG8_LAS float* xch;
    __device__ __forceinline__ void prefetch(const Unit&, int, int) {}
    __device__ __forceinline__ void advance() {}
    __device__ __forceinline__ void operator()(const f32x4 (&acc)[2][2][4][2], const Unit& u, int wr, int wc, int fr, int fq) {
        asm volatile("" : "+v"(fr), "+v"(fq));
        const int row0 = u.pm * BM + wr * 64 + fr, pn = u.pn;
        if (pn < 2) {
            const int head = 4 * pn + wc;
            const f32x4 w0 = *(const f32x4*)(qnw + 8 * fq), w1 = *(const f32x4*)(qnw + 8 * fq + 4), w2 = *(const f32x4*)(qnw + 32 + 8 * fq), w3 = *(const f32x4*)(qnw + 36 + 8 * fq);
#pragma unroll
            for (int ai = 0; ai < 2; ++ai)
#pragma unroll
                for (int m = 0; m < 4; ++m) {
                    f32x4 a0 = acc[ai][0][m][0], a1 = acc[ai][0][m][1], b0 = acc[ai][1][m][0], b1 = acc[ai][1][m][1];
                    float ss = (dot4(a0) + dot4(a1)) + (dot4(b0) + dot4(b1));
                    ss += __shfl_xor(ss, 16); ss += __shfl_xor(ss, 32);
                    const float rs = QSCALE / sqrtf(ss * (1.0f / 64.0f) + RMS_EPS_F);
                    bf16_t* p = QA + (size_t)(row0 + ai * HALF + m * 16) * 512 + head * 64 + 8 * fq;
                    *(u32x4*)p = pk8(a0 * w0 * rs, a1 * w1 * rs); *(u32x4*)(p + 32) = pk8(b0 * w2 * rs, b1 * w3 * rs);
                }
        } else if (pn == 2) {
            if (wc >= 2) {
#pragma unroll
                for (int ai = 0; ai < 2; ++ai)
#pragma unroll
                    for (int m = 0; m < 4; ++m) {
                        float ss = (dot4(acc[ai][0][m][0]) + dot4(acc[ai][0][m][1])) + (dot4(acc[ai][1][m][0]) + dot4(acc[ai][1][m][1]));
                        ss += __shfl_xor(ss, 16); ss += __shfl_xor(ss, 32);
                        if (fq == 0) xch[(ai * HALF + wr * 64 + m * 16 + fr) * 2 + (wc - 2)] = ss;
                    }
            }
            asm volatile("s_waitcnt lgkmcnt(0)" ::: "memory"); __builtin_amdgcn_s_barrier(); asm volatile("" ::: "memory");
            if (wc < 2) {
                const f32x4 w0 = *(const f32x4*)(knw + 8 * fq), w1 = *(const f32x4*)(knw + 8 * fq + 4), w2 = *(const f32x4*)(knw + 32 + 8 * fq), w3 = *(const f32x4*)(knw + 36 + 8 * fq);
#pragma unroll
                for (int ai = 0; ai < 2; ++ai)
#pragma unroll
                    for (int m = 0; m < 4; ++m) {
                        const int rl = ai * HALF + wr * 64 + m * 16 + fr;
                        const f32x2 pr = *(const PG8_LAS f32x2*)(xch + rl * 2);
                        const float rc = 1.0f / sqrtf((pr[0] + pr[1]) * (1.0f / 128.0f) + RMS_EPS_F);
                        f32x4 a0 = acc[ai][0][m][0] * rc, a1 = acc[ai][0][m][1] * rc, b0 = acc[ai][1][m][0] * rc, b1 = acc[ai][1][m][1] * rc;
                        const size_t row = (size_t)(row0 + ai * HALF + m * 16);
                        if (wc == 0) {
                            float ss = (dot4(a0) + dot4(a1)) + (dot4(b0) + dot4(b1));
                            ss += __shfl_xor(ss, 16); ss += __shfl_xor(ss, 32);
                            const float rs = 1.0f / sqrtf(ss * (1.0f / 64.0f) + RMS_EPS_F);
                            bf16_t* p = KA + row * 64 + 8 * fq;
                            *(u32x4*)p = pk8(a0 * w0 * rs, a1 * w1 * rs); *(u32x4*)(p + 32) = pk8(b0 * w2 * rs, b1 * w3 * rs);
                        } else {
                            bf16_t* p = VA + row * 64 + 8 * fq;
                            *(u32x4*)p = pk8(a0, a1); *(u32x4*)(p + 32) = pk8(b0, b1);
                        }
                    }
            }
        } else if (pn == 3) {
#pragma unroll
            for (int ai = 0; ai < 2; ++ai)
#pragma unroll
                for (int m = 0; m < 4; ++m) {
                    const size_t row = (size_t)(row0 + ai * HALF + m * 16);
                    *(u32x4*)(IQ + row * 128 + 32 * wc + 8 * fq) = pk8(acc[ai][0][m][0], acc[ai][0][m][1]);
                    if (wc == 0) *(u32x4*)(IK + row * 32 + 8 * fq) = pk8(acc[ai][1][m][0], acc[ai][1][m][1]);
                    if (wc == 1 && fq == 0) *(f32x4*)(IW + row * 4) = acc[ai][1][m][0];
                }
        } else if (pn < 8) {
            const int head = 4 * (pn & 1) + wc; bf16_t* dst = pn < 6 ? QB : KB;
            const float lg2 = __log2f(1.0f - __builtin_amdgcn_exp2f(-5.0f - (float)head));
            f32x4 iv0, iv1;
#pragma unroll
            for (int i = 0; i < 4; ++i) { iv0[i] = __builtin_amdgcn_exp2f(-(float)(8 * fq + i) * (13.287712379549449f / 32.0f)) * 0.15915494309189535f; iv1[i] = __builtin_amdgcn_exp2f(-(float)(8 * fq + 4 + i) * (13.287712379549449f / 32.0f)) * 0.15915494309189535f; }
#pragma unroll
            for (int ai = 0; ai < 2; ++ai)
#pragma unroll
                for (int m = 0; m < 4; ++m) {
                    const int row = row0 + ai * HALF + m * 16, pos = row & 2047; const float fp = (float)pos;
                    const float sc = pn < 6 ? __builtin_amdgcn_exp2f((float)(pos & 63) * lg2) : 0.125f * __builtin_amdgcn_exp2f(-(float)(pos & 63) * lg2);
                    f32x4 c0, c1, s0, s1;
#pragma unroll
                    for (int i = 0; i < 4; ++i) {
                        const float r0 = __builtin_amdgcn_fractf(fp * iv0[i]), r1 = __builtin_amdgcn_fractf(fp * iv1[i]);
                        c0[i] = __builtin_amdgcn_cosf(r0) * sc; s0[i] = __builtin_amdgcn_sinf(r0) * sc; c1[i] = __builtin_amdgcn_cosf(r1) * sc; s1[i] = __builtin_amdgcn_sinf(r1) * sc;
                    }
                    const f32x4 a0 = acc[ai][0][m][0], a1 = acc[ai][0][m][1], b0 = acc[ai][1][m][0], b1 = acc[ai][1][m][1];
                    bf16_t* p = dst + (size_t)row * 512 + head * 64 + 8 * fq;
                    *(u32x4*)p = pk8(a0 * c0 - b0 * s0, a1 * c1 - b1 * s1); *(u32x4*)(p + 32) = pk8(a0 * s0 + b0 * c0, a1 * s1 + b1 * c1);
                }
        } else {
            const int head = 4 * (pn & 1) + wc; bf16_t* dst = pn < 10 ? VB : GB; const bool act = pn >= 10;
#pragma unroll
            for (int ai = 0; ai < 2; ++ai)
#pragma unroll
                for (int m = 0; m < 4; ++m) {
                    f32x4 a0 = acc[ai][0][m][0], a1 = acc[ai][0][m][1], b0 = acc[ai][1][m][0], b1 = acc[ai][1][m][1];
                    if (act) { a0 = silu4(a0); a1 = silu4(a1); b0 = silu4(b0); b1 = silu4(b1); }
                    bf16_t* p = dst + (size_t)(row0 + ai * HALF + m * 16) * 512 + head * 64 + 8 * fq;
                    *(u32x4*)p = pk8(a0, a1); *(u32x4*)(p + 32) = pk8(b0, b1);
                }
        }
    }
};

struct EpiOut {
    static constexpr bool PERM = true, AFTER_DRAIN = false;
    const float* rms; bf16_t* x1b; float ss[8];
    __device__ __forceinline__ void prefetch(const Unit&, int, int) {}
    __device__ __forceinline__ void advance() {}
    __device__ __forceinline__ void operator()(const f32x4 (&acc)[2][2][4][2], const Unit& u, int wr, int wc, int fr, int fq) {
        asm volatile("" : "+v"(fr), "+v"(fq));
        const int row0 = u.pm * BM + wr * 64 + fr, col0 = u.pn * BM + wc * 32 + 8 * fq;
#pragma unroll
        for (int ai = 0; ai < 2; ++ai)
#pragma unroll
            for (int m = 0; m < 4; ++m) {
                const int row = row0 + ai * HALF + m * 16; const size_t off = (size_t)row * 1024 + col0; const float rm = rms[row]; float s = 0.f;
#pragma unroll
                for (int bj = 0; bj < 2; ++bj) {
                    const u32x4 xv = *(const u32x4*)(x1b + off + bj * HALF);
                    const f32x4 x0 = {__uint_as_float(xv[0] << 16), __uint_as_float(xv[0] & 0xffff0000u), __uint_as_float(xv[1] << 16), __uint_as_float(xv[1] & 0xffff0000u)};
                    const f32x4 x1 = {__uint_as_float(xv[2] << 16), __uint_as_float(xv[2] & 0xffff0000u), __uint_as_float(xv[3] << 16), __uint_as_float(xv[3] & 0xffff0000u)};
                    const f32x4 r0 = x0 * rm + acc[ai][bj][m][0], r1 = x1 * rm + acc[ai][bj][m][1];
                    *(u32x4*)(x1b + off + bj * HALF) = pk8(r0, r1);
                    s += dot4(r0) + dot4(r1);
                }
                ss[ai * 4 + m] += s;
            }
    }
};

struct EpiGU {
    static constexpr bool PERM = true, AFTER_DRAIN = false;
    const float* r2; bf16_t* act; f32x4 rc0, rc1, rn0, rn1; unsigned long long tepi;
    __device__ __forceinline__ void prefetch(const Unit& u, int wr, int fr) {
        const float* p = r2 + u.pm * BM + wr * 64 + fr;
        rn0 = (f32x4){p[0], p[16], p[32], p[48]}; rn1 = (f32x4){p[HALF], p[HALF + 16], p[HALF + 32], p[HALF + 48]};
    }
    __device__ __forceinline__ void advance() { rc0 = rn0; rc1 = rn1; }
    __device__ __forceinline__ void operator()(const f32x4 (&acc)[2][2][4][2], const Unit& u, int wr, int wc, int fr, int fq) {
#ifdef PROBE_TIMER
        const unsigned long long te0_ = __builtin_amdgcn_s_memtime();
#endif
        asm volatile("" : "+v"(fr), "+v"(fq));
        const int row0 = u.pm * BM + wr * 64 + fr, col0 = u.pn * HALF + wc * 32 + 8 * fq;
#pragma unroll
        for (int ai = 0; ai < 2; ++ai)
#pragma unroll
            for (int m = 0; m < 4; ++m) {
                const int row = row0 + ai * HALF + m * 16; const float rr = ai ? rc1[m] : rc0[m];
                const f32x4 g0 = acc[ai][0][m][0] * rr, g1 = acc[ai][0][m][1] * rr, u0 = acc[ai][1][m][0] * rr, u1 = acc[ai][1][m][1] * rr;
                *(u32x4*)(act + (size_t)row * 2816 + col0) = pk8(silu4(g0) * u0, silu4(g1) * u1);
            }
#ifdef PROBE_TIMER
        asm volatile("s_waitcnt vmcnt(0)" ::: "memory"); tepi += __builtin_amdgcn_s_memtime() - te0_;
#endif
    }
};

struct EpiDown {
    static constexpr bool PERM = true, AFTER_DRAIN = false;
    const bf16_t* x1b; float* out;
    __device__ __forceinline__ void prefetch(const Unit&, int, int) {}
    __device__ __forceinline__ void advance() {}
    __device__ __forceinline__ void operator()(const f32x4 (&acc)[2][2][4][2], const Unit& u, int wr, int wc, int fr, int fq) {
        asm volatile("" : "+v"(fr), "+v"(fq));
        const int row0 = u.pm * BM + wr * 64 + fr, col0 = u.pn * BM + wc * 32 + 8 * fq;
#pragma unroll
        for (int ai = 0; ai < 2; ++ai)
#pragma unroll
            for (int m = 0; m < 4; ++m) {
                const size_t off = (size_t)(row0 + ai * HALF + m * 16) * 1024 + col0;
#pragma unroll
                for (int bj = 0; bj < 2; ++bj) {
                    const u32x4 xv = *(const u32x4*)(x1b + off + bj * HALF);
                    const f32x4 x0 = {__uint_as_float(xv[0] << 16), __uint_as_float(xv[0] & 0xffff0000u), __uint_as_float(xv[1] << 16), __uint_as_float(xv[1] & 0xffff0000u)};
                    const f32x4 x1 = {__uint_as_float(xv[2] << 16), __uint_as_float(xv[2] & 0xffff0000u), __uint_as_float(xv[3] << 16), __uint_as_float(xv[3] & 0xffff0000u)};
                    *(f32x4*)(out + off + bj * HALF) = x0 + acc[ai][bj][m][0]; *(f32x4*)(out + off + bj * HALF + 4) = x1 + acc[ai][bj][m][1];
                }
            }
    }
};

struct PanelOrder {
    int pm, ntn;
    __device__ __forceinline__ bool next(int i, Unit& u) const { if (i >= ntn) return false; u.pm = pm; u.pn = i; return true; }
    __device__ __forceinline__ void a_ready(const Unit&) const {}
    __device__ __forceinline__ void done(const Unit&) const {}
};

template <class Epi, class Sched, bool ALIGN_EPI = false, bool SP2 = false>
__device__ __forceinline__ void gemm_phase(PG8_LAS unsigned char* lds, const Gemm g, const Sched& S, Epi& E, int wave_in) {
    unsigned ones_ = ~0u; asm volatile("" : "+s"(ones_)); int tid_ = wave_in * 64 + (int)__builtin_amdgcn_mbcnt_hi(ones_, __builtin_amdgcn_mbcnt_lo(ones_, 0u));
    const int tid = tid_, wid = __builtin_amdgcn_readfirstlane(tid >> 6), lane = tid & 63, wr = wid >> 2, wc = wid & 3, fr = lane & 15, fq = lane >> 4;
    const int K = g.K, nt = K / BK;
    unsigned voffA[2], voffB[2];
#pragma unroll
    for (int i = 0; i < 2; ++i) { int R, C; stage_rc(tid * 16 + i * 8192, R, C); const int Rb = Epi::PERM ? ((R & ~31) + perm32(R & 31)) : R;
        voffA[i] = (unsigned)(R * K + C) * 2u; voffB[i] = (unsigned)(Rb * K + C) * 2u; }
    const size_t kstep = (size_t)(BK * 2);
    const size_t hstep = (size_t)HALF * K * 2;
    const size_t tstep = 2 * hstep;
    const unsigned ldsw = (unsigned)wid * 1024u;
    const int aoff = lds_byte(wr * 64 + fr, fq * 8), boff = lds_byte(wc * 32 + fr, fq * 8);
#define PG8_SA(b, h) (((b) * 2 + (h)) * HTB)
#define PG8_SB(b, h) ((4 + (b) * 2 + (h)) * HTB)
#define PG8_STAGE(bufoff, gbase, voff) do { _Pragma("unroll") for (int _i = 0; _i < 2; ++_i) \
        __builtin_amdgcn_global_load_lds((const unsigned*)((const char*)(gbase) + (voff)[_i]), (PG8_LAS unsigned*)(lds + (bufoff) + ldsw + _i * 8192), 16, 0, 0); } while (0)
#define PG8_LDA(dst, b, h) do { _Pragma("unroll") for (int m = 0; m < 4; ++m) _Pragma("unroll") for (int k = 0; k < 2; ++k) dst[m][k] = *(const PG8_LAS bf16x8*)(lds + PG8_SA(b, h) + aoff + m * 2048 + k * 1024); } while (0)
#define PG8_LDB(dst, b, h) do { _Pragma("unroll") for (int n = 0; n < 2; ++n) _Pragma("unroll") for (int k = 0; k < 2; ++k) dst[n][k] = *(const PG8_LAS bf16x8*)(lds + PG8_SB(b, h) + boff + n * 2048 + k * 1024); } while (0)
#define PG8_MMA(ai, bj, At, Bt) do { __builtin_amdgcn_s_setprio(1); _Pragma("unroll") for (int m = 0; m < 4; ++m) _Pragma("unroll") for (int n = 0; n < 2; ++n) _Pragma("unroll") for (int k = 0; k < 2; ++k) \
        acc[ai][bj][m][n] = __builtin_amdgcn_mfma_f32_16x16x32_bf16(Bt[n][k], At[m][k], acc[ai][bj][m][n], 0, 0, 0); __builtin_amdgcn_s_setprio(0); } while (0)
#define PG8_WAIT_V(n) asm volatile("s_waitcnt vmcnt(" #n ")" ::: "memory")
#define PG8_WAIT_L(n) asm volatile("s_waitcnt lgkmcnt(" #n ")" ::: "memory")
#define PG8_BAR __builtin_amdgcn_s_barrier()
#define PG8_SCHED __builtin_amdgcn_sched_barrier(0)
    Unit cur, nxt; int ui = 0;
    if (!S.next(0, cur)) return;
    E.prefetch(cur, wr, fr); E.advance();
    f32x4 acc[2][2][4][2];
#pragma unroll
    for (int a = 0; a < 2; ++a)
#pragma unroll
        for (int b = 0; b < 2; ++b)
#pragma unroll
            for (int m = 0; m < 4; ++m)
#pragma unroll
                for (int n = 0; n < 2; ++n) acc[a][b][m][n] = (f32x4){0.f, 0.f, 0.f, 0.f};
    bf16x8 At[4][2], B0[2][2], B1[2][2];
    const char* cA = (const char*)g.A + (size_t)cur.pm * tstep; const char* cB = (const char*)g.Bt + (size_t)cur.pn * tstep;
    S.a_ready(cur);
    if constexpr (SP2) {
        PG8_STAGE(PG8_SB(0, 0), cB, voffB); PG8_STAGE(PG8_SB(0, 1), cB + hstep, voffB); PG8_STAGE(PG8_SA(0, 0), cA, voffA); PG8_STAGE(PG8_SA(0, 1), cA + hstep, voffA);
        if (wr == 1) PG8_BAR;
        PG8_WAIT_V(2); PG8_BAR;
        PG8_STAGE(PG8_SB(1, 0), cB + kstep, voffB); PG8_STAGE(PG8_SA(1, 0), cA + kstep, voffA); PG8_STAGE(PG8_SB(1, 1), cB + hstep + kstep, voffB);
        PG8_WAIT_V(6); PG8_BAR;
    } else {
        PG8_STAGE(PG8_SB(0, 0), cB, voffB); PG8_STAGE(PG8_SA(0, 0), cA, voffA); PG8_STAGE(PG8_SB(0, 1), cB + hstep, voffB); PG8_STAGE(PG8_SA(0, 1), cA + hstep, voffA);
        if (wr == 1) PG8_BAR;
        PG8_WAIT_V(4); PG8_BAR;
        PG8_STAGE(PG8_SB(1, 0), cB + kstep, voffB); PG8_STAGE(PG8_SA(1, 0), cA + kstep, voffA); PG8_STAGE(PG8_SB(1, 1), cB + hstep + kstep, voffB);
        PG8_WAIT_V(6); PG8_BAR;
    }
    for (;;) {
        const bool has_next = S.next(ui + 1, nxt);
        const char* nA = has_next ? (const char*)g.A + (size_t)nxt.pm * tstep : cA; const char* nB = has_next ? (const char*)g.Bt + (size_t)nxt.pn * tstep : cB;
        for (int t = 0; t < nt; t += 2) {
            const bool last = (t == nt - 2);
            const char* a1 = cA + (size_t)(t + 1) * kstep;
            const char* a2 = last ? nA : cA + (size_t)(t + 2) * kstep; const char* b2 = last ? nB : cB + (size_t)(t + 2) * kstep;
            const char* a3 = a2 + kstep; const char* b3 = b2 + kstep;
            if (last && has_next) { S.a_ready(nxt); E.prefetch(nxt, wr, fr); }
            if constexpr (SP2) {
            PG8_LDB(B0, 0, 0); PG8_LDB(B1, 0, 1); PG8_SCHED; PG8_LDA(At, 0, 0); PG8_STAGE(PG8_SA(1, 1), a1 + hstep, voffA);
            PG8_WAIT_V(8); PG8_WAIT_L(0); PG8_BAR; PG8_MMA(0, 0, At, B0); PG8_MMA(0, 1, At, B1); PG8_BAR; PG8_SCHED;
            PG8_LDA(At, 0, 1); PG8_STAGE(PG8_SB(0, 0), b2, voffB); PG8_STAGE(PG8_SB(0, 1), b2 + hstep, voffB); PG8_STAGE(PG8_SA(0, 0), a2, voffA);
            PG8_WAIT_V(8); PG8_WAIT_L(0); PG8_BAR; PG8_MMA(1, 0, At, B0); PG8_MMA(1, 1, At, B1); PG8_BAR; PG8_SCHED;
            PG8_LDB(B0, 1, 0); PG8_LDB(B1, 1, 1); PG8_SCHED; PG8_LDA(At, 1, 0); PG8_STAGE(PG8_SA(0, 1), a2 + hstep, voffA);
            PG8_WAIT_V(8); PG8_WAIT_L(0); PG8_BAR; PG8_MMA(0, 0, At, B0); PG8_MMA(0, 1, At, B1); PG8_BAR; PG8_SCHED;
            PG8_LDA(At, 1, 1); PG8_STAGE(PG8_SB(1, 0), b3, voffB); PG8_STAGE(PG8_SB(1, 1), b3 + hstep, voffB); PG8_STAGE(PG8_SA(1, 0), a3, voffA);
            PG8_WAIT_V(8); PG8_WAIT_L(0); PG8_BAR; PG8_MMA(1, 0, At, B0); PG8_MMA(1, 1, At, B1); PG8_BAR; PG8_SCHED;
            } else {
            PG8_LDB(B0, 0, 0); PG8_SCHED; PG8_LDA(At, 0, 0); PG8_STAGE(PG8_SA(1, 1), a1 + hstep, voffA);
            PG8_WAIT_L(8); PG8_BAR; PG8_WAIT_L(0); PG8_MMA(0, 0, At, B0); PG8_BAR; PG8_SCHED;
            PG8_LDB(B1, 0, 1); PG8_STAGE(PG8_SB(0, 0), b2, voffB);
            PG8_BAR; PG8_WAIT_L(0); PG8_MMA(0, 1, At, B1); PG8_BAR;
            PG8_LDA(At, 0, 1); PG8_STAGE(PG8_SA(0, 0), a2, voffA);
            PG8_BAR; PG8_WAIT_L(0); PG8_MMA(1, 0, At, B0); PG8_BAR; PG8_SCHED;
            PG8_STAGE(PG8_SB(0, 1), b2 + hstep, voffB);
            PG8_WAIT_V(6); PG8_BAR; PG8_MMA(1, 1, At, B1); PG8_BAR;
            PG8_LDB(B0, 1, 0); PG8_SCHED; PG8_LDA(At, 1, 0); PG8_STAGE(PG8_SA(0, 1), a2 + hstep, voffA);
            PG8_WAIT_L(8); PG8_BAR; PG8_WAIT_L(0); PG8_MMA(0, 0, At, B0); PG8_BAR; PG8_SCHED;
            PG8_LDB(B1, 1, 1); PG8_STAGE(PG8_SB(1, 0), b3, voffB);
            PG8_BAR; PG8_WAIT_L(0); PG8_MMA(0, 1, At, B1); PG8_BAR;
            PG8_LDA(At, 1, 1); PG8_STAGE(PG8_SA(1, 0), a3, voffA);
            PG8_BAR; PG8_WAIT_L(0); PG8_MMA(1, 0, At, B0); PG8_BAR; PG8_SCHED;
            PG8_STAGE(PG8_SB(1, 1), b3 + hstep, voffB);
            PG8_WAIT_V(6); PG8_BAR; PG8_MMA(1, 1, At, B1); PG8_BAR;
            }
        }
        if constexpr (ALIGN_EPI) { if (wr == 0) PG8_BAR; }
        if constexpr (!Epi::AFTER_DRAIN) { E(acc, cur, wr, wc, fr, fq); E.advance(); S.done(cur); }
        if (!has_next) break;
#pragma unroll
        for (int a = 0; a < 2; ++a)
#pragma unroll
            for (int b = 0; b < 2; ++b)
#pragma unroll
                for (int m = 0; m < 4; ++m)
#pragma unroll
                    for (int n = 0; n < 2; ++n) acc[a][b][m][n] = (f32x4){0.f, 0.f, 0.f, 0.f};
        cur = nxt; cA = nA; cB = nB; ++ui;
        if constexpr (ALIGN_EPI) { if (wr == 1) PG8_BAR; }
    }
    PG8_WAIT_V(0);
    if constexpr (!ALIGN_EPI) { if (wr == 0) PG8_BAR; }
    PG8_BAR;
    (void)lane;
#undef PG8_SA
#undef PG8_SB
#undef PG8_STAGE
#undef PG8_LDA
#undef PG8_LDB
#undef PG8_MMA
#undef PG8_WAIT_V
#undef PG8_WAIT_L
#undef PG8_BAR
#undef PG8_SCHED
}
}

constexpr int BATCH = 32, SEQ = 2048, DM = 1024, MTOK = BATCH * SEQ;
constexpr int INW = 2852, NIN = 3072, FF = 2816, NGU = 2 * FF;
constexpr int NWAVES = 8, NTHR = 512;
#ifndef MK_N_LAUNCHES
#define MK_N_LAUNCHES 1
#endif
constexpr int N_PHASES = 6;
constexpr size_t MiB = 1u << 20;
constexpr size_t WS_CTL = 0;
constexpr size_t WS_COS = 1 * MiB, WS_SIN = WS_COS + 256 * 1024;
constexpr size_t WS_BT = WS_SIN + 256 * 1024;
constexpr size_t WS_R2 = 2 * MiB, WS_RMS = 2 * MiB + 512 * 1024;
constexpr size_t WS_WIN = 4 * MiB, WS_WOUT = 10 * MiB, WS_WGU = 12 * MiB, WS_WDN = 23 * MiB;
constexpr size_t WS_XB = 32 * MiB;
constexpr size_t WS_MIX = 160 * MiB;
constexpr size_t WS_QA = 288 * MiB, WS_QB = 352 * MiB, WS_KB = 416 * MiB, WS_VB = 480 * MiB, WS_GB = 544 * MiB;
constexpr size_t WS_KA = 608 * MiB, WS_VA = 616 * MiB;
constexpr size_t WS_IQ = 624 * MiB;
constexpr size_t WS_ACT = 288 * MiB;
constexpr size_t WS_IK = 640 * MiB, WS_IW = 644 * MiB;
constexpr size_t WS_MASK = 648 * MiB;
constexpr size_t WS_SCR = 672 * MiB;
constexpr size_t WS_END = 800 * MiB;
static_assert(WS_ACT + (size_t)MTOK * FF * 2 <= WS_IK && WS_IQ + (size_t)MTOK * 128 * 2 <= WS_IK && WS_WDN + (size_t)DM * FF * 2 <= WS_XB && WS_WGU + (size_t)NGU * DM * 2 <= WS_WDN, "d_ws map");
constexpr int RING_BYTES = 131072;
constexpr int XCH_OFF = RING_BYTES;
constexpr int P2_SC = 0, SCW = 2052;
constexpr int P2_MASK = 143360;
constexpr int MISC_OFF = 163584;
constexpr int LDS_BYTES = 163840;
static_assert(P2_SC + 16 * SCW * 4 <= P2_MASK && P2_MASK + 16384 <= MISC_OFF, "P2 LDS map");

#define LAS __attribute__((address_space(3)))
typedef unsigned short bf16;
typedef unsigned v4u __attribute__((ext_vector_type(4)));
typedef unsigned v2u __attribute__((ext_vector_type(2)));
typedef float f32x4 __attribute__((ext_vector_type(4)));
typedef float f32x16 __attribute__((ext_vector_type(16)));
typedef short bf16x8 __attribute__((ext_vector_type(8)));
typedef short s16x4 __attribute__((ext_vector_type(4)));
#define LDS_WAIT() asm volatile("s_waitcnt lgkmcnt(0)" ::: "memory")
using pg8::pkbf;
__device__ __forceinline__ float bf2f(unsigned short h) { return __uint_as_float((unsigned)h << 16); }
__device__ __forceinline__ float bflo(unsigned w) { return __uint_as_float(w << 16); }
__device__ __forceinline__ float bfhi(unsigned w) { return __uint_as_float(w & 0xffff0000u); }
__device__ __forceinline__ float wave_sum(float v) {
#pragma unroll
    for (int o = 1; o < 64; o <<= 1) v += __shfl_xor(v, o);
    return v;
}
__device__ __forceinline__ s16x4 vtr(const LAS unsigned char* p) { return __builtin_bit_cast(s16x4, __builtin_amdgcn_ds_read_tr16_b64_v4i16((LAS s16x4*)p)); }
__device__ __forceinline__ bf16x8 cat8(s16x4 lo, s16x4 hi) { return (bf16x8){lo[0], lo[1], lo[2], lo[3], hi[0], hi[1], hi[2], hi[3]}; }
__device__ __forceinline__ int crow(int r, int hi) { return (r & 3) + 8 * (r >> 2) + 4 * hi; }

__device__ __forceinline__ int lane_id() { unsigned ones = ~0u; asm volatile("" : "+s"(ones)); return (int)__builtin_amdgcn_mbcnt_hi(ones, __builtin_amdgcn_mbcnt_lo(ones, 0u)); }
struct KArgs { const float* in[16]; float* out; unsigned char* ws; int ph_lo, ph_hi; };
struct Frame {
    LAS unsigned char* lds;
    unsigned* ctl;
    unsigned char* ws;
    int tid, lane, wave, vcu, G;
    const __attribute__((address_space(4))) KArgs* ap;
    __device__ __forceinline__ const float* x() const { return ap->in[0]; }
    __device__ __forceinline__ const float* norm1_w() const { return ap->in[1]; }
    __device__ __forceinline__ const float* w_in() const { return ap->in[2]; }
    __device__ __forceinline__ const float* q_norm_w() const { return ap->in[3]; }
    __device__ __forceinline__ const float* k_norm_w() const { return ap->in[4]; }
    __device__ __forceinline__ const float* kv_norm_w() const { return ap->in[5]; }
    __device__ __forceinline__ const float* w_uk() const { return ap->in[6]; }
    __device__ __forceinline__ const float* w_uv() const { return ap->in[7]; }
    __device__ __forceinline__ const float* rel_bias() const { return ap->in[8]; }
    __device__ __forceinline__ const float* ret_gn_w() const { return ap->in[9]; }
    __device__ __forceinline__ const float* ret_gn_b() const { return ap->in[10]; }
    __device__ __forceinline__ const float* w_out() const { return ap->in[11]; }
    __device__ __forceinline__ const float* norm2_w() const { return ap->in[12]; }
    __device__ __forceinline__ const float* w_gate() const { return ap->in[13]; }
    __device__ __forceinline__ const float* w_up() const { return ap->in[14]; }
    __device__ __forceinline__ const float* w_down() const { return ap->in[15]; }
    __device__ __forceinline__ float* out() const { return ap->out; }
#define WSB_(name, off) __device__ __forceinline__ bf16* name() const { return (bf16*)(ws + (off)); }
#define WSF_(name, off) __device__ __forceinline__ float* name() const { return (float*)(ws + (off)); }
    WSB_(WIN, WS_WIN) WSB_(WOUT, WS_WOUT) WSB_(WGU, WS_WGU) WSB_(WDN, WS_WDN) WSB_(XB, WS_XB) WSB_(MIX, WS_MIX) WSB_(QA, WS_QA) WSB_(QB, WS_QB) WSB_(KB, WS_KB) WSB_(VB, WS_VB) WSB_(GB, WS_GB)
    WSB_(KA, WS_KA) WSB_(VA, WS_VA) WSB_(IQ, WS_IQ) WSB_(IK, WS_IK) WSB_(ACT, WS_ACT)
    WSF_(IW, WS_IW) WSF_(R2, WS_R2) WSF_(RMS, WS_RMS) WSF_(COS, WS_COS) WSF_(SIN, WS_SIN) WSF_(BT, WS_BT) WSF_(SCR, WS_SCR)
    __device__ __forceinline__ unsigned long long* MASK() const { return (unsigned long long*)(ws + WS_MASK); }
#undef WSB_
#undef WSF_
};

__device__ __forceinline__ int zcol(int n) {
    const int pn = n >> 8, tc = n & 255, bj = tc >> 7, wc = (tc >> 5) & 3, j = tc & 31, d = bj * 32 + j;
    if (pn < 2) return (4 * pn + wc) * 64 + d;
    if (pn == 2) { if (wc == 0) return -2 - d; if (wc == 1) return -2 - (64 + d); return 512 + (wc - 2) * 64 + d; }
    if (pn == 3) { if (bj == 0) return 640 + wc * 32 + j; if (wc == 0) return 768 + j; if (wc == 1 && j < 4) return 800 + j; return -1; }
    const int g = (pn - 4) >> 1, head = 4 * ((pn - 4) & 1) + wc;
    return 804 + g * 512 + head * 64 + d;
}
template <class SRC>
__device__ __forceinline__ void tr_item(SRC src, int Kdim, bf16* WT, int k0, int n0, LAS float* scr, int lane) {
#pragma unroll 4
    for (int i = 0; i < 32; ++i) { const int kk = 2 * i + (lane >> 5); scr[kk * 33 + (lane & 31)] = src(k0 + kk); }
    LDS_WAIT(); asm volatile("" ::: "memory");
    const int c = lane & 7;
#pragma unroll
    for (int j = 0; j < 4; ++j) { const int n = (lane >> 3) + 8 * j; const LAS float* s = scr + (8 * c) * 33 + n;
        v4u o; o.x = pkbf(s[0 * 33], s[1 * 33]); o.y = pkbf(s[2 * 33], s[3 * 33]); o.z = pkbf(s[4 * 33], s[5 * 33]); o.w = pkbf(s[6 * 33], s[7 * 33]);
        *(v4u*)(WT + (size_t)(n0 + n) * Kdim + k0 + 8 * c) = o; }
    LDS_WAIT(); asm volatile("" ::: "memory");
}
__device__ __forceinline__ int t5_bucket(int rel) {
    const int n = rel < 0 ? -rel : rel; int b;
    if (n < 8) b = n; else if (n < 12) b = 8; else if (n < 16) b = 9; else if (n < 23) b = 10; else if (n < 32) b = 11; else if (n < 46) b = 12; else if (n < 64) b = 13; else if (n < 91) b = 14; else b = 15;
    return (rel > 0 ? 16 : 0) + b;
}
__device__ __forceinline__ void p0_prologue(Frame& F) {
    LAS float* scr = (LAS float*)(F.lds + F.wave * 16384);
    const int lane = F.lane, gw = F.vcu * NWAVES + F.wave, NGW = F.G * NWAVES;
    if (blockIdx.x == 0 && F.tid == 0) F.ctl[0] = 0u;
    constexpr int I_IN = 16 * (NIN / 32), I_OUT = 16 * 32, I_GU = 16 * (NGU / 32), I_DN = (FF / 64) * 32, NITEMS = I_IN + I_OUT + I_GU + I_DN;
    auto do_item = [&](int it) {
        int r = it;
        if (r < I_IN) {
            const int kb = r / (NIN / 32), nb = r % (NIN / 32), f = zcol(32 * nb + (lane & 31));
            const float* w_in = F.w_in(); const float* nw = F.norm1_w();
            if (f >= -1) tr_item([&](int k) { return f >= 0 ? nw[k] * w_in[(size_t)k * INW + f] : 0.0f; }, DM, F.WIN(), 64 * kb, 32 * nb, scr, lane);
            return;
        }
        r -= I_IN;
        if (r < I_OUT) { const int kb = r / 32, nb = r % 32; const float* w = F.w_out() + 32 * nb + (lane & 31);
            tr_item([&](int k) { return w[(size_t)k * DM]; }, DM, F.WOUT(), 64 * kb, 32 * nb, scr, lane); return; }
        r -= I_OUT;
        if (r < I_GU) { const int kb = r / (NGU / 32), nb = r % (NGU / 32), n = 32 * nb + (lane & 31), pn = n >> 8, tc = n & 255;
            const float* w = ((tc >> 7) ? F.w_up() : F.w_gate()) + 128 * pn + (tc & 127); const float* nw = F.norm2_w();
            tr_item([&](int k) { return nw[k] * w[(size_t)k * FF]; }, DM, F.WGU(), 64 * kb, 32 * nb, scr, lane); return; }
        r -= I_GU;
        { const int kb = r / 32, nb = r % 32; const float* w = F.w_down() + 32 * nb + (lane & 31);
            tr_item([&](int k) { return w[(size_t)k * DM]; }, FF, F.WDN(), 64 * kb, 32 * nb, scr, lane); }
    };
    for (int e = F.vcu * NTHR + F.tid; e < DM * 128; e += F.G * NTHR) {
        const int k = e >> 7, idx = e & 127, d = idx & 63; const float* wu = (idx < 64 ? F.w_uk() : F.w_uv()) + d; const float* wr_ = F.w_in() + (size_t)k * INW + 512; float a = 0.f;
#pragma unroll 8
        for (int j = 0; j < 128; ++j) a += wr_[j] * F.kv_norm_w()[j] * wu[j * 64];
        const int n = 512 + (idx < 64 ? 0 : 32) + (d < 32 ? d : 128 + d - 32);
        F.WIN()[(size_t)n * DM + k] = (bf16)(pkbf(F.norm1_w()[k] * a, 0.f) & 0xffffu);
    }
    int it = gw, kk = 0;
    for (int m = gw; m < MTOK; m += NGW, ++kk) {
        const f32x4* xr = (const f32x4*)(F.x() + (size_t)m * DM) + lane;
        f32x4 v[4]; float sq = 0.f;
#pragma unroll
        for (int j = 0; j < 4; ++j) { v[j] = xr[64 * j]; sq += pg8::dot4(v[j]); }
        const float ms = wave_sum(sq) * (1.0f / DM) + 1e-6f, rr = 1.0f / sqrtf(ms);
        v2u* o8 = (v2u*)(F.XB() + (size_t)m * DM) + lane;
#pragma unroll
        for (int j = 0; j < 4; ++j) o8[64 * j] = (v2u){pkbf(v[j][0] * rr, v[j][1] * rr), pkbf(v[j][2] * rr, v[j][3] * rr)};
        if (lane == 0) F.RMS()[m] = sqrtf(ms);
        if ((kk & 7) == 3 && it < NITEMS) { do_item(it); it += NGW; }
    }
    for (; it < NITEMS; it += NGW) do_item(it);
    const int gt = F.vcu * NTHR + F.tid, NGT = F.G * NTHR;
    for (int i = gt; i < 8 * 256; i += NGT) { const int h = i >> 8, rel = (i & 255) - 191;
        F.BT()[i] = (F.rel_bias()[t5_bucket(rel) * 8 + h] - F.rel_bias()[15 * 8 + h]) * 1.4426950408889634f; }
}

#ifndef PLANES
#define PLANES 1
#endif
#ifndef MIXREP
#define MIXREP 0
#endif
typedef float f32x4_t __attribute__((ext_vector_type(4)));
typedef float f32x2v __attribute__((ext_vector_type(2)));
struct IdxOps { bf16x8 bq[4]; f32x4 wv; bf16x8 a0; };
__device__ __forceinline__ void idx_fetch(IdxOps& o, const Frame& F, int b, int c, int rq) {
    const int w = F.wave, lane = F.lane, q = lane & 15, g = lane >> 4;
    const size_t rowq = (size_t)b * SEQ + 64 * c + 16 * rq + q;
#pragma unroll
    for (int h = 0; h < 4; ++h) o.bq[h] = *(const bf16x8*)(F.IQ() + rowq * 128 + 32 * h + 8 * g);
    o.wv = *(const f32x4*)(F.IW() + rowq * 4) * (0.5f * 0.17677669529663687f);
    o.a0 = *(const bf16x8*)(F.IK() + ((size_t)b * SEQ + q) * 32 + 8 * g + (size_t)w * 512);
}
__device__ __forceinline__ void idx_round(const IdxOps& o, const Frame& F, int b, int c, LAS unsigned char* lds) {
    const int w = F.wave, lane = F.lane, q = lane & 15, g = lane >> 4;
    const int nkb = 4 * (c + 1);
    const bf16* kp = F.IK() + ((size_t)b * SEQ + q) * 32 + 8 * g;
    LAS float* dst = (LAS float*)(lds + P2_SC) + q * SCW + 4 * g;
    int kb = w; bf16x8 a = o.a0;
    for (; kb < nkb; kb += 8) {
        bf16x8 an = a; if (kb + 8 < nkb) an = *(const bf16x8*)(kp + (size_t)(kb + 8) * 512);
        f32x4 sc = {0.f, 0.f, 0.f, 0.f};
#pragma unroll
        for (int h = 0; h < 4; ++h) {
            const f32x4 d = __builtin_amdgcn_mfma_f32_16x16x32_bf16(a, o.bq[h], (f32x4){0.f, 0.f, 0.f, 0.f}, 0, 0, 0);
#pragma unroll
            for (int i = 0; i < 4; ++i) sc[i] += o.wv[h] * fmaxf(d[i], 0.f);
        }
        *(LAS f32x4*)(dst + 16 * kb) = (f32x4){sc[0] + 0.f, sc[1] + 0.f, sc[2] + 0.f, sc[3] + 0.f};
        a = an;
    }
}
__device__ __forceinline__ int wave_sum_i(int v) {
    v += __builtin_amdgcn_update_dpp(0, v, 0xB1, 0xF, 0xF, false);
    v += __builtin_amdgcn_update_dpp(0, v, 0x4E, 0xF, 0xF, false);
    v += __builtin_amdgcn_update_dpp(0, v, 0x141, 0xF, 0xF, false);
    v += __builtin_amdgcn_update_dpp(0, v, 0x140, 0xF, 0xF, false);
    return (__builtin_amdgcn_readlane(v, 0) + __builtin_amdgcn_readlane(v, 16)) + (__builtin_amdgcn_readlane(v, 32) + __builtin_amdgcn_readlane(v, 48));
}
__device__ __forceinline__ unsigned sortable(float f) { const unsigned bits = __float_as_uint(f); return bits ^ ((unsigned)((int)bits >> 31) | 0x80000000u); }
template <int NJ>
__device__ __forceinline__ void mask_words(const unsigned (&u)[NJ], unsigned prefix, bool exact, LAS unsigned long long* mrow, int nj, int lane) {
    unsigned long long mv = 0ull;
    if (exact) {
#pragma unroll
        for (int j = 0; j < NJ; ++j) { const unsigned long long sel = __ballot(u[j] >= prefix); if (lane == j) mv = sel; }
    } else {
        int ngt = 0;
#pragma unroll
        for (int j = 0; j < NJ; ++j) ngt += __popcll(__ballot(u[j] > prefix));
        int need = 256 - ngt;
#pragma unroll
        for (int j = 0; j < NJ; ++j) {
            const unsigned long long eq = __ballot(u[j] == prefix);
            const int rank = (int)__builtin_amdgcn_mbcnt_hi((unsigned)(eq >> 32), __builtin_amdgcn_mbcnt_lo((unsigned)eq, 0u));
            const unsigned long long sel = __ballot(u[j] > prefix || (u[j] == prefix && rank < need));
            need -= __popcll(eq);
            if (lane == j) mv = sel;
        }
    }
    if (lane < nj) mrow[lane] = mv;
}
template <int NJ>
__device__ __forceinline__ void select_row(const LAS float* row, LAS unsigned long long* mrow, int nj, int lane) {
    static_assert(NJ % 4 == 0, "groups of four");
    unsigned u[NJ];
#pragma unroll
    for (int j = 0; j < NJ; ++j) { float v = row[64 * j + lane]; asm volatile("" : "+v"(v)); u[j] = (j < nj) ? sortable(v) : 0u; }
    unsigned prefix = 0u; bool exact = false;
#pragma unroll 1
    for (int bit = 31; bit >= 0; --bit) {
        const unsigned trial = prefix | (1u << bit); int c0 = 0, c1 = 0, c2 = 0, c3 = 0;
#pragma unroll
        for (int j = 0; j < NJ; j += 4) {
            unsigned long long m0, m1, m2, m3;
            asm volatile("v_cmp_le_u32_e64 %4, %12, %8\n\tv_cmp_le_u32_e64 %5, %12, %9\n\tv_cmp_le_u32_e64 %6, %12, %10\n\tv_cmp_le_u32_e64 %7, %12, %11\n\t"
                         "v_addc_co_u32_e64 %0, %4, 0, %0, %4\n\tv_addc_co_u32_e64 %1, %5, 0, %1, %5\n\tv_addc_co_u32_e64 %2, %6, 0, %2, %6\n\tv_addc_co_u32_e64 %3, %7, 0, %3, %7"
                         : "+v"(c0), "+v"(c1), "+v"(c2), "+v"(c3), "=&s"(m0), "=&s"(m1), "=&s"(m2), "=&s"(m3) : "v"(u[j]), "v"(u[j + 1]), "v"(u[j + 2]), "v"(u[j + 3]), "s"(trial));
        }
        const int cnt = wave_sum_i((c0 + c1) + (c2 + c3));
        if (cnt >= 256) prefix = trial;
        if (cnt == 256) { exact = true; break; }
    }
    mask_words<NJ>(u, prefix, exact, mrow, nj, lane);
}
template <int S, unsigned M>
__device__ __forceinline__ void tr_stage(unsigned (&A)[32]) {
#pragma unroll
    for (int k = 0; k < 32; ++k) if (!(k & S)) { const unsigned a = A[k], b = A[k + S]; A[k] = (a & M) | ((b & M) << S); A[k + S] = ((a >> S) & M) | (b & ~M); }
}
__device__ __forceinline__ void tr_bytes(unsigned (&A)[32]) {
#pragma unroll
    for (int k = 0; k < 16; ++k) { const unsigned a = A[k], b = A[k + 16];
        A[k] = __builtin_amdgcn_perm(b, a, 0x05040100u);
        A[k + 16] = __builtin_amdgcn_perm(b, a, 0x07060302u); }
#pragma unroll
    for (int k = 0; k < 32; ++k) if (!(k & 8)) { const unsigned a = A[k], b = A[k + 8];
        A[k] = __builtin_amdgcn_perm(b, a, 0x06020400u);
        A[k + 8] = __builtin_amdgcn_perm(b, a, 0x07030501u); }
}
__device__ __forceinline__ void planes_finish(unsigned gt, unsigned alive, int G, bool done, LAS unsigned long long* mrow, int nj, int lane) {
    unsigned sel = gt | alive;
    if (!done) {
        int need = 256 - G; unsigned ts = 0u;
#pragma unroll
        for (int j = 0; j < 32; ++j) {
            const bool mine = (alive >> j) & 1u; const unsigned long long eq = __ballot(mine);
            const int rank = (int)__builtin_amdgcn_mbcnt_hi((unsigned)(eq >> 32), __builtin_amdgcn_mbcnt_lo((unsigned)eq, 0u));
            ts |= (mine && rank < need) ? (1u << j) : 0u; need -= __popcll(eq);
        }
        sel = gt | ts;
    }
    unsigned long long mv = 0ull;
#pragma unroll
    for (int j = 0; j < 32; ++j) { const unsigned long long w = __ballot((sel >> j) & 1u); if (lane == j) mv = w; }
    if (lane < nj) mrow[lane] = mv;
}
__device__ __forceinline__ void select_rows_planes2(const LAS float* rowa, const LAS float* rowb, LAS unsigned long long* mrowa, LAS unsigned long long* mrowb, int nj, int lane) {
    unsigned A[32], B[32];
#pragma unroll
    for (int j = 0; j < 32; ++j) { float va = rowa[64 * j + lane], vb = rowb[64 * j + lane]; asm volatile("" : "+v"(va), "+v"(vb)); A[j] = (j < nj) ? sortable(va) : 0u; B[j] = (j < nj) ? sortable(vb) : 0u; }
    tr_bytes(A); tr_stage<4, 0x0F0F0F0Fu>(A); tr_stage<2, 0x33333333u>(A); tr_stage<1, 0x55555555u>(A);
    tr_bytes(B); tr_stage<4, 0x0F0F0F0Fu>(B); tr_stage<2, 0x33333333u>(B); tr_stage<1, 0x55555555u>(B);
#pragma unroll
    for (int j = 0; j < 32; ++j) asm volatile("" : "+v"(A[j]), "+v"(B[j]));
    unsigned alivea = 0xFFFFFFFFu, gta = 0u, aliveb = 0xFFFFFFFFu, gtb = 0u; int Ga = 0, Aa = 2048, Gb = 0, Ab = 2048; bool donea = false, doneb = false;
#pragma unroll
    for (int b = 31; b >= 0; --b) {
        if (!(donea && doneb)) {
            const unsigned onesa = alivea & A[b], onesb = aliveb & B[b];
            const int both = wave_sum_i(__builtin_popcount(onesa) | (__builtin_popcount(onesb) << 16)), C1a = both & 0xffff, C1b = both >> 16;
            if (!donea) {
                if (Ga + C1a >= 256) { alivea = onesa; Aa = C1a; } else { Ga += C1a; gta |= onesa; alivea &= ~A[b]; Aa -= C1a; }
                donea = (Ga + Aa == 256);
            }
            if (!doneb) {
                if (Gb + C1b >= 256) { aliveb = onesb; Ab = C1b; } else { Gb += C1b; gtb |= onesb; aliveb &= ~B[b]; Ab -= C1b; }
                doneb = (Gb + Ab == 256);
            }
        }
    }
    planes_finish(gta, alivea, Ga, donea, mrowa, nj, lane);
    planes_finish(gtb, aliveb, Gb, doneb, mrowb, nj, lane);
}
constexpr int AT_K = 0, AT_V = 32768, AT_BT = 65536, AT_WS = 73728, AT_OST = 0, AT_Q = 75776;
static_assert(AT_Q + 65536 <= P2_MASK && AT_OST + 8 * 4608 <= AT_BT, "attention LDS map");
__device__ __forceinline__ bf16x8 pk16(const f32x16& v, int o) { return __builtin_bit_cast(bf16x8, (v4u){pkbf(v[o], v[o + 1]), pkbf(v[o + 2], v[o + 3]), pkbf(v[o + 4], v[o + 5]), pkbf(v[o + 6], v[o + 7])}); }
__device__ __forceinline__ void glds16(const void* gsrc, unsigned lds_dst) {
    unsigned keep;
    asm volatile("s_mov_b32 %0, m0\n\ts_mov_b32 m0, %2\n\ts_nop 0\n\tglobal_load_lds_dwordx4 %1, off\n\ts_mov_b32 m0, %0" : "=&s"(keep) : "v"(gsrc), "s"(lds_dst) : "memory");
}
__device__ __forceinline__ unsigned lds_addr(const LAS unsigned char* p) { return (unsigned)(uintptr_t)p; }
template <bool MASK, bool NEAR>
__device__ __forceinline__ void attn_soft(f32x16& p0, f32x16& p1, f32x2v& lacc, bf16x8 (&pa)[4], const LAS float* bt, unsigned long long mw, int hi) {
#pragma unroll
    for (int i = 0; i < 16; ++i) { p0[i] = __builtin_amdgcn_exp2f(p0[i]); p1[i] = __builtin_amdgcn_exp2f(p1[i]); }
    if (MASK) {
        const unsigned long long ws_ = mw >> (4 * hi); const int lo = (int)(unsigned)ws_, hh = (int)(unsigned)(ws_ >> 32);
#define MSK_(i) { int m0_, m1_; asm("v_bfe_i32 %0, %1, %2, 1" : "=v"(m0_) : "v"(lo), "n"(((i) & 3) + 8 * ((i) >> 2))); asm("v_bfe_i32 %0, %1, %2, 1" : "=v"(m1_) : "v"(hh), "n"(((i) & 3) + 8 * ((i) >> 2))); \
            p0[i] = __uint_as_float(__float_as_uint(p0[i]) & (unsigned)m0_); p1[i] = __uint_as_float(__float_as_uint(p1[i]) & (unsigned)m1_); }
        MSK_(0) MSK_(1) MSK_(2) MSK_(3) MSK_(4) MSK_(5) MSK_(6) MSK_(7) MSK_(8) MSK_(9) MSK_(10) MSK_(11) MSK_(12) MSK_(13) MSK_(14) MSK_(15)
#undef MSK_
    }
#pragma unroll
    for (int i = 0; i < 16; i += 2) { lacc += (f32x2v){p0[i], p0[i + 1]}; lacc += (f32x2v){p1[i], p1[i + 1]}; }
    pa[0] = pk16(p0, 0); pa[1] = pk16(p0, 8); pa[2] = pk16(p1, 0); pa[3] = pk16(p1, 8);
}
__device__ __forceinline__ void attn_pv(f32x16& o0, f32x16& o1, const bf16x8 (&pa)[4], const LAS unsigned char* Vb) {
#pragma unroll
    for (int ks = 0; ks < 4; ++ks) {
        o0 = __builtin_amdgcn_mfma_f32_32x32x16_bf16(pa[ks], cat8(vtr(Vb + ks * 1024), vtr(Vb + ks * 1024 + 512)), o0, 0, 0, 0);
        o1 = __builtin_amdgcn_mfma_f32_32x32x16_bf16(pa[ks], cat8(vtr(Vb + 4096 + ks * 1024), vtr(Vb + 4096 + ks * 1024 + 512)), o1, 0, 0, 0);
    }
}
template <bool NEAR>
__device__ __forceinline__ void attn_qk(f32x16& a0, f32x16& a1, f32x16& b0, f32x16& b1, const LAS unsigned char* Qb, const LAS unsigned char* Kb, const LAS float* bt) {
#pragma unroll
    for (int i = 0; i < 16; ++i) {
        if (NEAR) { a0[i] = bt[(i & 3) + 8 * (i >> 2)]; a1[i] = bt[32 + (i & 3) + 8 * (i >> 2)]; b0[i] = bt[(i & 3) + 8 * (i >> 2) - 32]; b1[i] = bt[(i & 3) + 8 * (i >> 2)]; }
        else { a0[i] = 0.f; a1[i] = 0.f; b0[i] = 0.f; b1[i] = 0.f; }
    }
#pragma unroll
    for (int d0 = 0; d0 < 4; ++d0) {
        const bf16x8 k0 = *(const LAS bf16x8*)(Kb + d0 * 2048), k1 = *(const LAS bf16x8*)(Kb + d0 * 2048 + 512);
        const bf16x8 qfa = *(const LAS bf16x8*)(Qb + d0 * 1024), qfb = *(const LAS bf16x8*)(Qb + 4096 + d0 * 1024);
        a0 = __builtin_amdgcn_mfma_f32_32x32x16_bf16(k0, qfa, a0, 0, 0, 0); a1 = __builtin_amdgcn_mfma_f32_32x32x16_bf16(k1, qfa, a1, 0, 0, 0);
        b0 = __builtin_amdgcn_mfma_f32_32x32x16_bf16(k0, qfb, b0, 0, 0, 0); b1 = __builtin_amdgcn_mfma_f32_32x32x16_bf16(k1, qfb, b1, 0, 0, 0);
    }
}
template <bool MASK>
__device__ __forceinline__ void attn_sp(f32x16& a0, f32x16& a1, f32x16& b0, f32x16& b1, f32x16& oa0, f32x16& oa1, f32x16& ob0, f32x16& ob1, f32x2v& la, f32x2v& lb,
                                        const LAS unsigned char* Vb, unsigned long long mwa, unsigned long long mwb, int hi) {
    bf16x8 pa[4], pb[4];
    attn_soft<MASK, false>(a0, a1, la, pa, nullptr, mwa, hi);
    attn_pv(oa0, oa1, pa, Vb);
    attn_soft<MASK, false>(b0, b1, lb, pb, nullptr, mwb, hi);
    attn_pv(ob0, ob1, pb, Vb);
}
__device__ __forceinline__ void attn_store(const f32x16& o0, const f32x16& o1, f32x2v lacc, bf16* obase, LAS unsigned char* stg, LAS float* wsf, int lane) {
    const int r = lane & 31, hi = lane >> 5;
    float lsum = lacc[0] + lacc[1];
    lsum += __shfl_xor(lsum, 32);
    if (hi == 0) wsf[r] = lsum;
    LDS_WAIT(); asm volatile("" ::: "memory");
    LAS unsigned short* st = (LAS unsigned short*)stg;
#pragma unroll
    for (int i = 0; i < 16; ++i) {
        const int q = crow(i, hi); const float rl = 1.0f / wsf[q];
        st[q * 72 + r] = (unsigned short)(pkbf(o0[i] * rl, 0.f) & 0xffffu); st[q * 72 + 32 + r] = (unsigned short)(pkbf(o1[i] * rl, 0.f) & 0xffffu);
    }
    LDS_WAIT(); asm volatile("" ::: "memory");
#pragma unroll
    for (int k = 0; k < 4; ++k) { const int row = 8 * k + (lane >> 3), ch = lane & 7;
        const v4u v = *(const LAS v4u*)(stg + row * 144 + ch * 16); *(v4u*)(obase + (size_t)row * DM + ch * 8) = v; }
    LDS_WAIT(); asm volatile("" ::: "memory");
}
template <bool MASK>
__device__ __forceinline__ void attn_chunk(const Frame& F, int b, int c, LAS unsigned char* lds) {
    const int wid = F.wave, lane = F.lane, r = lane & 31, hi = lane >> 5;
    const size_t rowbase = (size_t)b * SEQ; const int q0 = 64 * c, nt = c + 1;
    const LAS unsigned char* Qb = lds + AT_Q + wid * 8192 + lane * 16;
#pragma unroll
    for (int d0 = 0; d0 < 4; ++d0) {
        *(LAS bf16x8*)(lds + AT_Q + wid * 8192 + d0 * 1024 + lane * 16) = *(const bf16x8*)(F.QA() + (rowbase + q0 + r) * 512 + wid * 64 + 16 * d0 + 8 * hi);
        *(LAS bf16x8*)(lds + AT_Q + wid * 8192 + 4096 + d0 * 1024 + lane * 16) = *(const bf16x8*)(F.QA() + (rowbase + q0 + 32 + r) * 512 + wid * 64 + 16 * d0 + 8 * hi); }
    const LAS float* BT = (const LAS float*)(lds + AT_BT) + wid * 256;
    const bf16* ksrc = F.KA() + (rowbase + lane) * 64 + 8 * wid;
    const bf16* vsrc = F.VA() + (rowbase + 16 * (wid & 3) + (lane >> 2)) * 64 + (wid >> 2) * 32 + (lane & 3) * 8;
    const LAS unsigned long long* mrow = (const LAS unsigned long long*)(lds + P2_MASK) + r * 32;
    const int voff = ((lane >> 4) & 1) * 32 + (lane & 3) * 8 + (4 * hi + ((lane & 15) >> 2)) * 64;
    f32x16 oa0, oa1, ob0, ob1; f32x2v la = {0.f, 0.f}, lb = {0.f, 0.f};
#pragma unroll
    for (int i = 0; i < 16; ++i) { oa0[i] = 0.f; oa1[i] = 0.f; ob0[i] = 0.f; ob1[i] = 0.f; }
#define AT_BAR() do { __builtin_amdgcn_sched_barrier(0); asm volatile("s_waitcnt lgkmcnt(0)" ::: "memory"); __builtin_amdgcn_s_barrier(); asm volatile("" ::: "memory"); __builtin_amdgcn_sched_barrier(0); } while (0)
#define AT_DMA(t_, slot_) do { const int tn_ = (t_) < nt ? (t_) : nt - 1;     \
        glds16(ksrc + (size_t)tn_ * 64 * 64, (unsigned)__builtin_amdgcn_readfirstlane((int)lds_addr(lds + AT_K + (slot_) * 8192 + wid * 1024))); \
        glds16(vsrc + (size_t)tn_ * 64 * 64, (unsigned)__builtin_amdgcn_readfirstlane((int)lds_addr(lds + AT_V + (slot_) * 8192 + wid * 1024))); } while (0)
    AT_DMA(0, 0); AT_DMA(1, 1); AT_DMA(2, 2);
    asm volatile("s_waitcnt vmcnt(0)" ::: "memory");
    AT_BAR();
    if (wid >= 4) AT_BAR();
    const int nfar = c >= 2 ? c - 2 : 0;
#if defined(PROBE_TIMER) && PROBE_TIMER == 3
    const unsigned long long pa0_ = __builtin_amdgcn_s_memtime();
#endif
    f32x16 a0, a1, b0, b1; bf16x8 pa[4], pb[4];
    {
        const LAS unsigned char* Kb = lds + AT_K + hi * 1024 + r * 16; const LAS float* bt = BT + (64 * (0 - c) + 191 - r + 4 * hi);
        if (0 < nfar) attn_qk<false>(a0, a1, b0, b1, Qb, Kb, bt); else attn_qk<true>(a0, a1, b0, b1, Qb, Kb, bt);
        AT_BAR();
    }
#pragma unroll 1
    for (int t = 0; t < nt; ++t) {
        unsigned long long mwa = 0ull, mwb = 0ull;
        if (MASK) { mwa = mrow[t]; mwb = mrow[32 * 32 + t]; }
        attn_soft<MASK, false>(a0, a1, la, pa, nullptr, mwa, hi);
        attn_soft<MASK, false>(b0, b1, lb, pb, nullptr, mwb, hi);
        AT_BAR();
        AT_DMA(t + 3, (t + 3) & 3);
        const LAS unsigned char* Vb = lds + AT_V + (t & 3) * 8192 + voff;
#pragma unroll
        for (int ks = 0; ks < 4; ++ks) {
            const bf16x8 v0 = cat8(vtr(Vb + ks * 1024), vtr(Vb + ks * 1024 + 512)), v1 = cat8(vtr(Vb + 4096 + ks * 1024), vtr(Vb + 4096 + ks * 1024 + 512));
            oa0 = __builtin_amdgcn_mfma_f32_32x32x16_bf16(pa[ks], v0, oa0, 0, 0, 0); ob0 = __builtin_amdgcn_mfma_f32_32x32x16_bf16(pb[ks], v0, ob0, 0, 0, 0);
            oa1 = __builtin_amdgcn_mfma_f32_32x32x16_bf16(pa[ks], v1, oa1, 0, 0, 0); ob1 = __builtin_amdgcn_mfma_f32_32x32x16_bf16(pb[ks], v1, ob1, 0, 0, 0);
        }
        if (t + 1 < nt) {
            const LAS unsigned char* Kb = lds + AT_K + ((t + 1) & 3) * 8192 + hi * 1024 + r * 16; const LAS float* bt = BT + (64 * (t + 1 - c) + 191 - r + 4 * hi);
            if (t + 1 < nfar) attn_qk<false>(a0, a1, b0, b1, Qb, Kb, bt); else attn_qk<true>(a0, a1, b0, b1, Qb, Kb, bt);
        }
        asm volatile("s_waitcnt vmcnt(2)" ::: "memory");
        AT_BAR();
    }
#if defined(PROBE_TIMER) && PROBE_TIMER == 3
    if (F.tid == 0 && nt >= 16) { volatile LAS unsigned* pm_ = (volatile LAS unsigned*)(lds + MISC_OFF); pm_[16] += (unsigned)(__builtin_amdgcn_s_memtime() - pa0_); pm_[17] += (unsigned)nt; }
#endif
    asm volatile("s_waitcnt vmcnt(0)" ::: "memory");
    if (wid < 4) AT_BAR();
    AT_BAR();
#undef AT_BAR
#undef AT_DMA
    LAS float* wsf = (LAS float*)(lds + AT_WS) + wid * 64; LAS unsigned char* stg = lds + AT_OST + wid * 4608;
    attn_store(oa0, oa1, la, F.MIX() + (rowbase + q0) * DM + wid * 64, stg, wsf, lane);
    attn_store(ob0, ob1, lb, F.MIX() + (rowbase + q0 + 32) * DM + wid * 64, stg, wsf, lane);
}
__device__ __forceinline__ void attn_unit(const Frame& F, int b, int c, LAS unsigned char* lds) {
    if (c >= 4) {
        const int nj = c + 1;
        IdxOps ops; idx_fetch(ops, F, b, c, 0);
        for (int rq = 0; rq < ((MIXREP & 2) ? 8 : 4); ++rq) {
            idx_round(ops, F, b, c, lds);
            idx_fetch(ops, F, b, c, (rq + 1) & 3);
            __syncthreads();
            {
                const int ql = 2 * F.wave;
                const LAS float* row = (const LAS float*)(lds + P2_SC) + ql * SCW; LAS unsigned long long* mrow = (LAS unsigned long long*)(lds + P2_MASK) + (16 * (rq & 3) + ql) * 32;
                if (nj <= 8) { select_row<8>(row, mrow, nj, F.lane); select_row<8>(row + SCW, mrow + 32, nj, F.lane); }
                else { if (PLANES) select_rows_planes2(row, row + SCW, mrow, mrow + 32, nj, F.lane); else { select_row<32>(row, mrow, nj, F.lane); select_row<32>(row + SCW, mrow + 32, nj, F.lane); } }
            }
            __syncthreads();
        }
    }
    { const f32x4 v = *(const f32x4*)(F.BT() + F.tid * 4); *(LAS f32x4*)(lds + AT_BT + F.tid * 16) = v; }
    __syncthreads();
    if (c >= 4) attn_chunk<true>(F, b, c, lds); else attn_chunk<false>(F, b, c, lds);
}

constexpr int RT_TAB = 131072;
__device__ __forceinline__ void ret_stage(const bf16* vsrc, const bf16* ksrc, LAS unsigned char* region) {
#pragma unroll
    for (int k = 0; k < 8; ++k) {
        const size_t o = (size_t)(16 * (k & 3)) * 512 + 32 * (k >> 2);
        __builtin_amdgcn_global_load_lds((const unsigned*)(vsrc + o), (LAS unsigned*)(region + k * 1024), 16, 0, 0);
        __builtin_amdgcn_global_load_lds((const unsigned*)(ksrc + o), (LAS unsigned*)(region + 8192 + k * 1024), 16, 0, 0);
    }
}
__device__ __forceinline__ void ret_kv(f32x16 (&T)[2][2], const LAS unsigned char* img) {
#pragma unroll
    for (int ks = 0; ks < 4; ++ks) {
        const bf16x8 k0 = cat8(vtr(img + 8192 + ks * 1024), vtr(img + 8192 + ks * 1024 + 512)), k1 = cat8(vtr(img + 8192 + 4096 + ks * 1024), vtr(img + 8192 + 4096 + ks * 1024 + 512));
        const bf16x8 v0 = cat8(vtr(img + ks * 1024), vtr(img + ks * 1024 + 512)), v1 = cat8(vtr(img + 4096 + ks * 1024), vtr(img + 4096 + ks * 1024 + 512));
        T[0][0] = __builtin_amdgcn_mfma_f32_32x32x16_bf16(k0, v0, T[0][0], 0, 0, 0); T[0][1] = __builtin_amdgcn_mfma_f32_32x32x16_bf16(k0, v1, T[0][1], 0, 0, 0);
        T[1][0] = __builtin_amdgcn_mfma_f32_32x32x16_bf16(k1, v0, T[1][0], 0, 0, 0); T[1][1] = __builtin_amdgcn_mfma_f32_32x32x16_bf16(k1, v1, T[1][1], 0, 0, 0);
    }
}
__device__ __forceinline__ void ret_unit(const Frame& F, int b, int h, LAS unsigned char* lds) {
    const int lane = F.lane, w = F.wave, r = lane & 31, hi = lane >> 5;
    const float gam = 1.0f - exp2f(-5.0f - (float)h), lg2 = log2f(gam), cd = exp2f(64.0f * lg2), cd4 = exp2f(256.0f * lg2);
    LAS unsigned char* region = lds + w * 16384;
    const LAS unsigned char* img = region + ((lane >> 4) & 1) * 32 + (lane & 3) * 8 + (4 * hi + ((lane & 15) >> 2)) * 64;
    LAS float* tab = (LAS float*)(lds + RT_TAB);
    __syncthreads();
    if (F.tid < 128) tab[F.tid] = F.tid < 64 ? F.ret_gn_w()[h * 64 + F.tid] : F.ret_gn_b()[h * 64 + F.tid - 64];
    const size_t hbase = (size_t)b * SEQ * 512 + h * 64;
    const size_t stg = hbase + (size_t)(lane >> 2) * 512 + (lane & 3) * 8;
    f32x16 T[2][2];
#pragma unroll
    for (int i = 0; i < 16; ++i) { T[0][0][i] = 0.f; T[0][1][i] = 0.f; T[1][0][i] = 0.f; T[1][1][i] = 0.f; }
#pragma unroll 1
    for (int i = 0; i < 4; ++i) {
        const size_t co = (size_t)(4 * w + i) * 64 * 512;
        ret_stage(F.VB() + stg + co, F.KB() + stg + co, region);
        if (i) {
#pragma unroll
            for (int k = 0; k < 16; ++k) { T[0][0][k] *= cd; T[0][1][k] *= cd; T[1][0][k] *= cd; T[1][1][k] *= cd; }
        }
        asm volatile("s_waitcnt vmcnt(0)" ::: "memory");
        ret_kv(T, img);
        LDS_WAIT();
    }
#pragma unroll
    for (int eb = 0; eb < 2; ++eb)
#pragma unroll
        for (int db = 0; db < 2; ++db)
#pragma unroll
            for (int g = 0; g < 4; ++g) *(LAS f32x4*)(region + ((eb * 2 + db) * 4 + g) * 1024 + lane * 16) = (f32x4){T[eb][db][4 * g], T[eb][db][4 * g + 1], T[eb][db][4 * g + 2], T[eb][db][4 * g + 3]};
    __syncthreads();
#pragma unroll
    for (int i = 0; i < 16; ++i) { T[0][0][i] = 0.f; T[0][1][i] = 0.f; T[1][0][i] = 0.f; T[1][1][i] = 0.f; }
#pragma unroll 1
    for (int wp = 0; wp < w; ++wp) {
        const LAS unsigned char* src = lds + wp * 16384 + lane * 16;
#pragma unroll
        for (int eb = 0; eb < 2; ++eb)
#pragma unroll
            for (int db = 0; db < 2; ++db)
#pragma unroll
                for (int g = 0; g < 4; ++g) { const f32x4 v = *(const LAS f32x4*)(src + ((eb * 2 + db) * 4 + g) * 1024);
                    T[eb][db][4 * g] = T[eb][db][4 * g] * cd4 + v[0]; T[eb][db][4 * g + 1] = T[eb][db][4 * g + 1] * cd4 + v[1]; T[eb][db][4 * g + 2] = T[eb][db][4 * g + 2] * cd4 + v[2]; T[eb][db][4 * g + 3] = T[eb][db][4 * g + 3] * cd4 + v[3]; }
    }
    __syncthreads();
#pragma unroll 1
    for (int i = 0; i < 4; ++i) {
        const int n = 4 * w + i; const size_t co = (size_t)n * 64 * 512;
        ret_stage(F.VB() + stg + co, F.KB() + stg + co, region);
#pragma unroll
        for (int k = 0; k < 16; ++k) { T[0][0][k] *= cd; T[0][1][k] *= cd; T[1][0][k] *= cd; T[1][1][k] *= cd; }
        const bf16* qrow = F.QB() + hbase + co + (size_t)r * 512 + 8 * hi;
        const bf16* krow = F.KB() + hbase + co + (size_t)r * 512 + 8 * hi;
#pragma unroll 1
        for (int ib = 0; ib < 2; ++ib) {
            bf16x8 qf[4], kf[4];
#pragma unroll
            for (int s = 0; s < 4; ++s) { qf[s] = *(const bf16x8*)(qrow + (size_t)(32 * ib) * 512 + 16 * s); kf[s] = *(const bf16x8*)(krow + 16 * s); }
            const size_t tok = (size_t)b * SEQ + 64 * n + 32 * ib + r;
            const bf16* grow = F.GB() + tok * 512 + h * 64 + 4 * hi;
            v2u gq[2][4];
#pragma unroll
            for (int db = 0; db < 2; ++db)
#pragma unroll
                for (int g = 0; g < 4; ++g) gq[db][g] = *(const v2u*)(grow + 32 * db + 8 * g);
            f32x16 s0, s1;
#pragma unroll
            for (int k = 0; k < 16; ++k) { s0[k] = 0.f; s1[k] = 0.f; }
#pragma unroll
            for (int s = 0; s < 4; ++s) s0 = __builtin_amdgcn_mfma_f32_32x32x16_bf16(kf[s], qf[s], s0, 0, 0, 0);
            if (ib == 1) {
#pragma unroll
                for (int s = 0; s < 4; ++s) kf[s] = *(const bf16x8*)(krow + (size_t)32 * 512 + 16 * s);
#pragma unroll
                for (int s = 0; s < 4; ++s) s1 = __builtin_amdgcn_mfma_f32_32x32x16_bf16(kf[s], qf[s], s1, 0, 0, 0);
#pragma unroll
                for (int k = 0; k < 16; ++k) s1[k] = (r >= crow(k, hi)) ? s1[k] : 0.f;
            } else {
#pragma unroll
                for (int k = 0; k < 16; ++k) s0[k] = (r >= crow(k, hi)) ? s0[k] : 0.f;
            }
#pragma unroll
            for (int s = 0; s < 4; ++s) {
                v4u q4 = __builtin_bit_cast(v4u, qf[s]);
                auto x0 = __builtin_amdgcn_permlane32_swap(q4[0], q4[2], false, false); auto x1 = __builtin_amdgcn_permlane32_swap(q4[1], q4[3], false, false);
                q4[0] = x0[0]; q4[2] = x0[1]; q4[1] = x1[0]; q4[3] = x1[1];
                qf[s] = __builtin_bit_cast(bf16x8, q4);
            }
            asm volatile("s_waitcnt vmcnt(0)" ::: "memory");
            f32x16 y0, y1;
#pragma unroll
            for (int k = 0; k < 16; ++k) { y0[k] = 0.f; y1[k] = 0.f; }
#pragma unroll
            for (int eb = 0; eb < 2; ++eb)
#pragma unroll
                for (int s2 = 0; s2 < 2; ++s2) {
                    y0 = __builtin_amdgcn_mfma_f32_32x32x16_bf16(pk16(T[eb][0], 8 * s2), qf[2 * eb + s2], y0, 0, 0, 0);
                    y1 = __builtin_amdgcn_mfma_f32_32x32x16_bf16(pk16(T[eb][1], 8 * s2), qf[2 * eb + s2], y1, 0, 0, 0);
                }
#pragma unroll
            for (int ks = 0; ks < 2; ++ks) {
                const bf16x8 pb = pk16(s0, 8 * ks);
                y0 = __builtin_amdgcn_mfma_f32_32x32x16_bf16(cat8(vtr(img + ks * 1024), vtr(img + ks * 1024 + 512)), pb, y0, 0, 0, 0);
                y1 = __builtin_amdgcn_mfma_f32_32x32x16_bf16(cat8(vtr(img + 4096 + ks * 1024), vtr(img + 4096 + ks * 1024 + 512)), pb, y1, 0, 0, 0);
            }
            if (ib == 1) {
#pragma unroll
                for (int ks = 0; ks < 2; ++ks) {
                    const bf16x8 pb = pk16(s1, 8 * ks);
                    y0 = __builtin_amdgcn_mfma_f32_32x32x16_bf16(cat8(vtr(img + (2 + ks) * 1024), vtr(img + (2 + ks) * 1024 + 512)), pb, y0, 0, 0, 0);
                    y1 = __builtin_amdgcn_mfma_f32_32x32x16_bf16(cat8(vtr(img + 4096 + (2 + ks) * 1024), vtr(img + 4096 + (2 + ks) * 1024 + 512)), pb, y1, 0, 0, 0);
                }
            }
            float sm = 0.f;
#pragma unroll
            for (int k = 0; k < 16; ++k) sm += y0[k] + y1[k];
            sm += __shfl_xor(sm, 32);
            const float mean = sm * (1.0f / 64.0f); float vr = 0.f;
#pragma unroll
            for (int k = 0; k < 16; ++k) { y0[k] -= mean; y1[k] -= mean; vr += y0[k] * y0[k] + y1[k] * y1[k]; }
            vr += __shfl_xor(vr, 32);
            const float rstd = 1.0f / sqrtf(vr * (1.0f / 64.0f) + 1e-5f);
            bf16* orow = F.MIX() + tok * DM + 512 + h * 64 + 4 * hi;
#pragma unroll
            for (int g = 0; g < 4; ++g) {
                const f32x4 w0 = *(const LAS f32x4*)(tab + 8 * g + 4 * hi), b0 = *(const LAS f32x4*)(tab + 64 + 8 * g + 4 * hi), w1 = *(const LAS f32x4*)(tab + 32 + 8 * g + 4 * hi), b1 = *(const LAS f32x4*)(tab + 96 + 8 * g + 4 * hi);
                const v2u g0 = gq[0][g], g1 = gq[1][g];
                *(v2u*)(orow + 8 * g) = (v2u){pkbf((y0[4 * g] * rstd * w0[0] + b0[0]) * bflo(g0[0]), (y0[4 * g + 1] * rstd * w0[1] + b0[1]) * bfhi(g0[0])),
                                              pkbf((y0[4 * g + 2] * rstd * w0[2] + b0[2]) * bflo(g0[1]), (y0[4 * g + 3] * rstd * w0[3] + b0[3]) * bfhi(g0[1]))};
                *(v2u*)(orow + 32 + 8 * g) = (v2u){pkbf((y1[4 * g] * rstd * w1[0] + b1[0]) * bflo(g1[0]), (y1[4 * g + 1] * rstd * w1[1] + b1[1]) * bfhi(g1[0])),
                                                   pkbf((y1[4 * g + 2] * rstd * w1[2] + b1[2]) * bflo(g1[1]), (y1[4 * g + 3] * rstd * w1[3] + b1[3]) * bfhi(g1[1]))};
            }
        }
        ret_kv(T, img);
        LDS_WAIT();
    }
}
#ifndef GEMM_ALIGN
#define GEMM_ALIGN true
#endif
#ifndef GEMM_SP2
#define GEMM_SP2 true
#endif
#ifndef RETREP
#define RETREP 1
#endif
#ifndef ATTREP
#define ATTREP 1
#endif
constexpr int N_RET = BATCH * 8 * RETREP, N_ATT = BATCH * 32 * ATTREP, N_MIX = N_RET + N_ATT;
__device__ __forceinline__ void p2_mixers(Frame& F) {
    for (;;) {
        int mo_ = MISC_OFF; asm volatile("" : "+s"(mo_));
        volatile LAS unsigned* misc = (volatile LAS unsigned*)(F.lds + mo_);
        __syncthreads();
        if (F.tid == 0) misc[0] = __hip_atomic_fetch_add(F.ctl, 1u, __ATOMIC_RELAXED, __HIP_MEMORY_SCOPE_AGENT);
        __syncthreads();
        const int u = (int)misc[0];
        if (u >= N_MIX) break;
        { int w_ = F.wave; asm volatile("" : "+s"(w_)); F.wave = w_; int l_ = lane_id(); asm volatile("" : "+v"(l_)); F.lane = l_; F.tid = w_ * 64 + l_; }
        constexpr int N_HEAD = 256 * ATTREP;
        if (u < N_HEAD) { const int a = u / ATTREP; attn_unit(F, a & 31, 31 - (a >> 5), F.lds); }
        else if (u < N_HEAD + N_RET) { const int ru = (u - N_HEAD) / RETREP; ret_unit(F, ru >> 3, ru & 7, F.lds); }
        else { const int a = (u - N_RET) / ATTREP; attn_unit(F, a & 31, 31 - (a >> 5), F.lds); }
    }
#if defined(PROBE_TIMER) && PROBE_TIMER == 3
    if (blockIdx.x == 7 && F.tid == 0) { volatile LAS unsigned* pm_ = (volatile LAS unsigned*)(F.lds + MISC_OFF); const float val = ((float)pm_[16] / (float)(pm_[17] ? pm_[17] : 1u)) / 8000.0f;
        F.ctl[64] = __float_as_uint(0.05f + 0.5f * floorf(fminf(fmaxf(val, 0.f), 1.f) * 8.0f + 0.5f) * 0.125f); }
#endif
}

typedef __attribute__((address_space(1))) unsigned gu32;
#define XB_TMO      128
#define XB_XCNT(j)  (256  + 64 * (j))
#define XB_XSUB(j)  (1280 + 64 * (j))
#define XB_XGEN(j)  (2304 + 64 * (j))
#define XB_TOP      3328
#define XB_TOPGEN   3392
#define XCD_BAR_WORDS 3456
#define XB_SPIN_CAP (1u << 18)

__device__ __forceinline__ unsigned xb_ld(unsigned* p)              { return __hip_atomic_load(p, __ATOMIC_RELAXED, __HIP_MEMORY_SCOPE_AGENT); }
__device__ __forceinline__ unsigned xb_add(unsigned* p, unsigned v) { return __hip_atomic_fetch_add(p, v, __ATOMIC_RELAXED, __HIP_MEMORY_SCOPE_AGENT); }
__device__ __forceinline__ unsigned xb_xcc_id() { return (unsigned)__builtin_amdgcn_s_getreg((3 << 11) | 20) & 0xFu; }
#define XB_SPIN(cond, bar) do { unsigned _sp = 0; while (cond) { __builtin_amdgcn_s_sleep(1); \
    if ((++_sp & 255u) == 0u) { if (xb_ld(&(bar)[XB_TMO])) break; if (_sp > XB_SPIN_CAP) { atomicAdd(&(bar)[XB_TMO], 1u); break; } } } } while (0)

struct XcdBarrier {
    unsigned* bar; unsigned x; int wv;
    volatile LAS unsigned* st;
};

__device__ __forceinline__ XcdBarrier xcd_barrier_post(unsigned* bar, volatile LAS unsigned* st, int wv_) {
    XcdBarrier b; b.bar = bar; b.x = xb_xcc_id(); b.st = st; b.wv = 0;
    if (wv_ == 0 && lane_id() == 0) (void)xb_add(&bar[XB_XCNT(b.x)], 1u);
    return b;
}
__device__ __forceinline__ void xcd_barrier_complete(unsigned* bar, unsigned x, unsigned& nloc, unsigned& nx) {
    const unsigned G = gridDim.x * gridDim.y * gridDim.z;
    unsigned sum, cnt, mine, sp = 0u;
    for (;;) {
        sum = 0u; cnt = 0u; mine = 0u;
#pragma unroll
        for (unsigned j = 0; j < 16; ++j) { const unsigned c = xb_ld(&bar[XB_XCNT(j)]); sum += c; cnt += (c > 0u) ? 1u : 0u; mine = (j == x) ? c : mine; }
        if (sum == G) break;
        __builtin_amdgcn_s_sleep(1);
        if ((++sp & 255u) == 0u) { if (xb_ld(&bar[XB_TMO])) break; if (sp > XB_SPIN_CAP) { atomicAdd(&bar[XB_TMO], 1u); break; } }
    }
    nloc = mine > 0u ? mine : 1u; nx = cnt > 0u ? cnt : 1u;
}

__device__ __forceinline__ void xcd_barrier(const XcdBarrier& b) {
    asm volatile("s_waitcnt vmcnt(0)" ::: "memory");
    __syncthreads();
    if (b.wv == 0 && lane_id() == 0) {
        unsigned* bar = b.bar;
        __builtin_amdgcn_s_waitcnt(0);
        unsigned nloc = b.st[0], nx = b.st[1];
        if (nloc == 0u) { xcd_barrier_complete(bar, b.x, nloc, nx); b.st[0] = nloc; b.st[1] = nx; }
        const unsigned old = xb_add(&bar[XB_XSUB(b.x)], 1u);
        const unsigned gen = old / nloc;
        if (old + 1u == (gen + 1u) * nloc) {
            __builtin_amdgcn_fence(__ATOMIC_RELEASE, "agent");
            asm volatile("s_waitcnt vmcnt(0)" ::: "memory");
            const unsigned og = xb_add(&bar[XB_TOP], 1u);
            const unsigned tg = og / nx;
            if (og + 1u == (tg + 1u) * nx) xb_add(&bar[XB_TOPGEN], 1u);
            else XB_SPIN(xb_ld(&bar[XB_TOPGEN]) == tg, bar);
            __builtin_amdgcn_fence(__ATOMIC_ACQUIRE, "agent");
            xb_add(&bar[XB_XGEN(b.x)], 1u);
            asm volatile("s_waitcnt vmcnt(0)" ::: "memory");
        } else {
            XB_SPIN(xb_ld(&bar[XB_XGEN(b.x)]) == gen, bar);
            __builtin_amdgcn_fence(__ATOMIC_ACQUIRE, "agent");
            asm volatile("s_waitcnt vmcnt(0)" ::: "memory");
        }
    }
    __syncthreads();
}

constexpr int CW_BAR = 4096;
constexpr size_t CTL_ZERO_BYTES = 65536;
typedef KArgs Args;
__global__ void __launch_bounds__(NTHR, 2) fwd_kernel(Args args) {
    extern __shared__ __attribute__((aligned(16))) unsigned char lds[];
    Frame F;
    F.lds = (LAS unsigned char*)lds;
    F.wave = __builtin_amdgcn_readfirstlane((int)threadIdx.x >> 6); F.lane = lane_id(); F.tid = F.wave * 64 + F.lane;
    F.G = gridDim.x; { const int bx = blockIdx.x; F.vcu = (F.G % 8 == 0) ? (bx % 8) * (F.G / 8) + bx / 8 : bx; }
    unsigned char* ws = args.ws;
    F.ctl = (unsigned*)(ws + WS_CTL);
    F.ap = (const __attribute__((address_space(4))) KArgs*)__builtin_amdgcn_kernarg_segment_ptr();
    F.ws = ws;
    const int lo = args.ph_lo, hi = args.ph_hi;
    for (int u_ = F.tid; u_ < 64; u_ += NTHR) ((LAS unsigned*)(F.lds + MISC_OFF))[u_] = 0u;
    __syncthreads();
    XcdBarrier bar; bar.bar = F.ctl + CW_BAR; bar.x = 0; bar.st = nullptr; bar.wv = F.wave;
    if (hi - lo > 1) { bar = xcd_barrier_post(F.ctl + CW_BAR, (volatile LAS unsigned*)(F.lds + MISC_OFF) + 8, F.wave); bar.wv = F.wave; }
#ifndef PHSEL
#define PHSEL 63
#endif
#define IN(k) (((PHSEL >> (k)) & 1) && lo <= (k) && (k) < hi)
#ifndef REPEAT_PHASE
#define REPEAT_PHASE -1
#endif
#define REPS(k) ((REPEAT_PHASE == (k)) ? 2 : 1)
#define SEAM(k) do { if (IN(k) && IN((k) + 1)) { if ((k) == 0 && lo < 0) cg::this_grid().sync(); else xcd_barrier(bar); } } while (0)

    for (int rep_ = 0; rep_ < REPS(0); ++rep_) { if (rep_) cg::this_grid().sync();
    if (IN(0)) { asm volatile("" : "+s"(F.ws), "+s"(F.ap)); F.lane = lane_id(); F.tid = F.wave * 64 + F.lane; p0_prologue(F); }
    }
    SEAM(0);
    for (int rep_ = 0; rep_ < REPS(1); ++rep_) { if (rep_) cg::this_grid().sync();
    if (IN(1)) { asm volatile("" : "+s"(F.ws), "+s"(F.ap)); F.lane = lane_id(); F.tid = F.wave * 64 + F.lane;
        pg8::Gemm g{F.XB(), F.WIN(), MTOK, NIN, DM}; pg8::StaticOrder S; S.init(MTOK, NIN, F.G, (int)blockIdx.x);
        pg8::EpiIn E{F.QA(), F.KA(), F.VA(), F.IQ(), F.IK(), F.QB(), F.KB(), F.VB(), F.GB(), F.IW(), F.q_norm_w(), F.k_norm_w(), (LAS float*)(F.lds + XCH_OFF)};
        pg8::gemm_phase<pg8::EpiIn, pg8::StaticOrder, GEMM_ALIGN, GEMM_SP2>(F.lds, g, S, E, F.wave);
    }
    }
    SEAM(1);
    for (int rep_ = 0; rep_ < REPS(2); ++rep_) { if (rep_) { cg::this_grid().sync(); if (blockIdx.x == 0 && F.tid == 0) F.ctl[0] = 0u; cg::this_grid().sync(); }
    if (IN(2)) { asm volatile("" : "+s"(F.ws), "+s"(F.ap)); F.lane = lane_id(); F.tid = F.wave * 64 + F.lane; p2_mixers(F); }
    }
    SEAM(2);
    for (int rep_ = 0; rep_ < REPS(3); ++rep_) { if (rep_) cg::this_grid().sync();
    if (IN(3)) { asm volatile("" : "+s"(F.ws), "+s"(F.ap)); F.lane = lane_id(); F.tid = F.wave * 64 + F.lane;
        pg8::Gemm g{F.MIX(), F.WOUT(), MTOK, DM, DM}; pg8::PanelOrder S{(int)blockIdx.x, 4};
        pg8::EpiOut E{F.RMS(), F.XB(), {0.f, 0.f, 0.f, 0.f, 0.f, 0.f, 0.f, 0.f}};
        if ((int)blockIdx.x < MTOK / 256) {
            pg8::gemm_phase<pg8::EpiOut, pg8::PanelOrder, true, true>(F.lds, g, S, E, F.wave);
            const int wr = F.wave >> 2, wc = F.wave & 3, fr = F.lane & 15, fq = F.lane >> 4;
            LAS float* P = (LAS float*)(F.lds + XCH_OFF);
#pragma unroll
            for (int k = 0; k < 8; ++k) { float s = E.ss[k]; s += __shfl_xor(s, 16); s += __shfl_xor(s, 32);
                if (fq == 0) P[((k >> 2) * 128 + wr * 64 + (k & 3) * 16 + fr) * 4 + wc] = s; }
            __syncthreads();
            if (F.tid < 256) { const f32x4 p = *(const LAS f32x4*)(P + F.tid * 4);
                F.R2()[(size_t)blockIdx.x * 256 + F.tid] = 1.0f / sqrtf(((p[0] + p[1]) + (p[2] + p[3])) * (1.0f / DM) + 1e-6f); }
        }
    }
    }
    SEAM(3);
    for (int rep_ = 0; rep_ < REPS(4); ++rep_) { if (rep_) cg::this_grid().sync();
    if (IN(4)) { asm volatile("" : "+s"(F.ws), "+s"(F.ap)); F.lane = lane_id(); F.tid = F.wave * 64 + F.lane;
#if defined(PROBE_TIMER) && PROBE_TIMER < 3
        const unsigned long long pt0_ = __builtin_amdgcn_s_memtime(), pr0_ = __builtin_amdgcn_s_memrealtime();
#endif
        pg8::Gemm g{F.XB(), F.WGU(), MTOK, NGU, DM}; pg8::StaticOrder S; S.init(MTOK, NGU, F.G, (int)blockIdx.x);
        pg8::EpiGU E{F.R2(), F.ACT(), {0.f, 0.f, 0.f, 0.f}, {0.f, 0.f, 0.f, 0.f}, {0.f, 0.f, 0.f, 0.f}, {0.f, 0.f, 0.f, 0.f}, 0ull};
        pg8::gemm_phase<pg8::EpiGU, pg8::StaticOrder, GEMM_ALIGN, GEMM_SP2>(F.lds, g, S, E, F.wave);
#if defined(PROBE_TIMER) && PROBE_TIMER < 3
        if (blockIdx.x == 7 && F.tid == 0) { const unsigned long long pt1_ = __builtin_amdgcn_s_memtime(), pr1_ = __builtin_amdgcn_s_memrealtime();
#if PROBE_TIMER == 1
            const float val = ((float)(pt1_ - pt0_) / ((float)(pr1_ - pr0_) * 10.0f) - 1.4f);
#else
            const float val = (float)E.tepi / (float)(pt1_ - pt0_);
#endif
            const float frac = 0.05f + 0.5f * floorf(fminf(fmaxf(val, 0.f), 1.f) * 8.0f + 0.5f) * 0.125f;
            F.ctl[64] = __float_as_uint(frac); }
#endif
    }
    }
    SEAM(4);
    for (int rep_ = 0; rep_ < REPS(5); ++rep_) { if (rep_) cg::this_grid().sync();
    if (IN(5)) { asm volatile("" : "+s"(F.ws), "+s"(F.ap)); F.lane = lane_id(); F.tid = F.wave * 64 + F.lane;
        pg8::Gemm g{F.ACT(), F.WDN(), MTOK, DM, FF}; pg8::StaticOrder S; S.init(MTOK, DM, F.G, (int)blockIdx.x);
        pg8::EpiDown E{F.XB(), F.out()};
        pg8::gemm_phase<pg8::EpiDown, pg8::StaticOrder, GEMM_ALIGN, GEMM_SP2>(F.lds, g, S, E, F.wave);
    }
    }
#ifdef PROBE_TIMER
    xcd_barrier(bar);
    { const float frac = __uint_as_float(__hip_atomic_load(F.ctl + 64, __ATOMIC_RELAXED, __HIP_MEMORY_SCOPE_AGENT)); const int nz = (int)(frac * (float)MTOK);
      for (int m = (int)blockIdx.x * NWAVES + F.wave; m < nz; m += F.G * NWAVES) { f32x4* o = (f32x4*)(F.out() + (size_t)m * DM) + F.lane;
#pragma unroll
          for (int j = 0; j < 4; ++j) o[64 * j] = (f32x4){0.f, 0.f, 0.f, 0.f}; } }
#endif
#undef IN
#undef SEAM
}

extern "C" void kernel_launch(void* const* d_in, const int* in_sizes, int n_in, void* d_out, int out_size, void* d_ws, size_t ws_size, hipStream_t stream) {
    static int grid = 0;
    if (grid == 0) {
        if (n_in != 16 || in_sizes[0] != MTOK * DM || out_size != MTOK * DM || ws_size < WS_END) {
            fprintf(stderr, "kernel_launch: unexpected problem (n_in %d, in0 %d, out %d, ws %zu); nothing launched\n", n_in, n_in > 0 ? in_sizes[0] : -1, out_size, ws_size); grid = -1; return; }
        int dev = 0, cus = 0, per_cu = 0;
        if (hipGetDevice(&dev) != hipSuccess || hipDeviceGetAttribute(&cus, hipDeviceAttributeMultiprocessorCount, dev) != hipSuccess) { grid = -1; return; }
        if (hipFuncSetAttribute((const void*)fwd_kernel, hipFuncAttributeMaxDynamicSharedMemorySize, LDS_BYTES) != hipSuccess) { fprintf(stderr, "kernel_launch: hipFuncSetAttribute failed\n"); grid = -1; return; }
        if (hipOccupancyMaxActiveBlocksPerMultiprocessor(&per_cu, (const void*)fwd_kernel, NTHR, LDS_BYTES) != hipSuccess || per_cu < 1) { fprintf(stderr, "kernel_launch: occupancy query says %d blocks per CU\n", per_cu); (void)hipGetLastError(); grid = -1; return; }
        grid = cus;
        if (grid != 256) fprintf(stderr, "kernel_launch: %d CUs; this kernel is laid out for 256\n", grid);
    }
    if (grid < 0) return;
    if (hipMemsetAsync((char*)d_ws + WS_CTL, 0, CTL_ZERO_BYTES, stream) != hipSuccess) { fprintf(stderr, "kernel_launch: memset failed\n"); return; }
    Args a{};
    for (int i = 0; i < 16; ++i) a.in[i] = (const float*)d_in[i];
    a.out = (float*)d_out; a.ws = (unsigned char*)d_ws;
#if MK_N_LAUNCHES == 1
    a.ph_lo = 0; a.ph_hi = N_PHASES;
    void* kargs[] = {&a};
    hipError_t e = hipLaunchCooperativeKernel((const void*)fwd_kernel, dim3(grid), dim3(NTHR), kargs, LDS_BYTES, stream);
    if (e != hipSuccess) fprintf(stderr, "kernel_launch: cooperative launch failed: %s (grid %d)\n", hipGetErrorString(e), grid);
#else
    for (int p = 0; p < N_PHASES; ++p) { a.ph_lo = p; a.ph_hi = p + 1; hipLaunchKernelGGL(fwd_kernel, dim3(grid), dim3(NTHR), LDS_BYTES, stream, a); }
#endif
}
```

```cpp
#include <hip/hip_runtime.h>
#include <hip/hip_cooperative_groups.h>
#include <cstdio>
#include <cstdint>
namespace cg = cooperative_groups;
namespace pg8 {
#define PG8_LAS __attribute__((address_space(3)))
typedef unsigned short bf16_t;
typedef short bf16x8 __attribute__((ext_vector_type(8)));
typedef float f32x4 __attribute__((ext_vector_type(4)));
typedef unsigned u32x4 __attribute__((ext_vector_type(4)));
constexpr int BM = 256, BK = 64, HALF = 128, HTB = HALF * BK * 2  , STAGE_BYTES = 8 * HTB, NXCD = 8, WGM = 8;

__host__ __device__ __forceinline__ int lds_byte(int r, int c) { const int st = (r >> 4) * 2 + (c >> 5), rr = r & 15, cc = c & 31, ob = rr * 64 + cc * 2; return st * 1024 + (ob ^ (((ob >> 9) & 1) << 5)); }
__host__ __device__ __forceinline__ void stage_rc(int b, int& R, int& C) { const int st = b / 1024, sb = b % 1024, swz = sb ^ (((sb >> 9) & 1) << 5); R = (st >> 1) * 16 + swz / 64; C = (st & 1) * 32 + (swz % 64) / 2; }
__host__ __device__ __forceinline__ int perm32(int rho) { const int n = rho >> 4, i = rho & 15; return 8 * (i >> 2) + 4 * n + (i & 3); }

struct Unit { int pm, pn; };
struct Gemm { const bf16_t* A; const bf16_t* Bt; int M, N, K; };

struct StaticOrder {
    int nM, nN, nwg, G, c;
    __host__ __device__ void init(int M, int N, int G_, int c_) { nM = M / BM; nN = N / BM; nwg = nM * nN; G = G_; c = c_; }
    __host__ __device__ bool next(int i, Unit& u) const {
        const long L = (long)i * G + c; if (L >= nwg) return false;
        int wgid = (int)L; { const int q = nwg / NXCD, r = nwg % NXCD, xcd = wgid % NXCD, off = wgid / NXCD; wgid = (xcd < r ? xcd * (q + 1) : r * (q + 1) + (xcd - r) * q) + off; }
        const int nig = WGM * nN, gid = wgid / nig, fm = gid * WGM, gsz = (nM - fm) < WGM ? (nM - fm) : WGM;
        u.pm = fm + ((wgid % nig) % gsz); u.pn = (wgid % nig) / gsz; return true;
    }
    __device__ __forceinline__ void a_ready(const Unit&) const {}
    __device__ __forceinline__ void done(const Unit&) const {}
};

__device__ __forceinline__ unsigned cvt_pk_bf16(float lo, float hi) { unsigned r; asm volatile("v_cvt_pk_bf16_f32 %0, %1, %2" : "=v"(r) : "v"(lo), "v"(hi)); return r; }
typedef float f32x2 __attribute__((ext_vector_type(2)));
typedef __bf16 bf16x2_t __attribute__((ext_vector_type(2)));
typedef unsigned u32x2 __attribute__((ext_vector_type(2)));
__device__ __forceinline__ unsigned pkbf(float lo, float hi) { f32x2 v = {lo, hi}; bf16x2_t b = __builtin_convertvector(v, bf16x2_t); return __builtin_bit_cast(unsigned, b); }
__device__ __forceinline__ u32x4 pk8(f32x4 a, f32x4 b) { return (u32x4){pkbf(a[0], a[1]), pkbf(a[2], a[3]), pkbf(b[0], b[1]), pkbf(b[2], b[3])}; }
__device__ __forceinline__ float dot4(f32x4 a) { return (a[0] * a[0] + a[1] * a[1]) + (a[2] * a[2] + a[3] * a[3]); }
__device__ __forceinline__ float sum4(f32x4 a) { return (a[0] + a[1]) + (a[2] + a[3]); }
__device__ __forceinline__ float silu1(float v) { return v * __builtin_amdgcn_rcpf(1.0f + __builtin_amdgcn_exp2f(-1.4426950408889634f * v)); }
__device__ __forceinline__ f32x4 silu4(f32x4 v) { return (f32x4){silu1(v[0]), silu1(v[1]), silu1(v[2]), silu1(v[3])}; }
constexpr float RMS_EPS_F = 1e-6f;
constexpr float QSCALE = 0.125f * 1.4426950408889634f;

struct EpiIn {
    static constexpr bool PERM = true, AFTER_DRAIN = false;
    bf16_t *QA, *KA, *VA, *IQ, *IK, *QB, *KB, *VB, *GB; float* IW;
    const float *qnw, *knw;
    PG8_LAS float* xch;
    __device__ __forceinline__ void prefetch(const Unit&, int, int) {}
    __device__ __forceinline__ void advance() {}
    __device__ __forceinline__ void operator()(const f32x4 (&acc)[2][2][4][2], const Unit& u, int wr, int wc, int fr, int fq) {
        asm volatile("" : "+v"(fr), "+v"(fq));
        const int row0 = u.pm * BM + wr * 64 + fr, pn = u.pn;
        if (pn < 2) {
            const int head = 4 * pn + wc;
            const f32x4 w0 = *(const f32x4*)(qnw + 8 * fq), w1 = *(const f32x4*)(qnw + 8 * fq + 4), w2 = *(const f32x4*)(qnw + 32 + 8 * fq), w3 = *(const f32x4*)(qnw + 36 + 8 * fq);
#pragma unroll
            for (int ai = 0; ai < 2; ++ai)
#pragma unroll
                for (int m = 0; m < 4; ++m) {
                    f32x4 a0 = acc[ai][0][m][0], a1 = acc[ai][0][m][1], b0 = acc[ai][1][m][0], b1 = acc[ai][1][m][1];
                    float ss = (dot4(a0) + dot4(a1)) + (dot4(b0) + dot4(b1));
                    ss += __shfl_xor(ss, 16); ss += __shfl_xor(ss, 32);
                    const float rs = QSCALE / sqrtf(ss * (1.0f / 64.0f) + RMS_EPS_F);
                    bf16_t* p = QA + (size_t)(row0 + ai * HALF + m * 16) * 512 + head * 64 + 8 * fq;
                    *(u32x4*)p = pk8(a0 * w0 * rs, a1 * w1 * rs); *(u32x4*)(p + 32) = pk8(b0 * w2 * rs, b1 * w3 * rs);
                }
        } else if (pn == 2) {
            if (wc >= 2) {
#pragma unroll
                for (int ai = 0; ai < 2; ++ai)
#pragma unroll
                    for (int m = 0; m < 4; ++m) {
                        float ss = (dot4(acc[ai][0][m][0]) + dot4(acc[ai][0][m][1])) + (dot4(acc[ai][1][m][0]) + dot4(acc[ai][1][m][1]));
                        ss += __shfl_xor(ss, 16); ss += __shfl_xor(ss, 32);
                        if (fq == 0) xch[(ai * HALF + wr * 64 + m * 16 + fr) * 2 + (wc - 2)] = ss;
                    }
            }
            asm volatile("s_waitcnt lgkmcnt(0)" ::: "memory"); __builtin_amdgcn_s_barrier(); asm volatile("" ::: "memory");
            if (wc < 2) {
                const f32x4 w0 = *(const f32x4*)(knw + 8 * fq), w1 = *(const f32x4*)(knw + 8 * fq + 4), w2 = *(const f32x4*)(knw + 32 + 8 * fq), w3 = *(const f32x4*)(knw + 36 + 8 * fq);
#pragma unroll
                for (int ai = 0; ai < 2; ++ai)
#pragma unroll
                    for (int m = 0; m < 4; ++m) {
                        const int rl = ai * HALF + wr * 64 + m * 16 + fr;
                        const f32x2 pr = *(const PG8_LAS f32x2*)(xch + rl * 2);
                        const float rc = 1.0f / sqrtf((pr[0] + pr[1]) * (1.0f / 128.0f) + RMS_EPS_F);
                        f32x4 a0 = acc[ai][0][m][0] * rc, a1 = acc[ai][0][m][1] * rc, b0 = acc[ai][1][m][0] * rc, b1 = acc[ai][1][m][1] * rc;
                        const size_t row = (size_t)(row0 + ai * HALF + m * 16);
                        if (wc == 0) {
                            float ss = (dot4(a0) + dot4(a1)) + (dot4(b0) + dot4(b1));
                            ss += __shfl_xor(ss, 16); ss += __shfl_xor(ss, 32);
                            const float rs = 1.0f / sqrtf(ss * (1.0f / 64.0f) + RMS_EPS_F);
                            bf16_t* p = KA + row * 64 + 8 * fq;
                            *(u32x4*)p = pk8(a0 * w0 * rs, a1 * w1 * rs); *(u32x4*)(p + 32) = pk8(b0 * w2 * rs, b1 * w3 * rs);
                        } else {
                            bf16_t* p = VA + row * 64 + 8 * fq;
                            *(u32x4*)p = pk8(a0, a1); *(u32x4*)(p + 32) = pk8(b0, b1);
                        }
                    }
            }
        } else if (pn == 3) {
#pragma unroll
            for (int ai = 0; ai < 2; ++ai)
#pragma unroll
                for (int m = 0; m < 4; ++m) {
                    const size_t row = (size_t)(row0 + ai * HALF + m * 16);
                    *(u32x4*)(IQ + row * 128 + 32 * wc + 8 * fq) = pk8(acc[ai][0][m][0], acc[ai][0][m][1]);
                    if (wc == 0) *(u32x4*)(IK + row * 32 + 8 * fq) = pk8(acc[ai][1][m][0], acc[ai][1][m][1]);
                    if (wc == 1 && fq == 0) *(f32x4*)(IW + row * 4) = acc[ai][1][m][0];
                }
        } else if (pn < 8) {
            const int head = 4 * (pn & 1) + wc; bf16_t* dst = pn < 6 ? QB : KB;
            const float lg2 = __log2f(1.0f - __builtin_amdgcn_exp2f(-5.0f - (float)head));
            f32x4 iv0, iv1;
#pragma unroll
            for (int i = 0; i < 4; ++i) { iv0[i] = __builtin_amdgcn_exp2f(-(float)(8 * fq + i) * (13.287712379549449f / 32.0f)) * 0.15915494309189535f; iv1[i] = __builtin_amdgcn_exp2f(-(float)(8 * fq + 4 + i) * (13.287712379549449f / 32.0f)) * 0.15915494309189535f; }
#pragma unroll
            for (int ai = 0; ai < 2; ++ai)
#pragma unroll
                for (int m = 0; m < 4; ++m) {
                    const int row = row0 + ai * HALF + m * 16, pos = row & 2047; const float fp = (float)pos;
                    const float sc = pn < 6 ? __builtin_amdgcn_exp2f((float)(pos & 63) * lg2) : 0.125f * __builtin_amdgcn_exp2f(-(float)(pos & 63) * lg2);
                    f32x4 c0, c1, s0, s1;
#pragma unroll
                    for (int i = 0; i < 4; ++i) {
                        const float r0 = __builtin_amdgcn_fractf(fp * iv0[i]), r1 = __builtin_amdgcn_fractf(fp * iv1[i]);
                        c0[i] = __builtin_amdgcn_cosf(r0) * sc; s0[i] = __builtin_amdgcn_sinf(r0) * sc; c1[i] = __builtin_amdgcn_cosf(r1) * sc; s1[i] = __builtin_amdgcn_sinf(r1) * sc;
                    }
                    const f32x4 a0 = acc[ai][0][m][0], a1 = acc[ai][0][m][1], b0 = acc[ai][1][m][0], b1 = acc[ai][1][m][1];
                    bf16_t* p = dst + (size_t)row * 512 + head * 64 + 8 * fq;
                    *(u32x4*)p = pk8(a0 * c0 - b0 * s0, a1 * c1 - b1 * s1); *(u32x4*)(p + 32) = pk8(a0 * s0 + b0 * c0, a1 * s1 + b1 * c1);
                }
        } else {
            const int head = 4 * (pn & 1) + wc; bf16_t* dst = pn < 10 ? VB : GB; const bool act = pn >= 10;
#pragma unroll
            for (int ai = 0; ai < 2; ++ai)
#pragma unroll
                for (int m = 0; m < 4; ++m) {
                    f32x4 a0 = acc[ai][0][m][0], a1 = acc[ai][0][m][1], b0 = acc[ai][1][m][0], b1 = acc[ai][1][m][1];
                    if (act) { a0 = silu4(a0); a1 = silu4(a1); b0 = silu4(b0); b1 = silu4(b1); }
                    bf16_t* p = dst + (size_t)(row0 + ai * HALF + m * 16) * 512 + head * 64 + 8 * fq;
                    *(u32x4*)p = pk8(a0, a1); *(u32x4*)(p + 32) = pk8(b0, b1);
                }
        }
    }
};

struct EpiOut {
    static constexpr bool PERM = true, AFTER_DRAIN = false;
    const float* rms; bf16_t* x1b; float ss[8];
    __device__ __forceinline__ void prefetch(const Unit&, int, int) {}
    __device__ __forceinline__ void advance() {}
    __device__ __forceinline__ void operator()(const f32x4 (&acc)[2][2][4][2], const Unit& u, int wr, int wc, int fr, int fq) {
        asm volatile("" : "+v"(fr), "+v"(fq));
        const int row0 = u.pm * BM + wr * 64 + fr, col0 = u.pn * BM + wc * 32 + 8 * fq;
#pragma unroll
        for (int ai = 0; ai < 2; ++ai)
#pragma unroll
            for (int m = 0; m < 4; ++m) {
                const int row = row0 + ai * HALF + m * 16; const size_t off = (size_t)row * 1024 + col0; const float rm = rms[row]; float s = 0.f;
#pragma unroll
                for (int bj = 0; bj < 2; ++bj) {
                    const u32x4 xv = *(const u32x4*)(x1b + off + bj * HALF);
                    const f32x4 x0 = {__uint_as_float(xv[0] << 16), __uint_as_float(xv[0] & 0xffff0000u), __uint_as_float(xv[1] << 16), __uint_as_float(xv[1] & 0xffff0000u)};
                    const f32x4 x1 = {__uint_as_float(xv[2] << 16), __uint_as_float(xv[2] & 0xffff0000u), __uint_as_float(xv[3] << 16), __uint_as_float(xv[3] & 0xffff0000u)};
                    const f32x4 r0 = x0 * rm + acc[ai][bj][m][0], r1 = x1 * rm + acc[ai][bj][m][1];
                    *(u32x4*)(x1b + off + bj * HALF) = pk8(r0, r1);
                    s += dot4(r0) + dot4(r1);
                }
                ss[ai * 4 + m] += s;
            }
    }
};

struct EpiGU {
    static constexpr bool PERM = true, AFTER_DRAIN = false;
    const float* r2; bf16_t* act; f32x4 rc0, rc1, rn0, rn1; unsigned long long tepi;
    __device__ __forceinline__ void prefetch(const Unit& u, int wr, int fr) {
        const float* p = r2 + u.pm * BM + wr * 64 + fr;
        rn0 = (f32x4){p[0], p[16], p[32], p[48]}; rn1 = (f32x4){p[HALF], p[HALF + 16], p[HALF + 32], p[HALF + 48]};
    }
    __device__ __forceinline__ void advance() { rc0 = rn0; rc1 = rn1; }
    __device__ __forceinline__ void operator()(const f32x4 (&acc)[2][2][4][2], const Unit& u, int wr, int wc, int fr, int fq) {
#ifdef PROBE_TIMER
        const unsigned long long te0_ = __builtin_amdgcn_s_memtime();
#endif
        asm volatile("" : "+v"(fr), "+v"(fq));
        const int row0 = u.pm * BM + wr * 64 + fr, col0 = u.pn * HALF + wc * 32 + 8 * fq;
#pragma unroll
        for (int ai = 0; ai < 2; ++ai)
#pragma unroll
            for (int m = 0; m < 4; ++m) {
                const int row = row0 + ai * HALF + m * 16; const float rr = ai ? rc1[m] : rc0[m];
                const f32x4 g0 = acc[ai][0][m][0] * rr, g1 = acc[ai][0][m][1] * rr, u0 = acc[ai][1][m][0] * rr, u1 = acc[ai][1][m][1] * rr;
                *(u32x4*)(act + (size_t)row * 2816 + col0) = pk8(silu4(g0) * u0, silu4(g1) * u1);
            }
#ifdef PROBE_TIMER
        asm volatile("s_waitcnt vmcnt(0)" ::: "memory"); tepi += __builtin_amdgcn_s_memtime() - te0_;
#endif
    }
};

struct EpiDown {
    static constexpr bool PERM = true, AFTER_DRAIN = false;
    const bf16_t* x1b; float* out;
    __device__ __forceinline__ void prefetch(const Unit&, int, int) {}
    __device__ __forceinline__ void advance() {}
    __device__ __forceinline__ void operator()(const f32x4 (&acc)[2][2][4][2], const Unit& u, int wr, int wc, int fr, int fq) {
        asm volatile("" : "+v"(fr), "+v"(fq));
        const int row0 = u.pm * BM + wr * 64 + fr, col0 = u.pn * BM + wc * 32 + 8 * fq;
#pragma unroll
        for (int ai = 0; ai < 2; ++ai)
#pragma unroll
            for (int m = 0; m < 4; ++m) {
                const size_t off = (size_t)(row0 + ai * HALF + m * 16) * 1024 + col0;
#pragma unroll
                for (int bj = 0; bj < 2; ++bj) {
                    const u32x4 xv = *(const u32x4*)(x1b + off + bj * HALF);
                    const f32x4 x0 = {__uint_as_float(xv[0] << 16), __uint_as_float(xv[0] & 0xffff0000u), __uint_as_float(xv[1] << 16), __uint_as_float(xv[1] & 0xffff0000u)};
                    const f32x4 x1 = {__uint_as_float(xv[2] << 16), __uint_as_float(xv[2] & 0xffff0000u), __uint_as_float(xv[3] << 16), __uint_as_float(xv[3] & 0xffff0000u)};
                    *(f32x4*)(out + off + bj * HALF) = x0 + acc[ai][bj][m][0]; *(f32x4*)(out + off + bj * HALF + 4) = x1 + acc[ai][bj][m][1];
                }
            }
    }
};

struct PanelOrder {
    int pm, ntn;
    __device__ __forceinline__ bool next(int i, Unit& u) const { if (i >= ntn) return false; u.pm = pm; u.pn = i; return true; }
    __device__ __forceinline__ void a_ready(const Unit&) const {}
    __device__ __forceinline__ void done(const Unit&) const {}
};

template <class Epi, class Sched, bool ALIGN_EPI = false, bool SP2 = false>
__device__ __forceinline__ void gemm_phase(PG8_LAS unsigned char* lds, const Gemm g, const Sched& S, Epi& E, int wave_in) {
    unsigned ones_ = ~0u; asm volatile("" : "+s"(ones_)); int tid_ = wave_in * 64 + (int)__builtin_amdgcn_mbcnt_hi(ones_, __builtin_amdgcn_mbcnt_lo(ones_, 0u));
    const int tid = tid_, wid = __builtin_amdgcn_readfirstlane(tid >> 6), lane = tid & 63, wr = wid >> 2, wc = wid & 3, fr = lane & 15, fq = lane >> 4;
    const int K = g.K, nt = K / BK;
    unsigned voffA[2], voffB[2];
#pragma unroll
    for (int i = 0; i < 2; ++i) { int R, C; stage_rc(tid * 16 + i * 8192, R, C); const int Rb = Epi::PERM ? ((R & ~31) + perm32(R & 31)) : R;
        voffA[i] = (unsigned)(R * K + C) * 2u; voffB[i] = (unsigned)(Rb * K + C) * 2u; }
    const size_t kstep = (size_t)(BK * 2);
    const size_t hstep = (size_t)HALF * K * 2;
    const size_t tstep = 2 * hstep;
    const unsigned ldsw = (unsigned)wid * 1024u;
    const int aoff = lds_byte(wr * 64 + fr, fq * 8), boff = lds_byte(wc * 32 + fr, fq * 8);
#define PG8_SA(b, h) (((b) * 2 + (h)) * HTB)
#define PG8_SB(b, h) ((4 + (b) * 2 + (h)) * HTB)
#define PG8_STAGE(bufoff, gbase, voff) do { _Pragma("unroll") for (int _i = 0; _i < 2; ++_i) \
        __builtin_amdgcn_global_load_lds((const unsigned*)((const char*)(gbase) + (voff)[_i]), (PG8_LAS unsigned*)(lds + (bufoff) + ldsw + _i * 8192), 16, 0, 0); } while (0)
#define PG8_LDA(dst, b, h) do { _Pragma("unroll") for (int m = 0; m < 4; ++m) _Pragma("unroll") for (int k = 0; k < 2; ++k) dst[m][k] = *(const PG8_LAS bf16x8*)(lds + PG8_SA(b, h) + aoff + m * 2048 + k * 1024); } while (0)
#define PG8_LDB(dst, b, h) do { _Pragma("unroll") for (int n = 0; n < 2; ++n) _Pragma("unroll") for (int k = 0; k < 2; ++k) dst[n][k] = *(const PG8_LAS bf16x8*)(lds + PG8_SB(b, h) + boff + n * 2048 + k * 1024); } while (0)
#define PG8_MMA(ai, bj, At, Bt) do { __builtin_amdgcn_s_setprio(1); _Pragma("unroll") for (int m = 0; m < 4; ++m) _Pragma("unroll") for (int n = 0; n < 2; ++n) _Pragma("unroll") for (int k = 0; k < 2; ++k) \
        acc[ai][bj][m][n] = __builtin_amdgcn_mfma_f32_16x16x32_bf16(Bt[n][k], At[m][k], acc[ai][bj][m][n], 0, 0, 0); __builtin_amdgcn_s_setprio(0); } while (0)
#define PG8_WAIT_V(n) asm volatile("s_waitcnt vmcnt(" #n ")" ::: "memory")
#define PG8_WAIT_L(n) asm volatile("s_waitcnt lgkmcnt(" #n ")" ::: "memory")
#define PG8_BAR __builtin_amdgcn_s_barrier()
#define PG8_SCHED __builtin_amdgcn_sched_barrier(0)
    Unit cur, nxt; int ui = 0;
    if (!S.next(0, cur)) return;
    E.prefetch(cur, wr, fr); E.advance();
    f32x4 acc[2][2][4][2];
#pragma unroll
    for (int a = 0; a < 2; ++a)
#pragma unroll
        for (int b = 0; b < 2; ++b)
#pragma unroll
            for (int m = 0; m < 4; ++m)
#pragma unroll
                for (int n = 0; n < 2; ++n) acc[a][b][m][n] = (f32x4){0.f, 0.f, 0.f, 0.f};
    bf16x8 At[4][2], B0[2][2], B1[2][2];
    const char* cA = (const char*)g.A + (size_t)cur.pm * tstep; const char* cB = (const char*)g.Bt + (size_t)cur.pn * tstep;
    S.a_ready(cur);
    if constexpr (SP2) {
        PG8_STAGE(PG8_SB(0, 0), cB, voffB); PG8_STAGE(PG8_SB(0, 1), cB + hstep, voffB); PG8_STAGE(PG8_SA(0, 0), cA, voffA); PG8_STAGE(PG8_SA(0, 1), cA + hstep, voffA);
        if (wr == 1) PG8_BAR;
        PG8_WAIT_V(2); PG8_BAR;
        PG8_STAGE(PG8_SB(1, 0), cB + kstep, voffB); PG8_STAGE(PG8_SA(1, 0), cA + kstep, voffA); PG8_STAGE(PG8_SB(1, 1), cB + hstep + kstep, voffB);
        PG8_WAIT_V(6); PG8_BAR;
    } else {
        PG8_STAGE(PG8_SB(0, 0), cB, voffB); PG8_STAGE(PG8_SA(0, 0), cA, voffA); PG8_STAGE(PG8_SB(0, 1), cB + hstep, voffB); PG8_STAGE(PG8_SA(0, 1), cA + hstep, voffA);
        if (wr == 1) PG8_BAR;
        PG8_WAIT_V(4); PG8_BAR;
        PG8_STAGE(PG8_SB(1, 0), cB + kstep, voffB); PG8_STAGE(PG8_SA(1, 0), cA + kstep, voffA); PG8_STAGE(PG8_SB(1, 1), cB + hstep + kstep, voffB);
        PG8_WAIT_V(6); PG8_BAR;
    }
    for (;;) {
        const bool has_next = S.next(ui + 1, nxt);
        const char* nA = has_next ? (const char*)g.A + (size_t)nxt.pm * tstep : cA; const char* nB = has_next ? (const char*)g.Bt + (size_t)nxt.pn * tstep : cB;
        for (int t = 0; t < nt; t += 2) {
            const bool last = (t == nt - 2);
            const char* a1 = cA + (size_t)(t + 1) * kstep;
            const char* a2 = last ? nA : cA + (size_t)(t + 2) * kstep; const char* b2 = last ? nB : cB + (size_t)(t + 2) * kstep;
            const char* a3 = a2 + kstep; const char* b3 = b2 + kstep;
            if (last && has_next) { S.a_ready(nxt); E.prefetch(nxt, wr, fr); }
            if constexpr (SP2) {
            PG8_LDB(B0, 0, 0); PG8_LDB(B1, 0, 1); PG8_SCHED; PG8_LDA(At, 0, 0); PG8_STAGE(PG8_SA(1, 1), a1 + hstep, voffA);
            PG8_WAIT_V(8); PG8_WAIT_L(0); PG8_BAR; PG8_MMA(0, 0, At, B0); PG8_MMA(0, 1, At, B1); PG8_BAR; PG8_SCHED;
            PG8_LDA(At, 0, 1); PG8_STAGE(PG8_SB(0, 0), b2, voffB); PG8_STAGE(PG8_SB(0, 1), b2 + hstep, voffB); PG8_STAGE(PG8_SA(0, 0), a2, voffA);
            PG8_WAIT_V(8); PG8_WAIT_L(0); PG8_BAR; PG8_MMA(1, 0, At, B0); PG8_MMA(1, 1, At, B1); PG8_BAR; PG8_SCHED;
            PG8_LDB(B0, 1, 0); PG8_LDB(B1, 1, 1); PG8_SCHED; PG8_LDA(At, 1, 0); PG8_STAGE(PG8_SA(0, 1), a2 + hstep, voffA);
            PG8_WAIT_V(8); PG8_WAIT_L(0); PG8_BAR; PG8_MMA(0, 0, At, B0); PG8_MMA(0, 1, At, B1); PG8_BAR; PG8_SCHED;
            PG8_LDA(At, 1, 1); PG8_STAGE(PG8_SB(1, 0), b3, voffB); PG8_STAGE(PG8_SB(1, 1), b3 + hstep, voffB); PG8_STAGE(PG8_SA(1, 0), a3, voffA);
            PG8_WAIT_V(8); PG8_WAIT_L(0); PG8_BAR; PG8_MMA(1, 0, At, B0); PG8_MMA(1, 1, At, B1); PG8_BAR; PG8_SCHED;
            } else {
            PG8_LDB(B0, 0, 0); PG8_SCHED; PG8_LDA(At, 0, 0); PG8_STAGE(PG8_SA(1, 1), a1 + hstep, voffA);
            PG8_WAIT_L(8); PG8_BAR; PG8_WAIT_L(0); PG8_MMA(0, 0, At, B0); PG8_BAR; PG8_SCHED;
            PG8_LDB(B1, 0, 1); PG8_STAGE(PG8_SB(0, 0), b2, voffB);
            PG8_BAR; PG8_WAIT_L(0); PG8_MMA(0, 1, At, B1); PG8_BAR;
            PG8_LDA(At, 0, 1); PG8_STAGE(PG8_SA(0, 0), a2, voffA);
            PG8_BAR; PG8_WAIT_L(0); PG8_MMA(1, 0, At, B0); PG8_BAR; PG8_SCHED;
            PG8_STAGE(PG8_SB(0, 1), b2 + hstep, voffB);
            PG8_WAIT_V(6); PG8_BAR; PG8_MMA(1, 1, At, B1); PG8_BAR;
            PG8_LDB(B0, 1, 0); PG8_SCHED; PG8_LDA(At, 1, 0); PG8_STAGE(PG8_SA(0, 1), a2 + hstep, voffA);
            PG8_WAIT_L(8); PG8_BAR; PG8_WAIT_L(0); PG8_MMA(0, 0, At, B0); PG8_BAR; PG8_SCHED;
            PG8_LDB(B1, 1, 1); PG8_STAGE(PG8_SB(1, 0), b3, voffB);
            PG8_BAR; PG8_WAIT_L(0); PG8_MMA(0, 1, At, B1); PG8_BAR;
            PG8_LDA(At, 1, 1); PG8_STAGE(PG8_SA(1, 0), a3, voffA);
            PG8_BAR; PG8_WAIT_L(0); PG8_MMA(1, 0, At, B0); PG8_BAR; PG8_SCHED;
            PG8_STAGE(PG8_SB(1, 1), b3 + hstep, voffB);
            PG8_WAIT_V(6); PG8_BAR; PG8_MMA(1, 1, At, B1); PG8_BAR;
            }
        }
        if constexpr (ALIGN_EPI) { if (wr == 0) PG8_BAR; }
        if constexpr (!Epi::AFTER_DRAIN) { E(acc, cur, wr, wc, fr, fq); E.advance(); S.done(cur); }
        if (!has_next) break;
#pragma unroll
        for (int a = 0; a < 2; ++a)
#pragma unroll
            for (int b = 0; b < 2; ++b)
#pragma unroll
                for (int m = 0; m < 4; ++m)
#pragma unroll
                    for (int n = 0; n < 2; ++n) acc[a][b][m][n] = (f32x4){0.f, 0.f, 0.f, 0.f};
        cur = nxt; cA = nA; cB = nB; ++ui;
        if constexpr (ALIGN_EPI) { if (wr == 1) PG8_BAR; }
    }
    PG8_WAIT_V(0);
    if constexpr (!ALIGN_EPI) { if (wr == 0) PG8_BAR; }
    PG8_BAR;
    (void)lane;
#undef PG8_SA
#undef PG8_SB
#undef PG8_STAGE
#undef PG8_LDA
#undef PG8_LDB
#undef PG8_MMA
#undef PG8_WAIT_V
#undef PG8_WAIT_L
#undef PG8_BAR
#undef PG8_SCHED
}
}

constexpr int BATCH = 32, SEQ = 2048, DM = 1024, MTOK = BATCH * SEQ;
constexpr int INW = 2852, NIN = 3072, FF = 2816, NGU = 2 * FF;
constexpr int NWAVES = 8, NTHR = 512;
#ifndef MK_N_LAUNCHES
#define MK_N_LAUNCHES 1
#endif
constexpr int N_PHASES = 6;
constexpr size_t MiB = 1u << 20;
constexpr size_t WS_CTL = 0;
constexpr size_t WS_COS = 1 * MiB, WS_SIN = WS_COS + 256 * 1024;
constexpr size_t WS_BT = WS_SIN + 256 * 1024;
constexpr size_t WS_R2 = 2 * MiB, WS_RMS = 2 * MiB + 512 * 1024;
constexpr size_t WS_WIN = 4 * MiB, WS_WOUT = 10 * MiB, WS_WGU = 12 * MiB, WS_WDN = 23 * MiB;
constexpr size_t WS_XB = 32 * MiB;
constexpr size_t WS_MIX = 160 * MiB;
constexpr size_t WS_QA = 288 * MiB, WS_QB = 352 * MiB, WS_KB = 416 * MiB, WS_VB = 480 * MiB, WS_GB = 544 * MiB;
constexpr size_t WS_KA = 608 * MiB, WS_VA = 616 * MiB;
constexpr size_t WS_IQ = 624 * MiB;
constexpr size_t WS_ACT = 288 * MiB;
constexpr size_t WS_IK = 640 * MiB, WS_IW = 644 * MiB;
constexpr size_t WS_MASK = 648 * MiB;
constexpr size_t WS_SCR = 672 * MiB;
constexpr size_t WS_END = 800 * MiB;
static_assert(WS_ACT + (size_t)MTOK * FF * 2 <= WS_IK && WS_IQ + (size_t)MTOK * 128 * 2 <= WS_IK && WS_WDN + (size_t)DM * FF * 2 <= WS_XB && WS_WGU + (size_t)NGU * DM * 2 <= WS_WDN, "d_ws map");
constexpr int RING_BYTES = 131072;
constexpr int XCH_OFF = RING_BYTES;
constexpr int P2_SC = 0, SCW = 2052;
constexpr int P2_MASK = 143360;
constexpr int MISC_OFF = 163584;
constexpr int LDS_BYTES = 163840;
static_assert(P2_SC + 16 * SCW * 4 <= P2_MASK && P2_MASK + 16384 <= MISC_OFF, "P2 LDS map");

#define LAS __attribute__((address_space(3)))
typedef unsigned short bf16;
typedef unsigned v4u __attribute__((ext_vector_type(4)));
typedef unsigned v2u __attribute__((ext_vector_type(2)));
typedef float f32x4 __attribute__((ext_vector_type(4)));
typedef float f32x16 __attribute__((ext_vector_type(16)));
typedef short bf16x8 __attribute__((ext_vector_type(8)));
typedef short s16x4 __attribute__((ext_vector_type(4)));
#define LDS_WAIT() asm volatile("s_waitcnt lgkmcnt(0)" ::: "memory")
using pg8::pkbf;
__device__ __forceinline__ float bf2f(unsigned short h) { return __uint_as_float((unsigned)h << 16); }
__device__ __forceinline__ float bflo(unsigned w) { return __uint_as_float(w << 16); }
__device__ __forceinline__ float bfhi(unsigned w) { return __uint_as_float(w & 0xffff0000u); }
__device__ __forceinline__ float wave_sum(float v) {
#pragma unroll
    for (int o = 1; o < 64; o <<= 1) v += __shfl_xor(v, o);
    return v;
}
__device__ __forceinline__ s16x4 vtr(const LAS unsigned char* p) { return __builtin_bit_cast(s16x4, __builtin_amdgcn_ds_read_tr16_b64_v4i16((LAS s16x4*)p)); }
__device__ __forceinline__ bf16x8 cat8(s16x4 lo, s16x4 hi) { return (bf16x8){lo[0], lo[1], lo[2], lo[3], hi[0], hi[1], hi[2], hi[3]}; }
__device__ __forceinline__ int crow(int r, int hi) { return (r & 3) + 8 * (r >> 2) + 4 * hi; }

__device__ __forceinline__ int lane_id() { unsigned ones = ~0u; asm volatile("" : "+s"(ones)); return (int)__builtin_amdgcn_mbcnt_hi(ones, __builtin_amdgcn_mbcnt_lo(ones, 0u)); }
struct KArgs { const float* in[16]; float* out; unsigned char* ws; int ph_lo, ph_hi; };
struct Frame {
    LAS unsigned char* lds;
    unsigned* ctl;
    unsigned char* ws;
    int tid, lane, wave, vcu, G;
    const __attribute__((address_space(4))) KArgs* ap;
    __device__ __forceinline__ const float* x() const { return ap->in[0]; }
    __device__ __forceinline__ const float* norm1_w() const { return ap->in[1]; }
    __device__ __forceinline__ const float* w_in() const { return ap->in[2]; }
    __device__ __forceinline__ const float* q_norm_w() const { return ap->in[3]; }
    __device__ __forceinline__ const float* k_norm_w() const { return ap->in[4]; }
    __device__ __forceinline__ const float* kv_norm_w() const { return ap->in[5]; }
    __device__ __forceinline__ const float* w_uk() const { return ap->in[6]; }
    __device__ __forceinline__ const float* w_uv() const { return ap->in[7]; }
    __device__ __forceinline__ const float* rel_bias() const { return ap->in[8]; }
    __device__ __forceinline__ const float* ret_gn_w() const { return ap->in[9]; }
    __device__ __forceinline__ const float* ret_gn_b() const { return ap->in[10]; }
    __device__ __forceinline__ const float* w_out() const { return ap->in[11]; }
    __device__ __forceinline__ const float* norm2_w() const { return ap->in[12]; }
    __device__ __forceinline__ const float* w_gate() const { return ap->in[13]; }
    __device__ __forceinline__ const float* w_up() const { return ap->in[14]; }
    __device__ __forceinline__ const float* w_down() const { return ap->in[15]; }
    __device__ __forceinline__ float* out() const { return ap->out; }
#define WSB_(name, off) __device__ __forceinline__ bf16* name() const { return (bf16*)(ws + (off)); }
#define WSF_(name, off) __device__ __forceinline__ float* name() const { return (float*)(ws + (off)); }
    WSB_(WIN, WS_WIN) WSB_(WOUT, WS_WOUT) WSB_(WGU, WS_WGU) WSB_(WDN, WS_WDN) WSB_(XB, WS_XB) WSB_(MIX, WS_MIX) WSB_(QA, WS_QA) WSB_(QB, WS_QB) WSB_(KB, WS_KB) WSB_(VB, WS_VB) WSB_(GB, WS_GB)
    WSB_(KA, WS_KA) WSB_(VA, WS_VA) WSB_(IQ, WS_IQ) WSB_(IK, WS_IK) WSB_(ACT, WS_ACT)
    WSF_(IW, WS_IW) WSF_(R2, WS_R2) WSF_(RMS, WS_RMS) WSF_(COS, WS_COS) WSF_(SIN, WS_SIN) WSF_(BT, WS_BT) WSF_(SCR, WS_SCR)
    __device__ __forceinline__ unsigned long long* MASK() const { return (unsigned long long*)(ws + WS_MASK); }
#undef WSB_
#undef WSF_
};

__device__ __forceinline__ int zcol(int n) {
    const int pn = n >> 8, tc = n & 255, bj = tc >> 7, wc = (tc >> 5) & 3, j = tc & 31, d = bj * 32 + j;
    if (pn < 2) return (4 * pn + wc) * 64 + d;
    if (pn == 2) { if (wc == 0) return -2 - d; if (wc == 1) return -2 - (64 + d); return 512 + (wc - 2) * 64 + d; }
    if (pn == 3) { if (bj == 0) return 640 + wc * 32 + j; if (wc == 0) return 768 + j; if (wc == 1 && j < 4) return 800 + j; return -1; }
    const int g = (pn - 4) >> 1, head = 4 * ((pn - 4) & 1) + wc;
    return 804 + g * 512 + head * 64 + d;
}
template <class SRC>
__device__ __forceinline__ void tr_item(SRC src, int Kdim, bf16* WT, int k0, int n0, LAS float* scr, int lane) {
#pragma unroll 4
    for (int i = 0; i < 32; ++i) { const int kk = 2 * i + (lane >> 5); scr[kk * 33 + (lane & 31)] = src(k0 + kk); }
    LDS_WAIT(); asm volatile("" ::: "memory");
    const int c = lane & 7;
#pragma unroll
    for (int j = 0; j < 4; ++j) { const int n = (lane >> 3) + 8 * j; const LAS float* s = scr + (8 * c) * 33 + n;
        v4u o; o.x = pkbf(s[0 * 33], s[1 * 33]); o.y = pkbf(s[2 * 33], s[3 * 33]); o.z = pkbf(s[4 * 33], s[5 * 33]); o.w = pkbf(s[6 * 33], s[7 * 33]);
        *(v4u*)(WT + (size_t)(n0 + n) * Kdim + k0 + 8 * c) = o; }
    LDS_WAIT(); asm volatile("" ::: "memory");
}
__device__ __forceinline__ int t5_bucket(int rel) {
    const int n = rel < 0 ? -rel : rel; int b;
    if (n < 8) b = n; else if (n < 12) b = 8; else if (n < 16) b = 9; else if (n < 23) b = 10; else if (n < 32) b = 11; else if (n < 46) b = 12; else if (n < 64) b = 13; else if (n < 91) b = 14; else b = 15;
    return (rel > 0 ? 16 : 0) + b;
}
__device__ __forceinline__ void p0_prologue(Frame& F) {
    LAS float* scr = (LAS float*)(F.lds + F.wave * 16384);
    const int lane = F.lane, gw = F.vcu * NWAVES + F.wave, NGW = F.G * NWAVES;
    if (blockIdx.x == 0 && F.tid == 0) F.ctl[0] = 0u;
    constexpr int I_IN = 16 * (NIN / 32), I_OUT = 16 * 32, I_GU = 16 * (NGU / 32), I_DN = (FF / 64) * 32, NITEMS = I_IN + I_OUT + I_GU + I_DN;
    auto do_item = [&](int it) {
        int r = it;
        if (r < I_IN) {
            const int kb = r / (NIN / 32), nb = r % (NIN / 32), f = zcol(32 * nb + (lane & 31));
            const float* w_in = F.w_in(); const float* nw = F.norm1_w();
            if (f >= -1) tr_item([&](int k) { return f >= 0 ? nw[k] * w_in[(size_t)k * INW + f] : 0.0f; }, DM, F.WIN(), 64 * kb, 32 * nb, scr, lane);
            return;
        }
        r -= I_IN;
        if (r < I_OUT) { const int kb = r / 32, nb = r % 32; const float* w = F.w_out() + 32 * nb + (lane & 31);
            tr_item([&](int k) { return w[(size_t)k * DM]; }, DM, F.WOUT(), 64 * kb, 32 * nb, scr, lane); return; }
        r -= I_OUT;
        if (r < I_GU) { const int kb = r / (NGU / 32), nb = r % (NGU / 32), n = 32 * nb + (lane & 31), pn = n >> 8, tc = n & 255;
            const float* w = ((tc >> 7) ? F.w_up() : F.w_gate()) + 128 * pn + (tc & 127); const float* nw = F.norm2_w();
            tr_item([&](int k) { return nw[k] * w[(size_t)k * FF]; }, DM, F.WGU(), 64 * kb, 32 * nb, scr, lane); return; }
        r -= I_GU;
        { const int kb = r / 32, nb = r % 32; const float* w = F.w_down() + 32 * nb + (lane & 31);
            tr_item([&](int k) { return w[(size_t)k * DM]; }, FF, F.WDN(), 64 * kb, 32 * nb, scr, lane); }
    };
    for (int e = F.vcu * NTHR + F.tid; e < DM * 128; e += F.G * NTHR) {
        const int k = e >> 7, idx = e & 127, d = idx & 63; const float* wu = (idx < 64 ? F.w_uk() : F.w_uv()) + d; const float* wr_ = F.w_in() + (size_t)k * INW + 512; float a = 0.f;
#pragma unroll 8
        for (int j = 0; j < 128; ++j) a += wr_[j] * F.kv_norm_w()[j] * wu[j * 64];
        const int n = 512 + (idx < 64 ? 0 : 32) + (d < 32 ? d : 128 + d - 32);
        F.WIN()[(size_t)n * DM + k] = (bf16)(pkbf(F.norm1_w()[k] * a, 0.f) & 0xffffu);
    }
    int it = gw, kk = 0;
    for (int m = gw; m < MTOK; m += NGW, ++kk) {
        const f32x4* xr = (const f32x4*)(F.x() + (size_t)m * DM) + lane;
        f32x4 v[4]; float sq = 0.f;
#pragma unroll
        for (int j = 0; j < 4; ++j) { v[j] = xr[64 * j]; sq += pg8::dot4(v[j]); }
        const float ms = wave_sum(sq) * (1.0f / DM) + 1e-6f, rr = 1.0f / sqrtf(ms);
        v2u* o8 = (v2u*)(F.XB() + (size_t)m * DM) + lane;
#pragma unroll
        for (int j = 0; j < 4; ++j) o8[64 * j] = (v2u){pkbf(v[j][0] * rr, v[j][1] * rr), pkbf(v[j][2] * rr, v[j][3] * rr)};
        if (lane == 0) F.RMS()[m] = sqrtf(ms);
        if ((kk & 7) == 3 && it < NITEMS) { do_item(it); it += NGW; }
    }
    for (; it < NITEMS; it += NGW) do_item(it);
    const int gt = F.vcu * NTHR + F.tid, NGT = F.G * NTHR;
    for (int i = gt; i < 8 * 256; i += NGT) { const int h = i >> 8, rel = (i & 255) - 191;
        F.BT()[i] = (F.rel_bias()[t5_bucket(rel) * 8 + h] - F.rel_bias()[15 * 8 + h]) * 1.4426950408889634f; }
}

#ifndef PROBE_LO
#define PROBE_LO 3000.0f
#define PROBE_RANGE 4000.0f
#endif
#ifndef PLANES
#define PLANES 1
#endif
#ifndef MIXREP
#define MIXREP 0
#endif
typedef float f32x4_t __attribute__((ext_vector_type(4)));
typedef float f32x2v __attribute__((ext_vector_type(2)));
struct IdxOps { bf16x8 bq[4]; f32x4 wv; bf16x8 a0; };
__device__ __forceinline__ void idx_fetch(IdxOps& o, const Frame& F, int b, int c, int rq) {
    const int w = F.wave, lane = F.lane, q = lane & 15, g = lane >> 4;
    const size_t rowq = (size_t)b * SEQ + 64 * c + 16 * rq + q;
#pragma unroll
    for (int h = 0; h < 4; ++h) o.bq[h] = *(const bf16x8*)(F.IQ() + rowq * 128 + 32 * h + 8 * g);
    o.wv = *(const f32x4*)(F.IW() + rowq * 4) * (0.5f * 0.17677669529663687f);
    o.a0 = *(const bf16x8*)(F.IK() + ((size_t)b * SEQ + q) * 32 + 8 * g + (size_t)w * 512);
}
__device__ __forceinline__ void idx_round(const IdxOps& o, const Frame& F, int b, int c, LAS unsigned char* lds) {
    const int w = F.wave, lane = F.lane, q = lane & 15, g = lane >> 4;
    const int nkb = 4 * (c + 1);
    const bf16* kp = F.IK() + ((size_t)b * SEQ + q) * 32 + 8 * g;
    LAS float* dst = (LAS float*)(lds + P2_SC) + q * SCW + 4 * g;
    int kb = w; bf16x8 a = o.a0;
    for (; kb < nkb; kb += 8) {
        bf16x8 an = a; if (kb + 8 < nkb) an = *(const bf16x8*)(kp + (size_t)(kb + 8) * 512);
        f32x4 sc = {0.f, 0.f, 0.f, 0.f};
#pragma unroll
        for (int h = 0; h < 4; ++h) {
            const f32x4 d = __builtin_amdgcn_mfma_f32_16x16x32_bf16(a, o.bq[h], (f32x4){0.f, 0.f, 0.f, 0.f}, 0, 0, 0);
#pragma unroll
            for (int i = 0; i < 4; ++i) sc[i] += o.wv[h] * fmaxf(d[i], 0.f);
        }
        *(LAS f32x4*)(dst + 16 * kb) = (f32x4){sc[0] + 0.f, sc[1] + 0.f, sc[2] + 0.f, sc[3] + 0.f};
        a = an;
    }
}
__device__ __forceinline__ int wave_sum_i(int v) {
    v += __builtin_amdgcn_update_dpp(0, v, 0xB1, 0xF, 0xF, false);
    v += __builtin_amdgcn_update_dpp(0, v, 0x4E, 0xF, 0xF, false);
    v += __builtin_amdgcn_update_dpp(0, v, 0x141, 0xF, 0xF, false);
    v += __builtin_amdgcn_update_dpp(0, v, 0x140, 0xF, 0xF, false);
    return (__builtin_amdgcn_readlane(v, 0) + __builtin_amdgcn_readlane(v, 16)) + (__builtin_amdgcn_readlane(v, 32) + __builtin_amdgcn_readlane(v, 48));
}
__device__ __forceinline__ unsigned sortable(float f) { const unsigned bits = __float_as_uint(f); return bits ^ ((unsigned)((int)bits >> 31) | 0x80000000u); }
template <int NJ>
__device__ __forceinline__ void mask_words(const unsigned (&u)[NJ], unsigned prefix, bool exact, LAS unsigned long long* mrow, int nj, int lane) {
    unsigned long long mv = 0ull;
    if (exact) {
#pragma unroll
        for (int j = 0; j < NJ; ++j) { const unsigned long long sel = __ballot(u[j] >= prefix); if (lane == j) mv = sel; }
    } else {
        int ngt = 0;
#pragma unroll
        for (int j = 0; j < NJ; ++j) ngt += __popcll(__ballot(u[j] > prefix));
        int need = 256 - ngt;
#pragma unroll
        for (int j = 0; j < NJ; ++j) {
            const unsigned long long eq = __ballot(u[j] == prefix);
            const int rank = (int)__builtin_amdgcn_mbcnt_hi((unsigned)(eq >> 32), __builtin_amdgcn_mbcnt_lo((unsigned)eq, 0u));
            const unsigned long long sel = __ballot(u[j] > prefix || (u[j] == prefix && rank < need));
            need -= __popcll(eq);
            if (lane == j) mv = sel;
        }
    }
    if (lane < nj) mrow[lane] = mv;
}
template <int NJ>
__device__ __forceinline__ void select_row(const LAS float* row, LAS unsigned long long* mrow, int nj, int lane) {
    static_assert(NJ % 4 == 0, "groups of four");
    unsigned u[NJ];
#pragma unroll
    for (int j = 0; j < NJ; ++j) { float v = row[64 * j + lane]; asm volatile("" : "+v"(v)); u[j] = (j < nj) ? sortable(v) : 0u; }
    unsigned prefix = 0u; bool exact = false;
#pragma unroll 1
    for (int bit = 31; bit >= 0; --bit) {
        const unsigned trial = prefix | (1u << bit); int c0 = 0, c1 = 0, c2 = 0, c3 = 0;
#pragma unroll
        for (int j = 0; j < NJ; j += 4) {
            unsigned long long m0, m1, m2, m3;
            asm volatile("v_cmp_le_u32_e64 %4, %12, %8\n\tv_cmp_le_u32_e64 %5, %12, %9\n\tv_cmp_le_u32_e64 %6, %12, %10\n\tv_cmp_le_u32_e64 %7, %12, %11\n\t"
                         "v_addc_co_u32_e64 %0, %4, 0, %0, %4\n\tv_addc_co_u32_e64 %1, %5, 0, %1, %5\n\tv_addc_co_u32_e64 %2, %6, 0, %2, %6\n\tv_addc_co_u32_e64 %3, %7, 0, %3, %7"
                         : "+v"(c0), "+v"(c1), "+v"(c2), "+v"(c3), "=&s"(m0), "=&s"(m1), "=&s"(m2), "=&s"(m3) : "v"(u[j]), "v"(u[j + 1]), "v"(u[j + 2]), "v"(u[j + 3]), "s"(trial));
        }
        const int cnt = wave_sum_i((c0 + c1) + (c2 + c3));
        if (cnt >= 256) prefix = trial;
        if (cnt == 256) { exact = true; break; }
    }
    mask_words<NJ>(u, prefix, exact, mrow, nj, lane);
}
template <int S, unsigned M>
__device__ __forceinline__ void tr_stage(unsigned (&A)[32]) {
#pragma unroll
    for (int k = 0; k < 32; ++k) if (!(k & S)) { const unsigned a = A[k], b = A[k + S]; A[k] = (a & M) | ((b & M) << S); A[k + S] = ((a >> S) & M) | (b & ~M); }
}
__device__ __forceinline__ void tr_bytes(unsigned (&A)[32]) {
#pragma unroll
    for (int k = 0; k < 16; ++k) { const unsigned a = A[k], b = A[k + 16];
        A[k] = __builtin_amdgcn_perm(b, a, 0x05040100u);
        A[k + 16] = __builtin_amdgcn_perm(b, a, 0x07060302u); }
#pragma unroll
    for (int k = 0; k < 32; ++k) if (!(k & 8)) { const unsigned a = A[k], b = A[k + 8];
        A[k] = __builtin_amdgcn_perm(b, a, 0x06020400u);
        A[k + 8] = __builtin_amdgcn_perm(b, a, 0x07030501u); }
}
__device__ __forceinline__ void planes_finish(unsigned gt, unsigned alive, int G, bool done, LAS unsigned long long* mrow, int nj, int lane) {
    unsigned sel = gt | alive;
    if (!done) {
        int need = 256 - G; unsigned ts = 0u;
#pragma unroll
        for (int j = 0; j < 32; ++j) {
            const bool mine = (alive >> j) & 1u; const unsigned long long eq = __ballot(mine);
            const int rank = (int)__builtin_amdgcn_mbcnt_hi((unsigned)(eq >> 32), __builtin_amdgcn_mbcnt_lo((unsigned)eq, 0u));
            ts |= (mine && rank < need) ? (1u << j) : 0u; need -= __popcll(eq);
        }
        sel = gt | ts;
    }
    unsigned long long mv = 0ull;
#pragma unroll
    for (int j = 0; j < 32; ++j) { const unsigned long long w = __ballot((sel >> j) & 1u); if (lane == j) mv = w; }
    if (lane < nj) mrow[lane] = mv;
}
__device__ __forceinline__ void select_rows_planes2(const LAS float* rowa, const LAS float* rowb, LAS unsigned long long* mrowa, LAS unsigned long long* mrowb, int nj, int lane) {
    unsigned A[32], B[32];
#pragma unroll
    for (int j = 0; j < 32; ++j) { float va = rowa[64 * j + lane], vb = rowb[64 * j + lane]; asm volatile("" : "+v"(va), "+v"(vb)); A[j] = (j < nj) ? sortable(va) : 0u; B[j] = (j < nj) ? sortable(vb) : 0u; }
    tr_bytes(A); tr_stage<4, 0x0F0F0F0Fu>(A); tr_stage<2, 0x33333333u>(A); tr_stage<1, 0x55555555u>(A);
    tr_bytes(B); tr_stage<4, 0x0F0F0F0Fu>(B); tr_stage<2, 0x33333333u>(B); tr_stage<1, 0x55555555u>(B);
#pragma unroll
    for (int j = 0; j < 32; ++j) asm volatile("" : "+v"(A[j]), "+v"(B[j]));
    unsigned alivea = 0xFFFFFFFFu, gta = 0u, aliveb = 0xFFFFFFFFu, gtb = 0u; int Ga = 0, Aa = 2048, Gb = 0, Ab = 2048; bool donea = false, doneb = false;
#pragma unroll
    for (int b = 31; b >= 0; --b) {
        if (!(donea && doneb)) {
            const unsigned onesa = alivea & A[b], onesb = aliveb & B[b];
            const int both = wave_sum_i(__builtin_popcount(onesa) | (__builtin_popcount(onesb) << 16)), C1a = both & 0xffff, C1b = both >> 16;
            if (!donea) {
                if (Ga + C1a >= 256) { alivea = onesa; Aa = C1a; } else { Ga += C1a; gta |= onesa; alivea &= ~A[b]; Aa -= C1a; }
                donea = (Ga + Aa == 256);
            }
            if (!doneb) {
                if (Gb + C1b >= 256) { aliveb = onesb; Ab = C1b; } else { Gb += C1b; gtb |= onesb; aliveb &= ~B[b]; Ab -= C1b; }
                doneb = (Gb + Ab == 256);
            }
        }
    }
    planes_finish(gta, alivea, Ga, donea, mrowa, nj, lane);
    planes_finish(gtb, aliveb, Gb, doneb, mrowb, nj, lane);
}
constexpr int MP_STRIDE = 36, MP_PLANE = 64 * MP_STRIDE;
__device__ __forceinline__ unsigned row32_sum(unsigned v) {
    v += __builtin_amdgcn_update_dpp(0, v, 0xB1, 0xF, 0xF, false);
    v += __builtin_amdgcn_update_dpp(0, v, 0x4E, 0xF, 0xF, false);
    v += __builtin_amdgcn_update_dpp(0, v, 0x141, 0xF, 0xF, false);
    v += __builtin_amdgcn_update_dpp(0, v, 0x140, 0xF, 0xF, false);
    return v + (unsigned)__builtin_amdgcn_ds_swizzle((int)v, 0x401F);
}
__device__ __forceinline__ void select_rows32(const LAS float* sc, LAS unsigned* mp, int rq, int nj, int wave, int lane) {
    const int half = lane >> 5, l32 = lane & 31, ql = 2 * wave + half;
    const LAS float* row = sc + ql * SCW + l32;
    unsigned A[32], B[32];
#pragma unroll
    for (int i = 0; i < 32; ++i) { float va = row[32 * i], vb = row[32 * (32 + i)]; asm volatile("" : "+v"(va), "+v"(vb)); A[i] = sortable(va); B[i] = sortable(vb); }
    tr_bytes(A); tr_stage<4, 0x0F0F0F0Fu>(A); tr_stage<2, 0x33333333u>(A); tr_stage<1, 0x55555555u>(A);
    tr_bytes(B); tr_stage<4, 0x0F0F0F0Fu>(B); tr_stage<2, 0x33333333u>(B); tr_stage<1, 0x55555555u>(B);
    const int nv = 2 * nj;
    unsigned al0 = nv >= 32 ? 0xFFFFFFFFu : ((1u << nv) - 1u), al1 = nv <= 32 ? 0u : (nv >= 64 ? 0xFFFFFFFFu : ((1u << (nv - 32)) - 1u));
    unsigned gt0 = 0u, gt1 = 0u, G = 0u;
#pragma unroll
    for (int b = 31; b >= 0; --b) {
        const unsigned o0 = al0 & A[b], o1 = al1 & B[b];
        const unsigned c1 = row32_sum((unsigned)__builtin_popcount(o0) + (unsigned)__builtin_popcount(o1));
        const bool take = G + c1 >= 256u;
        al0 = take ? o0 : (al0 & ~A[b]); al1 = take ? o1 : (al1 & ~B[b]);
        gt0 |= take ? 0u : o0; gt1 |= take ? 0u : o1;
        G += take ? 0u : c1;
    }
    const unsigned ce = row32_sum((unsigned)__builtin_popcount(al0) + (unsigned)__builtin_popcount(al1));
    const bool tie = G + ce != 256u;
    if (__any(tie)) {
        const unsigned need = tie ? 256u - G : 0x7fffffffu; unsigned m = 0u;
#pragma unroll
        for (int bit = 6; bit >= 0; --bit) {
            const unsigned cand = m + (1u << bit);
            const unsigned k0 = cand >= 32u ? 0xFFFFFFFFu : ((1u << cand) - 1u), k1 = cand <= 32u ? 0u : (cand >= 64u ? 0xFFFFFFFFu : ((1u << (cand - 32u)) - 1u));
            const unsigned cc = row32_sum((unsigned)__builtin_popcount(al0 & k0) + (unsigned)__builtin_popcount(al1 & k1));
            m = (cand <= 64u && cc <= need) ? cand : m;
        }
        const unsigned k0 = m >= 32u ? 0xFFFFFFFFu : ((1u << m) - 1u), k1 = m <= 32u ? 0u : (m >= 64u ? 0xFFFFFFFFu : ((1u << (m - 32u)) - 1u));
        const unsigned cm = row32_sum((unsigned)__builtin_popcount(al0 & k0) + (unsigned)__builtin_popcount(al1 & k1));
        const unsigned rem = need - cm;
        const bool mine = m < 64u && (((m < 32u ? al0 >> m : al1 >> (m - 32u)) & 1u) != 0u);
        const unsigned long long eq = __ballot(mine); const unsigned eqr = half ? (unsigned)(eq >> 32) : (unsigned)eq;
        const bool tk = mine && (unsigned)__builtin_popcount(eqr & ((1u << l32) - 1u)) < rem;
        al0 = (al0 & k0) | ((tk && m < 32u) ? (1u << m) : 0u); al1 = (al1 & k1) | ((tk && m >= 32u) ? (1u << (m - 32u)) : 0u);
    }
    LAS unsigned* rec = mp + (16 * rq + ql) * MP_STRIDE + l32;
    rec[0] = gt0 | al0; rec[MP_PLANE] = gt1 | al1;
}
constexpr int AT_K = 0, AT_V = 32768, AT_BT = 65536, AT_WS = 73728, AT_OST = 0, AT_Q = 75776;
static_assert(AT_Q + 65536 <= P2_MASK && AT_OST + 8 * 4608 <= AT_BT, "attention LDS map");
__device__ __forceinline__ bf16x8 pk16(const f32x16& v, int o) { return __builtin_bit_cast(bf16x8, (v4u){pkbf(v[o], v[o + 1]), pkbf(v[o + 2], v[o + 3]), pkbf(v[o + 4], v[o + 5]), pkbf(v[o + 6], v[o + 7])}); }
__device__ __forceinline__ void glds16(const void* gsrc, unsigned lds_dst) {
    unsigned keep;
    asm volatile("s_mov_b32 %0, m0\n\ts_mov_b32 m0, %2\n\ts_nop 0\n\tglobal_load_lds_dwordx4 %1, off\n\ts_mov_b32 m0, %0" : "=&s"(keep) : "v"(gsrc), "s"(lds_dst) : "memory");
}
__device__ __forceinline__ unsigned lds_addr(const LAS unsigned char* p) { return (unsigned)(uintptr_t)p; }
template <bool MASK, bool NEAR>
__device__ __forceinline__ void attn_soft(f32x16& p0, f32x16& p1, f32x2v& lacc, bf16x8 (&pa)[4], const LAS unsigned* mrec, int sbit) {
#pragma unroll
    for (int i = 0; i < 16; ++i) { p0[i] = __builtin_amdgcn_exp2f(p0[i]); p1[i] = __builtin_amdgcn_exp2f(p1[i]); }
    if (MASK) {
#pragma unroll
        for (int g = 0; g < 4; ++g) {
            const v4u w4 = *(const LAS v4u*)(mrec + 8 * g);
#pragma unroll
            for (int k = 0; k < 4; ++k) { int m0_, m1_; asm("v_bfe_i32 %0, %1, %2, 1" : "=v"(m0_) : "v"(w4[k]), "s"(sbit)); asm("v_bfe_i32 %0, %1, %2, 1" : "=v"(m1_) : "v"(w4[k]), "s"(sbit + 1));
                p0[4 * g + k] = __uint_as_float(__float_as_uint(p0[4 * g + k]) & (unsigned)m0_); p1[4 * g + k] = __uint_as_float(__float_as_uint(p1[4 * g + k]) & (unsigned)m1_); }
        }
    }
#pragma unroll
    for (int i = 0; i < 16; i += 2) { lacc += (f32x2v){p0[i], p0[i + 1]}; lacc += (f32x2v){p1[i], p1[i + 1]}; }
    pa[0] = pk16(p0, 0); pa[1] = pk16(p0, 8); pa[2] = pk16(p1, 0); pa[3] = pk16(p1, 8);
}
__device__ __forceinline__ void attn_pv(f32x16& o0, f32x16& o1, const bf16x8 (&pa)[4], const LAS unsigned char* Vb) {
#pragma unroll
    for (int ks = 0; ks < 4; ++ks) {
        o0 = __builtin_amdgcn_mfma_f32_32x32x16_bf16(pa[ks], cat8(vtr(Vb + ks * 1024), vtr(Vb + ks * 1024 + 512)), o0, 0, 0, 0);
        o1 = __builtin_amdgcn_mfma_f32_32x32x16_bf16(pa[ks], cat8(vtr(Vb + 4096 + ks * 1024), vtr(Vb + 4096 + ks * 1024 + 512)), o1, 0, 0, 0);
    }
}
template <bool NEAR>
__device__ __forceinline__ void attn_qk(f32x16& a0, f32x16& a1, f32x16& b0, f32x16& b1, const LAS unsigned char* Qb, const LAS unsigned char* Kb, const LAS float* bt) {
#pragma unroll
    for (int i = 0; i < 16; ++i) {
        if (NEAR) { a0[i] = bt[(i & 3) + 8 * (i >> 2)]; a1[i] = bt[32 + (i & 3) + 8 * (i >> 2)]; b0[i] = bt[(i & 3) + 8 * (i >> 2) - 32]; b1[i] = bt[(i & 3) + 8 * (i >> 2)]; }
        else { a0[i] = 0.f; a1[i] = 0.f; b0[i] = 0.f; b1[i] = 0.f; }
    }
#pragma unroll
    for (int d0 = 0; d0 < 4; ++d0) {
        const bf16x8 k0 = *(const LAS bf16x8*)(Kb + d0 * 2048), k1 = *(const LAS bf16x8*)(Kb + d0 * 2048 + 512);
        const bf16x8 qfa = *(const LAS bf16x8*)(Qb + d0 * 1024), qfb = *(const LAS bf16x8*)(Qb + 4096 + d0 * 1024);
        a0 = __builtin_amdgcn_mfma_f32_32x32x16_bf16(k0, qfa, a0, 0, 0, 0); a1 = __builtin_amdgcn_mfma_f32_32x32x16_bf16(k1, qfa, a1, 0, 0, 0);
        b0 = __builtin_amdgcn_mfma_f32_32x32x16_bf16(k0, qfb, b0, 0, 0, 0); b1 = __builtin_amdgcn_mfma_f32_32x32x16_bf16(k1, qfb, b1, 0, 0, 0);
    }
}
__device__ __forceinline__ void attn_store(const f32x16& o0, const f32x16& o1, f32x2v lacc, bf16* obase, LAS unsigned char* stg, LAS float* wsf, int lane) {
    const int r = lane & 31, hi = lane >> 5;
    float lsum = lacc[0] + lacc[1];
    lsum += __shfl_xor(lsum, 32);
    if (hi == 0) wsf[r] = lsum;
    LDS_WAIT(); asm volatile("" ::: "memory");
    LAS unsigned short* st = (LAS unsigned short*)stg;
#pragma unroll
    for (int i = 0; i < 16; ++i) {
        const int q = crow(i, hi); const float rl = 1.0f / wsf[q];
        st[q * 72 + r] = (unsigned short)(pkbf(o0[i] * rl, 0.f) & 0xffffu); st[q * 72 + 32 + r] = (unsigned short)(pkbf(o1[i] * rl, 0.f) & 0xffffu);
    }
    LDS_WAIT(); asm volatile("" ::: "memory");
#pragma unroll
    for (int k = 0; k < 4; ++k) { const int row = 8 * k + (lane >> 3), ch = lane & 7;
        const v4u v = *(const LAS v4u*)(stg + row * 144 + ch * 16); *(v4u*)(obase + (size_t)row * DM + ch * 8) = v; }
    LDS_WAIT(); asm volatile("" ::: "memory");
}
template <bool MASK>
__device__ __forceinline__ void attn_chunk(const Frame& F, int b, int c, LAS unsigned char* lds) {
    const int wid = F.wave, lane = F.lane, r = lane & 31, hi = lane >> 5;
    const size_t rowbase = (size_t)b * SEQ; const int q0 = 64 * c, nt = c + 1;
    const LAS unsigned char* Qb = lds + AT_Q + wid * 8192 + lane * 16;
#pragma unroll
    for (int d0 = 0; d0 < 4; ++d0) {
        *(LAS bf16x8*)(lds + AT_Q + wid * 8192 + d0 * 1024 + lane * 16) = *(const bf16x8*)(F.QA() + (rowbase + q0 + r) * 512 + wid * 64 + 16 * d0 + 8 * hi);
        *(LAS bf16x8*)(lds + AT_Q + wid * 8192 + 4096 + d0 * 1024 + lane * 16) = *(const bf16x8*)(F.QA() + (rowbase + q0 + 32 + r) * 512 + wid * 64 + 16 * d0 + 8 * hi); }
    const LAS float* BT = (const LAS float*)(lds + AT_BT) + wid * 256;
    const bf16* ksrc = F.KA() + (rowbase + lane) * 64 + 8 * wid;
    const bf16* vsrc = F.VA() + (rowbase + 16 * (wid & 3) + (lane >> 2)) * 64 + (wid >> 2) * 32 + (lane & 3) * 8;
    const LAS unsigned* mreca = (const LAS unsigned*)(lds + P2_MASK) + r * MP_STRIDE + 4 * hi; const LAS unsigned* mrecb = mreca + 32 * MP_STRIDE;
    const int voff = ((lane >> 4) & 1) * 32 + (lane & 3) * 8 + (4 * hi + ((lane & 15) >> 2)) * 64;
    f32x16 oa0, oa1, ob0, ob1; f32x2v la = {0.f, 0.f}, lb = {0.f, 0.f};
#pragma unroll
    for (int i = 0; i < 16; ++i) { oa0[i] = 0.f; oa1[i] = 0.f; ob0[i] = 0.f; ob1[i] = 0.f; }
#define AT_BAR() do { __builtin_amdgcn_sched_barrier(0); asm volatile("s_waitcnt lgkmcnt(0)" ::: "memory"); __builtin_amdgcn_s_barrier(); asm volatile("" ::: "memory"); __builtin_amdgcn_sched_barrier(0); } while (0)
#define AT_DMA(t_, slot_) do { const int tn_ = (t_) < nt ? (t_) : nt - 1;     \
        glds16(ksrc + (size_t)tn_ * 64 * 64, (unsigned)__builtin_amdgcn_readfirstlane((int)lds_addr(lds + AT_K + (slot_) * 8192 + wid * 1024))); \
        glds16(vsrc + (size_t)tn_ * 64 * 64, (unsigned)__builtin_amdgcn_readfirstlane((int)lds_addr(lds + AT_V + (slot_) * 8192 + wid * 1024))); } while (0)
    AT_DMA(0, 0); AT_DMA(1, 1); AT_DMA(2, 2);
    asm volatile("s_waitcnt vmcnt(0)" ::: "memory");
    AT_BAR();
    if (wid >= 4) AT_BAR();
    const int nfar = c >= 2 ? c - 2 : 0;
#if defined(PROBE_TIMER) && PROBE_TIMER == 3
    const unsigned long long pa0_ = __builtin_amdgcn_s_memtime();
#endif
    f32x16 a0, a1, b0, b1; bf16x8 pa[4], pb[4];
#if defined(PROBE_TIMER) && PROBE_TIMER >= 4
    unsigned psum_ = 0u;
#endif
    {
        const LAS unsigned char* Kb = lds + AT_K + hi * 1024 + r * 16; const LAS float* bt = BT + (64 * (0 - c) + 191 - r + 4 * hi);
        if (0 < nfar) attn_qk<false>(a0, a1, b0, b1, Qb, Kb, bt); else attn_qk<true>(a0, a1, b0, b1, Qb, Kb, bt);
        AT_BAR();
    }
#pragma unroll 1
    for (int t = 0; t < nt; ++t) {
        const int pl_ = (t >> 4) * MP_PLANE, sbit = (2 * t) & 31;
#ifdef NOSOFT
        { const bf16x8 c_ = {0x3c00, 0x3c00, 0x3c00, 0x3c00, 0x3c00, 0x3c00, 0x3c00, 0x3c00}; pa[0] = c_; pa[1] = c_; pa[2] = c_; pa[3] = c_; pb[0] = c_; pb[1] = c_; pb[2] = c_; pb[3] = c_; la += (f32x2v){a0[0], b0[0]}; }
#else
#if defined(PROBE_TIMER) && PROBE_TIMER == 4
        __builtin_amdgcn_sched_barrier(0); const unsigned long long pv0_ = __builtin_amdgcn_s_memtime(); __builtin_amdgcn_sched_barrier(0);
#endif
        attn_soft<MASK, false>(a0, a1, la, pa, mreca + pl_, sbit);
        attn_soft<MASK, false>(b0, b1, lb, pb, mrecb + pl_, sbit);
#if defined(PROBE_TIMER) && PROBE_TIMER == 4
        __builtin_amdgcn_sched_barrier(0); asm volatile("s_nop 0" : : "v"(pa[0]), "v"(pa[1]), "v"(pa[2]), "v"(pa[3]), "v"(pb[0]), "v"(pb[1]), "v"(pb[2]), "v"(pb[3]), "v"(la), "v"(lb)); psum_ += (unsigned)(__builtin_amdgcn_s_memtime() - pv0_); __builtin_amdgcn_sched_barrier(0);
#endif
#endif
#if defined(PROBE_TIMER) && PROBE_TIMER == 6
        __builtin_amdgcn_sched_barrier(0); asm volatile("s_nop 0" : : "v"(pa[0]), "v"(pa[3]), "v"(pb[0]), "v"(pb[3]), "v"(la), "v"(lb)); const unsigned long long pw0_ = __builtin_amdgcn_s_memtime();
#endif
        AT_BAR();
#if defined(PROBE_TIMER) && PROBE_TIMER == 6
        psum_ += (unsigned)(__builtin_amdgcn_s_memtime() - pw0_);
#endif
#if defined(PROBE_TIMER) && PROBE_TIMER == 5
        const unsigned long long pm0_ = __builtin_amdgcn_s_memtime();
#endif
        AT_DMA(t + 3, (t + 3) & 3);
        const LAS unsigned char* Vb = lds + AT_V + (t & 3) * 8192 + voff;
#pragma unroll
        for (int ks = 0; ks < 4; ++ks) {
            const bf16x8 v0 = cat8(vtr(Vb + ks * 1024), vtr(Vb + ks * 1024 + 512)), v1 = cat8(vtr(Vb + 4096 + ks * 1024), vtr(Vb + 4096 + ks * 1024 + 512));
            oa0 = __builtin_amdgcn_mfma_f32_32x32x16_bf16(pa[ks], v0, oa0, 0, 0, 0); ob0 = __builtin_amdgcn_mfma_f32_32x32x16_bf16(pb[ks], v0, ob0, 0, 0, 0);
            oa1 = __builtin_amdgcn_mfma_f32_32x32x16_bf16(pa[ks], v1, oa1, 0, 0, 0); ob1 = __builtin_amdgcn_mfma_f32_32x32x16_bf16(pb[ks], v1, ob1, 0, 0, 0);
        }
        if (t + 1 < nt) {
            const LAS unsigned char* Kb = lds + AT_K + ((t + 1) & 3) * 8192 + hi * 1024 + r * 16; const LAS float* bt = BT + (64 * (t + 1 - c) + 191 - r + 4 * hi);
            if (t + 1 < nfar) attn_qk<false>(a0, a1, b0, b1, Qb, Kb, bt); else attn_qk<true>(a0, a1, b0, b1, Qb, Kb, bt);
        }
#if defined(PROBE_TIMER) && PROBE_TIMER == 5
        asm volatile("s_nop 15\n\ts_nop 15" : : "v"(oa0), "v"(ob1), "v"(a0), "v"(b1)); psum_ += (unsigned)(__builtin_amdgcn_s_memtime() - pm0_);
#endif
#if defined(PROBE_TIMER) && PROBE_TIMER == 7
        __builtin_amdgcn_sched_barrier(0); asm volatile("s_nop 15\n\ts_nop 15" : : "v"(oa0), "v"(ob1), "v"(a0), "v"(b1)); const unsigned long long px0_ = __builtin_amdgcn_s_memtime();
#endif
        asm volatile("s_waitcnt vmcnt(2)" ::: "memory");
        AT_BAR();
#if defined(PROBE_TIMER) && PROBE_TIMER == 7
        psum_ += (unsigned)(__builtin_amdgcn_s_memtime() - px0_);
#endif
    }
#if defined(PROBE_TIMER) && PROBE_TIMER >= 4
    if (F.tid == 0 && nt >= 16) { volatile LAS unsigned* pm_ = (volatile LAS unsigned*)(lds + MISC_OFF); pm_[16] += psum_; pm_[17] += (unsigned)nt; }
#endif
#if defined(PROBE_TIMER) && PROBE_TIMER == 3
    if (F.tid == 0 && nt >= 16) { volatile LAS unsigned* pm_ = (volatile LAS unsigned*)(lds + MISC_OFF); pm_[16] += (unsigned)(__builtin_amdgcn_s_memtime() - pa0_); pm_[17] += (unsigned)nt; }
#endif
    asm volatile("s_waitcnt vmcnt(0)" ::: "memory");
    if (wid < 4) AT_BAR();
    AT_BAR();
#undef AT_BAR
#undef AT_DMA
    LAS float* wsf = (LAS float*)(lds + AT_WS) + wid * 64; LAS unsigned char* stg = lds + AT_OST + wid * 4608;
    attn_store(oa0, oa1, la, F.MIX() + (rowbase + q0) * DM + wid * 64, stg, wsf, lane);
    attn_store(ob0, ob1, lb, F.MIX() + (rowbase + q0 + 32) * DM + wid * 64, stg, wsf, lane);
}
__device__ __forceinline__ void attn_unit(const Frame& F, int b, int c, LAS unsigned char* lds) {
    if (c >= 4) {
        const int nj = c + 1;
        IdxOps ops; idx_fetch(ops, F, b, c, 0);
#if defined(PROBE_TIMER) && PROBE_TIMER >= 10
        unsigned ps_ = 0u;
#define PT0_(k) unsigned long long pt_##k = 0; if (PROBE_TIMER == (k)) { __builtin_amdgcn_sched_barrier(0); pt_##k = __builtin_amdgcn_s_memtime(); __builtin_amdgcn_sched_barrier(0); }
#define PT1_(k) if (PROBE_TIMER == (k)) { __builtin_amdgcn_sched_barrier(0); ps_ += (unsigned)(__builtin_amdgcn_s_memtime() - pt_##k); __builtin_amdgcn_sched_barrier(0); }
#else
#define PT0_(k)
#define PT1_(k)
#endif
        for (int rq = 0; rq < ((MIXREP & 2) ? 8 : 4); ++rq) {
            PT0_(10)
            idx_round(ops, F, b, c, lds);
            idx_fetch(ops, F, b, c, (rq + 1) & 3);
            asm volatile("s_waitcnt lgkmcnt(0)" ::: "memory");
            PT1_(10)
            PT0_(11)
            __syncthreads();
            PT1_(11)
            PT0_(12)
            select_rows32((const LAS float*)(lds + P2_SC), (LAS unsigned*)(lds + P2_MASK), rq & 3, nj, F.wave, F.lane);
            asm volatile("s_waitcnt lgkmcnt(0)" ::: "memory");
            PT1_(12)
            PT0_(13)
            __syncthreads();
            PT1_(13)
        }
#if defined(PROBE_TIMER) && PROBE_TIMER >= 10
        if (F.tid == 0 && c >= 15) { volatile LAS unsigned* pm_ = (volatile LAS unsigned*)(lds + MISC_OFF); pm_[16] += ps_; pm_[17] += 4u; }
#endif
#undef PT0_
#undef PT1_
    }
    { const f32x4 v = *(const f32x4*)(F.BT() + F.tid * 4); *(LAS f32x4*)(lds + AT_BT + F.tid * 16) = v; }
    __syncthreads();
    if (c >= 4) attn_chunk<true>(F, b, c, lds); else attn_chunk<false>(F, b, c, lds);
}

constexpr int RT_TAB = 131072;
__device__ __forceinline__ void ret_stage(const bf16* vsrc, const bf16* ksrc, LAS unsigned char* region) {
#pragma unroll
    for (int k = 0; k < 8; ++k) {
        const size_t o = (size_t)(16 * (k & 3)) * 512 + 32 * (k >> 2);
        __builtin_amdgcn_global_load_lds((const unsigned*)(vsrc + o), (LAS unsigned*)(region + k * 1024), 16, 0, 0);
        __builtin_amdgcn_global_load_lds((const unsigned*)(ksrc + o), (LAS unsigned*)(region + 8192 + k * 1024), 16, 0, 0);
    }
}
__device__ __forceinline__ void ret_kv(f32x16 (&T)[2][2], const LAS unsigned char* img) {
#pragma unroll
    for (int ks = 0; ks < 4; ++ks) {
        const bf16x8 k0 = cat8(vtr(img + 8192 + ks * 1024), vtr(img + 8192 + ks * 1024 + 512)), k1 = cat8(vtr(img + 8192 + 4096 + ks * 1024), vtr(img + 8192 + 4096 + ks * 1024 + 512));
        const bf16x8 v0 = cat8(vtr(img + ks * 1024), vtr(img + ks * 1024 + 512)), v1 = cat8(vtr(img + 4096 + ks * 1024), vtr(img + 4096 + ks * 1024 + 512));
        T[0][0] = __builtin_amdgcn_mfma_f32_32x32x16_bf16(k0, v0, T[0][0], 0, 0, 0); T[0][1] = __builtin_amdgcn_mfma_f32_32x32x16_bf16(k0, v1, T[0][1], 0, 0, 0);
        T[1][0] = __builtin_amdgcn_mfma_f32_32x32x16_bf16(k1, v0, T[1][0], 0, 0, 0); T[1][1] = __builtin_amdgcn_mfma_f32_32x32x16_bf16(k1, v1, T[1][1], 0, 0, 0);
    }
}
__device__ __forceinline__ void ret_unit(const Frame& F, int b, int h, LAS unsigned char* lds) {
    const int lane = F.lane, w = F.wave, r = lane & 31, hi = lane >> 5;
    const float gam = 1.0f - exp2f(-5.0f - (float)h), lg2 = log2f(gam), cd = exp2f(64.0f * lg2), cd4 = exp2f(256.0f * lg2);
    LAS unsigned char* region = lds + w * 16384;
    const LAS unsigned char* img = region + ((lane >> 4) & 1) * 32 + (lane & 3) * 8 + (4 * hi + ((lane & 15) >> 2)) * 64;
    LAS float* tab = (LAS float*)(lds + RT_TAB);
    __syncthreads();
    if (F.tid < 128) tab[F.tid] = F.tid < 64 ? F.ret_gn_w()[h * 64 + F.tid] : F.ret_gn_b()[h * 64 + F.tid - 64];
    const size_t hbase = (size_t)b * SEQ * 512 + h * 64;
    const size_t stg = hbase + (size_t)(lane >> 2) * 512 + (lane & 3) * 8;
    f32x16 T[2][2];
#pragma unroll
    for (int i = 0; i < 16; ++i) { T[0][0][i] = 0.f; T[0][1][i] = 0.f; T[1][0][i] = 0.f; T[1][1][i] = 0.f; }
#pragma unroll 1
    for (int i = 0; i < 4; ++i) {
        const size_t co = (size_t)(4 * w + i) * 64 * 512;
        ret_stage(F.VB() + stg + co, F.KB() + stg + co, region);
        if (i) {
#pragma unroll
            for (int k = 0; k < 16; ++k) { T[0][0][k] *= cd; T[0][1][k] *= cd; T[1][0][k] *= cd; T[1][1][k] *= cd; }
        }
        asm volatile("s_waitcnt vmcnt(0)" ::: "memory");
        ret_kv(T, img);
        LDS_WAIT();
    }
#pragma unroll
    for (int eb = 0; eb < 2; ++eb)
#pragma unroll
        for (int db = 0; db < 2; ++db)
#pragma unroll
            for (int g = 0; g < 4; ++g) *(LAS f32x4*)(region + ((eb * 2 + db) * 4 + g) * 1024 + lane * 16) = (f32x4){T[eb][db][4 * g], T[eb][db][4 * g + 1], T[eb][db][4 * g + 2], T[eb][db][4 * g + 3]};
    __syncthreads();
#pragma unroll
    for (int i = 0; i < 16; ++i) { T[0][0][i] = 0.f; T[0][1][i] = 0.f; T[1][0][i] = 0.f; T[1][1][i] = 0.f; }
#pragma unroll 1
    for (int wp = 0; wp < w; ++wp) {
        const LAS unsigned char* src = lds + wp * 16384 + lane * 16;
#pragma unroll
        for (int eb = 0; eb < 2; ++eb)
#pragma unroll
            for (int db = 0; db < 2; ++db)
#pragma unroll
                for (int g = 0; g < 4; ++g) { const f32x4 v = *(const LAS f32x4*)(src + ((eb * 2 + db) * 4 + g) * 1024);
                    T[eb][db][4 * g] = T[eb][db][4 * g] * cd4 + v[0]; T[eb][db][4 * g + 1] = T[eb][db][4 * g + 1] * cd4 + v[1]; T[eb][db][4 * g + 2] = T[eb][db][4 * g + 2] * cd4 + v[2]; T[eb][db][4 * g + 3] = T[eb][db][4 * g + 3] * cd4 + v[3]; }
    }
    __syncthreads();
#pragma unroll 1
    for (int i = 0; i < 4; ++i) {
        const int n = 4 * w + i; const size_t co = (size_t)n * 64 * 512;
        ret_stage(F.VB() + stg + co, F.KB() + stg + co, region);
#pragma unroll
        for (int k = 0; k < 16; ++k) { T[0][0][k] *= cd; T[0][1][k] *= cd; T[1][0][k] *= cd; T[1][1][k] *= cd; }
        const bf16* qrow = F.QB() + hbase + co + (size_t)r * 512 + 8 * hi;
        const bf16* krow = F.KB() + hbase + co + (size_t)r * 512 + 8 * hi;
#pragma unroll 1
        for (int ib = 0; ib < 2; ++ib) {
            bf16x8 qf[4], kf[4];
#pragma unroll
            for (int s = 0; s < 4; ++s) { qf[s] = *(const bf16x8*)(qrow + (size_t)(32 * ib) * 512 + 16 * s); kf[s] = *(const bf16x8*)(krow + 16 * s); }
            const size_t tok = (size_t)b * SEQ + 64 * n + 32 * ib + r;
            const bf16* grow = F.GB() + tok * 512 + h * 64 + 4 * hi;
            v2u gq[2][4];
#pragma unroll
            for (int db = 0; db < 2; ++db)
#pragma unroll
                for (int g = 0; g < 4; ++g) gq[db][g] = *(const v2u*)(grow + 32 * db + 8 * g);
            f32x16 s0, s1;
#pragma unroll
            for (int k = 0; k < 16; ++k) { s0[k] = 0.f; s1[k] = 0.f; }
#pragma unroll
            for (int s = 0; s < 4; ++s) s0 = __builtin_amdgcn_mfma_f32_32x32x16_bf16(kf[s], qf[s], s0, 0, 0, 0);
            if (ib == 1) {
#pragma unroll
                for (int s = 0; s < 4; ++s) kf[s] = *(const bf16x8*)(krow + (size_t)32 * 512 + 16 * s);
#pragma unroll
                for (int s = 0; s < 4; ++s) s1 = __builtin_amdgcn_mfma_f32_32x32x16_bf16(kf[s], qf[s], s1, 0, 0, 0);
#pragma unroll
                for (int k = 0; k < 16; ++k) s1[k] = (r >= crow(k, hi)) ? s1[k] : 0.f;
            } else {
#pragma unroll
                for (int k = 0; k < 16; ++k) s0[k] = (r >= crow(k, hi)) ? s0[k] : 0.f;
            }
#pragma unroll
            for (int s = 0; s < 4; ++s) {
                v4u q4 = __builtin_bit_cast(v4u, qf[s]);
                auto x0 = __builtin_amdgcn_permlane32_swap(q4[0], q4[2], false, false); auto x1 = __builtin_amdgcn_permlane32_swap(q4[1], q4[3], false, false);
                q4[0] = x0[0]; q4[2] = x0[1]; q4[1] = x1[0]; q4[3] = x1[1];
                qf[s] = __builtin_bit_cast(bf16x8, q4);
            }
            asm volatile("s_waitcnt vmcnt(0)" ::: "memory");
            f32x16 y0, y1;
#pragma unroll
            for (int k = 0; k < 16; ++k) { y0[k] = 0.f; y1[k] = 0.f; }
#pragma unroll
            for (int eb = 0; eb < 2; ++eb)
#pragma unroll
                for (int s2 = 0; s2 < 2; ++s2) {
                    y0 = __builtin_amdgcn_mfma_f32_32x32x16_bf16(pk16(T[eb][0], 8 * s2), qf[2 * eb + s2], y0, 0, 0, 0);
                    y1 = __builtin_amdgcn_mfma_f32_32x32x16_bf16(pk16(T[eb][1], 8 * s2), qf[2 * eb + s2], y1, 0, 0, 0);
                }
#pragma unroll
            for (int ks = 0; ks < 2; ++ks) {
                const bf16x8 pb = pk16(s0, 8 * ks);
                y0 = __builtin_amdgcn_mfma_f32_32x32x16_bf16(cat8(vtr(img + ks * 1024), vtr(img + ks * 1024 + 512)), pb, y0, 0, 0, 0);
                y1 = __builtin_amdgcn_mfma_f32_32x32x16_bf16(cat8(vtr(img + 4096 + ks * 1024), vtr(img + 4096 + ks * 1024 + 512)), pb, y1, 0, 0, 0);
            }
            if (ib == 1) {
#pragma unroll
                for (int ks = 0; ks < 2; ++ks) {
                    const bf16x8 pb = pk16(s1, 8 * ks);
                    y0 = __builtin_amdgcn_mfma_f32_32x32x16_bf16(cat8(vtr(img + (2 + ks) * 1024), vtr(img + (2 + ks) * 1024 + 512)), pb, y0, 0, 0, 0);
                    y1 = __builtin_amdgcn_mfma_f32_32x32x16_bf16(cat8(vtr(img + 4096 + (2 + ks) * 1024), vtr(img + 4096 + (2 + ks) * 1024 + 512)), pb, y1, 0, 0, 0);
                }
            }
            float sm = 0.f;
#pragma unroll
            for (int k = 0; k < 16; ++k) sm += y0[k] + y1[k];
            sm += __shfl_xor(sm, 32);
            const float mean = sm * (1.0f / 64.0f); float vr = 0.f;
#pragma unroll
            for (int k = 0; k < 16; ++k) { y0[k] -= mean; y1[k] -= mean; vr += y0[k] * y0[k] + y1[k] * y1[k]; }
            vr += __shfl_xor(vr, 32);
            const float rstd = 1.0f / sqrtf(vr * (1.0f / 64.0f) + 1e-5f);
            bf16* orow = F.MIX() + tok * DM + 512 + h * 64 + 4 * hi;
#pragma unroll
            for (int g = 0; g < 4; ++g) {
                const f32x4 w0 = *(const LAS f32x4*)(tab + 8 * g + 4 * hi), b0 = *(const LAS f32x4*)(tab + 64 + 8 * g + 4 * hi), w1 = *(const LAS f32x4*)(tab + 32 + 8 * g + 4 * hi), b1 = *(const LAS f32x4*)(tab + 96 + 8 * g + 4 * hi);
                const v2u g0 = gq[0][g], g1 = gq[1][g];
                *(v2u*)(orow + 8 * g) = (v2u){pkbf((y0[4 * g] * rstd * w0[0] + b0[0]) * bflo(g0[0]), (y0[4 * g + 1] * rstd * w0[1] + b0[1]) * bfhi(g0[0])),
                                              pkbf((y0[4 * g + 2] * rstd * w0[2] + b0[2]) * bflo(g0[1]), (y0[4 * g + 3] * rstd * w0[3] + b0[3]) * bfhi(g0[1]))};
                *(v2u*)(orow + 32 + 8 * g) = (v2u){pkbf((y1[4 * g] * rstd * w1[0] + b1[0]) * bflo(g1[0]), (y1[4 * g + 1] * rstd * w1[1] + b1[1]) * bfhi(g1[0])),
                                                   pkbf((y1[4 * g + 2] * rstd * w1[2] + b1[2]) * bflo(g1[1]), (y1[4 * g + 3] * rstd * w1[3] + b1[3]) * bfhi(g1[1]))};
            }
        }
        ret_kv(T, img);
        LDS_WAIT();
    }
}
#ifndef GEMM_ALIGN
#define GEMM_ALIGN true
#endif
#ifndef GEMM_SP2
#define GEMM_SP2 true
#endif
#ifndef RETREP
#define RETREP 1
#endif
#ifndef ATTREP
#define ATTREP 1
#endif
constexpr int N_RET = BATCH * 8 * RETREP, N_ATT = BATCH * 32 * ATTREP, N_MIX = N_RET + N_ATT;
__device__ __forceinline__ void p2_mixers(Frame& F) {
    for (;;) {
        int mo_ = MISC_OFF; asm volatile("" : "+s"(mo_));
        volatile LAS unsigned* misc = (volatile LAS unsigned*)(F.lds + mo_);
        __syncthreads();
        if (F.tid == 0) misc[0] = __hip_atomic_fetch_add(F.ctl, 1u, __ATOMIC_RELAXED, __HIP_MEMORY_SCOPE_AGENT);
        __syncthreads();
        const int u = (int)misc[0];
        if (u >= N_MIX) break;
        { int w_ = F.wave; asm volatile("" : "+s"(w_)); F.wave = w_; int l_ = lane_id(); asm volatile("" : "+v"(l_)); F.lane = l_; F.tid = w_ * 64 + l_; }
        constexpr int N_HEAD = 256 * ATTREP;
        if (u < N_HEAD) { const int a = u / ATTREP; attn_unit(F, a & 31, 31 - (a >> 5), F.lds); }
        else if (u < N_HEAD + N_RET) { const int ru = (u - N_HEAD) / RETREP; ret_unit(F, ru >> 3, ru & 7, F.lds); }
        else { const int a = (u - N_RET) / ATTREP; attn_unit(F, a & 31, 31 - (a >> 5), F.lds); }
    }
#if defined(PROBE_TIMER) && PROBE_TIMER >= 3
    if (blockIdx.x == 7 && F.tid == 0) { volatile LAS unsigned* pm_ = (volatile LAS unsigned*)(F.lds + MISC_OFF); const float val = ((float)pm_[16] / (float)(pm_[17] ? pm_[17] : 1u)) / 8000.0f;
        F.ctl[64] = __float_as_uint(0.05f + 0.5f * floorf(fminf(fmaxf(val, 0.f), 1.f) * 8.0f + 0.5f) * 0.125f); }
#endif
}

typedef __attribute__((address_space(1))) unsigned gu32;
#define XB_TMO      128
#define XB_XCNT(j)  (256  + 64 * (j))
#define XB_XSUB(j)  (1280 + 64 * (j))
#define XB_XGEN(j)  (2304 + 64 * (j))
#define XB_TOP      3328
#define XB_TOPGEN   3392
#define XCD_BAR_WORDS 3456
#define XB_SPIN_CAP (1u << 18)

__device__ __forceinline__ unsigned xb_ld(unsigned* p)              { return __hip_atomic_load(p, __ATOMIC_RELAXED, __HIP_MEMORY_SCOPE_AGENT); }
__device__ __forceinline__ unsigned xb_add(unsigned* p, unsigned v) { return __hip_atomic_fetch_add(p, v, __ATOMIC_RELAXED, __HIP_MEMORY_SCOPE_AGENT); }
__device__ __forceinline__ unsigned xb_xcc_id() { return (unsigned)__builtin_amdgcn_s_getreg((3 << 11) | 20) & 0xFu; }
#define XB_SPIN(cond, bar) do { unsigned _sp = 0; while (cond) { __builtin_amdgcn_s_sleep(1); \
    if ((++_sp & 255u) == 0u) { if (xb_ld(&(bar)[XB_TMO])) break; if (_sp > XB_SPIN_CAP) { atomicAdd(&(bar)[XB_TMO], 1u); break; } } } } while (0)

struct XcdBarrier {
    unsigned* bar; unsigned x; int wv;
    volatile LAS unsigned* st;
};

__device__ __forceinline__ XcdBarrier xcd_barrier_post(unsigned* bar, volatile LAS unsigned* st, int wv_) {
    XcdBarrier b; b.bar = bar; b.x = xb_xcc_id(); b.st = st; b.wv = 0;
    if (wv_ == 0 && lane_id() == 0) (void)xb_add(&bar[XB_XCNT(b.x)], 1u);
    return b;
}
__device__ __forceinline__ void xcd_barrier_complete(unsigned* bar, unsigned x, unsigned& nloc, unsigned& nx) {
    const unsigned G = gridDim.x * gridDim.y * gridDim.z;
    unsigned sum, cnt, mine, sp = 0u;
    for (;;) {
        sum = 0u; cnt = 0u; mine = 0u;
#pragma unroll
        for (unsigned j = 0; j < 16; ++j) { const unsigned c = xb_ld(&bar[XB_XCNT(j)]); sum += c; cnt += (c > 0u) ? 1u : 0u; mine = (j == x) ? c : mine; }
        if (sum == G) break;
        __builtin_amdgcn_s_sleep(1);
        if ((++sp & 255u) == 0u) { if (xb_ld(&bar[XB_TMO])) break; if (sp > XB_SPIN_CAP) { atomicAdd(&bar[XB_TMO], 1u); break; } }
    }
    nloc = mine > 0u ? mine : 1u; nx = cnt > 0u ? cnt : 1u;
}

__device__ __forceinline__ void xcd_barrier(const XcdBarrier& b) {
    asm volatile("s_waitcnt vmcnt(0)" ::: "memory");
    __syncthreads();
    if (b.wv == 0 && lane_id() == 0) {
        unsigned* bar = b.bar;
        __builtin_amdgcn_s_waitcnt(0);
        unsigned nloc = b.st[0], nx = b.st[1];
        if (nloc == 0u) { xcd_barrier_complete(bar, b.x, nloc, nx); b.st[0] = nloc; b.st[1] = nx; }
        const unsigned old = xb_add(&bar[XB_XSUB(b.x)], 1u);
        const unsigned gen = old / nloc;
        if (old + 1u == (gen + 1u) * nloc) {
            __builtin_amdgcn_fence(__ATOMIC_RELEASE, "agent");
            asm volatile("s_waitcnt vmcnt(0)" ::: "memory");
            const unsigned og = xb_add(&bar[XB_TOP], 1u);
            const unsigned tg = og / nx;
            if (og + 1u == (tg + 1u) * nx) xb_add(&bar[XB_TOPGEN], 1u);
            else XB_SPIN(xb_ld(&bar[XB_TOPGEN]) == tg, bar);
            __builtin_amdgcn_fence(__ATOMIC_ACQUIRE, "agent");
            xb_add(&bar[XB_XGEN(b.x)], 1u);
            asm volatile("s_waitcnt vmcnt(0)" ::: "memory");
        } else {
            XB_SPIN(xb_ld(&bar[XB_XGEN(b.x)]) == gen, bar);
            __builtin_amdgcn_fence(__ATOMIC_ACQUIRE, "agent");
            asm volatile("s_waitcnt vmcnt(0)" ::: "memory");
        }
    }
    __syncthreads();
}

constexpr int CW_BAR = 4096;
constexpr size_t CTL_ZERO_BYTES = 65536;
typedef KArgs Args;
__global__ void __launch_bounds__(NTHR, 2) fwd_kernel(Args args) {
    extern __shared__ __attribute__((aligned(16))) unsigned char lds[];
    Frame F;
    F.lds = (LAS unsigned char*)lds;
    F.wave = __builtin_amdgcn_readfirstlane((int)threadIdx.x >> 6); F.lane = lane_id(); F.tid = F.wave * 64 + F.lane;
    F.G = gridDim.x; { const int bx = blockIdx.x; F.vcu = (F.G % 8 == 0) ? (bx % 8) * (F.G / 8) + bx / 8 : bx; }
    unsigned char* ws = args.ws;
    F.ctl = (unsigned*)(ws + WS_CTL);
    F.ap = (const __attribute__((address_space(4))) KArgs*)__builtin_amdgcn_kernarg_segment_ptr();
    F.ws = ws;
    const int lo = args.ph_lo, hi = args.ph_hi;
    for (int u_ = F.tid; u_ < 64; u_ += NTHR) ((LAS unsigned*)(F.lds + MISC_OFF))[u_] = 0u;
    __syncthreads();
    XcdBarrier bar; bar.bar = F.ctl + CW_BAR; bar.x = 0; bar.st = nullptr; bar.wv = F.wave;
    if (hi - lo > 1) { bar = xcd_barrier_post(F.ctl + CW_BAR, (volatile LAS unsigned*)(F.lds + MISC_OFF) + 8, F.wave); bar.wv = F.wave; }
#ifndef PHSEL
#define PHSEL 63
#endif
#define IN(k) (((PHSEL >> (k)) & 1) && lo <= (k) && (k) < hi)
#ifndef REPEAT_PHASE
#define REPEAT_PHASE -1
#endif
#define REPS(k) ((REPEAT_PHASE == (k)) ? 2 : 1)
#define SEAM(k) do { if (IN(k) && IN((k) + 1)) { if ((k) == 0 && lo < 0) cg::this_grid().sync(); else xcd_barrier(bar); } } while (0)

    for (int rep_ = 0; rep_ < REPS(0); ++rep_) { if (rep_) cg::this_grid().sync();
    if (IN(0)) { asm volatile("" : "+s"(F.ws), "+s"(F.ap)); F.lane = lane_id(); F.tid = F.wave * 64 + F.lane; p0_prologue(F); }
    }
    SEAM(0);
    for (int rep_ = 0; rep_ < REPS(1); ++rep_) { if (rep_) cg::this_grid().sync();
    if (IN(1)) { asm volatile("" : "+s"(F.ws), "+s"(F.ap)); F.lane = lane_id(); F.tid = F.wave * 64 + F.lane;
        pg8::Gemm g{F.XB(), F.WIN(), MTOK, NIN, DM}; pg8::StaticOrder S; S.init(MTOK, NIN, F.G, (int)blockIdx.x);
        pg8::EpiIn E{F.QA(), F.KA(), F.VA(), F.IQ(), F.IK(), F.QB(), F.KB(), F.VB(), F.GB(), F.IW(), F.q_norm_w(), F.k_norm_w(), (LAS float*)(F.lds + XCH_OFF)};
        pg8::gemm_phase<pg8::EpiIn, pg8::StaticOrder, GEMM_ALIGN, GEMM_SP2>(F.lds, g, S, E, F.wave);
    }
    }
    SEAM(1);
    for (int rep_ = 0; rep_ < REPS(2); ++rep_) { if (rep_) { cg::this_grid().sync(); if (blockIdx.x == 0 && F.tid == 0) F.ctl[0] = 0u; cg::this_grid().sync(); }
    if (IN(2)) { asm volatile("" : "+s"(F.ws), "+s"(F.ap)); F.lane = lane_id(); F.tid = F.wave * 64 + F.lane; p2_mixers(F); }
    }
    SEAM(2);
    for (int rep_ = 0; rep_ < REPS(3); ++rep_) { if (rep_) cg::this_grid().sync();
    if (IN(3)) { asm volatile("" : "+s"(F.ws), "+s"(F.ap)); F.lane = lane_id(); F.tid = F.wave * 64 + F.lane;
        pg8::Gemm g{F.MIX(), F.WOUT(), MTOK, DM, DM}; pg8::PanelOrder S{(int)blockIdx.x, 4};
        pg8::EpiOut E{F.RMS(), F.XB(), {0.f, 0.f, 0.f, 0.f, 0.f, 0.f, 0.f, 0.f}};
        if ((int)blockIdx.x < MTOK / 256) {
            pg8::gemm_phase<pg8::EpiOut, pg8::PanelOrder, true, true>(F.lds, g, S, E, F.wave);
            const int wr = F.wave >> 2, wc = F.wave & 3, fr = F.lane & 15, fq = F.lane >> 4;
            LAS float* P = (LAS float*)(F.lds + XCH_OFF);
#pragma unroll
            for (int k = 0; k < 8; ++k) { float s = E.ss[k]; s += __shfl_xor(s, 16); s += __shfl_xor(s, 32);
                if (fq == 0) P[((k >> 2) * 128 + wr * 64 + (k & 3) * 16 + fr) * 4 + wc] = s; }
            __syncthreads();
            if (F.tid < 256) { const f32x4 p = *(const LAS f32x4*)(P + F.tid * 4);
                F.R2()[(size_t)blockIdx.x * 256 + F.tid] = 1.0f / sqrtf(((p[0] + p[1]) + (p[2] + p[3])) * (1.0f / DM) + 1e-6f); }
        }
    }
    }
    SEAM(3);
    for (int rep_ = 0; rep_ < REPS(4); ++rep_) { if (rep_) cg::this_grid().sync();
    if (IN(4)) { asm volatile("" : "+s"(F.ws), "+s"(F.ap)); F.lane = lane_id(); F.tid = F.wave * 64 + F.lane;
#if defined(PROBE_TIMER) && PROBE_TIMER < 3
        const unsigned long long pt0_ = __builtin_amdgcn_s_memtime(), pr0_ = __builtin_amdgcn_s_memrealtime();
#endif
        pg8::Gemm g{F.XB(), F.WGU(), MTOK, NGU, DM}; pg8::StaticOrder S; S.init(MTOK, NGU, F.G, (int)blockIdx.x);
        pg8::EpiGU E{F.R2(), F.ACT(), {0.f, 0.f, 0.f, 0.f}, {0.f, 0.f, 0.f, 0.f}, {0.f, 0.f, 0.f, 0.f}, {0.f, 0.f, 0.f, 0.f}, 0ull};
        pg8::gemm_phase<pg8::EpiGU, pg8::StaticOrder, GEMM_ALIGN, GEMM_SP2>(F.lds, g, S, E, F.wave);
#if defined(PROBE_TIMER) && PROBE_TIMER < 3
        if (blockIdx.x == 7 && F.tid == 0) { const unsigned long long pt1_ = __builtin_amdgcn_s_memtime(), pr1_ = __builtin_amdgcn_s_memrealtime();
#if PROBE_TIMER == 1
            const float val = ((float)(pt1_ - pt0_) / ((float)(pr1_ - pr0_) * 10.0f) - 1.4f);
#else
            const float val = (float)E.tepi / (float)(pt1_ - pt0_);
#endif
            const float frac = 0.05f + 0.5f * floorf(fminf(fmaxf(val, 0.f), 1.f) * 8.0f + 0.5f) * 0.125f;
            F.ctl[64] = __float_as_uint(frac); }
#endif
    }
    }
    SEAM(4);
    for (int rep_ = 0; rep_ < REPS(5); ++rep_) { if (rep_) cg::this_grid().sync();
    if (IN(5)) { asm volatile("" : "+s"(F.ws), "+s"(F.ap)); F.lane = lane_id(); F.tid = F.wave * 64 + F.lane;
        pg8::Gemm g{F.ACT(), F.WDN(), MTOK, DM, FF}; pg8::StaticOrder S; S.init(MTOK, DM, F.G, (int)blockIdx.x);
        pg8::EpiDown E{F.XB(), F.out()};
        pg8::gemm_phase<pg8::EpiDown, pg8::StaticOrder, GEMM_ALIGN, GEMM_SP2>(F.lds, g, S, E, F.wave);
    }
    }
#ifdef PROBE_TIMER
    xcd_barrier(bar);
    { const float frac = __uint_as_float(__hip_atomic_load(F.ctl + 64, __ATOMIC_RELAXED, __HIP_MEMORY_SCOPE_AGENT)); const int nz = (int)(frac * (float)MTOK);
      for (int m = (int)blockIdx.x * NWAVES + F.wave; m < nz; m += F.G * NWAVES) { f32x4* o = (f32x4*)(F.out() + (size_t)m * DM) + F.lane;
#pragma unroll
          for (int j = 0; j < 4; ++j) o[64 * j] = (f32x4){0.f, 0.f, 0.f, 0.f}; } }
#endif
#undef IN
#undef SEAM
}

extern "C" void kernel_launch(void* const* d_in, const int* in_sizes, int n_in, void* d_out, int out_size, void* d_ws, size_t ws_size, hipStream_t stream) {
    static int grid = 0;
    if (grid == 0) {
        if (n_in != 16 || in_sizes[0] != MTOK * DM || out_size != MTOK * DM || ws_size < WS_END) {
            fprintf(stderr, "kernel_launch: unexpected problem (n_in %d, in0 %d, out %d, ws %zu); nothing launched\n", n_in, n_in > 0 ? in_sizes[0] : -1, out_size, ws_size); grid = -1; return; }
        int dev = 0, cus = 0, per_cu = 0;
        if (hipGetDevice(&dev) != hipSuccess || hipDeviceGetAttribute(&cus, hipDeviceAttributeMultiprocessorCount, dev) != hipSuccess) { grid = -1; return; }
        if (hipFuncSetAttribute((const void*)fwd_kernel, hipFuncAttributeMaxDynamicSharedMemorySize, LDS_BYTES) != hipSuccess) { fprintf(stderr, "kernel_launch: hipFuncSetAttribute failed\n"); grid = -1; return; }
        if (hipOccupancyMaxActiveBlocksPerMultiprocessor(&per_cu, (const void*)fwd_kernel, NTHR, LDS_BYTES) != hipSuccess || per_cu < 1) { fprintf(stderr, "kernel_launch: occupancy query says %d blocks per CU\n", per_cu); (void)hipGetLastError(); grid = -1; return; }
        grid = cus;
        if (grid != 256) fprintf(stderr, "kernel_launch: %d CUs; this kernel is laid out for 256\n", grid);
    }
    if (grid < 0) return;
    if (hipMemsetAsync((char*)d_ws + WS_CTL, 0, CTL_ZERO_BYTES, stream) != hipSuccess) { fprintf(stderr, "kernel_launch: memset failed\n"); return; }
    Args a{};
    for (int i = 0; i < 16; ++i) a.in[i] = (const float*)d_in[i];
    a.out = (float*)d_out; a.ws = (unsigned char*)d_ws;
#if MK_N_LAUNCHES == 1
    a.ph_lo = 0; a.ph_hi = N_PHASES;
    void* kargs[] = {&a};
    hipError_t e = hipLaunchCooperativeKernel((const void*)fwd_kernel, dim3(grid), dim3(NTHR), kargs, LDS_BYTES, stream);
    if (e != hipSuccess) fprintf(stderr, "kernel_launch: cooperative launch failed: %s (grid %d)\n", hipGetErrorString(e), grid);
#else
    for (int p = 0; p < N_PHASES; ++p) { a.ph_lo = p; a.ph_hi = p + 1; hipLaunchKernelGGL(fwd_kernel, dim3(grid), dim3(NTHR), LDS_BYTES, stream, a); }
#endif
}
```

```cpp
#include <hip/hip_runtime.h>
#include <hip/hip_cooperative_groups.h>
#include <cstdio>
#include <cstdint>
namespace cg = cooperative_groups;
namespace pg8 {
#define PG8_LAS __attribute__((address_space(3)))
typedef unsigned short bf16_t;
typedef short bf16x8 __attribute__((ext_vector_type(8)));
typedef float f32x4 __attribute__((ext_vector_type(4)));
typedef unsigned u32x4 __attribute__((ext_vector_type(4)));
constexpr int BM = 256, BK = 64, HALF = 128, HTB = HALF * BK * 2  , STAGE_BYTES = 8 * HTB, NXCD = 8, WGM = 8;

__host__ __device__ __forceinline__ int lds_byte(int r, int c) { const int st = (r >> 4) * 2 + (c >> 5), rr = r & 15, cc = c & 31, ob = rr * 64 + cc * 2; return st * 1024 + (ob ^ (((ob >> 9) & 1) << 5)); }
__host__ __device__ __forceinline__ void stage_rc(int b, int& R, int& C) { const int st = b / 1024, sb = b % 1024, swz = sb ^ (((sb >> 9) & 1) << 5); R = (st >> 1) * 16 + swz / 64; C = (st & 1) * 32 + (swz % 64) / 2; }
__host__ __device__ __forceinline__ int perm32(int rho) { const int n = rho >> 4, i = rho & 15; return 8 * (i >> 2) + 4 * n + (i & 3); }

struct Unit { int pm, pn; };
struct Gemm { const bf16_t* A; const bf16_t* Bt; int M, N, K; };

struct StaticOrder {
    int nM, nN, nwg, G, c;
    __host__ __device__ void init(int M, int N, int G_, int c_) { nM = M / BM; nN = N / BM; nwg = nM * nN; G = G_; c = c_; }
    __host__ __device__ bool next(int i, Unit& u) const {
        const long L = (long)i * G + c; if (L >= nwg) return false;
        int wgid = (int)L; { const int q = nwg / NXCD, r = nwg % NXCD, xcd = wgid % NXCD, off = wgid / NXCD; wgid = (xcd < r ? xcd * (q + 1) : r * (q + 1) + (xcd - r) * q) + off; }
        const int nig = WGM * nN, gid = wgid / nig, fm = gid * WGM, gsz = (nM - fm) < WGM ? (nM - fm) : WGM;
        u.pm = fm + ((wgid % nig) % gsz); u.pn = (wgid % nig) / gsz; return true;
    }
    __device__ __forceinline__ void a_ready(const Unit&) const {}
    __device__ __forceinline__ void done(const Unit&) const {}
};

__device__ __forceinline__ unsigned cvt_pk_bf16(float lo, float hi) { unsigned r; asm volatile("v_cvt_pk_bf16_f32 %0, %1, %2" : "=v"(r) : "v"(lo), "v"(hi)); return r; }
typedef float f32x2 __attribute__((ext_vector_type(2)));
typedef __bf16 bf16x2_t __attribute__((ext_vector_type(2)));
typedef unsigned u32x2 __attribute__((ext_vector_type(2)));
__device__ __forceinline__ unsigned pkbf(float lo, float hi) { f32x2 v = {lo, hi}; bf16x2_t b = __builtin_convertvector(v, bf16x2_t); return __builtin_bit_cast(unsigned, b); }
__device__ __forceinline__ u32x4 pk8(f32x4 a, f32x4 b) { return (u32x4){pkbf(a[0], a[1]), pkbf(a[2], a[3]), pkbf(b[0], b[1]), pkbf(b[2], b[3])}; }
__device__ __forceinline__ float dot4(f32x4 a) { return (a[0] * a[0] + a[1] * a[1]) + (a[2] * a[2] + a[3] * a[3]); }
__device__ __forceinline__ float sum4(f32x4 a) { return (a[0] + a[1]) + (a[2] + a[3]); }
__device__ __forceinline__ float silu1(float v) { return v * __builtin_amdgcn_rcpf(1.0f + __builtin_amdgcn_exp2f(-1.4426950408889634f * v)); }
__device__ __forceinline__ f32x4 silu4(f32x4 v) { return (f32x4){silu1(v[0]), silu1(v[1]), silu1(v[2]), silu1(v[3])}; }
constexpr float RMS_EPS_F = 1e-6f;
constexpr float QSCALE = 0.125f * 1.4426950408889634f;

struct EpiIn {
    static constexpr bool PERM = true, AFTER_DRAIN = false;
    bf16_t *QA, *KA, *VA, *IQ, *IK, *QB, *KB, *VB, *GB; float* IW;
    const float *qnw, *knw;
    PG8_LAS float* xch;
    __device__ __forceinline__ void prefetch(const Unit&, int, int) {}
    __device__ __forceinline__ void advance() {}
    __device__ __forceinline__ void operator()(const f32x4 (&acc)[2][2][4][2], const Unit& u, int wr, int wc, int fr, int fq) {
        asm volatile("" : "+v"(fr), "+v"(fq));
        const int row0 = u.pm * BM + wr * 64 + fr, pn = u.pn;
        if (pn < 2) {
            const int head = 4 * pn + wc;
            const f32x4 w0 = *(const f32x4*)(qnw + 8 * fq), w1 = *(const f32x4*)(qnw + 8 * fq + 4), w2 = *(const f32x4*)(qnw + 32 + 8 * fq), w3 = *(const f32x4*)(qnw + 36 + 8 * fq);
#pragma unroll
            for (int ai = 0; ai < 2; ++ai)
#pragma unroll
                for (int m = 0; m < 4; ++m) {
                    f32x4 a0 = acc[ai][0][m][0], a1 = acc[ai][0][m][1], b0 = acc[ai][1][m][0], b1 = acc[ai][1][m][1];
                    float ss = (dot4(a0) + dot4(a1)) + (dot4(b0) + dot4(b1));
                    ss += __shfl_xor(ss, 16); ss += __shfl_xor(ss, 32);
                    const float rs = QSCALE / sqrtf(ss * (1.0f / 64.0f) + RMS_EPS_F);
                    bf16_t* p = QA + (size_t)(row0 + ai * HALF + m * 16) * 512 + head * 64 + 8 * fq;
                    *(u32x4*)p = pk8(a0 * w0 * rs, a1 * w1 * rs); *(u32x4*)(p + 32) = pk8(b0 * w2 * rs, b1 * w3 * rs);
                }
        } else if (pn == 2) {
            if (wc >= 2) {
#pragma unroll
                for (int ai = 0; ai < 2; ++ai)
#pragma unroll
                    for (int m = 0; m < 4; ++m) {
                        float ss = (dot4(acc[ai][0][m][0]) + dot4(acc[ai][0][m][1])) + (dot4(acc[ai][1][m][0]) + dot4(acc[ai][1][m][1]));
                        ss += __shfl_xor(ss, 16); ss += __shfl_xor(ss, 32);
                        if (fq == 0) xch[(ai * HALF + wr * 64 + m * 16 + fr) * 2 + (wc - 2)] = ss;
                    }
            }
            asm volatile("s_waitcnt lgkmcnt(0)" ::: "memory"); __builtin_amdgcn_s_barrier(); asm volatile("" ::: "memory");
            if (wc < 2) {
                const f32x4 w0 = *(const f32x4*)(knw + 8 * fq), w1 = *(const f32x4*)(knw + 8 * fq + 4), w2 = *(const f32x4*)(knw + 32 + 8 * fq), w3 = *(const f32x4*)(knw + 36 + 8 * fq);
#pragma unroll
                for (int ai = 0; ai < 2; ++ai)
#pragma unroll
                    for (int m = 0; m < 4; ++m) {
                        const int rl = ai * HALF + wr * 64 + m * 16 + fr;
                        const f32x2 pr = *(const PG8_LAS f32x2*)(xch + rl * 2);
                        const float rc = 1.0f / sqrtf((pr[0] + pr[1]) * (1.0f / 128.0f) + RMS_EPS_F);
                        f32x4 a0 = acc[ai][0][m][0] * rc, a1 = acc[ai][0][m][1] * rc, b0 = acc[ai][1][m][0] * rc, b1 = acc[ai][1][m][1] * rc;
                        const size_t row = (size_t)(row0 + ai * HALF + m * 16);
                        if (wc == 0) {
                            float ss = (dot4(a0) + dot4(a1)) + (dot4(b0) + dot4(b1));
                            ss += __shfl_xor(ss, 16); ss += __shfl_xor(ss, 32);
                            const float rs = 1.0f / sqrtf(ss * (1.0f / 64.0f) + RMS_EPS_F);
                            bf16_t* p = KA + row * 64 + 8 * fq;
                            *(u32x4*)p = pk8(a0 * w0 * rs, a1 * w1 * rs); *(u32x4*)(p + 32) = pk8(b0 * w2 * rs, b1 * w3 * rs);
                        } else {
                            bf16_t* p = VA + row * 64 + 8 * fq;
                            *(u32x4*)p = pk8(a0, a1); *(u32x4*)(p + 32) = pk8(b0, b1);
                        }
                    }
            }
        } else if (pn == 3) {
#pragma unroll
            for (int ai = 0; ai < 2; ++ai)
#pragma unroll
                for (int m = 0; m < 4; ++m) {
                    const size_t row = (size_t)(row0 + ai * HALF + m * 16);
                    *(u32x4*)(IQ + row * 128 + 32 * wc + 8 * fq) = pk8(acc[ai][0][m][0], acc[ai][0][m][1]);
                    if (wc == 0) *(u32x4*)(IK + row * 32 + 8 * fq) = pk8(acc[ai][1][m][0], acc[ai][1][m][1]);
                    if (wc == 1 && fq == 0) *(f32x4*)(IW + row * 4) = acc[ai][1][m][0];
                }
        } else if (pn < 8) {
            const int head = 4 * (pn & 1) + wc; bf16_t* dst = pn < 6 ? QB : KB;
            const float lg2 = __log2f(1.0f - __builtin_amdgcn_exp2f(-5.0f - (float)head));
            f32x4 iv0, iv1;
#pragma unroll
            for (int i = 0; i < 4; ++i) { iv0[i] = __builtin_amdgcn_exp2f(-(float)(8 * fq + i) * (13.287712379549449f / 32.0f)) * 0.15915494309189535f; iv1[i] = __builtin_amdgcn_exp2f(-(float)(8 * fq + 4 + i) * (13.287712379549449f / 32.0f)) * 0.15915494309189535f; }
#pragma unroll
            for (int ai = 0; ai < 2; ++ai)
#pragma unroll
                for (int m = 0; m < 4; ++m) {
                    const int row = row0 + ai * HALF + m * 16, pos = row & 2047; const float fp = (float)pos;
                    const float sc = pn < 6 ? __builtin_amdgcn_exp2f((float)(pos & 63) * lg2) : 0.125f * __builtin_amdgcn_exp2f(-(float)(pos & 63) * lg2);
                    f32x4 c0, c1, s0, s1;
#pragma unroll
                    for (int i = 0; i < 4; ++i) {
                        const float r0 = __builtin_amdgcn_fractf(fp * iv0[i]), r1 = __builtin_amdgcn_fractf(fp * iv1[i]);
                        c0[i] = __builtin_amdgcn_cosf(r0) * sc; s0[i] = __builtin_amdgcn_sinf(r0) * sc; c1[i] = __builtin_amdgcn_cosf(r1) * sc; s1[i] = __builtin_amdgcn_sinf(r1) * sc;
                    }
                    const f32x4 a0 = acc[ai][0][m][0], a1 = acc[ai][0][m][1], b0 = acc[ai][1][m][0], b1 = acc[ai][1][m][1];
                    bf16_t* p = dst + (size_t)row * 512 + head * 64 + 8 * fq;
                    *(u32x4*)p = pk8(a0 * c0 - b0 * s0, a1 * c1 - b1 * s1); *(u32x4*)(p + 32) = pk8(a0 * s0 + b0 * c0, a1 * s1 + b1 * c1);
                }
        } else {
            const int head = 4 * (pn & 1) + wc; bf16_t* dst = pn < 10 ? VB : GB; const bool act = pn >= 10;
#pragma unroll
            for (int ai = 0; ai < 2; ++ai)
#pragma unroll
                for (int m = 0; m < 4; ++m) {
                    f32x4 a0 = acc[ai][0][m][0], a1 = acc[ai][0][m][1], b0 = acc[ai][1][m][0], b1 = acc[ai][1][m][1];
                    if (act) { a0 = silu4(a0); a1 = silu4(a1); b0 = silu4(b0); b1 = silu4(b1); }
                    bf16_t* p = dst + (size_t)(row0 + ai * HALF + m * 16) * 512 + head * 64 + 8 * fq;
                    *(u32x4*)p = pk8(a0, a1); *(u32x4*)(p + 32) = pk8(b0, b1);
                }
        }
    }
};

struct EpiOut {
    static constexpr bool PERM = true, AFTER_DRAIN = false;
    const float* rms; bf16_t* x1b; float ss[8];
    __device__ __forceinline__ void prefetch(const Unit&, int, int) {}
    __device__ __forceinline__ void advance() {}
    __device__ __forceinline__ void operator()(const f32x4 (&acc)[2][2][4][2], const Unit& u, int wr, int wc, int fr, int fq) {
        asm volatile("" : "+v"(fr), "+v"(fq));
        const int row0 = u.pm * BM + wr * 64 + fr, col0 = u.pn * BM + wc * 32 + 8 * fq;
#pragma unroll
        for (int ai = 0; ai < 2; ++ai)
#pragma unroll
            for (int m = 0; m < 4; ++m) {
                const int row = row0 + ai * HALF + m * 16; const size_t off = (size_t)row * 1024 + col0; const float rm = rms[row]; float s = 0.f;
#pragma unroll
                for (int bj = 0; bj < 2; ++bj) {
                    const u32x4 xv = *(const u32x4*)(x1b + off + bj * HALF);
                    const f32x4 x0 = {__uint_as_float(xv[0] << 16), __uint_as_float(xv[0] & 0xffff0000u), __uint_as_float(xv[1] << 16), __uint_as_float(xv[1] & 0xffff0000u)};
                    const f32x4 x1 = {__uint_as_float(xv[2] << 16), __uint_as_float(xv[2] & 0xffff0000u), __uint_as_float(xv[3] << 16), __uint_as_float(xv[3] & 0xffff0000u)};
                    const f32x4 r0 = x0 * rm + acc[ai][bj][m][0], r1 = x1 * rm + acc[ai][bj][m][1];
                    *(u32x4*)(x1b + off + bj * HALF) = pk8(r0, r1);
                    s += dot4(r0) + dot4(r1);
                }
                ss[ai * 4 + m] += s;
            }
    }
};

struct EpiGU {
    static constexpr bool PERM = true, AFTER_DRAIN = false;
    const float* r2; bf16_t* act; f32x4 rc0, rc1, rn0, rn1; unsigned long long tepi;
    __device__ __forceinline__ void prefetch(const Unit& u, int wr, int fr) {
        const float* p = r2 + u.pm * BM + wr * 64 + fr;
        rn0 = (f32x4){p[0], p[16], p[32], p[48]}; rn1 = (f32x4){p[HALF], p[HALF + 16], p[HALF + 32], p[HALF + 48]};
    }
    __device__ __forceinline__ void advance() { rc0 = rn0; rc1 = rn1; }
    __device__ __forceinline__ void operator()(const f32x4 (&acc)[2][2][4][2], const Unit& u, int wr, int wc, int fr, int fq) {
#ifdef PROBE_TIMER
        const unsigned long long te0_ = __builtin_amdgcn_s_memtime();
#endif
        asm volatile("" : "+v"(fr), "+v"(fq));
        const int row0 = u.pm * BM + wr * 64 + fr, col0 = u.pn * HALF + wc * 32 + 8 * fq;
#pragma unroll
        for (int ai = 0; ai < 2; ++ai)
#pragma unroll
            for (int m = 0; m < 4; ++m) {
                const int row = row0 + ai * HALF + m * 16; const float rr = ai ? rc1[m] : rc0[m];
                const f32x4 g0 = acc[ai][0][m][0] * rr, g1 = acc[ai][0][m][1] * rr, u0 = acc[ai][1][m][0] * rr, u1 = acc[ai][1][m][1] * rr;
                *(u32x4*)(act + (size_t)row * 2816 + col0) = pk8(silu4(g0) * u0, silu4(g1) * u1);
            }
#ifdef PROBE_TIMER
        asm volatile("s_waitcnt vmcnt(0)" ::: "memory"); tepi += __builtin_amdgcn_s_memtime() - te0_;
#endif
    }
};

struct EpiDown {
    static constexpr bool PERM = true, AFTER_DRAIN = false;
    const bf16_t* x1b; float* out;
    __device__ __forceinline__ void prefetch(const Unit&, int, int) {}
    __device__ __forceinline__ void advance() {}
    __device__ __forceinline__ void operator()(const f32x4 (&acc)[2][2][4][2], const Unit& u, int wr, int wc, int fr, int fq) {
        asm volatile("" : "+v"(fr), "+v"(fq));
        const int row0 = u.pm * BM + wr * 64 + fr, col0 = u.pn * BM + wc * 32 + 8 * fq;
#pragma unroll
        for (int ai = 0; ai < 2; ++ai)
#pragma unroll
            for (int m = 0; m < 4; ++m) {
                const size_t off = (size_t)(row0 + ai * HALF + m * 16) * 1024 + col0;
#pragma unroll
                for (int bj = 0; bj < 2; ++bj) {
                    const u32x4 xv = *(const u32x4*)(x1b + off + bj * HALF);
                    const f32x4 x0 = {__uint_as_float(xv[0] << 16), __uint_as_float(xv[0] & 0xffff0000u), __uint_as_float(xv[1] << 16), __uint_as_float(xv[1] & 0xffff0000u)};
                    const f32x4 x1 = {__uint_as_float(xv[2] << 16), __uint_as_float(xv[2] & 0xffff0000u), __uint_as_float(xv[3] << 16), __uint_as_float(xv[3] & 0xffff0000u)};
                    *(f32x4*)(out + off + bj * HALF) = x0 + acc[ai][bj][m][0]; *(f32x4*)(out + off + bj * HALF + 4) = x1 + acc[ai][bj][m][1];
                }
            }
    }
};

struct PanelOrder {
    int pm, ntn;
    __device__ __forceinline__ bool next(int i, Unit& u) const { if (i >= ntn) return false; u.pm = pm; u.pn = i; return true; }
    __device__ __forceinline__ void a_ready(const Unit&) const {}
    __device__ __forceinline__ void done(const Unit&) const {}
};

template <class Epi, class Sched, bool ALIGN_EPI = false, bool SP2 = false>
__device__ __forceinline__ void gemm_phase(PG8_LAS unsigned char* lds, const Gemm g, const Sched& S, Epi& E, int wave_in) {
    unsigned ones_ = ~0u; asm volatile("" : "+s"(ones_)); int tid_ = wave_in * 64 + (int)__builtin_amdgcn_mbcnt_hi(ones_, __builtin_amdgcn_mbcnt_lo(ones_, 0u));
    const int tid = tid_, wid = __builtin_amdgcn_readfirstlane(tid >> 6), lane = tid & 63, wr = wid >> 2, wc = wid & 3, fr = lane & 15, fq = lane >> 4;
    const int K = g.K, nt = K / BK;
    unsigned voffA[2], voffB[2];
#pragma unroll
    for (int i = 0; i < 2; ++i) { int R, C; stage_rc(tid * 16 + i * 8192, R, C); const int Rb = Epi::PERM ? ((R & ~31) + perm32(R & 31)) : R;
        voffA[i] = (unsigned)(R * K + C) * 2u; voffB[i] = (unsigned)(Rb * K + C) * 2u; }
    const size_t kstep = (size_t)(BK * 2);
    const size_t hstep = (size_t)HALF * K * 2;
    const size_t tstep = 2 * hstep;
    const unsigned ldsw = (unsigned)wid * 1024u;
    const int aoff = lds_byte(wr * 64 + fr, fq * 8), boff = lds_byte(wc * 32 + fr, fq * 8);
#define PG8_SA(b, h) (((b) * 2 + (h)) * HTB)
#define PG8_SB(b, h) ((4 + (b) * 2 + (h)) * HTB)
#define PG8_STAGE(bufoff, gbase, voff) do { _Pragma("unroll") for (int _i = 0; _i < 2; ++_i) \
        __builtin_amdgcn_global_load_lds((const unsigned*)((const char*)(gbase) + (voff)[_i]), (PG8_LAS unsigned*)(lds + (bufoff) + ldsw + _i * 8192), 16, 0, 0); } while (0)
#define PG8_LDA(dst, b, h) do { _Pragma("unroll") for (int m = 0; m < 4; ++m) _Pragma("unroll") for (int k = 0; k < 2; ++k) dst[m][k] = *(const PG8_LAS bf16x8*)(lds + PG8_SA(b, h) + aoff + m * 2048 + k * 1024); } while (0)
#define PG8_LDB(dst, b, h) do { _Pragma("unroll") for (int n = 0; n < 2; ++n) _Pragma("unroll") for (int k = 0; k < 2; ++k) dst[n][k] = *(const PG8_LAS bf16x8*)(lds + PG8_SB(b, h) + boff + n * 2048 + k * 1024); } while (0)
#define PG8_MMA(ai, bj, At, Bt) do { __builtin_amdgcn_s_setprio(1); _Pragma("unroll") for (int m = 0; m < 4; ++m) _Pragma("unroll") for (int n = 0; n < 2; ++n) _Pragma("unroll") for (int k = 0; k < 2; ++k) \
        acc[ai][bj][m][n] = __builtin_amdgcn_mfma_f32_16x16x32_bf16(Bt[n][k], At[m][k], acc[ai][bj][m][n], 0, 0, 0); __builtin_amdgcn_s_setprio(0); } while (0)
#define PG8_WAIT_V(n) asm volatile("s_waitcnt vmcnt(" #n ")" ::: "memory")
#define PG8_WAIT_L(n) asm volatile("s_waitcnt lgkmcnt(" #n ")" ::: "memory")
#define PG8_BAR __builtin_amdgcn_s_barrier()
#define PG8_SCHED __builtin_amdgcn_sched_barrier(0)
    Unit cur, nxt; int ui = 0;
    if (!S.next(0, cur)) return;
    E.prefetch(cur, wr, fr); E.advance();
    f32x4 acc[2][2][4][2];
#pragma unroll
    for (int a = 0; a < 2; ++a)
#pragma unroll
        for (int b = 0; b < 2; ++b)
#pragma unroll
            for (int m = 0; m < 4; ++m)
#pragma unroll
                for (int n = 0; n < 2; ++n) acc[a][b][m][n] = (f32x4){0.f, 0.f, 0.f, 0.f};
    bf16x8 At[4][2], B0[2][2], B1[2][2];
    const char* cA = (const char*)g.A + (size_t)cur.pm * tstep; const char* cB = (const char*)g.Bt + (size_t)cur.pn * tstep;
    S.a_ready(cur);
    if constexpr (SP2) {
        PG8_STAGE(PG8_SB(0, 0), cB, voffB); PG8_STAGE(PG8_SB(0, 1), cB + hstep, voffB); PG8_STAGE(PG8_SA(0, 0), cA, voffA); PG8_STAGE(PG8_SA(0, 1), cA + hstep, voffA);
        if (wr == 1) PG8_BAR;
        PG8_WAIT_V(2); PG8_BAR;
        PG8_STAGE(PG8_SB(1, 0), cB + kstep, voffB); PG8_STAGE(PG8_SA(1, 0), cA + kstep, voffA); PG8_STAGE(PG8_SB(1, 1), cB + hstep + kstep, voffB);
        PG8_WAIT_V(6); PG8_BAR;
    } else {
        PG8_STAGE(PG8_SB(0, 0), cB, voffB); PG8_STAGE(PG8_SA(0, 0), cA, voffA); PG8_STAGE(PG8_SB(0, 1), cB + hstep, voffB); PG8_STAGE(PG8_SA(0, 1), cA + hstep, voffA);
        if (wr == 1) PG8_BAR;
        PG8_WAIT_V(4); PG8_BAR;
        PG8_STAGE(PG8_SB(1, 0), cB + kstep, voffB); PG8_STAGE(PG8_SA(1, 0), cA + kstep, voffA); PG8_STAGE(PG8_SB(1, 1), cB + hstep + kstep, voffB);
        PG8_WAIT_V(6); PG8_BAR;
    }
    for (;;) {
        const bool has_next = S.next(ui + 1, nxt);
        const char* nA = has_next ? (const char*)g.A + (size_t)nxt.pm * tstep : cA; const char* nB = has_next ? (const char*)g.Bt + (size_t)nxt.pn * tstep : cB;
        for (int t = 0; t < nt; t += 2) {
            const bool last = (t == nt - 2);
            const char* a1 = cA + (size_t)(t + 1) * kstep;
            const char* a2 = last ? nA : cA + (size_t)(t + 2) * kstep; const char* b2 = last ? nB : cB + (size_t)(t + 2) * kstep;
            const char* a3 = a2 + kstep; const char* b3 = b2 + kstep;
            if (last && has_next) { S.a_ready(nxt); E.prefetch(nxt, wr, fr); }
            if constexpr (SP2) {
            PG8_LDB(B0, 0, 0); PG8_LDB(B1, 0, 1); PG8_SCHED; PG8_LDA(At, 0, 0); PG8_STAGE(PG8_SA(1, 1), a1 + hstep, voffA);
            PG8_WAIT_V(8); PG8_WAIT_L(0); PG8_BAR; PG8_MMA(0, 0, At, B0); PG8_MMA(0, 1, At, B1); PG8_BAR; PG8_SCHED;
            PG8_LDA(At, 0, 1); PG8_STAGE(PG8_SB(0, 0), b2, voffB); PG8_STAGE(PG8_SB(0, 1), b2 + hstep, voffB); PG8_STAGE(PG8_SA(0, 0), a2, voffA);
            PG8_WAIT_V(8); PG8_WAIT_L(0); PG8_BAR; PG8_MMA(1, 0, At, B0); PG8_MMA(1, 1, At, B1); PG8_BAR; PG8_SCHED;
            PG8_LDB(B0, 1, 0); PG8_LDB(B1, 1, 1); PG8_SCHED; PG8_LDA(At, 1, 0); PG8_STAGE(PG8_SA(0, 1), a2 + hstep, voffA);
            PG8_WAIT_V(8); PG8_WAIT_L(0); PG8_BAR; PG8_MMA(0, 0, At, B0); PG8_MMA(0, 1, At, B1); PG8_BAR; PG8_SCHED;
            PG8_LDA(At, 1, 1); PG8_STAGE(PG8_SB(1, 0), b3, voffB); PG8_STAGE(PG8_SB(1, 1), b3 + hstep, voffB); PG8_STAGE(PG8_SA(1, 0), a3, voffA);
            PG8_WAIT_V(8); PG8_WAIT_L(0); PG8_BAR; PG8_MMA(1, 0, At, B0); PG8_MMA(1, 1, At, B1); PG8_BAR; PG8_SCHED;
            } else {
            PG8_LDB(B0, 0, 0); PG8_SCHED; PG8_LDA(At, 0, 0); PG8_STAGE(PG8_SA(1, 1), a1 + hstep, voffA);
            PG8_WAIT_L(8); PG8_BAR; PG8_WAIT_L(0); PG8_MMA(0, 0, At, B0); PG8_BAR; PG8_SCHED;
            PG8_LDB(B1, 0, 1); PG8_STAGE(PG8_SB(0, 0), b2, voffB);
            PG8_BAR; PG8_WAIT_L(0); PG8_MMA(0, 1, At, B1); PG8_BAR;
            PG8_LDA(At, 0, 1); PG8_STAGE(PG8_SA(0, 0), a2, voffA);
            PG8_BAR; PG8_WAIT_L(0); PG8_MMA(1, 0, At, B0); PG8_BAR; PG8_SCHED;
            PG8_STAGE(PG8_SB(0, 1), b2 + hstep, voffB);
            PG8_WAIT_V(6); PG8_BAR; PG8_MMA(1, 1, At, B1); PG8_BAR;
            PG8_LDB(B0, 1, 0); PG8_SCHED; PG8_LDA(At, 1, 0); PG8_STAGE(PG8_SA(0, 1), a2 + hstep, voffA);
            PG8_WAIT_L(8); PG8_BAR; PG8_WAIT_L(0); PG8_MMA(0, 0, At, B0); PG8_BAR; PG8_SCHED;
            PG8_LDB(B1, 1, 1); PG8_STAGE(PG8_SB(1, 0), b3, voffB);
            PG8_BAR; PG8_WAIT_L(0); PG8_MMA(0, 1, At, B1); PG8_BAR;
            PG8_LDA(At, 1, 1); PG8_STAGE(PG8_SA(1, 0), a3, voffA);
            PG8_BAR; PG8_WAIT_L(0); PG8_MMA(1, 0, At, B0); PG8_BAR; PG8_SCHED;
            PG8_STAGE(PG8_SB(1, 1), b3 + hstep, voffB);
            PG8_WAIT_V(6); PG8_BAR; PG8_MMA(1, 1, At, B1); PG8_BAR;
            }
        }
        if constexpr (ALIGN_EPI) { if (wr == 0) PG8_BAR; }
        if constexpr (!Epi::AFTER_DRAIN) { E(acc, cur, wr, wc, fr, fq); E.advance(); S.done(cur); }
        if (!has_next) break;
#pragma unroll
        for (int a = 0; a < 2; ++a)
#pragma unroll
            for (int b = 0; b < 2; ++b)
#pragma unroll
                for (int m = 0; m < 4; ++m)
#pragma unroll
                    for (int n = 0; n < 2; ++n) acc[a][b][m][n] = (f32x4){0.f, 0.f, 0.f, 0.f};
        cur = nxt; cA = nA; cB = nB; ++ui;
        if constexpr (ALIGN_EPI) { if (wr == 1) PG8_BAR; }
    }
    PG8_WAIT_V(0);
    if constexpr (!ALIGN_EPI) { if (wr == 0) PG8_BAR; }
    PG8_BAR;
    (void)lane;
#undef PG8_SA
#undef PG8_SB
#undef PG8_STAGE
#undef PG8_LDA
#undef PG8_LDB
#undef PG8_MMA
#undef PG8_WAIT_V
#undef PG8_WAIT_L
#undef PG8_BAR
#undef PG8_SCHED
}
}

constexpr int BATCH = 32, SEQ = 2048, DM = 1024, MTOK = BATCH * SEQ;
constexpr int INW = 2852, NIN = 3072, FF = 2816, NGU = 2 * FF;
constexpr int NWAVES = 8, NTHR = 512;
#ifndef MK_N_LAUNCHES
#define MK_N_LAUNCHES 1
#endif
constexpr int N_PHASES = 6;
constexpr size_t MiB = 1u << 20;
constexpr size_t WS_CTL = 0;
constexpr size_t WS_COS = 1 * MiB, WS_SIN = WS_COS + 256 * 1024;
constexpr size_t WS_BT = WS_SIN + 256 * 1024;
constexpr size_t WS_R2 = 2 * MiB, WS_RMS = 2 * MiB + 512 * 1024;
constexpr size_t WS_WIN = 4 * MiB, WS_WOUT = 10 * MiB, WS_WGU = 12 * MiB, WS_WDN = 23 * MiB;
constexpr size_t WS_XB = 32 * MiB;
constexpr size_t WS_MIX = 160 * MiB;
constexpr size_t WS_QA = 288 * MiB, WS_QB = 352 * MiB, WS_KB = 416 * MiB, WS_VB = 480 * MiB, WS_GB = 544 * MiB;
constexpr size_t WS_KA = 608 * MiB, WS_VA = 616 * MiB;
constexpr size_t WS_IQ = 624 * MiB;
constexpr size_t WS_ACT = 648 * MiB;
constexpr size_t WS_IK = 640 * MiB, WS_IW = 644 * MiB;
constexpr size_t WS_END = 1000 * MiB;
static_assert(WS_ACT + (size_t)MTOK * FF * 2 <= WS_END && WS_IW + (size_t)MTOK * 16 <= WS_ACT && WS_IQ + (size_t)MTOK * 128 * 2 <= WS_IK && WS_WDN + (size_t)DM * FF * 2 <= WS_XB && WS_WGU + (size_t)NGU * DM * 2 <= WS_WDN, "d_ws map");
constexpr int RING_BYTES = 131072;
constexpr int XCH_OFF = RING_BYTES;
constexpr int P2_SC = 0, SCW = 2052;
constexpr int P2_MASK = 143360;
constexpr int MISC_OFF = 163584;
constexpr int LDS_BYTES = 163840;
static_assert(P2_SC + 16 * SCW * 4 <= P2_MASK && P2_MASK + 16384 <= MISC_OFF, "P2 LDS map");

#define LAS __attribute__((address_space(3)))
typedef unsigned short bf16;
typedef unsigned v4u __attribute__((ext_vector_type(4)));
typedef unsigned v2u __attribute__((ext_vector_type(2)));
typedef float f32x4 __attribute__((ext_vector_type(4)));
typedef float f32x16 __attribute__((ext_vector_type(16)));
typedef short bf16x8 __attribute__((ext_vector_type(8)));
typedef short s16x4 __attribute__((ext_vector_type(4)));
#define LDS_WAIT() asm volatile("s_waitcnt lgkmcnt(0)" ::: "memory")
using pg8::pkbf;
__device__ __forceinline__ float bf2f(unsigned short h) { return __uint_as_float((unsigned)h << 16); }
__device__ __forceinline__ float bflo(unsigned w) { return __uint_as_float(w << 16); }
__device__ __forceinline__ float bfhi(unsigned w) { return __uint_as_float(w & 0xffff0000u); }
__device__ __forceinline__ float wave_sum(float v) {
#pragma unroll
    for (int o = 1; o < 64; o <<= 1) v += __shfl_xor(v, o);
    return v;
}
__device__ __forceinline__ s16x4 vtr(const LAS unsigned char* p) { return __builtin_bit_cast(s16x4, __builtin_amdgcn_ds_read_tr16_b64_v4i16((LAS s16x4*)p)); }
__device__ __forceinline__ bf16x8 cat8(s16x4 lo, s16x4 hi) { return (bf16x8){lo[0], lo[1], lo[2], lo[3], hi[0], hi[1], hi[2], hi[3]}; }
__device__ __forceinline__ int crow(int r, int hi) { return (r & 3) + 8 * (r >> 2) + 4 * hi; }

__device__ __forceinline__ int lane_id() { unsigned ones = ~0u; asm volatile("" : "+s"(ones)); return (int)__builtin_amdgcn_mbcnt_hi(ones, __builtin_amdgcn_mbcnt_lo(ones, 0u)); }
struct KArgs { const float* in[16]; float* out; unsigned char* ws; int ph_lo, ph_hi; };
struct Frame {
    LAS unsigned char* lds;
    unsigned* ctl;
    unsigned char* ws;
    int tid, lane, wave, vcu, G;
    int grp, rk;
    const __attribute__((address_space(4))) KArgs* ap;
    __device__ __forceinline__ const float* x() const { return ap->in[0]; }
    __device__ __forceinline__ const float* norm1_w() const { return ap->in[1]; }
    __device__ __forceinline__ const float* w_in() const { return ap->in[2]; }
    __device__ __forceinline__ const float* q_norm_w() const { return ap->in[3]; }
    __device__ __forceinline__ const float* k_norm_w() const { return ap->in[4]; }
    __device__ __forceinline__ const float* kv_norm_w() const { return ap->in[5]; }
    __device__ __forceinline__ const float* w_uk() const { return ap->in[6]; }
    __device__ __forceinline__ const float* w_uv() const { return ap->in[7]; }
    __device__ __forceinline__ const float* rel_bias() const { return ap->in[8]; }
    __device__ __forceinline__ const float* ret_gn_w() const { return ap->in[9]; }
    __device__ __forceinline__ const float* ret_gn_b() const { return ap->in[10]; }
    __device__ __forceinline__ const float* w_out() const { return ap->in[11]; }
    __device__ __forceinline__ const float* norm2_w() const { return ap->in[12]; }
    __device__ __forceinline__ const float* w_gate() const { return ap->in[13]; }
    __device__ __forceinline__ const float* w_up() const { return ap->in[14]; }
    __device__ __forceinline__ const float* w_down() const { return ap->in[15]; }
    __device__ __forceinline__ float* out() const { return ap->out; }
#define WSB_(name, off) __device__ __forceinline__ bf16* name() const { return (bf16*)(ws + (off)); }
#define WSF_(name, off) __device__ __forceinline__ float* name() const { return (float*)(ws + (off)); }
    WSB_(WIN, WS_WIN) WSB_(WOUT, WS_WOUT) WSB_(WGU, WS_WGU) WSB_(WDN, WS_WDN) WSB_(XB, WS_XB) WSB_(MIX, WS_MIX) WSB_(QA, WS_QA) WSB_(QB, WS_QB) WSB_(KB, WS_KB) WSB_(VB, WS_VB) WSB_(GB, WS_GB)
    WSB_(KA, WS_KA) WSB_(VA, WS_VA) WSB_(IQ, WS_IQ) WSB_(IK, WS_IK) WSB_(ACT, WS_ACT)
    WSF_(IW, WS_IW) WSF_(R2, WS_R2) WSF_(RMS, WS_RMS) WSF_(COS, WS_COS) WSF_(SIN, WS_SIN) WSF_(BT, WS_BT)
#undef WSB_
#undef WSF_
};

__device__ __forceinline__ int zcol(int n) {
    const int pn = n >> 8, tc = n & 255, bj = tc >> 7, wc = (tc >> 5) & 3, j = tc & 31, d = bj * 32 + j;
    if (pn < 2) return (4 * pn + wc) * 64 + d;
    if (pn == 2) { if (wc == 0) return -2 - d; if (wc == 1) return -2 - (64 + d); return 512 + (wc - 2) * 64 + d; }
    if (pn == 3) { if (bj == 0) return 640 + wc * 32 + j; if (wc == 0) return 768 + j; if (wc == 1 && j < 4) return 800 + j; return -1; }
    const int g = (pn - 4) >> 1, head = 4 * ((pn - 4) & 1) + wc;
    return 804 + g * 512 + head * 64 + d;
}
template <class SRC>
__device__ __forceinline__ void tr_item(SRC src, int Kdim, bf16* WT, int k0, int n0, LAS float* scr, int lane) {
#pragma unroll 4
    for (int i = 0; i < 32; ++i) { const int kk = 2 * i + (lane >> 5); scr[kk * 33 + (lane & 31)] = src(k0 + kk); }
    LDS_WAIT(); asm volatile("" ::: "memory");
    const int c = lane & 7;
#pragma unroll
    for (int j = 0; j < 4; ++j) { const int n = (lane >> 3) + 8 * j; const LAS float* s = scr + (8 * c) * 33 + n;
        v4u o; o.x = pkbf(s[0 * 33], s[1 * 33]); o.y = pkbf(s[2 * 33], s[3 * 33]); o.z = pkbf(s[4 * 33], s[5 * 33]); o.w = pkbf(s[6 * 33], s[7 * 33]);
        *(v4u*)(WT + (size_t)(n0 + n) * Kdim + k0 + 8 * c) = o; }
    LDS_WAIT(); asm volatile("" ::: "memory");
}
__device__ __forceinline__ int t5_bucket(int rel) {
    const int n = rel < 0 ? -rel : rel; int b;
    if (n < 8) b = n; else if (n < 12) b = 8; else if (n < 16) b = 9; else if (n < 23) b = 10; else if (n < 32) b = 11; else if (n < 46) b = 12; else if (n < 64) b = 13; else if (n < 91) b = 14; else b = 15;
    return (rel > 0 ? 16 : 0) + b;
}
__device__ __forceinline__ void p0_prologue(Frame& F) {
    LAS float* scr = (LAS float*)(F.lds + F.wave * 16384);
    const int lane = F.lane, gw = F.vcu * NWAVES + F.wave, NGW = F.G * NWAVES;
    if (blockIdx.x == 0 && F.tid == 0) F.ctl[0] = 0u;
    constexpr int I_IN = 16 * (NIN / 32), I_OUT = 16 * 32, I_GU = 16 * (NGU / 32), I_DN = (FF / 64) * 32, NITEMS = I_IN + I_OUT + I_GU + I_DN;
    auto do_item = [&](int it) {
        int r = it;
        if (r < I_IN) {
            const int kb = r / (NIN / 32), nb = r % (NIN / 32), f = zcol(32 * nb + (lane & 31));
            const float* w_in = F.w_in(); const float* nw = F.norm1_w();
            if (f >= -1) tr_item([&](int k) { return f >= 0 ? nw[k] * w_in[(size_t)k * INW + f] : 0.0f; }, DM, F.WIN(), 64 * kb, 32 * nb, scr, lane);
            return;
        }
        r -= I_IN;
        if (r < I_OUT) { const int kb = r / 32, nb = r % 32; const float* w = F.w_out() + 32 * nb + (lane & 31);
            tr_item([&](int k) { return w[(size_t)k * DM]; }, DM, F.WOUT(), 64 * kb, 32 * nb, scr, lane); return; }
        r -= I_OUT;
        if (r < I_GU) { const int kb = r / (NGU / 32), nb = r % (NGU / 32), n = 32 * nb + (lane & 31), pn = n >> 8, tc = n & 255;
            const float* w = ((tc >> 7) ? F.w_up() : F.w_gate()) + 128 * pn + (tc & 127); const float* nw = F.norm2_w();
            tr_item([&](int k) { return nw[k] * w[(size_t)k * FF]; }, DM, F.WGU(), 64 * kb, 32 * nb, scr, lane); return; }
        r -= I_GU;
        { const int kb = r / 32, nb = r % 32; const float* w = F.w_down() + 32 * nb + (lane & 31);
            tr_item([&](int k) { return w[(size_t)k * DM]; }, FF, F.WDN(), 64 * kb, 32 * nb, scr, lane); }
    };
    for (int e = F.vcu * NTHR + F.tid; e < DM * 128; e += F.G * NTHR) {
        const int k = e >> 7, idx = e & 127, d = idx & 63; const float* wu = (idx < 64 ? F.w_uk() : F.w_uv()) + d; const float* wr_ = F.w_in() + (size_t)k * INW + 512; float a = 0.f;
#pragma unroll 8
        for (int j = 0; j < 128; ++j) a += wr_[j] * F.kv_norm_w()[j] * wu[j * 64];
        const int n = 512 + (idx < 64 ? 0 : 32) + (d < 32 ? d : 128 + d - 32);
        F.WIN()[(size_t)n * DM + k] = (bf16)(pkbf(F.norm1_w()[k] * a, 0.f) & 0xffffu);
    }
    int it = gw, kk = 0;
    for (int m = gw; m < MTOK; m += NGW, ++kk) {
        const f32x4* xr = (const f32x4*)(F.x() + (size_t)m * DM) + lane;
        f32x4 v[4]; float sq = 0.f;
#pragma unroll
        for (int j = 0; j < 4; ++j) { v[j] = xr[64 * j]; sq += pg8::dot4(v[j]); }
        const float ms = wave_sum(sq) * (1.0f / DM) + 1e-6f, rr = 1.0f / sqrtf(ms);
        v2u* o8 = (v2u*)(F.XB() + (size_t)m * DM) + lane;
#pragma unroll
        for (int j = 0; j < 4; ++j) o8[64 * j] = (v2u){pkbf(v[j][0] * rr, v[j][1] * rr), pkbf(v[j][2] * rr, v[j][3] * rr)};
        if (lane == 0) F.RMS()[m] = sqrtf(ms);
        if ((kk & 7) == 3 && it < NITEMS) { do_item(it); it += NGW; }
    }
    for (; it < NITEMS; it += NGW) do_item(it);
    const int gt = F.vcu * NTHR + F.tid, NGT = F.G * NTHR;
    for (int i = gt; i < 8 * 256; i += NGT) { const int h = i >> 8, rel = (i & 255) - 191;
        F.BT()[i] = (F.rel_bias()[t5_bucket(rel) * 8 + h] - F.rel_bias()[15 * 8 + h]) * 1.4426950408889634f; }
}

#ifndef PROBE_LO
#define PROBE_LO 3000.0f
#define PROBE_RANGE 4000.0f
#endif
#ifndef PLANES
#define PLANES 1
#endif
#ifndef MIXREP
#define MIXREP 0
#endif
typedef float f32x4_t __attribute__((ext_vector_type(4)));
typedef float f32x2v __attribute__((ext_vector_type(2)));
struct IdxOps { bf16x8 bq[4]; f32x4 wv; bf16x8 a0; };
__device__ __forceinline__ void idx_fetch(IdxOps& o, const Frame& F, int b, int c, int rq) {
    const int w = F.wave, lane = F.lane, q = lane & 15, g = lane >> 4;
    const size_t rowq = (size_t)b * SEQ + 64 * c + 16 * rq + q;
#pragma unroll
    for (int h = 0; h < 4; ++h) o.bq[h] = *(const bf16x8*)(F.IQ() + rowq * 128 + 32 * h + 8 * g);
    o.wv = *(const f32x4*)(F.IW() + rowq * 4) * (0.5f * 0.17677669529663687f);
    o.a0 = *(const bf16x8*)(F.IK() + ((size_t)b * SEQ + q) * 32 + 8 * g + (size_t)w * 512);
}
__device__ __forceinline__ void idx_round(const IdxOps& o, const Frame& F, int b, int c, LAS unsigned char* lds) {
    const int w = F.wave, lane = F.lane, q = lane & 15, g = lane >> 4;
    const int nkb = 4 * (c + 1);
    const bf16* kp = F.IK() + ((size_t)b * SEQ + q) * 32 + 8 * g;
    LAS float* dst = (LAS float*)(lds + P2_SC) + q * SCW + 4 * g;
    int kb = w; bf16x8 a = o.a0;
    for (; kb < nkb; kb += 8) {
        bf16x8 an = a; if (kb + 8 < nkb) an = *(const bf16x8*)(kp + (size_t)(kb + 8) * 512);
        f32x4 sc = {0.f, 0.f, 0.f, 0.f};
#pragma unroll
        for (int h = 0; h < 4; ++h) {
            const f32x4 d = __builtin_amdgcn_mfma_f32_16x16x32_bf16(a, o.bq[h], (f32x4){0.f, 0.f, 0.f, 0.f}, 0, 0, 0);
#pragma unroll
            for (int i = 0; i < 4; ++i) sc[i] += o.wv[h] * fmaxf(d[i], 0.f);
        }
        *(LAS f32x4*)(dst + 16 * kb) = (f32x4){sc[0] + 0.f, sc[1] + 0.f, sc[2] + 0.f, sc[3] + 0.f};
        a = an;
    }
}
__device__ __forceinline__ int wave_sum_i(int v) {
    v += __builtin_amdgcn_update_dpp(0, v, 0xB1, 0xF, 0xF, false);
    v += __builtin_amdgcn_update_dpp(0, v, 0x4E, 0xF, 0xF, false);
    v += __builtin_amdgcn_update_dpp(0, v, 0x141, 0xF, 0xF, false);
    v += __builtin_amdgcn_update_dpp(0, v, 0x140, 0xF, 0xF, false);
    return (__builtin_amdgcn_readlane(v, 0) + __builtin_amdgcn_readlane(v, 16)) + (__builtin_amdgcn_readlane(v, 32) + __builtin_amdgcn_readlane(v, 48));
}
__device__ __forceinline__ unsigned sortable(float f) { const unsigned bits = __float_as_uint(f); return bits ^ ((unsigned)((int)bits >> 31) | 0x80000000u); }
template <int NJ>
__device__ __forceinline__ void mask_words(const unsigned (&u)[NJ], unsigned prefix, bool exact, LAS unsigned long long* mrow, int nj, int lane) {
    unsigned long long mv = 0ull;
    if (exact) {
#pragma unroll
        for (int j = 0; j < NJ; ++j) { const unsigned long long sel = __ballot(u[j] >= prefix); if (lane == j) mv = sel; }
    } else {
        int ngt = 0;
#pragma unroll
        for (int j = 0; j < NJ; ++j) ngt += __popcll(__ballot(u[j] > prefix));
        int need = 256 - ngt;
#pragma unroll
        for (int j = 0; j < NJ; ++j) {
            const unsigned long long eq = __ballot(u[j] == prefix);
            const int rank = (int)__builtin_amdgcn_mbcnt_hi((unsigned)(eq >> 32), __builtin_amdgcn_mbcnt_lo((unsigned)eq, 0u));
            const unsigned long long sel = __ballot(u[j] > prefix || (u[j] == prefix && rank < need));
            need -= __popcll(eq);
            if (lane == j) mv = sel;
        }
    }
    if (lane < nj) mrow[lane] = mv;
}
template <int NJ>
__device__ __forceinline__ void select_row(const LAS float* row, LAS unsigned long long* mrow, int nj, int lane) {
    static_assert(NJ % 4 == 0, "groups of four");
    unsigned u[NJ];
#pragma unroll
    for (int j = 0; j < NJ; ++j) { float v = row[64 * j + lane]; asm volatile("" : "+v"(v)); u[j] = (j < nj) ? sortable(v) : 0u; }
    unsigned prefix = 0u; bool exact = false;
#pragma unroll 1
    for (int bit = 31; bit >= 0; --bit) {
        const unsigned trial = prefix | (1u << bit); int c0 = 0, c1 = 0, c2 = 0, c3 = 0;
#pragma unroll
        for (int j = 0; j < NJ; j += 4) {
            unsigned long long m0, m1, m2, m3;
            asm volatile("v_cmp_le_u32_e64 %4, %12, %8\n\tv_cmp_le_u32_e64 %5, %12, %9\n\tv_cmp_le_u32_e64 %6, %12, %10\n\tv_cmp_le_u32_e64 %7, %12, %11\n\t"
                         "v_addc_co_u32_e64 %0, %4, 0, %0, %4\n\tv_addc_co_u32_e64 %1, %5, 0, %1, %5\n\tv_addc_co_u32_e64 %2, %6, 0, %2, %6\n\tv_addc_co_u32_e64 %3, %7, 0, %3, %7"
                         : "+v"(c0), "+v"(c1), "+v"(c2), "+v"(c3), "=&s"(m0), "=&s"(m1), "=&s"(m2), "=&s"(m3) : "v"(u[j]), "v"(u[j + 1]), "v"(u[j + 2]), "v"(u[j + 3]), "s"(trial));
        }
        const int cnt = wave_sum_i((c0 + c1) + (c2 + c3));
        if (cnt >= 256) prefix = trial;
        if (cnt == 256) { exact = true; break; }
    }
    mask_words<NJ>(u, prefix, exact, mrow, nj, lane);
}
template <int S, unsigned M>
__device__ __forceinline__ void tr_stage(unsigned (&A)[32]) {
#pragma unroll
    for (int k = 0; k < 32; ++k) if (!(k & S)) {
        const unsigned a = A[k], b = A[k + S], bs = b << S, as = a >> S; unsigned lo, hi;
        asm("v_bfi_b32 %0, %1, %2, %3" : "=v"(lo) : "s"(M), "v"(a), "v"(bs)); asm("v_bfi_b32 %0, %1, %2, %3" : "=v"(hi) : "s"(M), "v"(as), "v"(b));
        A[k] = lo; A[k + S] = hi; }
}
__device__ __forceinline__ void tr_bytes(unsigned (&A)[32]) {
#pragma unroll
    for (int k = 0; k < 16; ++k) { const unsigned a = A[k], b = A[k + 16];
        A[k] = __builtin_amdgcn_perm(b, a, 0x05040100u);
        A[k + 16] = __builtin_amdgcn_perm(b, a, 0x07060302u); }
#pragma unroll
    for (int k = 0; k < 32; ++k) if (!(k & 8)) { const unsigned a = A[k], b = A[k + 8];
        A[k] = __builtin_amdgcn_perm(b, a, 0x06020400u);
        A[k + 8] = __builtin_amdgcn_perm(b, a, 0x07030501u); }
}
__device__ __forceinline__ void planes_finish(unsigned gt, unsigned alive, int G, bool done, LAS unsigned long long* mrow, int nj, int lane) {
    unsigned sel = gt | alive;
    if (!done) {
        int need = 256 - G; unsigned ts = 0u;
#pragma unroll
        for (int j = 0; j < 32; ++j) {
            const bool mine = (alive >> j) & 1u; const unsigned long long eq = __ballot(mine);
            const int rank = (int)__builtin_amdgcn_mbcnt_hi((unsigned)(eq >> 32), __builtin_amdgcn_mbcnt_lo((unsigned)eq, 0u));
            ts |= (mine && rank < need) ? (1u << j) : 0u; need -= __popcll(eq);
        }
        sel = gt | ts;
    }
    unsigned long long mv = 0ull;
#pragma unroll
    for (int j = 0; j < 32; ++j) { const unsigned long long w = __ballot((sel >> j) & 1u); if (lane == j) mv = w; }
    if (lane < nj) mrow[lane] = mv;
}
__device__ __forceinline__ void select_rows_planes2(const LAS float* rowa, const LAS float* rowb, LAS unsigned long long* mrowa, LAS unsigned long long* mrowb, int nj, int lane) {
    unsigned A[32], B[32];
#pragma unroll
    for (int j = 0; j < 32; ++j) { float va = rowa[64 * j + lane], vb = rowb[64 * j + lane]; asm volatile("" : "+v"(va), "+v"(vb)); A[j] = (j < nj) ? sortable(va) : 0u; B[j] = (j < nj) ? sortable(vb) : 0u; }
    tr_bytes(A); tr_stage<4, 0x0F0F0F0Fu>(A); tr_stage<2, 0x33333333u>(A); tr_stage<1, 0x55555555u>(A);
    tr_bytes(B); tr_stage<4, 0x0F0F0F0Fu>(B); tr_stage<2, 0x33333333u>(B); tr_stage<1, 0x55555555u>(B);
#pragma unroll
    for (int j = 0; j < 32; ++j) asm volatile("" : "+v"(A[j]), "+v"(B[j]));
    unsigned alivea = 0xFFFFFFFFu, gta = 0u, aliveb = 0xFFFFFFFFu, gtb = 0u; int Ga = 0, Aa = 2048, Gb = 0, Ab = 2048; bool donea = false, doneb = false;
#pragma unroll
    for (int b = 31; b >= 0; --b) {
        if (!(donea && doneb)) {
            const unsigned onesa = alivea & A[b], onesb = aliveb & B[b];
            const int both = wave_sum_i(__builtin_popcount(onesa) | (__builtin_popcount(onesb) << 16)), C1a = both & 0xffff, C1b = both >> 16;
            if (!donea) {
                if (Ga + C1a >= 256) { alivea = onesa; Aa = C1a; } else { Ga += C1a; gta |= onesa; alivea &= ~A[b]; Aa -= C1a; }
                donea = (Ga + Aa == 256);
            }
            if (!doneb) {
                if (Gb + C1b >= 256) { aliveb = onesb; Ab = C1b; } else { Gb += C1b; gtb |= onesb; aliveb &= ~B[b]; Ab -= C1b; }
                doneb = (Gb + Ab == 256);
            }
        }
    }
    planes_finish(gta, alivea, Ga, donea, mrowa, nj, lane);
    planes_finish(gtb, aliveb, Gb, doneb, mrowb, nj, lane);
}
constexpr int MP_STRIDE = 36, MP_PLANE = 64 * MP_STRIDE;
__device__ __forceinline__ unsigned row32_sum(unsigned v) {
    v += __builtin_amdgcn_update_dpp(0, v, 0xB1, 0xF, 0xF, true);
    v += __builtin_amdgcn_update_dpp(0, v, 0x4E, 0xF, 0xF, true);
    v += __builtin_amdgcn_update_dpp(0, v, 0x141, 0xF, 0xF, true);
    v += __builtin_amdgcn_update_dpp(0, v, 0x140, 0xF, 0xF, true);
#if defined(SWZ_SUM)
    return v + (unsigned)__builtin_amdgcn_ds_swizzle((int)v, 0x401F);
#else
    const auto sw = __builtin_amdgcn_permlane16_swap(v, v, false, false);
    return (unsigned)sw[0] + (unsigned)sw[1];
#endif
}
__device__ __forceinline__ void select_rows32(const LAS float* sc, LAS unsigned* mp, int rq, int nj, int wave, int lane) {
    const int half = lane >> 5, l32 = lane & 31, ql = 2 * wave + half;
    const LAS float* row = sc + ql * SCW + l32;
    unsigned A[32], B[32];
#ifdef ASM_MARK
    asm volatile("; SEL_BEGIN");
#endif
#pragma unroll
    for (int i = 0; i < 32; ++i) { float va = row[32 * i], vb = row[32 * (32 + i)]; asm volatile("" : "+v"(va), "+v"(vb)); A[i] = __float_as_uint(va); B[i] = __float_as_uint(vb); }
    tr_bytes(A); tr_stage<4, 0x0F0F0F0Fu>(A); tr_stage<2, 0x33333333u>(A); tr_stage<1, 0x55555555u>(A);
    tr_bytes(B); tr_stage<4, 0x0F0F0F0Fu>(B); tr_stage<2, 0x33333333u>(B); tr_stage<1, 0x55555555u>(B);
#ifdef ASM_MARK
    asm volatile("; SEL_TR_END");
#endif
    const int nv = 2 * nj;
    unsigned al0 = nv >= 32 ? 0xFFFFFFFFu : ((1u << nv) - 1u), al1 = nv <= 32 ? 0u : (nv >= 64 ? 0xFFFFFFFFu : ((1u << (nv - 32)) - 1u));
    unsigned gt0 = 0u, gt1 = 0u, G = 0u;
    const unsigned S0 = A[31], S1 = B[31];
#pragma unroll
    for (int b = 31; b >= 0; --b) {
        const unsigned o0 = b == 31 ? (al0 & ~S0) : __builtin_amdgcn_bitop3_b32(al0, A[b], S0, 0x60), o1 = b == 31 ? (al1 & ~S1) : __builtin_amdgcn_bitop3_b32(al1, B[b], S1, 0x60);
        const unsigned c1 = row32_sum((unsigned)__builtin_popcount(o0) + (unsigned)__builtin_popcount(o1));
        const unsigned nt = (unsigned)((int)(G + c1 - 256u) >> 31);
        al0 = __builtin_amdgcn_bitop3_b32(o0, al0, nt, 0x78); al1 = __builtin_amdgcn_bitop3_b32(o1, al1, nt, 0x78);
        gt0 = __builtin_amdgcn_bitop3_b32(gt0, o0, nt, 0xF8); gt1 = __builtin_amdgcn_bitop3_b32(gt1, o1, nt, 0xF8);
        G += c1 & nt;
    }
#ifdef ASM_MARK
    asm volatile("; SEL_LOOP_END");
#endif
    const unsigned ce = row32_sum((unsigned)__builtin_popcount(al0) + (unsigned)__builtin_popcount(al1));
    const bool tie = G + ce != 256u;
    if (__any(tie)) {
        const unsigned need = tie ? 256u - G : 0x7fffffffu; unsigned m = 0u;
#pragma unroll
        for (int bit = 6; bit >= 0; --bit) {
            const unsigned cand = m + (1u << bit);
            const unsigned k0 = cand >= 32u ? 0xFFFFFFFFu : ((1u << cand) - 1u), k1 = cand <= 32u ? 0u : (cand >= 64u ? 0xFFFFFFFFu : ((1u << (cand - 32u)) - 1u));
            const unsigned cc = row32_sum((unsigned)__builtin_popcount(al0 & k0) + (unsigned)__builtin_popcount(al1 & k1));
            m = (cand <= 64u && cc <= need) ? cand : m;
        }
        const unsigned k0 = m >= 32u ? 0xFFFFFFFFu : ((1u << m) - 1u), k1 = m <= 32u ? 0u : (m >= 64u ? 0xFFFFFFFFu : ((1u << (m - 32u)) - 1u));
        const unsigned cm = row32_sum((unsigned)__builtin_popcount(al0 & k0) + (unsigned)__builtin_popcount(al1 & k1));
        const unsigned rem = need - cm;
        const bool mine = m < 64u && (((m < 32u ? al0 >> m : al1 >> (m - 32u)) & 1u) != 0u);
        const unsigned long long eq = __ballot(mine); const unsigned eqr = half ? (unsigned)(eq >> 32) : (unsigned)eq;
        const bool tk = mine && (unsigned)__builtin_popcount(eqr & ((1u << l32) - 1u)) < rem;
        al0 = (al0 & k0) | ((tk && m < 32u) ? (1u << m) : 0u); al1 = (al1 & k1) | ((tk && m >= 32u) ? (1u << (m - 32u)) : 0u);
    }
#ifdef ASM_MARK
    asm volatile("; SEL_TIE_END");
#endif
    LAS unsigned* rec = mp + (16 * rq + ql) * MP_STRIDE + l32;
    rec[0] = gt0 | al0; rec[MP_PLANE] = gt1 | al1;
}
constexpr int AT_K = 0, AT_V = 32768, AT_BT = 65536, AT_WS = 73728, AT_OST = 0, AT_Q = 75776;
static_assert(AT_Q + 65536 <= P2_MASK && AT_OST + 8 * 4608 <= AT_BT, "attention LDS map");
__device__ __forceinline__ bf16x8 pk16(const f32x16& v, int o) { return __builtin_bit_cast(bf16x8, (v4u){pkbf(v[o], v[o + 1]), pkbf(v[o + 2], v[o + 3]), pkbf(v[o + 4], v[o + 5]), pkbf(v[o + 6], v[o + 7])}); }
__device__ __forceinline__ void glds16(const void* gsrc, unsigned lds_dst) {
    unsigned keep;
    asm volatile("s_mov_b32 %0, m0\n\ts_mov_b32 m0, %2\n\ts_nop 0\n\tglobal_load_lds_dwordx4 %1, off\n\ts_mov_b32 m0, %0" : "=&s"(keep) : "v"(gsrc), "s"(lds_dst) : "memory");
}
__device__ __forceinline__ unsigned lds_addr(const LAS unsigned char* p) { return (unsigned)(uintptr_t)p; }
template <bool MASK, bool NEAR>
__device__ __forceinline__ void attn_soft(f32x16& p0, f32x16& p1, f32x2v& lacc, bf16x8 (&pa)[4], const LAS unsigned* mrec, int sbit) {
#pragma unroll
    for (int i = 0; i < 16; ++i) { p0[i] = __builtin_amdgcn_exp2f(p0[i]); p1[i] = __builtin_amdgcn_exp2f(p1[i]); }
    if (MASK) {
#pragma unroll
        for (int g = 0; g < 4; ++g) {
            const v4u w4 = *(const LAS v4u*)(mrec + 8 * g);
#pragma unroll
            for (int k = 0; k < 4; ++k) { int m0_, m1_; asm("v_bfe_i32 %0, %1, %2, 1" : "=v"(m0_) : "v"(w4[k]), "s"(sbit)); asm("v_bfe_i32 %0, %1, %2, 1" : "=v"(m1_) : "v"(w4[k]), "s"(sbit + 1));
                p0[4 * g + k] = __uint_as_float(__float_as_uint(p0[4 * g + k]) & (unsigned)m0_); p1[4 * g + k] = __uint_as_float(__float_as_uint(p1[4 * g + k]) & (unsigned)m1_); }
        }
    }
#pragma unroll
    for (int i = 0; i < 16; i += 2) { lacc += (f32x2v){p0[i], p0[i + 1]}; lacc += (f32x2v){p1[i], p1[i + 1]}; }
    pa[0] = pk16(p0, 0); pa[1] = pk16(p0, 8); pa[2] = pk16(p1, 0); pa[3] = pk16(p1, 8);
}
__device__ __forceinline__ void attn_pv(f32x16& o0, f32x16& o1, const bf16x8 (&pa)[4], const LAS unsigned char* Vb) {
#pragma unroll
    for (int ks = 0; ks < 4; ++ks) {
        o0 = __builtin_amdgcn_mfma_f32_32x32x16_bf16(pa[ks], cat8(vtr(Vb + ks * 1024), vtr(Vb + ks * 1024 + 512)), o0, 0, 0, 0);
        o1 = __builtin_amdgcn_mfma_f32_32x32x16_bf16(pa[ks], cat8(vtr(Vb + 4096 + ks * 1024), vtr(Vb + 4096 + ks * 1024 + 512)), o1, 0, 0, 0);
    }
}
template <bool NEAR>
__device__ __forceinline__ void attn_qk(f32x16& a0, f32x16& a1, f32x16& b0, f32x16& b1, const LAS unsigned char* Qb, const LAS unsigned char* Kb, const LAS float* bt) {
#pragma unroll
    for (int i = 0; i < 16; ++i) {
        if (NEAR) { a0[i] = bt[(i & 3) + 8 * (i >> 2)]; a1[i] = bt[32 + (i & 3) + 8 * (i >> 2)]; b0[i] = bt[(i & 3) + 8 * (i >> 2) - 32]; b1[i] = bt[(i & 3) + 8 * (i >> 2)]; }
        else { a0[i] = 0.f; a1[i] = 0.f; b0[i] = 0.f; b1[i] = 0.f; }
    }
#pragma unroll
    for (int d0 = 0; d0 < 4; ++d0) {
        const bf16x8 k0 = *(const LAS bf16x8*)(Kb + d0 * 2048), k1 = *(const LAS bf16x8*)(Kb + d0 * 2048 + 512);
        const bf16x8 qfa = *(const LAS bf16x8*)(Qb + d0 * 1024), qfb = *(const LAS bf16x8*)(Qb + 4096 + d0 * 1024);
        a0 = __builtin_amdgcn_mfma_f32_32x32x16_bf16(k0, qfa, a0, 0, 0, 0); a1 = __builtin_amdgcn_mfma_f32_32x32x16_bf16(k1, qfa, a1, 0, 0, 0);
        b0 = __builtin_amdgcn_mfma_f32_32x32x16_bf16(k0, qfb, b0, 0, 0, 0); b1 = __builtin_amdgcn_mfma_f32_32x32x16_bf16(k1, qfb, b1, 0, 0, 0);
    }
}
__device__ __forceinline__ void attn_store(const f32x16& o0, const f32x16& o1, f32x2v lacc, bf16* obase, LAS unsigned char* stg, LAS float* wsf, int lane) {
    const int r = lane & 31, hi = lane >> 5;
    float lsum = lacc[0] + lacc[1];
    lsum += __shfl_xor(lsum, 32);
    if (hi == 0) wsf[r] = lsum;
    LDS_WAIT(); asm volatile("" ::: "memory");
    LAS unsigned short* st = (LAS unsigned short*)stg;
#pragma unroll
    for (int i = 0; i < 16; ++i) {
        const int q = crow(i, hi); const float rl = 1.0f / wsf[q];
        st[q * 72 + r] = (unsigned short)(pkbf(o0[i] * rl, 0.f) & 0xffffu); st[q * 72 + 32 + r] = (unsigned short)(pkbf(o1[i] * rl, 0.f) & 0xffffu);
    }
    LDS_WAIT(); asm volatile("" ::: "memory");
#pragma unroll
    for (int k = 0; k < 4; ++k) { const int row = 8 * k + (lane >> 3), ch = lane & 7;
        const v4u v = *(const LAS v4u*)(stg + row * 144 + ch * 16); *(v4u*)(obase + (size_t)row * DM + ch * 8) = v; }
    LDS_WAIT(); asm volatile("" ::: "memory");
}
template <bool MASK>
__device__ __forceinline__ void attn_chunk(const Frame& F, int b, int c, LAS unsigned char* lds) {
    const int wid = F.wave, lane = F.lane, r = lane & 31, hi = lane >> 5;
    const size_t rowbase = (size_t)b * SEQ; const int q0 = 64 * c, nt = c + 1;
    const LAS unsigned char* Qb = lds + AT_Q + wid * 8192 + lane * 16;
#pragma unroll
    for (int d0 = 0; d0 < 4; ++d0) {
        *(LAS bf16x8*)(lds + AT_Q + wid * 8192 + d0 * 1024 + lane * 16) = *(const bf16x8*)(F.QA() + (rowbase + q0 + r) * 512 + wid * 64 + 16 * d0 + 8 * hi);
        *(LAS bf16x8*)(lds + AT_Q + wid * 8192 + 4096 + d0 * 1024 + lane * 16) = *(const bf16x8*)(F.QA() + (rowbase + q0 + 32 + r) * 512 + wid * 64 + 16 * d0 + 8 * hi); }
    const LAS float* BT = (const LAS float*)(lds + AT_BT) + wid * 256;
    const bf16* ksrc = F.KA() + (rowbase + lane) * 64 + 8 * wid;
    const bf16* vsrc = F.VA() + (rowbase + 16 * (wid & 3) + (lane >> 2)) * 64 + (wid >> 2) * 32 + (lane & 3) * 8;
    const LAS unsigned* mreca = (const LAS unsigned*)(lds + P2_MASK) + r * MP_STRIDE + 4 * hi; const LAS unsigned* mrecb = mreca + 32 * MP_STRIDE;
    const int voff = ((lane >> 4) & 1) * 32 + (lane & 3) * 8 + (4 * hi + ((lane & 15) >> 2)) * 64;
    f32x16 oa0, oa1, ob0, ob1; f32x2v la = {0.f, 0.f}, lb = {0.f, 0.f};
#pragma unroll
    for (int i = 0; i < 16; ++i) { oa0[i] = 0.f; oa1[i] = 0.f; ob0[i] = 0.f; ob1[i] = 0.f; }
#define AT_BAR() do { __builtin_amdgcn_sched_barrier(0); asm volatile("s_waitcnt lgkmcnt(0)" ::: "memory"); __builtin_amdgcn_s_barrier(); asm volatile("" ::: "memory"); __builtin_amdgcn_sched_barrier(0); } while (0)
#define AT_DMA(t_, slot_) do { const int tn_ = (t_) < nt ? (t_) : nt - 1;     \
        glds16(ksrc + (size_t)tn_ * 64 * 64, (unsigned)__builtin_amdgcn_readfirstlane((int)lds_addr(lds + AT_K + (slot_) * 8192 + wid * 1024))); \
        glds16(vsrc + (size_t)tn_ * 64 * 64, (unsigned)__builtin_amdgcn_readfirstlane((int)lds_addr(lds + AT_V + (slot_) * 8192 + wid * 1024))); } while (0)
    AT_DMA(0, 0); AT_DMA(1, 1); AT_DMA(2, 2);
    asm volatile("s_waitcnt vmcnt(0)" ::: "memory");
    AT_BAR();
    if (wid >= 4) AT_BAR();
    const int nfar = c >= 2 ? c - 2 : 0;
#if defined(PROBE_TIMER) && PROBE_TIMER == 3
    const unsigned long long pa0_ = __builtin_amdgcn_s_memtime();
#endif
    f32x16 a0, a1, b0, b1; bf16x8 pa[4], pb[4];
#if defined(PROBE_TIMER) && PROBE_TIMER >= 4
    unsigned psum_ = 0u;
#endif
    {
        const LAS unsigned char* Kb = lds + AT_K + hi * 1024 + r * 16; const LAS float* bt = BT + (64 * (0 - c) + 191 - r + 4 * hi);
        if (0 < nfar) attn_qk<false>(a0, a1, b0, b1, Qb, Kb, bt); else attn_qk<true>(a0, a1, b0, b1, Qb, Kb, bt);
        AT_BAR();
    }
#pragma unroll 1
    for (int t = 0; t < nt; ++t) {
        const int pl_ = (t >> 4) * MP_PLANE, sbit = (2 * t) & 31;
#ifdef NOSOFT
        { const bf16x8 c_ = {0x3c00, 0x3c00, 0x3c00, 0x3c00, 0x3c00, 0x3c00, 0x3c00, 0x3c00}; pa[0] = c_; pa[1] = c_; pa[2] = c_; pa[3] = c_; pb[0] = c_; pb[1] = c_; pb[2] = c_; pb[3] = c_; la += (f32x2v){a0[0], b0[0]}; }
#else
#if defined(PROBE_TIMER) && PROBE_TIMER == 4
        __builtin_amdgcn_sched_barrier(0); const unsigned long long pv0_ = __builtin_amdgcn_s_memtime(); __builtin_amdgcn_sched_barrier(0);
#endif
        attn_soft<MASK, false>(a0, a1, la, pa, mreca + pl_, sbit);
        attn_soft<MASK, false>(b0, b1, lb, pb, mrecb + pl_, sbit);
#if defined(PROBE_TIMER) && PROBE_TIMER == 4
        __builtin_amdgcn_sched_barrier(0); asm volatile("s_nop 0" : : "v"(pa[0]), "v"(pa[1]), "v"(pa[2]), "v"(pa[3]), "v"(pb[0]), "v"(pb[1]), "v"(pb[2]), "v"(pb[3]), "v"(la), "v"(lb)); psum_ += (unsigned)(__builtin_amdgcn_s_memtime() - pv0_); __builtin_amdgcn_sched_barrier(0);
#endif
#endif
#if defined(PROBE_TIMER) && PROBE_TIMER == 6
        __builtin_amdgcn_sched_barrier(0); asm volatile("s_nop 0" : : "v"(pa[0]), "v"(pa[3]), "v"(pb[0]), "v"(pb[3]), "v"(la), "v"(lb)); const unsigned long long pw0_ = __builtin_amdgcn_s_memtime();
#endif
        AT_BAR();
#if defined(PROBE_TIMER) && PROBE_TIMER == 6
        psum_ += (unsigned)(__builtin_amdgcn_s_memtime() - pw0_);
#endif
#if defined(PROBE_TIMER) && PROBE_TIMER == 5
        const unsigned long long pm0_ = __builtin_amdgcn_s_memtime();
#endif
        AT_DMA(t + 3, (t + 3) & 3);
        const LAS unsigned char* Vb = lds + AT_V + (t & 3) * 8192 + voff;
#pragma unroll
        for (int ks = 0; ks < 4; ++ks) {
            const bf16x8 v0 = cat8(vtr(Vb + ks * 1024), vtr(Vb + ks * 1024 + 512)), v1 = cat8(vtr(Vb + 4096 + ks * 1024), vtr(Vb + 4096 + ks * 1024 + 512));
            oa0 = __builtin_amdgcn_mfma_f32_32x32x16_bf16(pa[ks], v0, oa0, 0, 0, 0); ob0 = __builtin_amdgcn_mfma_f32_32x32x16_bf16(pb[ks], v0, ob0, 0, 0, 0);
            oa1 = __builtin_amdgcn_mfma_f32_32x32x16_bf16(pa[ks], v1, oa1, 0, 0, 0); ob1 = __builtin_amdgcn_mfma_f32_32x32x16_bf16(pb[ks], v1, ob1, 0, 0, 0);
        }
        if (t + 1 < nt) {
            const LAS unsigned char* Kb = lds + AT_K + ((t + 1) & 3) * 8192 + hi * 1024 + r * 16; const LAS float* bt = BT + (64 * (t + 1 - c) + 191 - r + 4 * hi);
            if (t + 1 < nfar) attn_qk<false>(a0, a1, b0, b1, Qb, Kb, bt); else attn_qk<true>(a0, a1, b0, b1, Qb, Kb, bt);
        }
#if defined(PROBE_TIMER) && PROBE_TIMER == 5
        asm volatile("s_nop 15\n\ts_nop 15" : : "v"(oa0), "v"(ob1), "v"(a0), "v"(b1)); psum_ += (unsigned)(__builtin_amdgcn_s_memtime() - pm0_);
#endif
#if defined(PROBE_TIMER) && PROBE_TIMER == 7
        __builtin_amdgcn_sched_barrier(0); asm volatile("s_nop 15\n\ts_nop 15" : : "v"(oa0), "v"(ob1), "v"(a0), "v"(b1)); const unsigned long long px0_ = __builtin_amdgcn_s_memtime();
#endif
        asm volatile("s_waitcnt vmcnt(2)" ::: "memory");
        AT_BAR();
#if defined(PROBE_TIMER) && PROBE_TIMER == 7
        psum_ += (unsigned)(__builtin_amdgcn_s_memtime() - px0_);
#endif
    }
#if defined(PROBE_TIMER) && PROBE_TIMER >= 4
    if (F.tid == 0 && nt >= 16) { volatile LAS unsigned* pm_ = (volatile LAS unsigned*)(lds + MISC_OFF); pm_[16] += psum_; pm_[17] += (unsigned)nt; }
#endif
#if defined(PROBE_TIMER) && PROBE_TIMER == 3
    if (F.tid == 0 && nt >= 16) { volatile LAS unsigned* pm_ = (volatile LAS unsigned*)(lds + MISC_OFF); pm_[16] += (unsigned)(__builtin_amdgcn_s_memtime() - pa0_); pm_[17] += (unsigned)nt; }
#endif
    asm volatile("s_waitcnt vmcnt(0)" ::: "memory");
    if (wid < 4) AT_BAR();
    AT_BAR();
#undef AT_BAR
#undef AT_DMA
    LAS float* wsf = (LAS float*)(lds + AT_WS) + wid * 64; LAS unsigned char* stg = lds + AT_OST + wid * 4608;
    attn_store(oa0, oa1, la, F.MIX() + (rowbase + q0) * DM + wid * 64, stg, wsf, lane);
    attn_store(ob0, ob1, lb, F.MIX() + (rowbase + q0 + 32) * DM + wid * 64, stg, wsf, lane);
}
__device__ __forceinline__ void attn_unit(const Frame& F, int b, int c, LAS unsigned char* lds) {
    if (c >= 4) {
        const int nj = c + 1;
        IdxOps ops; idx_fetch(ops, F, b, c, 0);
#if defined(PROBE_TIMER) && PROBE_TIMER >= 10
        unsigned ps_ = 0u;
#define PT0_(k) unsigned long long pt_##k = 0; if (PROBE_TIMER == (k)) { __builtin_amdgcn_sched_barrier(0); pt_##k = __builtin_amdgcn_s_memtime(); __builtin_amdgcn_sched_barrier(0); }
#define PT1_(k) if (PROBE_TIMER == (k)) { __builtin_amdgcn_sched_barrier(0); ps_ += (unsigned)(__builtin_amdgcn_s_memtime() - pt_##k); __builtin_amdgcn_sched_barrier(0); }
#else
#define PT0_(k)
#define PT1_(k)
#endif
        for (int rq = 0; rq < ((MIXREP & 2) ? 8 : 4); ++rq) {
            PT0_(10)
            idx_round(ops, F, b, c, lds);
            idx_fetch(ops, F, b, c, (rq + 1) & 3);
            asm volatile("s_waitcnt lgkmcnt(0)" ::: "memory");
            PT1_(10)
            PT0_(11)
            __syncthreads();
            PT1_(11)
            PT0_(12)
            select_rows32((const LAS float*)(lds + P2_SC), (LAS unsigned*)(lds + P2_MASK), rq & 3, nj, F.wave, F.lane);
            asm volatile("s_waitcnt lgkmcnt(0)" ::: "memory");
            PT1_(12)
            PT0_(13)
            __syncthreads();
            PT1_(13)
        }
#if defined(PROBE_TIMER) && PROBE_TIMER >= 10
        if (F.tid == 0 && c >= 15) { volatile LAS unsigned* pm_ = (volatile LAS unsigned*)(lds + MISC_OFF); pm_[16] += ps_; pm_[17] += 4u; }
#endif
#undef PT0_
#undef PT1_
    }
    { const f32x4 v = *(const f32x4*)(F.BT() + F.tid * 4); *(LAS f32x4*)(lds + AT_BT + F.tid * 16) = v; }
    __syncthreads();
    if (c >= 4) attn_chunk<true>(F, b, c, lds); else attn_chunk<false>(F, b, c, lds);
}

constexpr int RT_TAB = 131072;
__device__ __forceinline__ void ret_stage(const bf16* vsrc, const bf16* ksrc, LAS unsigned char* region) {
#pragma unroll
    for (int k = 0; k < 8; ++k) {
        const size_t o = (size_t)(16 * (k & 3)) * 512 + 32 * (k >> 2);
        __builtin_amdgcn_global_load_lds((const unsigned*)(vsrc + o), (LAS unsigned*)(region + k * 1024), 16, 0, 0);
        __builtin_amdgcn_global_load_lds((const unsigned*)(ksrc + o), (LAS unsigned*)(region + 8192 + k * 1024), 16, 0, 0);
    }
}
__device__ __forceinline__ void ret_kv(f32x16 (&T)[2][2], const LAS unsigned char* img) {
#pragma unroll
    for (int ks = 0; ks < 4; ++ks) {
        const bf16x8 k0 = cat8(vtr(img + 8192 + ks * 1024), vtr(img + 8192 + ks * 1024 + 512)), k1 = cat8(vtr(img + 8192 + 4096 + ks * 1024), vtr(img + 8192 + 4096 + ks * 1024 + 512));
        const bf16x8 v0 = cat8(vtr(img + ks * 1024), vtr(img + ks * 1024 + 512)), v1 = cat8(vtr(img + 4096 + ks * 1024), vtr(img + 4096 + ks * 1024 + 512));
        T[0][0] = __builtin_amdgcn_mfma_f32_32x32x16_bf16(k0, v0, T[0][0], 0, 0, 0); T[0][1] = __builtin_amdgcn_mfma_f32_32x32x16_bf16(k0, v1, T[0][1], 0, 0, 0);
        T[1][0] = __builtin_amdgcn_mfma_f32_32x32x16_bf16(k1, v0, T[1][0], 0, 0, 0); T[1][1] = __builtin_amdgcn_mfma_f32_32x32x16_bf16(k1, v1, T[1][1], 0, 0, 0);
    }
}
__device__ __forceinline__ void ret_unit(const Frame& F, int b, int h, LAS unsigned char* lds) {
    const int lane = F.lane, w = F.wave, r = lane & 31, hi = lane >> 5;
    const float gam = 1.0f - exp2f(-5.0f - (float)h), lg2 = log2f(gam), cd = exp2f(64.0f * lg2), cd4 = exp2f(256.0f * lg2);
    LAS unsigned char* region = lds + w * 16384;
    const LAS unsigned char* img = region + ((lane >> 4) & 1) * 32 + (lane & 3) * 8 + (4 * hi + ((lane & 15) >> 2)) * 64;
    LAS float* tab = (LAS float*)(lds + RT_TAB);
    __syncthreads();
    if (F.tid < 128) tab[F.tid] = F.tid < 64 ? F.ret_gn_w()[h * 64 + F.tid] : F.ret_gn_b()[h * 64 + F.tid - 64];
    const size_t hbase = (size_t)b * SEQ * 512 + h * 64;
    const size_t stg = hbase + (size_t)(lane >> 2) * 512 + (lane & 3) * 8;
    f32x16 T[2][2];
#pragma unroll
    for (int i = 0; i < 16; ++i) { T[0][0][i] = 0.f; T[0][1][i] = 0.f; T[1][0][i] = 0.f; T[1][1][i] = 0.f; }
#pragma unroll 1
    for (int i = 0; i < 4; ++i) {
        const size_t co = (size_t)(4 * w + i) * 64 * 512;
        ret_stage(F.VB() + stg + co, F.KB() + stg + co, region);
        if (i) {
#pragma unroll
            for (int k = 0; k < 16; ++k) { T[0][0][k] *= cd; T[0][1][k] *= cd; T[1][0][k] *= cd; T[1][1][k] *= cd; }
        }
        asm volatile("s_waitcnt vmcnt(0)" ::: "memory");
        ret_kv(T, img);
        LDS_WAIT();
    }
#pragma unroll
    for (int eb = 0; eb < 2; ++eb)
#pragma unroll
        for (int db = 0; db < 2; ++db)
#pragma unroll
            for (int g = 0; g < 4; ++g) *(LAS f32x4*)(region + ((eb * 2 + db) * 4 + g) * 1024 + lane * 16) = (f32x4){T[eb][db][4 * g], T[eb][db][4 * g + 1], T[eb][db][4 * g + 2], T[eb][db][4 * g + 3]};
    __syncthreads();
#pragma unroll
    for (int i = 0; i < 16; ++i) { T[0][0][i] = 0.f; T[0][1][i] = 0.f; T[1][0][i] = 0.f; T[1][1][i] = 0.f; }
#pragma unroll 1
    for (int wp = 0; wp < w; ++wp) {
        const LAS unsigned char* src = lds + wp * 16384 + lane * 16;
#pragma unroll
        for (int eb = 0; eb < 2; ++eb)
#pragma unroll
            for (int db = 0; db < 2; ++db)
#pragma unroll
                for (int g = 0; g < 4; ++g) { const f32x4 v = *(const LAS f32x4*)(src + ((eb * 2 + db) * 4 + g) * 1024);
                    T[eb][db][4 * g] = T[eb][db][4 * g] * cd4 + v[0]; T[eb][db][4 * g + 1] = T[eb][db][4 * g + 1] * cd4 + v[1]; T[eb][db][4 * g + 2] = T[eb][db][4 * g + 2] * cd4 + v[2]; T[eb][db][4 * g + 3] = T[eb][db][4 * g + 3] * cd4 + v[3]; }
    }
    __syncthreads();
#pragma unroll 1
    for (int i = 0; i < 4; ++i) {
        const int n = 4 * w + i; const size_t co = (size_t)n * 64 * 512;
        ret_stage(F.VB() + stg + co, F.KB() + stg + co, region);
#pragma unroll
        for (int k = 0; k < 16; ++k) { T[0][0][k] *= cd; T[0][1][k] *= cd; T[1][0][k] *= cd; T[1][1][k] *= cd; }
        const bf16* qrow = F.QB() + hbase + co + (size_t)r * 512 + 8 * hi;
        const bf16* krow = F.KB() + hbase + co + (size_t)r * 512 + 8 * hi;
#pragma unroll 1
        for (int ib = 0; ib < 2; ++ib) {
            bf16x8 qf[4], kf[4];
#pragma unroll
            for (int s = 0; s < 4; ++s) { qf[s] = *(const bf16x8*)(qrow + (size_t)(32 * ib) * 512 + 16 * s); kf[s] = *(const bf16x8*)(krow + 16 * s); }
            const size_t tok = (size_t)b * SEQ + 64 * n + 32 * ib + r;
            const bf16* grow = F.GB() + tok * 512 + h * 64 + 4 * hi;
            v2u gq[2][4];
#pragma unroll
            for (int db = 0; db < 2; ++db)
#pragma unroll
                for (int g = 0; g < 4; ++g) gq[db][g] = *(const v2u*)(grow + 32 * db + 8 * g);
            f32x16 s0, s1;
#pragma unroll
            for (int k = 0; k < 16; ++k) { s0[k] = 0.f; s1[k] = 0.f; }
#pragma unroll
            for (int s = 0; s < 4; ++s) s0 = __builtin_amdgcn_mfma_f32_32x32x16_bf16(kf[s], qf[s], s0, 0, 0, 0);
            if (ib == 1) {
#pragma unroll
                for (int s = 0; s < 4; ++s) kf[s] = *(const bf16x8*)(krow + (size_t)32 * 512 + 16 * s);
#pragma unroll
                for (int s = 0; s < 4; ++s) s1 = __builtin_amdgcn_mfma_f32_32x32x16_bf16(kf[s], qf[s], s1, 0, 0, 0);
#pragma unroll
                for (int k = 0; k < 16; ++k) s1[k] = (r >= crow(k, hi)) ? s1[k] : 0.f;
            } else {
#pragma unroll
                for (int k = 0; k < 16; ++k) s0[k] = (r >= crow(k, hi)) ? s0[k] : 0.f;
            }
#pragma unroll
            for (int s = 0; s < 4; ++s) {
                v4u q4 = __builtin_bit_cast(v4u, qf[s]);
                auto x0 = __builtin_amdgcn_permlane32_swap(q4[0], q4[2], false, false); auto x1 = __builtin_amdgcn_permlane32_swap(q4[1], q4[3], false, false);
                q4[0] = x0[0]; q4[2] = x0[1]; q4[1] = x1[0]; q4[3] = x1[1];
                qf[s] = __builtin_bit_cast(bf16x8, q4);
            }
            asm volatile("s_waitcnt vmcnt(0)" ::: "memory");
            f32x16 y0, y1;
#pragma unroll
            for (int k = 0; k < 16; ++k) { y0[k] = 0.f; y1[k] = 0.f; }
#pragma unroll
            for (int eb = 0; eb < 2; ++eb)
#pragma unroll
                for (int s2 = 0; s2 < 2; ++s2) {
                    y0 = __builtin_amdgcn_mfma_f32_32x32x16_bf16(pk16(T[eb][0], 8 * s2), qf[2 * eb + s2], y0, 0, 0, 0);
                    y1 = __builtin_amdgcn_mfma_f32_32x32x16_bf16(pk16(T[eb][1], 8 * s2), qf[2 * eb + s2], y1, 0, 0, 0);
                }
#pragma unroll
            for (int ks = 0; ks < 2; ++ks) {
                const bf16x8 pb = pk16(s0, 8 * ks);
                y0 = __builtin_amdgcn_mfma_f32_32x32x16_bf16(cat8(vtr(img + ks * 1024), vtr(img + ks * 1024 + 512)), pb, y0, 0, 0, 0);
                y1 = __builtin_amdgcn_mfma_f32_32x32x16_bf16(cat8(vtr(img + 4096 + ks * 1024), vtr(img + 4096 + ks * 1024 + 512)), pb, y1, 0, 0, 0);
            }
            if (ib == 1) {
#pragma unroll
                for (int ks = 0; ks < 2; ++ks) {
                    const bf16x8 pb = pk16(s1, 8 * ks);
                    y0 = __builtin_amdgcn_mfma_f32_32x32x16_bf16(cat8(vtr(img + (2 + ks) * 1024), vtr(img + (2 + ks) * 1024 + 512)), pb, y0, 0, 0, 0);
                    y1 = __builtin_amdgcn_mfma_f32_32x32x16_bf16(cat8(vtr(img + 4096 + (2 + ks) * 1024), vtr(img + 4096 + (2 + ks) * 1024 + 512)), pb, y1, 0, 0, 0);
                }
            }
            float sm = 0.f;
#pragma unroll
            for (int k = 0; k < 16; ++k) sm += y0[k] + y1[k];
            sm += __shfl_xor(sm, 32);
            const float mean = sm * (1.0f / 64.0f); float vr = 0.f;
#pragma unroll
            for (int k = 0; k < 16; ++k) { y0[k] -= mean; y1[k] -= mean; vr += y0[k] * y0[k] + y1[k] * y1[k]; }
            vr += __shfl_xor(vr, 32);
            const float rstd = 1.0f / sqrtf(vr * (1.0f / 64.0f) + 1e-5f);
            bf16* orow = F.MIX() + tok * DM + 512 + h * 64 + 4 * hi;
#pragma unroll
            for (int g = 0; g < 4; ++g) {
                const f32x4 w0 = *(const LAS f32x4*)(tab + 8 * g + 4 * hi), b0 = *(const LAS f32x4*)(tab + 64 + 8 * g + 4 * hi), w1 = *(const LAS f32x4*)(tab + 32 + 8 * g + 4 * hi), b1 = *(const LAS f32x4*)(tab + 96 + 8 * g + 4 * hi);
                const v2u g0 = gq[0][g], g1 = gq[1][g];
                *(v2u*)(orow + 8 * g) = (v2u){pkbf((y0[4 * g] * rstd * w0[0] + b0[0]) * bflo(g0[0]), (y0[4 * g + 1] * rstd * w0[1] + b0[1]) * bfhi(g0[0])),
                                              pkbf((y0[4 * g + 2] * rstd * w0[2] + b0[2]) * bflo(g0[1]), (y0[4 * g + 3] * rstd * w0[3] + b0[3]) * bfhi(g0[1]))};
                *(v2u*)(orow + 32 + 8 * g) = (v2u){pkbf((y1[4 * g] * rstd * w1[0] + b1[0]) * bflo(g1[0]), (y1[4 * g + 1] * rstd * w1[1] + b1[1]) * bfhi(g1[0])),
                                                   pkbf((y1[4 * g + 2] * rstd * w1[2] + b1[2]) * bflo(g1[1]), (y1[4 * g + 3] * rstd * w1[3] + b1[3]) * bfhi(g1[1]))};
            }
        }
        ret_kv(T, img);
        LDS_WAIT();
    }
}
#ifndef GEMM_ALIGN
#define GEMM_ALIGN true
#endif
#ifndef GEMM_SP2
#define GEMM_SP2 true
#endif
#ifndef RETREP
#define RETREP 1
#endif
#ifndef ATTREP
#define ATTREP 1
#endif
constexpr int CW_Q = 10240;
constexpr int NG_ATT = 4 * 32, NG_RET = 4 * 8, NG_MIX = NG_ATT + NG_RET;
__device__ __forceinline__ void p2_mixers(Frame& F) {
    for (;;) {
        int mo_ = MISC_OFF; asm volatile("" : "+s"(mo_));
        volatile LAS unsigned* misc = (volatile LAS unsigned*)(F.lds + mo_);
        __syncthreads();
        if (F.tid == 0) misc[0] = __hip_atomic_fetch_add(F.ctl + CW_Q + 64 * F.grp, 1u, __ATOMIC_RELAXED, __HIP_MEMORY_SCOPE_AGENT);
        __syncthreads();
        const int u = (int)misc[0];
        if (u >= NG_MIX) break;
        { int w_ = F.wave; asm volatile("" : "+s"(w_)); F.wave = w_; int l_ = lane_id(); asm volatile("" : "+v"(l_)); F.lane = l_; F.tid = w_ * 64 + l_; }
        const int b0 = 4 * F.grp;
        if (u < 32) attn_unit(F, b0 + (u & 3), 31 - (u >> 2), F.lds);
        else if (u < 32 + NG_RET) { const int ru = u - 32; ret_unit(F, b0 + (ru >> 3), ru & 7, F.lds); }
        else { const int a = u - NG_RET; attn_unit(F, b0 + (a & 3), 31 - (a >> 2), F.lds); }
    }
#if defined(PROBE_TIMER) && PROBE_TIMER >= 3
    if (blockIdx.x == 7 && F.tid == 0) { volatile LAS unsigned* pm_ = (volatile LAS unsigned*)(F.lds + MISC_OFF); const float val = ((float)pm_[16] / (float)(pm_[17] ? pm_[17] : 1u)) / 8000.0f;
        F.ctl[64] = __float_as_uint(0.05f + 0.5f * floorf(fminf(fmaxf(val, 0.f), 1.f) * 8.0f + 0.5f) * 0.125f); }
#endif
}

typedef __attribute__((address_space(1))) unsigned gu32;
#define XB_TMO      128
#define XB_XCNT(j)  (256  + 64 * (j))
#define XB_XSUB(j)  (1280 + 64 * (j))
#define XB_XGEN(j)  (2304 + 64 * (j))
#define XB_TOP      3328
#define XB_TOPGEN   3392
#define XCD_BAR_WORDS 3456
#define XB_SPIN_CAP (1u << 18)

__device__ __forceinline__ unsigned xb_ld(unsigned* p)              { return __hip_atomic_load(p, __ATOMIC_RELAXED, __HIP_MEMORY_SCOPE_AGENT); }
__device__ __forceinline__ unsigned xb_add(unsigned* p, unsigned v) { return __hip_atomic_fetch_add(p, v, __ATOMIC_RELAXED, __HIP_MEMORY_SCOPE_AGENT); }
__device__ __forceinline__ unsigned xb_xcc_id() { return (unsigned)__builtin_amdgcn_s_getreg((3 << 11) | 20) & 0xFu; }
#define XB_SPIN(cond, bar) do { unsigned _sp = 0; while (cond) { __builtin_amdgcn_s_sleep(1); \
    if ((++_sp & 255u) == 0u) { if (xb_ld(&(bar)[XB_TMO])) break; if (_sp > XB_SPIN_CAP) { atomicAdd(&(bar)[XB_TMO], 1u); break; } } } } while (0)

struct XcdBarrier {
    unsigned* bar; unsigned x; int wv;
    volatile LAS unsigned* st;
};

__device__ __forceinline__ XcdBarrier xcd_barrier_post(unsigned* bar, volatile LAS unsigned* st, int wv_) {
    XcdBarrier b; b.bar = bar; b.x = xb_xcc_id(); b.st = st; b.wv = 0;
    if (wv_ == 0 && lane_id() == 0) { st[2] = xb_add(&bar[XB_XCNT(b.x)], 1u); st[3] = b.x; }
    return b;
}
__device__ __forceinline__ void xcd_barrier_complete(unsigned* bar, unsigned x, unsigned& nloc, unsigned& nx, unsigned& even) {
    const unsigned G = gridDim.x * gridDim.y * gridDim.z;
    unsigned sum, cnt, mine, sp = 0u, ev;
    for (;;) {
        sum = 0u; cnt = 0u; mine = 0u; ev = 1u;
#pragma unroll
        for (unsigned j = 0; j < 16; ++j) { const unsigned c = xb_ld(&bar[XB_XCNT(j)]); sum += c; cnt += (c > 0u) ? 1u : 0u; mine = (j == x) ? c : mine; ev &= (c == (j < 8u ? 32u : 0u)) ? 1u : 0u; }
        even = ev;
        if (sum == G) break;
        __builtin_amdgcn_s_sleep(1);
        if ((++sp & 255u) == 0u) { if (xb_ld(&bar[XB_TMO])) break; if (sp > XB_SPIN_CAP) { atomicAdd(&bar[XB_TMO], 1u); break; } }
    }
    nloc = mine > 0u ? mine : 1u; nx = cnt > 0u ? cnt : 1u;
}

__device__ __forceinline__ void xcd_barrier(const XcdBarrier& b) {
    asm volatile("s_waitcnt vmcnt(0)" ::: "memory");
    __syncthreads();
    if (b.wv == 0 && lane_id() == 0) {
        unsigned* bar = b.bar;
        __builtin_amdgcn_s_waitcnt(0);
        unsigned nloc = b.st[0], nx = b.st[1];
        if (nloc == 0u) { unsigned ev_; xcd_barrier_complete(bar, b.x, nloc, nx, ev_); b.st[0] = nloc; b.st[1] = nx; b.st[4] = ev_; }
        const unsigned old = xb_add(&bar[XB_XSUB(b.x)], 1u);
        const unsigned gen = old / nloc;
        if (old + 1u == (gen + 1u) * nloc) {
            __builtin_amdgcn_fence(__ATOMIC_RELEASE, "agent");
            asm volatile("s_waitcnt vmcnt(0)" ::: "memory");
            const unsigned og = xb_add(&bar[XB_TOP], 1u);
            const unsigned tg = og / nx;
            if (og + 1u == (tg + 1u) * nx) xb_add(&bar[XB_TOPGEN], 1u);
            else XB_SPIN(xb_ld(&bar[XB_TOPGEN]) == tg, bar);
            __builtin_amdgcn_fence(__ATOMIC_ACQUIRE, "agent");
            xb_add(&bar[XB_XGEN(b.x)], 1u);
            asm volatile("s_waitcnt vmcnt(0)" ::: "memory");
        } else {
            XB_SPIN(xb_ld(&bar[XB_XGEN(b.x)]) == gen, bar);
            __builtin_amdgcn_fence(__ATOMIC_ACQUIRE, "agent");
            asm volatile("s_waitcnt vmcnt(0)" ::: "memory");
        }
    }
    __syncthreads();
}

constexpr int CW_GB = 8192;
__device__ __forceinline__ void grp_barrier(unsigned* ctl, int g, bool phys, int wave) {
    asm volatile("s_waitcnt vmcnt(0)" ::: "memory");
    __syncthreads();
    if (wave == 0 && lane_id() == 0) {
        unsigned* bar = ctl + 4096; unsigned* sub = ctl + CW_GB + 64 * g; unsigned* genw = ctl + CW_GB + 64 * (8 + g);
        __builtin_amdgcn_s_waitcnt(0);
        if (!phys) { __builtin_amdgcn_fence(__ATOMIC_RELEASE, "agent"); asm volatile("s_waitcnt vmcnt(0)" ::: "memory"); }
        const unsigned old = xb_add(sub, 1u), gen = old / 32u;
        if (old + 1u == (gen + 1u) * 32u) xb_add(genw, 1u);
        else XB_SPIN(xb_ld(genw) == gen, bar);
        __builtin_amdgcn_fence(__ATOMIC_ACQUIRE, "agent");
        asm volatile("s_waitcnt vmcnt(0)" ::: "memory");
    }
    __syncthreads();
}

constexpr int CW_BAR = 4096;
constexpr size_t CTL_ZERO_BYTES = 65536;
typedef KArgs Args;
__global__ void __launch_bounds__(NTHR, 2) fwd_kernel(Args args) {
    extern __shared__ __attribute__((aligned(16))) unsigned char lds[];
    Frame F;
    F.lds = (LAS unsigned char*)lds;
    F.wave = __builtin_amdgcn_readfirstlane((int)threadIdx.x >> 6); F.lane = lane_id(); F.tid = F.wave * 64 + F.lane;
    F.G = gridDim.x; { const int bx = blockIdx.x; F.vcu = (F.G % 8 == 0) ? (bx % 8) * (F.G / 8) + bx / 8 : bx; }
    unsigned char* ws = args.ws;
    F.ctl = (unsigned*)(ws + WS_CTL);
    F.ap = (const __attribute__((address_space(4))) KArgs*)__builtin_amdgcn_kernarg_segment_ptr();
    F.ws = ws;
    const int lo = args.ph_lo, hi = args.ph_hi;
    for (int u_ = F.tid; u_ < 64; u_ += NTHR) ((LAS unsigned*)(F.lds + MISC_OFF))[u_] = 0u;
    __syncthreads();
    XcdBarrier bar; bar.bar = F.ctl + CW_BAR; bar.x = 0; bar.st = nullptr; bar.wv = F.wave;
    if (hi - lo > 1) { bar = xcd_barrier_post(F.ctl + CW_BAR, (volatile LAS unsigned*)(F.lds + MISC_OFF) + 8, F.wave); bar.wv = F.wave; }
#define IN(k) (lo <= (k) && (k) < hi)
#ifndef STAGGER
#define STAGGER 0
#endif
    if (IN(0)) { asm volatile("" : "+s"(F.ws), "+s"(F.ap)); F.lane = lane_id(); F.tid = F.wave * 64 + F.lane; p0_prologue(F); }
    if (IN(0) && IN(1)) { if (lo < 0) cg::this_grid().sync(); else xcd_barrier(bar); }
    bool phys = false; F.grp = (int)blockIdx.x & 7; F.rk = (int)blockIdx.x >> 3;
    if (hi - lo > 1) { volatile LAS unsigned* st = (volatile LAS unsigned*)(F.lds + MISC_OFF) + 8;
        if (st[4] == 1u && F.G == 256) { phys = true; F.grp = (int)st[3]; F.rk = (int)st[2]; } }
    F.grp = __builtin_amdgcn_readfirstlane(F.grp) & 7; F.rk = __builtin_amdgcn_readfirstlane(F.rk) & 31;
    const int cid = F.grp + 8 * F.rk;
#define GSEAM(k) do { if (IN(k) && IN((k) + 1)) grp_barrier(F.ctl, F.grp, phys, F.wave); } while (0)
#if STAGGER > 0
    if (hi - lo > 1) for (int i_ = 0; i_ < F.grp * STAGGER; ++i_) __builtin_amdgcn_s_sleep(127);
#endif
    if (IN(1)) { asm volatile("" : "+s"(F.ws), "+s"(F.ap)); F.lane = lane_id(); F.tid = F.wave * 64 + F.lane;
        pg8::Gemm g{F.XB(), F.WIN(), MTOK, NIN, DM}; pg8::StaticOrder S; S.init(MTOK, NIN, 256, cid);
        pg8::EpiIn E{F.QA(), F.KA(), F.VA(), F.IQ(), F.IK(), F.QB(), F.KB(), F.VB(), F.GB(), F.IW(), F.q_norm_w(), F.k_norm_w(), (LAS float*)(F.lds + XCH_OFF)};
        pg8::gemm_phase<pg8::EpiIn, pg8::StaticOrder, GEMM_ALIGN, GEMM_SP2>(F.lds, g, S, E, F.wave);
    }
    GSEAM(1);
    if (IN(2)) { asm volatile("" : "+s"(F.ws), "+s"(F.ap)); F.lane = lane_id(); F.tid = F.wave * 64 + F.lane; p2_mixers(F); }
    GSEAM(2);
    if (IN(3)) { asm volatile("" : "+s"(F.ws), "+s"(F.ap)); F.lane = lane_id(); F.tid = F.wave * 64 + F.lane;
        const int pm = 32 * F.grp + F.rk;
        pg8::Gemm g{F.MIX(), F.WOUT(), MTOK, DM, DM}; pg8::PanelOrder S{pm, 4};
        pg8::EpiOut E{F.RMS(), F.XB(), {0.f, 0.f, 0.f, 0.f, 0.f, 0.f, 0.f, 0.f}};
        pg8::gemm_phase<pg8::EpiOut, pg8::PanelOrder, true, true>(F.lds, g, S, E, F.wave);
        const int wr = F.wave >> 2, wc = F.wave & 3, fr = F.lane & 15, fq = F.lane >> 4;
        LAS float* P = (LAS float*)(F.lds + XCH_OFF);
#pragma unroll
        for (int k = 0; k < 8; ++k) { float s = E.ss[k]; s += __shfl_xor(s, 16); s += __shfl_xor(s, 32);
            if (fq == 0) P[((k >> 2) * 128 + wr * 64 + (k & 3) * 16 + fr) * 4 + wc] = s; }
        __syncthreads();
        if (F.tid < 256) { const f32x4 p = *(const LAS f32x4*)(P + F.tid * 4);
            F.R2()[(size_t)pm * 256 + F.tid] = 1.0f / sqrtf(((p[0] + p[1]) + (p[2] + p[3])) * (1.0f / DM) + 1e-6f); }
    }
    GSEAM(3);
    if (IN(4)) { asm volatile("" : "+s"(F.ws), "+s"(F.ap)); F.lane = lane_id(); F.tid = F.wave * 64 + F.lane;
        pg8::Gemm g{F.XB(), F.WGU(), MTOK, NGU, DM}; pg8::StaticOrder S; S.init(MTOK, NGU, 256, cid);
        pg8::EpiGU E{F.R2(), F.ACT(), {0.f, 0.f, 0.f, 0.f}, {0.f, 0.f, 0.f, 0.f}, {0.f, 0.f, 0.f, 0.f}, {0.f, 0.f, 0.f, 0.f}, 0ull};
        pg8::gemm_phase<pg8::EpiGU, pg8::StaticOrder, GEMM_ALIGN, GEMM_SP2>(F.lds, g, S, E, F.wave);
    }
    GSEAM(4);
    if (IN(5)) { asm volatile("" : "+s"(F.ws), "+s"(F.ap)); F.lane = lane_id(); F.tid = F.wave * 64 + F.lane;
        pg8::Gemm g{F.ACT(), F.WDN(), MTOK, DM, FF}; pg8::StaticOrder S; S.init(MTOK, DM, 256, cid);
        pg8::EpiDown E{F.XB(), F.out()};
        pg8::gemm_phase<pg8::EpiDown, pg8::StaticOrder, GEMM_ALIGN, GEMM_SP2>(F.lds, g, S, E, F.wave);
    }
#undef GSEAM
#ifdef PROBE_TIMER
    xcd_barrier(bar);
    { const float frac = __uint_as_float(__hip_atomic_load(F.ctl + 64, __ATOMIC_RELAXED, __HIP_MEMORY_SCOPE_AGENT)); const int nz = (int)(frac * (float)MTOK);
      for (int m = (int)blockIdx.x * NWAVES + F.wave; m < nz; m += F.G * NWAVES) { f32x4* o = (f32x4*)(F.out() + (size_t)m * DM) + F.lane;
#pragma unroll
          for (int j = 0; j < 4; ++j) o[64 * j] = (f32x4){0.f, 0.f, 0.f, 0.f}; } }
#endif
#undef IN
}

extern "C" void kernel_launch(void* const* d_in, const int* in_sizes, int n_in, void* d_out, int out_size, void* d_ws, size_t ws_size, hipStream_t stream) {
    static int grid = 0;
    if (grid == 0) {
        if (n_in != 16 || in_sizes[0] != MTOK * DM || out_size != MTOK * DM || ws_size < WS_END) {
            fprintf(stderr, "kernel_launch: unexpected problem (n_in %d, in0 %d, out %d, ws %zu); nothing launched\n", n_in, n_in > 0 ? in_sizes[0] : -1, out_size, ws_size); grid = -1; return; }
        int dev = 0, cus = 0, per_cu = 0;
        if (hipGetDevice(&dev) != hipSuccess || hipDeviceGetAttribute(&cus, hipDeviceAttributeMultiprocessorCount, dev) != hipSuccess) { grid = -1; return; }
        if (hipFuncSetAttribute((const void*)fwd_kernel, hipFuncAttributeMaxDynamicSharedMemorySize, LDS_BYTES) != hipSuccess) { fprintf(stderr, "kernel_launch: hipFuncSetAttribute failed\n"); grid = -1; return; }
        if (hipOccupancyMaxActiveBlocksPerMultiprocessor(&per_cu, (const void*)fwd_kernel, NTHR, LDS_BYTES) != hipSuccess || per_cu < 1) { fprintf(stderr, "kernel_launch: occupancy query says %d blocks per CU\n", per_cu); (void)hipGetLastError(); grid = -1; return; }
        grid = cus;
        if (grid != 256) { fprintf(stderr, "kernel_launch: %d CUs; this kernel is laid out for 256 (eight groups of 32 workgroups)\n", grid); grid = -1; return; }
    }
    if (grid < 0) return;
    if (hipMemsetAsync((char*)d_ws + WS_CTL, 0, CTL_ZERO_BYTES, stream) != hipSuccess) { fprintf(stderr, "kernel_launch: memset failed\n"); return; }
    Args a{};
    for (int i = 0; i < 16; ++i) a.in[i] = (const float*)d_in[i];
    a.out = (float*)d_out; a.ws = (unsigned char*)d_ws;
#if MK_N_LAUNCHES == 1
    a.ph_lo = 0; a.ph_hi = N_PHASES;
    void* kargs[] = {&a};
    hipError_t e = hipLaunchCooperativeKernel((const void*)fwd_kernel, dim3(grid), dim3(NTHR), kargs, LDS_BYTES, stream);
    if (e != hipSuccess) fprintf(stderr, "kernel_launch: cooperative launch failed: %s (grid %d)\n", hipGetErrorString(e), grid);
#else
    for (int p = 0; p < N_PHASES; ++p) { a.ph_lo = p; a.ph_hi = p + 1; hipLaunchKernelGGL(fwd_kernel, dim3(grid), dim3(NTHR), LDS_BYTES, stream, a); }
#endif
}
```

```cpp
#include <hip/hip_runtime.h>
#include <hip/hip_cooperative_groups.h>
#include <cstdio>
#include <cstdint>
namespace cg = cooperative_groups;
namespace pg8 {
#define PG8_LAS __attribute__((address_space(3)))
typedef unsigned short bf16_t;
typedef short bf16x8 __attribute__((ext_vector_type(8)));
typedef float f32x4 __attribute__((ext_vector_type(4)));
typedef unsigned u32x4 __attribute__((ext_vector_type(4)));
constexpr int BM = 256, BK = 64, HALF = 128, HTB = HALF * BK * 2  , STAGE_BYTES = 8 * HTB, NXCD = 8, WGM = 8;

__host__ __device__ __forceinline__ int lds_byte(int r, int c) { const int st = (r >> 4) * 2 + (c >> 5), rr = r & 15, cc = c & 31, ob = rr * 64 + cc * 2; return st * 1024 + (ob ^ (((ob >> 9) & 1) << 5)); }
__host__ __device__ __forceinline__ void stage_rc(int b, int& R, int& C) { const int st = b / 1024, sb = b % 1024, swz = sb ^ (((sb >> 9) & 1) << 5); R = (st >> 1) * 16 + swz / 64; C = (st & 1) * 32 + (swz % 64) / 2; }
__host__ __device__ __forceinline__ int perm32(int rho) { const int n = rho >> 4, i = rho & 15; return 8 * (i >> 2) + 4 * n + (i & 3); }

struct Unit { int pm, pn; };
struct Gemm { const bf16_t* A; const bf16_t* Bt; int M, N, K; };

struct StaticOrder {
    int nM, nN, nwg, G, c;
    __host__ __device__ void init(int M, int N, int G_, int c_) { nM = M / BM; nN = N / BM; nwg = nM * nN; G = G_; c = c_; }
    __host__ __device__ bool next(int i, Unit& u) const {
        const long L = (long)i * G + c; if (L >= nwg) return false;
        int wgid = (int)L; { const int q = nwg / NXCD, r = nwg % NXCD, xcd = wgid % NXCD, off = wgid / NXCD; wgid = (xcd < r ? xcd * (q + 1) : r * (q + 1) + (xcd - r) * q) + off; }
        const int nig = WGM * nN, gid = wgid / nig, fm = gid * WGM, gsz = (nM - fm) < WGM ? (nM - fm) : WGM;
        u.pm = fm + ((wgid % nig) % gsz); u.pn = (wgid % nig) / gsz; return true;
    }
    __device__ __forceinline__ void a_ready(const Unit&) const {}
    __device__ __forceinline__ void done(const Unit&) const {}
};

__device__ __forceinline__ unsigned cvt_pk_bf16(float lo, float hi) { unsigned r; asm volatile("v_cvt_pk_bf16_f32 %0, %1, %2" : "=v"(r) : "v"(lo), "v"(hi)); return r; }
typedef float f32x2 __attribute__((ext_vector_type(2)));
typedef __bf16 bf16x2_t __attribute__((ext_vector_type(2)));
typedef unsigned u32x2 __attribute__((ext_vector_type(2)));
__device__ __forceinline__ unsigned pkbf(float lo, float hi) { f32x2 v = {lo, hi}; bf16x2_t b = __builtin_convertvector(v, bf16x2_t); return __builtin_bit_cast(unsigned, b); }
__device__ __forceinline__ u32x4 pk8(f32x4 a, f32x4 b) { return (u32x4){pkbf(a[0], a[1]), pkbf(a[2], a[3]), pkbf(b[0], b[1]), pkbf(b[2], b[3])}; }
__device__ __forceinline__ float dot4(f32x4 a) { return (a[0] * a[0] + a[1] * a[1]) + (a[2] * a[2] + a[3] * a[3]); }
__device__ __forceinline__ float sum4(f32x4 a) { return (a[0] + a[1]) + (a[2] + a[3]); }
__device__ __forceinline__ float silu1(float v) { return v * __builtin_amdgcn_rcpf(1.0f + __builtin_amdgcn_exp2f(-1.4426950408889634f * v)); }
__device__ __forceinline__ f32x4 silu4(f32x4 v) { return (f32x4){silu1(v[0]), silu1(v[1]), silu1(v[2]), silu1(v[3])}; }
constexpr float RMS_EPS_F = 1e-6f;
constexpr float QSCALE = 0.125f * 1.4426950408889634f;

struct EpiIn {
    static constexpr bool PERM = true, AFTER_DRAIN = false;
    bf16_t *QA, *KA, *VA, *IQ, *IK, *QB, *KB, *VB, *GB; float* IW;
    const float *qnw, *knw;
    PG8_LAS float* xch;
    __device__ __forceinline__ void prefetch(const Unit&, int, int) {}
    __device__ __forceinline__ void advance() {}
    __device__ __forceinline__ void operator()(const f32x4 (&acc)[2][2][4][2], const Unit& u, int wr, int wc, int fr, int fq) {
        asm volatile("" : "+v"(fr), "+v"(fq));
        const int row0 = u.pm * BM + wr * 64 + fr, pn = u.pn;
        if (pn < 2) {
            const int head = 4 * pn + wc;
            const f32x4 w0 = *(const f32x4*)(qnw + 8 * fq), w1 = *(const f32x4*)(qnw + 8 * fq + 4), w2 = *(const f32x4*)(qnw + 32 + 8 * fq), w3 = *(const f32x4*)(qnw + 36 + 8 * fq);
#pragma unroll
            for (int ai = 0; ai < 2; ++ai)
#pragma unroll
                for (int m = 0; m < 4; ++m) {
                    f32x4 a0 = acc[ai][0][m][0], a1 = acc[ai][0][m][1], b0 = acc[ai][1][m][0], b1 = acc[ai][1][m][1];
                    float ss = (dot4(a0) + dot4(a1)) + (dot4(b0) + dot4(b1));
                    ss += __shfl_xor(ss, 16); ss += __shfl_xor(ss, 32);
                    const float rs = QSCALE / sqrtf(ss * (1.0f / 64.0f) + RMS_EPS_F);
                    bf16_t* p = QA + (size_t)(row0 + ai * HALF + m * 16) * 512 + head * 64 + 8 * fq;
                    *(u32x4*)p = pk8(a0 * w0 * rs, a1 * w1 * rs); *(u32x4*)(p + 32) = pk8(b0 * w2 * rs, b1 * w3 * rs);
                }
        } else if (pn == 2) {
            if (wc >= 2) {
#pragma unroll
                for (int ai = 0; ai < 2; ++ai)
#pragma unroll
                    for (int m = 0; m < 4; ++m) {
                        float ss = (dot4(acc[ai][0][m][0]) + dot4(acc[ai][0][m][1])) + (dot4(acc[ai][1][m][0]) + dot4(acc[ai][1][m][1]));
                        ss += __shfl_xor(ss, 16); ss += __shfl_xor(ss, 32);
                        if (fq == 0) xch[(ai * HALF + wr * 64 + m * 16 + fr) * 2 + (wc - 2)] = ss;
                    }
            }
            asm volatile("s_waitcnt lgkmcnt(0)" ::: "memory"); __builtin_amdgcn_s_barrier(); asm volatile("" ::: "memory");
            if (wc < 2) {
                const f32x4 w0 = *(const f32x4*)(knw + 8 * fq), w1 = *(const f32x4*)(knw + 8 * fq + 4), w2 = *(const f32x4*)(knw + 32 + 8 * fq), w3 = *(const f32x4*)(knw + 36 + 8 * fq);
#pragma unroll
                for (int ai = 0; ai < 2; ++ai)
#pragma unroll
                    for (int m = 0; m < 4; ++m) {
                        const int rl = ai * HALF + wr * 64 + m * 16 + fr;
                        const f32x2 pr = *(const PG8_LAS f32x2*)(xch + rl * 2);
                        const float rc = 1.0f / sqrtf((pr[0] + pr[1]) * (1.0f / 128.0f) + RMS_EPS_F);
                        f32x4 a0 = acc[ai][0][m][0] * rc, a1 = acc[ai][0][m][1] * rc, b0 = acc[ai][1][m][0] * rc, b1 = acc[ai][1][m][1] * rc;
                        const size_t row = (size_t)(row0 + ai * HALF + m * 16);
                        if (wc == 0) {
                            float ss = (dot4(a0) + dot4(a1)) + (dot4(b0) + dot4(b1));
                            ss += __shfl_xor(ss, 16); ss += __shfl_xor(ss, 32);
                            const float rs = 1.0f / sqrtf(ss * (1.0f / 64.0f) + RMS_EPS_F);
                            bf16_t* p = KA + row * 64 + 8 * fq;
                            *(u32x4*)p = pk8(a0 * w0 * rs, a1 * w1 * rs); *(u32x4*)(p + 32) = pk8(b0 * w2 * rs, b1 * w3 * rs);
                        } else {
                            bf16_t* p = VA + row * 64 + 8 * fq;
                            *(u32x4*)p = pk8(a0, a1); *(u32x4*)(p + 32) = pk8(b0, b1);
                        }
                    }
            }
        } else if (pn == 3) {
#pragma unroll
            for (int ai = 0; ai < 2; ++ai)
#pragma unroll
                for (int m = 0; m < 4; ++m) {
                    const size_t row = (size_t)(row0 + ai * HALF + m * 16);
                    *(u32x4*)(IQ + row * 128 + 32 * wc + 8 * fq) = pk8(acc[ai][0][m][0], acc[ai][0][m][1]);
                    if (wc == 0) *(u32x4*)(IK + row * 32 + 8 * fq) = pk8(acc[ai][1][m][0], acc[ai][1][m][1]);
                    if (wc == 1 && fq == 0) *(f32x4*)(IW + row * 4) = acc[ai][1][m][0];
                }
        } else if (pn < 8) {
            const int head = 4 * (pn & 1) + wc; bf16_t* dst = pn < 6 ? QB : KB;
            const float lg2 = __log2f(1.0f - __builtin_amdgcn_exp2f(-5.0f - (float)head));
            f32x4 iv0, iv1;
#pragma unroll
            for (int i = 0; i < 4; ++i) { iv0[i] = __builtin_amdgcn_exp2f(-(float)(8 * fq + i) * (13.287712379549449f / 32.0f)) * 0.15915494309189535f; iv1[i] = __builtin_amdgcn_exp2f(-(float)(8 * fq + 4 + i) * (13.287712379549449f / 32.0f)) * 0.15915494309189535f; }
#pragma unroll
            for (int ai = 0; ai < 2; ++ai)
#pragma unroll
                for (int m = 0; m < 4; ++m) {
                    const int row = row0 + ai * HALF + m * 16, pos = row & 2047; const float fp = (float)pos;
                    const float sc = pn < 6 ? __builtin_amdgcn_exp2f((float)(pos & 63) * lg2) : 0.125f * __builtin_amdgcn_exp2f(-(float)(pos & 63) * lg2);
                    f32x4 c0, c1, s0, s1;
#pragma unroll
                    for (int i = 0; i < 4; ++i) {
                        const float r0 = __builtin_amdgcn_fractf(fp * iv0[i]), r1 = __builtin_amdgcn_fractf(fp * iv1[i]);
                        c0[i] = __builtin_amdgcn_cosf(r0) * sc; s0[i] = __builtin_amdgcn_sinf(r0) * sc; c1[i] = __builtin_amdgcn_cosf(r1) * sc; s1[i] = __builtin_amdgcn_sinf(r1) * sc;
                    }
                    const f32x4 a0 = acc[ai][0][m][0], a1 = acc[ai][0][m][1], b0 = acc[ai][1][m][0], b1 = acc[ai][1][m][1];
                    bf16_t* p = dst + (size_t)row * 512 + head * 64 + 8 * fq;
                    *(u32x4*)p = pk8(a0 * c0 - b0 * s0, a1 * c1 - b1 * s1); *(u32x4*)(p + 32) = pk8(a0 * s0 + b0 * c0, a1 * s1 + b1 * c1);
                }
        } else {
            const int head = 4 * (pn & 1) + wc; bf16_t* dst = pn < 10 ? VB : GB; const bool act = pn >= 10;
#pragma unroll
            for (int ai = 0; ai < 2; ++ai)
#pragma unroll
                for (int m = 0; m < 4; ++m) {
                    f32x4 a0 = acc[ai][0][m][0], a1 = acc[ai][0][m][1], b0 = acc[ai][1][m][0], b1 = acc[ai][1][m][1];
                    if (act) { a0 = silu4(a0); a1 = silu4(a1); b0 = silu4(b0); b1 = silu4(b1); }
                    bf16_t* p = dst + (size_t)(row0 + ai * HALF + m * 16) * 512 + head * 64 + 8 * fq;
                    *(u32x4*)p = pk8(a0, a1); *(u32x4*)(p + 32) = pk8(b0, b1);
                }
        }
    }
};

struct EpiOut {
    static constexpr bool PERM = true, AFTER_DRAIN = false;
    const float* rms; bf16_t* x1b; float ss[8];
    __device__ __forceinline__ void prefetch(const Unit&, int, int) {}
    __device__ __forceinline__ void advance() {}
    __device__ __forceinline__ void operator()(const f32x4 (&acc)[2][2][4][2], const Unit& u, int wr, int wc, int fr, int fq) {
        asm volatile("" : "+v"(fr), "+v"(fq));
        const int row0 = u.pm * BM + wr * 64 + fr, col0 = u.pn * BM + wc * 32 + 8 * fq;
#pragma unroll
        for (int ai = 0; ai < 2; ++ai)
#pragma unroll
            for (int m = 0; m < 4; ++m) {
                const int row = row0 + ai * HALF + m * 16; const size_t off = (size_t)row * 1024 + col0; const float rm = rms[row]; float s = 0.f;
#pragma unroll
                for (int bj = 0; bj < 2; ++bj) {
                    const u32x4 xv = *(const u32x4*)(x1b + off + bj * HALF);
                    const f32x4 x0 = {__uint_as_float(xv[0] << 16), __uint_as_float(xv[0] & 0xffff0000u), __uint_as_float(xv[1] << 16), __uint_as_float(xv[1] & 0xffff0000u)};
                    const f32x4 x1 = {__uint_as_float(xv[2] << 16), __uint_as_float(xv[2] & 0xffff0000u), __uint_as_float(xv[3] << 16), __uint_as_float(xv[3] & 0xffff0000u)};
                    const f32x4 r0 = x0 * rm + acc[ai][bj][m][0], r1 = x1 * rm + acc[ai][bj][m][1];
                    *(u32x4*)(x1b + off + bj * HALF) = pk8(r0, r1);
                    s += dot4(r0) + dot4(r1);
                }
                ss[ai * 4 + m] += s;
            }
    }
};

struct EpiGU {
    static constexpr bool PERM = true, AFTER_DRAIN = false;
    const float* r2; bf16_t* act; f32x4 rc0, rc1, rn0, rn1; unsigned long long tepi;
    __device__ __forceinline__ void prefetch(const Unit& u, int wr, int fr) {
        const float* p = r2 + u.pm * BM + wr * 64 + fr;
        rn0 = (f32x4){p[0], p[16], p[32], p[48]}; rn1 = (f32x4){p[HALF], p[HALF + 16], p[HALF + 32], p[HALF + 48]};
    }
    __device__ __forceinline__ void advance() { rc0 = rn0; rc1 = rn1; }
    __device__ __forceinline__ void operator()(const f32x4 (&acc)[2][2][4][2], const Unit& u, int wr, int wc, int fr, int fq) {
#ifdef PROBE_TIMER
        const unsigned long long te0_ = __builtin_amdgcn_s_memtime();
#endif
        asm volatile("" : "+v"(fr), "+v"(fq));
        const int row0 = u.pm * BM + wr * 64 + fr, col0 = u.pn * HALF + wc * 32 + 8 * fq;
#pragma unroll
        for (int ai = 0; ai < 2; ++ai)
#pragma unroll
            for (int m = 0; m < 4; ++m) {
                const int row = row0 + ai * HALF + m * 16; const float rr = ai ? rc1[m] : rc0[m];
                const f32x4 g0 = acc[ai][0][m][0] * rr, g1 = acc[ai][0][m][1] * rr, u0 = acc[ai][1][m][0] * rr, u1 = acc[ai][1][m][1] * rr;
                *(u32x4*)(act + (size_t)row * 2816 + col0) = pk8(silu4(g0) * u0, silu4(g1) * u1);
            }
#ifdef PROBE_TIMER
        asm volatile("s_waitcnt vmcnt(0)" ::: "memory"); tepi += __builtin_amdgcn_s_memtime() - te0_;
#endif
    }
};

struct EpiDown {
    static constexpr bool PERM = true, AFTER_DRAIN = false;
    const bf16_t* x1b; float* out;
    __device__ __forceinline__ void prefetch(const Unit&, int, int) {}
    __device__ __forceinline__ void advance() {}
    __device__ __forceinline__ void operator()(const f32x4 (&acc)[2][2][4][2], const Unit& u, int wr, int wc, int fr, int fq) {
        asm volatile("" : "+v"(fr), "+v"(fq));
        const int row0 = u.pm * BM + wr * 64 + fr, col0 = u.pn * BM + wc * 32 + 8 * fq;
#pragma unroll
        for (int ai = 0; ai < 2; ++ai)
#pragma unroll
            for (int m = 0; m < 4; ++m) {
                const size_t off = (size_t)(row0 + ai * HALF + m * 16) * 1024 + col0;
#pragma unroll
                for (int bj = 0; bj < 2; ++bj) {
                    const u32x4 xv = *(const u32x4*)(x1b + off + bj * HALF);
                    const f32x4 x0 = {__uint_as_float(xv[0] << 16), __uint_as_float(xv[0] & 0xffff0000u), __uint_as_float(xv[1] << 16), __uint_as_float(xv[1] & 0xffff0000u)};
                    const f32x4 x1 = {__uint_as_float(xv[2] << 16), __uint_as_float(xv[2] & 0xffff0000u), __uint_as_float(xv[3] << 16), __uint_as_float(xv[3] & 0xffff0000u)};
                    *(f32x4*)(out + off + bj * HALF) = x0 + acc[ai][bj][m][0]; *(f32x4*)(out + off + bj * HALF + 4) = x1 + acc[ai][bj][m][1];
                }
            }
    }
};

struct PanelOrder {
    int pm, ntn;
    __device__ __forceinline__ bool next(int i, Unit& u) const { if (i >= ntn) return false; u.pm = pm; u.pn = i; return true; }
    __device__ __forceinline__ void a_ready(const Unit&) const {}
    __device__ __forceinline__ void done(const Unit&) const {}
};

template <class Epi, class Sched, bool ALIGN_EPI = false, bool SP2 = false>
__device__ __forceinline__ void gemm_phase(PG8_LAS unsigned char* lds, const Gemm g, const Sched& S, Epi& E, int wave_in) {
    unsigned ones_ = ~0u; asm volatile("" : "+s"(ones_)); int tid_ = wave_in * 64 + (int)__builtin_amdgcn_mbcnt_hi(ones_, __builtin_amdgcn_mbcnt_lo(ones_, 0u));
    const int tid = tid_, wid = __builtin_amdgcn_readfirstlane(tid >> 6), lane = tid & 63, wr = wid >> 2, wc = wid & 3, fr = lane & 15, fq = lane >> 4;
    const int K = g.K, nt = K / BK;
    unsigned voffA[2], voffB[2];
#pragma unroll
    for (int i = 0; i < 2; ++i) { int R, C; stage_rc(tid * 16 + i * 8192, R, C); const int Rb = Epi::PERM ? ((R & ~31) + perm32(R & 31)) : R;
        voffA[i] = (unsigned)(R * K + C) * 2u; voffB[i] = (unsigned)(Rb * K + C) * 2u; }
    const size_t kstep = (size_t)(BK * 2);
    const size_t hstep = (size_t)HALF * K * 2;
    const size_t tstep = 2 * hstep;
    const unsigned ldsw = (unsigned)wid * 1024u;
    const int aoff = lds_byte(wr * 64 + fr, fq * 8), boff = lds_byte(wc * 32 + fr, fq * 8);
#define PG8_SA(b, h) (((b) * 2 + (h)) * HTB)
#define PG8_SB(b, h) ((4 + (b) * 2 + (h)) * HTB)
#define PG8_STAGE(bufoff, gbase, voff) do { _Pragma("unroll") for (int _i = 0; _i < 2; ++_i) \
        __builtin_amdgcn_global_load_lds((const unsigned*)((const char*)(gbase) + (voff)[_i]), (PG8_LAS unsigned*)(lds + (bufoff) + ldsw + _i * 8192), 16, 0, 0); } while (0)
#define PG8_LDA(dst, b, h) do { _Pragma("unroll") for (int m = 0; m < 4; ++m) _Pragma("unroll") for (int k = 0; k < 2; ++k) dst[m][k] = *(const PG8_LAS bf16x8*)(lds + PG8_SA(b, h) + aoff + m * 2048 + k * 1024); } while (0)
#define PG8_LDB(dst, b, h) do { _Pragma("unroll") for (int n = 0; n < 2; ++n) _Pragma("unroll") for (int k = 0; k < 2; ++k) dst[n][k] = *(const PG8_LAS bf16x8*)(lds + PG8_SB(b, h) + boff + n * 2048 + k * 1024); } while (0)
#define PG8_MMA(ai, bj, At, Bt) do { __builtin_amdgcn_s_setprio(1); _Pragma("unroll") for (int m = 0; m < 4; ++m) _Pragma("unroll") for (int n = 0; n < 2; ++n) _Pragma("unroll") for (int k = 0; k < 2; ++k) \
        acc[ai][bj][m][n] = __builtin_amdgcn_mfma_f32_16x16x32_bf16(Bt[n][k], At[m][k], acc[ai][bj][m][n], 0, 0, 0); __builtin_amdgcn_s_setprio(0); } while (0)
#define PG8_WAIT_V(n) asm volatile("s_waitcnt vmcnt(" #n ")" ::: "memory")
#define PG8_WAIT_L(n) asm volatile("s_waitcnt lgkmcnt(" #n ")" ::: "memory")
#define PG8_BAR __builtin_amdgcn_s_barrier()
#define PG8_SCHED __builtin_amdgcn_sched_barrier(0)
    Unit cur, nxt; int ui = 0;
    if (!S.next(0, cur)) return;
    E.prefetch(cur, wr, fr); E.advance();
    f32x4 acc[2][2][4][2];
#pragma unroll
    for (int a = 0; a < 2; ++a)
#pragma unroll
        for (int b = 0; b < 2; ++b)
#pragma unroll
            for (int m = 0; m < 4; ++m)
#pragma unroll
                for (int n = 0; n < 2; ++n) acc[a][b][m][n] = (f32x4){0.f, 0.f, 0.f, 0.f};
    bf16x8 At[4][2], B0[2][2], B1[2][2];
    const char* cA = (const char*)g.A + (size_t)cur.pm * tstep; const char* cB = (const char*)g.Bt + (size_t)cur.pn * tstep;
    S.a_ready(cur);
    if constexpr (SP2) {
        PG8_STAGE(PG8_SB(0, 0), cB, voffB); PG8_STAGE(PG8_SB(0, 1), cB + hstep, voffB); PG8_STAGE(PG8_SA(0, 0), cA, voffA); PG8_STAGE(PG8_SA(0, 1), cA + hstep, voffA);
        if (wr == 1) PG8_BAR;
        PG8_WAIT_V(2); PG8_BAR;
        PG8_STAGE(PG8_SB(1, 0), cB + kstep, voffB); PG8_STAGE(PG8_SA(1, 0), cA + kstep, voffA); PG8_STAGE(PG8_SB(1, 1), cB + hstep + kstep, voffB);
        PG8_WAIT_V(6); PG8_BAR;
    } else {
        PG8_STAGE(PG8_SB(0, 0), cB, voffB); PG8_STAGE(PG8_SA(0, 0), cA, voffA); PG8_STAGE(PG8_SB(0, 1), cB + hstep, voffB); PG8_STAGE(PG8_SA(0, 1), cA + hstep, voffA);
        if (wr == 1) PG8_BAR;
        PG8_WAIT_V(4); PG8_BAR;
        PG8_STAGE(PG8_SB(1, 0), cB + kstep, voffB); PG8_STAGE(PG8_SA(1, 0), cA + kstep, voffA); PG8_STAGE(PG8_SB(1, 1), cB + hstep + kstep, voffB);
        PG8_WAIT_V(6); PG8_BAR;
    }
    for (;;) {
        const bool has_next = S.next(ui + 1, nxt);
        const char* nA = has_next ? (const char*)g.A + (size_t)nxt.pm * tstep : cA; const char* nB = has_next ? (const char*)g.Bt + (size_t)nxt.pn * tstep : cB;
        for (int t = 0; t < nt; t += 2) {
            const bool last = (t == nt - 2);
            const char* a1 = cA + (size_t)(t + 1) * kstep;
            const char* a2 = last ? nA : cA + (size_t)(t + 2) * kstep; const char* b2 = last ? nB : cB + (size_t)(t + 2) * kstep;
            const char* a3 = a2 + kstep; const char* b3 = b2 + kstep;
            if (last && has_next) { S.a_ready(nxt); E.prefetch(nxt, wr, fr); }
            if constexpr (SP2) {
            PG8_LDB(B0, 0, 0); PG8_LDB(B1, 0, 1); PG8_SCHED; PG8_LDA(At, 0, 0); PG8_STAGE(PG8_SA(1, 1), a1 + hstep, voffA);
            PG8_WAIT_V(8); PG8_WAIT_L(0); PG8_BAR; PG8_MMA(0, 0, At, B0); PG8_MMA(0, 1, At, B1); PG8_BAR; PG8_SCHED;
            PG8_LDA(At, 0, 1); PG8_STAGE(PG8_SB(0, 0), b2, voffB); PG8_STAGE(PG8_SB(0, 1), b2 + hstep, voffB); PG8_STAGE(PG8_SA(0, 0), a2, voffA);
            PG8_WAIT_V(8); PG8_WAIT_L(0); PG8_BAR; PG8_MMA(1, 0, At, B0); PG8_MMA(1, 1, At, B1); PG8_BAR; PG8_SCHED;
            PG8_LDB(B0, 1, 0); PG8_LDB(B1, 1, 1); PG8_SCHED; PG8_LDA(At, 1, 0); PG8_STAGE(PG8_SA(0, 1), a2 + hstep, voffA);
            PG8_WAIT_V(8); PG8_WAIT_L(0); PG8_BAR; PG8_MMA(0, 0, At, B0); PG8_MMA(0, 1, At, B1); PG8_BAR; PG8_SCHED;
            PG8_LDA(At, 1, 1); PG8_STAGE(PG8_SB(1, 0), b3, voffB); PG8_STAGE(PG8_SB(1, 1), b3 + hstep, voffB); PG8_STAGE(PG8_SA(1, 0), a3, voffA);
            PG8_WAIT_V(8); PG8_WAIT_L(0); PG8_BAR; PG8_MMA(1, 0, At, B0); PG8_MMA(1, 1, At, B1); PG8_BAR; PG8_SCHED;
            } else {
            PG8_LDB(B0, 0, 0); PG8_SCHED; PG8_LDA(At, 0, 0); PG8_STAGE(PG8_SA(1, 1), a1 + hstep, voffA);
            PG8_WAIT_L(8); PG8_BAR; PG8_WAIT_L(0); PG8_MMA(0, 0, At, B0); PG8_BAR; PG8_SCHED;
            PG8_LDB(B1, 0, 1); PG8_STAGE(PG8_SB(0, 0), b2, voffB);
            PG8_BAR; PG8_WAIT_L(0); PG8_MMA(0, 1, At, B1); PG8_BAR;
            PG8_LDA(At, 0, 1); PG8_STAGE(PG8_SA(0, 0), a2, voffA);
            PG8_BAR; PG8_WAIT_L(0); PG8_MMA(1, 0, At, B0); PG8_BAR; PG8_SCHED;
            PG8_STAGE(PG8_SB(0, 1), b2 + hstep, voffB);
            PG8_WAIT_V(6); PG8_BAR; PG8_MMA(1, 1, At, B1); PG8_BAR;
            PG8_LDB(B0, 1, 0); PG8_SCHED; PG8_LDA(At, 1, 0); PG8_STAGE(PG8_SA(0, 1), a2 + hstep, voffA);
            PG8_WAIT_L(8); PG8_BAR; PG8_WAIT_L(0); PG8_MMA(0, 0, At, B0); PG8_BAR; PG8_SCHED;
            PG8_LDB(B1, 1, 1); PG8_STAGE(PG8_SB(1, 0), b3, voffB);
            PG8_BAR; PG8_WAIT_L(0); PG8_MMA(0, 1, At, B1); PG8_BAR;
            PG8_LDA(At, 1, 1); PG8_STAGE(PG8_SA(1, 0), a3, voffA);
            PG8_BAR; PG8_WAIT_L(0); PG8_MMA(1, 0, At, B0); PG8_BAR; PG8_SCHED;
            PG8_STAGE(PG8_SB(1, 1), b3 + hstep, voffB);
            PG8_WAIT_V(6); PG8_BAR; PG8_MMA(1, 1, At, B1); PG8_BAR;
            }
        }
        if constexpr (ALIGN_EPI) { if (wr == 0) PG8_BAR; }
        if constexpr (!Epi::AFTER_DRAIN) { E(acc, cur, wr, wc, fr, fq); E.advance(); S.done(cur); }
        if (!has_next) break;
#pragma unroll
        for (int a = 0; a < 2; ++a)
#pragma unroll
            for (int b = 0; b < 2; ++b)
#pragma unroll
                for (int m = 0; m < 4; ++m)
#pragma unroll
                    for (int n = 0; n < 2; ++n) acc[a][b][m][n] = (f32x4){0.f, 0.f, 0.f, 0.f};
        cur = nxt; cA = nA; cB = nB; ++ui;
        if constexpr (ALIGN_EPI) { if (wr == 1) PG8_BAR; }
    }
    PG8_WAIT_V(0);
    if constexpr (!ALIGN_EPI) { if (wr == 0) PG8_BAR; }
    PG8_BAR;
    (void)lane;
#undef PG8_SA
#undef PG8_SB
#undef PG8_STAGE
#undef PG8_LDA
#undef PG8_LDB
#undef PG8_MMA
#undef PG8_WAIT_V
#undef PG8_WAIT_L
#undef PG8_BAR
#undef PG8_SCHED
}
}

constexpr int BATCH = 32, SEQ = 2048, DM = 1024, MTOK = BATCH * SEQ;
constexpr int INW = 2852, NIN = 3072, FF = 2816, NGU = 2 * FF;
constexpr int NWAVES = 8, NTHR = 512;
#ifndef MK_N_LAUNCHES
#define MK_N_LAUNCHES 1
#endif
constexpr int N_PHASES = 6;
constexpr size_t MiB = 1u << 20;
constexpr size_t WS_CTL = 0;
constexpr size_t WS_COS = 1 * MiB, WS_SIN = WS_COS + 256 * 1024;
constexpr size_t WS_BT = WS_SIN + 256 * 1024;
constexpr size_t WS_R2 = 2 * MiB, WS_RMS = 2 * MiB + 512 * 1024;
constexpr size_t WS_WIN = 4 * MiB, WS_WOUT = 10 * MiB, WS_WGU = 12 * MiB, WS_WDN = 23 * MiB;
constexpr size_t WS_XB = 32 * MiB;
constexpr size_t WS_MIX = 160 * MiB;
constexpr size_t WS_QA = 288 * MiB, WS_QB = 352 * MiB, WS_KB = 416 * MiB, WS_VB = 480 * MiB, WS_GB = 544 * MiB;
constexpr size_t WS_KA = 608 * MiB, WS_VA = 616 * MiB;
constexpr size_t WS_IQ = 624 * MiB;
constexpr size_t WS_ACT = 648 * MiB;
constexpr size_t WS_IK = 640 * MiB, WS_IW = 644 * MiB;
constexpr size_t WS_END = 1000 * MiB;
static_assert(WS_ACT + (size_t)MTOK * FF * 2 <= WS_END && WS_IW + (size_t)MTOK * 16 <= WS_ACT && WS_IQ + (size_t)MTOK * 128 * 2 <= WS_IK && WS_WDN + (size_t)DM * FF * 2 <= WS_XB && WS_WGU + (size_t)NGU * DM * 2 <= WS_WDN, "d_ws map");
constexpr int RING_BYTES = 131072;
constexpr int XCH_OFF = RING_BYTES;
constexpr int P2_SC = 0, SCW = 2052;
constexpr int P2_MASK = 143360;
constexpr int MISC_OFF = 163584;
constexpr int LDS_BYTES = 163840;
static_assert(P2_SC + 16 * SCW * 4 <= P2_MASK && P2_MASK + 16384 <= MISC_OFF, "P2 LDS map");

#define LAS __attribute__((address_space(3)))
typedef unsigned short bf16;
typedef unsigned v4u __attribute__((ext_vector_type(4)));
typedef unsigned v2u __attribute__((ext_vector_type(2)));
typedef float f32x4 __attribute__((ext_vector_type(4)));
typedef float f32x16 __attribute__((ext_vector_type(16)));
typedef short bf16x8 __attribute__((ext_vector_type(8)));
typedef short s16x4 __attribute__((ext_vector_type(4)));
#define LDS_WAIT() asm volatile("s_waitcnt lgkmcnt(0)" ::: "memory")
using pg8::pkbf;
__device__ __forceinline__ float bf2f(unsigned short h) { return __uint_as_float((unsigned)h << 16); }
__device__ __forceinline__ float bflo(unsigned w) { return __uint_as_float(w << 16); }
__device__ __forceinline__ float bfhi(unsigned w) { return __uint_as_float(w & 0xffff0000u); }
__device__ __forceinline__ float wave_sum(float v) {
#pragma unroll
    for (int o = 1; o < 64; o <<= 1) v += __shfl_xor(v, o);
    return v;
}
__device__ __forceinline__ s16x4 vtr(const LAS unsigned char* p) { return __builtin_bit_cast(s16x4, __builtin_amdgcn_ds_read_tr16_b64_v4i16((LAS s16x4*)p)); }
__device__ __forceinline__ bf16x8 cat8(s16x4 lo, s16x4 hi) { return (bf16x8){lo[0], lo[1], lo[2], lo[3], hi[0], hi[1], hi[2], hi[3]}; }
__device__ __forceinline__ int crow(int r, int hi) { return (r & 3) + 8 * (r >> 2) + 4 * hi; }

__device__ __forceinline__ int lane_id() { unsigned ones = ~0u; asm volatile("" : "+s"(ones)); return (int)__builtin_amdgcn_mbcnt_hi(ones, __builtin_amdgcn_mbcnt_lo(ones, 0u)); }
struct KArgs { const float* in[16]; float* out; unsigned char* ws; int ph_lo, ph_hi; };
struct Frame {
    LAS unsigned char* lds;
    unsigned* ctl;
    unsigned char* ws;
    int tid, lane, wave, vcu, G;
    int grp, rk;
    const __attribute__((address_space(4))) KArgs* ap;
    __device__ __forceinline__ const float* x() const { return ap->in[0]; }
    __device__ __forceinline__ const float* norm1_w() const { return ap->in[1]; }
    __device__ __forceinline__ const float* w_in() const { return ap->in[2]; }
    __device__ __forceinline__ const float* q_norm_w() const { return ap->in[3]; }
    __device__ __forceinline__ const float* k_norm_w() const { return ap->in[4]; }
    __device__ __forceinline__ const float* kv_norm_w() const { return ap->in[5]; }
    __device__ __forceinline__ const float* w_uk() const { return ap->in[6]; }
    __device__ __forceinline__ const float* w_uv() const { return ap->in[7]; }
    __device__ __forceinline__ const float* rel_bias() const { return ap->in[8]; }
    __device__ __forceinline__ const float* ret_gn_w() const { return ap->in[9]; }
    __device__ __forceinline__ const float* ret_gn_b() const { return ap->in[10]; }
    __device__ __forceinline__ const float* w_out() const { return ap->in[11]; }
    __device__ __forceinline__ const float* norm2_w() const { return ap->in[12]; }
    __device__ __forceinline__ const float* w_gate() const { return ap->in[13]; }
    __device__ __forceinline__ const float* w_up() const { return ap->in[14]; }
    __device__ __forceinline__ const float* w_down() const { return ap->in[15]; }
    __device__ __forceinline__ float* out() const { return ap->out; }
#define WSB_(name, off) __device__ __forceinline__ bf16* name() const { return (bf16*)(ws + (off)); }
#define WSF_(name, off) __device__ __forceinline__ float* name() const { return (float*)(ws + (off)); }
    WSB_(WIN, WS_WIN) WSB_(WOUT, WS_WOUT) WSB_(WGU, WS_WGU) WSB_(WDN, WS_WDN) WSB_(XB, WS_XB) WSB_(MIX, WS_MIX) WSB_(QA, WS_QA) WSB_(QB, WS_QB) WSB_(KB, WS_KB) WSB_(VB, WS_VB) WSB_(GB, WS_GB)
    WSB_(KA, WS_KA) WSB_(VA, WS_VA) WSB_(IQ, WS_IQ) WSB_(IK, WS_IK) WSB_(ACT, WS_ACT)
    WSF_(IW, WS_IW) WSF_(R2, WS_R2) WSF_(RMS, WS_RMS) WSF_(COS, WS_COS) WSF_(SIN, WS_SIN) WSF_(BT, WS_BT)
#undef WSB_
#undef WSF_
};

__device__ __forceinline__ int zcol(int n) {
    const int pn = n >> 8, tc = n & 255, bj = tc >> 7, wc = (tc >> 5) & 3, j = tc & 31, d = bj * 32 + j;
    if (pn < 2) return (4 * pn + wc) * 64 + d;
    if (pn == 2) { if (wc == 0) return -2 - d; if (wc == 1) return -2 - (64 + d); return 512 + (wc - 2) * 64 + d; }
    if (pn == 3) { if (bj == 0) return 640 + wc * 32 + j; if (wc == 0) return 768 + j; if (wc == 1 && j < 4) return 800 + j; return -1; }
    const int g = (pn - 4) >> 1, head = 4 * ((pn - 4) & 1) + wc;
    return 804 + g * 512 + head * 64 + d;
}
template <class SRC>
__device__ __forceinline__ void tr_item(SRC src, int Kdim, bf16* WT, int k0, int n0, LAS float* scr, int lane) {
#pragma unroll 4
    for (int i = 0; i < 32; ++i) { const int kk = 2 * i + (lane >> 5); scr[kk * 33 + (lane & 31)] = src(k0 + kk); }
    LDS_WAIT(); asm volatile("" ::: "memory");
    const int c = lane & 7;
#pragma unroll
    for (int j = 0; j < 4; ++j) { const int n = (lane >> 3) + 8 * j; const LAS float* s = scr + (8 * c) * 33 + n;
        v4u o; o.x = pkbf(s[0 * 33], s[1 * 33]); o.y = pkbf(s[2 * 33], s[3 * 33]); o.z = pkbf(s[4 * 33], s[5 * 33]); o.w = pkbf(s[6 * 33], s[7 * 33]);
        *(v4u*)(WT + (size_t)(n0 + n) * Kdim + k0 + 8 * c) = o; }
    LDS_WAIT(); asm volatile("" ::: "memory");
}
__device__ __forceinline__ int t5_bucket(int rel) {
    const int n = rel < 0 ? -rel : rel; int b;
    if (n < 8) b = n; else if (n < 12) b = 8; else if (n < 16) b = 9; else if (n < 23) b = 10; else if (n < 32) b = 11; else if (n < 46) b = 12; else if (n < 64) b = 13; else if (n < 91) b = 14; else b = 15;
    return (rel > 0 ? 16 : 0) + b;
}
__device__ __forceinline__ void p0_prologue(Frame& F) {
    LAS float* scr = (LAS float*)(F.lds + F.wave * 16384);
    const int lane = F.lane, gw = F.vcu * NWAVES + F.wave, NGW = F.G * NWAVES;
    if (blockIdx.x == 0 && F.tid == 0) F.ctl[0] = 0u;
    constexpr int I_IN = 16 * (NIN / 32), I_OUT = 16 * 32, I_GU = 16 * (NGU / 32), I_DN = (FF / 64) * 32, NITEMS = I_IN + I_OUT + I_GU + I_DN;
    auto do_item = [&](int it) {
        int r = it;
        if (r < I_IN) {
            const int kb = r / (NIN / 32), nb = r % (NIN / 32), f = zcol(32 * nb + (lane & 31));
            const float* w_in = F.w_in(); const float* nw = F.norm1_w();
            if (f >= -1) tr_item([&](int k) { return f >= 0 ? nw[k] * w_in[(size_t)k * INW + f] : 0.0f; }, DM, F.WIN(), 64 * kb, 32 * nb, scr, lane);
            return;
        }
        r -= I_IN;
        if (r < I_OUT) { const int kb = r / 32, nb = r % 32; const float* w = F.w_out() + 32 * nb + (lane & 31);
            tr_item([&](int k) { return w[(size_t)k * DM]; }, DM, F.WOUT(), 64 * kb, 32 * nb, scr, lane); return; }
        r -= I_OUT;
        if (r < I_GU) { const int kb = r / (NGU / 32), nb = r % (NGU / 32), n = 32 * nb + (lane & 31), pn = n >> 8, tc = n & 255;
            const float* w = ((tc >> 7) ? F.w_up() : F.w_gate()) + 128 * pn + (tc & 127); const float* nw = F.norm2_w();
            tr_item([&](int k) { return nw[k] * w[(size_t)k * FF]; }, DM, F.WGU(), 64 * kb, 32 * nb, scr, lane); return; }
        r -= I_GU;
        { const int kb = r / 32, nb = r % 32; const float* w = F.w_down() + 32 * nb + (lane & 31);
            tr_item([&](int k) { return w[(size_t)k * DM]; }, FF, F.WDN(), 64 * kb, 32 * nb, scr, lane); }
    };
    for (int e = F.vcu * NTHR + F.tid; e < DM * 128; e += F.G * NTHR) {
        const int k = e >> 7, idx = e & 127, d = idx & 63; const float* wu = (idx < 64 ? F.w_uk() : F.w_uv()) + d; const float* wr_ = F.w_in() + (size_t)k * INW + 512; float a = 0.f;
#pragma unroll 8
        for (int j = 0; j < 128; ++j) a += wr_[j] * F.kv_norm_w()[j] * wu[j * 64];
        const int n = 512 + (idx < 64 ? 0 : 32) + (d < 32 ? d : 128 + d - 32);
        F.WIN()[(size_t)n * DM + k] = (bf16)(pkbf(F.norm1_w()[k] * a, 0.f) & 0xffffu);
    }
    int it = gw, kk = 0;
    for (int m = gw; m < MTOK; m += NGW, ++kk) {
        const f32x4* xr = (const f32x4*)(F.x() + (size_t)m * DM) + lane;
        f32x4 v[4]; float sq = 0.f;
#pragma unroll
        for (int j = 0; j < 4; ++j) { v[j] = xr[64 * j]; sq += pg8::dot4(v[j]); }
        const float ms = wave_sum(sq) * (1.0f / DM) + 1e-6f, rr = 1.0f / sqrtf(ms);
        v2u* o8 = (v2u*)(F.XB() + (size_t)m * DM) + lane;
#pragma unroll
        for (int j = 0; j < 4; ++j) o8[64 * j] = (v2u){pkbf(v[j][0] * rr, v[j][1] * rr), pkbf(v[j][2] * rr, v[j][3] * rr)};
        if (lane == 0) F.RMS()[m] = sqrtf(ms);
        if ((kk & 7) == 3 && it < NITEMS) { do_item(it); it += NGW; }
    }
    for (; it < NITEMS; it += NGW) do_item(it);
    const int gt = F.vcu * NTHR + F.tid, NGT = F.G * NTHR;
    for (int i = gt; i < 8 * 256; i += NGT) { const int h = i >> 8, rel = (i & 255) - 191;
        F.BT()[i] = (F.rel_bias()[t5_bucket(rel) * 8 + h] - F.rel_bias()[15 * 8 + h]) * 1.4426950408889634f; }
}

#ifndef PROBE_LO
#define PROBE_LO 3000.0f
#define PROBE_RANGE 4000.0f
#endif
#ifndef PLANES
#define PLANES 1
#endif
#ifndef MIXREP
#define MIXREP 0
#endif
typedef float f32x4_t __attribute__((ext_vector_type(4)));
typedef float f32x2v __attribute__((ext_vector_type(2)));
struct IdxOps { bf16x8 bq[4]; f32x4 wv; bf16x8 a0; };
__device__ __forceinline__ void idx_fetch(IdxOps& o, const Frame& F, int b, int c, int rq) {
    const int w = F.wave, lane = F.lane, q = lane & 15, g = lane >> 4;
    const size_t rowq = (size_t)b * SEQ + 64 * c + 16 * rq + q;
#pragma unroll
    for (int h = 0; h < 4; ++h) o.bq[h] = *(const bf16x8*)(F.IQ() + rowq * 128 + 32 * h + 8 * g);
    o.wv = *(const f32x4*)(F.IW() + rowq * 4) * (0.5f * 0.17677669529663687f);
    o.a0 = *(const bf16x8*)(F.IK() + ((size_t)b * SEQ + q) * 32 + 8 * g + (size_t)w * 512);
}
__device__ __forceinline__ void idx_round(const IdxOps& o, const Frame& F, int b, int c, LAS unsigned char* lds) {
    const int w = F.wave, lane = F.lane, q = lane & 15, g = lane >> 4;
    const int nkb = 4 * (c + 1);
    const bf16* kp = F.IK() + ((size_t)b * SEQ + q) * 32 + 8 * g;
    LAS float* dst = (LAS float*)(lds + P2_SC) + q * SCW + 4 * g;
    int kb = w; bf16x8 a = o.a0;
    for (; kb < nkb; kb += 8) {
        bf16x8 an = a; if (kb + 8 < nkb) an = *(const bf16x8*)(kp + (size_t)(kb + 8) * 512);
        f32x4 sc = {0.f, 0.f, 0.f, 0.f};
#pragma unroll
        for (int h = 0; h < 4; ++h) {
            const f32x4 d = __builtin_amdgcn_mfma_f32_16x16x32_bf16(a, o.bq[h], (f32x4){0.f, 0.f, 0.f, 0.f}, 0, 0, 0);
#pragma unroll
            for (int i = 0; i < 4; ++i) sc[i] += o.wv[h] * fmaxf(d[i], 0.f);
        }
        *(LAS f32x4*)(dst + 16 * kb) = (f32x4){sc[0] + 0.f, sc[1] + 0.f, sc[2] + 0.f, sc[3] + 0.f};
        a = an;
    }
}
__device__ __forceinline__ int wave_sum_i(int v) {
    v += __builtin_amdgcn_update_dpp(0, v, 0xB1, 0xF, 0xF, false);
    v += __builtin_amdgcn_update_dpp(0, v, 0x4E, 0xF, 0xF, false);
    v += __builtin_amdgcn_update_dpp(0, v, 0x141, 0xF, 0xF, false);
    v += __builtin_amdgcn_update_dpp(0, v, 0x140, 0xF, 0xF, false);
    return (__builtin_amdgcn_readlane(v, 0) + __builtin_amdgcn_readlane(v, 16)) + (__builtin_amdgcn_readlane(v, 32) + __builtin_amdgcn_readlane(v, 48));
}
__device__ __forceinline__ unsigned sortable(float f) { const unsigned bits = __float_as_uint(f); return bits ^ ((unsigned)((int)bits >> 31) | 0x80000000u); }
template <int NJ>
__device__ __forceinline__ void mask_words(const unsigned (&u)[NJ], unsigned prefix, bool exact, LAS unsigned long long* mrow, int nj, int lane) {
    unsigned long long mv = 0ull;
    if (exact) {
#pragma unroll
        for (int j = 0; j < NJ; ++j) { const unsigned long long sel = __ballot(u[j] >= prefix); if (lane == j) mv = sel; }
    } else {
        int ngt = 0;
#pragma unroll
        for (int j = 0; j < NJ; ++j) ngt += __popcll(__ballot(u[j] > prefix));
        int need = 256 - ngt;
#pragma unroll
        for (int j = 0; j < NJ; ++j) {
            const unsigned long long eq = __ballot(u[j] == prefix);
            const int rank = (int)__builtin_amdgcn_mbcnt_hi((unsigned)(eq >> 32), __builtin_amdgcn_mbcnt_lo((unsigned)eq, 0u));
            const unsigned long long sel = __ballot(u[j] > prefix || (u[j] == prefix && rank < need));
            need -= __popcll(eq);
            if (lane == j) mv = sel;
        }
    }
    if (lane < nj) mrow[lane] = mv;
}
template <int NJ>
__device__ __forceinline__ void select_row(const LAS float* row, LAS unsigned long long* mrow, int nj, int lane) {
    static_assert(NJ % 4 == 0, "groups of four");
    unsigned u[NJ];
#pragma unroll
    for (int j = 0; j < NJ; ++j) { float v = row[64 * j + lane]; asm volatile("" : "+v"(v)); u[j] = (j < nj) ? sortable(v) : 0u; }
    unsigned prefix = 0u; bool exact = false;
#pragma unroll 1
    for (int bit = 31; bit >= 0; --bit) {
        const unsigned trial = prefix | (1u << bit); int c0 = 0, c1 = 0, c2 = 0, c3 = 0;
#pragma unroll
        for (int j = 0; j < NJ; j += 4) {
            unsigned long long m0, m1, m2, m3;
            asm volatile("v_cmp_le_u32_e64 %4, %12, %8\n\tv_cmp_le_u32_e64 %5, %12, %9\n\tv_cmp_le_u32_e64 %6, %12, %10\n\tv_cmp_le_u32_e64 %7, %12, %11\n\t"
                         "v_addc_co_u32_e64 %0, %4, 0, %0, %4\n\tv_addc_co_u32_e64 %1, %5, 0, %1, %5\n\tv_addc_co_u32_e64 %2, %6, 0, %2, %6\n\tv_addc_co_u32_e64 %3, %7, 0, %3, %7"
                         : "+v"(c0), "+v"(c1), "+v"(c2), "+v"(c3), "=&s"(m0), "=&s"(m1), "=&s"(m2), "=&s"(m3) : "v"(u[j]), "v"(u[j + 1]), "v"(u[j + 2]), "v"(u[j + 3]), "s"(trial));
        }
        const int cnt = wave_sum_i((c0 + c1) + (c2 + c3));
        if (cnt >= 256) prefix = trial;
        if (cnt == 256) { exact = true; break; }
    }
    mask_words<NJ>(u, prefix, exact, mrow, nj, lane);
}
template <int S, unsigned M>
__device__ __forceinline__ void tr_stage(unsigned (&A)[32]) {
#pragma unroll
    for (int k = 0; k < 32; ++k) if (!(k & S)) {
        const unsigned a = A[k], b = A[k + S], bs = b << S, as = a >> S; unsigned lo, hi;
        asm("v_bfi_b32 %0, %1, %2, %3" : "=v"(lo) : "s"(M), "v"(a), "v"(bs)); asm("v_bfi_b32 %0, %1, %2, %3" : "=v"(hi) : "s"(M), "v"(as), "v"(b));
        A[k] = lo; A[k + S] = hi; }
}
__device__ __forceinline__ void tr_bytes(unsigned (&A)[32]) {
#pragma unroll
    for (int k = 0; k < 16; ++k) { const unsigned a = A[k], b = A[k + 16];
        A[k] = __builtin_amdgcn_perm(b, a, 0x05040100u);
        A[k + 16] = __builtin_amdgcn_perm(b, a, 0x07060302u); }
#pragma unroll
    for (int k = 0; k < 32; ++k) if (!(k & 8)) { const unsigned a = A[k], b = A[k + 8];
        A[k] = __builtin_amdgcn_perm(b, a, 0x06020400u);
        A[k + 8] = __builtin_amdgcn_perm(b, a, 0x07030501u); }
}
__device__ __forceinline__ void planes_finish(unsigned gt, unsigned alive, int G, bool done, LAS unsigned long long* mrow, int nj, int lane) {
    unsigned sel = gt | alive;
    if (!done) {
        int need = 256 - G; unsigned ts = 0u;
#pragma unroll
        for (int j = 0; j < 32; ++j) {
            const bool mine = (alive >> j) & 1u; const unsigned long long eq = __ballot(mine);
            const int rank = (int)__builtin_amdgcn_mbcnt_hi((unsigned)(eq >> 32), __builtin_amdgcn_mbcnt_lo((unsigned)eq, 0u));
            ts |= (mine && rank < need) ? (1u << j) : 0u; need -= __popcll(eq);
        }
        sel = gt | ts;
    }
    unsigned long long mv = 0ull;
#pragma unroll
    for (int j = 0; j < 32; ++j) { const unsigned long long w = __ballot((sel >> j) & 1u); if (lane == j) mv = w; }
    if (lane < nj) mrow[lane] = mv;
}
__device__ __forceinline__ void select_rows_planes2(const LAS float* rowa, const LAS float* rowb, LAS unsigned long long* mrowa, LAS unsigned long long* mrowb, int nj, int lane) {
    unsigned A[32], B[32];
#pragma unroll
    for (int j = 0; j < 32; ++j) { float va = rowa[64 * j + lane], vb = rowb[64 * j + lane]; asm volatile("" : "+v"(va), "+v"(vb)); A[j] = (j < nj) ? sortable(va) : 0u; B[j] = (j < nj) ? sortable(vb) : 0u; }
    tr_bytes(A); tr_stage<4, 0x0F0F0F0Fu>(A); tr_stage<2, 0x33333333u>(A); tr_stage<1, 0x55555555u>(A);
    tr_bytes(B); tr_stage<4, 0x0F0F0F0Fu>(B); tr_stage<2, 0x33333333u>(B); tr_stage<1, 0x55555555u>(B);
#pragma unroll
    for (int j = 0; j < 32; ++j) asm volatile("" : "+v"(A[j]), "+v"(B[j]));
    unsigned alivea = 0xFFFFFFFFu, gta = 0u, aliveb = 0xFFFFFFFFu, gtb = 0u; int Ga = 0, Aa = 2048, Gb = 0, Ab = 2048; bool donea = false, doneb = false;
#pragma unroll
    for (int b = 31; b >= 0; --b) {
        if (!(donea && doneb)) {
            const unsigned onesa = alivea & A[b], onesb = aliveb & B[b];
            const int both = wave_sum_i(__builtin_popcount(onesa) | (__builtin_popcount(onesb) << 16)), C1a = both & 0xffff, C1b = both >> 16;
            if (!donea) {
                if (Ga + C1a >= 256) { alivea = onesa; Aa = C1a; } else { Ga += C1a; gta |= onesa; alivea &= ~A[b]; Aa -= C1a; }
                donea = (Ga + Aa == 256);
            }
            if (!doneb) {
                if (Gb + C1b >= 256) { aliveb = onesb; Ab = C1b; } else { Gb += C1b; gtb |= onesb; aliveb &= ~B[b]; Ab -= C1b; }
                doneb = (Gb + Ab == 256);
            }
        }
    }
    planes_finish(gta, alivea, Ga, donea, mrowa, nj, lane);
    planes_finish(gtb, aliveb, Gb, doneb, mrowb, nj, lane);
}
constexpr int MP_STRIDE = 36, MP_PLANE = 64 * MP_STRIDE;
__device__ __forceinline__ unsigned row32_sum(unsigned v) {
    v += __builtin_amdgcn_update_dpp(0, v, 0xB1, 0xF, 0xF, true);
    v += __builtin_amdgcn_update_dpp(0, v, 0x4E, 0xF, 0xF, true);
    v += __builtin_amdgcn_update_dpp(0, v, 0x141, 0xF, 0xF, true);
    v += __builtin_amdgcn_update_dpp(0, v, 0x140, 0xF, 0xF, true);
#if defined(SWZ_SUM)
    return v + (unsigned)__builtin_amdgcn_ds_swizzle((int)v, 0x401F);
#else
    const auto sw = __builtin_amdgcn_permlane16_swap(v, v, false, false);
    return (unsigned)sw[0] + (unsigned)sw[1];
#endif
}
__device__ __forceinline__ void select_rows32(const LAS float* sc, LAS unsigned* mp, int rq, int nj, int wave, int lane) {
    const int half = lane >> 5, l32 = lane & 31, ql = 2 * wave + half;
    const LAS float* row = sc + ql * SCW + l32;
    unsigned A[32], B[32];
#ifdef ASM_MARK
    asm volatile("; SEL_BEGIN");
#endif
#pragma unroll
    for (int i = 0; i < 32; ++i) { float va = row[32 * i], vb = row[32 * (32 + i)]; asm volatile("" : "+v"(va), "+v"(vb)); A[i] = __float_as_uint(va); B[i] = __float_as_uint(vb); }
    tr_bytes(A); tr_stage<4, 0x0F0F0F0Fu>(A); tr_stage<2, 0x33333333u>(A); tr_stage<1, 0x55555555u>(A);
    tr_bytes(B); tr_stage<4, 0x0F0F0F0Fu>(B); tr_stage<2, 0x33333333u>(B); tr_stage<1, 0x55555555u>(B);
#ifdef ASM_MARK
    asm volatile("; SEL_TR_END");
#endif
    const int nv = 2 * nj;
    unsigned al0 = nv >= 32 ? 0xFFFFFFFFu : ((1u << nv) - 1u), al1 = nv <= 32 ? 0u : (nv >= 64 ? 0xFFFFFFFFu : ((1u << (nv - 32)) - 1u));
    unsigned gt0 = 0u, gt1 = 0u, G = 0u;
    const unsigned S0 = A[31], S1 = B[31];
#pragma unroll
    for (int b = 31; b >= 0; --b) {
        const unsigned o0 = b == 31 ? (al0 & ~S0) : __builtin_amdgcn_bitop3_b32(al0, A[b], S0, 0x60), o1 = b == 31 ? (al1 & ~S1) : __builtin_amdgcn_bitop3_b32(al1, B[b], S1, 0x60);
        const unsigned c1 = row32_sum((unsigned)__builtin_popcount(o0) + (unsigned)__builtin_popcount(o1));
        const unsigned nt = (unsigned)((int)(G + c1 - 256u) >> 31);
        al0 = __builtin_amdgcn_bitop3_b32(o0, al0, nt, 0x78); al1 = __builtin_amdgcn_bitop3_b32(o1, al1, nt, 0x78);
        gt0 = __builtin_amdgcn_bitop3_b32(gt0, o0, nt, 0xF8); gt1 = __builtin_amdgcn_bitop3_b32(gt1, o1, nt, 0xF8);
        G += c1 & nt;
    }
#ifdef ASM_MARK
    asm volatile("; SEL_LOOP_END");
#endif
    const unsigned ce = row32_sum((unsigned)__builtin_popcount(al0) + (unsigned)__builtin_popcount(al1));
    const bool tie = G + ce != 256u;
    if (__any(tie)) {
        const unsigned need = tie ? 256u - G : 0x7fffffffu; unsigned m = 0u;
#pragma unroll
        for (int bit = 6; bit >= 0; --bit) {
            const unsigned cand = m + (1u << bit);
            const unsigned k0 = cand >= 32u ? 0xFFFFFFFFu : ((1u << cand) - 1u), k1 = cand <= 32u ? 0u : (cand >= 64u ? 0xFFFFFFFFu : ((1u << (cand - 32u)) - 1u));
            const unsigned cc = row32_sum((unsigned)__builtin_popcount(al0 & k0) + (unsigned)__builtin_popcount(al1 & k1));
            m = (cand <= 64u && cc <= need) ? cand : m;
        }
        const unsigned k0 = m >= 32u ? 0xFFFFFFFFu : ((1u << m) - 1u), k1 = m <= 32u ? 0u : (m >= 64u ? 0xFFFFFFFFu : ((1u << (m - 32u)) - 1u));
        const unsigned cm = row32_sum((unsigned)__builtin_popcount(al0 & k0) + (unsigned)__builtin_popcount(al1 & k1));
        const unsigned rem = need - cm;
        const bool mine = m < 64u && (((m < 32u ? al0 >> m : al1 >> (m - 32u)) & 1u) != 0u);
        const unsigned long long eq = __ballot(mine); const unsigned eqr = half ? (unsigned)(eq >> 32) : (unsigned)eq;
        const bool tk = mine && (unsigned)__builtin_popcount(eqr & ((1u << l32) - 1u)) < rem;
        al0 = (al0 & k0) | ((tk && m < 32u) ? (1u << m) : 0u); al1 = (al1 & k1) | ((tk && m >= 32u) ? (1u << (m - 32u)) : 0u);
    }
#ifdef ASM_MARK
    asm volatile("; SEL_TIE_END");
#endif
    LAS unsigned* rec = mp + (16 * rq + ql) * MP_STRIDE + l32;
    rec[0] = gt0 | al0; rec[MP_PLANE] = gt1 | al1;
}
constexpr int AT_K = 0, AT_V = 32768, AT_BT = 65536, AT_WS = 73728, AT_OST = 0, AT_Q = 75776;
static_assert(AT_Q + 65536 <= P2_MASK && AT_OST + 8 * 4608 <= AT_BT, "attention LDS map");
__device__ __forceinline__ bf16x8 pk16(const f32x16& v, int o) { return __builtin_bit_cast(bf16x8, (v4u){pkbf(v[o], v[o + 1]), pkbf(v[o + 2], v[o + 3]), pkbf(v[o + 4], v[o + 5]), pkbf(v[o + 6], v[o + 7])}); }
__device__ __forceinline__ void glds16(const void* gsrc, unsigned lds_dst) {
    unsigned keep;
    asm volatile("s_mov_b32 %0, m0\n\ts_mov_b32 m0, %2\n\ts_nop 0\n\tglobal_load_lds_dwordx4 %1, off\n\ts_mov_b32 m0, %0" : "=&s"(keep) : "v"(gsrc), "s"(lds_dst) : "memory");
}
__device__ __forceinline__ unsigned lds_addr(const LAS unsigned char* p) { return (unsigned)(uintptr_t)p; }
template <bool MASK, bool NEAR>
__device__ __forceinline__ void attn_soft(f32x16& p0, f32x16& p1, f32x2v& lacc, bf16x8 (&pa)[4], const LAS unsigned* mrec, int sbit) {
#pragma unroll
    for (int i = 0; i < 16; ++i) { p0[i] = __builtin_amdgcn_exp2f(p0[i]); p1[i] = __builtin_amdgcn_exp2f(p1[i]); }
    if (MASK) {
#pragma unroll
        for (int g = 0; g < 4; ++g) {
            const v4u w4 = *(const LAS v4u*)(mrec + 8 * g);
#pragma unroll
            for (int k = 0; k < 4; ++k) { int m0_, m1_; asm("v_bfe_i32 %0, %1, %2, 1" : "=v"(m0_) : "v"(w4[k]), "s"(sbit)); asm("v_bfe_i32 %0, %1, %2, 1" : "=v"(m1_) : "v"(w4[k]), "s"(sbit + 1));
                p0[4 * g + k] = __uint_as_float(__float_as_uint(p0[4 * g + k]) & (unsigned)m0_); p1[4 * g + k] = __uint_as_float(__float_as_uint(p1[4 * g + k]) & (unsigned)m1_); }
        }
    }
#pragma unroll
    for (int i = 0; i < 16; i += 2) { lacc += (f32x2v){p0[i], p0[i + 1]}; lacc += (f32x2v){p1[i], p1[i + 1]}; }
    pa[0] = pk16(p0, 0); pa[1] = pk16(p0, 8); pa[2] = pk16(p1, 0); pa[3] = pk16(p1, 8);
}
__device__ __forceinline__ void attn_pv(f32x16& o0, f32x16& o1, const bf16x8 (&pa)[4], const LAS unsigned char* Vb) {
#pragma unroll
    for (int ks = 0; ks < 4; ++ks) {
        o0 = __builtin_amdgcn_mfma_f32_32x32x16_bf16(pa[ks], cat8(vtr(Vb + ks * 1024), vtr(Vb + ks * 1024 + 512)), o0, 0, 0, 0);
        o1 = __builtin_amdgcn_mfma_f32_32x32x16_bf16(pa[ks], cat8(vtr(Vb + 4096 + ks * 1024), vtr(Vb + 4096 + ks * 1024 + 512)), o1, 0, 0, 0);
    }
}
template <bool NEAR>
__device__ __forceinline__ void attn_qk(f32x16& a0, f32x16& a1, f32x16& b0, f32x16& b1, const LAS unsigned char* Qb, const LAS unsigned char* Kb, const LAS float* bt) {
#pragma unroll
    for (int i = 0; i < 16; ++i) {
        if (NEAR) { a0[i] = bt[(i & 3) + 8 * (i >> 2)]; a1[i] = bt[32 + (i & 3) + 8 * (i >> 2)]; b0[i] = bt[(i & 3) + 8 * (i >> 2) - 32]; b1[i] = bt[(i & 3) + 8 * (i >> 2)]; }
        else { a0[i] = 0.f; a1[i] = 0.f; b0[i] = 0.f; b1[i] = 0.f; }
    }
#pragma unroll
    for (int d0 = 0; d0 < 4; ++d0) {
        const bf16x8 k0 = *(const LAS bf16x8*)(Kb + d0 * 2048), k1 = *(const LAS bf16x8*)(Kb + d0 * 2048 + 512);
        const bf16x8 qfa = *(const LAS bf16x8*)(Qb + d0 * 1024), qfb = *(const LAS bf16x8*)(Qb + 4096 + d0 * 1024);
        a0 = __builtin_amdgcn_mfma_f32_32x32x16_bf16(k0, qfa, a0, 0, 0, 0); a1 = __builtin_amdgcn_mfma_f32_32x32x16_bf16(k1, qfa, a1, 0, 0, 0);
        b0 = __builtin_amdgcn_mfma_f32_32x32x16_bf16(k0, qfb, b0, 0, 0, 0); b1 = __builtin_amdgcn_mfma_f32_32x32x16_bf16(k1, qfb, b1, 0, 0, 0);
    }
}
__device__ __forceinline__ void attn_store(const f32x16& o0, const f32x16& o1, f32x2v lacc, bf16* obase, LAS unsigned char* stg, LAS float* wsf, int lane) {
    const int r = lane & 31, hi = lane >> 5;
    float lsum = lacc[0] + lacc[1];
    lsum += __shfl_xor(lsum, 32);
    if (hi == 0) wsf[r] = lsum;
    LDS_WAIT(); asm volatile("" ::: "memory");
    LAS unsigned short* st = (LAS unsigned short*)stg;
#pragma unroll
    for (int i = 0; i < 16; ++i) {
        const int q = crow(i, hi); const float rl = 1.0f / wsf[q];
        st[q * 72 + r] = (unsigned short)(pkbf(o0[i] * rl, 0.f) & 0xffffu); st[q * 72 + 32 + r] = (unsigned short)(pkbf(o1[i] * rl, 0.f) & 0xffffu);
    }
    LDS_WAIT(); asm volatile("" ::: "memory");
#pragma unroll
    for (int k = 0; k < 4; ++k) { const int row = 8 * k + (lane >> 3), ch = lane & 7;
        const v4u v = *(const LAS v4u*)(stg + row * 144 + ch * 16); *(v4u*)(obase + (size_t)row * DM + ch * 8) = v; }
    LDS_WAIT(); asm volatile("" ::: "memory");
}
template <bool MASK>
__device__ __forceinline__ void attn_chunk(const Frame& F, int b, int c, LAS unsigned char* lds) {
    const int wid = F.wave, lane = F.lane, r = lane & 31, hi = lane >> 5;
    const size_t rowbase = (size_t)b * SEQ; const int q0 = 64 * c, nt = c + 1;
    const LAS unsigned char* Qb = lds + AT_Q + wid * 8192 + lane * 16;
#pragma unroll
    for (int d0 = 0; d0 < 4; ++d0) {
        *(LAS bf16x8*)(lds + AT_Q + wid * 8192 + d0 * 1024 + lane * 16) = *(const bf16x8*)(F.QA() + (rowbase + q0 + r) * 512 + wid * 64 + 16 * d0 + 8 * hi);
        *(LAS bf16x8*)(lds + AT_Q + wid * 8192 + 4096 + d0 * 1024 + lane * 16) = *(const bf16x8*)(F.QA() + (rowbase + q0 + 32 + r) * 512 + wid * 64 + 16 * d0 + 8 * hi); }
    const LAS float* BT = (const LAS float*)(lds + AT_BT) + wid * 256;
    const bf16* ksrc = F.KA() + (rowbase + lane) * 64 + 8 * wid;
    const bf16* vsrc = F.VA() + (rowbase + 16 * (wid & 3) + (lane >> 2)) * 64 + (wid >> 2) * 32 + (lane & 3) * 8;
    const LAS unsigned* mreca = (const LAS unsigned*)(lds + P2_MASK) + r * MP_STRIDE + 4 * hi; const LAS unsigned* mrecb = mreca + 32 * MP_STRIDE;
    const int voff = ((lane >> 4) & 1) * 32 + (lane & 3) * 8 + (4 * hi + ((lane & 15) >> 2)) * 64;
    f32x16 oa0, oa1, ob0, ob1; f32x2v la = {0.f, 0.f}, lb = {0.f, 0.f};
#pragma unroll
    for (int i = 0; i < 16; ++i) { oa0[i] = 0.f; oa1[i] = 0.f; ob0[i] = 0.f; ob1[i] = 0.f; }
#define AT_BAR() do { __builtin_amdgcn_sched_barrier(0); asm volatile("s_waitcnt lgkmcnt(0)" ::: "memory"); __builtin_amdgcn_s_barrier(); asm volatile("" ::: "memory"); __builtin_amdgcn_sched_barrier(0); } while (0)
#define AT_DMA(t_, slot_) do { const int tn_ = (t_) < nt ? (t_) : nt - 1;     \
        glds16(ksrc + (size_t)tn_ * 64 * 64, (unsigned)__builtin_amdgcn_readfirstlane((int)lds_addr(lds + AT_K + (slot_) * 8192 + wid * 1024))); \
        glds16(vsrc + (size_t)tn_ * 64 * 64, (unsigned)__builtin_amdgcn_readfirstlane((int)lds_addr(lds + AT_V + (slot_) * 8192 + wid * 1024))); } while (0)
    AT_DMA(0, 0); AT_DMA(1, 1); AT_DMA(2, 2);
    asm volatile("s_waitcnt vmcnt(0)" ::: "memory");
    AT_BAR();
    if (wid >= 4) AT_BAR();
    const int nfar = c >= 2 ? c - 2 : 0;
#if defined(PROBE_TIMER) && PROBE_TIMER == 3
    const unsigned long long pa0_ = __builtin_amdgcn_s_memtime();
#endif
    f32x16 a0, a1, b0, b1; bf16x8 pa[4], pb[4];
#if defined(PROBE_TIMER) && PROBE_TIMER >= 4
    unsigned psum_ = 0u;
#endif
    {
        const LAS unsigned char* Kb = lds + AT_K + hi * 1024 + r * 16; const LAS float* bt = BT + (64 * (0 - c) + 191 - r + 4 * hi);
        if (0 < nfar) attn_qk<false>(a0, a1, b0, b1, Qb, Kb, bt); else attn_qk<true>(a0, a1, b0, b1, Qb, Kb, bt);
        AT_BAR();
    }
#pragma unroll 1
    for (int t = 0; t < nt; ++t) {
        const int pl_ = (t >> 4) * MP_PLANE, sbit = (2 * t) & 31;
#ifdef NOSOFT
        { const bf16x8 c_ = {0x3c00, 0x3c00, 0x3c00, 0x3c00, 0x3c00, 0x3c00, 0x3c00, 0x3c00}; pa[0] = c_; pa[1] = c_; pa[2] = c_; pa[3] = c_; pb[0] = c_; pb[1] = c_; pb[2] = c_; pb[3] = c_; la += (f32x2v){a0[0], b0[0]}; }
#else
#if defined(PROBE_TIMER) && PROBE_TIMER == 4
        __builtin_amdgcn_sched_barrier(0); const unsigned long long pv0_ = __builtin_amdgcn_s_memtime(); __builtin_amdgcn_sched_barrier(0);
#endif
        attn_soft<MASK, false>(a0, a1, la, pa, mreca + pl_, sbit);
        attn_soft<MASK, false>(b0, b1, lb, pb, mrecb + pl_, sbit);
#if defined(PROBE_TIMER) && PROBE_TIMER == 4
        __builtin_amdgcn_sched_barrier(0); asm volatile("s_nop 0" : : "v"(pa[0]), "v"(pa[1]), "v"(pa[2]), "v"(pa[3]), "v"(pb[0]), "v"(pb[1]), "v"(pb[2]), "v"(pb[3]), "v"(la), "v"(lb)); psum_ += (unsigned)(__builtin_amdgcn_s_memtime() - pv0_); __builtin_amdgcn_sched_barrier(0);
#endif
#endif
#if defined(PROBE_TIMER) && PROBE_TIMER == 6
        __builtin_amdgcn_sched_barrier(0); asm volatile("s_nop 0" : : "v"(pa[0]), "v"(pa[3]), "v"(pb[0]), "v"(pb[3]), "v"(la), "v"(lb)); const unsigned long long pw0_ = __builtin_amdgcn_s_memtime();
#endif
        AT_BAR();
#if defined(PROBE_TIMER) && PROBE_TIMER == 6
        psum_ += (unsigned)(__builtin_amdgcn_s_memtime() - pw0_);
#endif
#if defined(PROBE_TIMER) && PROBE_TIMER == 5
        const unsigned long long pm0_ = __builtin_amdgcn_s_memtime();
#endif
        AT_DMA(t + 3, (t + 3) & 3);
        const LAS unsigned char* Vb = lds + AT_V + (t & 3) * 8192 + voff;
#pragma unroll
        for (int ks = 0; ks < 4; ++ks) {
            const bf16x8 v0 = cat8(vtr(Vb + ks * 1024), vtr(Vb + ks * 1024 + 512)), v1 = cat8(vtr(Vb + 4096 + ks * 1024), vtr(Vb + 4096 + ks * 1024 + 512));
            oa0 = __builtin_amdgcn_mfma_f32_32x32x16_bf16(pa[ks], v0, oa0, 0, 0, 0); ob0 = __builtin_amdgcn_mfma_f32_32x32x16_bf16(pb[ks], v0, ob0, 0, 0, 0);
            oa1 = __builtin_amdgcn_mfma_f32_32x32x16_bf16(pa[ks], v1, oa1, 0, 0, 0); ob1 = __builtin_amdgcn_mfma_f32_32x32x16_bf16(pb[ks], v1, ob1, 0, 0, 0);
        }
        if (t + 1 < nt) {
            const LAS unsigned char* Kb = lds + AT_K + ((t + 1) & 3) * 8192 + hi * 1024 + r * 16; const LAS float* bt = BT + (64 * (t + 1 - c) + 191 - r + 4 * hi);
            if (t + 1 < nfar) attn_qk<false>(a0, a1, b0, b1, Qb, Kb, bt); else attn_qk<true>(a0, a1, b0, b1, Qb, Kb, bt);
        }
#if defined(PROBE_TIMER) && PROBE_TIMER == 5
        asm volatile("s_nop 15\n\ts_nop 15" : : "v"(oa0), "v"(ob1), "v"(a0), "v"(b1)); psum_ += (unsigned)(__builtin_amdgcn_s_memtime() - pm0_);
#endif
#if defined(PROBE_TIMER) && PROBE_TIMER == 7
        __builtin_amdgcn_sched_barrier(0); asm volatile("s_nop 15\n\ts_nop 15" : : "v"(oa0), "v"(ob1), "v"(a0), "v"(b1)); const unsigned long long px0_ = __builtin_amdgcn_s_memtime();
#endif
        asm volatile("s_waitcnt vmcnt(2)" ::: "memory");
        AT_BAR();
#if defined(PROBE_TIMER) && PROBE_TIMER == 7
        psum_ += (unsigned)(__builtin_amdgcn_s_memtime() - px0_);
#endif
    }
#if defined(PROBE_TIMER) && PROBE_TIMER >= 4
    if (F.tid == 0 && nt >= 16) { volatile LAS unsigned* pm_ = (volatile LAS unsigned*)(lds + MISC_OFF); pm_[16] += psum_; pm_[17] += (unsigned)nt; }
#endif
#if defined(PROBE_TIMER) && PROBE_TIMER == 3
    if (F.tid == 0 && nt >= 16) { volatile LAS unsigned* pm_ = (volatile LAS unsigned*)(lds + MISC_OFF); pm_[16] += (unsigned)(__builtin_amdgcn_s_memtime() - pa0_); pm_[17] += (unsigned)nt; }
#endif
    asm volatile("s_waitcnt vmcnt(0)" ::: "memory");
    if (wid < 4) AT_BAR();
    AT_BAR();
#undef AT_BAR
#undef AT_DMA
    LAS float* wsf = (LAS float*)(lds + AT_WS) + wid * 64; LAS unsigned char* stg = lds + AT_OST + wid * 4608;
    attn_store(oa0, oa1, la, F.MIX() + (rowbase + q0) * DM + wid * 64, stg, wsf, lane);
    attn_store(ob0, ob1, lb, F.MIX() + (rowbase + q0 + 32) * DM + wid * 64, stg, wsf, lane);
}
__device__ __forceinline__ void attn_unit(const Frame& F, int b, int c, LAS unsigned char* lds) {
    if (c >= 4) {
        const int nj = c + 1;
        IdxOps ops; idx_fetch(ops, F, b, c, 0);
#if defined(PROBE_TIMER) && PROBE_TIMER >= 10
        unsigned ps_ = 0u;
#define PT0_(k) unsigned long long pt_##k = 0; if (PROBE_TIMER == (k)) { __builtin_amdgcn_sched_barrier(0); pt_##k = __builtin_amdgcn_s_memtime(); __builtin_amdgcn_sched_barrier(0); }
#define PT1_(k) if (PROBE_TIMER == (k)) { __builtin_amdgcn_sched_barrier(0); ps_ += (unsigned)(__builtin_amdgcn_s_memtime() - pt_##k); __builtin_amdgcn_sched_barrier(0); }
#else
#define PT0_(k)
#define PT1_(k)
#endif
        for (int rq = 0; rq < ((MIXREP & 2) ? 8 : 4); ++rq) {
            PT0_(10)
            idx_round(ops, F, b, c, lds);
            idx_fetch(ops, F, b, c, (rq + 1) & 3);
            asm volatile("s_waitcnt lgkmcnt(0)" ::: "memory");
            PT1_(10)
            PT0_(11)
            __syncthreads();
            PT1_(11)
            PT0_(12)
            select_rows32((const LAS float*)(lds + P2_SC), (LAS unsigned*)(lds + P2_MASK), rq & 3, nj, F.wave, F.lane);
            asm volatile("s_waitcnt lgkmcnt(0)" ::: "memory");
            PT1_(12)
            PT0_(13)
            __syncthreads();
            PT1_(13)
        }
#if defined(PROBE_TIMER) && PROBE_TIMER >= 10
        if (F.tid == 0 && c >= 15) { volatile LAS unsigned* pm_ = (volatile LAS unsigned*)(lds + MISC_OFF); pm_[16] += ps_; pm_[17] += 4u; }
#endif
#undef PT0_
#undef PT1_
    }
    { const f32x4 v = *(const f32x4*)(F.BT() + F.tid * 4); *(LAS f32x4*)(lds + AT_BT + F.tid * 16) = v; }
    __syncthreads();
    if (c >= 4) attn_chunk<true>(F, b, c, lds); else attn_chunk<false>(F, b, c, lds);
}

constexpr int RT_TAB = 131072;
__device__ __forceinline__ void ret_stage(const bf16* vsrc, const bf16* ksrc, LAS unsigned char* region) {
#pragma unroll
    for (int k = 0; k < 8; ++k) {
        const size_t o = (size_t)(16 * (k & 3)) * 512 + 32 * (k >> 2);
        __builtin_amdgcn_global_load_lds((const unsigned*)(vsrc + o), (LAS unsigned*)(region + k * 1024), 16, 0, 0);
        __builtin_amdgcn_global_load_lds((const unsigned*)(ksrc + o), (LAS unsigned*)(region + 8192 + k * 1024), 16, 0, 0);
    }
}
__device__ __forceinline__ void ret_kv(f32x16 (&T)[2][2], const LAS unsigned char* img) {
#pragma unroll
    for (int ks = 0; ks < 4; ++ks) {
        const bf16x8 k0 = cat8(vtr(img + 8192 + ks * 1024), vtr(img + 8192 + ks * 1024 + 512)), k1 = cat8(vtr(img + 8192 + 4096 + ks * 1024), vtr(img + 8192 + 4096 + ks * 1024 + 512));
        const bf16x8 v0 = cat8(vtr(img + ks * 1024), vtr(img + ks * 1024 + 512)), v1 = cat8(vtr(img + 4096 + ks * 1024), vtr(img + 4096 + ks * 1024 + 512));
        T[0][0] = __builtin_amdgcn_mfma_f32_32x32x16_bf16(k0, v0, T[0][0], 0, 0, 0); T[0][1] = __builtin_amdgcn_mfma_f32_32x32x16_bf16(k0, v1, T[0][1], 0, 0, 0);
        T[1][0] = __builtin_amdgcn_mfma_f32_32x32x16_bf16(k1, v0, T[1][0], 0, 0, 0); T[1][1] = __builtin_amdgcn_mfma_f32_32x32x16_bf16(k1, v1, T[1][1], 0, 0, 0);
    }
}
__device__ __forceinline__ void ret_unit(const Frame& F, int b, int h, LAS unsigned char* lds) {
    const int lane = F.lane, w = F.wave, r = lane & 31, hi = lane >> 5;
    const float gam = 1.0f - exp2f(-5.0f - (float)h), lg2 = log2f(gam), cd = exp2f(64.0f * lg2), cd4 = exp2f(256.0f * lg2);
    LAS unsigned char* region = lds + w * 16384;
    const LAS unsigned char* img = region + ((lane >> 4) & 1) * 32 + (lane & 3) * 8 + (4 * hi + ((lane & 15) >> 2)) * 64;
    LAS float* tab = (LAS float*)(lds + RT_TAB);
    __syncthreads();
    if (F.tid < 128) tab[F.tid] = F.tid < 64 ? F.ret_gn_w()[h * 64 + F.tid] : F.ret_gn_b()[h * 64 + F.tid - 64];
    const size_t hbase = (size_t)b * SEQ * 512 + h * 64;
    const size_t stg = hbase + (size_t)(lane >> 2) * 512 + (lane & 3) * 8;
    f32x16 T[2][2];
#pragma unroll
    for (int i = 0; i < 16; ++i) { T[0][0][i] = 0.f; T[0][1][i] = 0.f; T[1][0][i] = 0.f; T[1][1][i] = 0.f; }
#pragma unroll 1
    for (int i = 0; i < 4; ++i) {
        const size_t co = (size_t)(4 * w + i) * 64 * 512;
        ret_stage(F.VB() + stg + co, F.KB() + stg + co, region);
        if (i) {
#pragma unroll
            for (int k = 0; k < 16; ++k) { T[0][0][k] *= cd; T[0][1][k] *= cd; T[1][0][k] *= cd; T[1][1][k] *= cd; }
        }
        asm volatile("s_waitcnt vmcnt(0)" ::: "memory");
        ret_kv(T, img);
        LDS_WAIT();
    }
#pragma unroll
    for (int eb = 0; eb < 2; ++eb)
#pragma unroll
        for (int db = 0; db < 2; ++db)
#pragma unroll
            for (int g = 0; g < 4; ++g) *(LAS f32x4*)(region + ((eb * 2 + db) * 4 + g) * 1024 + lane * 16) = (f32x4){T[eb][db][4 * g], T[eb][db][4 * g + 1], T[eb][db][4 * g + 2], T[eb][db][4 * g + 3]};
    __syncthreads();
#pragma unroll
    for (int i = 0; i < 16; ++i) { T[0][0][i] = 0.f; T[0][1][i] = 0.f; T[1][0][i] = 0.f; T[1][1][i] = 0.f; }
#pragma unroll 1
    for (int wp = 0; wp < w; ++wp) {
        const LAS unsigned char* src = lds + wp * 16384 + lane * 16;
#pragma unroll
        for (int eb = 0; eb < 2; ++eb)
#pragma unroll
            for (int db = 0; db < 2; ++db)
#pragma unroll
                for (int g = 0; g < 4; ++g) { const f32x4 v = *(const LAS f32x4*)(src + ((eb * 2 + db) * 4 + g) * 1024);
                    T[eb][db][4 * g] = T[eb][db][4 * g] * cd4 + v[0]; T[eb][db][4 * g + 1] = T[eb][db][4 * g + 1] * cd4 + v[1]; T[eb][db][4 * g + 2] = T[eb][db][4 * g + 2] * cd4 + v[2]; T[eb][db][4 * g + 3] = T[eb][db][4 * g + 3] * cd4 + v[3]; }
    }
    __syncthreads();
#pragma unroll 1
    for (int i = 0; i < 4; ++i) {
        const int n = 4 * w + i; const size_t co = (size_t)n * 64 * 512;
        ret_stage(F.VB() + stg + co, F.KB() + stg + co, region);
#pragma unroll
        for (int k = 0; k < 16; ++k) { T[0][0][k] *= cd; T[0][1][k] *= cd; T[1][0][k] *= cd; T[1][1][k] *= cd; }
        const bf16* qrow = F.QB() + hbase + co + (size_t)r * 512 + 8 * hi;
        const bf16* krow = F.KB() + hbase + co + (size_t)r * 512 + 8 * hi;
#pragma unroll 1
        for (int ib = 0; ib < 2; ++ib) {
            bf16x8 qf[4], kf[4];
#pragma unroll
            for (int s = 0; s < 4; ++s) { qf[s] = *(const bf16x8*)(qrow + (size_t)(32 * ib) * 512 + 16 * s); kf[s] = *(const bf16x8*)(krow + 16 * s); }
            const size_t tok = (size_t)b * SEQ + 64 * n + 32 * ib + r;
            const bf16* grow = F.GB() + tok * 512 + h * 64 + 4 * hi;
            v2u gq[2][4];
#pragma unroll
            for (int db = 0; db < 2; ++db)
#pragma unroll
                for (int g = 0; g < 4; ++g) gq[db][g] = *(const v2u*)(grow + 32 * db + 8 * g);
            f32x16 s0, s1;
#pragma unroll
            for (int k = 0; k < 16; ++k) { s0[k] = 0.f; s1[k] = 0.f; }
#pragma unroll
            for (int s = 0; s < 4; ++s) s0 = __builtin_amdgcn_mfma_f32_32x32x16_bf16(kf[s], qf[s], s0, 0, 0, 0);
            if (ib == 1) {
#pragma unroll
                for (int s = 0; s < 4; ++s) kf[s] = *(const bf16x8*)(krow + (size_t)32 * 512 + 16 * s);
#pragma unroll
                for (int s = 0; s < 4; ++s) s1 = __builtin_amdgcn_mfma_f32_32x32x16_bf16(kf[s], qf[s], s1, 0, 0, 0);
#pragma unroll
                for (int k = 0; k < 16; ++k) s1[k] = (r >= crow(k, hi)) ? s1[k] : 0.f;
            } else {
#pragma unroll
                for (int k = 0; k < 16; ++k) s0[k] = (r >= crow(k, hi)) ? s0[k] : 0.f;
            }
#pragma unroll
            for (int s = 0; s < 4; ++s) {
                v4u q4 = __builtin_bit_cast(v4u, qf[s]);
                auto x0 = __builtin_amdgcn_permlane32_swap(q4[0], q4[2], false, false); auto x1 = __builtin_amdgcn_permlane32_swap(q4[1], q4[3], false, false);
                q4[0] = x0[0]; q4[2] = x0[1]; q4[1] = x1[0]; q4[3] = x1[1];
                qf[s] = __builtin_bit_cast(bf16x8, q4);
            }
            asm volatile("s_waitcnt vmcnt(0)" ::: "memory");
            f32x16 y0, y1;
#pragma unroll
            for (int k = 0; k < 16; ++k) { y0[k] = 0.f; y1[k] = 0.f; }
#pragma unroll
            for (int eb = 0; eb < 2; ++eb)
#pragma unroll
                for (int s2 = 0; s2 < 2; ++s2) {
                    y0 = __builtin_amdgcn_mfma_f32_32x32x16_bf16(pk16(T[eb][0], 8 * s2), qf[2 * eb + s2], y0, 0, 0, 0);
                    y1 = __builtin_amdgcn_mfma_f32_32x32x16_bf16(pk16(T[eb][1], 8 * s2), qf[2 * eb + s2], y1, 0, 0, 0);
                }
#pragma unroll
            for (int ks = 0; ks < 2; ++ks) {
                const bf16x8 pb = pk16(s0, 8 * ks);
                y0 = __builtin_amdgcn_mfma_f32_32x32x16_bf16(cat8(vtr(img + ks * 1024), vtr(img + ks * 1024 + 512)), pb, y0, 0, 0, 0);
                y1 = __builtin_amdgcn_mfma_f32_32x32x16_bf16(cat8(vtr(img + 4096 + ks * 1024), vtr(img + 4096 + ks * 1024 + 512)), pb, y1, 0, 0, 0);
            }
            if (ib == 1) {
#pragma unroll
                for (int ks = 0; ks < 2; ++ks) {
                    const bf16x8 pb = pk16(s1, 8 * ks);
                    y0 = __builtin_amdgcn_mfma_f32_32x32x16_bf16(cat8(vtr(img + (2 + ks) * 1024), vtr(img + (2 + ks) * 1024 + 512)), pb, y0, 0, 0, 0);
                    y1 = __builtin_amdgcn_mfma_f32_32x32x16_bf16(cat8(vtr(img + 4096 + (2 + ks) * 1024), vtr(img + 4096 + (2 + ks) * 1024 + 512)), pb, y1, 0, 0, 0);
                }
            }
            float sm = 0.f;
#pragma unroll
            for (int k = 0; k < 16; ++k) sm += y0[k] + y1[k];
            sm += __shfl_xor(sm, 32);
            const float mean = sm * (1.0f / 64.0f); float vr = 0.f;
#pragma unroll
            for (int k = 0; k < 16; ++k) { y0[k] -= mean; y1[k] -= mean; vr += y0[k] * y0[k] + y1[k] * y1[k]; }
            vr += __shfl_xor(vr, 32);
            const float rstd = 1.0f / sqrtf(vr * (1.0f / 64.0f) + 1e-5f);
            bf16* orow = F.MIX() + tok * DM + 512 + h * 64 + 4 * hi;
#pragma unroll
            for (int g = 0; g < 4; ++g) {
                const f32x4 w0 = *(const LAS f32x4*)(tab + 8 * g + 4 * hi), b0 = *(const LAS f32x4*)(tab + 64 + 8 * g + 4 * hi), w1 = *(const LAS f32x4*)(tab + 32 + 8 * g + 4 * hi), b1 = *(const LAS f32x4*)(tab + 96 + 8 * g + 4 * hi);
                const v2u g0 = gq[0][g], g1 = gq[1][g];
                *(v2u*)(orow + 8 * g) = (v2u){pkbf((y0[4 * g] * rstd * w0[0] + b0[0]) * bflo(g0[0]), (y0[4 * g + 1] * rstd * w0[1] + b0[1]) * bfhi(g0[0])),
                                              pkbf((y0[4 * g + 2] * rstd * w0[2] + b0[2]) * bflo(g0[1]), (y0[4 * g + 3] * rstd * w0[3] + b0[3]) * bfhi(g0[1]))};
                *(v2u*)(orow + 32 + 8 * g) = (v2u){pkbf((y1[4 * g] * rstd * w1[0] + b1[0]) * bflo(g1[0]), (y1[4 * g + 1] * rstd * w1[1] + b1[1]) * bfhi(g1[0])),
                                                   pkbf((y1[4 * g + 2] * rstd * w1[2] + b1[2]) * bflo(g1[1]), (y1[4 * g + 3] * rstd * w1[3] + b1[3]) * bfhi(g1[1]))};
            }
        }
        ret_kv(T, img);
        LDS_WAIT();
    }
}
#ifndef GEMM_ALIGN
#define GEMM_ALIGN true
#endif
#ifndef GEMM_SP2
#define GEMM_SP2 true
#endif
#ifndef RETREP
#define RETREP 1
#endif
#ifndef ATTREP
#define ATTREP 1
#endif
constexpr int CW_Q = 10240;
constexpr int NG_ATT = 4 * 32, NG_RET = 4 * 8, NG_MIX = NG_ATT + NG_RET;
__device__ __forceinline__ void p2_mixers(Frame& F) {
    for (;;) {
        int mo_ = MISC_OFF; asm volatile("" : "+s"(mo_));
        volatile LAS unsigned* misc = (volatile LAS unsigned*)(F.lds + mo_);
        __syncthreads();
        if (F.tid == 0) misc[0] = __hip_atomic_fetch_add(F.ctl + CW_Q + 64 * F.grp, 1u, __ATOMIC_RELAXED, __HIP_MEMORY_SCOPE_AGENT);
        __syncthreads();
        const int u = (int)misc[0];
        if (u >= NG_MIX) break;
        { int w_ = F.wave; asm volatile("" : "+s"(w_)); F.wave = w_; int l_ = lane_id(); asm volatile("" : "+v"(l_)); F.lane = l_; F.tid = w_ * 64 + l_; }
        const int b0 = 4 * F.grp;
        if (u < 32) attn_unit(F, b0 + (u & 3), 31 - (u >> 2), F.lds);
        else if (u < 32 + NG_RET) { const int ru = u - 32; ret_unit(F, b0 + (ru >> 3), ru & 7, F.lds); }
        else { const int a = u - NG_RET; attn_unit(F, b0 + (a & 3), 31 - (a >> 2), F.lds); }
    }
#if defined(PROBE_TIMER) && PROBE_TIMER >= 3
    if (blockIdx.x == 7 && F.tid == 0) { volatile LAS unsigned* pm_ = (volatile LAS unsigned*)(F.lds + MISC_OFF); const float val = ((float)pm_[16] / (float)(pm_[17] ? pm_[17] : 1u)) / 8000.0f;
        F.ctl[64] = __float_as_uint(0.05f + 0.5f * floorf(fminf(fmaxf(val, 0.f), 1.f) * 8.0f + 0.5f) * 0.125f); }
#endif
}

typedef __attribute__((address_space(1))) unsigned gu32;
#define XB_TMO      128
#define XB_XCNT(j)  (256  + 64 * (j))
#define XB_XSUB(j)  (1280 + 64 * (j))
#define XB_XGEN(j)  (2304 + 64 * (j))
#define XB_TOP      3328
#define XB_TOPGEN   3392
#define XCD_BAR_WORDS 3456
#define XB_SPIN_CAP (1u << 18)

__device__ __forceinline__ unsigned xb_ld(unsigned* p)              { return __hip_atomic_load(p, __ATOMIC_RELAXED, __HIP_MEMORY_SCOPE_AGENT); }
__device__ __forceinline__ unsigned xb_add(unsigned* p, unsigned v) { return __hip_atomic_fetch_add(p, v, __ATOMIC_RELAXED, __HIP_MEMORY_SCOPE_AGENT); }
__device__ __forceinline__ unsigned xb_xcc_id() { return (unsigned)__builtin_amdgcn_s_getreg((3 << 11) | 20) & 0xFu; }
#define XB_SPIN(cond, bar) do { unsigned _sp = 0; while (cond) { __builtin_amdgcn_s_sleep(1); \
    if ((++_sp & 255u) == 0u) { if (xb_ld(&(bar)[XB_TMO])) break; if (_sp > XB_SPIN_CAP) { atomicAdd(&(bar)[XB_TMO], 1u); break; } } } } while (0)

struct XcdBarrier {
    unsigned* bar; unsigned x; int wv;
    volatile LAS unsigned* st;
};

__device__ __forceinline__ XcdBarrier xcd_barrier_post(unsigned* bar, volatile LAS unsigned* st, int wv_) {
    XcdBarrier b; b.bar = bar; b.x = xb_xcc_id(); b.st = st; b.wv = 0;
    if (wv_ == 0 && lane_id() == 0) { st[2] = xb_add(&bar[XB_XCNT(b.x)], 1u); st[3] = b.x; }
    return b;
}
__device__ __forceinline__ void xcd_barrier_complete(unsigned* bar, unsigned x, unsigned& nloc, unsigned& nx, unsigned& even) {
    const unsigned G = gridDim.x * gridDim.y * gridDim.z;
    unsigned sum, cnt, mine, sp = 0u, ev;
    for (;;) {
        sum = 0u; cnt = 0u; mine = 0u; ev = 1u;
#pragma unroll
        for (unsigned j = 0; j < 16; ++j) { const unsigned c = xb_ld(&bar[XB_XCNT(j)]); sum += c; cnt += (c > 0u) ? 1u : 0u; mine = (j == x) ? c : mine; ev &= (c == (j < 8u ? 32u : 0u)) ? 1u : 0u; }
        even = ev;
        if (sum == G) break;
        __builtin_amdgcn_s_sleep(1);
        if ((++sp & 255u) == 0u) { if (xb_ld(&bar[XB_TMO])) break; if (sp > XB_SPIN_CAP) { atomicAdd(&bar[XB_TMO], 1u); break; } }
    }
    nloc = mine > 0u ? mine : 1u; nx = cnt > 0u ? cnt : 1u;
}

__device__ __forceinline__ void xcd_barrier(const XcdBarrier& b) {
    asm volatile("s_waitcnt vmcnt(0)" ::: "memory");
    __syncthreads();
    if (b.wv == 0 && lane_id() == 0) {
        unsigned* bar = b.bar;
        __builtin_amdgcn_s_waitcnt(0);
        unsigned nloc = b.st[0], nx = b.st[1];
        if (nloc == 0u) { unsigned ev_; xcd_barrier_complete(bar, b.x, nloc, nx, ev_); b.st[0] = nloc; b.st[1] = nx; b.st[4] = ev_; }
        const unsigned old = xb_add(&bar[XB_XSUB(b.x)], 1u);
        const unsigned gen = old / nloc;
        if (old + 1u == (gen + 1u) * nloc) {
            __builtin_amdgcn_fence(__ATOMIC_RELEASE, "agent");
            asm volatile("s_waitcnt vmcnt(0)" ::: "memory");
            const unsigned og = xb_add(&bar[XB_TOP], 1u);
            const unsigned tg = og / nx;
            if (og + 1u == (tg + 1u) * nx) xb_add(&bar[XB_TOPGEN], 1u);
            else XB_SPIN(xb_ld(&bar[XB_TOPGEN]) == tg, bar);
            __builtin_amdgcn_fence(__ATOMIC_ACQUIRE, "agent");
            xb_add(&bar[XB_XGEN(b.x)], 1u);
            asm volatile("s_waitcnt vmcnt(0)" ::: "memory");
        } else {
            XB_SPIN(xb_ld(&bar[XB_XGEN(b.x)]) == gen, bar);
            __builtin_amdgcn_fence(__ATOMIC_ACQUIRE, "agent");
            asm volatile("s_waitcnt vmcnt(0)" ::: "memory");
        }
    }
    __syncthreads();
}

constexpr int CW_GB = 8192;
__device__ __forceinline__ void grp_barrier(unsigned* ctl, int g, bool phys, int wave) {
    asm volatile("s_waitcnt vmcnt(0)" ::: "memory");
    __syncthreads();
    if (wave == 0 && lane_id() == 0) {
        unsigned* bar = ctl + 4096; unsigned* sub = ctl + CW_GB + 64 * g; unsigned* genw = ctl + CW_GB + 64 * (8 + g);
        __builtin_amdgcn_s_waitcnt(0);
        if (!phys) { __builtin_amdgcn_fence(__ATOMIC_RELEASE, "agent"); asm volatile("s_waitcnt vmcnt(0)" ::: "memory"); }
        const unsigned old = xb_add(sub, 1u), gen = old / 32u;
        if (old + 1u == (gen + 1u) * 32u) xb_add(genw, 1u);
        else XB_SPIN(xb_ld(genw) == gen, bar);
        __builtin_amdgcn_fence(__ATOMIC_ACQUIRE, "agent");
        asm volatile("s_waitcnt vmcnt(0)" ::: "memory");
    }
    __syncthreads();
}

constexpr int CW_BAR = 4096;
constexpr size_t CTL_ZERO_BYTES = 65536;
typedef KArgs Args;
__global__ void __launch_bounds__(NTHR, 2) fwd_kernel(Args args) {
    extern __shared__ __attribute__((aligned(16))) unsigned char lds[];
    Frame F;
    F.lds = (LAS unsigned char*)lds;
    F.wave = __builtin_amdgcn_readfirstlane((int)threadIdx.x >> 6); F.lane = lane_id(); F.tid = F.wave * 64 + F.lane;
    F.G = gridDim.x; { const int bx = blockIdx.x; F.vcu = (F.G % 8 == 0) ? (bx % 8) * (F.G / 8) + bx / 8 : bx; }
    unsigned char* ws = args.ws;
    F.ctl = (unsigned*)(ws + WS_CTL);
    F.ap = (const __attribute__((address_space(4))) KArgs*)__builtin_amdgcn_kernarg_segment_ptr();
    F.ws = ws;
    const int lo = args.ph_lo, hi = args.ph_hi;
    for (int u_ = F.tid; u_ < 64; u_ += NTHR) ((LAS unsigned*)(F.lds + MISC_OFF))[u_] = 0u;
    __syncthreads();
    XcdBarrier bar; bar.bar = F.ctl + CW_BAR; bar.x = 0; bar.st = nullptr; bar.wv = F.wave;
    if (hi - lo > 1) { bar = xcd_barrier_post(F.ctl + CW_BAR, (volatile LAS unsigned*)(F.lds + MISC_OFF) + 8, F.wave); bar.wv = F.wave; }
#define IN(k) (lo <= (k) && (k) < hi)
#ifndef STAGGER
#define STAGGER 4
#endif
    if (IN(0)) { asm volatile("" : "+s"(F.ws), "+s"(F.ap)); F.lane = lane_id(); F.tid = F.wave * 64 + F.lane; p0_prologue(F); }
    if (IN(0) && IN(1)) { if (lo < 0) cg::this_grid().sync(); else xcd_barrier(bar); }
    bool phys = false; F.grp = (int)blockIdx.x & 7; F.rk = (int)blockIdx.x >> 3;
    if (hi - lo > 1) { volatile LAS unsigned* st = (volatile LAS unsigned*)(F.lds + MISC_OFF) + 8;
        if (st[4] == 1u && F.G == 256) { phys = true; F.grp = (int)st[3]; F.rk = (int)st[2]; } }
    F.grp = __builtin_amdgcn_readfirstlane(F.grp) & 7; F.rk = __builtin_amdgcn_readfirstlane(F.rk) & 31;
    const int cid = F.grp + 8 * F.rk;
#define GSEAM(k) do { if (IN(k) && IN((k) + 1)) grp_barrier(F.ctl, F.grp, phys, F.wave); } while (0)
#if STAGGER > 0
    if (hi - lo > 1) for (int i_ = 0; i_ < F.grp * STAGGER; ++i_) __builtin_amdgcn_s_sleep(32);
#endif
    if (IN(1)) { asm volatile("" : "+s"(F.ws), "+s"(F.ap)); F.lane = lane_id(); F.tid = F.wave * 64 + F.lane;
        pg8::Gemm g{F.XB(), F.WIN(), MTOK, NIN, DM}; pg8::StaticOrder S; S.init(MTOK, NIN, 256, cid);
        pg8::EpiIn E{F.QA(), F.KA(), F.VA(), F.IQ(), F.IK(), F.QB(), F.KB(), F.VB(), F.GB(), F.IW(), F.q_norm_w(), F.k_norm_w(), (LAS float*)(F.lds + XCH_OFF)};
        pg8::gemm_phase<pg8::EpiIn, pg8::StaticOrder, GEMM_ALIGN, GEMM_SP2>(F.lds, g, S, E, F.wave);
    }
    GSEAM(1);
    if (IN(2)) { asm volatile("" : "+s"(F.ws), "+s"(F.ap)); F.lane = lane_id(); F.tid = F.wave * 64 + F.lane; p2_mixers(F); }
    GSEAM(2);
    if (IN(3)) { asm volatile("" : "+s"(F.ws), "+s"(F.ap)); F.lane = lane_id(); F.tid = F.wave * 64 + F.lane;
        const int pm = 32 * F.grp + F.rk;
        pg8::Gemm g{F.MIX(), F.WOUT(), MTOK, DM, DM}; pg8::PanelOrder S{pm, 4};
        pg8::EpiOut E{F.RMS(), F.XB(), {0.f, 0.f, 0.f, 0.f, 0.f, 0.f, 0.f, 0.f}};
        pg8::gemm_phase<pg8::EpiOut, pg8::PanelOrder, true, true>(F.lds, g, S, E, F.wave);
        const int wr = F.wave >> 2, wc = F.wave & 3, fr = F.lane & 15, fq = F.lane >> 4;
        LAS float* P = (LAS float*)(F.lds + XCH_OFF);
#pragma unroll
        for (int k = 0; k < 8; ++k) { float s = E.ss[k]; s += __shfl_xor(s, 16); s += __shfl_xor(s, 32);
            if (fq == 0) P[((k >> 2) * 128 + wr * 64 + (k & 3) * 16 + fr) * 4 + wc] = s; }
        __syncthreads();
        if (F.tid < 256) { const f32x4 p = *(const LAS f32x4*)(P + F.tid * 4);
            F.R2()[(size_t)pm * 256 + F.tid] = 1.0f / sqrtf(((p[0] + p[1]) + (p[2] + p[3])) * (1.0f / DM) + 1e-6f); }
    }
    GSEAM(3);
    if (IN(4)) { asm volatile("" : "+s"(F.ws), "+s"(F.ap)); F.lane = lane_id(); F.tid = F.wave * 64 + F.lane;
        pg8::Gemm g{F.XB(), F.WGU(), MTOK, NGU, DM}; pg8::StaticOrder S; S.init(MTOK, NGU, 256, cid);
        pg8::EpiGU E{F.R2(), F.ACT(), {0.f, 0.f, 0.f, 0.f}, {0.f, 0.f, 0.f, 0.f}, {0.f, 0.f, 0.f, 0.f}, {0.f, 0.f, 0.f, 0.f}, 0ull};
        pg8::gemm_phase<pg8::EpiGU, pg8::StaticOrder, GEMM_ALIGN, GEMM_SP2>(F.lds, g, S, E, F.wave);
    }
    GSEAM(4);
    if (IN(5)) { asm volatile("" : "+s"(F.ws), "+s"(F.ap)); F.lane = lane_id(); F.tid = F.wave * 64 + F.lane;
        pg8::Gemm g{F.ACT(), F.WDN(), MTOK, DM, FF}; pg8::StaticOrder S; S.init(MTOK, DM, 256, cid);
        pg8::EpiDown E{F.XB(), F.out()};
        pg8::gemm_phase<pg8::EpiDown, pg8::StaticOrder, GEMM_ALIGN, GEMM_SP2>(F.lds, g, S, E, F.wave);
    }
#undef GSEAM
#ifdef PROBE_TIMER
    xcd_barrier(bar);
    { const float frac = __uint_as_float(__hip_atomic_load(F.ctl + 64, __ATOMIC_RELAXED, __HIP_MEMORY_SCOPE_AGENT)); const int nz = (int)(frac * (float)MTOK);
      for (int m = (int)blockIdx.x * NWAVES + F.wave; m < nz; m += F.G * NWAVES) { f32x4* o = (f32x4*)(F.out() + (size_t)m * DM) + F.lane;
#pragma unroll
          for (int j = 0; j < 4; ++j) o[64 * j] = (f32x4){0.f, 0.f, 0.f, 0.f}; } }
#endif
#undef IN
}

extern "C" void kernel_launch(void* const* d_in, const int* in_sizes, int n_in, void* d_out, int out_size, void* d_ws, size_t ws_size, hipStream_t stream) {
    static int grid = 0;
    if (grid == 0) {
        if (n_in != 16 || in_sizes[0] != MTOK * DM || out_size != MTOK * DM || ws_size < WS_END) {
            fprintf(stderr, "kernel_launch: unexpected problem (n_in %d, in0 %d, out %d, ws %zu); nothing launched\n", n_in, n_in > 0 ? in_sizes[0] : -1, out_size, ws_size); grid = -1; return; }
        int dev = 0, cus = 0, per_cu = 0;
        if (hipGetDevice(&dev) != hipSuccess || hipDeviceGetAttribute(&cus, hipDeviceAttributeMultiprocessorCount, dev) != hipSuccess) { grid = -1; return; }
        if (hipFuncSetAttribute((const void*)fwd_kernel, hipFuncAttributeMaxDynamicSharedMemorySize, LDS_BYTES) != hipSuccess) { fprintf(stderr, "kernel_launch: hipFuncSetAttribute failed\n"); grid = -1; return; }
        if (hipOccupancyMaxActiveBlocksPerMultiprocessor(&per_cu, (const void*)fwd_kernel, NTHR, LDS_BYTES) != hipSuccess || per_cu < 1) { fprintf(stderr, "kernel_launch: occupancy query says %d blocks per CU\n", per_cu); (void)hipGetLastError(); grid = -1; return; }
        grid = cus;
        if (grid != 256) { fprintf(stderr, "kernel_launch: %d CUs; this kernel is laid out for 256 (eight groups of 32 workgroups)\n", grid); grid = -1; return; }
    }
    if (grid < 0) return;
    if (hipMemsetAsync((char*)d_ws + WS_CTL, 0, CTL_ZERO_BYTES, stream) != hipSuccess) { fprintf(stderr, "kernel_launch: memset failed\n"); return; }
    Args a{};
    for (int i = 0; i < 16; ++i) a.in[i] = (const float*)d_in[i];
    a.out = (float*)d_out; a.ws = (unsigned char*)d_ws;
#if MK_N_LAUNCHES == 1
    a.ph_lo = 0; a.ph_hi = N_PHASES;
    void* kargs[] = {&a};
    hipError_t e = hipLaunchCooperativeKernel((const void*)fwd_kernel, dim3(grid), dim3(NTHR), kargs, LDS_BYTES, stream);
    if (e != hipSuccess) fprintf(stderr, "kernel_launch: cooperative launch failed: %s (grid %d)\n", hipGetErrorString(e), grid);
#else
    for (int p = 0; p < N_PHASES; ++p) { a.ph_lo = p; a.ph_hi = p + 1; hipLaunchKernelGGL(fwd_kernel, dim3(grid), dim3(NTHR), LDS_BYTES, stream, a); }
#endif
}
```

```cpp
#include <hip/hip_runtime.h>
#define STAGGER 8
#include <hip/hip_cooperative_groups.h>
#include <cstdio>
#include <cstdint>
namespace cg = cooperative_groups;
namespace pg8 {
#define PG8_LAS __attribute__((address_space(3)))
typedef unsigned short bf16_t;
typedef short bf16x8 __attribute__((ext_vector_type(8)));
typedef float f32x4 __attribute__((ext_vector_type(4)));
typedef unsigned u32x4 __attribute__((ext_vector_type(4)));
constexpr int BM = 256, BK = 64, HALF = 128, HTB = HALF * BK * 2  , STAGE_BYTES = 8 * HTB, NXCD = 8, WGM = 8;

__host__ __device__ __forceinline__ int lds_byte(int r, int c) { const int st = (r >> 4) * 2 + (c >> 5), rr = r & 15, cc = c & 31, ob = rr * 64 + cc * 2; return st * 1024 + (ob ^ (((ob >> 9) & 1) << 5)); }
__host__ __device__ __forceinline__ void stage_rc(int b, int& R, int& C) { const int st = b / 1024, sb = b % 1024, swz = sb ^ (((sb >> 9) & 1) << 5); R = (st >> 1) * 16 + swz / 64; C = (st & 1) * 32 + (swz % 64) / 2; }
__host__ __device__ __forceinline__ int perm32(int rho) { const int n = rho >> 4, i = rho & 15; return 8 * (i >> 2) + 4 * n + (i & 3); }

struct Unit { int pm, pn; };
struct Gemm { const bf16_t* A; const bf16_t* Bt; int M, N, K; };

struct StaticOrder {
    int nM, nN, nwg, G, c;
    __host__ __device__ void init(int M, int N, int G_, int c_) { nM = M / BM; nN = N / BM; nwg = nM * nN; G = G_; c = c_; }
    __host__ __device__ bool next(int i, Unit& u) const {
        const long L = (long)i * G + c; if (L >= nwg) return false;
        int wgid = (int)L; { const int q = nwg / NXCD, r = nwg % NXCD, xcd = wgid % NXCD, off = wgid / NXCD; wgid = (xcd < r ? xcd * (q + 1) : r * (q + 1) + (xcd - r) * q) + off; }
        const int nig = WGM * nN, gid = wgid / nig, fm = gid * WGM, gsz = (nM - fm) < WGM ? (nM - fm) : WGM;
        u.pm = fm + ((wgid % nig) % gsz); u.pn = (wgid % nig) / gsz; return true;
    }
    __device__ __forceinline__ void a_ready(const Unit&) const {}
    __device__ __forceinline__ void done(const Unit&) const {}
};

__device__ __forceinline__ unsigned cvt_pk_bf16(float lo, float hi) { unsigned r; asm volatile("v_cvt_pk_bf16_f32 %0, %1, %2" : "=v"(r) : "v"(lo), "v"(hi)); return r; }
typedef float f32x2 __attribute__((ext_vector_type(2)));
typedef __bf16 bf16x2_t __attribute__((ext_vector_type(2)));
typedef unsigned u32x2 __attribute__((ext_vector_type(2)));
__device__ __forceinline__ unsigned pkbf(float lo, float hi) { f32x2 v = {lo, hi}; bf16x2_t b = __builtin_convertvector(v, bf16x2_t); return __builtin_bit_cast(unsigned, b); }
__device__ __forceinline__ u32x4 pk8(f32x4 a, f32x4 b) { return (u32x4){pkbf(a[0], a[1]), pkbf(a[2], a[3]), pkbf(b[0], b[1]), pkbf(b[2], b[3])}; }
__device__ __forceinline__ float dot4(f32x4 a) { return (a[0] * a[0] + a[1] * a[1]) + (a[2] * a[2] + a[3] * a[3]); }
__device__ __forceinline__ float sum4(f32x4 a) { return (a[0] + a[1]) + (a[2] + a[3]); }
__device__ __forceinline__ float silu1(float v) { return v * __builtin_amdgcn_rcpf(1.0f + __builtin_amdgcn_exp2f(-1.4426950408889634f * v)); }
__device__ __forceinline__ f32x4 silu4(f32x4 v) { return (f32x4){silu1(v[0]), silu1(v[1]), silu1(v[2]), silu1(v[3])}; }
constexpr float RMS_EPS_F = 1e-6f;
constexpr float QSCALE = 0.125f * 1.4426950408889634f;

struct EpiIn {
    static constexpr bool PERM = true, AFTER_DRAIN = false;
    bf16_t *QA, *KA, *VA, *IQ, *IK, *QB, *KB, *VB, *GB; float* IW;
    const float *qnw, *knw;
    PG8_LAS float* xch;
    __device__ __forceinline__ void prefetch(const Unit&, int, int) {}
    __device__ __forceinline__ void advance() {}
    __device__ __forceinline__ void operator()(const f32x4 (&acc)[2][2][4][2], const Unit& u, int wr, int wc, int fr, int fq) {
        asm volatile("" : "+v"(fr), "+v"(fq));
        const int row0 = u.pm * BM + wr * 64 + fr, pn = u.pn;
        if (pn < 2) {
            const int head = 4 * pn + wc;
            const f32x4 w0 = *(const f32x4*)(qnw + 8 * fq), w1 = *(const f32x4*)(qnw + 8 * fq + 4), w2 = *(const f32x4*)(qnw + 32 + 8 * fq), w3 = *(const f32x4*)(qnw + 36 + 8 * fq);
#pragma unroll
            for (int ai = 0; ai < 2; ++ai)
#pragma unroll
                for (int m = 0; m < 4; ++m) {
                    f32x4 a0 = acc[ai][0][m][0], a1 = acc[ai][0][m][1], b0 = acc[ai][1][m][0], b1 = acc[ai][1][m][1];
                    float ss = (dot4(a0) + dot4(a1)) + (dot4(b0) + dot4(b1));
                    ss += __shfl_xor(ss, 16); ss += __shfl_xor(ss, 32);
                    const float rs = QSCALE / sqrtf(ss * (1.0f / 64.0f) + RMS_EPS_F);
                    bf16_t* p = QA + (size_t)(row0 + ai * HALF + m * 16) * 512 + head * 64 + 8 * fq;
                    *(u32x4*)p = pk8(a0 * w0 * rs, a1 * w1 * rs); *(u32x4*)(p + 32) = pk8(b0 * w2 * rs, b1 * w3 * rs);
                }
        } else if (pn == 2) {
            if (wc >= 2) {
#pragma unroll
                for (int ai = 0; ai < 2; ++ai)
#pragma unroll
                    for (int m = 0; m < 4; ++m) {
                        float ss = (dot4(acc[ai][0][m][0]) + dot4(acc[ai][0][m][1])) + (dot4(acc[ai][1][m][0]) + dot4(acc[ai][1][m][1]));
                        ss += __shfl_xor(ss, 16); ss += __shfl_xor(ss, 32);
                        if (fq == 0) xch[(ai * HALF + wr * 64 + m * 16 + fr) * 2 + (wc - 2)] = ss;
                    }
            }
            asm volatile("s_waitcnt lgkmcnt(0)" ::: "memory"); __builtin_amdgcn_s_barrier(); asm volatile("" ::: "memory");
            if (wc < 2) {
                const f32x4 w0 = *(const f32x4*)(knw + 8 * fq), w1 = *(const f32x4*)(knw + 8 * fq + 4), w2 = *(const f32x4*)(knw + 32 + 8 * fq), w3 = *(const f32x4*)(knw + 36 + 8 * fq);
#pragma unroll
                for (int ai = 0; ai < 2; ++ai)
#pragma unroll
                    for (int m = 0; m < 4; ++m) {
                        const int rl = ai * HALF + wr * 64 + m * 16 + fr;
                        const f32x2 pr = *(const PG8_LAS f32x2*)(xch + rl * 2);
                        const float rc = 1.0f / sqrtf((pr[0] + pr[1]) * (1.0f / 128.0f) + RMS_EPS_F);
                        f32x4 a0 = acc[ai][0][m][0] * rc, a1 = acc[ai][0][m][1] * rc, b0 = acc[ai][1][m][0] * rc, b1 = acc[ai][1][m][1] * rc;
                        const size_t row = (size_t)(row0 + ai * HALF + m * 16);
                        if (wc == 0) {
                            float ss = (dot4(a0) + dot4(a1)) + (dot4(b0) + dot4(b1));
                            ss += __shfl_xor(ss, 16); ss += __shfl_xor(ss, 32);
                            const float rs = 1.0f / sqrtf(ss * (1.0f / 64.0f) + RMS_EPS_F);
                            bf16_t* p = KA + row * 64 + 8 * fq;
                            *(u32x4*)p = pk8(a0 * w0 * rs, a1 * w1 * rs); *(u32x4*)(p + 32) = pk8(b0 * w2 * rs, b1 * w3 * rs);
                        } else {
                            bf16_t* p = VA + row * 64 + 8 * fq;
                            *(u32x4*)p = pk8(a0, a1); *(u32x4*)(p + 32) = pk8(b0, b1);
                        }
                    }
            }
        } else if (pn == 3) {
#pragma unroll
            for (int ai = 0; ai < 2; ++ai)
#pragma unroll
                for (int m = 0; m < 4; ++m) {
                    const size_t row = (size_t)(row0 + ai * HALF + m * 16);
                    *(u32x4*)(IQ + row * 128 + 32 * wc + 8 * fq) = pk8(acc[ai][0][m][0], acc[ai][0][m][1]);
                    if (wc == 0) *(u32x4*)(IK + row * 32 + 8 * fq) = pk8(acc[ai][1][m][0], acc[ai][1][m][1]);
                    if (wc == 1 && fq == 0) *(f32x4*)(IW + row * 4) = acc[ai][1][m][0];
                }
        } else if (pn < 8) {
            const int head = 4 * (pn & 1) + wc; bf16_t* dst = pn < 6 ? QB : KB;
            const float lg2 = __log2f(1.0f - __builtin_amdgcn_exp2f(-5.0f - (float)head));
            f32x4 iv0, iv1;
#pragma unroll
            for (int i = 0; i < 4; ++i) { iv0[i] = __builtin_amdgcn_exp2f(-(float)(8 * fq + i) * (13.287712379549449f / 32.0f)) * 0.15915494309189535f; iv1[i] = __builtin_amdgcn_exp2f(-(float)(8 * fq + 4 + i) * (13.287712379549449f / 32.0f)) * 0.15915494309189535f; }
#pragma unroll
            for (int ai = 0; ai < 2; ++ai)
#pragma unroll
                for (int m = 0; m < 4; ++m) {
                    const int row = row0 + ai * HALF + m * 16, pos = row & 2047; const float fp = (float)pos;
                    const float sc = pn < 6 ? __builtin_amdgcn_exp2f((float)(pos & 63) * lg2) : 0.125f * __builtin_amdgcn_exp2f(-(float)(pos & 63) * lg2);
                    f32x4 c0, c1, s0, s1;
#pragma unroll
                    for (int i = 0; i < 4; ++i) {
                        const float r0 = __builtin_amdgcn_fractf(fp * iv0[i]), r1 = __builtin_amdgcn_fractf(fp * iv1[i]);
                        c0[i] = __builtin_amdgcn_cosf(r0) * sc; s0[i] = __builtin_amdgcn_sinf(r0) * sc; c1[i] = __builtin_amdgcn_cosf(r1) * sc; s1[i] = __builtin_amdgcn_sinf(r1) * sc;
                    }
                    const f32x4 a0 = acc[ai][0][m][0], a1 = acc[ai][0][m][1], b0 = acc[ai][1][m][0], b1 = acc[ai][1][m][1];
                    bf16_t* p = dst + (size_t)row * 512 + head * 64 + 8 * fq;
                    *(u32x4*)p = pk8(a0 * c0 - b0 * s0, a1 * c1 - b1 * s1); *(u32x4*)(p + 32) = pk8(a0 * s0 + b0 * c0, a1 * s1 + b1 * c1);
                }
        } else {
            const int head = 4 * (pn & 1) + wc; bf16_t* dst = pn < 10 ? VB : GB; const bool act = pn >= 10;
#pragma unroll
            for (int ai = 0; ai < 2; ++ai)
#pragma unroll
                for (int m = 0; m < 4; ++m) {
                    f32x4 a0 = acc[ai][0][m][0], a1 = acc[ai][0][m][1], b0 = acc[ai][1][m][0], b1 = acc[ai][1][m][1];
                    if (act) { a0 = silu4(a0); a1 = silu4(a1); b0 = silu4(b0); b1 = silu4(b1); }
                    bf16_t* p = dst + (size_t)(row0 + ai * HALF + m * 16) * 512 + head * 64 + 8 * fq;
                    *(u32x4*)p = pk8(a0, a1); *(u32x4*)(p + 32) = pk8(b0, b1);
                }
        }
    }
};

struct EpiOut {
    static constexpr bool PERM = true, AFTER_DRAIN = false;
    const float* rms; bf16_t* x1b; float ss[8];
    __device__ __forceinline__ void prefetch(const Unit&, int, int) {}
    __device__ __forceinline__ void advance() {}
    __device__ __forceinline__ void operator()(const f32x4 (&acc)[2][2][4][2], const Unit& u, int wr, int wc, int fr, int fq) {
        asm volatile("" : "+v"(fr), "+v"(fq));
        const int row0 = u.pm * BM + wr * 64 + fr, col0 = u.pn * BM + wc * 32 + 8 * fq;
#pragma unroll
        for (int ai = 0; ai < 2; ++ai)
#pragma unroll
            for (int m = 0; m < 4; ++m) {
                const int row = row0 + ai * HALF + m * 16; const size_t off = (size_t)row * 1024 + col0; const float rm = rms[row]; float s = 0.f;
#pragma unroll
                for (int bj = 0; bj < 2; ++bj) {
                    const u32x4 xv = *(const u32x4*)(x1b + off + bj * HALF);
                    const f32x4 x0 = {__uint_as_float(xv[0] << 16), __uint_as_float(xv[0] & 0xffff0000u), __uint_as_float(xv[1] << 16), __uint_as_float(xv[1] & 0xffff0000u)};
                    const f32x4 x1 = {__uint_as_float(xv[2] << 16), __uint_as_float(xv[2] & 0xffff0000u), __uint_as_float(xv[3] << 16), __uint_as_float(xv[3] & 0xffff0000u)};
                    const f32x4 r0 = x0 * rm + acc[ai][bj][m][0], r1 = x1 * rm + acc[ai][bj][m][1];
                    *(u32x4*)(x1b + off + bj * HALF) = pk8(r0, r1);
                    s += dot4(r0) + dot4(r1);
                }
                ss[ai * 4 + m] += s;
            }
    }
};

struct EpiGU {
    static constexpr bool PERM = true, AFTER_DRAIN = false;
    const float* r2; bf16_t* act; f32x4 rc0, rc1, rn0, rn1; unsigned long long tepi;
    __device__ __forceinline__ void prefetch(const Unit& u, int wr, int fr) {
        const float* p = r2 + u.pm * BM + wr * 64 + fr;
        rn0 = (f32x4){p[0], p[16], p[32], p[48]}; rn1 = (f32x4){p[HALF], p[HALF + 16], p[HALF + 32], p[HALF + 48]};
    }
    __device__ __forceinline__ void advance() { rc0 = rn0; rc1 = rn1; }
    __device__ __forceinline__ void operator()(const f32x4 (&acc)[2][2][4][2], const Unit& u, int wr, int wc, int fr, int fq) {
#ifdef PROBE_TIMER
        const unsigned long long te0_ = __builtin_amdgcn_s_memtime();
#endif
        asm volatile("" : "+v"(fr), "+v"(fq));
        const int row0 = u.pm * BM + wr * 64 + fr, col0 = u.pn * HALF + wc * 32 + 8 * fq;
#pragma unroll
        for (int ai = 0; ai < 2; ++ai)
#pragma unroll
            for (int m = 0; m < 4; ++m) {
                const int row = row0 + ai * HALF + m * 16; const float rr = ai ? rc1[m] : rc0[m];
                const f32x4 g0 = acc[ai][0][m][0] * rr, g1 = acc[ai][0][m][1] * rr, u0 = acc[ai][1][m][0] * rr, u1 = acc[ai][1][m][1] * rr;
                *(u32x4*)(act + (size_t)row * 2816 + col0) = pk8(silu4(g0) * u0, silu4(g1) * u1);
            }
#ifdef PROBE_TIMER
        asm volatile("s_waitcnt vmcnt(0)" ::: "memory"); tepi += __builtin_amdgcn_s_memtime() - te0_;
#endif
    }
};

struct EpiDown {
    static constexpr bool PERM = true, AFTER_DRAIN = false;
    const bf16_t* x1b; float* out;
    __device__ __forceinline__ void prefetch(const Unit&, int, int) {}
    __device__ __forceinline__ void advance() {}
    __device__ __forceinline__ void operator()(const f32x4 (&acc)[2][2][4][2], const Unit& u, int wr, int wc, int fr, int fq) {
        asm volatile("" : "+v"(fr), "+v"(fq));
        const int row0 = u.pm * BM + wr * 64 + fr, col0 = u.pn * BM + wc * 32 + 8 * fq;
#pragma unroll
        for (int ai = 0; ai < 2; ++ai)
#pragma unroll
            for (int m = 0; m < 4; ++m) {
                const size_t off = (size_t)(row0 + ai * HALF + m * 16) * 1024 + col0;
#pragma unroll
                for (int bj = 0; bj < 2; ++bj) {
                    const u32x4 xv = *(const u32x4*)(x1b + off + bj * HALF);
                    const f32x4 x0 = {__uint_as_float(xv[0] << 16), __uint_as_float(xv[0] & 0xffff0000u), __uint_as_float(xv[1] << 16), __uint_as_float(xv[1] & 0xffff0000u)};
                    const f32x4 x1 = {__uint_as_float(xv[2] << 16), __uint_as_float(xv[2] & 0xffff0000u), __uint_as_float(xv[3] << 16), __uint_as_float(xv[3] & 0xffff0000u)};
                    *(f32x4*)(out + off + bj * HALF) = x0 + acc[ai][bj][m][0]; *(f32x4*)(out + off + bj * HALF + 4) = x1 + acc[ai][bj][m][1];
                }
            }
    }
};

struct PanelOrder {
    int pm, ntn;
    __device__ __forceinline__ bool next(int i, Unit& u) const { if (i >= ntn) return false; u.pm = pm; u.pn = i; return true; }
    __device__ __forceinline__ void a_ready(const Unit&) const {}
    __device__ __forceinline__ void done(const Unit&) const {}
};

template <class Epi, class Sched, bool ALIGN_EPI = false, bool SP2 = false>
__device__ __forceinline__ void gemm_phase(PG8_LAS unsigned char* lds, const Gemm g, const Sched& S, Epi& E, int wave_in) {
    unsigned ones_ = ~0u; asm volatile("" : "+s"(ones_)); int tid_ = wave_in * 64 + (int)__builtin_amdgcn_mbcnt_hi(ones_, __builtin_amdgcn_mbcnt_lo(ones_, 0u));
    const int tid = tid_, wid = __builtin_amdgcn_readfirstlane(tid >> 6), lane = tid & 63, wr = wid >> 2, wc = wid & 3, fr = lane & 15, fq = lane >> 4;
    const int K = g.K, nt = K / BK;
    unsigned voffA[2], voffB[2];
#pragma unroll
    for (int i = 0; i < 2; ++i) { int R, C; stage_rc(tid * 16 + i * 8192, R, C); const int Rb = Epi::PERM ? ((R & ~31) + perm32(R & 31)) : R;
        voffA[i] = (unsigned)(R * K + C) * 2u; voffB[i] = (unsigned)(Rb * K + C) * 2u; }
    const size_t kstep = (size_t)(BK * 2);
    const size_t hstep = (size_t)HALF * K * 2;
    const size_t tstep = 2 * hstep;
    const unsigned ldsw = (unsigned)wid * 1024u;
    const int aoff = lds_byte(wr * 64 + fr, fq * 8), boff = lds_byte(wc * 32 + fr, fq * 8);
#define PG8_SA(b, h) (((b) * 2 + (h)) * HTB)
#define PG8_SB(b, h) ((4 + (b) * 2 + (h)) * HTB)
#define PG8_STAGE(bufoff, gbase, voff) do { _Pragma("unroll") for (int _i = 0; _i < 2; ++_i) \
        __builtin_amdgcn_global_load_lds((const unsigned*)((const char*)(gbase) + (voff)[_i]), (PG8_LAS unsigned*)(lds + (bufoff) + ldsw + _i * 8192), 16, 0, 0); } while (0)
#define PG8_LDA(dst, b, h) do { _Pragma("unroll") for (int m = 0; m < 4; ++m) _Pragma("unroll") for (int k = 0; k < 2; ++k) dst[m][k] = *(const PG8_LAS bf16x8*)(lds + PG8_SA(b, h) + aoff + m * 2048 + k * 1024); } while (0)
#define PG8_LDB(dst, b, h) do { _Pragma("unroll") for (int n = 0; n < 2; ++n) _Pragma("unroll") for (int k = 0; k < 2; ++k) dst[n][k] = *(const PG8_LAS bf16x8*)(lds + PG8_SB(b, h) + boff + n * 2048 + k * 1024); } while (0)
#define PG8_MMA(ai, bj, At, Bt) do { __builtin_amdgcn_s_setprio(1); _Pragma("unroll") for (int m = 0; m < 4; ++m) _Pragma("unroll") for (int n = 0; n < 2; ++n) _Pragma("unroll") for (int k = 0; k < 2; ++k) \
        acc[ai][bj][m][n] = __builtin_amdgcn_mfma_f32_16x16x32_bf16(Bt[n][k], At[m][k], acc[ai][bj][m][n], 0, 0, 0); __builtin_amdgcn_s_setprio(0); } while (0)
#define PG8_WAIT_V(n) asm volatile("s_waitcnt vmcnt(" #n ")" ::: "memory")
#define PG8_WAIT_L(n) asm volatile("s_waitcnt lgkmcnt(" #n ")" ::: "memory")
#define PG8_BAR __builtin_amdgcn_s_barrier()
#define PG8_SCHED __builtin_amdgcn_sched_barrier(0)
    Unit cur, nxt; int ui = 0;
    if (!S.next(0, cur)) return;
    E.prefetch(cur, wr, fr); E.advance();
    f32x4 acc[2][2][4][2];
#pragma unroll
    for (int a = 0; a < 2; ++a)
#pragma unroll
        for (int b = 0; b < 2; ++b)
#pragma unroll
            for (int m = 0; m < 4; ++m)
#pragma unroll
                for (int n = 0; n < 2; ++n) acc[a][b][m][n] = (f32x4){0.f, 0.f, 0.f, 0.f};
    bf16x8 At[4][2], B0[2][2], B1[2][2];
    const char* cA = (const char*)g.A + (size_t)cur.pm * tstep; const char* cB = (const char*)g.Bt + (size_t)cur.pn * tstep;
    S.a_ready(cur);
    if constexpr (SP2) {
        PG8_STAGE(PG8_SB(0, 0), cB, voffB); PG8_STAGE(PG8_SB(0, 1), cB + hstep, voffB); PG8_STAGE(PG8_SA(0, 0), cA, voffA); PG8_STAGE(PG8_SA(0, 1), cA + hstep, voffA);
        if (wr == 1) PG8_BAR;
        PG8_WAIT_V(2); PG8_BAR;
        PG8_STAGE(PG8_SB(1, 0), cB + kstep, voffB); PG8_STAGE(PG8_SA(1, 0), cA + kstep, voffA); PG8_STAGE(PG8_SB(1, 1), cB + hstep + kstep, voffB);
        PG8_WAIT_V(6); PG8_BAR;
    } else {
        PG8_STAGE(PG8_SB(0, 0), cB, voffB); PG8_STAGE(PG8_SA(0, 0), cA, voffA); PG8_STAGE(PG8_SB(0, 1), cB + hstep, voffB); PG8_STAGE(PG8_SA(0, 1), cA + hstep, voffA);
        if (wr == 1) PG8_BAR;
        PG8_WAIT_V(4); PG8_BAR;
        PG8_STAGE(PG8_SB(1, 0), cB + kstep, voffB); PG8_STAGE(PG8_SA(1, 0), cA + kstep, voffA); PG8_STAGE(PG8_SB(1, 1), cB + hstep + kstep, voffB);
        PG8_WAIT_V(6); PG8_BAR;
    }
    for (;;) {
        const bool has_next = S.next(ui + 1, nxt);
        const char* nA = has_next ? (const char*)g.A + (size_t)nxt.pm * tstep : cA; const char* nB = has_next ? (const char*)g.Bt + (size_t)nxt.pn * tstep : cB;
        for (int t = 0; t < nt; t += 2) {
            const bool last = (t == nt - 2);
            const char* a1 = cA + (size_t)(t + 1) * kstep;
            const char* a2 = last ? nA : cA + (size_t)(t + 2) * kstep; const char* b2 = last ? nB : cB + (size_t)(t + 2) * kstep;
            const char* a3 = a2 + kstep; const char* b3 = b2 + kstep;
            if (last && has_next) { S.a_ready(nxt); E.prefetch(nxt, wr, fr); }
            if constexpr (SP2) {
            PG8_LDB(B0, 0, 0); PG8_LDB(B1, 0, 1); PG8_SCHED; PG8_LDA(At, 0, 0); PG8_STAGE(PG8_SA(1, 1), a1 + hstep, voffA);
            PG8_WAIT_V(8); PG8_WAIT_L(0); PG8_BAR; PG8_MMA(0, 0, At, B0); PG8_MMA(0, 1, At, B1); PG8_BAR; PG8_SCHED;
            PG8_LDA(At, 0, 1); PG8_STAGE(PG8_SB(0, 0), b2, voffB); PG8_STAGE(PG8_SB(0, 1), b2 + hstep, voffB); PG8_STAGE(PG8_SA(0, 0), a2, voffA);
            PG8_WAIT_V(8); PG8_WAIT_L(0); PG8_BAR; PG8_MMA(1, 0, At, B0); PG8_MMA(1, 1, At, B1); PG8_BAR; PG8_SCHED;
            PG8_LDB(B0, 1, 0); PG8_LDB(B1, 1, 1); PG8_SCHED; PG8_LDA(At, 1, 0); PG8_STAGE(PG8_SA(0, 1), a2 + hstep, voffA);
            PG8_WAIT_V(8); PG8_WAIT_L(0); PG8_BAR; PG8_MMA(0, 0, At, B0); PG8_MMA(0, 1, At, B1); PG8_BAR; PG8_SCHED;
            PG8_LDA(At, 1, 1); PG8_STAGE(PG8_SB(1, 0), b3, voffB); PG8_STAGE(PG8_SB(1, 1), b3 + hstep, voffB); PG8_STAGE(PG8_SA(1, 0), a3, voffA);
            PG8_WAIT_V(8); PG8_WAIT_L(0); PG8_BAR; PG8_MMA(1, 0, At, B0); PG8_MMA(1, 1, At, B1); PG8_BAR; PG8_SCHED;
            } else {
            PG8_LDB(B0, 0, 0); PG8_SCHED; PG8_LDA(At, 0, 0); PG8_STAGE(PG8_SA(1, 1), a1 + hstep, voffA);
            PG8_WAIT_L(8); PG8_BAR; PG8_WAIT_L(0); PG8_MMA(0, 0, At, B0); PG8_BAR; PG8_SCHED;
            PG8_LDB(B1, 0, 1); PG8_STAGE(PG8_SB(0, 0), b2, voffB);
            PG8_BAR; PG8_WAIT_L(0); PG8_MMA(0, 1, At, B1); PG8_BAR;
            PG8_LDA(At, 0, 1); PG8_STAGE(PG8_SA(0, 0), a2, voffA);
            PG8_BAR; PG8_WAIT_L(0); PG8_MMA(1, 0, At, B0); PG8_BAR; PG8_SCHED;
            PG8_STAGE(PG8_SB(0, 1), b2 + hstep, voffB);
            PG8_WAIT_V(6); PG8_BAR; PG8_MMA(1, 1, At, B1); PG8_BAR;
            PG8_LDB(B0, 1, 0); PG8_SCHED; PG8_LDA(At, 1, 0); PG8_STAGE(PG8_SA(0, 1), a2 + hstep, voffA);
            PG8_WAIT_L(8); PG8_BAR; PG8_WAIT_L(0); PG8_MMA(0, 0, At, B0); PG8_BAR; PG8_SCHED;
            PG8_LDB(B1, 1, 1); PG8_STAGE(PG8_SB(1, 0), b3, voffB);
            PG8_BAR; PG8_WAIT_L(0); PG8_MMA(0, 1, At, B1); PG8_BAR;
            PG8_LDA(At, 1, 1); PG8_STAGE(PG8_SA(1, 0), a3, voffA);
            PG8_BAR; PG8_WAIT_L(0); PG8_MMA(1, 0, At, B0); PG8_BAR; PG8_SCHED;
            PG8_STAGE(PG8_SB(1, 1), b3 + hstep, voffB);
            PG8_WAIT_V(6); PG8_BAR; PG8_MMA(1, 1, At, B1); PG8_BAR;
            }
        }
        if constexpr (ALIGN_EPI) { if (wr == 0) PG8_BAR; }
        if constexpr (!Epi::AFTER_DRAIN) { E(acc, cur, wr, wc, fr, fq); E.advance(); S.done(cur); }
        if (!has_next) break;
#pragma unroll
        for (int a = 0; a < 2; ++a)
#pragma unroll
            for (int b = 0; b < 2; ++b)
#pragma unroll
                for (int m = 0; m < 4; ++m)
#pragma unroll
                    for (int n = 0; n < 2; ++n) acc[a][b][m][n] = (f32x4){0.f, 0.f, 0.f, 0.f};
        cur = nxt; cA = nA; cB = nB; ++ui;
        if constexpr (ALIGN_EPI) { if (wr == 1) PG8_BAR; }
    }
    PG8_WAIT_V(0);
    if constexpr (!ALIGN_EPI) { if (wr == 0) PG8_BAR; }
    PG8_BAR;
    (void)lane;
#undef PG8_SA
#undef PG8_SB
#undef PG8_STAGE
#undef PG8_LDA
#undef PG8_LDB
#undef PG8_MMA
#undef PG8_WAIT_V
#undef PG8_WAIT_L
#undef PG8_BAR
#undef PG8_SCHED
}
}

constexpr int BATCH = 32, SEQ = 2048, DM = 1024, MTOK = BATCH * SEQ;
constexpr int INW = 2852, NIN = 3072, FF = 2816, NGU = 2 * FF;
constexpr int NWAVES = 8, NTHR = 512;
#ifndef MK_N_LAUNCHES
#define MK_N_LAUNCHES 1
#endif
constexpr int N_PHASES = 6;
constexpr size_t MiB = 1u << 20;
constexpr size_t WS_CTL = 0;
constexpr size_t WS_COS = 1 * MiB, WS_SIN = WS_COS + 256 * 1024;
constexpr size_t WS_BT = WS_SIN + 256 * 1024;
constexpr size_t WS_R2 = 2 * MiB, WS_RMS = 2 * MiB + 512 * 1024;
constexpr size_t WS_WIN = 4 * MiB, WS_WOUT = 10 * MiB, WS_WGU = 12 * MiB, WS_WDN = 23 * MiB;
constexpr size_t WS_XB = 32 * MiB;
constexpr size_t WS_MIX = 160 * MiB;
constexpr size_t WS_QA = 288 * MiB, WS_QB = 352 * MiB, WS_KB = 416 * MiB, WS_VB = 480 * MiB, WS_GB = 544 * MiB;
constexpr size_t WS_KA = 608 * MiB, WS_VA = 616 * MiB;
constexpr size_t WS_IQ = 624 * MiB;
constexpr size_t WS_ACT = 648 * MiB;
constexpr size_t WS_IK = 640 * MiB, WS_IW = 644 * MiB;
constexpr size_t WS_END = 1000 * MiB;
static_assert(WS_ACT + (size_t)MTOK * FF * 2 <= WS_END && WS_IW + (size_t)MTOK * 16 <= WS_ACT && WS_IQ + (size_t)MTOK * 128 * 2 <= WS_IK && WS_WDN + (size_t)DM * FF * 2 <= WS_XB && WS_WGU + (size_t)NGU * DM * 2 <= WS_WDN, "d_ws map");
constexpr int RING_BYTES = 131072;
constexpr int XCH_OFF = RING_BYTES;
constexpr int P2_SC = 0, SCW = 2052;
constexpr int P2_MASK = 143360;
constexpr int MISC_OFF = 163584;
constexpr int LDS_BYTES = 163840;
static_assert(P2_SC + 16 * SCW * 4 <= P2_MASK && P2_MASK + 16384 <= MISC_OFF, "P2 LDS map");

#define LAS __attribute__((address_space(3)))
typedef unsigned short bf16;
typedef unsigned v4u __attribute__((ext_vector_type(4)));
typedef unsigned v2u __attribute__((ext_vector_type(2)));
typedef float f32x4 __attribute__((ext_vector_type(4)));
typedef float f32x16 __attribute__((ext_vector_type(16)));
typedef short bf16x8 __attribute__((ext_vector_type(8)));
typedef short s16x4 __attribute__((ext_vector_type(4)));
#define LDS_WAIT() asm volatile("s_waitcnt lgkmcnt(0)" ::: "memory")
using pg8::pkbf;
__device__ __forceinline__ float bf2f(unsigned short h) { return __uint_as_float((unsigned)h << 16); }
__device__ __forceinline__ float bflo(unsigned w) { return __uint_as_float(w << 16); }
__device__ __forceinline__ float bfhi(unsigned w) { return __uint_as_float(w & 0xffff0000u); }
__device__ __forceinline__ float wave_sum(float v) {
#pragma unroll
    for (int o = 1; o < 64; o <<= 1) v += __shfl_xor(v, o);
    return v;
}
__device__ __forceinline__ s16x4 vtr(const LAS unsigned char* p) { return __builtin_bit_cast(s16x4, __builtin_amdgcn_ds_read_tr16_b64_v4i16((LAS s16x4*)p)); }
__device__ __forceinline__ bf16x8 cat8(s16x4 lo, s16x4 hi) { return (bf16x8){lo[0], lo[1], lo[2], lo[3], hi[0], hi[1], hi[2], hi[3]}; }
__device__ __forceinline__ int crow(int r, int hi) { return (r & 3) + 8 * (r >> 2) + 4 * hi; }

__device__ __forceinline__ int lane_id() { unsigned ones = ~0u; asm volatile("" : "+s"(ones)); return (int)__builtin_amdgcn_mbcnt_hi(ones, __builtin_amdgcn_mbcnt_lo(ones, 0u)); }
struct KArgs { const float* in[16]; float* out; unsigned char* ws; int ph_lo, ph_hi; };
struct Frame {
    LAS unsigned char* lds;
    unsigned* ctl;
    unsigned char* ws;
    int tid, lane, wave, vcu, G;
    int grp, rk;
    const __attribute__((address_space(4))) KArgs* ap;
    __device__ __forceinline__ const float* x() const { return ap->in[0]; }
    __device__ __forceinline__ const float* norm1_w() const { return ap->in[1]; }
    __device__ __forceinline__ const float* w_in() const { return ap->in[2]; }
    __device__ __forceinline__ const float* q_norm_w() const { return ap->in[3]; }
    __device__ __forceinline__ const float* k_norm_w() const { return ap->in[4]; }
    __device__ __forceinline__ const float* kv_norm_w() const { return ap->in[5]; }
    __device__ __forceinline__ const float* w_uk() const { return ap->in[6]; }
    __device__ __forceinline__ const float* w_uv() const { return ap->in[7]; }
    __device__ __forceinline__ const float* rel_bias() const { return ap->in[8]; }
    __device__ __forceinline__ const float* ret_gn_w() const { return ap->in[9]; }
    __device__ __forceinline__ const float* ret_gn_b() const { return ap->in[10]; }
    __device__ __forceinline__ const float* w_out() const { return ap->in[11]; }
    __device__ __forceinline__ const float* norm2_w() const { return ap->in[12]; }
    __device__ __forceinline__ const float* w_gate() const { return ap->in[13]; }
    __device__ __forceinline__ const float* w_up() const { return ap->in[14]; }
    __device__ __forceinline__ const float* w_down() const { return ap->in[15]; }
    __device__ __forceinline__ float* out() const { return ap->out; }
#define WSB_(name, off) __device__ __forceinline__ bf16* name() const { return (bf16*)(ws + (off)); }
#define WSF_(name, off) __device__ __forceinline__ float* name() const { return (float*)(ws + (off)); }
    WSB_(WIN, WS_WIN) WSB_(WOUT, WS_WOUT) WSB_(WGU, WS_WGU) WSB_(WDN, WS_WDN) WSB_(XB, WS_XB) WSB_(MIX, WS_MIX) WSB_(QA, WS_QA) WSB_(QB, WS_QB) WSB_(KB, WS_KB) WSB_(VB, WS_VB) WSB_(GB, WS_GB)
    WSB_(KA, WS_KA) WSB_(VA, WS_VA) WSB_(IQ, WS_IQ) WSB_(IK, WS_IK) WSB_(ACT, WS_ACT)
    WSF_(IW, WS_IW) WSF_(R2, WS_R2) WSF_(RMS, WS_RMS) WSF_(COS, WS_COS) WSF_(SIN, WS_SIN) WSF_(BT, WS_BT)
#undef WSB_
#undef WSF_
};

__device__ __forceinline__ int zcol(int n) {
    const int pn = n >> 8, tc = n & 255, bj = tc >> 7, wc = (tc >> 5) & 3, j = tc & 31, d = bj * 32 + j;
    if (pn < 2) return (4 * pn + wc) * 64 + d;
    if (pn == 2) { if (wc == 0) return -2 - d; if (wc == 1) return -2 - (64 + d); return 512 + (wc - 2) * 64 + d; }
    if (pn == 3) { if (bj == 0) return 640 + wc * 32 + j; if (wc == 0) return 768 + j; if (wc == 1 && j < 4) return 800 + j; return -1; }
    const int g = (pn - 4) >> 1, head = 4 * ((pn - 4) & 1) + wc;
    return 804 + g * 512 + head * 64 + d;
}
template <class SRC>
__device__ __forceinline__ void tr_item(SRC src, int Kdim, bf16* WT, int k0, int n0, LAS float* scr, int lane) {
#pragma unroll 4
    for (int i = 0; i < 32; ++i) { const int kk = 2 * i + (lane >> 5); scr[kk * 33 + (lane & 31)] = src(k0 + kk); }
    LDS_WAIT(); asm volatile("" ::: "memory");
    const int c = lane & 7;
#pragma unroll
    for (int j = 0; j < 4; ++j) { const int n = (lane >> 3) + 8 * j; const LAS float* s = scr + (8 * c) * 33 + n;
        v4u o; o.x = pkbf(s[0 * 33], s[1 * 33]); o.y = pkbf(s[2 * 33], s[3 * 33]); o.z = pkbf(s[4 * 33], s[5 * 33]); o.w = pkbf(s[6 * 33], s[7 * 33]);
        *(v4u*)(WT + (size_t)(n0 + n) * Kdim + k0 + 8 * c) = o; }
    LDS_WAIT(); asm volatile("" ::: "memory");
}
__device__ __forceinline__ int t5_bucket(int rel) {
    const int n = rel < 0 ? -rel : rel; int b;
    if (n < 8) b = n; else if (n < 12) b = 8; else if (n < 16) b = 9; else if (n < 23) b = 10; else if (n < 32) b = 11; else if (n < 46) b = 12; else if (n < 64) b = 13; else if (n < 91) b = 14; else b = 15;
    return (rel > 0 ? 16 : 0) + b;
}
__device__ __forceinline__ void p0_prologue(Frame& F) {
    LAS float* scr = (LAS float*)(F.lds + F.wave * 16384);
    const int lane = F.lane, gw = F.vcu * NWAVES + F.wave, NGW = F.G * NWAVES;
    if (blockIdx.x == 0 && F.tid == 0) F.ctl[0] = 0u;
    constexpr int I_IN = 16 * (NIN / 32), I_OUT = 16 * 32, I_GU = 16 * (NGU / 32), I_DN = (FF / 64) * 32, NITEMS = I_IN + I_OUT + I_GU + I_DN;
    auto do_item = [&](int it) {
        int r = it;
        if (r < I_IN) {
            const int kb = r / (NIN / 32), nb = r % (NIN / 32), f = zcol(32 * nb + (lane & 31));
            const float* w_in = F.w_in(); const float* nw = F.norm1_w();
            if (f >= -1) tr_item([&](int k) { return f >= 0 ? nw[k] * w_in[(size_t)k * INW + f] : 0.0f; }, DM, F.WIN(), 64 * kb, 32 * nb, scr, lane);
            return;
        }
        r -= I_IN;
        if (r < I_OUT) { const int kb = r / 32, nb = r % 32; const float* w = F.w_out() + 32 * nb + (lane & 31);
            tr_item([&](int k) { return w[(size_t)k * DM]; }, DM, F.WOUT(), 64 * kb, 32 * nb, scr, lane); return; }
        r -= I_OUT;
        if (r < I_GU) { const int kb = r / (NGU / 32), nb = r % (NGU / 32), n = 32 * nb + (lane & 31), pn = n >> 8, tc = n & 255;
            const float* w = ((tc >> 7) ? F.w_up() : F.w_gate()) + 128 * pn + (tc & 127); const float* nw = F.norm2_w();
            tr_item([&](int k) { return nw[k] * w[(size_t)k * FF]; }, DM, F.WGU(), 64 * kb, 32 * nb, scr, lane); return; }
        r -= I_GU;
        { const int kb = r / 32, nb = r % 32; const float* w = F.w_down() + 32 * nb + (lane & 31);
            tr_item([&](int k) { return w[(size_t)k * DM]; }, FF, F.WDN(), 64 * kb, 32 * nb, scr, lane); }
    };
    for (int e = F.vcu * NTHR + F.tid; e < DM * 128; e += F.G * NTHR) {
        const int k = e >> 7, idx = e & 127, d = idx & 63; const float* wu = (idx < 64 ? F.w_uk() : F.w_uv()) + d; const float* wr_ = F.w_in() + (size_t)k * INW + 512; float a = 0.f;
#pragma unroll 8
        for (int j = 0; j < 128; ++j) a += wr_[j] * F.kv_norm_w()[j] * wu[j * 64];
        const int n = 512 + (idx < 64 ? 0 : 32) + (d < 32 ? d : 128 + d - 32);
        F.WIN()[(size_t)n * DM + k] = (bf16)(pkbf(F.norm1_w()[k] * a, 0.f) & 0xffffu);
    }
    int it = gw, kk = 0;
    for (int m = gw; m < MTOK; m += NGW, ++kk) {
        const f32x4* xr = (const f32x4*)(F.x() + (size_t)m * DM) + lane;
        f32x4 v[4]; float sq = 0.f;
#pragma unroll
        for (int j = 0; j < 4; ++j) { v[j] = xr[64 * j]; sq += pg8::dot4(v[j]); }
        const float ms = wave_sum(sq) * (1.0f / DM) + 1e-6f, rr = 1.0f / sqrtf(ms);
        v2u* o8 = (v2u*)(F.XB() + (size_t)m * DM) + lane;
#pragma unroll
        for (int j = 0; j < 4; ++j) o8[64 * j] = (v2u){pkbf(v[j][0] * rr, v[j][1] * rr), pkbf(v[j][2] * rr, v[j][3] * rr)};
        if (lane == 0) F.RMS()[m] = sqrtf(ms);
        if ((kk & 7) == 3 && it < NITEMS) { do_item(it); it += NGW; }
    }
    for (; it < NITEMS; it += NGW) do_item(it);
    const int gt = F.vcu * NTHR + F.tid, NGT = F.G * NTHR;
    for (int i = gt; i < 8 * 256; i += NGT) { const int h = i >> 8, rel = (i & 255) - 191;
        F.BT()[i] = (F.rel_bias()[t5_bucket(rel) * 8 + h] - F.rel_bias()[15 * 8 + h]) * 1.4426950408889634f; }
}

#ifndef PROBE_LO
#define PROBE_LO 3000.0f
#define PROBE_RANGE 4000.0f
#endif
#ifndef PLANES
#define PLANES 1
#endif
#ifndef MIXREP
#define MIXREP 0
#endif
typedef float f32x4_t __attribute__((ext_vector_type(4)));
typedef float f32x2v __attribute__((ext_vector_type(2)));
struct IdxOps { bf16x8 bq[4]; f32x4 wv; bf16x8 a0; };
__device__ __forceinline__ void idx_fetch(IdxOps& o, const Frame& F, int b, int c, int rq) {
    const int w = F.wave, lane = F.lane, q = lane & 15, g = lane >> 4;
    const size_t rowq = (size_t)b * SEQ + 64 * c + 16 * rq + q;
#pragma unroll
    for (int h = 0; h < 4; ++h) o.bq[h] = *(const bf16x8*)(F.IQ() + rowq * 128 + 32 * h + 8 * g);
    o.wv = *(const f32x4*)(F.IW() + rowq * 4) * (0.5f * 0.17677669529663687f);
    o.a0 = *(const bf16x8*)(F.IK() + ((size_t)b * SEQ + q) * 32 + 8 * g + (size_t)w * 512);
}
__device__ __forceinline__ void idx_round(const IdxOps& o, const Frame& F, int b, int c, LAS unsigned char* lds) {
    const int w = F.wave, lane = F.lane, q = lane & 15, g = lane >> 4;
    const int nkb = 4 * (c + 1);
    const bf16* kp = F.IK() + ((size_t)b * SEQ + q) * 32 + 8 * g;
    LAS float* dst = (LAS float*)(lds + P2_SC) + q * SCW + 4 * g;
    int kb = w; bf16x8 a = o.a0;
    for (; kb < nkb; kb += 8) {
        bf16x8 an = a; if (kb + 8 < nkb) an = *(const bf16x8*)(kp + (size_t)(kb + 8) * 512);
        f32x4 sc = {0.f, 0.f, 0.f, 0.f};
#pragma unroll
        for (int h = 0; h < 4; ++h) {
            const f32x4 d = __builtin_amdgcn_mfma_f32_16x16x32_bf16(a, o.bq[h], (f32x4){0.f, 0.f, 0.f, 0.f}, 0, 0, 0);
#pragma unroll
            for (int i = 0; i < 4; ++i) sc[i] += o.wv[h] * fmaxf(d[i], 0.f);
        }
        *(LAS f32x4*)(dst + 16 * kb) = (f32x4){sc[0] + 0.f, sc[1] + 0.f, sc[2] + 0.f, sc[3] + 0.f};
        a = an;
    }
}
__device__ __forceinline__ int wave_sum_i(int v) {
    v += __builtin_amdgcn_update_dpp(0, v, 0xB1, 0xF, 0xF, false);
    v += __builtin_amdgcn_update_dpp(0, v, 0x4E, 0xF, 0xF, false);
    v += __builtin_amdgcn_update_dpp(0, v, 0x141, 0xF, 0xF, false);
    v += __builtin_amdgcn_update_dpp(0, v, 0x140, 0xF, 0xF, false);
    return (__builtin_amdgcn_readlane(v, 0) + __builtin_amdgcn_readlane(v, 16)) + (__builtin_amdgcn_readlane(v, 32) + __builtin_amdgcn_readlane(v, 48));
}
__device__ __forceinline__ unsigned sortable(float f) { const unsigned bits = __float_as_uint(f); return bits ^ ((unsigned)((int)bits >> 31) | 0x80000000u); }
template <int NJ>
__device__ __forceinline__ void mask_words(const unsigned (&u)[NJ], unsigned prefix, bool exact, LAS unsigned long long* mrow, int nj, int lane) {
    unsigned long long mv = 0ull;
    if (exact) {
#pragma unroll
        for (int j = 0; j < NJ; ++j) { const unsigned long long sel = __ballot(u[j] >= prefix); if (lane == j) mv = sel; }
    } else {
        int ngt = 0;
#pragma unroll
        for (int j = 0; j < NJ; ++j) ngt += __popcll(__ballot(u[j] > prefix));
        int need = 256 - ngt;
#pragma unroll
        for (int j = 0; j < NJ; ++j) {
            const unsigned long long eq = __ballot(u[j] == prefix);
            const int rank = (int)__builtin_amdgcn_mbcnt_hi((unsigned)(eq >> 32), __builtin_amdgcn_mbcnt_lo((unsigned)eq, 0u));
            const unsigned long long sel = __ballot(u[j] > prefix || (u[j] == prefix && rank < need));
            need -= __popcll(eq);
            if (lane == j) mv = sel;
        }
    }
    if (lane < nj) mrow[lane] = mv;
}
template <int NJ>
__device__ __forceinline__ void select_row(const LAS float* row, LAS unsigned long long* mrow, int nj, int lane) {
    static_assert(NJ % 4 == 0, "groups of four");
    unsigned u[NJ];
#pragma unroll
    for (int j = 0; j < NJ; ++j) { float v = row[64 * j + lane]; asm volatile("" : "+v"(v)); u[j] = (j < nj) ? sortable(v) : 0u; }
    unsigned prefix = 0u; bool exact = false;
#pragma unroll 1
    for (int bit = 31; bit >= 0; --bit) {
        const unsigned trial = prefix | (1u << bit); int c0 = 0, c1 = 0, c2 = 0, c3 = 0;
#pragma unroll
        for (int j = 0; j < NJ; j += 4) {
            unsigned long long m0, m1, m2, m3;
            asm volatile("v_cmp_le_u32_e64 %4, %12, %8\n\tv_cmp_le_u32_e64 %5, %12, %9\n\tv_cmp_le_u32_e64 %6, %12, %10\n\tv_cmp_le_u32_e64 %7, %12, %11\n\t"
                         "v_addc_co_u32_e64 %0, %4, 0, %0, %4\n\tv_addc_co_u32_e64 %1, %5, 0, %1, %5\n\tv_addc_co_u32_e64 %2, %6, 0, %2, %6\n\tv_addc_co_u32_e64 %3, %7, 0, %3, %7"
                         : "+v"(c0), "+v"(c1), "+v"(c2), "+v"(c3), "=&s"(m0), "=&s"(m1), "=&s"(m2), "=&s"(m3) : "v"(u[j]), "v"(u[j + 1]), "v"(u[j + 2]), "v"(u[j + 3]), "s"(trial));
        }
        const int cnt = wave_sum_i((c0 + c1) + (c2 + c3));
        if (cnt >= 256) prefix = trial;
        if (cnt == 256) { exact = true; break; }
    }
    mask_words<NJ>(u, prefix, exact, mrow, nj, lane);
}
template <int S, unsigned M>
__device__ __forceinline__ void tr_stage(unsigned (&A)[32]) {
#pragma unroll
    for (int k = 0; k < 32; ++k) if (!(k & S)) {
        const unsigned a = A[k], b = A[k + S], bs = b << S, as = a >> S; unsigned lo, hi;
        asm("v_bfi_b32 %0, %1, %2, %3" : "=v"(lo) : "s"(M), "v"(a), "v"(bs)); asm("v_bfi_b32 %0, %1, %2, %3" : "=v"(hi) : "s"(M), "v"(as), "v"(b));
        A[k] = lo; A[k + S] = hi; }
}
__device__ __forceinline__ void tr_bytes(unsigned (&A)[32]) {
#pragma unroll
    for (int k = 0; k < 16; ++k) { const unsigned a = A[k], b = A[k + 16];
        A[k] = __builtin_amdgcn_perm(b, a, 0x05040100u);
        A[k + 16] = __builtin_amdgcn_perm(b, a, 0x07060302u); }
#pragma unroll
    for (int k = 0; k < 32; ++k) if (!(k & 8)) { const unsigned a = A[k], b = A[k + 8];
        A[k] = __builtin_amdgcn_perm(b, a, 0x06020400u);
        A[k + 8] = __builtin_amdgcn_perm(b, a, 0x07030501u); }
}
__device__ __forceinline__ void planes_finish(unsigned gt, unsigned alive, int G, bool done, LAS unsigned long long* mrow, int nj, int lane) {
    unsigned sel = gt | alive;
    if (!done) {
        int need = 256 - G; unsigned ts = 0u;
#pragma unroll
        for (int j = 0; j < 32; ++j) {
            const bool mine = (alive >> j) & 1u; const unsigned long long eq = __ballot(mine);
            const int rank = (int)__builtin_amdgcn_mbcnt_hi((unsigned)(eq >> 32), __builtin_amdgcn_mbcnt_lo((unsigned)eq, 0u));
            ts |= (mine && rank < need) ? (1u << j) : 0u; need -= __popcll(eq);
        }
        sel = gt | ts;
    }
    unsigned long long mv = 0ull;
#pragma unroll
    for (int j = 0; j < 32; ++j) { const unsigned long long w = __ballot((sel >> j) & 1u); if (lane == j) mv = w; }
    if (lane < nj) mrow[lane] = mv;
}
__device__ __forceinline__ void select_rows_planes2(const LAS float* rowa, const LAS float* rowb, LAS unsigned long long* mrowa, LAS unsigned long long* mrowb, int nj, int lane) {
    unsigned A[32], B[32];
#pragma unroll
    for (int j = 0; j < 32; ++j) { float va = rowa[64 * j + lane], vb = rowb[64 * j + lane]; asm volatile("" : "+v"(va), "+v"(vb)); A[j] = (j < nj) ? sortable(va) : 0u; B[j] = (j < nj) ? sortable(vb) : 0u; }
    tr_bytes(A); tr_stage<4, 0x0F0F0F0Fu>(A); tr_stage<2, 0x33333333u>(A); tr_stage<1, 0x55555555u>(A);
    tr_bytes(B); tr_stage<4, 0x0F0F0F0Fu>(B); tr_stage<2, 0x33333333u>(B); tr_stage<1, 0x55555555u>(B);
#pragma unroll
    for (int j = 0; j < 32; ++j) asm volatile("" : "+v"(A[j]), "+v"(B[j]));
    unsigned alivea = 0xFFFFFFFFu, gta = 0u, aliveb = 0xFFFFFFFFu, gtb = 0u; int Ga = 0, Aa = 2048, Gb = 0, Ab = 2048; bool donea = false, doneb = false;
#pragma unroll
    for (int b = 31; b >= 0; --b) {
        if (!(donea && doneb)) {
            const unsigned onesa = alivea & A[b], onesb = aliveb & B[b];
            const int both = wave_sum_i(__builtin_popcount(onesa) | (__builtin_popcount(onesb) << 16)), C1a = both & 0xffff, C1b = both >> 16;
            if (!donea) {
                if (Ga + C1a >= 256) { alivea = onesa; Aa = C1a; } else { Ga += C1a; gta |= onesa; alivea &= ~A[b]; Aa -= C1a; }
                donea = (Ga + Aa == 256);
            }
            if (!doneb) {
                if (Gb + C1b >= 256) { aliveb = onesb; Ab = C1b; } else { Gb += C1b; gtb |= onesb; aliveb &= ~B[b]; Ab -= C1b; }
                doneb = (Gb + Ab == 256);
            }
        }
    }
    planes_finish(gta, alivea, Ga, donea, mrowa, nj, lane);
    planes_finish(gtb, aliveb, Gb, doneb, mrowb, nj, lane);
}
constexpr int MP_STRIDE = 36, MP_PLANE = 64 * MP_STRIDE;
__device__ __forceinline__ unsigned row32_sum(unsigned v) {
    v += __builtin_amdgcn_update_dpp(0, v, 0xB1, 0xF, 0xF, true);
    v += __builtin_amdgcn_update_dpp(0, v, 0x4E, 0xF, 0xF, true);
    v += __builtin_amdgcn_update_dpp(0, v, 0x141, 0xF, 0xF, true);
    v += __builtin_amdgcn_update_dpp(0, v, 0x140, 0xF, 0xF, true);
#if defined(SWZ_SUM)
    return v + (unsigned)__builtin_amdgcn_ds_swizzle((int)v, 0x401F);
#else
    const auto sw = __builtin_amdgcn_permlane16_swap(v, v, false, false);
    return (unsigned)sw[0] + (unsigned)sw[1];
#endif
}
__device__ __forceinline__ void select_rows32(const LAS float* sc, LAS unsigned* mp, int rq, int nj, int wave, int lane) {
    const int half = lane >> 5, l32 = lane & 31, ql = 2 * wave + half;
    const LAS float* row = sc + ql * SCW + l32;
    unsigned A[32], B[32];
#ifdef ASM_MARK
    asm volatile("; SEL_BEGIN");
#endif
#pragma unroll
    for (int i = 0; i < 32; ++i) { float va = row[32 * i], vb = row[32 * (32 + i)]; asm volatile("" : "+v"(va), "+v"(vb)); A[i] = __float_as_uint(va); B[i] = __float_as_uint(vb); }
    tr_bytes(A); tr_stage<4, 0x0F0F0F0Fu>(A); tr_stage<2, 0x33333333u>(A); tr_stage<1, 0x55555555u>(A);
    tr_bytes(B); tr_stage<4, 0x0F0F0F0Fu>(B); tr_stage<2, 0x33333333u>(B); tr_stage<1, 0x55555555u>(B);
#ifdef ASM_MARK
    asm volatile("; SEL_TR_END");
#endif
    const int nv = 2 * nj;
    unsigned al0 = nv >= 32 ? 0xFFFFFFFFu : ((1u << nv) - 1u), al1 = nv <= 32 ? 0u : (nv >= 64 ? 0xFFFFFFFFu : ((1u << (nv - 32)) - 1u));
    unsigned gt0 = 0u, gt1 = 0u, G = 0u;
    const unsigned S0 = A[31], S1 = B[31];
#pragma unroll
    for (int b = 31; b >= 0; --b) {
        const unsigned o0 = b == 31 ? (al0 & ~S0) : __builtin_amdgcn_bitop3_b32(al0, A[b], S0, 0x60), o1 = b == 31 ? (al1 & ~S1) : __builtin_amdgcn_bitop3_b32(al1, B[b], S1, 0x60);
        const unsigned c1 = row32_sum((unsigned)__builtin_popcount(o0) + (unsigned)__builtin_popcount(o1));
        const unsigned nt = (unsigned)((int)(G + c1 - 256u) >> 31);
        al0 = __builtin_amdgcn_bitop3_b32(o0, al0, nt, 0x78); al1 = __builtin_amdgcn_bitop3_b32(o1, al1, nt, 0x78);
        gt0 = __builtin_amdgcn_bitop3_b32(gt0, o0, nt, 0xF8); gt1 = __builtin_amdgcn_bitop3_b32(gt1, o1, nt, 0xF8);
        G += c1 & nt;
    }
#ifdef ASM_MARK
    asm volatile("; SEL_LOOP_END");
#endif
    const unsigned ce = row32_sum((unsigned)__builtin_popcount(al0) + (unsigned)__builtin_popcount(al1));
    const bool tie = G + ce != 256u;
    if (__any(tie)) {
        const unsigned need = tie ? 256u - G : 0x7fffffffu; unsigned m = 0u;
#pragma unroll
        for (int bit = 6; bit >= 0; --bit) {
            const unsigned cand = m + (1u << bit);
            const unsigned k0 = cand >= 32u ? 0xFFFFFFFFu : ((1u << cand) - 1u), k1 = cand <= 32u ? 0u : (cand >= 64u ? 0xFFFFFFFFu : ((1u << (cand - 32u)) - 1u));
            const unsigned cc = row32_sum((unsigned)__builtin_popcount(al0 & k0) + (unsigned)__builtin_popcount(al1 & k1));
            m = (cand <= 64u && cc <= need) ? cand : m;
        }
        const unsigned k0 = m >= 32u ? 0xFFFFFFFFu : ((1u << m) - 1u), k1 = m <= 32u ? 0u : (m >= 64u ? 0xFFFFFFFFu : ((1u << (m - 32u)) - 1u));
        const unsigned cm = row32_sum((unsigned)__builtin_popcount(al0 & k0) + (unsigned)__builtin_popcount(al1 & k1));
        const unsigned rem = need - cm;
        const bool mine = m < 64u && (((m < 32u ? al0 >> m : al1 >> (m - 32u)) & 1u) != 0u);
        const unsigned long long eq = __ballot(mine); const unsigned eqr = half ? (unsigned)(eq >> 32) : (unsigned)eq;
        const bool tk = mine && (unsigned)__builtin_popcount(eqr & ((1u << l32) - 1u)) < rem;
        al0 = (al0 & k0) | ((tk && m < 32u) ? (1u << m) : 0u); al1 = (al1 & k1) | ((tk && m >= 32u) ? (1u << (m - 32u)) : 0u);
    }
#ifdef ASM_MARK
    asm volatile("; SEL_TIE_END");
#endif
    LAS unsigned* rec = mp + (16 * rq + ql) * MP_STRIDE + l32;
    rec[0] = gt0 | al0; rec[MP_PLANE] = gt1 | al1;
}
constexpr int AT_K = 0, AT_V = 32768, AT_BT = 65536, AT_WS = 73728, AT_OST = 0, AT_Q = 75776;
static_assert(AT_Q + 65536 <= P2_MASK && AT_OST + 8 * 4608 <= AT_BT, "attention LDS map");
__device__ __forceinline__ bf16x8 pk16(const f32x16& v, int o) { return __builtin_bit_cast(bf16x8, (v4u){pkbf(v[o], v[o + 1]), pkbf(v[o + 2], v[o + 3]), pkbf(v[o + 4], v[o + 5]), pkbf(v[o + 6], v[o + 7])}); }
__device__ __forceinline__ void glds16(const void* gsrc, unsigned lds_dst) {
    unsigned keep;
    asm volatile("s_mov_b32 %0, m0\n\ts_mov_b32 m0, %2\n\ts_nop 0\n\tglobal_load_lds_dwordx4 %1, off\n\ts_mov_b32 m0, %0" : "=&s"(keep) : "v"(gsrc), "s"(lds_dst) : "memory");
}
__device__ __forceinline__ unsigned lds_addr(const LAS unsigned char* p) { return (unsigned)(uintptr_t)p; }
template <bool MASK, bool NEAR>
__device__ __forceinline__ void attn_soft(f32x16& p0, f32x16& p1, f32x2v& lacc, bf16x8 (&pa)[4], const LAS unsigned* mrec, int sbit) {
#pragma unroll
    for (int i = 0; i < 16; ++i) { p0[i] = __builtin_amdgcn_exp2f(p0[i]); p1[i] = __builtin_amdgcn_exp2f(p1[i]); }
    if (MASK) {
#pragma unroll
        for (int g = 0; g < 4; ++g) {
            const v4u w4 = *(const LAS v4u*)(mrec + 8 * g);
#pragma unroll
            for (int k = 0; k < 4; ++k) { int m0_, m1_; asm("v_bfe_i32 %0, %1, %2, 1" : "=v"(m0_) : "v"(w4[k]), "s"(sbit)); asm("v_bfe_i32 %0, %1, %2, 1" : "=v"(m1_) : "v"(w4[k]), "s"(sbit + 1));
                p0[4 * g + k] = __uint_as_float(__float_as_uint(p0[4 * g + k]) & (unsigned)m0_); p1[4 * g + k] = __uint_as_float(__float_as_uint(p1[4 * g + k]) & (unsigned)m1_); }
        }
    }
#pragma unroll
    for (int i = 0; i < 16; i += 2) { lacc += (f32x2v){p0[i], p0[i + 1]}; lacc += (f32x2v){p1[i], p1[i + 1]}; }
    pa[0] = pk16(p0, 0); pa[1] = pk16(p0, 8); pa[2] = pk16(p1, 0); pa[3] = pk16(p1, 8);
}
__device__ __forceinline__ void attn_pv(f32x16& o0, f32x16& o1, const bf16x8 (&pa)[4], const LAS unsigned char* Vb) {
#pragma unroll
    for (int ks = 0; ks < 4; ++ks) {
        o0 = __builtin_amdgcn_mfma_f32_32x32x16_bf16(pa[ks], cat8(vtr(Vb + ks * 1024), vtr(Vb + ks * 1024 + 512)), o0, 0, 0, 0);
        o1 = __builtin_amdgcn_mfma_f32_32x32x16_bf16(pa[ks], cat8(vtr(Vb + 4096 + ks * 1024), vtr(Vb + 4096 + ks * 1024 + 512)), o1, 0, 0, 0);
    }
}
template <bool NEAR>
__device__ __forceinline__ void attn_qk(f32x16& a0, f32x16& a1, f32x16& b0, f32x16& b1, const LAS unsigned char* Qb, const LAS unsigned char* Kb, const LAS float* bt) {
#pragma unroll
    for (int i = 0; i < 16; ++i) {
        if (NEAR) { a0[i] = bt[(i & 3) + 8 * (i >> 2)]; a1[i] = bt[32 + (i & 3) + 8 * (i >> 2)]; b0[i] = bt[(i & 3) + 8 * (i >> 2) - 32]; b1[i] = bt[(i & 3) + 8 * (i >> 2)]; }
        else { a0[i] = 0.f; a1[i] = 0.f; b0[i] = 0.f; b1[i] = 0.f; }
    }
#pragma unroll
    for (int d0 = 0; d0 < 4; ++d0) {
        const bf16x8 k0 = *(const LAS bf16x8*)(Kb + d0 * 2048), k1 = *(const LAS bf16x8*)(Kb + d0 * 2048 + 512);
        const bf16x8 qfa = *(const LAS bf16x8*)(Qb + d0 * 1024), qfb = *(const LAS bf16x8*)(Qb + 4096 + d0 * 1024);
        a0 = __builtin_amdgcn_mfma_f32_32x32x16_bf16(k0, qfa, a0, 0, 0, 0); a1 = __builtin_amdgcn_mfma_f32_32x32x16_bf16(k1, qfa, a1, 0, 0, 0);
        b0 = __builtin_amdgcn_mfma_f32_32x32x16_bf16(k0, qfb, b0, 0, 0, 0); b1 = __builtin_amdgcn_mfma_f32_32x32x16_bf16(k1, qfb, b1, 0, 0, 0);
    }
}
__device__ __forceinline__ void attn_store(const f32x16& o0, const f32x16& o1, f32x2v lacc, bf16* obase, LAS unsigned char* stg, LAS float* wsf, int lane) {
    const int r = lane & 31, hi = lane >> 5;
    float lsum = lacc[0] + lacc[1];
    lsum += __shfl_xor(lsum, 32);
    if (hi == 0) wsf[r] = lsum;
    LDS_WAIT(); asm volatile("" ::: "memory");
    LAS unsigned short* st = (LAS unsigned short*)stg;
#pragma unroll
    for (int i = 0; i < 16; ++i) {
        const int q = crow(i, hi); const float rl = 1.0f / wsf[q];
        st[q * 72 + r] = (unsigned short)(pkbf(o0[i] * rl, 0.f) & 0xffffu); st[q * 72 + 32 + r] = (unsigned short)(pkbf(o1[i] * rl, 0.f) & 0xffffu);
    }
    LDS_WAIT(); asm volatile("" ::: "memory");
#pragma unroll
    for (int k = 0; k < 4; ++k) { const int row = 8 * k + (lane >> 3), ch = lane & 7;
        const v4u v = *(const LAS v4u*)(stg + row * 144 + ch * 16); *(v4u*)(obase + (size_t)row * DM + ch * 8) = v; }
    LDS_WAIT(); asm volatile("" ::: "memory");
}
template <bool MASK>
__device__ __forceinline__ void attn_chunk(const Frame& F, int b, int c, LAS unsigned char* lds) {
    const int wid = F.wave, lane = F.lane, r = lane & 31, hi = lane >> 5;
    const size_t rowbase = (size_t)b * SEQ; const int q0 = 64 * c, nt = c + 1;
    const LAS unsigned char* Qb = lds + AT_Q + wid * 8192 + lane * 16;
#pragma unroll
    for (int d0 = 0; d0 < 4; ++d0) {
        *(LAS bf16x8*)(lds + AT_Q + wid * 8192 + d0 * 1024 + lane * 16) = *(const bf16x8*)(F.QA() + (rowbase + q0 + r) * 512 + wid * 64 + 16 * d0 + 8 * hi);
        *(LAS bf16x8*)(lds + AT_Q + wid * 8192 + 4096 + d0 * 1024 + lane * 16) = *(const bf16x8*)(F.QA() + (rowbase + q0 + 32 + r) * 512 + wid * 64 + 16 * d0 + 8 * hi); }
    const LAS float* BT = (const LAS float*)(lds + AT_BT) + wid * 256;
    const bf16* ksrc = F.KA() + (rowbase + lane) * 64 + 8 * wid;
    const bf16* vsrc = F.VA() + (rowbase + 16 * (wid & 3) + (lane >> 2)) * 64 + (wid >> 2) * 32 + (lane & 3) * 8;
    const LAS unsigned* mreca = (const LAS unsigned*)(lds + P2_MASK) + r * MP_STRIDE + 4 * hi; const LAS unsigned* mrecb = mreca + 32 * MP_STRIDE;
    const int voff = ((lane >> 4) & 1) * 32 + (lane & 3) * 8 + (4 * hi + ((lane & 15) >> 2)) * 64;
    f32x16 oa0, oa1, ob0, ob1; f32x2v la = {0.f, 0.f}, lb = {0.f, 0.f};
#pragma unroll
    for (int i = 0; i < 16; ++i) { oa0[i] = 0.f; oa1[i] = 0.f; ob0[i] = 0.f; ob1[i] = 0.f; }
#define AT_BAR() do { __builtin_amdgcn_sched_barrier(0); asm volatile("s_waitcnt lgkmcnt(0)" ::: "memory"); __builtin_amdgcn_s_barrier(); asm volatile("" ::: "memory"); __builtin_amdgcn_sched_barrier(0); } while (0)
#define AT_DMA(t_, slot_) do { const int tn_ = (t_) < nt ? (t_) : nt - 1;     \
        glds16(ksrc + (size_t)tn_ * 64 * 64, (unsigned)__builtin_amdgcn_readfirstlane((int)lds_addr(lds + AT_K + (slot_) * 8192 + wid * 1024))); \
        glds16(vsrc + (size_t)tn_ * 64 * 64, (unsigned)__builtin_amdgcn_readfirstlane((int)lds_addr(lds + AT_V + (slot_) * 8192 + wid * 1024))); } while (0)
    AT_DMA(0, 0); AT_DMA(1, 1); AT_DMA(2, 2);
    asm volatile("s_waitcnt vmcnt(0)" ::: "memory");
    AT_BAR();
    if (wid >= 4) AT_BAR();
    const int nfar = c >= 2 ? c - 2 : 0;
#if defined(PROBE_TIMER) && PROBE_TIMER == 3
    const unsigned long long pa0_ = __builtin_amdgcn_s_memtime();
#endif
    f32x16 a0, a1, b0, b1; bf16x8 pa[4], pb[4];
#if defined(PROBE_TIMER) && PROBE_TIMER >= 4
    unsigned psum_ = 0u;
#endif
    {
        const LAS unsigned char* Kb = lds + AT_K + hi * 1024 + r * 16; const LAS float* bt = BT + (64 * (0 - c) + 191 - r + 4 * hi);
        if (0 < nfar) attn_qk<false>(a0, a1, b0, b1, Qb, Kb, bt); else attn_qk<true>(a0, a1, b0, b1, Qb, Kb, bt);
        AT_BAR();
    }
#pragma unroll 1
    for (int t = 0; t < nt; ++t) {
        const int pl_ = (t >> 4) * MP_PLANE, sbit = (2 * t) & 31;
#ifdef NOSOFT
        { const bf16x8 c_ = {0x3c00, 0x3c00, 0x3c00, 0x3c00, 0x3c00, 0x3c00, 0x3c00, 0x3c00}; pa[0] = c_; pa[1] = c_; pa[2] = c_; pa[3] = c_; pb[0] = c_; pb[1] = c_; pb[2] = c_; pb[3] = c_; la += (f32x2v){a0[0], b0[0]}; }
#else
#if defined(PROBE_TIMER) && PROBE_TIMER == 4
        __builtin_amdgcn_sched_barrier(0); const unsigned long long pv0_ = __builtin_amdgcn_s_memtime(); __builtin_amdgcn_sched_barrier(0);
#endif
        attn_soft<MASK, false>(a0, a1, la, pa, mreca + pl_, sbit);
        attn_soft<MASK, false>(b0, b1, lb, pb, mrecb + pl_, sbit);
#if defined(PROBE_TIMER) && PROBE_TIMER == 4
        __builtin_amdgcn_sched_barrier(0); asm volatile("s_nop 0" : : "v"(pa[0]), "v"(pa[1]), "v"(pa[2]), "v"(pa[3]), "v"(pb[0]), "v"(pb[1]), "v"(pb[2]), "v"(pb[3]), "v"(la), "v"(lb)); psum_ += (unsigned)(__builtin_amdgcn_s_memtime() - pv0_); __builtin_amdgcn_sched_barrier(0);
#endif
#endif
#if defined(PROBE_TIMER) && PROBE_TIMER == 6
        __builtin_amdgcn_sched_barrier(0); asm volatile("s_nop 0" : : "v"(pa[0]), "v"(pa[3]), "v"(pb[0]), "v"(pb[3]), "v"(la), "v"(lb)); const unsigned long long pw0_ = __builtin_amdgcn_s_memtime();
#endif
        AT_BAR();
#if defined(PROBE_TIMER) && PROBE_TIMER == 6
        psum_ += (unsigned)(__builtin_amdgcn_s_memtime() - pw0_);
#endif
#if defined(PROBE_TIMER) && PROBE_TIMER == 5
        const unsigned long long pm0_ = __builtin_amdgcn_s_memtime();
#endif
        AT_DMA(t + 3, (t + 3) & 3);
        const LAS unsigned char* Vb = lds + AT_V + (t & 3) * 8192 + voff;
#pragma unroll
        for (int ks = 0; ks < 4; ++ks) {
            const bf16x8 v0 = cat8(vtr(Vb + ks * 1024), vtr(Vb + ks * 1024 + 512)), v1 = cat8(vtr(Vb + 4096 + ks * 1024), vtr(Vb + 4096 + ks * 1024 + 512));
            oa0 = __builtin_amdgcn_mfma_f32_32x32x16_bf16(pa[ks], v0, oa0, 0, 0, 0); ob0 = __builtin_amdgcn_mfma_f32_32x32x16_bf16(pb[ks], v0, ob0, 0, 0, 0);
            oa1 = __builtin_amdgcn_mfma_f32_32x32x16_bf16(pa[ks], v1, oa1, 0, 0, 0); ob1 = __builtin_amdgcn_mfma_f32_32x32x16_bf16(pb[ks], v1, ob1, 0, 0, 0);
        }
        if (t + 1 < nt) {
            const LAS unsigned char* Kb = lds + AT_K + ((t + 1) & 3) * 8192 + hi * 1024 + r * 16; const LAS float* bt = BT + (64 * (t + 1 - c) + 191 - r + 4 * hi);
            if (t + 1 < nfar) attn_qk<false>(a0, a1, b0, b1, Qb, Kb, bt); else attn_qk<true>(a0, a1, b0, b1, Qb, Kb, bt);
        }
#if defined(PROBE_TIMER) && PROBE_TIMER == 5
        asm volatile("s_nop 15\n\ts_nop 15" : : "v"(oa0), "v"(ob1), "v"(a0), "v"(b1)); psum_ += (unsigned)(__builtin_amdgcn_s_memtime() - pm0_);
#endif
#if defined(PROBE_TIMER) && PROBE_TIMER == 7
        __builtin_amdgcn_sched_barrier(0); asm volatile("s_nop 15\n\ts_nop 15" : : "v"(oa0), "v"(ob1), "v"(a0), "v"(b1)); const unsigned long long px0_ = __builtin_amdgcn_s_memtime();
#endif
        asm volatile("s_waitcnt vmcnt(2)" ::: "memory");
        AT_BAR();
#if defined(PROBE_TIMER) && PROBE_TIMER == 7
        psum_ += (unsigned)(__builtin_amdgcn_s_memtime() - px0_);
#endif
    }
#if defined(PROBE_TIMER) && PROBE_TIMER >= 4
    if (F.tid == 0 && nt >= 16) { volatile LAS unsigned* pm_ = (volatile LAS unsigned*)(lds + MISC_OFF); pm_[16] += psum_; pm_[17] += (unsigned)nt; }
#endif
#if defined(PROBE_TIMER) && PROBE_TIMER == 3
    if (F.tid == 0 && nt >= 16) { volatile LAS unsigned* pm_ = (volatile LAS unsigned*)(lds + MISC_OFF); pm_[16] += (unsigned)(__builtin_amdgcn_s_memtime() - pa0_); pm_[17] += (unsigned)nt; }
#endif
    asm volatile("s_waitcnt vmcnt(0)" ::: "memory");
    if (wid < 4) AT_BAR();
    AT_BAR();
#undef AT_BAR
#undef AT_DMA
    LAS float* wsf = (LAS float*)(lds + AT_WS) + wid * 64; LAS unsigned char* stg = lds + AT_OST + wid * 4608;
    attn_store(oa0, oa1, la, F.MIX() + (rowbase + q0) * DM + wid * 64, stg, wsf, lane);
    attn_store(ob0, ob1, lb, F.MIX() + (rowbase + q0 + 32) * DM + wid * 64, stg, wsf, lane);
}
__device__ __forceinline__ void attn_unit(const Frame& F, int b, int c, LAS unsigned char* lds) {
    if (c >= 4) {
        const int nj = c + 1;
        IdxOps ops; idx_fetch(ops, F, b, c, 0);
#if defined(PROBE_TIMER) && PROBE_TIMER >= 10
        unsigned ps_ = 0u;
#define PT0_(k) unsigned long long pt_##k = 0; if (PROBE_TIMER == (k)) { __builtin_amdgcn_sched_barrier(0); pt_##k = __builtin_amdgcn_s_memtime(); __builtin_amdgcn_sched_barrier(0); }
#define PT1_(k) if (PROBE_TIMER == (k)) { __builtin_amdgcn_sched_barrier(0); ps_ += (unsigned)(__builtin_amdgcn_s_memtime() - pt_##k); __builtin_amdgcn_sched_barrier(0); }
#else
#define PT0_(k)
#define PT1_(k)
#endif
        for (int rq = 0; rq < ((MIXREP & 2) ? 8 : 4); ++rq) {
            PT0_(10)
            idx_round(ops, F, b, c, lds);
            idx_fetch(ops, F, b, c, (rq + 1) & 3);
            asm volatile("s_waitcnt lgkmcnt(0)" ::: "memory");
            PT1_(10)
            PT0_(11)
            __syncthreads();
            PT1_(11)
            PT0_(12)
            select_rows32((const LAS float*)(lds + P2_SC), (LAS unsigned*)(lds + P2_MASK), rq & 3, nj, F.wave, F.lane);
            asm volatile("s_waitcnt lgkmcnt(0)" ::: "memory");
            PT1_(12)
            PT0_(13)
            __syncthreads();
            PT1_(13)
        }
#if defined(PROBE_TIMER) && PROBE_TIMER >= 10
        if (F.tid == 0 && c >= 15) { volatile LAS unsigned* pm_ = (volatile LAS unsigned*)(lds + MISC_OFF); pm_[16] += ps_; pm_[17] += 4u; }
#endif
#undef PT0_
#undef PT1_
    }
    { const f32x4 v = *(const f32x4*)(F.BT() + F.tid * 4); *(LAS f32x4*)(lds + AT_BT + F.tid * 16) = v; }
    __syncthreads();
    if (c >= 4) attn_chunk<true>(F, b, c, lds); else attn_chunk<false>(F, b, c, lds);
}

constexpr int RT_TAB = 131072;
__device__ __forceinline__ void ret_stage(const bf16* vsrc, const bf16* ksrc, LAS unsigned char* region) {
#pragma unroll
    for (int k = 0; k < 8; ++k) {
        const size_t o = (size_t)(16 * (k & 3)) * 512 + 32 * (k >> 2);
        __builtin_amdgcn_global_load_lds((const unsigned*)(vsrc + o), (LAS unsigned*)(region + k * 1024), 16, 0, 0);
        __builtin_amdgcn_global_load_lds((const unsigned*)(ksrc + o), (LAS unsigned*)(region + 8192 + k * 1024), 16, 0, 0);
    }
}
__device__ __forceinline__ void ret_kv(f32x16 (&T)[2][2], const LAS unsigned char* img) {
#pragma unroll
    for (int ks = 0; ks < 4; ++ks) {
        const bf16x8 k0 = cat8(vtr(img + 8192 + ks * 1024), vtr(img + 8192 + ks * 1024 + 512)), k1 = cat8(vtr(img + 8192 + 4096 + ks * 1024), vtr(img + 8192 + 4096 + ks * 1024 + 512));
        const bf16x8 v0 = cat8(vtr(img + ks * 1024), vtr(img + ks * 1024 + 512)), v1 = cat8(vtr(img + 4096 + ks * 1024), vtr(img + 4096 + ks * 1024 + 512));
        T[0][0] = __builtin_amdgcn_mfma_f32_32x32x16_bf16(k0, v0, T[0][0], 0, 0, 0); T[0][1] = __builtin_amdgcn_mfma_f32_32x32x16_bf16(k0, v1, T[0][1], 0, 0, 0);
        T[1][0] = __builtin_amdgcn_mfma_f32_32x32x16_bf16(k1, v0, T[1][0], 0, 0, 0); T[1][1] = __builtin_amdgcn_mfma_f32_32x32x16_bf16(k1, v1, T[1][1], 0, 0, 0);
    }
}
__device__ __forceinline__ void ret_unit(const Frame& F, int b, int h, LAS unsigned char* lds) {
    const int lane = F.lane, w = F.wave, r = lane & 31, hi = lane >> 5;
    const float gam = 1.0f - exp2f(-5.0f - (float)h), lg2 = log2f(gam), cd = exp2f(64.0f * lg2), cd4 = exp2f(256.0f * lg2);
    LAS unsigned char* region = lds + w * 16384;
    const LAS unsigned char* img = region + ((lane >> 4) & 1) * 32 + (lane & 3) * 8 + (4 * hi + ((lane & 15) >> 2)) * 64;
    LAS float* tab = (LAS float*)(lds + RT_TAB);
    __syncthreads();
    if (F.tid < 128) tab[F.tid] = F.tid < 64 ? F.ret_gn_w()[h * 64 + F.tid] : F.ret_gn_b()[h * 64 + F.tid - 64];
    const size_t hbase = (size_t)b * SEQ * 512 + h * 64;
    const size_t stg = hbase + (size_t)(lane >> 2) * 512 + (lane & 3) * 8;
    f32x16 T[2][2];
#pragma unroll
    for (int i = 0; i < 16; ++i) { T[0][0][i] = 0.f; T[0][1][i] = 0.f; T[1][0][i] = 0.f; T[1][1][i] = 0.f; }
#pragma unroll 1
    for (int i = 0; i < 4; ++i) {
        const size_t co = (size_t)(4 * w + i) * 64 * 512;
        ret_stage(F.VB() + stg + co, F.KB() + stg + co, region);
        if (i) {
#pragma unroll
            for (int k = 0; k < 16; ++k) { T[0][0][k] *= cd; T[0][1][k] *= cd; T[1][0][k] *= cd; T[1][1][k] *= cd; }
        }
        asm volatile("s_waitcnt vmcnt(0)" ::: "memory");
        ret_kv(T, img);
        LDS_WAIT();
    }
#pragma unroll
    for (int eb = 0; eb < 2; ++eb)
#pragma unroll
        for (int db = 0; db < 2; ++db)
#pragma unroll
            for (int g = 0; g < 4; ++g) *(LAS f32x4*)(region + ((eb * 2 + db) * 4 + g) * 1024 + lane * 16) = (f32x4){T[eb][db][4 * g], T[eb][db][4 * g + 1], T[eb][db][4 * g + 2], T[eb][db][4 * g + 3]};
    __syncthreads();
#pragma unroll
    for (int i = 0; i < 16; ++i) { T[0][0][i] = 0.f; T[0][1][i] = 0.f; T[1][0][i] = 0.f; T[1][1][i] = 0.f; }
#pragma unroll 1
    for (int wp = 0; wp < w; ++wp) {
        const LAS unsigned char* src = lds + wp * 16384 + lane * 16;
#pragma unroll
        for (int eb = 0; eb < 2; ++eb)
#pragma unroll
            for (int db = 0; db < 2; ++db)
#pragma unroll
                for (int g = 0; g < 4; ++g) { const f32x4 v = *(const LAS f32x4*)(src + ((eb * 2 + db) * 4 + g) * 1024);
                    T[eb][db][4 * g] = T[eb][db][4 * g] * cd4 + v[0]; T[eb][db][4 * g + 1] = T[eb][db][4 * g + 1] * cd4 + v[1]; T[eb][db][4 * g + 2] = T[eb][db][4 * g + 2] * cd4 + v[2]; T[eb][db][4 * g + 3] = T[eb][db][4 * g + 3] * cd4 + v[3]; }
    }
    __syncthreads();
#pragma unroll 1
    for (int i = 0; i < 4; ++i) {
        const int n = 4 * w + i; const size_t co = (size_t)n * 64 * 512;
        ret_stage(F.VB() + stg + co, F.KB() + stg + co, region);
#pragma unroll
        for (int k = 0; k < 16; ++k) { T[0][0][k] *= cd; T[0][1][k] *= cd; T[1][0][k] *= cd; T[1][1][k] *= cd; }
        const bf16* qrow = F.QB() + hbase + co + (size_t)r * 512 + 8 * hi;
        const bf16* krow = F.KB() + hbase + co + (size_t)r * 512 + 8 * hi;
#pragma unroll 1
        for (int ib = 0; ib < 2; ++ib) {
            bf16x8 qf[4], kf[4];
#pragma unroll
            for (int s = 0; s < 4; ++s) { qf[s] = *(const bf16x8*)(qrow + (size_t)(32 * ib) * 512 + 16 * s); kf[s] = *(const bf16x8*)(krow + 16 * s); }
            const size_t tok = (size_t)b * SEQ + 64 * n + 32 * ib + r;
            const bf16* grow = F.GB() + tok * 512 + h * 64 + 4 * hi;
            v2u gq[2][4];
#pragma unroll
            for (int db = 0; db < 2; ++db)
#pragma unroll
                for (int g = 0; g < 4; ++g) gq[db][g] = *(const v2u*)(grow + 32 * db + 8 * g);
            f32x16 s0, s1;
#pragma unroll
            for (int k = 0; k < 16; ++k) { s0[k] = 0.f; s1[k] = 0.f; }
#pragma unroll
            for (int s = 0; s < 4; ++s) s0 = __builtin_amdgcn_mfma_f32_32x32x16_bf16(kf[s], qf[s], s0, 0, 0, 0);
            if (ib == 1) {
#pragma unroll
                for (int s = 0; s < 4; ++s) kf[s] = *(const bf16x8*)(krow + (size_t)32 * 512 + 16 * s);
#pragma unroll
                for (int s = 0; s < 4; ++s) s1 = __builtin_amdgcn_mfma_f32_32x32x16_bf16(kf[s], qf[s], s1, 0, 0, 0);
#pragma unroll
                for (int k = 0; k < 16; ++k) s1[k] = (r >= crow(k, hi)) ? s1[k] : 0.f;
            } else {
#pragma unroll
                for (int k = 0; k < 16; ++k) s0[k] = (r >= crow(k, hi)) ? s0[k] : 0.f;
            }
#pragma unroll
            for (int s = 0; s < 4; ++s) {
                v4u q4 = __builtin_bit_cast(v4u, qf[s]);
                auto x0 = __builtin_amdgcn_permlane32_swap(q4[0], q4[2], false, false); auto x1 = __builtin_amdgcn_permlane32_swap(q4[1], q4[3], false, false);
                q4[0] = x0[0]; q4[2] = x0[1]; q4[1] = x1[0]; q4[3] = x1[1];
                qf[s] = __builtin_bit_cast(bf16x8, q4);
            }
            asm volatile("s_waitcnt vmcnt(0)" ::: "memory");
            f32x16 y0, y1;
#pragma unroll
            for (int k = 0; k < 16; ++k) { y0[k] = 0.f; y1[k] = 0.f; }
#pragma unroll
            for (int eb = 0; eb < 2; ++eb)
#pragma unroll
                for (int s2 = 0; s2 < 2; ++s2) {
                    y0 = __builtin_amdgcn_mfma_f32_32x32x16_bf16(pk16(T[eb][0], 8 * s2), qf[2 * eb + s2], y0, 0, 0, 0);
                    y1 = __builtin_amdgcn_mfma_f32_32x32x16_bf16(pk16(T[eb][1], 8 * s2), qf[2 * eb + s2], y1, 0, 0, 0);
                }
#pragma unroll
            for (int ks = 0; ks < 2; ++ks) {
                const bf16x8 pb = pk16(s0, 8 * ks);
                y0 = __builtin_amdgcn_mfma_f32_32x32x16_bf16(cat8(vtr(img + ks * 1024), vtr(img + ks * 1024 + 512)), pb, y0, 0, 0, 0);
                y1 = __builtin_amdgcn_mfma_f32_32x32x16_bf16(cat8(vtr(img + 4096 + ks * 1024), vtr(img + 4096 + ks * 1024 + 512)), pb, y1, 0, 0, 0);
            }
            if (ib == 1) {
#pragma unroll
                for (int ks = 0; ks < 2; ++ks) {
                    const bf16x8 pb = pk16(s1, 8 * ks);
                    y0 = __builtin_amdgcn_mfma_f32_32x32x16_bf16(cat8(vtr(img + (2 + ks) * 1024), vtr(img + (2 + ks) * 1024 + 512)), pb, y0, 0, 0, 0);
                    y1 = __builtin_amdgcn_mfma_f32_32x32x16_bf16(cat8(vtr(img + 4096 + (2 + ks) * 1024), vtr(img + 4096 + (2 + ks) * 1024 + 512)), pb, y1, 0, 0, 0);
                }
            }
            float sm = 0.f;
#pragma unroll
            for (int k = 0; k < 16; ++k) sm += y0[k] + y1[k];
            sm += __shfl_xor(sm, 32);
            const float mean = sm * (1.0f / 64.0f); float vr = 0.f;
#pragma unroll
            for (int k = 0; k < 16; ++k) { y0[k] -= mean; y1[k] -= mean; vr += y0[k] * y0[k] + y1[k] * y1[k]; }
            vr += __shfl_xor(vr, 32);
            const float rstd = 1.0f / sqrtf(vr * (1.0f / 64.0f) + 1e-5f);
            bf16* orow = F.MIX() + tok * DM + 512 + h * 64 + 4 * hi;
#pragma unroll
            for (int g = 0; g < 4; ++g) {
                const f32x4 w0 = *(const LAS f32x4*)(tab + 8 * g + 4 * hi), b0 = *(const LAS f32x4*)(tab + 64 + 8 * g + 4 * hi), w1 = *(const LAS f32x4*)(tab + 32 + 8 * g + 4 * hi), b1 = *(const LAS f32x4*)(tab + 96 + 8 * g + 4 * hi);
                const v2u g0 = gq[0][g], g1 = gq[1][g];
                *(v2u*)(orow + 8 * g) = (v2u){pkbf((y0[4 * g] * rstd * w0[0] + b0[0]) * bflo(g0[0]), (y0[4 * g + 1] * rstd * w0[1] + b0[1]) * bfhi(g0[0])),
                                              pkbf((y0[4 * g + 2] * rstd * w0[2] + b0[2]) * bflo(g0[1]), (y0[4 * g + 3] * rstd * w0[3] + b0[3]) * bfhi(g0[1]))};
                *(v2u*)(orow + 32 + 8 * g) = (v2u){pkbf((y1[4 * g] * rstd * w1[0] + b1[0]) * bflo(g1[0]), (y1[4 * g + 1] * rstd * w1[1] + b1[1]) * bfhi(g1[0])),
                                                   pkbf((y1[4 * g + 2] * rstd * w1[2] + b1[2]) * bflo(g1[1]), (y1[4 * g + 3] * rstd * w1[3] + b1[3]) * bfhi(g1[1]))};
            }
        }
        ret_kv(T, img);
        LDS_WAIT();
    }
}
#ifndef GEMM_ALIGN
#define GEMM_ALIGN true
#endif
#ifndef GEMM_SP2
#define GEMM_SP2 true
#endif
#ifndef RETREP
#define RETREP 1
#endif
#ifndef ATTREP
#define ATTREP 1
#endif
constexpr int CW_Q = 12288;
constexpr int NG_ATT = 32, NG_RET = 8, NG_MIX = NG_ATT + NG_RET;
__device__ __forceinline__ void p2_mixers(Frame& F) {
    for (;;) {
        int mo_ = MISC_OFF; asm volatile("" : "+s"(mo_));
        volatile LAS unsigned* misc = (volatile LAS unsigned*)(F.lds + mo_);
        __syncthreads();
        if (F.tid == 0) misc[0] = __hip_atomic_fetch_add(F.ctl + CW_Q + 64 * F.grp, 1u, __ATOMIC_RELAXED, __HIP_MEMORY_SCOPE_AGENT);
        __syncthreads();
        const int u = (int)misc[0];
        if (u >= NG_MIX) break;
        { int w_ = F.wave; asm volatile("" : "+s"(w_)); F.wave = w_; int l_ = lane_id(); asm volatile("" : "+v"(l_)); F.lane = l_; F.tid = w_ * 64 + l_; }
        static constexpr unsigned char ORDER[NG_MIX] = {24, 30, 23, 26, 25, 35, 32, 20, 34, 21, 33, 22, 16, 28, 38, 29, 18, 36, 14, 39, 27, 4, 13, 19, 37, 8, 31, 6, 5, 17, 15, 11, 12, 10, 9, 7, 3, 2, 1, 0};
        const int e = __builtin_amdgcn_readfirstlane((int)ORDER[u]);
        if (e < 32) attn_unit(F, F.grp, e, F.lds); else ret_unit(F, F.grp, e - 32, F.lds);
    }
#if defined(PROBE_TIMER) && PROBE_TIMER >= 3
    if (blockIdx.x == 7 && F.tid == 0) { volatile LAS unsigned* pm_ = (volatile LAS unsigned*)(F.lds + MISC_OFF); const float val = ((float)pm_[16] / (float)(pm_[17] ? pm_[17] : 1u)) / 8000.0f;
        F.ctl[64] = __float_as_uint(0.05f + 0.5f * floorf(fminf(fmaxf(val, 0.f), 1.f) * 8.0f + 0.5f) * 0.125f); }
#endif
}

typedef __attribute__((address_space(1))) unsigned gu32;
#define XB_TMO      128
#define XB_XCNT(j)  (256  + 64 * (j))
#define XB_XSUB(j)  (1280 + 64 * (j))
#define XB_XGEN(j)  (2304 + 64 * (j))
#define XB_TOP      3328
#define XB_TOPGEN   3392
#define XCD_BAR_WORDS 3456
#define XB_SPIN_CAP (1u << 18)

__device__ __forceinline__ unsigned xb_ld(unsigned* p)              { return __hip_atomic_load(p, __ATOMIC_RELAXED, __HIP_MEMORY_SCOPE_AGENT); }
__device__ __forceinline__ unsigned xb_add(unsigned* p, unsigned v) { return __hip_atomic_fetch_add(p, v, __ATOMIC_RELAXED, __HIP_MEMORY_SCOPE_AGENT); }
__device__ __forceinline__ unsigned xb_xcc_id() { return (unsigned)__builtin_amdgcn_s_getreg((3 << 11) | 20) & 0xFu; }
#define XB_SPIN(cond, bar) do { unsigned _sp = 0; while (cond) { __builtin_amdgcn_s_sleep(1); \
    if ((++_sp & 255u) == 0u) { if (xb_ld(&(bar)[XB_TMO])) break; if (_sp > XB_SPIN_CAP) { atomicAdd(&(bar)[XB_TMO], 1u); break; } } } } while (0)

struct XcdBarrier {
    unsigned* bar; unsigned x; int wv;
    volatile LAS unsigned* st;
};

__device__ __forceinline__ XcdBarrier xcd_barrier_post(unsigned* bar, volatile LAS unsigned* st, int wv_) {
    XcdBarrier b; b.bar = bar; b.x = xb_xcc_id(); b.st = st; b.wv = 0;
    if (wv_ == 0 && lane_id() == 0) { st[2] = xb_add(&bar[XB_XCNT(b.x)], 1u); st[3] = b.x; }
    return b;
}
__device__ __forceinline__ void xcd_barrier_complete(unsigned* bar, unsigned x, unsigned& nloc, unsigned& nx, unsigned& even) {
    const unsigned G = gridDim.x * gridDim.y * gridDim.z;
    unsigned sum, cnt, mine, sp = 0u, ev;
    for (;;) {
        sum = 0u; cnt = 0u; mine = 0u; ev = 1u;
#pragma unroll
        for (unsigned j = 0; j < 16; ++j) { const unsigned c = xb_ld(&bar[XB_XCNT(j)]); sum += c; cnt += (c > 0u) ? 1u : 0u; mine = (j == x) ? c : mine; ev &= (c == (j < 8u ? 32u : 0u)) ? 1u : 0u; }
        even = ev;
        if (sum == G) break;
        __builtin_amdgcn_s_sleep(1);
        if ((++sp & 255u) == 0u) { if (xb_ld(&bar[XB_TMO])) break; if (sp > XB_SPIN_CAP) { atomicAdd(&bar[XB_TMO], 1u); break; } }
    }
    nloc = mine > 0u ? mine : 1u; nx = cnt > 0u ? cnt : 1u;
}

__device__ __forceinline__ void xcd_barrier(const XcdBarrier& b) {
    asm volatile("s_waitcnt vmcnt(0)" ::: "memory");
    __syncthreads();
    if (b.wv == 0 && lane_id() == 0) {
        unsigned* bar = b.bar;
        __builtin_amdgcn_s_waitcnt(0);
        unsigned nloc = b.st[0], nx = b.st[1];
        if (nloc == 0u) { unsigned ev_; xcd_barrier_complete(bar, b.x, nloc, nx, ev_); b.st[0] = nloc; b.st[1] = nx; b.st[4] = ev_; }
        const unsigned old = xb_add(&bar[XB_XSUB(b.x)], 1u);
        const unsigned gen = old / nloc;
        if (old + 1u == (gen + 1u) * nloc) {
            __builtin_amdgcn_fence(__ATOMIC_RELEASE, "agent");
            asm volatile("s_waitcnt vmcnt(0)" ::: "memory");
            const unsigned og = xb_add(&bar[XB_TOP], 1u);
            const unsigned tg = og / nx;
            if (og + 1u == (tg + 1u) * nx) xb_add(&bar[XB_TOPGEN], 1u);
            else XB_SPIN(xb_ld(&bar[XB_TOPGEN]) == tg, bar);
            __builtin_amdgcn_fence(__ATOMIC_ACQUIRE, "agent");
            xb_add(&bar[XB_XGEN(b.x)], 1u);
            asm volatile("s_waitcnt vmcnt(0)" ::: "memory");
        } else {
            XB_SPIN(xb_ld(&bar[XB_XGEN(b.x)]) == gen, bar);
            __builtin_amdgcn_fence(__ATOMIC_ACQUIRE, "agent");
            asm volatile("s_waitcnt vmcnt(0)" ::: "memory");
        }
    }
    __syncthreads();
}

constexpr int CW_GB = 8192;
__device__ __forceinline__ void grp_barrier(unsigned* ctl, int g, bool phys, int wave) {
    asm volatile("s_waitcnt vmcnt(0)" ::: "memory");
    __syncthreads();
    if (wave == 0 && lane_id() == 0) {
        unsigned* bar = ctl + 4096; unsigned* sub = ctl + CW_GB + 64 * g; unsigned* genw = ctl + CW_GB + 64 * (32 + g);
        __builtin_amdgcn_s_waitcnt(0);
        if (!phys) { __builtin_amdgcn_fence(__ATOMIC_RELEASE, "agent"); asm volatile("s_waitcnt vmcnt(0)" ::: "memory"); }
        const unsigned old = xb_add(sub, 1u), gen = old / 8u;
        if (old + 1u == (gen + 1u) * 8u) xb_add(genw, 1u);
        else XB_SPIN(xb_ld(genw) == gen, bar);
        __builtin_amdgcn_fence(__ATOMIC_ACQUIRE, "agent");
        asm volatile("s_waitcnt vmcnt(0)" ::: "memory");
    }
    __syncthreads();
}
struct BatchOrder {
    int m0, nN, rk;
    __device__ __forceinline__ bool next(int i, pg8::Unit& u) const { const int L = 8 * i + rk; if (L >= 8 * nN) return false; const int mp = L / (2 * nN), t = L - mp * 2 * nN; u.pm = m0 + 2 * mp + (t & 1); u.pn = t >> 1; return true; }
    __device__ __forceinline__ void a_ready(const pg8::Unit&) const {}
    __device__ __forceinline__ void done(const pg8::Unit&) const {}
};

constexpr int CW_BAR = 4096;
constexpr size_t CTL_ZERO_BYTES = 65536;
typedef KArgs Args;
__global__ void __launch_bounds__(NTHR, 2) fwd_kernel(Args args) {
    extern __shared__ __attribute__((aligned(16))) unsigned char lds[];
    Frame F;
    F.lds = (LAS unsigned char*)lds;
    F.wave = __builtin_amdgcn_readfirstlane((int)threadIdx.x >> 6); F.lane = lane_id(); F.tid = F.wave * 64 + F.lane;
    F.G = gridDim.x; { const int bx = blockIdx.x; F.vcu = (F.G % 8 == 0) ? (bx % 8) * (F.G / 8) + bx / 8 : bx; }
    unsigned char* ws = args.ws;
    F.ctl = (unsigned*)(ws + WS_CTL);
    F.ap = (const __attribute__((address_space(4))) KArgs*)__builtin_amdgcn_kernarg_segment_ptr();
    F.ws = ws;
    const int lo = args.ph_lo, hi = args.ph_hi;
    for (int u_ = F.tid; u_ < 64; u_ += NTHR) ((LAS unsigned*)(F.lds + MISC_OFF))[u_] = 0u;
    __syncthreads();
    XcdBarrier bar; bar.bar = F.ctl + CW_BAR; bar.x = 0; bar.st = nullptr; bar.wv = F.wave;
    if (hi - lo > 1) { bar = xcd_barrier_post(F.ctl + CW_BAR, (volatile LAS unsigned*)(F.lds + MISC_OFF) + 8, F.wave); bar.wv = F.wave; }
#define IN(k) (lo <= (k) && (k) < hi)
#ifndef STAGGER
#define STAGGER 0
#endif
    if (IN(0)) { asm volatile("" : "+s"(F.ws), "+s"(F.ap)); F.lane = lane_id(); F.tid = F.wave * 64 + F.lane; p0_prologue(F); }
    if (IN(0) && IN(1)) { if (lo < 0) cg::this_grid().sync(); else xcd_barrier(bar); }
    bool phys = false; F.grp = (int)blockIdx.x & 31; F.rk = (int)blockIdx.x >> 5;
    if (hi - lo > 1) { volatile LAS unsigned* st = (volatile LAS unsigned*)(F.lds + MISC_OFF) + 8;
        if (st[4] == 1u && F.G == 256) { phys = true; F.grp = 4 * (int)st[3] + ((int)st[2] >> 3); F.rk = (int)st[2] & 7; } }
    F.grp = __builtin_amdgcn_readfirstlane(F.grp) & 31; F.rk = __builtin_amdgcn_readfirstlane(F.rk) & 7;
#define GSEAM(k) do { if (IN(k) && IN((k) + 1)) grp_barrier(F.ctl, F.grp, phys, F.wave); } while (0)
#if STAGGER > 0
    if (hi - lo > 1) for (int i_ = 0; i_ < (F.grp & 3) * STAGGER; ++i_) __builtin_amdgcn_s_sleep(32);
#endif
    if (IN(1)) { asm volatile("" : "+s"(F.ws), "+s"(F.ap)); F.lane = lane_id(); F.tid = F.wave * 64 + F.lane;
        pg8::Gemm g{F.XB(), F.WIN(), MTOK, NIN, DM}; BatchOrder S{8 * F.grp, NIN / 256, F.rk};
        pg8::EpiIn E{F.QA(), F.KA(), F.VA(), F.IQ(), F.IK(), F.QB(), F.KB(), F.VB(), F.GB(), F.IW(), F.q_norm_w(), F.k_norm_w(), (LAS float*)(F.lds + XCH_OFF)};
        pg8::gemm_phase<pg8::EpiIn, BatchOrder, GEMM_ALIGN, GEMM_SP2>(F.lds, g, S, E, F.wave);
    }
    GSEAM(1);
    if (IN(2)) { asm volatile("" : "+s"(F.ws), "+s"(F.ap)); F.lane = lane_id(); F.tid = F.wave * 64 + F.lane; p2_mixers(F); }
    GSEAM(2);
    if (IN(3)) { asm volatile("" : "+s"(F.ws), "+s"(F.ap)); F.lane = lane_id(); F.tid = F.wave * 64 + F.lane;
        const int pm = 8 * F.grp + F.rk;
        pg8::Gemm g{F.MIX(), F.WOUT(), MTOK, DM, DM}; pg8::PanelOrder S{pm, 4};
        pg8::EpiOut E{F.RMS(), F.XB(), {0.f, 0.f, 0.f, 0.f, 0.f, 0.f, 0.f, 0.f}};
        pg8::gemm_phase<pg8::EpiOut, pg8::PanelOrder, true, true>(F.lds, g, S, E, F.wave);
        const int wr = F.wave >> 2, wc = F.wave & 3, fr = F.lane & 15, fq = F.lane >> 4;
        LAS float* P = (LAS float*)(F.lds + XCH_OFF);
#pragma unroll
        for (int k = 0; k < 8; ++k) { float s = E.ss[k]; s += __shfl_xor(s, 16); s += __shfl_xor(s, 32);
            if (fq == 0) P[((k >> 2) * 128 + wr * 64 + (k & 3) * 16 + fr) * 4 + wc] = s; }
        __syncthreads();
        if (F.tid < 256) { const f32x4 p = *(const LAS f32x4*)(P + F.tid * 4);
            F.R2()[(size_t)pm * 256 + F.tid] = 1.0f / sqrtf(((p[0] + p[1]) + (p[2] + p[3])) * (1.0f / DM) + 1e-6f); }
    }
    GSEAM(3);
    if (IN(4)) { asm volatile("" : "+s"(F.ws), "+s"(F.ap)); F.lane = lane_id(); F.tid = F.wave * 64 + F.lane;
        pg8::Gemm g{F.XB(), F.WGU(), MTOK, NGU, DM}; BatchOrder S{8 * F.grp, NGU / 256, F.rk};
        pg8::EpiGU E{F.R2(), F.ACT(), {0.f, 0.f, 0.f, 0.f}, {0.f, 0.f, 0.f, 0.f}, {0.f, 0.f, 0.f, 0.f}, {0.f, 0.f, 0.f, 0.f}, 0ull};
        pg8::gemm_phase<pg8::EpiGU, BatchOrder, GEMM_ALIGN, GEMM_SP2>(F.lds, g, S, E, F.wave);
    }
    GSEAM(4);
    if (IN(5)) { asm volatile("" : "+s"(F.ws), "+s"(F.ap)); F.lane = lane_id(); F.tid = F.wave * 64 + F.lane;
        pg8::Gemm g{F.ACT(), F.WDN(), MTOK, DM, FF}; BatchOrder S{8 * F.grp, DM / 256, F.rk};
        pg8::EpiDown E{F.XB(), F.out()};
        pg8::gemm_phase<pg8::EpiDown, BatchOrder, GEMM_ALIGN, GEMM_SP2>(F.lds, g, S, E, F.wave);
    }
#undef GSEAM
#ifdef PROBE_TIMER
    xcd_barrier(bar);
    { const float frac = __uint_as_float(__hip_atomic_load(F.ctl + 64, __ATOMIC_RELAXED, __HIP_MEMORY_SCOPE_AGENT)); const int nz = (int)(frac * (float)MTOK);
      for (int m = (int)blockIdx.x * NWAVES + F.wave; m < nz; m += F.G * NWAVES) { f32x4* o = (f32x4*)(F.out() + (size_t)m * DM) + F.lane;
#pragma unroll
          for (int j = 0; j < 4; ++j) o[64 * j] = (f32x4){0.f, 0.f, 0.f, 0.f}; } }
#endif
#undef IN
}

extern "C" void kernel_launch(void* const* d_in, const int* in_sizes, int n_in, void* d_out, int out_size, void* d_ws, size_t ws_size, hipStream_t stream) {
    static int grid = 0;
    if (grid == 0) {
        if (n_in != 16 || in_sizes[0] != MTOK * DM || out_size != MTOK * DM || ws_size < WS_END) {
            fprintf(stderr, "kernel_launch: unexpected problem (n_in %d, in0 %d, out %d, ws %zu); nothing launched\n", n_in, n_in > 0 ? in_sizes[0] : -1, out_size, ws_size); grid = -1; return; }
        int dev = 0, cus = 0, per_cu = 0;
        if (hipGetDevice(&dev) != hipSuccess || hipDeviceGetAttribute(&cus, hipDeviceAttributeMultiprocessorCount, dev) != hipSuccess) { grid = -1; return; }
        if (hipFuncSetAttribute((const void*)fwd_kernel, hipFuncAttributeMaxDynamicSharedMemorySize, LDS_BYTES) != hipSuccess) { fprintf(stderr, "kernel_launch: hipFuncSetAttribute failed\n"); grid = -1; return; }
        if (hipOccupancyMaxActiveBlocksPerMultiprocessor(&per_cu, (const void*)fwd_kernel, NTHR, LDS_BYTES) != hipSuccess || per_cu < 1) { fprintf(stderr, "kernel_launch: occupancy query says %d blocks per CU\n", per_cu); (void)hipGetLastError(); grid = -1; return; }
        grid = cus;
        if (grid != 256) { fprintf(stderr, "kernel_launch: %d CUs; this kernel is laid out for 256 (eight groups of 32 workgroups)\n", grid); grid = -1; return; }
    }
    if (grid < 0) return;
    if (hipMemsetAsync((char*)d_ws + WS_CTL, 0, CTL_ZERO_BYTES, stream) != hipSuccess) { fprintf(stderr, "kernel_launch: memset failed\n"); return; }
    Args a{};
    for (int i = 0; i < 16; ++i) a.in[i] = (const float*)d_in[i];
    a.out = (float*)d_out; a.ws = (unsigned char*)d_ws;
#if MK_N_LAUNCHES == 1
    a.ph_lo = 0; a.ph_hi = N_PHASES;
    void* kargs[] = {&a};
    hipError_t e = hipLaunchCooperativeKernel((const void*)fwd_kernel, dim3(grid), dim3(NTHR), kargs, LDS_BYTES, stream);
    if (e != hipSuccess) fprintf(stderr, "kernel_launch: cooperative launch failed: %s (grid %d)\n", hipGetErrorString(e), grid);
#else
    for (int p = 0; p < N_PHASES; ++p) { a.ph_lo = p; a.ph_hi = p + 1; hipLaunchKernelGGL(fwd_kernel, dim3(grid), dim3(NTHR), LDS_BYTES, stream, a); }
#endif
}
```

```cpp
#include <hip/hip_runtime.h>
#define STAGGER 8
#include <hip/hip_cooperative_groups.h>
#include <cstdio>
#include <cstdint>
namespace cg = cooperative_groups;
namespace pg8 {
#define PG8_LAS __attribute__((address_space(3)))
typedef unsigned short bf16_t;
typedef short bf16x8 __attribute__((ext_vector_type(8)));
typedef float f32x4 __attribute__((ext_vector_type(4)));
typedef unsigned u32x4 __attribute__((ext_vector_type(4)));
constexpr int BM = 256, BK = 64, HALF = 128, HTB = HALF * BK * 2  , STAGE_BYTES = 8 * HTB, NXCD = 8, WGM = 8;

__host__ __device__ __forceinline__ int lds_byte(int r, int c) { const int st = (r >> 4) * 2 + (c >> 5), rr = r & 15, cc = c & 31, ob = rr * 64 + cc * 2; return st * 1024 + (ob ^ (((ob >> 9) & 1) << 5)); }
__host__ __device__ __forceinline__ void stage_rc(int b, int& R, int& C) { const int st = b / 1024, sb = b % 1024, swz = sb ^ (((sb >> 9) & 1) << 5); R = (st >> 1) * 16 + swz / 64; C = (st & 1) * 32 + (swz % 64) / 2; }
__host__ __device__ __forceinline__ int perm32(int rho) { const int n = rho >> 4, i = rho & 15; return 8 * (i >> 2) + 4 * n + (i & 3); }

struct Unit { int pm, pn; };
struct Gemm { const bf16_t* A; const bf16_t* Bt; int M, N, K; };

struct StaticOrder {
    int nM, nN, nwg, G, c;
    __host__ __device__ void init(int M, int N, int G_, int c_) { nM = M / BM; nN = N / BM; nwg = nM * nN; G = G_; c = c_; }
    __host__ __device__ bool next(int i, Unit& u) const {
        const long L = (long)i * G + c; if (L >= nwg) return false;
        int wgid = (int)L; { const int q = nwg / NXCD, r = nwg % NXCD, xcd = wgid % NXCD, off = wgid / NXCD; wgid = (xcd < r ? xcd * (q + 1) : r * (q + 1) + (xcd - r) * q) + off; }
        const int nig = WGM * nN, gid = wgid / nig, fm = gid * WGM, gsz = (nM - fm) < WGM ? (nM - fm) : WGM;
        u.pm = fm + ((wgid % nig) % gsz); u.pn = (wgid % nig) / gsz; return true;
    }
    __device__ __forceinline__ void a_ready(const Unit&) const {}
    __device__ __forceinline__ void done(const Unit&) const {}
};

__device__ __forceinline__ unsigned cvt_pk_bf16(float lo, float hi) { unsigned r; asm volatile("v_cvt_pk_bf16_f32 %0, %1, %2" : "=v"(r) : "v"(lo), "v"(hi)); return r; }
typedef float f32x2 __attribute__((ext_vector_type(2)));
typedef __bf16 bf16x2_t __attribute__((ext_vector_type(2)));
typedef unsigned u32x2 __attribute__((ext_vector_type(2)));
__device__ __forceinline__ unsigned pkbf(float lo, float hi) { f32x2 v = {lo, hi}; bf16x2_t b = __builtin_convertvector(v, bf16x2_t); return __builtin_bit_cast(unsigned, b); }
__device__ __forceinline__ u32x4 pk8(f32x4 a, f32x4 b) { return (u32x4){pkbf(a[0], a[1]), pkbf(a[2], a[3]), pkbf(b[0], b[1]), pkbf(b[2], b[3])}; }
__device__ __forceinline__ float dot4(f32x4 a) { return (a[0] * a[0] + a[1] * a[1]) + (a[2] * a[2] + a[3] * a[3]); }
__device__ __forceinline__ float sum4(f32x4 a) { return (a[0] + a[1]) + (a[2] + a[3]); }
__device__ __forceinline__ float silu1(float v) { return v * __builtin_amdgcn_rcpf(1.0f + __builtin_amdgcn_exp2f(-1.4426950408889634f * v)); }
__device__ __forceinline__ f32x4 silu4(f32x4 v) { return (f32x4){silu1(v[0]), silu1(v[1]), silu1(v[2]), silu1(v[3])}; }
constexpr float RMS_EPS_F = 1e-6f;
constexpr float QSCALE = 0.125f * 1.4426950408889634f;

struct EpiIn {
    static constexpr bool PERM = true, AFTER_DRAIN = false;
    bf16_t *QA, *KA, *VA, *IQ, *IK, *QB, *KB, *VB, *GB; float* IW;
    const float *qnw, *knw;
    PG8_LAS float* xch;
    __device__ __forceinline__ void prefetch(const Unit&, int, int) {}
    __device__ __forceinline__ void advance() {}
    __device__ __forceinline__ void operator()(const f32x4 (&acc)[2][2][4][2], const Unit& u, int wr, int wc, int fr, int fq) {
        asm volatile("" : "+v"(fr), "+v"(fq));
        const int row0 = u.pm * BM + wr * 64 + fr, pn = u.pn;
        if (pn < 2) {
            const int head = 4 * pn + wc;
            const f32x4 w0 = *(const f32x4*)(qnw + 8 * fq), w1 = *(const f32x4*)(qnw + 8 * fq + 4), w2 = *(const f32x4*)(qnw + 32 + 8 * fq), w3 = *(const f32x4*)(qnw + 36 + 8 * fq);
#pragma unroll
            for (int ai = 0; ai < 2; ++ai)
#pragma unroll
                for (int m = 0; m < 4; ++m) {
                    f32x4 a0 = acc[ai][0][m][0], a1 = acc[ai][0][m][1], b0 = acc[ai][1][m][0], b1 = acc[ai][1][m][1];
                    float ss = (dot4(a0) + dot4(a1)) + (dot4(b0) + dot4(b1));
                    ss += __shfl_xor(ss, 16); ss += __shfl_xor(ss, 32);
                    const float rs = QSCALE / sqrtf(ss * (1.0f / 64.0f) + RMS_EPS_F);
                    bf16_t* p = QA + (size_t)(row0 + ai * HALF + m * 16) * 512 + head * 64 + 8 * fq;
                    *(u32x4*)p = pk8(a0 * w0 * rs, a1 * w1 * rs); *(u32x4*)(p + 32) = pk8(b0 * w2 * rs, b1 * w3 * rs);
                }
        } else if (pn == 2) {
            if (wc >= 2) {
#pragma unroll
                for (int ai = 0; ai < 2; ++ai)
#pragma unroll
                    for (int m = 0; m < 4; ++m) {
                        float ss = (dot4(acc[ai][0][m][0]) + dot4(acc[ai][0][m][1])) + (dot4(acc[ai][1][m][0]) + dot4(acc[ai][1][m][1]));
                        ss += __shfl_xor(ss, 16); ss += __shfl_xor(ss, 32);
                        if (fq == 0) xch[(ai * HALF + wr * 64 + m * 16 + fr) * 2 + (wc - 2)] = ss;
                    }
            }
            asm volatile("s_waitcnt lgkmcnt(0)" ::: "memory"); __builtin_amdgcn_s_barrier(); asm volatile("" ::: "memory");
            if (wc < 2) {
                const f32x4 w0 = *(const f32x4*)(knw + 8 * fq), w1 = *(const f32x4*)(knw + 8 * fq + 4), w2 = *(const f32x4*)(knw + 32 + 8 * fq), w3 = *(const f32x4*)(knw + 36 + 8 * fq);
#pragma unroll
                for (int ai = 0; ai < 2; ++ai)
#pragma unroll
                    for (int m = 0; m < 4; ++m) {
                        const int rl = ai * HALF + wr * 64 + m * 16 + fr;
                        const f32x2 pr = *(const PG8_LAS f32x2*)(xch + rl * 2);
                        const float rc = 1.0f / sqrtf((pr[0] + pr[1]) * (1.0f / 128.0f) + RMS_EPS_F);
                        f32x4 a0 = acc[ai][0][m][0] * rc, a1 = acc[ai][0][m][1] * rc, b0 = acc[ai][1][m][0] * rc, b1 = acc[ai][1][m][1] * rc;
                        const size_t row = (size_t)(row0 + ai * HALF + m * 16);
                        if (wc == 0) {
                            float ss = (dot4(a0) + dot4(a1)) + (dot4(b0) + dot4(b1));
                            ss += __shfl_xor(ss, 16); ss += __shfl_xor(ss, 32);
                            const float rs = 1.0f / sqrtf(ss * (1.0f / 64.0f) + RMS_EPS_F);
                            bf16_t* p = KA + row * 64 + 8 * fq;
                            *(u32x4*)p = pk8(a0 * w0 * rs, a1 * w1 * rs); *(u32x4*)(p + 32) = pk8(b0 * w2 * rs, b1 * w3 * rs);
                        } else {
                            bf16_t* p = VA + row * 64 + 8 * fq;
                            *(u32x4*)p = pk8(a0, a1); *(u32x4*)(p + 32) = pk8(b0, b1);
                        }
                    }
            }
        } else if (pn == 3) {
#pragma unroll
            for (int ai = 0; ai < 2; ++ai)
#pragma unroll
                for (int m = 0; m < 4; ++m) {
                    const size_t row = (size_t)(row0 + ai * HALF + m * 16);
                    *(u32x4*)(IQ + row * 128 + 32 * wc + 8 * fq) = pk8(acc[ai][0][m][0], acc[ai][0][m][1]);
                    if (wc == 0) *(u32x4*)(IK + row * 32 + 8 * fq) = pk8(acc[ai][1][m][0], acc[ai][1][m][1]);
                    if (wc == 1 && fq == 0) *(f32x4*)(IW + row * 4) = acc[ai][1][m][0];
                }
        } else if (pn < 8) {
            const int head = 4 * (pn & 1) + wc; bf16_t* dst = pn < 6 ? QB : KB;
            const float lg2 = __log2f(1.0f - __builtin_amdgcn_exp2f(-5.0f - (float)head));
            f32x4 iv0, iv1;
#pragma unroll
            for (int i = 0; i < 4; ++i) { iv0[i] = __builtin_amdgcn_exp2f(-(float)(8 * fq + i) * (13.287712379549449f / 32.0f)) * 0.15915494309189535f; iv1[i] = __builtin_amdgcn_exp2f(-(float)(8 * fq + 4 + i) * (13.287712379549449f / 32.0f)) * 0.15915494309189535f; }
#pragma unroll
            for (int ai = 0; ai < 2; ++ai)
#pragma unroll
                for (int m = 0; m < 4; ++m) {
                    const int row = row0 + ai * HALF + m * 16, pos = row & 2047; const float fp = (float)pos;
                    const float sc = pn < 6 ? __builtin_amdgcn_exp2f((float)(pos & 63) * lg2) : 0.125f * __builtin_amdgcn_exp2f(-(float)(pos & 63) * lg2);
                    f32x4 c0, c1, s0, s1;
#pragma unroll
                    for (int i = 0; i < 4; ++i) {
                        const float r0 = __builtin_amdgcn_fractf(fp * iv0[i]), r1 = __builtin_amdgcn_fractf(fp * iv1[i]);
                        c0[i] = __builtin_amdgcn_cosf(r0) * sc; s0[i] = __builtin_amdgcn_sinf(r0) * sc; c1[i] = __builtin_amdgcn_cosf(r1) * sc; s1[i] = __builtin_amdgcn_sinf(r1) * sc;
                    }
                    const f32x4 a0 = acc[ai][0][m][0], a1 = acc[ai][0][m][1], b0 = acc[ai][1][m][0], b1 = acc[ai][1][m][1];
                    bf16_t* p = dst + (size_t)row * 512 + head * 64 + 8 * fq;
                    *(u32x4*)p = pk8(a0 * c0 - b0 * s0, a1 * c1 - b1 * s1); *(u32x4*)(p + 32) = pk8(a0 * s0 + b0 * c0, a1 * s1 + b1 * c1);
                }
        } else {
            const int head = 4 * (pn & 1) + wc; bf16_t* dst = pn < 10 ? VB : GB; const bool act = pn >= 10;
#pragma unroll
            for (int ai = 0; ai < 2; ++ai)
#pragma unroll
                for (int m = 0; m < 4; ++m) {
                    f32x4 a0 = acc[ai][0][m][0], a1 = acc[ai][0][m][1], b0 = acc[ai][1][m][0], b1 = acc[ai][1][m][1];
                    if (act) { a0 = silu4(a0); a1 = silu4(a1); b0 = silu4(b0); b1 = silu4(b1); }
                    bf16_t* p = dst + (size_t)(row0 + ai * HALF + m * 16) * 512 + head * 64 + 8 * fq;
                    *(u32x4*)p = pk8(a0, a1); *(u32x4*)(p + 32) = pk8(b0, b1);
                }
        }
    }
};

struct EpiOut {
    static constexpr bool PERM = true, AFTER_DRAIN = false;
    const float* rms; bf16_t* x1b; float ss[8];
    __device__ __forceinline__ void prefetch(const Unit&, int, int) {}
    __device__ __forceinline__ void advance() {}
    __device__ __forceinline__ void operator()(const f32x4 (&acc)[2][2][4][2], const Unit& u, int wr, int wc, int fr, int fq) {
        asm volatile("" : "+v"(fr), "+v"(fq));
        const int row0 = u.pm * BM + wr * 64 + fr, col0 = u.pn * BM + wc * 32 + 8 * fq;
#pragma unroll
        for (int ai = 0; ai < 2; ++ai)
#pragma unroll
            for (int m = 0; m < 4; ++m) {
                const int row = row0 + ai * HALF + m * 16; const size_t off = (size_t)row * 1024 + col0; const float rm = rms[row]; float s = 0.f;
#pragma unroll
                for (int bj = 0; bj < 2; ++bj) {
                    const u32x4 xv = *(const u32x4*)(x1b + off + bj * HALF);
                    const f32x4 x0 = {__uint_as_float(xv[0] << 16), __uint_as_float(xv[0] & 0xffff0000u), __uint_as_float(xv[1] << 16), __uint_as_float(xv[1] & 0xffff0000u)};
                    const f32x4 x1 = {__uint_as_float(xv[2] << 16), __uint_as_float(xv[2] & 0xffff0000u), __uint_as_float(xv[3] << 16), __uint_as_float(xv[3] & 0xffff0000u)};
                    const f32x4 r0 = x0 * rm + acc[ai][bj][m][0], r1 = x1 * rm + acc[ai][bj][m][1];
                    *(u32x4*)(x1b + off + bj * HALF) = pk8(r0, r1);
                    s += dot4(r0) + dot4(r1);
                }
                ss[ai * 4 + m] += s;
            }
    }
};

struct EpiGU {
    static constexpr bool PERM = true, AFTER_DRAIN = false;
    const float* r2; bf16_t* act; f32x4 rc0, rc1, rn0, rn1; unsigned long long tepi;
    __device__ __forceinline__ void prefetch(const Unit& u, int wr, int fr) {
        const float* p = r2 + u.pm * BM + wr * 64 + fr;
        rn0 = (f32x4){p[0], p[16], p[32], p[48]}; rn1 = (f32x4){p[HALF], p[HALF + 16], p[HALF + 32], p[HALF + 48]};
    }
    __device__ __forceinline__ void advance() { rc0 = rn0; rc1 = rn1; }
    __device__ __forceinline__ void operator()(const f32x4 (&acc)[2][2][4][2], const Unit& u, int wr, int wc, int fr, int fq) {
#ifdef PROBE_TIMER
        const unsigned long long te0_ = __builtin_amdgcn_s_memtime();
#endif
        asm volatile("" : "+v"(fr), "+v"(fq));
        const int row0 = u.pm * BM + wr * 64 + fr, col0 = u.pn * HALF + wc * 32 + 8 * fq;
#pragma unroll
        for (int ai = 0; ai < 2; ++ai)
#pragma unroll
            for (int m = 0; m < 4; ++m) {
                const int row = row0 + ai * HALF + m * 16; const float rr = ai ? rc1[m] : rc0[m];
                const f32x4 g0 = acc[ai][0][m][0] * rr, g1 = acc[ai][0][m][1] * rr, u0 = acc[ai][1][m][0] * rr, u1 = acc[ai][1][m][1] * rr;
                *(u32x4*)(act + (size_t)row * 2816 + col0) = pk8(silu4(g0) * u0, silu4(g1) * u1);
            }
#ifdef PROBE_TIMER
        asm volatile("s_waitcnt vmcnt(0)" ::: "memory"); tepi += __builtin_amdgcn_s_memtime() - te0_;
#endif
    }
};

struct EpiDown {
    static constexpr bool PERM = true, AFTER_DRAIN = false;
    const bf16_t* x1b; float* out;
    __device__ __forceinline__ void prefetch(const Unit&, int, int) {}
    __device__ __forceinline__ void advance() {}
    __device__ __forceinline__ void operator()(const f32x4 (&acc)[2][2][4][2], const Unit& u, int wr, int wc, int fr, int fq) {
        asm volatile("" : "+v"(fr), "+v"(fq));
        const int row0 = u.pm * BM + wr * 64 + fr, col0 = u.pn * BM + wc * 32 + 8 * fq;
#pragma unroll
        for (int ai = 0; ai < 2; ++ai)
#pragma unroll
            for (int m = 0; m < 4; ++m) {
                const size_t off = (size_t)(row0 + ai * HALF + m * 16) * 1024 + col0;
#pragma unroll
                for (int bj = 0; bj < 2; ++bj) {
                    const u32x4 xv = *(const u32x4*)(x1b + off + bj * HALF);
                    const f32x4 x0 = {__uint_as_float(xv[0] << 16), __uint_as_float(xv[0] & 0xffff0000u), __uint_as_float(xv[1] << 16), __uint_as_float(xv[1] & 0xffff0000u)};
                    const f32x4 x1 = {__uint_as_float(xv[2] << 16), __uint_as_float(xv[2] & 0xffff0000u), __uint_as_float(xv[3] << 16), __uint_as_float(xv[3] & 0xffff0000u)};
                    *(f32x4*)(out + off + bj * HALF) = x0 + acc[ai][bj][m][0]; *(f32x4*)(out + off + bj * HALF + 4) = x1 + acc[ai][bj][m][1];
                }
            }
    }
};

struct PanelOrder {
    int pm, ntn;
    __device__ __forceinline__ bool next(int i, Unit& u) const { if (i >= ntn) return false; u.pm = pm; u.pn = i; return true; }
    __device__ __forceinline__ void a_ready(const Unit&) const {}
    __device__ __forceinline__ void done(const Unit&) const {}
};

template <class Epi, class Sched, bool ALIGN_EPI = false, bool SP2 = false>
__device__ __forceinline__ void gemm_phase(PG8_LAS unsigned char* lds, const Gemm g, const Sched& S, Epi& E, int wave_in) {
    unsigned ones_ = ~0u; asm volatile("" : "+s"(ones_)); int tid_ = wave_in * 64 + (int)__builtin_amdgcn_mbcnt_hi(ones_, __builtin_amdgcn_mbcnt_lo(ones_, 0u));
    const int tid = tid_, wid = __builtin_amdgcn_readfirstlane(tid >> 6), lane = tid & 63, wr = wid >> 2, wc = wid & 3, fr = lane & 15, fq = lane >> 4;
    const int K = g.K, nt = K / BK;
    unsigned voffA[2], voffB[2];
#pragma unroll
    for (int i = 0; i < 2; ++i) { int R, C; stage_rc(tid * 16 + i * 8192, R, C); const int Rb = Epi::PERM ? ((R & ~31) + perm32(R & 31)) : R;
        voffA[i] = (unsigned)(R * K + C) * 2u; voffB[i] = (unsigned)(Rb * K + C) * 2u; }
    const size_t kstep = (size_t)(BK * 2);
    const size_t hstep = (size_t)HALF * K * 2;
    const size_t tstep = 2 * hstep;
    const unsigned ldsw = (unsigned)wid * 1024u;
    const int aoff = lds_byte(wr * 64 + fr, fq * 8), boff = lds_byte(wc * 32 + fr, fq * 8);
#define PG8_SA(b, h) (((b) * 2 + (h)) * HTB)
#define PG8_SB(b, h) ((4 + (b) * 2 + (h)) * HTB)
#define PG8_STAGE(bufoff, gbase, voff) do { _Pragma("unroll") for (int _i = 0; _i < 2; ++_i) \
        __builtin_amdgcn_global_load_lds((const unsigned*)((const char*)(gbase) + (voff)[_i]), (PG8_LAS unsigned*)(lds + (bufoff) + ldsw + _i * 8192), 16, 0, 0); } while (0)
#define PG8_LDA(dst, b, h) do { _Pragma("unroll") for (int m = 0; m < 4; ++m) _Pragma("unroll") for (int k = 0; k < 2; ++k) dst[m][k] = *(const PG8_LAS bf16x8*)(lds + PG8_SA(b, h) + aoff + m * 2048 + k * 1024); } while (0)
#define PG8_LDB(dst, b, h) do { _Pragma("unroll") for (int n = 0; n < 2; ++n) _Pragma("unroll") for (int k = 0; k < 2; ++k) dst[n][k] = *(const PG8_LAS bf16x8*)(lds + PG8_SB(b, h) + boff + n * 2048 + k * 1024); } while (0)
#define PG8_MMA(ai, bj, At, Bt) do { __builtin_amdgcn_s_setprio(1); _Pragma("unroll") for (int m = 0; m < 4; ++m) _Pragma("unroll") for (int n = 0; n < 2; ++n) _Pragma("unroll") for (int k = 0; k < 2; ++k) \
        acc[ai][bj][m][n] = __builtin_amdgcn_mfma_f32_16x16x32_bf16(Bt[n][k], At[m][k], acc[ai][bj][m][n], 0, 0, 0); __builtin_amdgcn_s_setprio(0); } while (0)
#define PG8_WAIT_V(n) asm volatile("s_waitcnt vmcnt(" #n ")" ::: "memory")
#define PG8_WAIT_L(n) asm volatile("s_waitcnt lgkmcnt(" #n ")" ::: "memory")
#define PG8_BAR __builtin_amdgcn_s_barrier()
#define PG8_SCHED __builtin_amdgcn_sched_barrier(0)
    Unit cur, nxt; int ui = 0;
    if (!S.next(0, cur)) return;
    E.prefetch(cur, wr, fr); E.advance();
    f32x4 acc[2][2][4][2];
#pragma unroll
    for (int a = 0; a < 2; ++a)
#pragma unroll
        for (int b = 0; b < 2; ++b)
#pragma unroll
            for (int m = 0; m < 4; ++m)
#pragma unroll
                for (int n = 0; n < 2; ++n) acc[a][b][m][n] = (f32x4){0.f, 0.f, 0.f, 0.f};
    bf16x8 At[4][2], B0[2][2], B1[2][2];
    const char* cA = (const char*)g.A + (size_t)cur.pm * tstep; const char* cB = (const char*)g.Bt + (size_t)cur.pn * tstep;
    S.a_ready(cur);
    if constexpr (SP2) {
        PG8_STAGE(PG8_SB(0, 0), cB, voffB); PG8_STAGE(PG8_SB(0, 1), cB + hstep, voffB); PG8_STAGE(PG8_SA(0, 0), cA, voffA); PG8_STAGE(PG8_SA(0, 1), cA + hstep, voffA);
        if (wr == 1) PG8_BAR;
        PG8_WAIT_V(2); PG8_BAR;
        PG8_STAGE(PG8_SB(1, 0), cB + kstep, voffB); PG8_STAGE(PG8_SA(1, 0), cA + kstep, voffA); PG8_STAGE(PG8_SB(1, 1), cB + hstep + kstep, voffB);
        PG8_WAIT_V(6); PG8_BAR;
    } else {
        PG8_STAGE(PG8_SB(0, 0), cB, voffB); PG8_STAGE(PG8_SA(0, 0), cA, voffA); PG8_STAGE(PG8_SB(0, 1), cB + hstep, voffB); PG8_STAGE(PG8_SA(0, 1), cA + hstep, voffA);
        if (wr == 1) PG8_BAR;
        PG8_WAIT_V(4); PG8_BAR;
        PG8_STAGE(PG8_SB(1, 0), cB + kstep, voffB); PG8_STAGE(PG8_SA(1, 0), cA + kstep, voffA); PG8_STAGE(PG8_SB(1, 1), cB + hstep + kstep, voffB);
        PG8_WAIT_V(6); PG8_BAR;
    }
    for (;;) {
        const bool has_next = S.next(ui + 1, nxt);
        const char* nA = has_next ? (const char*)g.A + (size_t)nxt.pm * tstep : cA; const char* nB = has_next ? (const char*)g.Bt + (size_t)nxt.pn * tstep : cB;
        for (int t = 0; t < nt; t += 2) {
            const bool last = (t == nt - 2);
            const char* a1 = cA + (size_t)(t + 1) * kstep;
            const char* a2 = last ? nA : cA + (size_t)(t + 2) * kstep; const char* b2 = last ? nB : cB + (size_t)(t + 2) * kstep;
            const char* a3 = a2 + kstep; const char* b3 = b2 + kstep;
            if (last && has_next) { S.a_ready(nxt); E.prefetch(nxt, wr, fr); }
            if constexpr (SP2) {
            PG8_LDB(B0, 0, 0); PG8_LDB(B1, 0, 1); PG8_SCHED; PG8_LDA(At, 0, 0); PG8_STAGE(PG8_SA(1, 1), a1 + hstep, voffA);
            PG8_WAIT_V(8); PG8_WAIT_L(0); PG8_BAR; PG8_MMA(0, 0, At, B0); PG8_MMA(0, 1, At, B1); PG8_BAR; PG8_SCHED;
            PG8_LDA(At, 0, 1); PG8_STAGE(PG8_SB(0, 0), b2, voffB); PG8_STAGE(PG8_SB(0, 1), b2 + hstep, voffB); PG8_STAGE(PG8_SA(0, 0), a2, voffA);
            PG8_WAIT_V(8); PG8_WAIT_L(0); PG8_BAR; PG8_MMA(1, 0, At, B0); PG8_MMA(1, 1, At, B1); PG8_BAR; PG8_SCHED;
            PG8_LDB(B0, 1, 0); PG8_LDB(B1, 1, 1); PG8_SCHED; PG8_LDA(At, 1, 0); PG8_STAGE(PG8_SA(0, 1), a2 + hstep, voffA);
            PG8_WAIT_V(8); PG8_WAIT_L(0); PG8_BAR; PG8_MMA(0, 0, At, B0); PG8_MMA(0, 1, At, B1); PG8_BAR; PG8_SCHED;
            PG8_LDA(At, 1, 1); PG8_STAGE(PG8_SB(1, 0), b3, voffB); PG8_STAGE(PG8_SB(1, 1), b3 + hstep, voffB); PG8_STAGE(PG8_SA(1, 0), a3, voffA);
            PG8_WAIT_V(8); PG8_WAIT_L(0); PG8_BAR; PG8_MMA(1, 0, At, B0); PG8_MMA(1, 1, At, B1); PG8_BAR; PG8_SCHED;
            } else {
            PG8_LDB(B0, 0, 0); PG8_SCHED; PG8_LDA(At, 0, 0); PG8_STAGE(PG8_SA(1, 1), a1 + hstep, voffA);
            PG8_WAIT_L(8); PG8_BAR; PG8_WAIT_L(0); PG8_MMA(0, 0, At, B0); PG8_BAR; PG8_SCHED;
            PG8_LDB(B1, 0, 1); PG8_STAGE(PG8_SB(0, 0), b2, voffB);
            PG8_BAR; PG8_WAIT_L(0); PG8_MMA(0, 1, At, B1); PG8_BAR;
            PG8_LDA(At, 0, 1); PG8_STAGE(PG8_SA(0, 0), a2, voffA);
            PG8_BAR; PG8_WAIT_L(0); PG8_MMA(1, 0, At, B0); PG8_BAR; PG8_SCHED;
            PG8_STAGE(PG8_SB(0, 1), b2 + hstep, voffB);
            PG8_WAIT_V(6); PG8_BAR; PG8_MMA(1, 1, At, B1); PG8_BAR;
            PG8_LDB(B0, 1, 0); PG8_SCHED; PG8_LDA(At, 1, 0); PG8_STAGE(PG8_SA(0, 1), a2 + hstep, voffA);
            PG8_WAIT_L(8); PG8_BAR; PG8_WAIT_L(0); PG8_MMA(0, 0, At, B0); PG8_BAR; PG8_SCHED;
            PG8_LDB(B1, 1, 1); PG8_STAGE(PG8_SB(1, 0), b3, voffB);
            PG8_BAR; PG8_WAIT_L(0); PG8_MMA(0, 1, At, B1); PG8_BAR;
            PG8_LDA(At, 1, 1); PG8_STAGE(PG8_SA(1, 0), a3, voffA);
            PG8_BAR; PG8_WAIT_L(0); PG8_MMA(1, 0, At, B0); PG8_BAR; PG8_SCHED;
            PG8_STAGE(PG8_SB(1, 1), b3 + hstep, voffB);
            PG8_WAIT_V(6); PG8_BAR; PG8_MMA(1, 1, At, B1); PG8_BAR;
            }
        }
        if constexpr (ALIGN_EPI) { if (wr == 0) PG8_BAR; }
        if constexpr (!Epi::AFTER_DRAIN) { E(acc, cur, wr, wc, fr, fq); E.advance(); S.done(cur); }
        if (!has_next) break;
#pragma unroll
        for (int a = 0; a < 2; ++a)
#pragma unroll
            for (int b = 0; b < 2; ++b)
#pragma unroll
                for (int m = 0; m < 4; ++m)
#pragma unroll
                    for (int n = 0; n < 2; ++n) acc[a][b][m][n] = (f32x4){0.f, 0.f, 0.f, 0.f};
        cur = nxt; cA = nA; cB = nB; ++ui;
        if constexpr (ALIGN_EPI) { if (wr == 1) PG8_BAR; }
    }
    PG8_WAIT_V(0);
    if constexpr (!ALIGN_EPI) { if (wr == 0) PG8_BAR; }
    PG8_BAR;
    (void)lane;
#undef PG8_SA
#undef PG8_SB
#undef PG8_STAGE
#undef PG8_LDA
#undef PG8_LDB
#undef PG8_MMA
#undef PG8_WAIT_V
#undef PG8_WAIT_L
#undef PG8_BAR
#undef PG8_SCHED
}
}

constexpr int BATCH = 32, SEQ = 2048, DM = 1024, MTOK = BATCH * SEQ;
constexpr int INW = 2852, NIN = 3072, FF = 2816, NGU = 2 * FF;
constexpr int NWAVES = 8, NTHR = 512;
#ifndef MK_N_LAUNCHES
#define MK_N_LAUNCHES 1
#endif
constexpr int N_PHASES = 6;
constexpr size_t MiB = 1u << 20;
constexpr size_t WS_CTL = 0;
constexpr size_t WS_COS = 1 * MiB, WS_SIN = WS_COS + 256 * 1024;
constexpr size_t WS_BT = WS_SIN + 256 * 1024;
constexpr size_t WS_R2 = 2 * MiB, WS_RMS = 2 * MiB + 512 * 1024;
constexpr size_t WS_WIN = 4 * MiB, WS_WOUT = 10 * MiB, WS_WGU = 12 * MiB, WS_WDN = 23 * MiB;
constexpr size_t WS_XB = 32 * MiB;
constexpr size_t WS_MIX = 160 * MiB;
constexpr size_t WS_QA = 288 * MiB, WS_QB = 352 * MiB, WS_KB = 416 * MiB, WS_VB = 480 * MiB, WS_GB = 544 * MiB;
constexpr size_t WS_KA = 608 * MiB, WS_VA = 616 * MiB;
constexpr size_t WS_IQ = 624 * MiB;
constexpr size_t WS_ACT = 648 * MiB;
constexpr size_t WS_IK = 640 * MiB, WS_IW = 644 * MiB;
constexpr size_t WS_END = 1000 * MiB;
static_assert(WS_ACT + (size_t)MTOK * FF * 2 <= WS_END && WS_IW + (size_t)MTOK * 16 <= WS_ACT && WS_IQ + (size_t)MTOK * 128 * 2 <= WS_IK && WS_WDN + (size_t)DM * FF * 2 <= WS_XB && WS_WGU + (size_t)NGU * DM * 2 <= WS_WDN, "d_ws map");
constexpr int RING_BYTES = 131072;
constexpr int XCH_OFF = RING_BYTES;
constexpr int P2_SC = 0, SCW = 1028;
constexpr int P2_MASK = 143360;
constexpr int MISC_OFF = 163584;
constexpr int LDS_BYTES = 163840;
static_assert(P2_SC + 16 * SCW * 4 <= P2_MASK && P2_MASK + 16384 <= MISC_OFF, "P2 LDS map");

#define LAS __attribute__((address_space(3)))
typedef unsigned short bf16;
typedef unsigned v4u __attribute__((ext_vector_type(4)));
typedef unsigned v2u __attribute__((ext_vector_type(2)));
typedef float f32x4 __attribute__((ext_vector_type(4)));
typedef float f32x16 __attribute__((ext_vector_type(16)));
typedef short bf16x8 __attribute__((ext_vector_type(8)));
typedef short s16x4 __attribute__((ext_vector_type(4)));
#define LDS_WAIT() asm volatile("s_waitcnt lgkmcnt(0)" ::: "memory")
using pg8::pkbf;
__device__ __forceinline__ float bf2f(unsigned short h) { return __uint_as_float((unsigned)h << 16); }
__device__ __forceinline__ float bflo(unsigned w) { return __uint_as_float(w << 16); }
__device__ __forceinline__ float bfhi(unsigned w) { return __uint_as_float(w & 0xffff0000u); }
__device__ __forceinline__ float wave_sum(float v) {
#pragma unroll
    for (int o = 1; o < 64; o <<= 1) v += __shfl_xor(v, o);
    return v;
}
__device__ __forceinline__ s16x4 vtr(const LAS unsigned char* p) { return __builtin_bit_cast(s16x4, __builtin_amdgcn_ds_read_tr16_b64_v4i16((LAS s16x4*)p)); }
__device__ __forceinline__ bf16x8 cat8(s16x4 lo, s16x4 hi) { return (bf16x8){lo[0], lo[1], lo[2], lo[3], hi[0], hi[1], hi[2], hi[3]}; }
__device__ __forceinline__ int crow(int r, int hi) { return (r & 3) + 8 * (r >> 2) + 4 * hi; }

__device__ __forceinline__ int lane_id() { unsigned ones = ~0u; asm volatile("" : "+s"(ones)); return (int)__builtin_amdgcn_mbcnt_hi(ones, __builtin_amdgcn_mbcnt_lo(ones, 0u)); }
struct KArgs { const float* in[16]; float* out; unsigned char* ws; int ph_lo, ph_hi; };
struct Frame {
    LAS unsigned char* lds;
    unsigned* ctl;
    unsigned char* ws;
    int tid, lane, wave, vcu, G;
    int grp, rk;
    const __attribute__((address_space(4))) KArgs* ap;
    __device__ __forceinline__ const float* x() const { return ap->in[0]; }
    __device__ __forceinline__ const float* norm1_w() const { return ap->in[1]; }
    __device__ __forceinline__ const float* w_in() const { return ap->in[2]; }
    __device__ __forceinline__ const float* q_norm_w() const { return ap->in[3]; }
    __device__ __forceinline__ const float* k_norm_w() const { return ap->in[4]; }
    __device__ __forceinline__ const float* kv_norm_w() const { return ap->in[5]; }
    __device__ __forceinline__ const float* w_uk() const { return ap->in[6]; }
    __device__ __forceinline__ const float* w_uv() const { return ap->in[7]; }
    __device__ __forceinline__ const float* rel_bias() const { return ap->in[8]; }
    __device__ __forceinline__ const float* ret_gn_w() const { return ap->in[9]; }
    __device__ __forceinline__ const float* ret_gn_b() const { return ap->in[10]; }
    __device__ __forceinline__ const float* w_out() const { return ap->in[11]; }
    __device__ __forceinline__ const float* norm2_w() const { return ap->in[12]; }
    __device__ __forceinline__ const float* w_gate() const { return ap->in[13]; }
    __device__ __forceinline__ const float* w_up() const { return ap->in[14]; }
    __device__ __forceinline__ const float* w_down() const { return ap->in[15]; }
    __device__ __forceinline__ float* out() const { return ap->out; }
#define WSB_(name, off) __device__ __forceinline__ bf16* name() const { return (bf16*)(ws + (off)); }
#define WSF_(name, off) __device__ __forceinline__ float* name() const { return (float*)(ws + (off)); }
    WSB_(WIN, WS_WIN) WSB_(WOUT, WS_WOUT) WSB_(WGU, WS_WGU) WSB_(WDN, WS_WDN) WSB_(XB, WS_XB) WSB_(MIX, WS_MIX) WSB_(QA, WS_QA) WSB_(QB, WS_QB) WSB_(KB, WS_KB) WSB_(VB, WS_VB) WSB_(GB, WS_GB)
    WSB_(KA, WS_KA) WSB_(VA, WS_VA) WSB_(IQ, WS_IQ) WSB_(IK, WS_IK) WSB_(ACT, WS_ACT)
    WSF_(IW, WS_IW) WSF_(R2, WS_R2) WSF_(RMS, WS_RMS) WSF_(COS, WS_COS) WSF_(SIN, WS_SIN) WSF_(BT, WS_BT)
#undef WSB_
#undef WSF_
};

__device__ __forceinline__ int zcol(int n) {
    const int pn = n >> 8, tc = n & 255, bj = tc >> 7, wc = (tc >> 5) & 3, j = tc & 31, d = bj * 32 + j;
    if (pn < 2) return (4 * pn + wc) * 64 + d;
    if (pn == 2) { if (wc == 0) return -2 - d; if (wc == 1) return -2 - (64 + d); return 512 + (wc - 2) * 64 + d; }
    if (pn == 3) { if (bj == 0) return 640 + wc * 32 + j; if (wc == 0) return 768 + j; if (wc == 1 && j < 4) return 800 + j; return -1; }
    const int g = (pn - 4) >> 1, head = 4 * ((pn - 4) & 1) + wc;
    return 804 + g * 512 + head * 64 + d;
}
template <class SRC>
__device__ __forceinline__ void tr_item(SRC src, int Kdim, bf16* WT, int k0, int n0, LAS float* scr, int lane) {
#pragma unroll 4
    for (int i = 0; i < 32; ++i) { const int kk = 2 * i + (lane >> 5); scr[kk * 33 + (lane & 31)] = src(k0 + kk); }
    LDS_WAIT(); asm volatile("" ::: "memory");
    const int c = lane & 7;
#pragma unroll
    for (int j = 0; j < 4; ++j) { const int n = (lane >> 3) + 8 * j; const LAS float* s = scr + (8 * c) * 33 + n;
        v4u o; o.x = pkbf(s[0 * 33], s[1 * 33]); o.y = pkbf(s[2 * 33], s[3 * 33]); o.z = pkbf(s[4 * 33], s[5 * 33]); o.w = pkbf(s[6 * 33], s[7 * 33]);
        *(v4u*)(WT + (size_t)(n0 + n) * Kdim + k0 + 8 * c) = o; }
    LDS_WAIT(); asm volatile("" ::: "memory");
}
__device__ __forceinline__ int t5_bucket(int rel) {
    const int n = rel < 0 ? -rel : rel; int b;
    if (n < 8) b = n; else if (n < 12) b = 8; else if (n < 16) b = 9; else if (n < 23) b = 10; else if (n < 32) b = 11; else if (n < 46) b = 12; else if (n < 64) b = 13; else if (n < 91) b = 14; else b = 15;
    return (rel > 0 ? 16 : 0) + b;
}
__device__ __forceinline__ void p0_prologue(Frame& F) {
    LAS float* scr = (LAS float*)(F.lds + F.wave * 16384);
    const int lane = F.lane, gw = F.vcu * NWAVES + F.wave, NGW = F.G * NWAVES;
    if (blockIdx.x == 0 && F.tid == 0) F.ctl[0] = 0u;
    constexpr int I_IN = 16 * (NIN / 32), I_OUT = 16 * 32, I_GU = 16 * (NGU / 32), I_DN = (FF / 64) * 32, NITEMS = I_IN + I_OUT + I_GU + I_DN;
    auto do_item = [&](int it) {
        int r = it;
        if (r < I_IN) {
            const int kb = r / (NIN / 32), nb = r % (NIN / 32), f = zcol(32 * nb + (lane & 31));
            const float* w_in = F.w_in(); const float* nw = F.norm1_w();
            if (f >= -1) tr_item([&](int k) { return f >= 0 ? nw[k] * w_in[(size_t)k * INW + f] : 0.0f; }, DM, F.WIN(), 64 * kb, 32 * nb, scr, lane);
            return;
        }
        r -= I_IN;
        if (r < I_OUT) { const int kb = r / 32, nb = r % 32; const float* w = F.w_out() + 32 * nb + (lane & 31);
            tr_item([&](int k) { return w[(size_t)k * DM]; }, DM, F.WOUT(), 64 * kb, 32 * nb, scr, lane); return; }
        r -= I_OUT;
        if (r < I_GU) { const int kb = r / (NGU / 32), nb = r % (NGU / 32), n = 32 * nb + (lane & 31), pn = n >> 8, tc = n & 255;
            const float* w = ((tc >> 7) ? F.w_up() : F.w_gate()) + 128 * pn + (tc & 127); const float* nw = F.norm2_w();
            tr_item([&](int k) { return nw[k] * w[(size_t)k * FF]; }, DM, F.WGU(), 64 * kb, 32 * nb, scr, lane); return; }
        r -= I_GU;
        { const int kb = r / 32, nb = r % 32; const float* w = F.w_down() + 32 * nb + (lane & 31);
            tr_item([&](int k) { return w[(size_t)k * DM]; }, FF, F.WDN(), 64 * kb, 32 * nb, scr, lane); }
    };
    for (int e = F.vcu * NTHR + F.tid; e < DM * 128; e += F.G * NTHR) {
        const int k = e >> 7, idx = e & 127, d = idx & 63; const float* wu = (idx < 64 ? F.w_uk() : F.w_uv()) + d; const float* wr_ = F.w_in() + (size_t)k * INW + 512; float a = 0.f;
#pragma unroll 8
        for (int j = 0; j < 128; ++j) a += wr_[j] * F.kv_norm_w()[j] * wu[j * 64];
        const int n = 512 + (idx < 64 ? 0 : 32) + (d < 32 ? d : 128 + d - 32);
        F.WIN()[(size_t)n * DM + k] = (bf16)(pkbf(F.norm1_w()[k] * a, 0.f) & 0xffffu);
    }
    int it = gw, kk = 0;
    for (int m = gw; m < MTOK; m += NGW, ++kk) {
        const f32x4* xr = (const f32x4*)(F.x() + (size_t)m * DM) + lane;
        f32x4 v[4]; float sq = 0.f;
#pragma unroll
        for (int j = 0; j < 4; ++j) { v[j] = xr[64 * j]; sq += pg8::dot4(v[j]); }
        const float ms = wave_sum(sq) * (1.0f / DM) + 1e-6f, rr = 1.0f / sqrtf(ms);
        v2u* o8 = (v2u*)(F.XB() + (size_t)m * DM) + lane;
#pragma unroll
        for (int j = 0; j < 4; ++j) o8[64 * j] = (v2u){pkbf(v[j][0] * rr, v[j][1] * rr), pkbf(v[j][2] * rr, v[j][3] * rr)};
        if (lane == 0) F.RMS()[m] = sqrtf(ms);
        if ((kk & 7) == 3 && it < NITEMS) { do_item(it); it += NGW; }
    }
    for (; it < NITEMS; it += NGW) do_item(it);
    const int gt = F.vcu * NTHR + F.tid, NGT = F.G * NTHR;
    for (int i = gt; i < 8 * 256; i += NGT) { const int h = i >> 8, rel = (i & 255) - 191;
        F.BT()[i] = (F.rel_bias()[t5_bucket(rel) * 8 + h] - F.rel_bias()[15 * 8 + h]) * 1.4426950408889634f; }
}

#ifndef PROBE_LO
#define PROBE_LO 3000.0f
#define PROBE_RANGE 4000.0f
#endif
#ifndef PLANES
#define PLANES 1
#endif
#ifndef MIXREP
#define MIXREP 0
#endif
typedef float f32x4_t __attribute__((ext_vector_type(4)));
typedef float f32x2v __attribute__((ext_vector_type(2)));
struct IdxOps { bf16x8 bq[4]; f32x4 wv; bf16x8 a0, a1; };
__device__ __forceinline__ void idx_fetch(IdxOps& o, const Frame& F, int b, int c, int rq) {
    const int w = F.wave, lane = F.lane, q = lane & 15, g = lane >> 4;
    const size_t rowq = (size_t)b * SEQ + 64 * c + 16 * rq + q;
#pragma unroll
    for (int h = 0; h < 4; ++h) o.bq[h] = *(const bf16x8*)(F.IQ() + rowq * 128 + 32 * h + 8 * g);
    o.wv = *(const f32x4*)(F.IW() + rowq * 4) * (0.5f * 0.17677669529663687f);
    const bf16* kp = F.IK() + ((size_t)b * SEQ + q) * 32 + 8 * g;
    o.a0 = *(const bf16x8*)(kp + (size_t)w * 512);
    o.a1 = *(const bf16x8*)(kp + (size_t)(w + 32 < 4 * (c + 1) ? w + 32 : w) * 512);
}
__device__ __forceinline__ f32x4 idx_score(const IdxOps& o, bf16x8 a) {
    f32x4 sc = {0.f, 0.f, 0.f, 0.f};
#pragma unroll
    for (int h = 0; h < 4; ++h) {
        const f32x4 d = __builtin_amdgcn_mfma_f32_16x16x32_bf16(a, o.bq[h], (f32x4){0.f, 0.f, 0.f, 0.f}, 0, 0, 0);
#pragma unroll
        for (int i = 0; i < 4; ++i) sc[i] += o.wv[h] * fmaxf(d[i], 0.f);
    }
    return sc + 0.f;
}
__device__ __forceinline__ void idx_round(const IdxOps& o, const Frame& F, int b, int c, LAS unsigned char* lds) {
    const int w = F.wave, lane = F.lane, q = lane & 15, g = lane >> 4;
    const int nkb = 4 * (c + 1);
    const bf16* kp = F.IK() + ((size_t)b * SEQ + q) * 32 + 8 * g;
    LAS unsigned* dst = (LAS unsigned*)(lds + P2_SC) + q * SCW + 4 * g;
    bf16x8 a0 = o.a0, a1 = o.a1;
    for (int s2 = 0; s2 < 2; ++s2)
        for (int kbl = w; kbl < 32; kbl += 8) {
            const int kb0 = kbl + 64 * s2; if (kb0 >= nkb) break;
            int nx = kb0 + 8; if (kbl + 8 >= 32) nx = w + 64 * (s2 + 1);
            bf16x8 n0 = a0, n1 = a1;
            if (nx < nkb) { n0 = *(const bf16x8*)(kp + (size_t)nx * 512); n1 = *(const bf16x8*)(kp + (size_t)(nx + 32 < nkb ? nx + 32 : nx) * 512); }
            const f32x4 s0 = idx_score(o, a0);
            f32x4 s1 = {0.f, 0.f, 0.f, 0.f}; if (kb0 + 32 < nkb) s1 = idx_score(o, a1);
            v4u pk;
#pragma unroll
            for (int i = 0; i < 4; ++i) pk[i] = __builtin_amdgcn_perm(__float_as_uint(s1[i]), __float_as_uint(s0[i]), 0x07060302u);
            *(LAS v4u*)(dst + (16 * s2 + (kb0 >> 1 & 15)) * 32 + 16 * (kb0 & 1)) = pk;
            a0 = n0; a1 = n1;
        }
}
__device__ __forceinline__ int wave_sum_i(int v) {
    v += __builtin_amdgcn_update_dpp(0, v, 0xB1, 0xF, 0xF, false);
    v += __builtin_amdgcn_update_dpp(0, v, 0x4E, 0xF, 0xF, false);
    v += __builtin_amdgcn_update_dpp(0, v, 0x141, 0xF, 0xF, false);
    v += __builtin_amdgcn_update_dpp(0, v, 0x140, 0xF, 0xF, false);
    return (__builtin_amdgcn_readlane(v, 0) + __builtin_amdgcn_readlane(v, 16)) + (__builtin_amdgcn_readlane(v, 32) + __builtin_amdgcn_readlane(v, 48));
}
__device__ __forceinline__ unsigned sortable(float f) { const unsigned bits = __float_as_uint(f); return bits ^ ((unsigned)((int)bits >> 31) | 0x80000000u); }
template <int NJ>
__device__ __forceinline__ void mask_words(const unsigned (&u)[NJ], unsigned prefix, bool exact, LAS unsigned long long* mrow, int nj, int lane) {
    unsigned long long mv = 0ull;
    if (exact) {
#pragma unroll
        for (int j = 0; j < NJ; ++j) { const unsigned long long sel = __ballot(u[j] >= prefix); if (lane == j) mv = sel; }
    } else {
        int ngt = 0;
#pragma unroll
        for (int j = 0; j < NJ; ++j) ngt += __popcll(__ballot(u[j] > prefix));
        int need = 256 - ngt;
#pragma unroll
        for (int j = 0; j < NJ; ++j) {
            const unsigned long long eq = __ballot(u[j] == prefix);
            const int rank = (int)__builtin_amdgcn_mbcnt_hi((unsigned)(eq >> 32), __builtin_amdgcn_mbcnt_lo((unsigned)eq, 0u));
            const unsigned long long sel = __ballot(u[j] > prefix || (u[j] == prefix && rank < need));
            need -= __popcll(eq);
            if (lane == j) mv = sel;
        }
    }
    if (lane < nj) mrow[lane] = mv;
}
template <int NJ>
__device__ __forceinline__ void select_row(const LAS float* row, LAS unsigned long long* mrow, int nj, int lane) {
    static_assert(NJ % 4 == 0, "groups of four");
    unsigned u[NJ];
#pragma unroll
    for (int j = 0; j < NJ; ++j) { float v = row[64 * j + lane]; asm volatile("" : "+v"(v)); u[j] = (j < nj) ? sortable(v) : 0u; }
    unsigned prefix = 0u; bool exact = false;
#pragma unroll 1
    for (int bit = 31; bit >= 0; --bit) {
        const unsigned trial = prefix | (1u << bit); int c0 = 0, c1 = 0, c2 = 0, c3 = 0;
#pragma unroll
        for (int j = 0; j < NJ; j += 4) {
            unsigned long long m0, m1, m2, m3;
            asm volatile("v_cmp_le_u32_e64 %4, %12, %8\n\tv_cmp_le_u32_e64 %5, %12, %9\n\tv_cmp_le_u32_e64 %6, %12, %10\n\tv_cmp_le_u32_e64 %7, %12, %11\n\t"
                         "v_addc_co_u32_e64 %0, %4, 0, %0, %4\n\tv_addc_co_u32_e64 %1, %5, 0, %1, %5\n\tv_addc_co_u32_e64 %2, %6, 0, %2, %6\n\tv_addc_co_u32_e64 %3, %7, 0, %3, %7"
                         : "+v"(c0), "+v"(c1), "+v"(c2), "+v"(c3), "=&s"(m0), "=&s"(m1), "=&s"(m2), "=&s"(m3) : "v"(u[j]), "v"(u[j + 1]), "v"(u[j + 2]), "v"(u[j + 3]), "s"(trial));
        }
        const int cnt = wave_sum_i((c0 + c1) + (c2 + c3));
        if (cnt >= 256) prefix = trial;
        if (cnt == 256) { exact = true; break; }
    }
    mask_words<NJ>(u, prefix, exact, mrow, nj, lane);
}
template <int S, unsigned M>
__device__ __forceinline__ void tr_stage(unsigned (&A)[32]) {
#pragma unroll
    for (int k = 0; k < 32; ++k) if (!(k & S)) {
        const unsigned a = A[k], b = A[k + S], bs = b << S, as = a >> S; unsigned lo, hi;
        asm("v_bfi_b32 %0, %1, %2, %3" : "=v"(lo) : "s"(M), "v"(a), "v"(bs)); asm("v_bfi_b32 %0, %1, %2, %3" : "=v"(hi) : "s"(M), "v"(as), "v"(b));
        A[k] = lo; A[k + S] = hi; }
}
__device__ __forceinline__ void tr_bytes(unsigned (&A)[32]) {
#pragma unroll
    for (int k = 0; k < 16; ++k) { const unsigned a = A[k], b = A[k + 16];
        A[k] = __builtin_amdgcn_perm(b, a, 0x05040100u);
        A[k + 16] = __builtin_amdgcn_perm(b, a, 0x07060302u); }
#pragma unroll
    for (int k = 0; k < 32; ++k) if (!(k & 8)) { const unsigned a = A[k], b = A[k + 8];
        A[k] = __builtin_amdgcn_perm(b, a, 0x06020400u);
        A[k + 8] = __builtin_amdgcn_perm(b, a, 0x07030501u); }
}
__device__ __forceinline__ void planes_finish(unsigned gt, unsigned alive, int G, bool done, LAS unsigned long long* mrow, int nj, int lane) {
    unsigned sel = gt | alive;
    if (!done) {
        int need = 256 - G; unsigned ts = 0u;
#pragma unroll
        for (int j = 0; j < 32; ++j) {
            const bool mine = (alive >> j) & 1u; const unsigned long long eq = __ballot(mine);
            const int rank = (int)__builtin_amdgcn_mbcnt_hi((unsigned)(eq >> 32), __builtin_amdgcn_mbcnt_lo((unsigned)eq, 0u));
            ts |= (mine && rank < need) ? (1u << j) : 0u; need -= __popcll(eq);
        }
        sel = gt | ts;
    }
    unsigned long long mv = 0ull;
#pragma unroll
    for (int j = 0; j < 32; ++j) { const unsigned long long w = __ballot((sel >> j) & 1u); if (lane == j) mv = w; }
    if (lane < nj) mrow[lane] = mv;
}
__device__ __forceinline__ void select_rows_planes2(const LAS float* rowa, const LAS float* rowb, LAS unsigned long long* mrowa, LAS unsigned long long* mrowb, int nj, int lane) {
    unsigned A[32], B[32];
#pragma unroll
    for (int j = 0; j < 32; ++j) { float va = rowa[64 * j + lane], vb = rowb[64 * j + lane]; asm volatile("" : "+v"(va), "+v"(vb)); A[j] = (j < nj) ? sortable(va) : 0u; B[j] = (j < nj) ? sortable(vb) : 0u; }
    tr_bytes(A); tr_stage<4, 0x0F0F0F0Fu>(A); tr_stage<2, 0x33333333u>(A); tr_stage<1, 0x55555555u>(A);
    tr_bytes(B); tr_stage<4, 0x0F0F0F0Fu>(B); tr_stage<2, 0x33333333u>(B); tr_stage<1, 0x55555555u>(B);
#pragma unroll
    for (int j = 0; j < 32; ++j) asm volatile("" : "+v"(A[j]), "+v"(B[j]));
    unsigned alivea = 0xFFFFFFFFu, gta = 0u, aliveb = 0xFFFFFFFFu, gtb = 0u; int Ga = 0, Aa = 2048, Gb = 0, Ab = 2048; bool donea = false, doneb = false;
#pragma unroll
    for (int b = 31; b >= 0; --b) {
        if (!(donea && doneb)) {
            const unsigned onesa = alivea & A[b], onesb = aliveb & B[b];
            const int both = wave_sum_i(__builtin_popcount(onesa) | (__builtin_popcount(onesb) << 16)), C1a = both & 0xffff, C1b = both >> 16;
            if (!donea) {
                if (Ga + C1a >= 256) { alivea = onesa; Aa = C1a; } else { Ga += C1a; gta |= onesa; alivea &= ~A[b]; Aa -= C1a; }
                donea = (Ga + Aa == 256);
            }
            if (!doneb) {
                if (Gb + C1b >= 256) { aliveb = onesb; Ab = C1b; } else { Gb += C1b; gtb |= onesb; aliveb &= ~B[b]; Ab -= C1b; }
                doneb = (Gb + Ab == 256);
            }
        }
    }
    planes_finish(gta, alivea, Ga, donea, mrowa, nj, lane);
    planes_finish(gtb, aliveb, Gb, doneb, mrowb, nj, lane);
}
constexpr int MP_STRIDE = 36, MP_PLANE = 64 * MP_STRIDE;
__device__ __forceinline__ unsigned row32_sum(unsigned v) {
    v += __builtin_amdgcn_update_dpp(0, v, 0xB1, 0xF, 0xF, true);
    v += __builtin_amdgcn_update_dpp(0, v, 0x4E, 0xF, 0xF, true);
    v += __builtin_amdgcn_update_dpp(0, v, 0x141, 0xF, 0xF, true);
    v += __builtin_amdgcn_update_dpp(0, v, 0x140, 0xF, 0xF, true);
#if defined(SWZ_SUM)
    return v + (unsigned)__builtin_amdgcn_ds_swizzle((int)v, 0x401F);
#else
    const auto sw = __builtin_amdgcn_permlane16_swap(v, v, false, false);
    return (unsigned)sw[0] + (unsigned)sw[1];
#endif
}
__device__ __forceinline__ void tr16(unsigned (&T)[16]) {
#pragma unroll
    for (int k = 0; k < 8; ++k) { const unsigned a = T[k], b = T[k + 8];
        T[k] = __builtin_amdgcn_perm(b, a, 0x06020400u);
        T[k + 8] = __builtin_amdgcn_perm(b, a, 0x07030501u); }
#define TR16_STAGE(S, M) _Pragma("unroll") for (int k = 0; k < 16; ++k) if (!(k & S)) { const unsigned a = T[k], b = T[k + S], bs = b << S, as = a >> S; unsigned lo, hi; \
        asm("v_bfi_b32 %0, %1, %2, %3" : "=v"(lo) : "s"(M), "v"(a), "v"(bs)); asm("v_bfi_b32 %0, %1, %2, %3" : "=v"(hi) : "s"(M), "v"(as), "v"(b)); T[k] = lo; T[k + S] = hi; }
    TR16_STAGE(4, 0x0F0F0F0Fu) TR16_STAGE(2, 0x33333333u) TR16_STAGE(1, 0x55555555u)
#undef TR16_STAGE
}
__device__ __forceinline__ void select_rows32(const LAS unsigned* sc, LAS unsigned* mp, int rq, int nj, int wave, int lane) {
    const int half = lane >> 5, l32 = lane & 31, ql = wave + 8 * half;
    const LAS unsigned* row = sc + ql * SCW + l32;
    unsigned A[16], B[16];
#ifdef ASM_MARK
    asm volatile("; SEL_BEGIN");
#endif
#pragma unroll
    for (int k = 0; k < 16; ++k) { unsigned va = row[32 * k], vb = row[32 * (16 + k)]; asm volatile("" : "+v"(va), "+v"(vb)); A[k] = va; B[k] = vb; }
    tr16(A); tr16(B);
#ifdef ASM_MARK
    asm volatile("; SEL_TR_END");
#endif
    const int nv = 2 * nj;
    unsigned al0 = nv >= 32 ? 0xFFFFFFFFu : ((1u << nv) - 1u), al1 = nv <= 32 ? 0u : (nv >= 64 ? 0xFFFFFFFFu : ((1u << (nv - 32)) - 1u));
    unsigned gt0 = 0u, gt1 = 0u, G = 0u;
    const unsigned S0 = A[15], S1 = B[15];
#pragma unroll
    for (int b = 15; b >= 0; --b) {
        const unsigned o0 = b == 15 ? (al0 & ~S0) : __builtin_amdgcn_bitop3_b32(al0, A[b], S0, 0x60), o1 = b == 15 ? (al1 & ~S1) : __builtin_amdgcn_bitop3_b32(al1, B[b], S1, 0x60);
        const unsigned c1 = row32_sum((unsigned)__builtin_popcount(o0) + (unsigned)__builtin_popcount(o1));
        const unsigned nt = (unsigned)((int)(G + c1 - 256u) >> 31);
        al0 = __builtin_amdgcn_bitop3_b32(o0, al0, nt, 0x78); al1 = __builtin_amdgcn_bitop3_b32(o1, al1, nt, 0x78);
        gt0 = __builtin_amdgcn_bitop3_b32(gt0, o0, nt, 0xF8); gt1 = __builtin_amdgcn_bitop3_b32(gt1, o1, nt, 0xF8);
        G += c1 & nt;
    }
#ifdef ASM_MARK
    asm volatile("; SEL_LOOP_END");
#endif
    const unsigned ce = row32_sum((unsigned)__builtin_popcount(al0) + (unsigned)__builtin_popcount(al1));
    const bool tie = G + ce != 256u;
    if (__any(tie)) {
        const unsigned need = tie ? 256u - G : 0x7fffffffu; unsigned m = 0u;
#pragma unroll
        for (int bit = 6; bit >= 0; --bit) {
            const unsigned cand = m + (1u << bit);
            const unsigned k0 = cand >= 32u ? 0xFFFFFFFFu : ((1u << cand) - 1u), k1 = cand <= 32u ? 0u : (cand >= 64u ? 0xFFFFFFFFu : ((1u << (cand - 32u)) - 1u));
            const unsigned cc = row32_sum((unsigned)__builtin_popcount(al0 & k0) + (unsigned)__builtin_popcount(al1 & k1));
            m = (cand <= 64u && cc <= need) ? cand : m;
        }
        const unsigned k0 = m >= 32u ? 0xFFFFFFFFu : ((1u << m) - 1u), k1 = m <= 32u ? 0u : (m >= 64u ? 0xFFFFFFFFu : ((1u << (m - 32u)) - 1u));
        const unsigned cm = row32_sum((unsigned)__builtin_popcount(al0 & k0) + (unsigned)__builtin_popcount(al1 & k1));
        const unsigned rem = need - cm;
        const bool mine = m < 64u && (((m < 32u ? al0 >> m : al1 >> (m - 32u)) & 1u) != 0u);
        const unsigned long long eq = __ballot(mine); const unsigned eqr = half ? (unsigned)(eq >> 32) : (unsigned)eq;
        const bool tk = mine && (unsigned)__builtin_popcount(eqr & ((1u << l32) - 1u)) < rem;
        al0 = (al0 & k0) | ((tk && m < 32u) ? (1u << m) : 0u); al1 = (al1 & k1) | ((tk && m >= 32u) ? (1u << (m - 32u)) : 0u);
    }
#ifdef ASM_MARK
    asm volatile("; SEL_TIE_END");
#endif
    LAS unsigned* rec = mp + (16 * rq + ql) * MP_STRIDE + l32;
    rec[0] = gt0 | al0; rec[MP_PLANE] = gt1 | al1;
}
constexpr int AT_K = 0, AT_V = 32768, AT_BT = 65536, AT_WS = 73728, AT_OST = 0, AT_Q = 75776;
static_assert(AT_Q + 65536 <= P2_MASK && AT_OST + 8 * 4608 <= AT_BT, "attention LDS map");
__device__ __forceinline__ bf16x8 pk16(const f32x16& v, int o) { return __builtin_bit_cast(bf16x8, (v4u){pkbf(v[o], v[o + 1]), pkbf(v[o + 2], v[o + 3]), pkbf(v[o + 4], v[o + 5]), pkbf(v[o + 6], v[o + 7])}); }
__device__ __forceinline__ void glds16(const void* gsrc, unsigned lds_dst) {
    unsigned keep;
    asm volatile("s_mov_b32 %0, m0\n\ts_mov_b32 m0, %2\n\ts_nop 0\n\tglobal_load_lds_dwordx4 %1, off\n\ts_mov_b32 m0, %0" : "=&s"(keep) : "v"(gsrc), "s"(lds_dst) : "memory");
}
__device__ __forceinline__ unsigned lds_addr(const LAS unsigned char* p) { return (unsigned)(uintptr_t)p; }
template <bool MASK, bool NEAR>
__device__ __forceinline__ void attn_soft(f32x16& p0, f32x16& p1, f32x2v& lacc, bf16x8 (&pa)[4], const LAS unsigned* mrec, int sbit) {
#pragma unroll
    for (int i = 0; i < 16; ++i) { p0[i] = __builtin_amdgcn_exp2f(p0[i]); p1[i] = __builtin_amdgcn_exp2f(p1[i]); }
    if (MASK) {
#pragma unroll
        for (int g = 0; g < 4; ++g) {
            const v4u w4 = *(const LAS v4u*)(mrec + 8 * g);
#pragma unroll
            for (int k = 0; k < 4; ++k) { int m0_, m1_; asm("v_bfe_i32 %0, %1, %2, 1" : "=v"(m0_) : "v"(w4[k]), "s"(sbit)); asm("v_bfe_i32 %0, %1, %2, 1" : "=v"(m1_) : "v"(w4[k]), "s"(sbit + 1));
                p0[4 * g + k] = __uint_as_float(__float_as_uint(p0[4 * g + k]) & (unsigned)m0_); p1[4 * g + k] = __uint_as_float(__float_as_uint(p1[4 * g + k]) & (unsigned)m1_); }
        }
    }
#pragma unroll
    for (int i = 0; i < 16; i += 2) { lacc += (f32x2v){p0[i], p0[i + 1]}; lacc += (f32x2v){p1[i], p1[i + 1]}; }
    pa[0] = pk16(p0, 0); pa[1] = pk16(p0, 8); pa[2] = pk16(p1, 0); pa[3] = pk16(p1, 8);
}
__device__ __forceinline__ void attn_pv(f32x16& o0, f32x16& o1, const bf16x8 (&pa)[4], const LAS unsigned char* Vb) {
#pragma unroll
    for (int ks = 0; ks < 4; ++ks) {
        o0 = __builtin_amdgcn_mfma_f32_32x32x16_bf16(pa[ks], cat8(vtr(Vb + ks * 1024), vtr(Vb + ks * 1024 + 512)), o0, 0, 0, 0);
        o1 = __builtin_amdgcn_mfma_f32_32x32x16_bf16(pa[ks], cat8(vtr(Vb + 4096 + ks * 1024), vtr(Vb + 4096 + ks * 1024 + 512)), o1, 0, 0, 0);
    }
}
template <bool NEAR>
__device__ __forceinline__ void attn_qk(f32x16& a0, f32x16& a1, f32x16& b0, f32x16& b1, const LAS unsigned char* Qb, const LAS unsigned char* Kb, const LAS float* bt) {
#pragma unroll
    for (int i = 0; i < 16; ++i) {
        if (NEAR) { a0[i] = bt[(i & 3) + 8 * (i >> 2)]; a1[i] = bt[32 + (i & 3) + 8 * (i >> 2)]; b0[i] = bt[(i & 3) + 8 * (i >> 2) - 32]; b1[i] = bt[(i & 3) + 8 * (i >> 2)]; }
        else { a0[i] = 0.f; a1[i] = 0.f; b0[i] = 0.f; b1[i] = 0.f; }
    }
#pragma unroll
    for (int d0 = 0; d0 < 4; ++d0) {
        const bf16x8 k0 = *(const LAS bf16x8*)(Kb + d0 * 2048), k1 = *(const LAS bf16x8*)(Kb + d0 * 2048 + 512);
        const bf16x8 qfa = *(const LAS bf16x8*)(Qb + d0 * 1024), qfb = *(const LAS bf16x8*)(Qb + 4096 + d0 * 1024);
        a0 = __builtin_amdgcn_mfma_f32_32x32x16_bf16(k0, qfa, a0, 0, 0, 0); a1 = __builtin_amdgcn_mfma_f32_32x32x16_bf16(k1, qfa, a1, 0, 0, 0);
        b0 = __builtin_amdgcn_mfma_f32_32x32x16_bf16(k0, qfb, b0, 0, 0, 0); b1 = __builtin_amdgcn_mfma_f32_32x32x16_bf16(k1, qfb, b1, 0, 0, 0);
    }
}
__device__ __forceinline__ void attn_store(const f32x16& o0, const f32x16& o1, f32x2v lacc, bf16* obase, LAS unsigned char* stg, LAS float* wsf, int lane) {
    const int r = lane & 31, hi = lane >> 5;
    float lsum = lacc[0] + lacc[1];
    lsum += __shfl_xor(lsum, 32);
    if (hi == 0) wsf[r] = lsum;
    LDS_WAIT(); asm volatile("" ::: "memory");
    LAS unsigned short* st = (LAS unsigned short*)stg;
#pragma unroll
    for (int i = 0; i < 16; ++i) {
        const int q = crow(i, hi); const float rl = 1.0f / wsf[q];
        st[q * 72 + r] = (unsigned short)(pkbf(o0[i] * rl, 0.f) & 0xffffu); st[q * 72 + 32 + r] = (unsigned short)(pkbf(o1[i] * rl, 0.f) & 0xffffu);
    }
    LDS_WAIT(); asm volatile("" ::: "memory");
#pragma unroll
    for (int k = 0; k < 4; ++k) { const int row = 8 * k + (lane >> 3), ch = lane & 7;
        const v4u v = *(const LAS v4u*)(stg + row * 144 + ch * 16); *(v4u*)(obase + (size_t)row * DM + ch * 8) = v; }
    LDS_WAIT(); asm volatile("" ::: "memory");
}
template <bool MASK>
__device__ __forceinline__ void attn_chunk(const Frame& F, int b, int c, LAS unsigned char* lds) {
    const int wid = F.wave, lane = F.lane, r = lane & 31, hi = lane >> 5;
    const size_t rowbase = (size_t)b * SEQ; const int q0 = 64 * c, nt = c + 1;
    const LAS unsigned char* Qb = lds + AT_Q + wid * 8192 + lane * 16;
#pragma unroll
    for (int d0 = 0; d0 < 4; ++d0) {
        *(LAS bf16x8*)(lds + AT_Q + wid * 8192 + d0 * 1024 + lane * 16) = *(const bf16x8*)(F.QA() + (rowbase + q0 + r) * 512 + wid * 64 + 16 * d0 + 8 * hi);
        *(LAS bf16x8*)(lds + AT_Q + wid * 8192 + 4096 + d0 * 1024 + lane * 16) = *(const bf16x8*)(F.QA() + (rowbase + q0 + 32 + r) * 512 + wid * 64 + 16 * d0 + 8 * hi); }
    const LAS float* BT = (const LAS float*)(lds + AT_BT) + wid * 256;
    const bf16* ksrc = F.KA() + (rowbase + lane) * 64 + 8 * wid;
    const bf16* vsrc = F.VA() + (rowbase + 16 * (wid & 3) + (lane >> 2)) * 64 + (wid >> 2) * 32 + (lane & 3) * 8;
    const LAS unsigned* mreca = (const LAS unsigned*)(lds + P2_MASK) + r * MP_STRIDE + 4 * hi; const LAS unsigned* mrecb = mreca + 32 * MP_STRIDE;
    const int voff = ((lane >> 4) & 1) * 32 + (lane & 3) * 8 + (4 * hi + ((lane & 15) >> 2)) * 64;
    f32x16 oa0, oa1, ob0, ob1; f32x2v la = {0.f, 0.f}, lb = {0.f, 0.f};
#pragma unroll
    for (int i = 0; i < 16; ++i) { oa0[i] = 0.f; oa1[i] = 0.f; ob0[i] = 0.f; ob1[i] = 0.f; }
#define AT_BAR() do { __builtin_amdgcn_sched_barrier(0); asm volatile("s_waitcnt lgkmcnt(0)" ::: "memory"); __builtin_amdgcn_s_barrier(); asm volatile("" ::: "memory"); __builtin_amdgcn_sched_barrier(0); } while (0)
#define AT_DMA(t_, slot_) do { const int tn_ = (t_) < nt ? (t_) : nt - 1;     \
        glds16(ksrc + (size_t)tn_ * 64 * 64, (unsigned)__builtin_amdgcn_readfirstlane((int)lds_addr(lds + AT_K + (slot_) * 8192 + wid * 1024))); \
        glds16(vsrc + (size_t)tn_ * 64 * 64, (unsigned)__builtin_amdgcn_readfirstlane((int)lds_addr(lds + AT_V + (slot_) * 8192 + wid * 1024))); } while (0)
    AT_DMA(0, 0); AT_DMA(1, 1); AT_DMA(2, 2);
    asm volatile("s_waitcnt vmcnt(0)" ::: "memory");
    AT_BAR();
    if (wid >= 4) AT_BAR();
    const int nfar = c >= 2 ? c - 2 : 0;
#if defined(PROBE_TIMER) && PROBE_TIMER == 3
    const unsigned long long pa0_ = __builtin_amdgcn_s_memtime();
#endif
    f32x16 a0, a1, b0, b1; bf16x8 pa[4], pb[4];
#if defined(PROBE_TIMER) && PROBE_TIMER >= 4
    unsigned psum_ = 0u;
#endif
    {
        const LAS unsigned char* Kb = lds + AT_K + hi * 1024 + r * 16; const LAS float* bt = BT + (64 * (0 - c) + 191 - r + 4 * hi);
        if (0 < nfar) attn_qk<false>(a0, a1, b0, b1, Qb, Kb, bt); else attn_qk<true>(a0, a1, b0, b1, Qb, Kb, bt);
        AT_BAR();
    }
#pragma unroll 1
    for (int t = 0; t < nt; ++t) {
        const int pl_ = (t >> 4) * MP_PLANE, sbit = (2 * t) & 31;
#ifdef NOSOFT
        { const bf16x8 c_ = {0x3c00, 0x3c00, 0x3c00, 0x3c00, 0x3c00, 0x3c00, 0x3c00, 0x3c00}; pa[0] = c_; pa[1] = c_; pa[2] = c_; pa[3] = c_; pb[0] = c_; pb[1] = c_; pb[2] = c_; pb[3] = c_; la += (f32x2v){a0[0], b0[0]}; }
#else
#if defined(PROBE_TIMER) && PROBE_TIMER == 4
        __builtin_amdgcn_sched_barrier(0); const unsigned long long pv0_ = __builtin_amdgcn_s_memtime(); __builtin_amdgcn_sched_barrier(0);
#endif
        attn_soft<MASK, false>(a0, a1, la, pa, mreca + pl_, sbit);
        attn_soft<MASK, false>(b0, b1, lb, pb, mrecb + pl_, sbit);
#if defined(PROBE_TIMER) && PROBE_TIMER == 4
        __builtin_amdgcn_sched_barrier(0); asm volatile("s_nop 0" : : "v"(pa[0]), "v"(pa[1]), "v"(pa[2]), "v"(pa[3]), "v"(pb[0]), "v"(pb[1]), "v"(pb[2]), "v"(pb[3]), "v"(la), "v"(lb)); psum_ += (unsigned)(__builtin_amdgcn_s_memtime() - pv0_); __builtin_amdgcn_sched_barrier(0);
#endif
#endif
#if defined(PROBE_TIMER) && PROBE_TIMER == 6
        __builtin_amdgcn_sched_barrier(0); asm volatile("s_nop 0" : : "v"(pa[0]), "v"(pa[3]), "v"(pb[0]), "v"(pb[3]), "v"(la), "v"(lb)); const unsigned long long pw0_ = __builtin_amdgcn_s_memtime();
#endif
        AT_BAR();
#if defined(PROBE_TIMER) && PROBE_TIMER == 6
        psum_ += (unsigned)(__builtin_amdgcn_s_memtime() - pw0_);
#endif
#if defined(PROBE_TIMER) && PROBE_TIMER == 5
        const unsigned long long pm0_ = __builtin_amdgcn_s_memtime();
#endif
        AT_DMA(t + 3, (t + 3) & 3);
        const LAS unsigned char* Vb = lds + AT_V + (t & 3) * 8192 + voff;
#pragma unroll
        for (int ks = 0; ks < 4; ++ks) {
            const bf16x8 v0 = cat8(vtr(Vb + ks * 1024), vtr(Vb + ks * 1024 + 512)), v1 = cat8(vtr(Vb + 4096 + ks * 1024), vtr(Vb + 4096 + ks * 1024 + 512));
            oa0 = __builtin_amdgcn_mfma_f32_32x32x16_bf16(pa[ks], v0, oa0, 0, 0, 0); ob0 = __builtin_amdgcn_mfma_f32_32x32x16_bf16(pb[ks], v0, ob0, 0, 0, 0);
            oa1 = __builtin_amdgcn_mfma_f32_32x32x16_bf16(pa[ks], v1, oa1, 0, 0, 0); ob1 = __builtin_amdgcn_mfma_f32_32x32x16_bf16(pb[ks], v1, ob1, 0, 0, 0);
        }
        if (t + 1 < nt) {
            const LAS unsigned char* Kb = lds + AT_K + ((t + 1) & 3) * 8192 + hi * 1024 + r * 16; const LAS float* bt = BT + (64 * (t + 1 - c) + 191 - r + 4 * hi);
            if (t + 1 < nfar) attn_qk<false>(a0, a1, b0, b1, Qb, Kb, bt); else attn_qk<true>(a0, a1, b0, b1, Qb, Kb, bt);
        }
#if defined(PROBE_TIMER) && PROBE_TIMER == 5
        asm volatile("s_nop 15\n\ts_nop 15" : : "v"(oa0), "v"(ob1), "v"(a0), "v"(b1)); psum_ += (unsigned)(__builtin_amdgcn_s_memtime() - pm0_);
#endif
#if defined(PROBE_TIMER) && PROBE_TIMER == 7
        __builtin_amdgcn_sched_barrier(0); asm volatile("s_nop 15\n\ts_nop 15" : : "v"(oa0), "v"(ob1), "v"(a0), "v"(b1)); const unsigned long long px0_ = __builtin_amdgcn_s_memtime();
#endif
        asm volatile("s_waitcnt vmcnt(2)" ::: "memory");
        AT_BAR();
#if defined(PROBE_TIMER) && PROBE_TIMER == 7
        psum_ += (unsigned)(__builtin_amdgcn_s_memtime() - px0_);
#endif
    }
#if defined(PROBE_TIMER) && PROBE_TIMER >= 4
    if (F.tid == 0 && nt >= 16) { volatile LAS unsigned* pm_ = (volatile LAS unsigned*)(lds + MISC_OFF); pm_[16] += psum_; pm_[17] += (unsigned)nt; }
#endif
#if defined(PROBE_TIMER) && PROBE_TIMER == 3
    if (F.tid == 0 && nt >= 16) { volatile LAS unsigned* pm_ = (volatile LAS unsigned*)(lds + MISC_OFF); pm_[16] += (unsigned)(__builtin_amdgcn_s_memtime() - pa0_); pm_[17] += (unsigned)nt; }
#endif
    asm volatile("s_waitcnt vmcnt(0)" ::: "memory");
    if (wid < 4) AT_BAR();
    AT_BAR();
#undef AT_BAR
#undef AT_DMA
    LAS float* wsf = (LAS float*)(lds + AT_WS) + wid * 64; LAS unsigned char* stg = lds + AT_OST + wid * 4608;
    attn_store(oa0, oa1, la, F.MIX() + (rowbase + q0) * DM + wid * 64, stg, wsf, lane);
    attn_store(ob0, ob1, lb, F.MIX() + (rowbase + q0 + 32) * DM + wid * 64, stg, wsf, lane);
}
__device__ __forceinline__ void attn_unit(const Frame& F, int b, int c, LAS unsigned char* lds) {
    if (c >= 4) {
        const int nj = c + 1;
        IdxOps ops; idx_fetch(ops, F, b, c, 0);
#if defined(PROBE_TIMER) && PROBE_TIMER >= 10
        unsigned ps_ = 0u;
#define PT0_(k) unsigned long long pt_##k = 0; if (PROBE_TIMER == (k)) { __builtin_amdgcn_sched_barrier(0); pt_##k = __builtin_amdgcn_s_memtime(); __builtin_amdgcn_sched_barrier(0); }
#define PT1_(k) if (PROBE_TIMER == (k)) { __builtin_amdgcn_sched_barrier(0); ps_ += (unsigned)(__builtin_amdgcn_s_memtime() - pt_##k); __builtin_amdgcn_sched_barrier(0); }
#else
#define PT0_(k)
#define PT1_(k)
#endif
        for (int rq = 0; rq < ((MIXREP & 2) ? 8 : 4); ++rq) {
            PT0_(10)
            idx_round(ops, F, b, c, lds);
            idx_fetch(ops, F, b, c, (rq + 1) & 3);
            asm volatile("s_waitcnt lgkmcnt(0)" ::: "memory");
            PT1_(10)
            PT0_(11)
            __syncthreads();
            PT1_(11)
            PT0_(12)
            select_rows32((const LAS unsigned*)(lds + P2_SC), (LAS unsigned*)(lds + P2_MASK), rq & 3, nj, F.wave, F.lane);
            asm volatile("s_waitcnt lgkmcnt(0)" ::: "memory");
            PT1_(12)
            PT0_(13)
            __syncthreads();
            PT1_(13)
        }
#if defined(PROBE_TIMER) && PROBE_TIMER >= 10
        if (F.tid == 0 && c >= 15) { volatile LAS unsigned* pm_ = (volatile LAS unsigned*)(lds + MISC_OFF); pm_[16] += ps_; pm_[17] += 4u; }
#endif
#undef PT0_
#undef PT1_
    }
    { const f32x4 v = *(const f32x4*)(F.BT() + F.tid * 4); *(LAS f32x4*)(lds + AT_BT + F.tid * 16) = v; }
    __syncthreads();
    if (c >= 4) attn_chunk<true>(F, b, c, lds); else attn_chunk<false>(F, b, c, lds);
}

constexpr int RT_TAB = 131072;
__device__ __forceinline__ void ret_stage(const bf16* vsrc, const bf16* ksrc, LAS unsigned char* region) {
#pragma unroll
    for (int k = 0; k < 8; ++k) {
        const size_t o = (size_t)(16 * (k & 3)) * 512 + 32 * (k >> 2);
        __builtin_amdgcn_global_load_lds((const unsigned*)(vsrc + o), (LAS unsigned*)(region + k * 1024), 16, 0, 0);
        __builtin_amdgcn_global_load_lds((const unsigned*)(ksrc + o), (LAS unsigned*)(region + 8192 + k * 1024), 16, 0, 0);
    }
}
__device__ __forceinline__ void ret_kv(f32x16 (&T)[2][2], const LAS unsigned char* img) {
#pragma unroll
    for (int ks = 0; ks < 4; ++ks) {
        const bf16x8 k0 = cat8(vtr(img + 8192 + ks * 1024), vtr(img + 8192 + ks * 1024 + 512)), k1 = cat8(vtr(img + 8192 + 4096 + ks * 1024), vtr(img + 8192 + 4096 + ks * 1024 + 512));
        const bf16x8 v0 = cat8(vtr(img + ks * 1024), vtr(img + ks * 1024 + 512)), v1 = cat8(vtr(img + 4096 + ks * 1024), vtr(img + 4096 + ks * 1024 + 512));
        T[0][0] = __builtin_amdgcn_mfma_f32_32x32x16_bf16(k0, v0, T[0][0], 0, 0, 0); T[0][1] = __builtin_amdgcn_mfma_f32_32x32x16_bf16(k0, v1, T[0][1], 0, 0, 0);
        T[1][0] = __builtin_amdgcn_mfma_f32_32x32x16_bf16(k1, v0, T[1][0], 0, 0, 0); T[1][1] = __builtin_amdgcn_mfma_f32_32x32x16_bf16(k1, v1, T[1][1], 0, 0, 0);
    }
}
__device__ __forceinline__ void ret_unit(const Frame& F, int b, int h, LAS unsigned char* lds) {
    const int lane = F.lane, w = F.wave, r = lane & 31, hi = lane >> 5;
    const float gam = 1.0f - exp2f(-5.0f - (float)h), lg2 = log2f(gam), cd = exp2f(64.0f * lg2), cd4 = exp2f(256.0f * lg2);
    LAS unsigned char* region = lds + w * 16384;
    const LAS unsigned char* img = region + ((lane >> 4) & 1) * 32 + (lane & 3) * 8 + (4 * hi + ((lane & 15) >> 2)) * 64;
    LAS float* tab = (LAS float*)(lds + RT_TAB);
    __syncthreads();
    if (F.tid < 128) tab[F.tid] = F.tid < 64 ? F.ret_gn_w()[h * 64 + F.tid] : F.ret_gn_b()[h * 64 + F.tid - 64];
    const size_t hbase = (size_t)b * SEQ * 512 + h * 64;
    const size_t stg = hbase + (size_t)(lane >> 2) * 512 + (lane & 3) * 8;
    f32x16 T[2][2];
#pragma unroll
    for (int i = 0; i < 16; ++i) { T[0][0][i] = 0.f; T[0][1][i] = 0.f; T[1][0][i] = 0.f; T[1][1][i] = 0.f; }
#pragma unroll 1
    for (int i = 0; i < 4; ++i) {
        const size_t co = (size_t)(4 * w + i) * 64 * 512;
        ret_stage(F.VB() + stg + co, F.KB() + stg + co, region);
        if (i) {
#pragma unroll
            for (int k = 0; k < 16; ++k) { T[0][0][k] *= cd; T[0][1][k] *= cd; T[1][0][k] *= cd; T[1][1][k] *= cd; }
        }
        asm volatile("s_waitcnt vmcnt(0)" ::: "memory");
        ret_kv(T, img);
        LDS_WAIT();
    }
#pragma unroll
    for (int eb = 0; eb < 2; ++eb)
#pragma unroll
        for (int db = 0; db < 2; ++db)
#pragma unroll
            for (int g = 0; g < 4; ++g) *(LAS f32x4*)(region + ((eb * 2 + db) * 4 + g) * 1024 + lane * 16) = (f32x4){T[eb][db][4 * g], T[eb][db][4 * g + 1], T[eb][db][4 * g + 2], T[eb][db][4 * g + 3]};
    __syncthreads();
#pragma unroll
    for (int i = 0; i < 16; ++i) { T[0][0][i] = 0.f; T[0][1][i] = 0.f; T[1][0][i] = 0.f; T[1][1][i] = 0.f; }
#pragma unroll 1
    for (int wp = 0; wp < w; ++wp) {
        const LAS unsigned char* src = lds + wp * 16384 + lane * 16;
#pragma unroll
        for (int eb = 0; eb < 2; ++eb)
#pragma unroll
            for (int db = 0; db < 2; ++db)
#pragma unroll
                for (int g = 0; g < 4; ++g) { const f32x4 v = *(const LAS f32x4*)(src + ((eb * 2 + db) * 4 + g) * 1024);
                    T[eb][db][4 * g] = T[eb][db][4 * g] * cd4 + v[0]; T[eb][db][4 * g + 1] = T[eb][db][4 * g + 1] * cd4 + v[1]; T[eb][db][4 * g + 2] = T[eb][db][4 * g + 2] * cd4 + v[2]; T[eb][db][4 * g + 3] = T[eb][db][4 * g + 3] * cd4 + v[3]; }
    }
    __syncthreads();
#pragma unroll 1
    for (int i = 0; i < 4; ++i) {
        const int n = 4 * w + i; const size_t co = (size_t)n * 64 * 512;
        ret_stage(F.VB() + stg + co, F.KB() + stg + co, region);
#pragma unroll
        for (int k = 0; k < 16; ++k) { T[0][0][k] *= cd; T[0][1][k] *= cd; T[1][0][k] *= cd; T[1][1][k] *= cd; }
        const bf16* qrow = F.QB() + hbase + co + (size_t)r * 512 + 8 * hi;
        const bf16* krow = F.KB() + hbase + co + (size_t)r * 512 + 8 * hi;
#pragma unroll 1
        for (int ib = 0; ib < 2; ++ib) {
            bf16x8 qf[4], kf[4];
#pragma unroll
            for (int s = 0; s < 4; ++s) { qf[s] = *(const bf16x8*)(qrow + (size_t)(32 * ib) * 512 + 16 * s); kf[s] = *(const bf16x8*)(krow + 16 * s); }
            const size_t tok = (size_t)b * SEQ + 64 * n + 32 * ib + r;
            const bf16* grow = F.GB() + tok * 512 + h * 64 + 4 * hi;
            v2u gq[2][4];
#pragma unroll
            for (int db = 0; db < 2; ++db)
#pragma unroll
                for (int g = 0; g < 4; ++g) gq[db][g] = *(const v2u*)(grow + 32 * db + 8 * g);
            f32x16 s0, s1;
#pragma unroll
            for (int k = 0; k < 16; ++k) { s0[k] = 0.f; s1[k] = 0.f; }
#pragma unroll
            for (int s = 0; s < 4; ++s) s0 = __builtin_amdgcn_mfma_f32_32x32x16_bf16(kf[s], qf[s], s0, 0, 0, 0);
            if (ib == 1) {
#pragma unroll
                for (int s = 0; s < 4; ++s) kf[s] = *(const bf16x8*)(krow + (size_t)32 * 512 + 16 * s);
#pragma unroll
                for (int s = 0; s < 4; ++s) s1 = __builtin_amdgcn_mfma_f32_32x32x16_bf16(kf[s], qf[s], s1, 0, 0, 0);
#pragma unroll
                for (int k = 0; k < 16; ++k) s1[k] = (r >= crow(k, hi)) ? s1[k] : 0.f;
            } else {
#pragma unroll
                for (int k = 0; k < 16; ++k) s0[k] = (r >= crow(k, hi)) ? s0[k] : 0.f;
            }
#pragma unroll
            for (int s = 0; s < 4; ++s) {
                v4u q4 = __builtin_bit_cast(v4u, qf[s]);
                auto x0 = __builtin_amdgcn_permlane32_swap(q4[0], q4[2], false, false); auto x1 = __builtin_amdgcn_permlane32_swap(q4[1], q4[3], false, false);
                q4[0] = x0[0]; q4[2] = x0[1]; q4[1] = x1[0]; q4[3] = x1[1];
                qf[s] = __builtin_bit_cast(bf16x8, q4);
            }
            asm volatile("s_waitcnt vmcnt(0)" ::: "memory");
            f32x16 y0, y1;
#pragma unroll
            for (int k = 0; k < 16; ++k) { y0[k] = 0.f; y1[k] = 0.f; }
#pragma unroll
            for (int eb = 0; eb < 2; ++eb)
#pragma unroll
                for (int s2 = 0; s2 < 2; ++s2) {
                    y0 = __builtin_amdgcn_mfma_f32_32x32x16_bf16(pk16(T[eb][0], 8 * s2), qf[2 * eb + s2], y0, 0, 0, 0);
                    y1 = __builtin_amdgcn_mfma_f32_32x32x16_bf16(pk16(T[eb][1], 8 * s2), qf[2 * eb + s2], y1, 0, 0, 0);
                }
#pragma unroll
            for (int ks = 0; ks < 2; ++ks) {
                const bf16x8 pb = pk16(s0, 8 * ks);
                y0 = __builtin_amdgcn_mfma_f32_32x32x16_bf16(cat8(vtr(img + ks * 1024), vtr(img + ks * 1024 + 512)), pb, y0, 0, 0, 0);
                y1 = __builtin_amdgcn_mfma_f32_32x32x16_bf16(cat8(vtr(img + 4096 + ks * 1024), vtr(img + 4096 + ks * 1024 + 512)), pb, y1, 0, 0, 0);
            }
            if (ib == 1) {
#pragma unroll
                for (int ks = 0; ks < 2; ++ks) {
                    const bf16x8 pb = pk16(s1, 8 * ks);
                    y0 = __builtin_amdgcn_mfma_f32_32x32x16_bf16(cat8(vtr(img + (2 + ks) * 1024), vtr(img + (2 + ks) * 1024 + 512)), pb, y0, 0, 0, 0);
                    y1 = __builtin_amdgcn_mfma_f32_32x32x16_bf16(cat8(vtr(img + 4096 + (2 + ks) * 1024), vtr(img + 4096 + (2 + ks) * 1024 + 512)), pb, y1, 0, 0, 0);
                }
            }
            float sm = 0.f;
#pragma unroll
            for (int k = 0; k < 16; ++k) sm += y0[k] + y1[k];
            sm += __shfl_xor(sm, 32);
            const float mean = sm * (1.0f / 64.0f); float vr = 0.f;
#pragma unroll
            for (int k = 0; k < 16; ++k) { y0[k] -= mean; y1[k] -= mean; vr += y0[k] * y0[k] + y1[k] * y1[k]; }
            vr += __shfl_xor(vr, 32);
            const float rstd = 1.0f / sqrtf(vr * (1.0f / 64.0f) + 1e-5f);
            bf16* orow = F.MIX() + tok * DM + 512 + h * 64 + 4 * hi;
#pragma unroll
            for (int g = 0; g < 4; ++g) {
                const f32x4 w0 = *(const LAS f32x4*)(tab + 8 * g + 4 * hi), b0 = *(const LAS f32x4*)(tab + 64 + 8 * g + 4 * hi), w1 = *(const LAS f32x4*)(tab + 32 + 8 * g + 4 * hi), b1 = *(const LAS f32x4*)(tab + 96 + 8 * g + 4 * hi);
                const v2u g0 = gq[0][g], g1 = gq[1][g];
                *(v2u*)(orow + 8 * g) = (v2u){pkbf((y0[4 * g] * rstd * w0[0] + b0[0]) * bflo(g0[0]), (y0[4 * g + 1] * rstd * w0[1] + b0[1]) * bfhi(g0[0])),
                                              pkbf((y0[4 * g + 2] * rstd * w0[2] + b0[2]) * bflo(g0[1]), (y0[4 * g + 3] * rstd * w0[3] + b0[3]) * bfhi(g0[1]))};
                *(v2u*)(orow + 32 + 8 * g) = (v2u){pkbf((y1[4 * g] * rstd * w1[0] + b1[0]) * bflo(g1[0]), (y1[4 * g + 1] * rstd * w1[1] + b1[1]) * bfhi(g1[0])),
                                                   pkbf((y1[4 * g + 2] * rstd * w1[2] + b1[2]) * bflo(g1[1]), (y1[4 * g + 3] * rstd * w1[3] + b1[3]) * bfhi(g1[1]))};
            }
        }
        ret_kv(T, img);
        LDS_WAIT();
    }
}
#ifndef GEMM_ALIGN
#define GEMM_ALIGN true
#endif
#ifndef GEMM_SP2
#define GEMM_SP2 true
#endif
#ifndef RETREP
#define RETREP 1
#endif
#ifndef ATTREP
#define ATTREP 1
#endif
constexpr int CW_Q = 12288;
constexpr int NG_ATT = 32, NG_RET = 8, NG_MIX = NG_ATT + NG_RET;
__device__ __forceinline__ void p2_mixers(Frame& F) {
    for (;;) {
        int mo_ = MISC_OFF; asm volatile("" : "+s"(mo_));
        volatile LAS unsigned* misc = (volatile LAS unsigned*)(F.lds + mo_);
        __syncthreads();
        if (F.tid == 0) misc[0] = __hip_atomic_fetch_add(F.ctl + CW_Q + 64 * F.grp, 1u, __ATOMIC_RELAXED, __HIP_MEMORY_SCOPE_AGENT);
        __syncthreads();
        const int u = (int)misc[0];
        if (u >= NG_MIX) break;
        { int w_ = F.wave; asm volatile("" : "+s"(w_)); F.wave = w_; int l_ = lane_id(); asm volatile("" : "+v"(l_)); F.lane = l_; F.tid = w_ * 64 + l_; }
        static constexpr unsigned char ORDER[NG_MIX] = {24, 30, 23, 26, 25, 35, 32, 20, 34, 21, 33, 22, 16, 28, 38, 29, 18, 36, 14, 39, 27, 4, 13, 19, 37, 8, 31, 6, 5, 17, 15, 11, 12, 10, 9, 7, 3, 2, 1, 0};
        const int e = __builtin_amdgcn_readfirstlane((int)ORDER[u]);
        if (e < 32) attn_unit(F, F.grp, e, F.lds); else ret_unit(F, F.grp, e - 32, F.lds);
    }
#if defined(PROBE_TIMER) && PROBE_TIMER >= 3
    if (blockIdx.x == 7 && F.tid == 0) { volatile LAS unsigned* pm_ = (volatile LAS unsigned*)(F.lds + MISC_OFF); const float val = ((float)pm_[16] / (float)(pm_[17] ? pm_[17] : 1u)) / 8000.0f;
        F.ctl[64] = __float_as_uint(0.05f + 0.5f * floorf(fminf(fmaxf(val, 0.f), 1.f) * 8.0f + 0.5f) * 0.125f); }
#endif
}

typedef __attribute__((address_space(1))) unsigned gu32;
#define XB_TMO      128
#define XB_XCNT(j)  (256  + 64 * (j))
#define XB_XSUB(j)  (1280 + 64 * (j))
#define XB_XGEN(j)  (2304 + 64 * (j))
#define XB_TOP      3328
#define XB_TOPGEN   3392
#define XCD_BAR_WORDS 3456
#define XB_SPIN_CAP (1u << 18)

__device__ __forceinline__ unsigned xb_ld(unsigned* p)              { return __hip_atomic_load(p, __ATOMIC_RELAXED, __HIP_MEMORY_SCOPE_AGENT); }
__device__ __forceinline__ unsigned xb_add(unsigned* p, unsigned v) { return __hip_atomic_fetch_add(p, v, __ATOMIC_RELAXED, __HIP_MEMORY_SCOPE_AGENT); }
__device__ __forceinline__ unsigned xb_xcc_id() { return (unsigned)__builtin_amdgcn_s_getreg((3 << 11) | 20) & 0xFu; }
#define XB_SPIN(cond, bar) do { unsigned _sp = 0; while (cond) { __builtin_amdgcn_s_sleep(1); \
    if ((++_sp & 255u) == 0u) { if (xb_ld(&(bar)[XB_TMO])) break; if (_sp > XB_SPIN_CAP) { atomicAdd(&(bar)[XB_TMO], 1u); break; } } } } while (0)

struct XcdBarrier {
    unsigned* bar; unsigned x; int wv;
    volatile LAS unsigned* st;
};

__device__ __forceinline__ XcdBarrier xcd_barrier_post(unsigned* bar, volatile LAS unsigned* st, int wv_) {
    XcdBarrier b; b.bar = bar; b.x = xb_xcc_id(); b.st = st; b.wv = 0;
    if (wv_ == 0 && lane_id() == 0) { st[2] = xb_add(&bar[XB_XCNT(b.x)], 1u); st[3] = b.x; }
    return b;
}
__device__ __forceinline__ void xcd_barrier_complete(unsigned* bar, unsigned x, unsigned& nloc, unsigned& nx, unsigned& even) {
    const unsigned G = gridDim.x * gridDim.y * gridDim.z;
    unsigned sum, cnt, mine, sp = 0u, ev;
    for (;;) {
        sum = 0u; cnt = 0u; mine = 0u; ev = 1u;
#pragma unroll
        for (unsigned j = 0; j < 16; ++j) { const unsigned c = xb_ld(&bar[XB_XCNT(j)]); sum += c; cnt += (c > 0u) ? 1u : 0u; mine = (j == x) ? c : mine; ev &= (c == (j < 8u ? 32u : 0u)) ? 1u : 0u; }
        even = ev;
        if (sum == G) break;
        __builtin_amdgcn_s_sleep(1);
        if ((++sp & 255u) == 0u) { if (xb_ld(&bar[XB_TMO])) break; if (sp > XB_SPIN_CAP) { atomicAdd(&bar[XB_TMO], 1u); break; } }
    }
    nloc = mine > 0u ? mine : 1u; nx = cnt > 0u ? cnt : 1u;
}

__device__ __forceinline__ void xcd_barrier(const XcdBarrier& b) {
    asm volatile("s_waitcnt vmcnt(0)" ::: "memory");
    __syncthreads();
    if (b.wv == 0 && lane_id() == 0) {
        unsigned* bar = b.bar;
        __builtin_amdgcn_s_waitcnt(0);
        unsigned nloc = b.st[0], nx = b.st[1];
        if (nloc == 0u) { unsigned ev_; xcd_barrier_complete(bar, b.x, nloc, nx, ev_); b.st[0] = nloc; b.st[1] = nx; b.st[4] = ev_; }
        const unsigned old = xb_add(&bar[XB_XSUB(b.x)], 1u);
        const unsigned gen = old / nloc;
        if (old + 1u == (gen + 1u) * nloc) {
            __builtin_amdgcn_fence(__ATOMIC_RELEASE, "agent");
            asm volatile("s_waitcnt vmcnt(0)" ::: "memory");
            const unsigned og = xb_add(&bar[XB_TOP], 1u);
            const unsigned tg = og / nx;
            if (og + 1u == (tg + 1u) * nx) xb_add(&bar[XB_TOPGEN], 1u);
            else XB_SPIN(xb_ld(&bar[XB_TOPGEN]) == tg, bar);
            __builtin_amdgcn_fence(__ATOMIC_ACQUIRE, "agent");
            xb_add(&bar[XB_XGEN(b.x)], 1u);
            asm volatile("s_waitcnt vmcnt(0)" ::: "memory");
        } else {
            XB_SPIN(xb_ld(&bar[XB_XGEN(b.x)]) == gen, bar);
            __builtin_amdgcn_fence(__ATOMIC_ACQUIRE, "agent");
            asm volatile("s_waitcnt vmcnt(0)" ::: "memory");
        }
    }
    __syncthreads();
}

constexpr int CW_GB = 8192;
__device__ __forceinline__ void grp_barrier(unsigned* ctl, int g, bool phys, int wave) {
    asm volatile("s_waitcnt vmcnt(0)" ::: "memory");
    __syncthreads();
    if (wave == 0 && lane_id() == 0) {
        unsigned* bar = ctl + 4096; unsigned* sub = ctl + CW_GB + 64 * g; unsigned* genw = ctl + CW_GB + 64 * (32 + g);
        __builtin_amdgcn_s_waitcnt(0);
        if (!phys) { __builtin_amdgcn_fence(__ATOMIC_RELEASE, "agent"); asm volatile("s_waitcnt vmcnt(0)" ::: "memory"); }
        const unsigned old = xb_add(sub, 1u), gen = old / 8u;
        if (old + 1u == (gen + 1u) * 8u) xb_add(genw, 1u);
        else XB_SPIN(xb_ld(genw) == gen, bar);
        __builtin_amdgcn_fence(__ATOMIC_ACQUIRE, "agent");
        asm volatile("s_waitcnt vmcnt(0)" ::: "memory");
    }
    __syncthreads();
}
struct BatchOrder {
    int m0, nN, rk;
    __device__ __forceinline__ bool next(int i, pg8::Unit& u) const { const int L = 8 * i + rk; if (L >= 8 * nN) return false; const int mp = L / (2 * nN), t = L - mp * 2 * nN; u.pm = m0 + 2 * mp + (t & 1); u.pn = t >> 1; return true; }
    __device__ __forceinline__ void a_ready(const pg8::Unit&) const {}
    __device__ __forceinline__ void done(const pg8::Unit&) const {}
};

constexpr int CW_BAR = 4096;
constexpr size_t CTL_ZERO_BYTES = 65536;
typedef KArgs Args;
__global__ void __launch_bounds__(NTHR, 2) fwd_kernel(Args args) {
    extern __shared__ __attribute__((aligned(16))) unsigned char lds[];
    Frame F;
    F.lds = (LAS unsigned char*)lds;
    F.wave = __builtin_amdgcn_readfirstlane((int)threadIdx.x >> 6); F.lane = lane_id(); F.tid = F.wave * 64 + F.lane;
    F.G = gridDim.x; { const int bx = blockIdx.x; F.vcu = (F.G % 8 == 0) ? (bx % 8) * (F.G / 8) + bx / 8 : bx; }
    unsigned char* ws = args.ws;
    F.ctl = (unsigned*)(ws + WS_CTL);
    F.ap = (const __attribute__((address_space(4))) KArgs*)__builtin_amdgcn_kernarg_segment_ptr();
    F.ws = ws;
    const int lo = args.ph_lo, hi = args.ph_hi;
    for (int u_ = F.tid; u_ < 64; u_ += NTHR) ((LAS unsigned*)(F.lds + MISC_OFF))[u_] = 0u;
    __syncthreads();
    XcdBarrier bar; bar.bar = F.ctl + CW_BAR; bar.x = 0; bar.st = nullptr; bar.wv = F.wave;
    if (hi - lo > 1) { bar = xcd_barrier_post(F.ctl + CW_BAR, (volatile LAS unsigned*)(F.lds + MISC_OFF) + 8, F.wave); bar.wv = F.wave; }
#define IN(k) (lo <= (k) && (k) < hi)
#ifndef STAGGER
#define STAGGER 0
#endif
    if (IN(0)) { asm volatile("" : "+s"(F.ws), "+s"(F.ap)); F.lane = lane_id(); F.tid = F.wave * 64 + F.lane; p0_prologue(F); }
    if (IN(0) && IN(1)) { if (lo < 0) cg::this_grid().sync(); else xcd_barrier(bar); }
    bool phys = false; F.grp = (int)blockIdx.x & 31; F.rk = (int)blockIdx.x >> 5;
    if (hi - lo > 1) { volatile LAS unsigned* st = (volatile LAS unsigned*)(F.lds + MISC_OFF) + 8;
        if (st[4] == 1u && F.G == 256) { phys = true; F.grp = 4 * (int)st[3] + ((int)st[2] >> 3); F.rk = (int)st[2] & 7; } }
    F.grp = __builtin_amdgcn_readfirstlane(F.grp) & 31; F.rk = __builtin_amdgcn_readfirstlane(F.rk) & 7;
#define GSEAM(k) do { if (IN(k) && IN((k) + 1)) grp_barrier(F.ctl, F.grp, phys, F.wave); } while (0)
#if STAGGER > 0
    if (hi - lo > 1) for (int i_ = 0; i_ < (F.grp & 3) * STAGGER; ++i_) __builtin_amdgcn_s_sleep(32);
#endif
    if (IN(1)) { asm volatile("" : "+s"(F.ws), "+s"(F.ap)); F.lane = lane_id(); F.tid = F.wave * 64 + F.lane;
        pg8::Gemm g{F.XB(), F.WIN(), MTOK, NIN, DM}; BatchOrder S{8 * F.grp, NIN / 256, F.rk};
        pg8::EpiIn E{F.QA(), F.KA(), F.VA(), F.IQ(), F.IK(), F.QB(), F.KB(), F.VB(), F.GB(), F.IW(), F.q_norm_w(), F.k_norm_w(), (LAS float*)(F.lds + XCH_OFF)};
        pg8::gemm_phase<pg8::EpiIn, BatchOrder, GEMM_ALIGN, GEMM_SP2>(F.lds, g, S, E, F.wave);
    }
    GSEAM(1);
    if (IN(2)) { asm volatile("" : "+s"(F.ws), "+s"(F.ap)); F.lane = lane_id(); F.tid = F.wave * 64 + F.lane; p2_mixers(F); }
    GSEAM(2);
    if (IN(3)) { asm volatile("" : "+s"(F.ws), "+s"(F.ap)); F.lane = lane_id(); F.tid = F.wave * 64 + F.lane;
        const int pm = 8 * F.grp + F.rk;
        pg8::Gemm g{F.MIX(), F.WOUT(), MTOK, DM, DM}; pg8::PanelOrder S{pm, 4};
        pg8::EpiOut E{F.RMS(), F.XB(), {0.f, 0.f, 0.f, 0.f, 0.f, 0.f, 0.f, 0.f}};
        pg8::gemm_phase<pg8::EpiOut, pg8::PanelOrder, true, true>(F.lds, g, S, E, F.wave);
        const int wr = F.wave >> 2, wc = F.wave & 3, fr = F.lane & 15, fq = F.lane >> 4;
        LAS float* P = (LAS float*)(F.lds + XCH_OFF);
#pragma unroll
        for (int k = 0; k < 8; ++k) { float s = E.ss[k]; s += __shfl_xor(s, 16); s += __shfl_xor(s, 32);
            if (fq == 0) P[((k >> 2) * 128 + wr * 64 + (k & 3) * 16 + fr) * 4 + wc] = s; }
        __syncthreads();
        if (F.tid < 256) { const f32x4 p = *(const LAS f32x4*)(P + F.tid * 4);
            F.R2()[(size_t)pm * 256 + F.tid] = 1.0f / sqrtf(((p[0] + p[1]) + (p[2] + p[3])) * (1.0f / DM) + 1e-6f); }
    }
    GSEAM(3);
    if (IN(4)) { asm volatile("" : "+s"(F.ws), "+s"(F.ap)); F.lane = lane_id(); F.tid = F.wave * 64 + F.lane;
        pg8::Gemm g{F.XB(), F.WGU(), MTOK, NGU, DM}; BatchOrder S{8 * F.grp, NGU / 256, F.rk};
        pg8::EpiGU E{F.R2(), F.ACT(), {0.f, 0.f, 0.f, 0.f}, {0.f, 0.f, 0.f, 0.f}, {0.f, 0.f, 0.f, 0.f}, {0.f, 0.f, 0.f, 0.f}, 0ull};
        pg8::gemm_phase<pg8::EpiGU, BatchOrder, GEMM_ALIGN, GEMM_SP2>(F.lds, g, S, E, F.wave);
    }
    GSEAM(4);
    if (IN(5)) { asm volatile("" : "+s"(F.ws), "+s"(F.ap)); F.lane = lane_id(); F.tid = F.wave * 64 + F.lane;
        pg8::Gemm g{F.ACT(), F.WDN(), MTOK, DM, FF}; BatchOrder S{8 * F.grp, DM / 256, F.rk};
        pg8::EpiDown E{F.XB(), F.out()};
        pg8::gemm_phase<pg8::EpiDown, BatchOrder, GEMM_ALIGN, GEMM_SP2>(F.lds, g, S, E, F.wave);
    }
#undef GSEAM
#ifdef PROBE_TIMER
    xcd_barrier(bar);
    { const float frac = __uint_as_float(__hip_atomic_load(F.ctl + 64, __ATOMIC_RELAXED, __HIP_MEMORY_SCOPE_AGENT)); const int nz = (int)(frac * (float)MTOK);
      for (int m = (int)blockIdx.x * NWAVES + F.wave; m < nz; m += F.G * NWAVES) { f32x4* o = (f32x4*)(F.out() + (size_t)m * DM) + F.lane;
#pragma unroll
          for (int j = 0; j < 4; ++j) o[64 * j] = (f32x4){0.f, 0.f, 0.f, 0.f}; } }
#endif
#undef IN
}

extern "C" void kernel_launch(void* const* d_in, const int* in_sizes, int n_in, void* d_out, int out_size, void* d_ws, size_t ws_size, hipStream_t stream) {
    static int grid = 0;
    if (grid == 0) {
        if (n_in != 16 || in_sizes[0] != MTOK * DM || out_size != MTOK * DM || ws_size < WS_END) {
            fprintf(stderr, "kernel_launch: unexpected problem (n_in %d, in0 %d, out %d, ws %zu); nothing launched\n", n_in, n_in > 0 ? in_sizes[0] : -1, out_size, ws_size); grid = -1; return; }
        int dev = 0, cus = 0, per_cu = 0;
        if (hipGetDevice(&dev) != hipSuccess || hipDeviceGetAttribute(&cus, hipDeviceAttributeMultiprocessorCount, dev) != hipSuccess) { grid = -1; return; }
        if (hipFuncSetAttribute((const void*)fwd_kernel, hipFuncAttributeMaxDynamicSharedMemorySize, LDS_BYTES) != hipSuccess) { fprintf(stderr, "kernel_launch: hipFuncSetAttribute failed\n"); grid = -1; return; }
        if (hipOccupancyMaxActiveBlocksPerMultiprocessor(&per_cu, (const void*)fwd_kernel, NTHR, LDS_BYTES) != hipSuccess || per_cu < 1) { fprintf(stderr, "kernel_launch: occupancy query says %d blocks per CU\n", per_cu); (void)hipGetLastError(); grid = -1; return; }
        grid = cus;
        if (grid != 256) { fprintf(stderr, "kernel_launch: %d CUs; this kernel is laid out for 256 (eight groups of 32 workgroups)\n", grid); grid = -1; return; }
    }
    if (grid < 0) return;
    if (hipMemsetAsync((char*)d_ws + WS_CTL, 0, CTL_ZERO_BYTES, stream) != hipSuccess) { fprintf(stderr, "kernel_launch: memset failed\n"); return; }
    Args a{};
    for (int i = 0; i < 16; ++i) a.in[i] = (const float*)d_in[i];
    a.out = (float*)d_out; a.ws = (unsigned char*)d_ws;
#if MK_N_LAUNCHES == 1
    a.ph_lo = 0; a.ph_hi = N_PHASES;
    void* kargs[] = {&a};
    hipError_t e = hipLaunchCooperativeKernel((const void*)fwd_kernel, dim3(grid), dim3(NTHR), kargs, LDS_BYTES, stream);
    if (e != hipSuccess) fprintf(stderr, "kernel_launch: cooperative launch failed: %s (grid %d)\n", hipGetErrorString(e), grid);
#else
    for (int p = 0; p < N_PHASES; ++p) { a.ph_lo = p; a.ph_hi = p + 1; hipLaunchKernelGGL(fwd_kernel, dim3(grid), dim3(NTHR), LDS_BYTES, stream, a); }
#endif
}
```

```cpp
#include <hip/hip_runtime.h>
#include <hip/hip_cooperative_groups.h>
#include <cstdio>
#include <cstdint>
namespace cg = cooperative_groups;
namespace pg8 {
#define PG8_LAS __attribute__((address_space(3)))
typedef unsigned short bf16_t;
typedef short bf16x8 __attribute__((ext_vector_type(8)));
typedef float f32x4 __attribute__((ext_vector_type(4)));
typedef unsigned u32x4 __attribute__((ext_vector_type(4)));
constexpr int BM = 256, BK = 64, HALF = 128, HTB = HALF * BK * 2  , STAGE_BYTES = 8 * HTB, NXCD = 8, WGM = 8;

__host__ __device__ __forceinline__ int lds_byte(int r, int c) { const int st = (r >> 4) * 2 + (c >> 5), rr = r & 15, cc = c & 31, ob = rr * 64 + cc * 2; return st * 1024 + (ob ^ (((ob >> 9) & 1) << 5)); }
__host__ __device__ __forceinline__ void stage_rc(int b, int& R, int& C) { const int st = b / 1024, sb = b % 1024, swz = sb ^ (((sb >> 9) & 1) << 5); R = (st >> 1) * 16 + swz / 64; C = (st & 1) * 32 + (swz % 64) / 2; }
__host__ __device__ __forceinline__ int perm32(int rho) { const int n = rho >> 4, i = rho & 15; return 8 * (i >> 2) + 4 * n + (i & 3); }

struct Unit { int pm, pn; };
struct Gemm { const bf16_t* A; const bf16_t* Bt; int M, N, K; };

struct StaticOrder {
    int nM, nN, nwg, G, c;
    __host__ __device__ void init(int M, int N, int G_, int c_) { nM = M / BM; nN = N / BM; nwg = nM * nN; G = G_; c = c_; }
    __host__ __device__ bool next(int i, Unit& u) const {
        const long L = (long)i * G + c; if (L >= nwg) return false;
        int wgid = (int)L; { const int q = nwg / NXCD, r = nwg % NXCD, xcd = wgid % NXCD, off = wgid / NXCD; wgid = (xcd < r ? xcd * (q + 1) : r * (q + 1) + (xcd - r) * q) + off; }
        const int nig = WGM * nN, gid = wgid / nig, fm = gid * WGM, gsz = (nM - fm) < WGM ? (nM - fm) : WGM;
        u.pm = fm + ((wgid % nig) % gsz); u.pn = (wgid % nig) / gsz; return true;
    }
    __device__ __forceinline__ void a_ready(const Unit&) const {}
    __device__ __forceinline__ void done(const Unit&) const {}
};

__device__ __forceinline__ unsigned cvt_pk_bf16(float lo, float hi) { unsigned r; asm volatile("v_cvt_pk_bf16_f32 %0, %1, %2" : "=v"(r) : "v"(lo), "v"(hi)); return r; }
typedef float f32x2 __attribute__((ext_vector_type(2)));
typedef __bf16 bf16x2_t __attribute__((ext_vector_type(2)));
typedef unsigned u32x2 __attribute__((ext_vector_type(2)));
__device__ __forceinline__ unsigned pkbf(float lo, float hi) { f32x2 v = {lo, hi}; bf16x2_t b = __builtin_convertvector(v, bf16x2_t); return __builtin_bit_cast(unsigned, b); }
__device__ __forceinline__ u32x4 pk8(f32x4 a, f32x4 b) { return (u32x4){pkbf(a[0], a[1]), pkbf(a[2], a[3]), pkbf(b[0], b[1]), pkbf(b[2], b[3])}; }
__device__ __forceinline__ float dot4(f32x4 a) { return (a[0] * a[0] + a[1] * a[1]) + (a[2] * a[2] + a[3] * a[3]); }
__device__ __forceinline__ float sum4(f32x4 a) { return (a[0] + a[1]) + (a[2] + a[3]); }
__device__ __forceinline__ float silu1(float v) { return v * __builtin_amdgcn_rcpf(1.0f + __builtin_amdgcn_exp2f(-1.4426950408889634f * v)); }
__device__ __forceinline__ f32x4 silu4(f32x4 v) { return (f32x4){silu1(v[0]), silu1(v[1]), silu1(v[2]), silu1(v[3])}; }
constexpr float RMS_EPS_F = 1e-6f;
constexpr float QSCALE = 0.125f * 1.4426950408889634f;

struct EpiIn {
    static constexpr bool PERM = true, AFTER_DRAIN = false;
    bf16_t *QA, *KA, *VA, *IQ, *IK, *QB, *KB, *VB, *GB; float* IW;
    const float *qnw, *knw;
    PG8_LAS float* xch;
    __device__ __forceinline__ void prefetch(const Unit&, int, int) {}
    __device__ __forceinline__ void advance() {}
    __device__ __forceinline__ void operator()(const f32x4 (&acc)[2][2][4][2], const Unit& u, int wr, int wc, int fr, int fq) {
        asm volatile("" : "+v"(fr), "+v"(fq));
        const int row0 = u.pm * BM + wr * 64 + fr, pn = u.pn;
        if (pn < 2) {
            const int head = 4 * pn + wc;
            const f32x4 w0 = *(const f32x4*)(qnw + 8 * fq), w1 = *(const f32x4*)(qnw + 8 * fq + 4), w2 = *(const f32x4*)(qnw + 32 + 8 * fq), w3 = *(const f32x4*)(qnw + 36 + 8 * fq);
#pragma unroll
            for (int ai = 0; ai < 2; ++ai)
#pragma unroll
                for (int m = 0; m < 4; ++m) {
                    f32x4 a0 = acc[ai][0][m][0], a1 = acc[ai][0][m][1], b0 = acc[ai][1][m][0], b1 = acc[ai][1][m][1];
                    float ss = (dot4(a0) + dot4(a1)) + (dot4(b0) + dot4(b1));
                    ss += __shfl_xor(ss, 16); ss += __shfl_xor(ss, 32);
                    const float rs = QSCALE / sqrtf(ss * (1.0f / 64.0f) + RMS_EPS_F);
                    bf16_t* p = QA + (size_t)(row0 + ai * HALF + m * 16) * 512 + head * 64 + 8 * fq;
                    *(u32x4*)p = pk8(a0 * w0 * rs, a1 * w1 * rs); *(u32x4*)(p + 32) = pk8(b0 * w2 * rs, b1 * w3 * rs);
                }
        } else if (pn == 2) {
            if (wc >= 2) {
#pragma unroll
                for (int ai = 0; ai < 2; ++ai)
#pragma unroll
                    for (int m = 0; m < 4; ++m) {
                        float ss = (dot4(acc[ai][0][m][0]) + dot4(acc[ai][0][m][1])) + (dot4(acc[ai][1][m][0]) + dot4(acc[ai][1][m][1]));
                        ss += __shfl_xor(ss, 16); ss += __shfl_xor(ss, 32);
                        if (fq == 0) xch[(ai * HALF + wr * 64 + m * 16 + fr) * 2 + (wc - 2)] = ss;
                    }
            }
            asm volatile("s_waitcnt lgkmcnt(0)" ::: "memory"); __builtin_amdgcn_s_barrier(); asm volatile("" ::: "memory");
            if (wc < 2) {
                const f32x4 w0 = *(const f32x4*)(knw + 8 * fq), w1 = *(const f32x4*)(knw + 8 * fq + 4), w2 = *(const f32x4*)(knw + 32 + 8 * fq), w3 = *(const f32x4*)(knw + 36 + 8 * fq);
#pragma unroll
                for (int ai = 0; ai < 2; ++ai)
#pragma unroll
                    for (int m = 0; m < 4; ++m) {
                        const int rl = ai * HALF + wr * 64 + m * 16 + fr;
                        const f32x2 pr = *(const PG8_LAS f32x2*)(xch + rl * 2);
                        const float rc = 1.0f / sqrtf((pr[0] + pr[1]) * (1.0f / 128.0f) + RMS_EPS_F);
                        f32x4 a0 = acc[ai][0][m][0] * rc, a1 = acc[ai][0][m][1] * rc, b0 = acc[ai][1][m][0] * rc, b1 = acc[ai][1][m][1] * rc;
                        const size_t row = (size_t)(row0 + ai * HALF + m * 16);
                        if (wc == 0) {
                            float ss = (dot4(a0) + dot4(a1)) + (dot4(b0) + dot4(b1));
                            ss += __shfl_xor(ss, 16); ss += __shfl_xor(ss, 32);
                            const float rs = 1.0f / sqrtf(ss * (1.0f / 64.0f) + RMS_EPS_F);
                            bf16_t* p = KA + row * 64 + 8 * fq;
                            *(u32x4*)p = pk8(a0 * w0 * rs, a1 * w1 * rs); *(u32x4*)(p + 32) = pk8(b0 * w2 * rs, b1 * w3 * rs);
                        } else {
                            bf16_t* p = VA + row * 64 + 8 * fq;
                            *(u32x4*)p = pk8(a0, a1); *(u32x4*)(p + 32) = pk8(b0, b1);
                        }
                    }
            }
        } else if (pn == 3) {
#pragma unroll
            for (int ai = 0; ai < 2; ++ai)
#pragma unroll
                for (int m = 0; m < 4; ++m) {
                    const size_t row = (size_t)(row0 + ai * HALF + m * 16);
                    *(u32x4*)(IQ + row * 128 + 32 * wc + 8 * fq) = pk8(acc[ai][0][m][0], acc[ai][0][m][1]);
                    if (wc == 0) *(u32x4*)(IK + row * 32 + 8 * fq) = pk8(acc[ai][1][m][0], acc[ai][1][m][1]);
                    if (wc == 1 && fq == 0) *(f32x4*)(IW + row * 4) = acc[ai][1][m][0];
                }
        } else if (pn < 8) {
            const int head = 4 * (pn & 1) + wc; bf16_t* dst = pn < 6 ? QB : KB;
            const float lg2 = __log2f(1.0f - __builtin_amdgcn_exp2f(-5.0f - (float)head));
            f32x4 iv0, iv1;
#pragma unroll
            for (int i = 0; i < 4; ++i) { iv0[i] = __builtin_amdgcn_exp2f(-(float)(8 * fq + i) * (13.287712379549449f / 32.0f)) * 0.15915494309189535f; iv1[i] = __builtin_amdgcn_exp2f(-(float)(8 * fq + 4 + i) * (13.287712379549449f / 32.0f)) * 0.15915494309189535f; }
#pragma unroll
            for (int ai = 0; ai < 2; ++ai)
#pragma unroll
                for (int m = 0; m < 4; ++m) {
                    const int row = row0 + ai * HALF + m * 16, pos = row & 2047; const float fp = (float)pos;
                    const float sc = pn < 6 ? __builtin_amdgcn_exp2f((float)(pos & 63) * lg2) : 0.125f * __builtin_amdgcn_exp2f(-(float)(pos & 63) * lg2);
                    f32x4 c0, c1, s0, s1;
#pragma unroll
                    for (int i = 0; i < 4; ++i) {
                        const float r0 = __builtin_amdgcn_fractf(fp * iv0[i]), r1 = __builtin_amdgcn_fractf(fp * iv1[i]);
                        c0[i] = __builtin_amdgcn_cosf(r0) * sc; s0[i] = __builtin_amdgcn_sinf(r0) * sc; c1[i] = __builtin_amdgcn_cosf(r1) * sc; s1[i] = __builtin_amdgcn_sinf(r1) * sc;
                    }
                    const f32x4 a0 = acc[ai][0][m][0], a1 = acc[ai][0][m][1], b0 = acc[ai][1][m][0], b1 = acc[ai][1][m][1];
                    bf16_t* p = dst + (size_t)row * 512 + head * 64 + 8 * fq;
                    *(u32x4*)p = pk8(a0 * c0 - b0 * s0, a1 * c1 - b1 * s1); *(u32x4*)(p + 32) = pk8(a0 * s0 + b0 * c0, a1 * s1 + b1 * c1);
                }
        } else {
            const int head = 4 * (pn & 1) + wc; bf16_t* dst = pn < 10 ? VB : GB; const bool act = pn >= 10;
#pragma unroll
            for (int ai = 0; ai < 2; ++ai)
#pragma unroll
                for (int m = 0; m < 4; ++m) {
                    f32x4 a0 = acc[ai][0][m][0], a1 = acc[ai][0][m][1], b0 = acc[ai][1][m][0], b1 = acc[ai][1][m][1];
                    if (act) { a0 = silu4(a0); a1 = silu4(a1); b0 = silu4(b0); b1 = silu4(b1); }
                    bf16_t* p = dst + (size_t)(row0 + ai * HALF + m * 16) * 512 + head * 64 + 8 * fq;
                    *(u32x4*)p = pk8(a0, a1); *(u32x4*)(p + 32) = pk8(b0, b1);
                }
        }
    }
};

struct EpiOut {
    static constexpr bool PERM = true, AFTER_DRAIN = false;
    const float* rms; bf16_t* x1b; float ss[8];
    __device__ __forceinline__ void prefetch(const Unit&, int, int) {}
    __device__ __forceinline__ void advance() {}
    __device__ __forceinline__ void operator()(const f32x4 (&acc)[2][2][4][2], const Unit& u, int wr, int wc, int fr, int fq) {
        asm volatile("" : "+v"(fr), "+v"(fq));
        const int row0 = u.pm * BM + wr * 64 + fr, col0 = u.pn * BM + wc * 32 + 8 * fq;
#pragma unroll
        for (int ai = 0; ai < 2; ++ai)
#pragma unroll
            for (int m = 0; m < 4; ++m) {
                const int row = row0 + ai * HALF + m * 16; const size_t off = (size_t)row * 1024 + col0; const float rm = rms[row]; float s = 0.f;
#pragma unroll
                for (int bj = 0; bj < 2; ++bj) {
                    const u32x4 xv = *(const u32x4*)(x1b + off + bj * HALF);
                    const f32x4 x0 = {__uint_as_float(xv[0] << 16), __uint_as_float(xv[0] & 0xffff0000u), __uint_as_float(xv[1] << 16), __uint_as_float(xv[1] & 0xffff0000u)};
                    const f32x4 x1 = {__uint_as_float(xv[2] << 16), __uint_as_float(xv[2] & 0xffff0000u), __uint_as_float(xv[3] << 16), __uint_as_float(xv[3] & 0xffff0000u)};
                    const f32x4 r0 = x0 * rm + acc[ai][bj][m][0], r1 = x1 * rm + acc[ai][bj][m][1];
                    *(u32x4*)(x1b + off + bj * HALF) = pk8(r0, r1);
                    s += dot4(r0) + dot4(r1);
                }
                ss[ai * 4 + m] += s;
            }
    }
};

struct EpiGU {
    static constexpr bool PERM = true, AFTER_DRAIN = false;
    const float* r2; bf16_t* act; f32x4 rc0, rc1, rn0, rn1; unsigned long long tepi;
    __device__ __forceinline__ void prefetch(const Unit& u, int wr, int fr) {
        const float* p = r2 + u.pm * BM + wr * 64 + fr;
        rn0 = (f32x4){p[0], p[16], p[32], p[48]}; rn1 = (f32x4){p[HALF], p[HALF + 16], p[HALF + 32], p[HALF + 48]};
    }
    __device__ __forceinline__ void advance() { rc0 = rn0; rc1 = rn1; }
    __device__ __forceinline__ void operator()(const f32x4 (&acc)[2][2][4][2], const Unit& u, int wr, int wc, int fr, int fq) {
#ifdef PROBE_TIMER
        const unsigned long long te0_ = __builtin_amdgcn_s_memtime();
#endif
        asm volatile("" : "+v"(fr), "+v"(fq));
        const int row0 = u.pm * BM + wr * 64 + fr, col0 = u.pn * HALF + wc * 32 + 8 * fq;
#pragma unroll
        for (int ai = 0; ai < 2; ++ai)
#pragma unroll
            for (int m = 0; m < 4; ++m) {
                const int row = row0 + ai * HALF + m * 16; const float rr = ai ? rc1[m] : rc0[m];
                const f32x4 g0 = acc[ai][0][m][0] * rr, g1 = acc[ai][0][m][1] * rr, u0 = acc[ai][1][m][0] * rr, u1 = acc[ai][1][m][1] * rr;
                *(u32x4*)(act + (size_t)row * 2816 + col0) = pk8(silu4(g0) * u0, silu4(g1) * u1);
            }
#ifdef PROBE_TIMER
        asm volatile("s_waitcnt vmcnt(0)" ::: "memory"); tepi += __builtin_amdgcn_s_memtime() - te0_;
#endif
    }
};

struct EpiDown {
    static constexpr bool PERM = true, AFTER_DRAIN = false;
    const bf16_t* x1b; float* out;
    __device__ __forceinline__ void prefetch(const Unit&, int, int) {}
    __device__ __forceinline__ void advance() {}
    __device__ __forceinline__ void operator()(const f32x4 (&acc)[2][2][4][2], const Unit& u, int wr, int wc, int fr, int fq) {
        asm volatile("" : "+v"(fr), "+v"(fq));
        const int row0 = u.pm * BM + wr * 64 + fr, col0 = u.pn * BM + wc * 32 + 8 * fq;
#pragma unroll
        for (int ai = 0; ai < 2; ++ai)
#pragma unroll
            for (int m = 0; m < 4; ++m) {
                const size_t off = (size_t)(row0 + ai * HALF + m * 16) * 1024 + col0;
#pragma unroll
                for (int bj = 0; bj < 2; ++bj) {
                    const u32x4 xv = __builtin_nontemporal_load((const u32x4*)(x1b + off + bj * HALF));
                    const f32x4 x0 = {__uint_as_float(xv[0] << 16), __uint_as_float(xv[0] & 0xffff0000u), __uint_as_float(xv[1] << 16), __uint_as_float(xv[1] & 0xffff0000u)};
                    const f32x4 x1 = {__uint_as_float(xv[2] << 16), __uint_as_float(xv[2] & 0xffff0000u), __uint_as_float(xv[3] << 16), __uint_as_float(xv[3] & 0xffff0000u)};
                    __builtin_nontemporal_store(x0 + acc[ai][bj][m][0], (f32x4*)(out + off + bj * HALF)); __builtin_nontemporal_store(x1 + acc[ai][bj][m][1], (f32x4*)(out + off + bj * HALF + 4));
                }
            }
    }
};

struct PanelOrder {
    int pm, ntn;
    __device__ __forceinline__ bool next(int i, Unit& u) const { if (i >= ntn) return false; u.pm = pm; u.pn = i; return true; }
    __device__ __forceinline__ void a_ready(const Unit&) const {}
    __device__ __forceinline__ void done(const Unit&) const {}
};

template <class Epi, class Sched, bool ALIGN_EPI = false, bool SP2 = false>
__device__ __forceinline__ void gemm_phase(PG8_LAS unsigned char* lds, const Gemm g, const Sched& S, Epi& E, int wave_in) {
    unsigned ones_ = ~0u; asm volatile("" : "+s"(ones_)); int tid_ = wave_in * 64 + (int)__builtin_amdgcn_mbcnt_hi(ones_, __builtin_amdgcn_mbcnt_lo(ones_, 0u));
    const int tid = tid_, wid = __builtin_amdgcn_readfirstlane(tid >> 6), lane = tid & 63, wr = wid >> 2, wc = wid & 3, fr = lane & 15, fq = lane >> 4;
    const int K = g.K, nt = K / BK;
    unsigned voffA[2], voffB[2];
#pragma unroll
    for (int i = 0; i < 2; ++i) { int R, C; stage_rc(tid * 16 + i * 8192, R, C); const int Rb = Epi::PERM ? ((R & ~31) + perm32(R & 31)) : R;
        voffA[i] = (unsigned)(R * K + C) * 2u; voffB[i] = (unsigned)(Rb * K + C) * 2u; }
    const size_t kstep = (size_t)(BK * 2);
    const size_t hstep = (size_t)HALF * K * 2;
    const size_t tstep = 2 * hstep;
    const unsigned ldsw = (unsigned)wid * 1024u;
    const int aoff = lds_byte(wr * 64 + fr, fq * 8), boff = lds_byte(wc * 32 + fr, fq * 8);
#define PG8_SA(b, h) (((b) * 2 + (h)) * HTB)
#define PG8_SB(b, h) ((4 + (b) * 2 + (h)) * HTB)
#define PG8_STAGE(bufoff, gbase, voff) do { _Pragma("unroll") for (int _i = 0; _i < 2; ++_i) \
        __builtin_amdgcn_global_load_lds((const unsigned*)((const char*)(gbase) + (voff)[_i]), (PG8_LAS unsigned*)(lds + (bufoff) + ldsw + _i * 8192), 16, 0, 0); } while (0)
#define PG8_LDA(dst, b, h) do { _Pragma("unroll") for (int m = 0; m < 4; ++m) _Pragma("unroll") for (int k = 0; k < 2; ++k) dst[m][k] = *(const PG8_LAS bf16x8*)(lds + PG8_SA(b, h) + aoff + m * 2048 + k * 1024); } while (0)
#define PG8_LDB(dst, b, h) do { _Pragma("unroll") for (int n = 0; n < 2; ++n) _Pragma("unroll") for (int k = 0; k < 2; ++k) dst[n][k] = *(const PG8_LAS bf16x8*)(lds + PG8_SB(b, h) + boff + n * 2048 + k * 1024); } while (0)
#define PG8_MMA(ai, bj, At, Bt) do { __builtin_amdgcn_s_setprio(1); _Pragma("unroll") for (int m = 0; m < 4; ++m) _Pragma("unroll") for (int n = 0; n < 2; ++n) _Pragma("unroll") for (int k = 0; k < 2; ++k) \
        acc[ai][bj][m][n] = __builtin_amdgcn_mfma_f32_16x16x32_bf16(Bt[n][k], At[m][k], acc[ai][bj][m][n], 0, 0, 0); __builtin_amdgcn_s_setprio(0); } while (0)
#define PG8_WAIT_V(n) asm volatile("s_waitcnt vmcnt(" #n ")" ::: "memory")
#define PG8_WAIT_L(n) asm volatile("s_waitcnt lgkmcnt(" #n ")" ::: "memory")
#define PG8_BAR __builtin_amdgcn_s_barrier()
#define PG8_SCHED __builtin_amdgcn_sched_barrier(0)
    Unit cur, nxt; int ui = 0;
    if (!S.next(0, cur)) return;
    E.prefetch(cur, wr, fr); E.advance();
    f32x4 acc[2][2][4][2];
#pragma unroll
    for (int a = 0; a < 2; ++a)
#pragma unroll
        for (int b = 0; b < 2; ++b)
#pragma unroll
            for (int m = 0; m < 4; ++m)
#pragma unroll
                for (int n = 0; n < 2; ++n) acc[a][b][m][n] = (f32x4){0.f, 0.f, 0.f, 0.f};
    bf16x8 At[4][2], B0[2][2], B1[2][2];
    const char* cA = (const char*)g.A + (size_t)cur.pm * tstep; const char* cB = (const char*)g.Bt + (size_t)cur.pn * tstep;
    S.a_ready(cur);
    if constexpr (SP2) {
        PG8_STAGE(PG8_SB(0, 0), cB, voffB); PG8_STAGE(PG8_SB(0, 1), cB + hstep, voffB); PG8_STAGE(PG8_SA(0, 0), cA, voffA); PG8_STAGE(PG8_SA(0, 1), cA + hstep, voffA);
        if (wr == 1) PG8_BAR;
        PG8_WAIT_V(2); PG8_BAR;
        PG8_STAGE(PG8_SB(1, 0), cB + kstep, voffB); PG8_STAGE(PG8_SA(1, 0), cA + kstep, voffA); PG8_STAGE(PG8_SB(1, 1), cB + hstep + kstep, voffB);
        PG8_WAIT_V(6); PG8_BAR;
    } else {
        PG8_STAGE(PG8_SB(0, 0), cB, voffB); PG8_STAGE(PG8_SA(0, 0), cA, voffA); PG8_STAGE(PG8_SB(0, 1), cB + hstep, voffB); PG8_STAGE(PG8_SA(0, 1), cA + hstep, voffA);
        if (wr == 1) PG8_BAR;
        PG8_WAIT_V(4); PG8_BAR;
        PG8_STAGE(PG8_SB(1, 0), cB + kstep, voffB); PG8_STAGE(PG8_SA(1, 0), cA + kstep, voffA); PG8_STAGE(PG8_SB(1, 1), cB + hstep + kstep, voffB);
        PG8_WAIT_V(6); PG8_BAR;
    }
    for (;;) {
        const bool has_next = S.next(ui + 1, nxt);
        const char* nA = has_next ? (const char*)g.A + (size_t)nxt.pm * tstep : cA; const char* nB = has_next ? (const char*)g.Bt + (size_t)nxt.pn * tstep : cB;
        for (int t = 0; t < nt; t += 2) {
            const bool last = (t == nt - 2);
            const char* a1 = cA + (size_t)(t + 1) * kstep;
            const char* a2 = last ? nA : cA + (size_t)(t + 2) * kstep; const char* b2 = last ? nB : cB + (size_t)(t + 2) * kstep;
            const char* a3 = a2 + kstep; const char* b3 = b2 + kstep;
            if (last && has_next) { S.a_ready(nxt); E.prefetch(nxt, wr, fr); }
            if constexpr (SP2) {
            PG8_LDB(B0, 0, 0); PG8_LDB(B1, 0, 1); PG8_SCHED; PG8_LDA(At, 0, 0); PG8_STAGE(PG8_SA(1, 1), a1 + hstep, voffA);
            PG8_WAIT_V(8); PG8_WAIT_L(0); PG8_BAR; PG8_MMA(0, 0, At, B0); PG8_MMA(0, 1, At, B1); PG8_BAR; PG8_SCHED;
            PG8_LDA(At, 0, 1); PG8_STAGE(PG8_SB(0, 0), b2, voffB); PG8_STAGE(PG8_SB(0, 1), b2 + hstep, voffB); PG8_STAGE(PG8_SA(0, 0), a2, voffA);
            PG8_WAIT_V(8); PG8_WAIT_L(0); PG8_BAR; PG8_MMA(1, 0, At, B0); PG8_MMA(1, 1, At, B1); PG8_BAR; PG8_SCHED;
            PG8_LDB(B0, 1, 0); PG8_LDB(B1, 1, 1); PG8_SCHED; PG8_LDA(At, 1, 0); PG8_STAGE(PG8_SA(0, 1), a2 + hstep, voffA);
            PG8_WAIT_V(8); PG8_WAIT_L(0); PG8_BAR; PG8_MMA(0, 0, At, B0); PG8_MMA(0, 1, At, B1); PG8_BAR; PG8_SCHED;
            PG8_LDA(At, 1, 1); PG8_STAGE(PG8_SB(1, 0), b3, voffB); PG8_STAGE(PG8_SB(1, 1), b3 + hstep, voffB); PG8_STAGE(PG8_SA(1, 0), a3, voffA);
            PG8_WAIT_V(8); PG8_WAIT_L(0); PG8_BAR; PG8_MMA(1, 0, At, B0); PG8_MMA(1, 1, At, B1); PG8_BAR; PG8_SCHED;
            } else {
            PG8_LDB(B0, 0, 0); PG8_SCHED; PG8_LDA(At, 0, 0); PG8_STAGE(PG8_SA(1, 1), a1 + hstep, voffA);
            PG8_WAIT_L(8); PG8_BAR; PG8_WAIT_L(0); PG8_MMA(0, 0, At, B0); PG8_BAR; PG8_SCHED;
            PG8_LDB(B1, 0, 1); PG8_STAGE(PG8_SB(0, 0), b2, voffB);
            PG8_BAR; PG8_WAIT_L(0); PG8_MMA(0, 1, At, B1); PG8_BAR;
            PG8_LDA(At, 0, 1); PG8_STAGE(PG8_SA(0, 0), a2, voffA);
            PG8_BAR; PG8_WAIT_L(0); PG8_MMA(1, 0, At, B0); PG8_BAR; PG8_SCHED;
            PG8_STAGE(PG8_SB(0, 1), b2 + hstep, voffB);
            PG8_WAIT_V(6); PG8_BAR; PG8_MMA(1, 1, At, B1); PG8_BAR;
            PG8_LDB(B0, 1, 0); PG8_SCHED; PG8_LDA(At, 1, 0); PG8_STAGE(PG8_SA(0, 1), a2 + hstep, voffA);
            PG8_WAIT_L(8); PG8_BAR; PG8_WAIT_L(0); PG8_MMA(0, 0, At, B0); PG8_BAR; PG8_SCHED;
            PG8_LDB(B1, 1, 1); PG8_STAGE(PG8_SB(1, 0), b3, voffB);
            PG8_BAR; PG8_WAIT_L(0); PG8_MMA(0, 1, At, B1); PG8_BAR;
            PG8_LDA(At, 1, 1); PG8_STAGE(PG8_SA(1, 0), a3, voffA);
            PG8_BAR; PG8_WAIT_L(0); PG8_MMA(1, 0, At, B0); PG8_BAR; PG8_SCHED;
            PG8_STAGE(PG8_SB(1, 1), b3 + hstep, voffB);
            PG8_WAIT_V(6); PG8_BAR; PG8_MMA(1, 1, At, B1); PG8_BAR;
            }
        }
        if constexpr (ALIGN_EPI) { if (wr == 0) PG8_BAR; }
        if constexpr (!Epi::AFTER_DRAIN) { E(acc, cur, wr, wc, fr, fq); E.advance(); S.done(cur); }
        if (!has_next) break;
#pragma unroll
        for (int a = 0; a < 2; ++a)
#pragma unroll
            for (int b = 0; b < 2; ++b)
#pragma unroll
                for (int m = 0; m < 4; ++m)
#pragma unroll
                    for (int n = 0; n < 2; ++n) acc[a][b][m][n] = (f32x4){0.f, 0.f, 0.f, 0.f};
        cur = nxt; cA = nA; cB = nB; ++ui;
        if constexpr (ALIGN_EPI) { if (wr == 1) PG8_BAR; }
    }
    PG8_WAIT_V(0);
    if constexpr (!ALIGN_EPI) { if (wr == 0) PG8_BAR; }
    PG8_BAR;
    (void)lane;
#undef PG8_SA
#undef PG8_SB
#undef PG8_STAGE
#undef PG8_LDA
#undef PG8_LDB
#undef PG8_MMA
#undef PG8_WAIT_V
#undef PG8_WAIT_L
#undef PG8_BAR
#undef PG8_SCHED
}
}

constexpr int BATCH = 32, SEQ = 2048, DM = 1024, MTOK = BATCH * SEQ;
constexpr int INW = 2852, NIN = 3072, FF = 2816, NGU = 2 * FF;
constexpr int NWAVES = 8, NTHR = 512;
#ifndef MK_N_LAUNCHES
#define MK_N_LAUNCHES 1
#endif
constexpr int N_PHASES = 6;
constexpr size_t MiB = 1u << 20;
constexpr size_t WS_CTL = 0;
constexpr size_t WS_COS = 1 * MiB, WS_SIN = WS_COS + 256 * 1024;
constexpr size_t WS_BT = WS_SIN + 256 * 1024;
constexpr size_t WS_R2 = 2 * MiB, WS_RMS = 2 * MiB + 512 * 1024;
constexpr size_t WS_WIN = 4 * MiB, WS_WOUT = 10 * MiB, WS_WGU = 12 * MiB, WS_WDN = 23 * MiB;
constexpr size_t WS_XB = 32 * MiB;
constexpr size_t WS_MIX = 160 * MiB;
constexpr size_t WS_QA = 288 * MiB, WS_QB = 352 * MiB, WS_KB = 416 * MiB, WS_VB = 480 * MiB, WS_GB = 544 * MiB;
constexpr size_t WS_KA = 608 * MiB, WS_VA = 616 * MiB;
constexpr size_t WS_IQ = 624 * MiB;
constexpr size_t WS_ACT = 648 * MiB;
constexpr size_t WS_IK = 640 * MiB, WS_IW = 644 * MiB;
constexpr size_t WS_END = 1000 * MiB;
static_assert(WS_ACT + (size_t)MTOK * FF * 2 <= WS_END && WS_IW + (size_t)MTOK * 16 <= WS_ACT && WS_IQ + (size_t)MTOK * 128 * 2 <= WS_IK && WS_WDN + (size_t)DM * FF * 2 <= WS_XB && WS_WGU + (size_t)NGU * DM * 2 <= WS_WDN, "d_ws map");
constexpr int RING_BYTES = 131072;
constexpr int XCH_OFF = RING_BYTES;
constexpr int P2_SC = 0, SCW = 1028;
constexpr int P2_MASK = 143360;
constexpr int MISC_OFF = 163584;
constexpr int LDS_BYTES = 163840;
static_assert(P2_SC + 16 * SCW * 4 <= P2_MASK && P2_MASK + 16384 <= MISC_OFF, "P2 LDS map");

#define LAS __attribute__((address_space(3)))
typedef unsigned short bf16;
typedef unsigned v4u __attribute__((ext_vector_type(4)));
typedef unsigned v2u __attribute__((ext_vector_type(2)));
typedef float f32x4 __attribute__((ext_vector_type(4)));
typedef float f32x16 __attribute__((ext_vector_type(16)));
typedef short bf16x8 __attribute__((ext_vector_type(8)));
typedef short s16x4 __attribute__((ext_vector_type(4)));
#define LDS_WAIT() asm volatile("s_waitcnt lgkmcnt(0)" ::: "memory")
using pg8::pkbf;
__device__ __forceinline__ float bf2f(unsigned short h) { return __uint_as_float((unsigned)h << 16); }
__device__ __forceinline__ float bflo(unsigned w) { return __uint_as_float(w << 16); }
__device__ __forceinline__ float bfhi(unsigned w) { return __uint_as_float(w & 0xffff0000u); }
__device__ __forceinline__ float wave_sum(float v) {
#pragma unroll
    for (int o = 1; o < 64; o <<= 1) v += __shfl_xor(v, o);
    return v;
}
__device__ __forceinline__ s16x4 vtr(const LAS unsigned char* p) { return __builtin_bit_cast(s16x4, __builtin_amdgcn_ds_read_tr16_b64_v4i16((LAS s16x4*)p)); }
__device__ __forceinline__ bf16x8 cat8(s16x4 lo, s16x4 hi) { return (bf16x8){lo[0], lo[1], lo[2], lo[3], hi[0], hi[1], hi[2], hi[3]}; }
__device__ __forceinline__ int crow(int r, int hi) { return (r & 3) + 8 * (r >> 2) + 4 * hi; }

__device__ __forceinline__ int lane_id() { unsigned ones = ~0u; asm volatile("" : "+s"(ones)); return (int)__builtin_amdgcn_mbcnt_hi(ones, __builtin_amdgcn_mbcnt_lo(ones, 0u)); }
struct KArgs { const float* in[16]; float* out; unsigned char* ws; int ph_lo, ph_hi; };
struct Frame {
    LAS unsigned char* lds;
    unsigned* ctl;
    unsigned char* ws;
    int tid, lane, wave, vcu, G;
    int grp, rk;
    const __attribute__((address_space(4))) KArgs* ap;
    __device__ __forceinline__ const float* x() const { return ap->in[0]; }
    __device__ __forceinline__ const float* norm1_w() const { return ap->in[1]; }
    __device__ __forceinline__ const float* w_in() const { return ap->in[2]; }
    __device__ __forceinline__ const float* q_norm_w() const { return ap->in[3]; }
    __device__ __forceinline__ const float* k_norm_w() const { return ap->in[4]; }
    __device__ __forceinline__ const float* kv_norm_w() const { return ap->in[5]; }
    __device__ __forceinline__ const float* w_uk() const { return ap->in[6]; }
    __device__ __forceinline__ const float* w_uv() const { return ap->in[7]; }
    __device__ __forceinline__ const float* rel_bias() const { return ap->in[8]; }
    __device__ __forceinline__ const float* ret_gn_w() const { return ap->in[9]; }
    __device__ __forceinline__ const float* ret_gn_b() const { return ap->in[10]; }
    __device__ __forceinline__ const float* w_out() const { return ap->in[11]; }
    __device__ __forceinline__ const float* norm2_w() const { return ap->in[12]; }
    __device__ __forceinline__ const float* w_gate() const { return ap->in[13]; }
    __device__ __forceinline__ const float* w_up() const { return ap->in[14]; }
    __device__ __forceinline__ const float* w_down() const { return ap->in[15]; }
    __device__ __forceinline__ float* out() const { return ap->out; }
#define WSB_(name, off) __device__ __forceinline__ bf16* name() const { return (bf16*)(ws + (off)); }
#define WSF_(name, off) __device__ __forceinline__ float* name() const { return (float*)(ws + (off)); }
    WSB_(WIN, WS_WIN) WSB_(WOUT, WS_WOUT) WSB_(WGU, WS_WGU) WSB_(WDN, WS_WDN) WSB_(XB, WS_XB) WSB_(MIX, WS_MIX) WSB_(QA, WS_QA) WSB_(QB, WS_QB) WSB_(KB, WS_KB) WSB_(VB, WS_VB) WSB_(GB, WS_GB)
    WSB_(KA, WS_KA) WSB_(VA, WS_VA) WSB_(IQ, WS_IQ) WSB_(IK, WS_IK) WSB_(ACT, WS_ACT)
    WSF_(IW, WS_IW) WSF_(R2, WS_R2) WSF_(RMS, WS_RMS) WSF_(COS, WS_COS) WSF_(SIN, WS_SIN) WSF_(BT, WS_BT)
#undef WSB_
#undef WSF_
};

__device__ __forceinline__ int zcol(int n) {
    const int pn = n >> 8, tc = n & 255, bj = tc >> 7, wc = (tc >> 5) & 3, j = tc & 31, d = bj * 32 + j;
    if (pn < 2) return (4 * pn + wc) * 64 + d;
    if (pn == 2) { if (wc == 0) return -2 - d; if (wc == 1) return -2 - (64 + d); return 512 + (wc - 2) * 64 + d; }
    if (pn == 3) { if (bj == 0) return 640 + wc * 32 + j; if (wc == 0) return 768 + j; if (wc == 1 && j < 4) return 800 + j; return -1; }
    const int g = (pn - 4) >> 1, head = 4 * ((pn - 4) & 1) + wc;
    return 804 + g * 512 + head * 64 + d;
}
template <class SRC>
__device__ __forceinline__ void tr_item(SRC src, int Kdim, bf16* WT, int k0, int n0, LAS float* scr, int lane) {
#pragma unroll 4
    for (int i = 0; i < 32; ++i) { const int kk = 2 * i + (lane >> 5); scr[kk * 33 + (lane & 31)] = src(k0 + kk); }
    LDS_WAIT(); asm volatile("" ::: "memory");
    const int c = lane & 7;
#pragma unroll
    for (int j = 0; j < 4; ++j) { const int n = (lane >> 3) + 8 * j; const LAS float* s = scr + (8 * c) * 33 + n;
        v4u o; o.x = pkbf(s[0 * 33], s[1 * 33]); o.y = pkbf(s[2 * 33], s[3 * 33]); o.z = pkbf(s[4 * 33], s[5 * 33]); o.w = pkbf(s[6 * 33], s[7 * 33]);
        *(v4u*)(WT + (size_t)(n0 + n) * Kdim + k0 + 8 * c) = o; }
    LDS_WAIT(); asm volatile("" ::: "memory");
}
__device__ __forceinline__ int t5_bucket(int rel) {
    const int n = rel < 0 ? -rel : rel; int b;
    if (n < 8) b = n; else if (n < 12) b = 8; else if (n < 16) b = 9; else if (n < 23) b = 10; else if (n < 32) b = 11; else if (n < 46) b = 12; else if (n < 64) b = 13; else if (n < 91) b = 14; else b = 15;
    return (rel > 0 ? 16 : 0) + b;
}
__device__ __forceinline__ void p0_prologue(Frame& F) {
    LAS float* scr = (LAS float*)(F.lds + F.wave * 16384);
    const int lane = F.lane, gw = F.vcu * NWAVES + F.wave, NGW = F.G * NWAVES;
    if (blockIdx.x == 0 && F.tid == 0) F.ctl[0] = 0u;
    constexpr int I_IN = 16 * (NIN / 32), I_OUT = 16 * 32, I_GU = 16 * (NGU / 32), I_DN = (FF / 64) * 32, NITEMS = I_IN + I_OUT + I_GU + I_DN;
    auto do_item = [&](int it) {
        int r = it;
        if (r < I_IN) {
            const int kb = r / (NIN / 32), nb = r % (NIN / 32), f = zcol(32 * nb + (lane & 31));
            const float* w_in = F.w_in(); const float* nw = F.norm1_w();
            if (f >= -1) tr_item([&](int k) { return f >= 0 ? nw[k] * w_in[(size_t)k * INW + f] : 0.0f; }, DM, F.WIN(), 64 * kb, 32 * nb, scr, lane);
            return;
        }
        r -= I_IN;
        if (r < I_OUT) { const int kb = r / 32, nb = r % 32; const float* w = F.w_out() + 32 * nb + (lane & 31);
            tr_item([&](int k) { return w[(size_t)k * DM]; }, DM, F.WOUT(), 64 * kb, 32 * nb, scr, lane); return; }
        r -= I_OUT;
        if (r < I_GU) { const int kb = r / (NGU / 32), nb = r % (NGU / 32), n = 32 * nb + (lane & 31), pn = n >> 8, tc = n & 255;
            const float* w = ((tc >> 7) ? F.w_up() : F.w_gate()) + 128 * pn + (tc & 127); const float* nw = F.norm2_w();
            tr_item([&](int k) { return nw[k] * w[(size_t)k * FF]; }, DM, F.WGU(), 64 * kb, 32 * nb, scr, lane); return; }
        r -= I_GU;
        { const int kb = r / 32, nb = r % 32; const float* w = F.w_down() + 32 * nb + (lane & 31);
            tr_item([&](int k) { return w[(size_t)k * DM]; }, FF, F.WDN(), 64 * kb, 32 * nb, scr, lane); }
    };
    for (int e = F.vcu * NTHR + F.tid; e < DM * 128; e += F.G * NTHR) {
        const int k = e >> 7, idx = e & 127, d = idx & 63; const float* wu = (idx < 64 ? F.w_uk() : F.w_uv()) + d; const float* wr_ = F.w_in() + (size_t)k * INW + 512; float a = 0.f;
#pragma unroll 8
        for (int j = 0; j < 128; ++j) a += wr_[j] * F.kv_norm_w()[j] * wu[j * 64];
        const int n = 512 + (idx < 64 ? 0 : 32) + (d < 32 ? d : 128 + d - 32);
        F.WIN()[(size_t)n * DM + k] = (bf16)(pkbf(F.norm1_w()[k] * a, 0.f) & 0xffffu);
    }
    int it = gw, kk = 0;
    for (int m = gw; m < MTOK; m += NGW, ++kk) {
        const f32x4* xr = (const f32x4*)(F.x() + (size_t)m * DM) + lane;
        f32x4 v[4]; float sq = 0.f;
#pragma unroll
        for (int j = 0; j < 4; ++j) { v[j] = __builtin_nontemporal_load(xr + 64 * j); sq += pg8::dot4(v[j]); }
        const float ms = wave_sum(sq) * (1.0f / DM) + 1e-6f, rr = 1.0f / sqrtf(ms);
        v2u* o8 = (v2u*)(F.XB() + (size_t)m * DM) + lane;
#pragma unroll
        for (int j = 0; j < 4; ++j) o8[64 * j] = (v2u){pkbf(v[j][0] * rr, v[j][1] * rr), pkbf(v[j][2] * rr, v[j][3] * rr)};
        if (lane == 0) F.RMS()[m] = sqrtf(ms);
        if ((kk & 7) == 3 && it < NITEMS) { do_item(it); it += NGW; }
    }
    for (; it < NITEMS; it += NGW) do_item(it);
    const int gt = F.vcu * NTHR + F.tid, NGT = F.G * NTHR;
    for (int i = gt; i < 8 * 256; i += NGT) { const int h = i >> 8, rel = (i & 255) - 191;
        F.BT()[i] = (F.rel_bias()[t5_bucket(rel) * 8 + h] - F.rel_bias()[15 * 8 + h]) * 1.4426950408889634f; }
}

#ifndef PROBE_LO
#define PROBE_LO 3000.0f
#define PROBE_RANGE 4000.0f
#endif
#ifndef PLANES
#define PLANES 1
#endif
#ifndef MIXREP
#define MIXREP 0
#endif
typedef float f32x4_t __attribute__((ext_vector_type(4)));
typedef float f32x2v __attribute__((ext_vector_type(2)));
struct IdxOps { bf16x8 bq[4]; f32x4 wv; bf16x8 a0, a1; };
__device__ __forceinline__ void idx_fetch(IdxOps& o, const Frame& F, int b, int c, int rq) {
    const int w = F.wave, lane = F.lane, q = lane & 15, g = lane >> 4;
    const size_t rowq = (size_t)b * SEQ + 64 * c + 16 * rq + q;
#pragma unroll
    for (int h = 0; h < 4; ++h) o.bq[h] = *(const bf16x8*)(F.IQ() + rowq * 128 + 32 * h + 8 * g);
    o.wv = *(const f32x4*)(F.IW() + rowq * 4) * (0.5f * 0.17677669529663687f);
    const bf16* kp = F.IK() + ((size_t)b * SEQ + q) * 32 + 8 * g;
    o.a0 = *(const bf16x8*)(kp + (size_t)w * 512);
    o.a1 = *(const bf16x8*)(kp + (size_t)(w + 32 < 4 * (c + 1) ? w + 32 : w) * 512);
}
__device__ __forceinline__ f32x4 idx_score(const IdxOps& o, bf16x8 a) {
    f32x4 sc = {0.f, 0.f, 0.f, 0.f};
#pragma unroll
    for (int h = 0; h < 4; ++h) {
        const f32x4 d = __builtin_amdgcn_mfma_f32_16x16x32_bf16(a, o.bq[h], (f32x4){0.f, 0.f, 0.f, 0.f}, 0, 0, 0);
#pragma unroll
        for (int i = 0; i < 4; ++i) sc[i] += o.wv[h] * fmaxf(d[i], 0.f);
    }
    return sc + 0.f;
}
__device__ __forceinline__ void idx_round(const IdxOps& o, const Frame& F, int b, int c, LAS unsigned char* lds) {
    const int w = F.wave, lane = F.lane, q = lane & 15, g = lane >> 4;
    const int nkb = 4 * (c + 1);
    const bf16* kp = F.IK() + ((size_t)b * SEQ + q) * 32 + 8 * g;
    LAS unsigned* dst = (LAS unsigned*)(lds + P2_SC) + q * SCW + 4 * g;
    bf16x8 a0 = o.a0, a1 = o.a1;
    for (int s2 = 0; s2 < 2; ++s2)
        for (int kbl = w; kbl < 32; kbl += 8) {
            const int kb0 = kbl + 64 * s2; if (kb0 >= nkb) break;
            int nx = kb0 + 8; if (kbl + 8 >= 32) nx = w + 64 * (s2 + 1);
            bf16x8 n0 = a0, n1 = a1;
            if (nx < nkb) { n0 = *(const bf16x8*)(kp + (size_t)nx * 512); n1 = *(const bf16x8*)(kp + (size_t)(nx + 32 < nkb ? nx + 32 : nx) * 512); }
            const f32x4 s0 = idx_score(o, a0);
            f32x4 s1 = {0.f, 0.f, 0.f, 0.f}; if (kb0 + 32 < nkb) s1 = idx_score(o, a1);
            v4u pk;
#pragma unroll
            for (int i = 0; i < 4; ++i) pk[i] = __builtin_amdgcn_perm(__float_as_uint(s1[i]), __float_as_uint(s0[i]), 0x07060302u);
            *(LAS v4u*)(dst + (16 * s2 + (kb0 >> 1 & 15)) * 32 + 16 * (kb0 & 1)) = pk;
            a0 = n0; a1 = n1;
        }
}
__device__ __forceinline__ int wave_sum_i(int v) {
    v += __builtin_amdgcn_update_dpp(0, v, 0xB1, 0xF, 0xF, false);
    v += __builtin_amdgcn_update_dpp(0, v, 0x4E, 0xF, 0xF, false);
    v += __builtin_amdgcn_update_dpp(0, v, 0x141, 0xF, 0xF, false);
    v += __builtin_amdgcn_update_dpp(0, v, 0x140, 0xF, 0xF, false);
    return (__builtin_amdgcn_readlane(v, 0) + __builtin_amdgcn_readlane(v, 16)) + (__builtin_amdgcn_readlane(v, 32) + __builtin_amdgcn_readlane(v, 48));
}
__device__ __forceinline__ unsigned sortable(float f) { const unsigned bits = __float_as_uint(f); return bits ^ ((unsigned)((int)bits >> 31) | 0x80000000u); }
template <int NJ>
__device__ __forceinline__ void mask_words(const unsigned (&u)[NJ], unsigned prefix, bool exact, LAS unsigned long long* mrow, int nj, int lane) {
    unsigned long long mv = 0ull;
    if (exact) {
#pragma unroll
        for (int j = 0; j < NJ; ++j) { const unsigned long long sel = __ballot(u[j] >= prefix); if (lane == j) mv = sel; }
    } else {
        int ngt = 0;
#pragma unroll
        for (int j = 0; j < NJ; ++j) ngt += __popcll(__ballot(u[j] > prefix));
        int need = 256 - ngt;
#pragma unroll
        for (int j = 0; j < NJ; ++j) {
            const unsigned long long eq = __ballot(u[j] == prefix);
            const int rank = (int)__builtin_amdgcn_mbcnt_hi((unsigned)(eq >> 32), __builtin_amdgcn_mbcnt_lo((unsigned)eq, 0u));
            const unsigned long long sel = __ballot(u[j] > prefix || (u[j] == prefix && rank < need));
            need -= __popcll(eq);
            if (lane == j) mv = sel;
        }
    }
    if (lane < nj) mrow[lane] = mv;
}
template <int NJ>
__device__ __forceinline__ void select_row(const LAS float* row, LAS unsigned long long* mrow, int nj, int lane) {
    static_assert(NJ % 4 == 0, "groups of four");
    unsigned u[NJ];
#pragma unroll
    for (int j = 0; j < NJ; ++j) { float v = row[64 * j + lane]; asm volatile("" : "+v"(v)); u[j] = (j < nj) ? sortable(v) : 0u; }
    unsigned prefix = 0u; bool exact = false;
#pragma unroll 1
    for (int bit = 31; bit >= 0; --bit) {
        const unsigned trial = prefix | (1u << bit); int c0 = 0, c1 = 0, c2 = 0, c3 = 0;
#pragma unroll
        for (int j = 0; j < NJ; j += 4) {
            unsigned long long m0, m1, m2, m3;
            asm volatile("v_cmp_le_u32_e64 %4, %12, %8\n\tv_cmp_le_u32_e64 %5, %12, %9\n\tv_cmp_le_u32_e64 %6, %12, %10\n\tv_cmp_le_u32_e64 %7, %12, %11\n\t"
                         "v_addc_co_u32_e64 %0, %4, 0, %0, %4\n\tv_addc_co_u32_e64 %1, %5, 0, %1, %5\n\tv_addc_co_u32_e64 %2, %6, 0, %2, %6\n\tv_addc_co_u32_e64 %3, %7, 0, %3, %7"
                         : "+v"(c0), "+v"(c1), "+v"(c2), "+v"(c3), "=&s"(m0), "=&s"(m1), "=&s"(m2), "=&s"(m3) : "v"(u[j]), "v"(u[j + 1]), "v"(u[j + 2]), "v"(u[j + 3]), "s"(trial));
        }
        const int cnt = wave_sum_i((c0 + c1) + (c2 + c3));
        if (cnt >= 256) prefix = trial;
        if (cnt == 256) { exact = true; break; }
    }
    mask_words<NJ>(u, prefix, exact, mrow, nj, lane);
}
template <int S, unsigned M>
__device__ __forceinline__ void tr_stage(unsigned (&A)[32]) {
#pragma unroll
    for (int k = 0; k < 32; ++k) if (!(k & S)) {
        const unsigned a = A[k], b = A[k + S], bs = b << S, as = a >> S; unsigned lo, hi;
        asm("v_bfi_b32 %0, %1, %2, %3" : "=v"(lo) : "s"(M), "v"(a), "v"(bs)); asm("v_bfi_b32 %0, %1, %2, %3" : "=v"(hi) : "s"(M), "v"(as), "v"(b));
        A[k] = lo; A[k + S] = hi; }
}
__device__ __forceinline__ void tr_bytes(unsigned (&A)[32]) {
#pragma unroll
    for (int k = 0; k < 16; ++k) { const unsigned a = A[k], b = A[k + 16];
        A[k] = __builtin_amdgcn_perm(b, a, 0x05040100u);
        A[k + 16] = __builtin_amdgcn_perm(b, a, 0x07060302u); }
#pragma unroll
    for (int k = 0; k < 32; ++k) if (!(k & 8)) { const unsigned a = A[k], b = A[k + 8];
        A[k] = __builtin_amdgcn_perm(b, a, 0x06020400u);
        A[k + 8] = __builtin_amdgcn_perm(b, a, 0x07030501u); }
}
__device__ __forceinline__ void planes_finish(unsigned gt, unsigned alive, int G, bool done, LAS unsigned long long* mrow, int nj, int lane) {
    unsigned sel = gt | alive;
    if (!done) {
        int need = 256 - G; unsigned ts = 0u;
#pragma unroll
        for (int j = 0; j < 32; ++j) {
            const bool mine = (alive >> j) & 1u; const unsigned long long eq = __ballot(mine);
            const int rank = (int)__builtin_amdgcn_mbcnt_hi((unsigned)(eq >> 32), __builtin_amdgcn_mbcnt_lo((unsigned)eq, 0u));
            ts |= (mine && rank < need) ? (1u << j) : 0u; need -= __popcll(eq);
        }
        sel = gt | ts;
    }
    unsigned long long mv = 0ull;
#pragma unroll
    for (int j = 0; j < 32; ++j) { const unsigned long long w = __ballot((sel >> j) & 1u); if (lane == j) mv = w; }
    if (lane < nj) mrow[lane] = mv;
}
__device__ __forceinline__ void select_rows_planes2(const LAS float* rowa, const LAS float* rowb, LAS unsigned long long* mrowa, LAS unsigned long long* mrowb, int nj, int lane) {
    unsigned A[32], B[32];
#pragma unroll
    for (int j = 0; j < 32; ++j) { float va = rowa[64 * j + lane], vb = rowb[64 * j + lane]; asm volatile("" : "+v"(va), "+v"(vb)); A[j] = (j < nj) ? sortable(va) : 0u; B[j] = (j < nj) ? sortable(vb) : 0u; }
    tr_bytes(A); tr_stage<4, 0x0F0F0F0Fu>(A); tr_stage<2, 0x33333333u>(A); tr_stage<1, 0x55555555u>(A);
    tr_bytes(B); tr_stage<4, 0x0F0F0F0Fu>(B); tr_stage<2, 0x33333333u>(B); tr_stage<1, 0x55555555u>(B);
#pragma unroll
    for (int j = 0; j < 32; ++j) asm volatile("" : "+v"(A[j]), "+v"(B[j]));
    unsigned alivea = 0xFFFFFFFFu, gta = 0u, aliveb = 0xFFFFFFFFu, gtb = 0u; int Ga = 0, Aa = 2048, Gb = 0, Ab = 2048; bool donea = false, doneb = false;
#pragma unroll
    for (int b = 31; b >= 0; --b) {
        if (!(donea && doneb)) {
            const unsigned onesa = alivea & A[b], onesb = aliveb & B[b];
            const int both = wave_sum_i(__builtin_popcount(onesa) | (__builtin_popcount(onesb) << 16)), C1a = both & 0xffff, C1b = both >> 16;
            if (!donea) {
                if (Ga + C1a >= 256) { alivea = onesa; Aa = C1a; } else { Ga += C1a; gta |= onesa; alivea &= ~A[b]; Aa -= C1a; }
                donea = (Ga + Aa == 256);
            }
            if (!doneb) {
                if (Gb + C1b >= 256) { aliveb = onesb; Ab = C1b; } else { Gb += C1b; gtb |= onesb; aliveb &= ~B[b]; Ab -= C1b; }
                doneb = (Gb + Ab == 256);
            }
        }
    }
    planes_finish(gta, alivea, Ga, donea, mrowa, nj, lane);
    planes_finish(gtb, aliveb, Gb, doneb, mrowb, nj, lane);
}
constexpr int MP_STRIDE = 36, MP_PLANE = 64 * MP_STRIDE;
__device__ __forceinline__ unsigned row32_sum(unsigned v) {
    v += __builtin_amdgcn_update_dpp(0, v, 0xB1, 0xF, 0xF, true);
    v += __builtin_amdgcn_update_dpp(0, v, 0x4E, 0xF, 0xF, true);
    v += __builtin_amdgcn_update_dpp(0, v, 0x141, 0xF, 0xF, true);
    v += __builtin_amdgcn_update_dpp(0, v, 0x140, 0xF, 0xF, true);
#if defined(SWZ_SUM)
    return v + (unsigned)__builtin_amdgcn_ds_swizzle((int)v, 0x401F);
#else
    const auto sw = __builtin_amdgcn_permlane16_swap(v, v, false, false);
    return (unsigned)sw[0] + (unsigned)sw[1];
#endif
}
__device__ __forceinline__ void tr16(unsigned (&T)[16]) {
#pragma unroll
    for (int k = 0; k < 8; ++k) { const unsigned a = T[k], b = T[k + 8];
        T[k] = __builtin_amdgcn_perm(b, a, 0x06020400u);
        T[k + 8] = __builtin_amdgcn_perm(b, a, 0x07030501u); }
#define TR16_STAGE(S, M) _Pragma("unroll") for (int k = 0; k < 16; ++k) if (!(k & S)) { const unsigned a = T[k], b = T[k + S], bs = b << S, as = a >> S; unsigned lo, hi; \
        asm("v_bfi_b32 %0, %1, %2, %3" : "=v"(lo) : "s"(M), "v"(a), "v"(bs)); asm("v_bfi_b32 %0, %1, %2, %3" : "=v"(hi) : "s"(M), "v"(as), "v"(b)); T[k] = lo; T[k + S] = hi; }
    TR16_STAGE(4, 0x0F0F0F0Fu) TR16_STAGE(2, 0x33333333u) TR16_STAGE(1, 0x55555555u)
#undef TR16_STAGE
}
__device__ __forceinline__ void select_rows32(const LAS unsigned* sc, LAS unsigned* mp, int rq, int nj, int wave, int lane) {
    const int half = lane >> 5, l32 = lane & 31, ql = wave + 8 * half;
    const LAS unsigned* row = sc + ql * SCW + l32;
    unsigned A[16], B[16];
#ifdef ASM_MARK
    asm volatile("; SEL_BEGIN");
#endif
#pragma unroll
    for (int k = 0; k < 16; ++k) { unsigned va = row[32 * k], vb = row[32 * (16 + k)]; asm volatile("" : "+v"(va), "+v"(vb)); A[k] = va; B[k] = vb; }
    tr16(A); tr16(B);
#ifdef ASM_MARK
    asm volatile("; SEL_TR_END");
#endif
    const int nv = 2 * nj;
    unsigned al0 = nv >= 32 ? 0xFFFFFFFFu : ((1u << nv) - 1u), al1 = nv <= 32 ? 0u : (nv >= 64 ? 0xFFFFFFFFu : ((1u << (nv - 32)) - 1u));
    unsigned gt0 = 0u, gt1 = 0u, G = 0u;
    const unsigned S0 = A[15], S1 = B[15];
#pragma unroll
    for (int b = 15; b >= 0; --b) {
        const unsigned o0 = b == 15 ? (al0 & ~S0) : __builtin_amdgcn_bitop3_b32(al0, A[b], S0, 0x60), o1 = b == 15 ? (al1 & ~S1) : __builtin_amdgcn_bitop3_b32(al1, B[b], S1, 0x60);
        const unsigned c1 = row32_sum((unsigned)__builtin_popcount(o0) + (unsigned)__builtin_popcount(o1));
        const unsigned nt = (unsigned)((int)(G + c1 - 256u) >> 31);
        al0 = __builtin_amdgcn_bitop3_b32(o0, al0, nt, 0x78); al1 = __builtin_amdgcn_bitop3_b32(o1, al1, nt, 0x78);
        gt0 = __builtin_amdgcn_bitop3_b32(gt0, o0, nt, 0xF8); gt1 = __builtin_amdgcn_bitop3_b32(gt1, o1, nt, 0xF8);
        G += c1 & nt;
    }
#ifdef ASM_MARK
    asm volatile("; SEL_LOOP_END");
#endif
    const unsigned ce = row32_sum((unsigned)__builtin_popcount(al0) + (unsigned)__builtin_popcount(al1));
    const bool tie = G + ce != 256u;
    if (__any(tie)) {
        const unsigned need = tie ? 256u - G : 0x7fffffffu; unsigned m = 0u;
#pragma unroll
        for (int bit = 6; bit >= 0; --bit) {
            const unsigned cand = m + (1u << bit);
            const unsigned k0 = cand >= 32u ? 0xFFFFFFFFu : ((1u << cand) - 1u), k1 = cand <= 32u ? 0u : (cand >= 64u ? 0xFFFFFFFFu : ((1u << (cand - 32u)) - 1u));
            const unsigned cc = row32_sum((unsigned)__builtin_popcount(al0 & k0) + (unsigned)__builtin_popcount(al1 & k1));
            m = (cand <= 64u && cc <= need) ? cand : m;
        }
        const unsigned k0 = m >= 32u ? 0xFFFFFFFFu : ((1u << m) - 1u), k1 = m <= 32u ? 0u : (m >= 64u ? 0xFFFFFFFFu : ((1u << (m - 32u)) - 1u));
        const unsigned cm = row32_sum((unsigned)__builtin_popcount(al0 & k0) + (unsigned)__builtin_popcount(al1 & k1));
        const unsigned rem = need - cm;
        const bool mine = m < 64u && (((m < 32u ? al0 >> m : al1 >> (m - 32u)) & 1u) != 0u);
        const unsigned long long eq = __ballot(mine); const unsigned eqr = half ? (unsigned)(eq >> 32) : (unsigned)eq;
        const bool tk = mine && (unsigned)__builtin_popcount(eqr & ((1u << l32) - 1u)) < rem;
        al0 = (al0 & k0) | ((tk && m < 32u) ? (1u << m) : 0u); al1 = (al1 & k1) | ((tk && m >= 32u) ? (1u << (m - 32u)) : 0u);
    }
#ifdef ASM_MARK
    asm volatile("; SEL_TIE_END");
#endif
    LAS unsigned* rec = mp + (16 * rq + ql) * MP_STRIDE + l32;
    rec[0] = gt0 | al0; rec[MP_PLANE] = gt1 | al1;
}
constexpr int AT_K = 0, AT_V = 32768, AT_BT = 65536, AT_WS = 73728, AT_OST = 0, AT_Q = 75776;
static_assert(AT_Q + 65536 <= P2_MASK && AT_OST + 8 * 4608 <= AT_BT, "attention LDS map");
__device__ __forceinline__ bf16x8 pk16(const f32x16& v, int o) { return __builtin_bit_cast(bf16x8, (v4u){pkbf(v[o], v[o + 1]), pkbf(v[o + 2], v[o + 3]), pkbf(v[o + 4], v[o + 5]), pkbf(v[o + 6], v[o + 7])}); }
__device__ __forceinline__ void glds16(const void* gsrc, unsigned lds_dst) {
    unsigned keep;
    asm volatile("s_mov_b32 %0, m0\n\ts_mov_b32 m0, %2\n\ts_nop 0\n\tglobal_load_lds_dwordx4 %1, off\n\ts_mov_b32 m0, %0" : "=&s"(keep) : "v"(gsrc), "s"(lds_dst) : "memory");
}
__device__ __forceinline__ unsigned lds_addr(const LAS unsigned char* p) { return (unsigned)(uintptr_t)p; }
template <bool MASK, bool NEAR>
__device__ __forceinline__ void attn_soft(f32x16& p0, f32x16& p1, f32x2v& lacc, bf16x8 (&pa)[4], const LAS unsigned* mrec, int sbit) {
#pragma unroll
    for (int i = 0; i < 16; ++i) { p0[i] = __builtin_amdgcn_exp2f(p0[i]); p1[i] = __builtin_amdgcn_exp2f(p1[i]); }
    if (MASK) {
#pragma unroll
        for (int g = 0; g < 4; ++g) {
            const v4u w4 = *(const LAS v4u*)(mrec + 8 * g);
#pragma unroll
            for (int k = 0; k < 4; ++k) { int m0_, m1_; asm("v_bfe_i32 %0, %1, %2, 1" : "=v"(m0_) : "v"(w4[k]), "s"(sbit)); asm("v_bfe_i32 %0, %1, %2, 1" : "=v"(m1_) : "v"(w4[k]), "s"(sbit + 1));
                p0[4 * g + k] = __uint_as_float(__float_as_uint(p0[4 * g + k]) & (unsigned)m0_); p1[4 * g + k] = __uint_as_float(__float_as_uint(p1[4 * g + k]) & (unsigned)m1_); }
        }
    }
#pragma unroll
    for (int i = 0; i < 16; i += 2) { lacc += (f32x2v){p0[i], p0[i + 1]}; lacc += (f32x2v){p1[i], p1[i + 1]}; }
    pa[0] = pk16(p0, 0); pa[1] = pk16(p0, 8); pa[2] = pk16(p1, 0); pa[3] = pk16(p1, 8);
}
__device__ __forceinline__ void attn_pv(f32x16& o0, f32x16& o1, const bf16x8 (&pa)[4], const LAS unsigned char* Vb) {
#pragma unroll
    for (int ks = 0; ks < 4; ++ks) {
        o0 = __builtin_amdgcn_mfma_f32_32x32x16_bf16(pa[ks], cat8(vtr(Vb + ks * 1024), vtr(Vb + ks * 1024 + 512)), o0, 0, 0, 0);
        o1 = __builtin_amdgcn_mfma_f32_32x32x16_bf16(pa[ks], cat8(vtr(Vb + 4096 + ks * 1024), vtr(Vb + 4096 + ks * 1024 + 512)), o1, 0, 0, 0);
    }
}
template <bool NEAR>
__device__ __forceinline__ void attn_qk(f32x16& a0, f32x16& a1, f32x16& b0, f32x16& b1, const LAS unsigned char* Qb, const LAS unsigned char* Kb, const LAS float* bt) {
#pragma unroll
    for (int i = 0; i < 16; ++i) {
        if (NEAR) { a0[i] = bt[(i & 3) + 8 * (i >> 2)]; a1[i] = bt[32 + (i & 3) + 8 * (i >> 2)]; b0[i] = bt[(i & 3) + 8 * (i >> 2) - 32]; b1[i] = bt[(i & 3) + 8 * (i >> 2)]; }
        else { a0[i] = 0.f; a1[i] = 0.f; b0[i] = 0.f; b1[i] = 0.f; }
    }
#pragma unroll
    for (int d0 = 0; d0 < 4; ++d0) {
        const bf16x8 k0 = *(const LAS bf16x8*)(Kb + d0 * 2048), k1 = *(const LAS bf16x8*)(Kb + d0 * 2048 + 512);
        const bf16x8 qfa = *(const LAS bf16x8*)(Qb + d0 * 1024), qfb = *(const LAS bf16x8*)(Qb + 4096 + d0 * 1024);
        a0 = __builtin_amdgcn_mfma_f32_32x32x16_bf16(k0, qfa, a0, 0, 0, 0); a1 = __builtin_amdgcn_mfma_f32_32x32x16_bf16(k1, qfa, a1, 0, 0, 0);
        b0 = __builtin_amdgcn_mfma_f32_32x32x16_bf16(k0, qfb, b0, 0, 0, 0); b1 = __builtin_amdgcn_mfma_f32_32x32x16_bf16(k1, qfb, b1, 0, 0, 0);
    }
}
__device__ __forceinline__ void attn_store(const f32x16& o0, const f32x16& o1, f32x2v lacc, bf16* obase, LAS unsigned char* stg, LAS float* wsf, int lane) {
    const int r = lane & 31, hi = lane >> 5;
    float lsum = lacc[0] + lacc[1];
    lsum += __shfl_xor(lsum, 32);
    if (hi == 0) wsf[r] = lsum;
    LDS_WAIT(); asm volatile("" ::: "memory");
    LAS unsigned short* st = (LAS unsigned short*)stg;
#pragma unroll
    for (int i = 0; i < 16; ++i) {
        const int q = crow(i, hi); const float rl = 1.0f / wsf[q];
        st[q * 72 + r] = (unsigned short)(pkbf(o0[i] * rl, 0.f) & 0xffffu); st[q * 72 + 32 + r] = (unsigned short)(pkbf(o1[i] * rl, 0.f) & 0xffffu);
    }
    LDS_WAIT(); asm volatile("" ::: "memory");
#pragma unroll
    for (int k = 0; k < 4; ++k) { const int row = 8 * k + (lane >> 3), ch = lane & 7;
        const v4u v = *(const LAS v4u*)(stg + row * 144 + ch * 16); *(v4u*)(obase + (size_t)row * DM + ch * 8) = v; }
    LDS_WAIT(); asm volatile("" ::: "memory");
}
template <bool MASK>
__device__ __forceinline__ void attn_chunk(const Frame& F, int b, int c, LAS unsigned char* lds) {
    const int wid = F.wave, lane = F.lane, r = lane & 31, hi = lane >> 5;
    const size_t rowbase = (size_t)b * SEQ; const int q0 = 64 * c, nt = c + 1;
    const LAS unsigned char* Qb = lds + AT_Q + wid * 8192 + lane * 16;
#pragma unroll
    for (int d0 = 0; d0 < 4; ++d0) {
        *(LAS bf16x8*)(lds + AT_Q + wid * 8192 + d0 * 1024 + lane * 16) = *(const bf16x8*)(F.QA() + (rowbase + q0 + r) * 512 + wid * 64 + 16 * d0 + 8 * hi);
        *(LAS bf16x8*)(lds + AT_Q + wid * 8192 + 4096 + d0 * 1024 + lane * 16) = *(const bf16x8*)(F.QA() + (rowbase + q0 + 32 + r) * 512 + wid * 64 + 16 * d0 + 8 * hi); }
    const LAS float* BT = (const LAS float*)(lds + AT_BT) + wid * 256;
    const bf16* ksrc = F.KA() + (rowbase + lane) * 64 + 8 * wid;
    const bf16* vsrc = F.VA() + (rowbase + 16 * (wid & 3) + (lane >> 2)) * 64 + (wid >> 2) * 32 + (lane & 3) * 8;
    const LAS unsigned* mreca = (const LAS unsigned*)(lds + P2_MASK) + r * MP_STRIDE + 4 * hi; const LAS unsigned* mrecb = mreca + 32 * MP_STRIDE;
    const int voff = ((lane >> 4) & 1) * 32 + (lane & 3) * 8 + (4 * hi + ((lane & 15) >> 2)) * 64;
    f32x16 oa0, oa1, ob0, ob1; f32x2v la = {0.f, 0.f}, lb = {0.f, 0.f};
#pragma unroll
    for (int i = 0; i < 16; ++i) { oa0[i] = 0.f; oa1[i] = 0.f; ob0[i] = 0.f; ob1[i] = 0.f; }
#define AT_BAR() do { __builtin_amdgcn_sched_barrier(0); asm volatile("s_waitcnt lgkmcnt(0)" ::: "memory"); __builtin_amdgcn_s_barrier(); asm volatile("" ::: "memory"); __builtin_amdgcn_sched_barrier(0); } while (0)
#define AT_DMA(t_, slot_) do { const int tn_ = (t_) < nt ? (t_) : nt - 1;     \
        glds16(ksrc + (size_t)tn_ * 64 * 64, (unsigned)__builtin_amdgcn_readfirstlane((int)lds_addr(lds + AT_K + (slot_) * 8192 + wid * 1024))); \
        glds16(vsrc + (size_t)tn_ * 64 * 64, (unsigned)__builtin_amdgcn_readfirstlane((int)lds_addr(lds + AT_V + (slot_) * 8192 + wid * 1024))); } while (0)
    AT_DMA(0, 0); AT_DMA(1, 1); AT_DMA(2, 2);
    asm volatile("s_waitcnt vmcnt(0)" ::: "memory");
    AT_BAR();
    if (wid >= 4) AT_BAR();
    const int nfar = c >= 2 ? c - 2 : 0;
#if defined(PROBE_TIMER) && PROBE_TIMER == 3
    const unsigned long long pa0_ = __builtin_amdgcn_s_memtime();
#endif
    f32x16 a0, a1, b0, b1; bf16x8 pa[4], pb[4];
#if defined(PROBE_TIMER) && PROBE_TIMER >= 4
    unsigned psum_ = 0u;
#endif
    {
        const LAS unsigned char* Kb = lds + AT_K + hi * 1024 + r * 16; const LAS float* bt = BT + (64 * (0 - c) + 191 - r + 4 * hi);
        if (0 < nfar) attn_qk<false>(a0, a1, b0, b1, Qb, Kb, bt); else attn_qk<true>(a0, a1, b0, b1, Qb, Kb, bt);
        AT_BAR();
    }
#pragma unroll 1
    for (int t = 0; t < nt; ++t) {
        const int pl_ = (t >> 4) * MP_PLANE, sbit = (2 * t) & 31;
#ifdef NOSOFT
        { const bf16x8 c_ = {0x3c00, 0x3c00, 0x3c00, 0x3c00, 0x3c00, 0x3c00, 0x3c00, 0x3c00}; pa[0] = c_; pa[1] = c_; pa[2] = c_; pa[3] = c_; pb[0] = c_; pb[1] = c_; pb[2] = c_; pb[3] = c_; la += (f32x2v){a0[0], b0[0]}; }
#else
#if defined(PROBE_TIMER) && PROBE_TIMER == 4
        __builtin_amdgcn_sched_barrier(0); const unsigned long long pv0_ = __builtin_amdgcn_s_memtime(); __builtin_amdgcn_sched_barrier(0);
#endif
        attn_soft<MASK, false>(a0, a1, la, pa, mreca + pl_, sbit);
        attn_soft<MASK, false>(b0, b1, lb, pb, mrecb + pl_, sbit);
#if defined(PROBE_TIMER) && PROBE_TIMER == 4
        __builtin_amdgcn_sched_barrier(0); asm volatile("s_nop 0" : : "v"(pa[0]), "v"(pa[1]), "v"(pa[2]), "v"(pa[3]), "v"(pb[0]), "v"(pb[1]), "v"(pb[2]), "v"(pb[3]), "v"(la), "v"(lb)); psum_ += (unsigned)(__builtin_amdgcn_s_memtime() - pv0_); __builtin_amdgcn_sched_barrier(0);
#endif
#endif
#if defined(PROBE_TIMER) && PROBE_TIMER == 6
        __builtin_amdgcn_sched_barrier(0); asm volatile("s_nop 0" : : "v"(pa[0]), "v"(pa[3]), "v"(pb[0]), "v"(pb[3]), "v"(la), "v"(lb)); const unsigned long long pw0_ = __builtin_amdgcn_s_memtime();
#endif
        AT_BAR();
#if defined(PROBE_TIMER) && PROBE_TIMER == 6
        psum_ += (unsigned)(__builtin_amdgcn_s_memtime() - pw0_);
#endif
#if defined(PROBE_TIMER) && PROBE_TIMER == 5
        const unsigned long long pm0_ = __builtin_amdgcn_s_memtime();
#endif
        AT_DMA(t + 3, (t + 3) & 3);
        const LAS unsigned char* Vb = lds + AT_V + (t & 3) * 8192 + voff;
#pragma unroll
        for (int ks = 0; ks < 4; ++ks) {
            const bf16x8 v0 = cat8(vtr(Vb + ks * 1024), vtr(Vb + ks * 1024 + 512)), v1 = cat8(vtr(Vb + 4096 + ks * 1024), vtr(Vb + 4096 + ks * 1024 + 512));
            oa0 = __builtin_amdgcn_mfma_f32_32x32x16_bf16(pa[ks], v0, oa0, 0, 0, 0); ob0 = __builtin_amdgcn_mfma_f32_32x32x16_bf16(pb[ks], v0, ob0, 0, 0, 0);
            oa1 = __builtin_amdgcn_mfma_f32_32x32x16_bf16(pa[ks], v1, oa1, 0, 0, 0); ob1 = __builtin_amdgcn_mfma_f32_32x32x16_bf16(pb[ks], v1, ob1, 0, 0, 0);
        }
        if (t + 1 < nt) {
            const LAS unsigned char* Kb = lds + AT_K + ((t + 1) & 3) * 8192 + hi * 1024 + r * 16; const LAS float* bt = BT + (64 * (t + 1 - c) + 191 - r + 4 * hi);
            if (t + 1 < nfar) attn_qk<false>(a0, a1, b0, b1, Qb, Kb, bt); else attn_qk<true>(a0, a1, b0, b1, Qb, Kb, bt);
        }
#if defined(PROBE_TIMER) && PROBE_TIMER == 5
        asm volatile("s_nop 15\n\ts_nop 15" : : "v"(oa0), "v"(ob1), "v"(a0), "v"(b1)); psum_ += (unsigned)(__builtin_amdgcn_s_memtime() - pm0_);
#endif
#if defined(PROBE_TIMER) && PROBE_TIMER == 7
        __builtin_amdgcn_sched_barrier(0); asm volatile("s_nop 15\n\ts_nop 15" : : "v"(oa0), "v"(ob1), "v"(a0), "v"(b1)); const unsigned long long px0_ = __builtin_amdgcn_s_memtime();
#endif
        asm volatile("s_waitcnt vmcnt(2)" ::: "memory");
        AT_BAR();
#if defined(PROBE_TIMER) && PROBE_TIMER == 7
        psum_ += (unsigned)(__builtin_amdgcn_s_memtime() - px0_);
#endif
    }
#if defined(PROBE_TIMER) && PROBE_TIMER >= 4
    if (F.tid == 0 && nt >= 16) { volatile LAS unsigned* pm_ = (volatile LAS unsigned*)(lds + MISC_OFF); pm_[16] += psum_; pm_[17] += (unsigned)nt; }
#endif
#if defined(PROBE_TIMER) && PROBE_TIMER == 3
    if (F.tid == 0 && nt >= 16) { volatile LAS unsigned* pm_ = (volatile LAS unsigned*)(lds + MISC_OFF); pm_[16] += (unsigned)(__builtin_amdgcn_s_memtime() - pa0_); pm_[17] += (unsigned)nt; }
#endif
    asm volatile("s_waitcnt vmcnt(0)" ::: "memory");
    if (wid < 4) AT_BAR();
    AT_BAR();
#undef AT_BAR
#undef AT_DMA
    LAS float* wsf = (LAS float*)(lds + AT_WS) + wid * 64; LAS unsigned char* stg = lds + AT_OST + wid * 4608;
    attn_store(oa0, oa1, la, F.MIX() + (rowbase + q0) * DM + wid * 64, stg, wsf, lane);
    attn_store(ob0, ob1, lb, F.MIX() + (rowbase + q0 + 32) * DM + wid * 64, stg, wsf, lane);
}
__device__ __forceinline__ void attn_unit(const Frame& F, int b, int c, LAS unsigned char* lds) {
    if (c >= 4) {
        const int nj = c + 1;
        IdxOps ops; idx_fetch(ops, F, b, c, 0);
#if defined(PROBE_TIMER) && PROBE_TIMER >= 10
        unsigned ps_ = 0u;
#define PT0_(k) unsigned long long pt_##k = 0; if (PROBE_TIMER == (k)) { __builtin_amdgcn_sched_barrier(0); pt_##k = __builtin_amdgcn_s_memtime(); __builtin_amdgcn_sched_barrier(0); }
#define PT1_(k) if (PROBE_TIMER == (k)) { __builtin_amdgcn_sched_barrier(0); ps_ += (unsigned)(__builtin_amdgcn_s_memtime() - pt_##k); __builtin_amdgcn_sched_barrier(0); }
#else
#define PT0_(k)
#define PT1_(k)
#endif
        for (int rq = 0; rq < ((MIXREP & 2) ? 8 : 4); ++rq) {
            PT0_(10)
            idx_round(ops, F, b, c, lds);
            idx_fetch(ops, F, b, c, (rq + 1) & 3);
            asm volatile("s_waitcnt lgkmcnt(0)" ::: "memory");
            PT1_(10)
            PT0_(11)
            __syncthreads();
            PT1_(11)
            PT0_(12)
            select_rows32((const LAS unsigned*)(lds + P2_SC), (LAS unsigned*)(lds + P2_MASK), rq & 3, nj, F.wave, F.lane);
            asm volatile("s_waitcnt lgkmcnt(0)" ::: "memory");
            PT1_(12)
            PT0_(13)
            __syncthreads();
            PT1_(13)
        }
#if defined(PROBE_TIMER) && PROBE_TIMER >= 10
        if (F.tid == 0 && c >= 15) { volatile LAS unsigned* pm_ = (volatile LAS unsigned*)(lds + MISC_OFF); pm_[16] += ps_; pm_[17] += 4u; }
#endif
#undef PT0_
#undef PT1_
    }
    { const f32x4 v = *(const f32x4*)(F.BT() + F.tid * 4); *(LAS f32x4*)(lds + AT_BT + F.tid * 16) = v; }
    __syncthreads();
    if (c >= 4) attn_chunk<true>(F, b, c, lds); else attn_chunk<false>(F, b, c, lds);
}

constexpr int RT_TAB = 131072;
__device__ __forceinline__ void ret_stage(const bf16* vsrc, const bf16* ksrc, LAS unsigned char* region) {
#pragma unroll
    for (int k = 0; k < 8; ++k) {
        const size_t o = (size_t)(16 * (k & 3)) * 512 + 32 * (k >> 2);
        __builtin_amdgcn_global_load_lds((const unsigned*)(vsrc + o), (LAS unsigned*)(region + k * 1024), 16, 0, 0);
        __builtin_amdgcn_global_load_lds((const unsigned*)(ksrc + o), (LAS unsigned*)(region + 8192 + k * 1024), 16, 0, 0);
    }
}
__device__ __forceinline__ void ret_kv(f32x16 (&T)[2][2], const LAS unsigned char* img) {
#pragma unroll
    for (int ks = 0; ks < 4; ++ks) {
        const bf16x8 k0 = cat8(vtr(img + 8192 + ks * 1024), vtr(img + 8192 + ks * 1024 + 512)), k1 = cat8(vtr(img + 8192 + 4096 + ks * 1024), vtr(img + 8192 + 4096 + ks * 1024 + 512));
        const bf16x8 v0 = cat8(vtr(img + ks * 1024), vtr(img + ks * 1024 + 512)), v1 = cat8(vtr(img + 4096 + ks * 1024), vtr(img + 4096 + ks * 1024 + 512));
        T[0][0] = __builtin_amdgcn_mfma_f32_32x32x16_bf16(k0, v0, T[0][0], 0, 0, 0); T[0][1] = __builtin_amdgcn_mfma_f32_32x32x16_bf16(k0, v1, T[0][1], 0, 0, 0);
        T[1][0] = __builtin_amdgcn_mfma_f32_32x32x16_bf16(k1, v0, T[1][0], 0, 0, 0); T[1][1] = __builtin_amdgcn_mfma_f32_32x32x16_bf16(k1, v1, T[1][1], 0, 0, 0);
    }
}
__device__ __forceinline__ void ret_unit(const Frame& F, int b, int h, LAS unsigned char* lds) {
    const int lane = F.lane, w = F.wave, r = lane & 31, hi = lane >> 5;
    const float gam = 1.0f - exp2f(-5.0f - (float)h), lg2 = log2f(gam), cd = exp2f(64.0f * lg2), cd4 = exp2f(256.0f * lg2);
    LAS unsigned char* region = lds + w * 16384;
    const LAS unsigned char* img = region + ((lane >> 4) & 1) * 32 + (lane & 3) * 8 + (4 * hi + ((lane & 15) >> 2)) * 64;
    LAS float* tab = (LAS float*)(lds + RT_TAB);
    __syncthreads();
    if (F.tid < 128) tab[F.tid] = F.tid < 64 ? F.ret_gn_w()[h * 64 + F.tid] : F.ret_gn_b()[h * 64 + F.tid - 64];
    const size_t hbase = (size_t)b * SEQ * 512 + h * 64;
    const size_t stg = hbase + (size_t)(lane >> 2) * 512 + (lane & 3) * 8;
    f32x16 T[2][2];
#pragma unroll
    for (int i = 0; i < 16; ++i) { T[0][0][i] = 0.f; T[0][1][i] = 0.f; T[1][0][i] = 0.f; T[1][1][i] = 0.f; }
#pragma unroll 1
    for (int i = 0; i < 4; ++i) {
        const size_t co = (size_t)(4 * w + i) * 64 * 512;
        ret_stage(F.VB() + stg + co, F.KB() + stg + co, region);
        if (i) {
#pragma unroll
            for (int k = 0; k < 16; ++k) { T[0][0][k] *= cd; T[0][1][k] *= cd; T[1][0][k] *= cd; T[1][1][k] *= cd; }
        }
        asm volatile("s_waitcnt vmcnt(0)" ::: "memory");
        ret_kv(T, img);
        LDS_WAIT();
    }
#pragma unroll
    for (int eb = 0; eb < 2; ++eb)
#pragma unroll
        for (int db = 0; db < 2; ++db)
#pragma unroll
            for (int g = 0; g < 4; ++g) *(LAS f32x4*)(region + ((eb * 2 + db) * 4 + g) * 1024 + lane * 16) = (f32x4){T[eb][db][4 * g], T[eb][db][4 * g + 1], T[eb][db][4 * g + 2], T[eb][db][4 * g + 3]};
    __syncthreads();
#pragma unroll
    for (int i = 0; i < 16; ++i) { T[0][0][i] = 0.f; T[0][1][i] = 0.f; T[1][0][i] = 0.f; T[1][1][i] = 0.f; }
#pragma unroll 1
    for (int wp = 0; wp < w; ++wp) {
        const LAS unsigned char* src = lds + wp * 16384 + lane * 16;
#pragma unroll
        for (int eb = 0; eb < 2; ++eb)
#pragma unroll
            for (int db = 0; db < 2; ++db)
#pragma unroll
                for (int g = 0; g < 4; ++g) { const f32x4 v = *(const LAS f32x4*)(src + ((eb * 2 + db) * 4 + g) * 1024);
                    T[eb][db][4 * g] = T[eb][db][4 * g] * cd4 + v[0]; T[eb][db][4 * g + 1] = T[eb][db][4 * g + 1] * cd4 + v[1]; T[eb][db][4 * g + 2] = T[eb][db][4 * g + 2] * cd4 + v[2]; T[eb][db][4 * g + 3] = T[eb][db][4 * g + 3] * cd4 + v[3]; }
    }
    __syncthreads();
#pragma unroll 1
    for (int i = 0; i < 4; ++i) {
        const int n = 4 * w + i; const size_t co = (size_t)n * 64 * 512;
        ret_stage(F.VB() + stg + co, F.KB() + stg + co, region);
#pragma unroll
        for (int k = 0; k < 16; ++k) { T[0][0][k] *= cd; T[0][1][k] *= cd; T[1][0][k] *= cd; T[1][1][k] *= cd; }
        const bf16* qrow = F.QB() + hbase + co + (size_t)r * 512 + 8 * hi;
        const bf16* krow = F.KB() + hbase + co + (size_t)r * 512 + 8 * hi;
#pragma unroll 1
        for (int ib = 0; ib < 2; ++ib) {
            bf16x8 qf[4], kf[4];
#pragma unroll
            for (int s = 0; s < 4; ++s) { qf[s] = *(const bf16x8*)(qrow + (size_t)(32 * ib) * 512 + 16 * s); kf[s] = *(const bf16x8*)(krow + 16 * s); }
            const size_t tok = (size_t)b * SEQ + 64 * n + 32 * ib + r;
            const bf16* grow = F.GB() + tok * 512 + h * 64 + 4 * hi;
            v2u gq[2][4];
#pragma unroll
            for (int db = 0; db < 2; ++db)
#pragma unroll
                for (int g = 0; g < 4; ++g) gq[db][g] = *(const v2u*)(grow + 32 * db + 8 * g);
            f32x16 s0, s1;
#pragma unroll
            for (int k = 0; k < 16; ++k) { s0[k] = 0.f; s1[k] = 0.f; }
#pragma unroll
            for (int s = 0; s < 4; ++s) s0 = __builtin_amdgcn_mfma_f32_32x32x16_bf16(kf[s], qf[s], s0, 0, 0, 0);
            if (ib == 1) {
#pragma unroll
                for (int s = 0; s < 4; ++s) kf[s] = *(const bf16x8*)(krow + (size_t)32 * 512 + 16 * s);
#pragma unroll
                for (int s = 0; s < 4; ++s) s1 = __builtin_amdgcn_mfma_f32_32x32x16_bf16(kf[s], qf[s], s1, 0, 0, 0);
#pragma unroll
                for (int k = 0; k < 16; ++k) s1[k] = (r >= crow(k, hi)) ? s1[k] : 0.f;
            } else {
#pragma unroll
                for (int k = 0; k < 16; ++k) s0[k] = (r >= crow(k, hi)) ? s0[k] : 0.f;
            }
#pragma unroll
            for (int s = 0; s < 4; ++s) {
                v4u q4 = __builtin_bit_cast(v4u, qf[s]);
                auto x0 = __builtin_amdgcn_permlane32_swap(q4[0], q4[2], false, false); auto x1 = __builtin_amdgcn_permlane32_swap(q4[1], q4[3], false, false);
                q4[0] = x0[0]; q4[2] = x0[1]; q4[1] = x1[0]; q4[3] = x1[1];
                qf[s] = __builtin_bit_cast(bf16x8, q4);
            }
            asm volatile("s_waitcnt vmcnt(0)" ::: "memory");
            f32x16 y0, y1;
#pragma unroll
            for (int k = 0; k < 16; ++k) { y0[k] = 0.f; y1[k] = 0.f; }
#pragma unroll
            for (int eb = 0; eb < 2; ++eb)
#pragma unroll
                for (int s2 = 0; s2 < 2; ++s2) {
                    y0 = __builtin_amdgcn_mfma_f32_32x32x16_bf16(pk16(T[eb][0], 8 * s2), qf[2 * eb + s2], y0, 0, 0, 0);
                    y1 = __builtin_amdgcn_mfma_f32_32x32x16_bf16(pk16(T[eb][1], 8 * s2), qf[2 * eb + s2], y1, 0, 0, 0);
                }
#pragma unroll
            for (int ks = 0; ks < 2; ++ks) {
                const bf16x8 pb = pk16(s0, 8 * ks);
                y0 = __builtin_amdgcn_mfma_f32_32x32x16_bf16(cat8(vtr(img + ks * 1024), vtr(img + ks * 1024 + 512)), pb, y0, 0, 0, 0);
                y1 = __builtin_amdgcn_mfma_f32_32x32x16_bf16(cat8(vtr(img + 4096 + ks * 1024), vtr(img + 4096 + ks * 1024 + 512)), pb, y1, 0, 0, 0);
            }
            if (ib == 1) {
#pragma unroll
                for (int ks = 0; ks < 2; ++ks) {
                    const bf16x8 pb = pk16(s1, 8 * ks);
                    y0 = __builtin_amdgcn_mfma_f32_32x32x16_bf16(cat8(vtr(img + (2 + ks) * 1024), vtr(img + (2 + ks) * 1024 + 512)), pb, y0, 0, 0, 0);
                    y1 = __builtin_amdgcn_mfma_f32_32x32x16_bf16(cat8(vtr(img + 4096 + (2 + ks) * 1024), vtr(img + 4096 + (2 + ks) * 1024 + 512)), pb, y1, 0, 0, 0);
                }
            }
            float sm = 0.f;
#pragma unroll
            for (int k = 0; k < 16; ++k) sm += y0[k] + y1[k];
            sm += __shfl_xor(sm, 32);
            const float mean = sm * (1.0f / 64.0f); float vr = 0.f;
#pragma unroll
            for (int k = 0; k < 16; ++k) { y0[k] -= mean; y1[k] -= mean; vr += y0[k] * y0[k] + y1[k] * y1[k]; }
            vr += __shfl_xor(vr, 32);
            const float rstd = 1.0f / sqrtf(vr * (1.0f / 64.0f) + 1e-5f);
            bf16* orow = F.MIX() + tok * DM + 512 + h * 64 + 4 * hi;
#pragma unroll
            for (int g = 0; g < 4; ++g) {
                const f32x4 w0 = *(const LAS f32x4*)(tab + 8 * g + 4 * hi), b0 = *(const LAS f32x4*)(tab + 64 + 8 * g + 4 * hi), w1 = *(const LAS f32x4*)(tab + 32 + 8 * g + 4 * hi), b1 = *(const LAS f32x4*)(tab + 96 + 8 * g + 4 * hi);
                const v2u g0 = gq[0][g], g1 = gq[1][g];
                *(v2u*)(orow + 8 * g) = (v2u){pkbf((y0[4 * g] * rstd * w0[0] + b0[0]) * bflo(g0[0]), (y0[4 * g + 1] * rstd * w0[1] + b0[1]) * bfhi(g0[0])),
                                              pkbf((y0[4 * g + 2] * rstd * w0[2] + b0[2]) * bflo(g0[1]), (y0[4 * g + 3] * rstd * w0[3] + b0[3]) * bfhi(g0[1]))};
                *(v2u*)(orow + 32 + 8 * g) = (v2u){pkbf((y1[4 * g] * rstd * w1[0] + b1[0]) * bflo(g1[0]), (y1[4 * g + 1] * rstd * w1[1] + b1[1]) * bfhi(g1[0])),
                                                   pkbf((y1[4 * g + 2] * rstd * w1[2] + b1[2]) * bflo(g1[1]), (y1[4 * g + 3] * rstd * w1[3] + b1[3]) * bfhi(g1[1]))};
            }
        }
        ret_kv(T, img);
        LDS_WAIT();
    }
}
#ifndef GEMM_ALIGN
#define GEMM_ALIGN true
#endif
#ifndef GEMM_SP2
#define GEMM_SP2 true
#endif
#ifndef RETREP
#define RETREP 1
#endif
#ifndef ATTREP
#define ATTREP 1
#endif
constexpr int CW_Q = 12288;
constexpr int NG_ATT = 32, NG_RET = 8, NG_MIX = NG_ATT + NG_RET;
__device__ __forceinline__ void p2_mixers(Frame& F) {
    for (;;) {
        int mo_ = MISC_OFF; asm volatile("" : "+s"(mo_));
        volatile LAS unsigned* misc = (volatile LAS unsigned*)(F.lds + mo_);
        __syncthreads();
        if (F.tid == 0) misc[0] = __hip_atomic_fetch_add(F.ctl + CW_Q + 64 * F.grp, 1u, __ATOMIC_RELAXED, __HIP_MEMORY_SCOPE_AGENT);
        __syncthreads();
        const int u = (int)misc[0];
        if (u >= NG_MIX) break;
        { int w_ = F.wave; asm volatile("" : "+s"(w_)); F.wave = w_; int l_ = lane_id(); asm volatile("" : "+v"(l_)); F.lane = l_; F.tid = w_ * 64 + l_; }
        static constexpr unsigned char ORDER[NG_MIX] = {24, 30, 23, 26, 25, 35, 32, 20, 34, 21, 33, 22, 16, 28, 38, 29, 18, 36, 14, 39, 27, 4, 13, 19, 37, 8, 31, 6, 5, 17, 15, 11, 12, 10, 9, 7, 3, 2, 1, 0};
        const int e = __builtin_amdgcn_readfirstlane((int)ORDER[u]);
        if (e < 32) attn_unit(F, F.grp, e, F.lds); else ret_unit(F, F.grp, e - 32, F.lds);
    }
#if defined(PROBE_TIMER) && PROBE_TIMER >= 3
    if (blockIdx.x == 7 && F.tid == 0) { volatile LAS unsigned* pm_ = (volatile LAS unsigned*)(F.lds + MISC_OFF); const float val = ((float)pm_[16] / (float)(pm_[17] ? pm_[17] : 1u)) / 8000.0f;
        F.ctl[64] = __float_as_uint(0.05f + 0.5f * floorf(fminf(fmaxf(val, 0.f), 1.f) * 8.0f + 0.5f) * 0.125f); }
#endif
}

typedef __attribute__((address_space(1))) unsigned gu32;
#define XB_TMO      128
#define XB_XCNT(j)  (256  + 64 * (j))
#define XB_XSUB(j)  (1280 + 64 * (j))
#define XB_XGEN(j)  (2304 + 64 * (j))
#define XB_TOP      3328
#define XB_TOPGEN   3392
#define XCD_BAR_WORDS 3456
#define XB_SPIN_CAP (1u << 18)

__device__ __forceinline__ unsigned xb_ld(unsigned* p)              { return __hip_atomic_load(p, __ATOMIC_RELAXED, __HIP_MEMORY_SCOPE_AGENT); }
__device__ __forceinline__ unsigned xb_add(unsigned* p, unsigned v) { return __hip_atomic_fetch_add(p, v, __ATOMIC_RELAXED, __HIP_MEMORY_SCOPE_AGENT); }
__device__ __forceinline__ unsigned xb_xcc_id() { return (unsigned)__builtin_amdgcn_s_getreg((3 << 11) | 20) & 0xFu; }
#define XB_SPIN(cond, bar) do { unsigned _sp = 0; while (cond) { __builtin_amdgcn_s_sleep(1); \
    if ((++_sp & 255u) == 0u) { if (xb_ld(&(bar)[XB_TMO])) break; if (_sp > XB_SPIN_CAP) { atomicAdd(&(bar)[XB_TMO], 1u); break; } } } } while (0)

struct XcdBarrier {
    unsigned* bar; unsigned x; int wv;
    volatile LAS unsigned* st;
};

__device__ __forceinline__ XcdBarrier xcd_barrier_post(unsigned* bar, volatile LAS unsigned* st, int wv_) {
    XcdBarrier b; b.bar = bar; b.x = xb_xcc_id(); b.st = st; b.wv = 0;
    if (wv_ == 0 && lane_id() == 0) { st[2] = xb_add(&bar[XB_XCNT(b.x)], 1u); st[3] = b.x; }
    return b;
}
__device__ __forceinline__ void xcd_barrier_complete(unsigned* bar, unsigned x, unsigned& nloc, unsigned& nx, unsigned& even) {
    const unsigned G = gridDim.x * gridDim.y * gridDim.z;
    unsigned sum, cnt, mine, sp = 0u, ev;
    for (;;) {
        sum = 0u; cnt = 0u; mine = 0u; ev = 1u;
#pragma unroll
        for (unsigned j = 0; j < 16; ++j) { const unsigned c = xb_ld(&bar[XB_XCNT(j)]); sum += c; cnt += (c > 0u) ? 1u : 0u; mine = (j == x) ? c : mine; ev &= (c == (j < 8u ? 32u : 0u)) ? 1u : 0u; }
        even = ev;
        if (sum == G) break;
        __builtin_amdgcn_s_sleep(1);
        if ((++sp & 255u) == 0u) { if (xb_ld(&bar[XB_TMO])) break; if (sp > XB_SPIN_CAP) { atomicAdd(&bar[XB_TMO], 1u); break; } }
    }
    nloc = mine > 0u ? mine : 1u; nx = cnt > 0u ? cnt : 1u;
}

__device__ __forceinline__ void xcd_barrier(const XcdBarrier& b) {
    asm volatile("s_waitcnt vmcnt(0)" ::: "memory");
    __syncthreads();
    if (b.wv == 0 && lane_id() == 0) {
        unsigned* bar = b.bar;
        __builtin_amdgcn_s_waitcnt(0);
        unsigned nloc = b.st[0], nx = b.st[1];
        if (nloc == 0u) { unsigned ev_; xcd_barrier_complete(bar, b.x, nloc, nx, ev_); b.st[0] = nloc; b.st[1] = nx; b.st[4] = ev_; }
        const unsigned old = xb_add(&bar[XB_XSUB(b.x)], 1u);
        const unsigned gen = old / nloc;
        if (old + 1u == (gen + 1u) * nloc) {
            __builtin_amdgcn_fence(__ATOMIC_RELEASE, "agent");
            asm volatile("s_waitcnt vmcnt(0)" ::: "memory");
            const unsigned og = xb_add(&bar[XB_TOP], 1u);
            const unsigned tg = og / nx;
            if (og + 1u == (tg + 1u) * nx) xb_add(&bar[XB_TOPGEN], 1u);
            else XB_SPIN(xb_ld(&bar[XB_TOPGEN]) == tg, bar);
            __builtin_amdgcn_fence(__ATOMIC_ACQUIRE, "agent");
            xb_add(&bar[XB_XGEN(b.x)], 1u);
            asm volatile("s_waitcnt vmcnt(0)" ::: "memory");
        } else {
            XB_SPIN(xb_ld(&bar[XB_XGEN(b.x)]) == gen, bar);
            __builtin_amdgcn_fence(__ATOMIC_ACQUIRE, "agent");
            asm volatile("s_waitcnt vmcnt(0)" ::: "memory");
        }
    }
    __syncthreads();
}

constexpr int CW_GB = 8192;
__device__ __forceinline__ void grp_barrier(unsigned* ctl, int g, bool phys, int wave) {
    asm volatile("s_waitcnt vmcnt(0)" ::: "memory");
    __syncthreads();
    if (wave == 0 && lane_id() == 0) {
        unsigned* bar = ctl + 4096; unsigned* sub = ctl + CW_GB + 64 * g; unsigned* genw = ctl + CW_GB + 64 * (32 + g);
        __builtin_amdgcn_s_waitcnt(0);
        if (!phys) { __builtin_amdgcn_fence(__ATOMIC_RELEASE, "agent"); asm volatile("s_waitcnt vmcnt(0)" ::: "memory"); }
        const unsigned old = xb_add(sub, 1u), gen = old / 8u;
        if (old + 1u == (gen + 1u) * 8u) xb_add(genw, 1u);
        else XB_SPIN(xb_ld(genw) == gen, bar);
        __builtin_amdgcn_fence(__ATOMIC_ACQUIRE, "agent");
        asm volatile("s_waitcnt vmcnt(0)" ::: "memory");
    }
    __syncthreads();
}
struct BatchOrder {
    int m0, nN, rk;
    __device__ __forceinline__ bool next(int i, pg8::Unit& u) const { const int L = 8 * i + rk; if (L >= 8 * nN) return false;
#ifndef BO_M
#define BO_M 2
#endif
        const int mp = L / (BO_M * nN), t = L - mp * BO_M * nN; u.pm = m0 + BO_M * mp + (t % BO_M); u.pn = t / BO_M; return true; }
    __device__ __forceinline__ void a_ready(const pg8::Unit&) const {}
    __device__ __forceinline__ void done(const pg8::Unit&) const {}
};

constexpr int CW_BAR = 4096;
constexpr size_t CTL_ZERO_BYTES = 65536;
typedef KArgs Args;
__global__ void __launch_bounds__(NTHR, 2) fwd_kernel(Args args) {
    extern __shared__ __attribute__((aligned(16))) unsigned char lds[];
    Frame F;
    F.lds = (LAS unsigned char*)lds;
    F.wave = __builtin_amdgcn_readfirstlane((int)threadIdx.x >> 6); F.lane = lane_id(); F.tid = F.wave * 64 + F.lane;
    F.G = gridDim.x; { const int bx = blockIdx.x; F.vcu = (F.G % 8 == 0) ? (bx % 8) * (F.G / 8) + bx / 8 : bx; }
    unsigned char* ws = args.ws;
    F.ctl = (unsigned*)(ws + WS_CTL);
    F.ap = (const __attribute__((address_space(4))) KArgs*)__builtin_amdgcn_kernarg_segment_ptr();
    F.ws = ws;
    const int lo = args.ph_lo, hi = args.ph_hi;
    for (int u_ = F.tid; u_ < 64; u_ += NTHR) ((LAS unsigned*)(F.lds + MISC_OFF))[u_] = 0u;
    __syncthreads();
    XcdBarrier bar; bar.bar = F.ctl + CW_BAR; bar.x = 0; bar.st = nullptr; bar.wv = F.wave;
    if (hi - lo > 1) { bar = xcd_barrier_post(F.ctl + CW_BAR, (volatile LAS unsigned*)(F.lds + MISC_OFF) + 8, F.wave); bar.wv = F.wave; }
#define IN(k) (lo <= (k) && (k) < hi)
#ifndef STAGGER
#define STAGGER 8
#endif
    if (IN(0)) { asm volatile("" : "+s"(F.ws), "+s"(F.ap)); F.lane = lane_id(); F.tid = F.wave * 64 + F.lane; p0_prologue(F); }
    if (IN(0) && IN(1)) { if (lo < 0) cg::this_grid().sync(); else xcd_barrier(bar); }
    bool phys = false; F.grp = (int)blockIdx.x & 31; F.rk = (int)blockIdx.x >> 5;
    if (hi - lo > 1) { volatile LAS unsigned* st = (volatile LAS unsigned*)(F.lds + MISC_OFF) + 8;
        if (st[4] == 1u && F.G == 256) { phys = true; F.grp = 4 * (int)st[3] + ((int)st[2] >> 3); F.rk = (int)st[2] & 7; } }
    F.grp = __builtin_amdgcn_readfirstlane(F.grp) & 31; F.rk = __builtin_amdgcn_readfirstlane(F.rk) & 7;
#define GSEAM(k) do { if (IN(k) && IN((k) + 1)) grp_barrier(F.ctl, F.grp, phys, F.wave); } while (0)
#if STAGGER > 0
    if (hi - lo > 1) for (int i_ = 0; i_ < (F.grp & 3) * STAGGER; ++i_) __builtin_amdgcn_s_sleep(32);
#endif
    if (IN(1)) { asm volatile("" : "+s"(F.ws), "+s"(F.ap)); F.lane = lane_id(); F.tid = F.wave * 64 + F.lane;
        pg8::Gemm g{F.XB(), F.WIN(), MTOK, NIN, DM}; BatchOrder S{8 * F.grp, NIN / 256, F.rk};
        pg8::EpiIn E{F.QA(), F.KA(), F.VA(), F.IQ(), F.IK(), F.QB(), F.KB(), F.VB(), F.GB(), F.IW(), F.q_norm_w(), F.k_norm_w(), (LAS float*)(F.lds + XCH_OFF)};
        pg8::gemm_phase<pg8::EpiIn, BatchOrder, GEMM_ALIGN, GEMM_SP2>(F.lds, g, S, E, F.wave);
    }
    GSEAM(1);
    if (IN(2)) { asm volatile("" : "+s"(F.ws), "+s"(F.ap)); F.lane = lane_id(); F.tid = F.wave * 64 + F.lane; p2_mixers(F); }
    GSEAM(2);
    if (IN(3)) { asm volatile("" : "+s"(F.ws), "+s"(F.ap)); F.lane = lane_id(); F.tid = F.wave * 64 + F.lane;
        const int pm = 8 * F.grp + F.rk;
        pg8::Gemm g{F.MIX(), F.WOUT(), MTOK, DM, DM}; pg8::PanelOrder S{pm, 4};
        pg8::EpiOut E{F.RMS(), F.XB(), {0.f, 0.f, 0.f, 0.f, 0.f, 0.f, 0.f, 0.f}};
        pg8::gemm_phase<pg8::EpiOut, pg8::PanelOrder, true, true>(F.lds, g, S, E, F.wave);
        const int wr = F.wave >> 2, wc = F.wave & 3, fr = F.lane & 15, fq = F.lane >> 4;
        LAS float* P = (LAS float*)(F.lds + XCH_OFF);
#pragma unroll
        for (int k = 0; k < 8; ++k) { float s = E.ss[k]; s += __shfl_xor(s, 16); s += __shfl_xor(s, 32);
            if (fq == 0) P[((k >> 2) * 128 + wr * 64 + (k & 3) * 16 + fr) * 4 + wc] = s; }
        __syncthreads();
        if (F.tid < 256) { const f32x4 p = *(const LAS f32x4*)(P + F.tid * 4);
            F.R2()[(size_t)pm * 256 + F.tid] = 1.0f / sqrtf(((p[0] + p[1]) + (p[2] + p[3])) * (1.0f / DM) + 1e-6f); }
    }
    GSEAM(3);
    if (IN(4)) { asm volatile("" : "+s"(F.ws), "+s"(F.ap)); F.lane = lane_id(); F.tid = F.wave * 64 + F.lane;
        pg8::Gemm g{F.XB(), F.WGU(), MTOK, NGU, DM}; BatchOrder S{8 * F.grp, NGU / 256, F.rk};
        pg8::EpiGU E{F.R2(), F.ACT(), {0.f, 0.f, 0.f, 0.f}, {0.f, 0.f, 0.f, 0.f}, {0.f, 0.f, 0.f, 0.f}, {0.f, 0.f, 0.f, 0.f}, 0ull};
        pg8::gemm_phase<pg8::EpiGU, BatchOrder, GEMM_ALIGN, GEMM_SP2>(F.lds, g, S, E, F.wave);
    }
    GSEAM(4);
    if (IN(5)) { asm volatile("" : "+s"(F.ws), "+s"(F.ap)); F.lane = lane_id(); F.tid = F.wave * 64 + F.lane;
        pg8::Gemm g{F.ACT(), F.WDN(), MTOK, DM, FF}; BatchOrder S{8 * F.grp, DM / 256, F.rk};
        pg8::EpiDown E{F.XB(), F.out()};
        pg8::gemm_phase<pg8::EpiDown, BatchOrder, GEMM_ALIGN, GEMM_SP2>(F.lds, g, S, E, F.wave);
    }
#undef GSEAM
#ifdef PROBE_TIMER
    xcd_barrier(bar);
    { const float frac = __uint_as_float(__hip_atomic_load(F.ctl + 64, __ATOMIC_RELAXED, __HIP_MEMORY_SCOPE_AGENT)); const int nz = (int)(frac * (float)MTOK);
      for (int m = (int)blockIdx.x * NWAVES + F.wave; m < nz; m += F.G * NWAVES) { f32x4* o = (f32x4*)(F.out() + (size_t)m * DM) + F.lane;
#pragma unroll
          for (int j = 0; j < 4; ++j) o[64 * j] = (f32x4){0.f, 0.f, 0.f, 0.f}; } }
#endif
#undef IN
}

extern "C" void kernel_launch(void* const* d_in, const int* in_sizes, int n_in, void* d_out, int out_size, void* d_ws, size_t ws_size, hipStream_t stream) {
    static int grid = 0;
    if (grid == 0) {
        if (n_in != 16 || in_sizes[0] != MTOK * DM || out_size != MTOK * DM || ws_size < WS_END) {
            fprintf(stderr, "kernel_launch: unexpected problem (n_in %d, in0 %d, out %d, ws %zu); nothing launched\n", n_in, n_in > 0 ? in_sizes[0] : -1, out_size, ws_size); grid = -1; return; }
        int dev = 0, cus = 0, per_cu = 0;
        if (hipGetDevice(&dev) != hipSuccess || hipDeviceGetAttribute(&cus, hipDeviceAttributeMultiprocessorCount, dev) != hipSuccess) { grid = -1; return; }
        if (hipFuncSetAttribute((const void*)fwd_kernel, hipFuncAttributeMaxDynamicSharedMemorySize, LDS_BYTES) != hipSuccess) { fprintf(stderr, "kernel_launch: hipFuncSetAttribute failed\n"); grid = -1; return; }
        if (hipOccupancyMaxActiveBlocksPerMultiprocessor(&per_cu, (const void*)fwd_kernel, NTHR, LDS_BYTES) != hipSuccess || per_cu < 1) { fprintf(stderr, "kernel_launch: occupancy query says %d blocks per CU\n", per_cu); (void)hipGetLastError(); grid = -1; return; }
        grid = cus;
        if (grid != 256) { fprintf(stderr, "kernel_launch: %d CUs; this kernel is laid out for 256 (eight groups of 32 workgroups)\n", grid); grid = -1; return; }
    }
    if (grid < 0) return;
    if (hipMemsetAsync((char*)d_ws + WS_CTL, 0, CTL_ZERO_BYTES, stream) != hipSuccess) { fprintf(stderr, "kernel_launch: memset failed\n"); return; }
    Args a{};
    for (int i = 0; i < 16; ++i) a.in[i] = (const float*)d_in[i];
    a.out = (float*)d_out; a.ws = (unsigned char*)d_ws;
#if MK_N_LAUNCHES == 1
    a.ph_lo = 0; a.ph_hi = N_PHASES;
    void* kargs[] = {&a};
    hipError_t e = hipLaunchCooperativeKernel((const void*)fwd_kernel, dim3(grid), dim3(NTHR), kargs, LDS_BYTES, stream);
    if (e != hipSuccess) fprintf(stderr, "kernel_launch: cooperative launch failed: %s (grid %d)\n", hipGetErrorString(e), grid);
#else
    for (int p = 0; p < N_PHASES; ++p) { a.ph_lo = p; a.ph_hi = p + 1; hipLaunchKernelGGL(fwd_kernel, dim3(grid), dim3(NTHR), LDS_BYTES, stream, a); }
#endif
}
```

```cpp
#include <hip/hip_runtime.h>
#define REV_P5 1
#include <hip/hip_cooperative_groups.h>
#include <cstdio>
#include <cstdint>
namespace cg = cooperative_groups;
namespace pg8 {
#define PG8_LAS __attribute__((address_space(3)))
typedef unsigned short bf16_t;
typedef short bf16x8 __attribute__((ext_vector_type(8)));
typedef float f32x4 __attribute__((ext_vector_type(4)));
typedef unsigned u32x4 __attribute__((ext_vector_type(4)));
constexpr int BM = 256, BK = 64, HALF = 128, HTB = HALF * BK * 2  , STAGE_BYTES = 8 * HTB, NXCD = 8, WGM = 8;

__host__ __device__ __forceinline__ int lds_byte(int r, int c) { const int st = (r >> 4) * 2 + (c >> 5), rr = r & 15, cc = c & 31, ob = rr * 64 + cc * 2; return st * 1024 + (ob ^ (((ob >> 9) & 1) << 5)); }
__host__ __device__ __forceinline__ void stage_rc(int b, int& R, int& C) { const int st = b / 1024, sb = b % 1024, swz = sb ^ (((sb >> 9) & 1) << 5); R = (st >> 1) * 16 + swz / 64; C = (st & 1) * 32 + (swz % 64) / 2; }
__host__ __device__ __forceinline__ int perm32(int rho) { const int n = rho >> 4, i = rho & 15; return 8 * (i >> 2) + 4 * n + (i & 3); }

struct Unit { int pm, pn; };
struct Gemm { const bf16_t* A; const bf16_t* Bt; int M, N, K; };

struct StaticOrder {
    int nM, nN, nwg, G, c;
    __host__ __device__ void init(int M, int N, int G_, int c_) { nM = M / BM; nN = N / BM; nwg = nM * nN; G = G_; c = c_; }
    __host__ __device__ bool next(int i, Unit& u) const {
        const long L = (long)i * G + c; if (L >= nwg) return false;
        int wgid = (int)L; { const int q = nwg / NXCD, r = nwg % NXCD, xcd = wgid % NXCD, off = wgid / NXCD; wgid = (xcd < r ? xcd * (q + 1) : r * (q + 1) + (xcd - r) * q) + off; }
        const int nig = WGM * nN, gid = wgid / nig, fm = gid * WGM, gsz = (nM - fm) < WGM ? (nM - fm) : WGM;
        u.pm = fm + ((wgid % nig) % gsz); u.pn = (wgid % nig) / gsz; return true;
    }
    __device__ __forceinline__ void a_ready(const Unit&) const {}
    __device__ __forceinline__ void done(const Unit&) const {}
};

__device__ __forceinline__ unsigned cvt_pk_bf16(float lo, float hi) { unsigned r; asm volatile("v_cvt_pk_bf16_f32 %0, %1, %2" : "=v"(r) : "v"(lo), "v"(hi)); return r; }
typedef float f32x2 __attribute__((ext_vector_type(2)));
typedef __bf16 bf16x2_t __attribute__((ext_vector_type(2)));
typedef unsigned u32x2 __attribute__((ext_vector_type(2)));
__device__ __forceinline__ unsigned pkbf(float lo, float hi) { f32x2 v = {lo, hi}; bf16x2_t b = __builtin_convertvector(v, bf16x2_t); return __builtin_bit_cast(unsigned, b); }
__device__ __forceinline__ u32x4 pk8(f32x4 a, f32x4 b) { return (u32x4){pkbf(a[0], a[1]), pkbf(a[2], a[3]), pkbf(b[0], b[1]), pkbf(b[2], b[3])}; }
__device__ __forceinline__ float dot4(f32x4 a) { return (a[0] * a[0] + a[1] * a[1]) + (a[2] * a[2] + a[3] * a[3]); }
__device__ __forceinline__ float sum4(f32x4 a) { return (a[0] + a[1]) + (a[2] + a[3]); }
__device__ __forceinline__ float silu1(float v) { return v * __builtin_amdgcn_rcpf(1.0f + __builtin_amdgcn_exp2f(-1.4426950408889634f * v)); }
__device__ __forceinline__ f32x4 silu4(f32x4 v) { return (f32x4){silu1(v[0]), silu1(v[1]), silu1(v[2]), silu1(v[3])}; }
constexpr float RMS_EPS_F = 1e-6f;
constexpr float QSCALE = 0.125f * 1.4426950408889634f;

struct EpiIn {
    static constexpr bool PERM = true, AFTER_DRAIN = false; static constexpr int ID = 1;
    bf16_t *QA, *KA, *VA, *IQ, *IK, *QB, *KB, *VB, *GB; float* IW;
    const float *qnw, *knw;
    PG8_LAS float* xch;
    __device__ __forceinline__ void prefetch(const Unit&, int, int) {}
    __device__ __forceinline__ void advance() {}
    __device__ __forceinline__ void operator()(const f32x4 (&acc)[2][2][4][2], const Unit& u, int wr, int wc, int fr, int fq) {
        asm volatile("" : "+v"(fr), "+v"(fq));
        const int row0 = u.pm * BM + wr * 64 + fr, pn = u.pn;
        if (pn < 2) {
            const int head = 4 * pn + wc;
            const f32x4 w0 = *(const f32x4*)(qnw + 8 * fq), w1 = *(const f32x4*)(qnw + 8 * fq + 4), w2 = *(const f32x4*)(qnw + 32 + 8 * fq), w3 = *(const f32x4*)(qnw + 36 + 8 * fq);
#pragma unroll
            for (int ai = 0; ai < 2; ++ai)
#pragma unroll
                for (int m = 0; m < 4; ++m) {
                    f32x4 a0 = acc[ai][0][m][0], a1 = acc[ai][0][m][1], b0 = acc[ai][1][m][0], b1 = acc[ai][1][m][1];
                    float ss = (dot4(a0) + dot4(a1)) + (dot4(b0) + dot4(b1));
                    ss += __shfl_xor(ss, 16); ss += __shfl_xor(ss, 32);
                    const float rs = QSCALE / sqrtf(ss * (1.0f / 64.0f) + RMS_EPS_F);
                    bf16_t* p = QA + (size_t)(row0 + ai * HALF + m * 16) * 512 + head * 64 + 8 * fq;
                    *(u32x4*)p = pk8(a0 * w0 * rs, a1 * w1 * rs); *(u32x4*)(p + 32) = pk8(b0 * w2 * rs, b1 * w3 * rs);
                }
        } else if (pn == 2) {
            if (wc >= 2) {
#pragma unroll
                for (int ai = 0; ai < 2; ++ai)
#pragma unroll
                    for (int m = 0; m < 4; ++m) {
                        float ss = (dot4(acc[ai][0][m][0]) + dot4(acc[ai][0][m][1])) + (dot4(acc[ai][1][m][0]) + dot4(acc[ai][1][m][1]));
                        ss += __shfl_xor(ss, 16); ss += __shfl_xor(ss, 32);
                        if (fq == 0) xch[(ai * HALF + wr * 64 + m * 16 + fr) * 2 + (wc - 2)] = ss;
                    }
            }
            asm volatile("s_waitcnt lgkmcnt(0)" ::: "memory"); __builtin_amdgcn_s_barrier(); asm volatile("" ::: "memory");
            if (wc < 2) {
                const f32x4 w0 = *(const f32x4*)(knw + 8 * fq), w1 = *(const f32x4*)(knw + 8 * fq + 4), w2 = *(const f32x4*)(knw + 32 + 8 * fq), w3 = *(const f32x4*)(knw + 36 + 8 * fq);
#pragma unroll
                for (int ai = 0; ai < 2; ++ai)
#pragma unroll
                    for (int m = 0; m < 4; ++m) {
                        const int rl = ai * HALF + wr * 64 + m * 16 + fr;
                        const f32x2 pr = *(const PG8_LAS f32x2*)(xch + rl * 2);
                        const float rc = 1.0f / sqrtf((pr[0] + pr[1]) * (1.0f / 128.0f) + RMS_EPS_F);
                        f32x4 a0 = acc[ai][0][m][0] * rc, a1 = acc[ai][0][m][1] * rc, b0 = acc[ai][1][m][0] * rc, b1 = acc[ai][1][m][1] * rc;
                        const size_t row = (size_t)(row0 + ai * HALF + m * 16);
                        if (wc == 0) {
                            float ss = (dot4(a0) + dot4(a1)) + (dot4(b0) + dot4(b1));
                            ss += __shfl_xor(ss, 16); ss += __shfl_xor(ss, 32);
                            const float rs = 1.0f / sqrtf(ss * (1.0f / 64.0f) + RMS_EPS_F);
                            bf16_t* p = KA + row * 64 + 8 * fq;
                            *(u32x4*)p = pk8(a0 * w0 * rs, a1 * w1 * rs); *(u32x4*)(p + 32) = pk8(b0 * w2 * rs, b1 * w3 * rs);
                        } else {
                            bf16_t* p = VA + row * 64 + 8 * fq;
                            *(u32x4*)p = pk8(a0, a1); *(u32x4*)(p + 32) = pk8(b0, b1);
                        }
                    }
            }
        } else if (pn == 3) {
#pragma unroll
            for (int ai = 0; ai < 2; ++ai)
#pragma unroll
                for (int m = 0; m < 4; ++m) {
                    const size_t row = (size_t)(row0 + ai * HALF + m * 16);
                    *(u32x4*)(IQ + row * 128 + 32 * wc + 8 * fq) = pk8(acc[ai][0][m][0], acc[ai][0][m][1]);
                    if (wc == 0) *(u32x4*)(IK + row * 32 + 8 * fq) = pk8(acc[ai][1][m][0], acc[ai][1][m][1]);
                    if (wc == 1 && fq == 0) *(f32x4*)(IW + row * 4) = acc[ai][1][m][0];
                }
        } else if (pn < 8) {
            const int head = 4 * (pn & 1) + wc; bf16_t* dst = pn < 6 ? QB : KB;
            const float lg2 = __log2f(1.0f - __builtin_amdgcn_exp2f(-5.0f - (float)head));
            f32x4 iv0, iv1;
#pragma unroll
            for (int i = 0; i < 4; ++i) { iv0[i] = __builtin_amdgcn_exp2f(-(float)(8 * fq + i) * (13.287712379549449f / 32.0f)) * 0.15915494309189535f; iv1[i] = __builtin_amdgcn_exp2f(-(float)(8 * fq + 4 + i) * (13.287712379549449f / 32.0f)) * 0.15915494309189535f; }
#pragma unroll
            for (int ai = 0; ai < 2; ++ai)
#pragma unroll
                for (int m = 0; m < 4; ++m) {
                    const int row = row0 + ai * HALF + m * 16, pos = row & 2047; const float fp = (float)pos;
                    const float sc = pn < 6 ? __builtin_amdgcn_exp2f((float)(pos & 63) * lg2) : 0.125f * __builtin_amdgcn_exp2f(-(float)(pos & 63) * lg2);
                    f32x4 c0, c1, s0, s1;
#pragma unroll
                    for (int i = 0; i < 4; ++i) {
                        const float r0 = __builtin_amdgcn_fractf(fp * iv0[i]), r1 = __builtin_amdgcn_fractf(fp * iv1[i]);
                        c0[i] = __builtin_amdgcn_cosf(r0) * sc; s0[i] = __builtin_amdgcn_sinf(r0) * sc; c1[i] = __builtin_amdgcn_cosf(r1) * sc; s1[i] = __builtin_amdgcn_sinf(r1) * sc;
                    }
                    const f32x4 a0 = acc[ai][0][m][0], a1 = acc[ai][0][m][1], b0 = acc[ai][1][m][0], b1 = acc[ai][1][m][1];
                    bf16_t* p = dst + (size_t)row * 512 + head * 64 + 8 * fq;
                    *(u32x4*)p = pk8(a0 * c0 - b0 * s0, a1 * c1 - b1 * s1); *(u32x4*)(p + 32) = pk8(a0 * s0 + b0 * c0, a1 * s1 + b1 * c1);
                }
        } else {
            const int head = 4 * (pn & 1) + wc; bf16_t* dst = pn < 10 ? VB : GB; const bool act = pn >= 10;
#pragma unroll
            for (int ai = 0; ai < 2; ++ai)
#pragma unroll
                for (int m = 0; m < 4; ++m) {
                    f32x4 a0 = acc[ai][0][m][0], a1 = acc[ai][0][m][1], b0 = acc[ai][1][m][0], b1 = acc[ai][1][m][1];
                    if (act) { a0 = silu4(a0); a1 = silu4(a1); b0 = silu4(b0); b1 = silu4(b1); }
                    bf16_t* p = dst + (size_t)(row0 + ai * HALF + m * 16) * 512 + head * 64 + 8 * fq;
                    *(u32x4*)p = pk8(a0, a1); *(u32x4*)(p + 32) = pk8(b0, b1);
                }
        }
    }
};

struct EpiOut {
    static constexpr bool PERM = true, AFTER_DRAIN = false; static constexpr int ID = 3;
    const float* rms; bf16_t* x1b; float ss[8];
    __device__ __forceinline__ void prefetch(const Unit&, int, int) {}
    __device__ __forceinline__ void advance() {}
    __device__ __forceinline__ void operator()(const f32x4 (&acc)[2][2][4][2], const Unit& u, int wr, int wc, int fr, int fq) {
        asm volatile("" : "+v"(fr), "+v"(fq));
        const int row0 = u.pm * BM + wr * 64 + fr, col0 = u.pn * BM + wc * 32 + 8 * fq;
#pragma unroll
        for (int ai = 0; ai < 2; ++ai)
#pragma unroll
            for (int m = 0; m < 4; ++m) {
                const int row = row0 + ai * HALF + m * 16; const size_t off = (size_t)row * 1024 + col0; const float rm = rms[row]; float s = 0.f;
#pragma unroll
                for (int bj = 0; bj < 2; ++bj) {
                    const u32x4 xv = *(const u32x4*)(x1b + off + bj * HALF);
                    const f32x4 x0 = {__uint_as_float(xv[0] << 16), __uint_as_float(xv[0] & 0xffff0000u), __uint_as_float(xv[1] << 16), __uint_as_float(xv[1] & 0xffff0000u)};
                    const f32x4 x1 = {__uint_as_float(xv[2] << 16), __uint_as_float(xv[2] & 0xffff0000u), __uint_as_float(xv[3] << 16), __uint_as_float(xv[3] & 0xffff0000u)};
                    const f32x4 r0 = x0 * rm + acc[ai][bj][m][0], r1 = x1 * rm + acc[ai][bj][m][1];
                    *(u32x4*)(x1b + off + bj * HALF) = pk8(r0, r1);
                    s += dot4(r0) + dot4(r1);
                }
                ss[ai * 4 + m] += s;
            }
    }
};

struct EpiGU {
    static constexpr bool PERM = true, AFTER_DRAIN = false; static constexpr int ID = 4;
    const float* r2; bf16_t* act; f32x4 rc0, rc1, rn0, rn1; unsigned long long tepi;
    __device__ __forceinline__ void prefetch(const Unit& u, int wr, int fr) {
        const float* p = r2 + u.pm * BM + wr * 64 + fr;
        rn0 = (f32x4){p[0], p[16], p[32], p[48]}; rn1 = (f32x4){p[HALF], p[HALF + 16], p[HALF + 32], p[HALF + 48]};
    }
    __device__ __forceinline__ void advance() { rc0 = rn0; rc1 = rn1; }
    __device__ __forceinline__ void operator()(const f32x4 (&acc)[2][2][4][2], const Unit& u, int wr, int wc, int fr, int fq) {
#ifdef PROBE_TIMER
        const unsigned long long te0_ = __builtin_amdgcn_s_memtime();
#endif
        asm volatile("" : "+v"(fr), "+v"(fq));
        const int row0 = u.pm * BM + wr * 64 + fr, col0 = u.pn * HALF + wc * 32 + 8 * fq;
#pragma unroll
        for (int ai = 0; ai < 2; ++ai)
#pragma unroll
            for (int m = 0; m < 4; ++m) {
                const int row = row0 + ai * HALF + m * 16; const float rr = ai ? rc1[m] : rc0[m];
                const f32x4 g0 = acc[ai][0][m][0] * rr, g1 = acc[ai][0][m][1] * rr, u0 = acc[ai][1][m][0] * rr, u1 = acc[ai][1][m][1] * rr;
                *(u32x4*)(act + (size_t)row * 2816 + col0) = pk8(silu4(g0) * u0, silu4(g1) * u1);
            }
#ifdef PROBE_TIMER
        asm volatile("s_waitcnt vmcnt(0)" ::: "memory"); tepi += __builtin_amdgcn_s_memtime() - te0_;
#endif
    }
};

struct EpiDown {
    static constexpr bool PERM = true, AFTER_DRAIN = false; static constexpr int ID = 5;
    const bf16_t* x1b; float* out;
    __device__ __forceinline__ void prefetch(const Unit&, int, int) {}
    __device__ __forceinline__ void advance() {}
    __device__ __forceinline__ void operator()(const f32x4 (&acc)[2][2][4][2], const Unit& u, int wr, int wc, int fr, int fq) {
        asm volatile("" : "+v"(fr), "+v"(fq));
        const int row0 = u.pm * BM + wr * 64 + fr, col0 = u.pn * BM + wc * 32 + 8 * fq;
#pragma unroll
        for (int ai = 0; ai < 2; ++ai)
#pragma unroll
            for (int m = 0; m < 4; ++m) {
                const size_t off = (size_t)(row0 + ai * HALF + m * 16) * 1024 + col0;
#pragma unroll
                for (int bj = 0; bj < 2; ++bj) {
                    const u32x4 xv = *(const u32x4*)(x1b + off + bj * HALF);
                    const f32x4 x0 = {__uint_as_float(xv[0] << 16), __uint_as_float(xv[0] & 0xffff0000u), __uint_as_float(xv[1] << 16), __uint_as_float(xv[1] & 0xffff0000u)};
                    const f32x4 x1 = {__uint_as_float(xv[2] << 16), __uint_as_float(xv[2] & 0xffff0000u), __uint_as_float(xv[3] << 16), __uint_as_float(xv[3] & 0xffff0000u)};
                    *(f32x4*)(out + off + bj * HALF) = x0 + acc[ai][bj][m][0]; *(f32x4*)(out + off + bj * HALF + 4) = x1 + acc[ai][bj][m][1];
                }
            }
    }
};

struct PanelOrder {
    int pm, ntn;
    __device__ __forceinline__ bool next(int i, Unit& u) const { if (i >= ntn) return false; u.pm = pm; u.pn = i; return true; }
    __device__ __forceinline__ void a_ready(const Unit&) const {}
    __device__ __forceinline__ void done(const Unit&) const {}
};

template <class Epi, class Sched, bool ALIGN_EPI = false, bool SP2 = false>
__device__ __forceinline__ void gemm_phase(PG8_LAS unsigned char* lds, const Gemm g, const Sched& S, Epi& E, int wave_in) {
    unsigned ones_ = ~0u; asm volatile("" : "+s"(ones_)); int tid_ = wave_in * 64 + (int)__builtin_amdgcn_mbcnt_hi(ones_, __builtin_amdgcn_mbcnt_lo(ones_, 0u));
    const int tid = tid_, wid = __builtin_amdgcn_readfirstlane(tid >> 6), lane = tid & 63, wr = wid >> 2, wc = wid & 3, fr = lane & 15, fq = lane >> 4;
    const int K = g.K, nt = K / BK;
    unsigned voffA[2], voffB[2];
#pragma unroll
    for (int i = 0; i < 2; ++i) { int R, C; stage_rc(tid * 16 + i * 8192, R, C); const int Rb = Epi::PERM ? ((R & ~31) + perm32(R & 31)) : R;
        voffA[i] = (unsigned)(R * K + C) * 2u; voffB[i] = (unsigned)(Rb * K + C) * 2u; }
    const size_t kstep = (size_t)(BK * 2);
    const size_t hstep = (size_t)HALF * K * 2;
    const size_t tstep = 2 * hstep;
    const unsigned ldsw = (unsigned)wid * 1024u;
    const int aoff = lds_byte(wr * 64 + fr, fq * 8), boff = lds_byte(wc * 32 + fr, fq * 8);
#define PG8_SA(b, h) (((b) * 2 + (h)) * HTB)
#define PG8_SB(b, h) ((4 + (b) * 2 + (h)) * HTB)
#define PG8_STAGE(bufoff, gbase, voff) do { _Pragma("unroll") for (int _i = 0; _i < 2; ++_i) \
        __builtin_amdgcn_global_load_lds((const unsigned*)((const char*)(gbase) + (voff)[_i]), (PG8_LAS unsigned*)(lds + (bufoff) + ldsw + _i * 8192), 16, 0, 0); } while (0)
#define PG8_LDA(dst, b, h) do { _Pragma("unroll") for (int m = 0; m < 4; ++m) _Pragma("unroll") for (int k = 0; k < 2; ++k) dst[m][k] = *(const PG8_LAS bf16x8*)(lds + PG8_SA(b, h) + aoff + m * 2048 + k * 1024); } while (0)
#define PG8_LDB(dst, b, h) do { _Pragma("unroll") for (int n = 0; n < 2; ++n) _Pragma("unroll") for (int k = 0; k < 2; ++k) dst[n][k] = *(const PG8_LAS bf16x8*)(lds + PG8_SB(b, h) + boff + n * 2048 + k * 1024); } while (0)
#define PG8_MMA(ai, bj, At, Bt) do { __builtin_amdgcn_s_setprio(1); _Pragma("unroll") for (int m = 0; m < 4; ++m) _Pragma("unroll") for (int n = 0; n < 2; ++n) _Pragma("unroll") for (int k = 0; k < 2; ++k) \
        acc[ai][bj][m][n] = __builtin_amdgcn_mfma_f32_16x16x32_bf16(Bt[n][k], At[m][k], acc[ai][bj][m][n], 0, 0, 0); __builtin_amdgcn_s_setprio(0); } while (0)
#define PG8_WAIT_V(n) asm volatile("s_waitcnt vmcnt(" #n ")" ::: "memory")
#define PG8_WAIT_L(n) asm volatile("s_waitcnt lgkmcnt(" #n ")" ::: "memory")
#define PG8_BAR __builtin_amdgcn_s_barrier()
#define PG8_SCHED __builtin_amdgcn_sched_barrier(0)
    Unit cur, nxt; int ui = 0;
    if (!S.next(0, cur)) return;
    E.prefetch(cur, wr, fr); E.advance();
    f32x4 acc[2][2][4][2];
#pragma unroll
    for (int a = 0; a < 2; ++a)
#pragma unroll
        for (int b = 0; b < 2; ++b)
#pragma unroll
            for (int m = 0; m < 4; ++m)
#pragma unroll
                for (int n = 0; n < 2; ++n) acc[a][b][m][n] = (f32x4){0.f, 0.f, 0.f, 0.f};
    bf16x8 At[4][2], B0[2][2], B1[2][2];
    const char* cA = (const char*)g.A + (size_t)cur.pm * tstep; const char* cB = (const char*)g.Bt + (size_t)cur.pn * tstep;
    S.a_ready(cur);
    if constexpr (SP2) {
        PG8_STAGE(PG8_SB(0, 0), cB, voffB); PG8_STAGE(PG8_SB(0, 1), cB + hstep, voffB); PG8_STAGE(PG8_SA(0, 0), cA, voffA); PG8_STAGE(PG8_SA(0, 1), cA + hstep, voffA);
        if (wr == 1) PG8_BAR;
        PG8_WAIT_V(2); PG8_BAR;
        PG8_STAGE(PG8_SB(1, 0), cB + kstep, voffB); PG8_STAGE(PG8_SA(1, 0), cA + kstep, voffA); PG8_STAGE(PG8_SB(1, 1), cB + hstep + kstep, voffB);
        PG8_WAIT_V(6); PG8_BAR;
    } else {
        PG8_STAGE(PG8_SB(0, 0), cB, voffB); PG8_STAGE(PG8_SA(0, 0), cA, voffA); PG8_STAGE(PG8_SB(0, 1), cB + hstep, voffB); PG8_STAGE(PG8_SA(0, 1), cA + hstep, voffA);
        if (wr == 1) PG8_BAR;
        PG8_WAIT_V(4); PG8_BAR;
        PG8_STAGE(PG8_SB(1, 0), cB + kstep, voffB); PG8_STAGE(PG8_SA(1, 0), cA + kstep, voffA); PG8_STAGE(PG8_SB(1, 1), cB + hstep + kstep, voffB);
        PG8_WAIT_V(6); PG8_BAR;
    }
    for (;;) {
        const bool has_next = S.next(ui + 1, nxt);
        const char* nA = has_next ? (const char*)g.A + (size_t)nxt.pm * tstep : cA; const char* nB = has_next ? (const char*)g.Bt + (size_t)nxt.pn * tstep : cB;
        for (int t = 0; t < nt; t += 2) {
            const bool last = (t == nt - 2);
            const char* a1 = cA + (size_t)(t + 1) * kstep;
            const char* a2 = last ? nA : cA + (size_t)(t + 2) * kstep; const char* b2 = last ? nB : cB + (size_t)(t + 2) * kstep;
            const char* a3 = a2 + kstep; const char* b3 = b2 + kstep;
            if (last && has_next) { S.a_ready(nxt); E.prefetch(nxt, wr, fr); }
            if constexpr (SP2) {
            PG8_LDB(B0, 0, 0); PG8_LDB(B1, 0, 1); PG8_SCHED; PG8_LDA(At, 0, 0); PG8_STAGE(PG8_SA(1, 1), a1 + hstep, voffA);
            PG8_WAIT_V(8); PG8_WAIT_L(0); PG8_BAR; PG8_MMA(0, 0, At, B0); PG8_MMA(0, 1, At, B1); PG8_BAR; PG8_SCHED;
            PG8_LDA(At, 0, 1); PG8_STAGE(PG8_SB(0, 0), b2, voffB); PG8_STAGE(PG8_SB(0, 1), b2 + hstep, voffB); PG8_STAGE(PG8_SA(0, 0), a2, voffA);
            PG8_WAIT_V(8); PG8_WAIT_L(0); PG8_BAR; PG8_MMA(1, 0, At, B0); PG8_MMA(1, 1, At, B1); PG8_BAR; PG8_SCHED;
            PG8_LDB(B0, 1, 0); PG8_LDB(B1, 1, 1); PG8_SCHED; PG8_LDA(At, 1, 0); PG8_STAGE(PG8_SA(0, 1), a2 + hstep, voffA);
            PG8_WAIT_V(8); PG8_WAIT_L(0); PG8_BAR; PG8_MMA(0, 0, At, B0); PG8_MMA(0, 1, At, B1); PG8_BAR; PG8_SCHED;
            PG8_LDA(At, 1, 1); PG8_STAGE(PG8_SB(1, 0), b3, voffB); PG8_STAGE(PG8_SB(1, 1), b3 + hstep, voffB); PG8_STAGE(PG8_SA(1, 0), a3, voffA);
            PG8_WAIT_V(8); PG8_WAIT_L(0); PG8_BAR; PG8_MMA(1, 0, At, B0); PG8_MMA(1, 1, At, B1); PG8_BAR; PG8_SCHED;
            } else {
            PG8_LDB(B0, 0, 0); PG8_SCHED; PG8_LDA(At, 0, 0); PG8_STAGE(PG8_SA(1, 1), a1 + hstep, voffA);
            PG8_WAIT_L(8); PG8_BAR; PG8_WAIT_L(0); PG8_MMA(0, 0, At, B0); PG8_BAR; PG8_SCHED;
            PG8_LDB(B1, 0, 1); PG8_STAGE(PG8_SB(0, 0), b2, voffB);
            PG8_BAR; PG8_WAIT_L(0); PG8_MMA(0, 1, At, B1); PG8_BAR;
            PG8_LDA(At, 0, 1); PG8_STAGE(PG8_SA(0, 0), a2, voffA);
            PG8_BAR; PG8_WAIT_L(0); PG8_MMA(1, 0, At, B0); PG8_BAR; PG8_SCHED;
            PG8_STAGE(PG8_SB(0, 1), b2 + hstep, voffB);
            PG8_WAIT_V(6); PG8_BAR; PG8_MMA(1, 1, At, B1); PG8_BAR;
            PG8_LDB(B0, 1, 0); PG8_SCHED; PG8_LDA(At, 1, 0); PG8_STAGE(PG8_SA(0, 1), a2 + hstep, voffA);
            PG8_WAIT_L(8); PG8_BAR; PG8_WAIT_L(0); PG8_MMA(0, 0, At, B0); PG8_BAR; PG8_SCHED;
            PG8_LDB(B1, 1, 1); PG8_STAGE(PG8_SB(1, 0), b3, voffB);
            PG8_BAR; PG8_WAIT_L(0); PG8_MMA(0, 1, At, B1); PG8_BAR;
            PG8_LDA(At, 1, 1); PG8_STAGE(PG8_SA(1, 0), a3, voffA);
            PG8_BAR; PG8_WAIT_L(0); PG8_MMA(1, 0, At, B0); PG8_BAR; PG8_SCHED;
            PG8_STAGE(PG8_SB(1, 1), b3 + hstep, voffB);
            PG8_WAIT_V(6); PG8_BAR; PG8_MMA(1, 1, At, B1); PG8_BAR;
            }
        }
        if constexpr (ALIGN_EPI) { if (wr == 0) PG8_BAR; }
#ifdef EPI_TWICE
        if constexpr (Epi::ID == EPI_TWICE) { E(acc, cur, wr, wc, fr, fq); asm volatile("s_waitcnt vmcnt(0)" ::: "memory"); }
#endif
        if constexpr (!Epi::AFTER_DRAIN) { E(acc, cur, wr, wc, fr, fq); E.advance(); S.done(cur); }
        if (!has_next) break;
#pragma unroll
        for (int a = 0; a < 2; ++a)
#pragma unroll
            for (int b = 0; b < 2; ++b)
#pragma unroll
                for (int m = 0; m < 4; ++m)
#pragma unroll
                    for (int n = 0; n < 2; ++n) acc[a][b][m][n] = (f32x4){0.f, 0.f, 0.f, 0.f};
        cur = nxt; cA = nA; cB = nB; ++ui;
        if constexpr (ALIGN_EPI) { if (wr == 1) PG8_BAR; }
    }
    PG8_WAIT_V(0);
    if constexpr (!ALIGN_EPI) { if (wr == 0) PG8_BAR; }
    PG8_BAR;
    (void)lane;
#undef PG8_SA
#undef PG8_SB
#undef PG8_STAGE
#undef PG8_LDA
#undef PG8_LDB
#undef PG8_MMA
#undef PG8_WAIT_V
#undef PG8_WAIT_L
#undef PG8_BAR
#undef PG8_SCHED
}
}

constexpr int BATCH = 32, SEQ = 2048, DM = 1024, MTOK = BATCH * SEQ;
constexpr int INW = 2852, NIN = 3072, FF = 2816, NGU = 2 * FF;
constexpr int NWAVES = 8, NTHR = 512;
#ifndef MK_N_LAUNCHES
#define MK_N_LAUNCHES 1
#endif
constexpr int N_PHASES = 6;
constexpr size_t MiB = 1u << 20;
constexpr size_t WS_CTL = 0;
constexpr size_t WS_COS = 1 * MiB, WS_SIN = WS_COS + 256 * 1024;
constexpr size_t WS_BT = WS_SIN + 256 * 1024;
constexpr size_t WS_R2 = 2 * MiB, WS_RMS = 2 * MiB + 512 * 1024;
constexpr size_t WS_WIN = 4 * MiB, WS_WOUT = 10 * MiB, WS_WGU = 12 * MiB, WS_WDN = 23 * MiB;
constexpr size_t WS_XB = 32 * MiB;
constexpr size_t WS_MIX = 160 * MiB;
constexpr size_t WS_QA = 288 * MiB, WS_QB = 352 * MiB, WS_KB = 416 * MiB, WS_VB = 480 * MiB, WS_GB = 544 * MiB;
constexpr size_t WS_KA = 608 * MiB, WS_VA = 616 * MiB;
constexpr size_t WS_IQ = 624 * MiB;
constexpr size_t WS_ACT = 648 * MiB;
constexpr size_t WS_IK = 640 * MiB, WS_IW = 644 * MiB;
constexpr size_t WS_END = 1000 * MiB;
static_assert(WS_ACT + (size_t)MTOK * FF * 2 <= WS_END && WS_IW + (size_t)MTOK * 16 <= WS_ACT && WS_IQ + (size_t)MTOK * 128 * 2 <= WS_IK && WS_WDN + (size_t)DM * FF * 2 <= WS_XB && WS_WGU + (size_t)NGU * DM * 2 <= WS_WDN, "d_ws map");
constexpr int RING_BYTES = 131072;
constexpr int XCH_OFF = RING_BYTES;
constexpr int P2_SC = 0, SCW = 1028;
constexpr int P2_MASK = 143360;
constexpr int MISC_OFF = 163584;
constexpr int LDS_BYTES = 163840;
static_assert(P2_SC + 16 * SCW * 4 <= P2_MASK && P2_MASK + 16384 <= MISC_OFF, "P2 LDS map");

#define LAS __attribute__((address_space(3)))
typedef unsigned short bf16;
typedef unsigned v4u __attribute__((ext_vector_type(4)));
typedef unsigned v2u __attribute__((ext_vector_type(2)));
typedef float f32x4 __attribute__((ext_vector_type(4)));
typedef float f32x16 __attribute__((ext_vector_type(16)));
typedef short bf16x8 __attribute__((ext_vector_type(8)));
typedef short s16x4 __attribute__((ext_vector_type(4)));
#define LDS_WAIT() asm volatile("s_waitcnt lgkmcnt(0)" ::: "memory")
using pg8::pkbf;
__device__ __forceinline__ float bf2f(unsigned short h) { return __uint_as_float((unsigned)h << 16); }
__device__ __forceinline__ float bflo(unsigned w) { return __uint_as_float(w << 16); }
__device__ __forceinline__ float bfhi(unsigned w) { return __uint_as_float(w & 0xffff0000u); }
__device__ __forceinline__ float wave_sum(float v) {
#pragma unroll
    for (int o = 1; o < 64; o <<= 1) v += __shfl_xor(v, o);
    return v;
}
__device__ __forceinline__ s16x4 vtr(const LAS unsigned char* p) { return __builtin_bit_cast(s16x4, __builtin_amdgcn_ds_read_tr16_b64_v4i16((LAS s16x4*)p)); }
__device__ __forceinline__ bf16x8 cat8(s16x4 lo, s16x4 hi) { return (bf16x8){lo[0], lo[1], lo[2], lo[3], hi[0], hi[1], hi[2], hi[3]}; }
__device__ __forceinline__ int crow(int r, int hi) { return (r & 3) + 8 * (r >> 2) + 4 * hi; }

__device__ __forceinline__ int lane_id() { unsigned ones = ~0u; asm volatile("" : "+s"(ones)); return (int)__builtin_amdgcn_mbcnt_hi(ones, __builtin_amdgcn_mbcnt_lo(ones, 0u)); }
struct KArgs { const float* in[16]; float* out; unsigned char* ws; int ph_lo, ph_hi; };
struct Frame {
    LAS unsigned char* lds;
    unsigned* ctl;
    unsigned char* ws;
    int tid, lane, wave, vcu, G;
    int grp, rk;
    const __attribute__((address_space(4))) KArgs* ap;
    __device__ __forceinline__ const float* x() const { return ap->in[0]; }
    __device__ __forceinline__ const float* norm1_w() const { return ap->in[1]; }
    __device__ __forceinline__ const float* w_in() const { return ap->in[2]; }
    __device__ __forceinline__ const float* q_norm_w() const { return ap->in[3]; }
    __device__ __forceinline__ const float* k_norm_w() const { return ap->in[4]; }
    __device__ __forceinline__ const float* kv_norm_w() const { return ap->in[5]; }
    __device__ __forceinline__ const float* w_uk() const { return ap->in[6]; }
    __device__ __forceinline__ const float* w_uv() const { return ap->in[7]; }
    __device__ __forceinline__ const float* rel_bias() const { return ap->in[8]; }
    __device__ __forceinline__ const float* ret_gn_w() const { return ap->in[9]; }
    __device__ __forceinline__ const float* ret_gn_b() const { return ap->in[10]; }
    __device__ __forceinline__ const float* w_out() const { return ap->in[11]; }
    __device__ __forceinline__ const float* norm2_w() const { return ap->in[12]; }
    __device__ __forceinline__ const float* w_gate() const { return ap->in[13]; }
    __device__ __forceinline__ const float* w_up() const { return ap->in[14]; }
    __device__ __forceinline__ const float* w_down() const { return ap->in[15]; }
    __device__ __forceinline__ float* out() const { return ap->out; }
#define WSB_(name, off) __device__ __forceinline__ bf16* name() const { return (bf16*)(ws + (off)); }
#define WSF_(name, off) __device__ __forceinline__ float* name() const { return (float*)(ws + (off)); }
    WSB_(WIN, WS_WIN) WSB_(WOUT, WS_WOUT) WSB_(WGU, WS_WGU) WSB_(WDN, WS_WDN) WSB_(XB, WS_XB) WSB_(MIX, WS_MIX) WSB_(QA, WS_QA) WSB_(QB, WS_QB) WSB_(KB, WS_KB) WSB_(VB, WS_VB) WSB_(GB, WS_GB)
    WSB_(KA, WS_KA) WSB_(VA, WS_VA) WSB_(IQ, WS_IQ) WSB_(IK, WS_IK) WSB_(ACT, WS_ACT)
    WSF_(IW, WS_IW) WSF_(R2, WS_R2) WSF_(RMS, WS_RMS) WSF_(COS, WS_COS) WSF_(SIN, WS_SIN) WSF_(BT, WS_BT)
#undef WSB_
#undef WSF_
};

__device__ __forceinline__ int zcol(int n) {
    const int pn = n >> 8, tc = n & 255, bj = tc >> 7, wc = (tc >> 5) & 3, j = tc & 31, d = bj * 32 + j;
    if (pn < 2) return (4 * pn + wc) * 64 + d;
    if (pn == 2) { if (wc == 0) return -2 - d; if (wc == 1) return -2 - (64 + d); return 512 + (wc - 2) * 64 + d; }
    if (pn == 3) { if (bj == 0) return 640 + wc * 32 + j; if (wc == 0) return 768 + j; if (wc == 1 && j < 4) return 800 + j; return -1; }
    const int g = (pn - 4) >> 1, head = 4 * ((pn - 4) & 1) + wc;
    return 804 + g * 512 + head * 64 + d;
}
template <class SRC>
__device__ __forceinline__ void tr_item(SRC src, int Kdim, bf16* WT, int k0, int n0, LAS float* scr, int lane) {
#pragma unroll 4
    for (int i = 0; i < 32; ++i) { const int kk = 2 * i + (lane >> 5); scr[kk * 33 + (lane & 31)] = src(k0 + kk); }
    LDS_WAIT(); asm volatile("" ::: "memory");
    const int c = lane & 7;
#pragma unroll
    for (int j = 0; j < 4; ++j) { const int n = (lane >> 3) + 8 * j; const LAS float* s = scr + (8 * c) * 33 + n;
        v4u o; o.x = pkbf(s[0 * 33], s[1 * 33]); o.y = pkbf(s[2 * 33], s[3 * 33]); o.z = pkbf(s[4 * 33], s[5 * 33]); o.w = pkbf(s[6 * 33], s[7 * 33]);
        *(v4u*)(WT + (size_t)(n0 + n) * Kdim + k0 + 8 * c) = o; }
    LDS_WAIT(); asm volatile("" ::: "memory");
}
__device__ __forceinline__ int t5_bucket(int rel) {
    const int n = rel < 0 ? -rel : rel; int b;
    if (n < 8) b = n; else if (n < 12) b = 8; else if (n < 16) b = 9; else if (n < 23) b = 10; else if (n < 32) b = 11; else if (n < 46) b = 12; else if (n < 64) b = 13; else if (n < 91) b = 14; else b = 15;
    return (rel > 0 ? 16 : 0) + b;
}
__device__ __forceinline__ void p0_prologue(Frame& F) {
    LAS float* scr = (LAS float*)(F.lds + F.wave * 16384);
    const int lane = F.lane, gw = F.vcu * NWAVES + F.wave, NGW = F.G * NWAVES;
    if (blockIdx.x == 0 && F.tid == 0) F.ctl[0] = 0u;
    constexpr int I_IN = 16 * (NIN / 32), I_OUT = 16 * 32, I_GU = 16 * (NGU / 32), I_DN = (FF / 64) * 32, NITEMS = I_IN + I_OUT + I_GU + I_DN;
    auto do_item = [&](int it) {
        int r = it;
        if (r < I_IN) {
            const int kb = r / (NIN / 32), nb = r % (NIN / 32), f = zcol(32 * nb + (lane & 31));
            const float* w_in = F.w_in(); const float* nw = F.norm1_w();
            if (f >= -1) tr_item([&](int k) { return f >= 0 ? nw[k] * w_in[(size_t)k * INW + f] : 0.0f; }, DM, F.WIN(), 64 * kb, 32 * nb, scr, lane);
            return;
        }
        r -= I_IN;
        if (r < I_OUT) { const int kb = r / 32, nb = r % 32; const float* w = F.w_out() + 32 * nb + (lane & 31);
            tr_item([&](int k) { return w[(size_t)k * DM]; }, DM, F.WOUT(), 64 * kb, 32 * nb, scr, lane); return; }
        r -= I_OUT;
        if (r < I_GU) { const int kb = r / (NGU / 32), nb = r % (NGU / 32), n = 32 * nb + (lane & 31), pn = n >> 8, tc = n & 255;
            const float* w = ((tc >> 7) ? F.w_up() : F.w_gate()) + 128 * pn + (tc & 127); const float* nw = F.norm2_w();
            tr_item([&](int k) { return nw[k] * w[(size_t)k * FF]; }, DM, F.WGU(), 64 * kb, 32 * nb, scr, lane); return; }
        r -= I_GU;
        { const int kb = r / 32, nb = r % 32; const float* w = F.w_down() + 32 * nb + (lane & 31);
            tr_item([&](int k) { return w[(size_t)k * DM]; }, FF, F.WDN(), 64 * kb, 32 * nb, scr, lane); }
    };
    for (int e = F.vcu * NTHR + F.tid; e < DM * 128; e += F.G * NTHR) {
        const int k = e >> 7, idx = e & 127, d = idx & 63; const float* wu = (idx < 64 ? F.w_uk() : F.w_uv()) + d; const float* wr_ = F.w_in() + (size_t)k * INW + 512; float a = 0.f;
#pragma unroll 8
        for (int j = 0; j < 128; ++j) a += wr_[j] * F.kv_norm_w()[j] * wu[j * 64];
        const int n = 512 + (idx < 64 ? 0 : 32) + (d < 32 ? d : 128 + d - 32);
        F.WIN()[(size_t)n * DM + k] = (bf16)(pkbf(F.norm1_w()[k] * a, 0.f) & 0xffffu);
    }
    int it = gw, kk = 0;
    for (int m = gw; m < MTOK; m += NGW, ++kk) {
        const f32x4* xr = (const f32x4*)(F.x() + (size_t)m * DM) + lane;
        f32x4 v[4]; float sq = 0.f;
#pragma unroll
        for (int j = 0; j < 4; ++j) { v[j] = __builtin_nontemporal_load(xr + 64 * j); sq += pg8::dot4(v[j]); }
        const float ms = wave_sum(sq) * (1.0f / DM) + 1e-6f, rr = 1.0f / sqrtf(ms);
        v2u* o8 = (v2u*)(F.XB() + (size_t)m * DM) + lane;
#pragma unroll
        for (int j = 0; j < 4; ++j) o8[64 * j] = (v2u){pkbf(v[j][0] * rr, v[j][1] * rr), pkbf(v[j][2] * rr, v[j][3] * rr)};
        if (lane == 0) F.RMS()[m] = sqrtf(ms);
        if ((kk & 7) == 3 && it < NITEMS) { do_item(it); it += NGW; }
    }
    for (; it < NITEMS; it += NGW) do_item(it);
    const int gt = F.vcu * NTHR + F.tid, NGT = F.G * NTHR;
    for (int i = gt; i < 8 * 256; i += NGT) { const int h = i >> 8, rel = (i & 255) - 191;
        F.BT()[i] = (F.rel_bias()[t5_bucket(rel) * 8 + h] - F.rel_bias()[15 * 8 + h]) * 1.4426950408889634f; }
}

#ifndef PROBE_LO
#define PROBE_LO 3000.0f
#define PROBE_RANGE 4000.0f
#endif
#ifndef PLANES
#define PLANES 1
#endif
#ifndef MIXREP
#define MIXREP 0
#endif
typedef float f32x4_t __attribute__((ext_vector_type(4)));
typedef float f32x2v __attribute__((ext_vector_type(2)));
struct IdxOps { bf16x8 bq[4]; f32x4 wv; bf16x8 a0, a1; };
__device__ __forceinline__ void idx_fetch(IdxOps& o, const Frame& F, int b, int c, int rq) {
    const int w = F.wave, lane = F.lane, q = lane & 15, g = lane >> 4;
    const size_t rowq = (size_t)b * SEQ + 64 * c + 16 * rq + q;
#pragma unroll
    for (int h = 0; h < 4; ++h) o.bq[h] = *(const bf16x8*)(F.IQ() + rowq * 128 + 32 * h + 8 * g);
    o.wv = *(const f32x4*)(F.IW() + rowq * 4) * (0.5f * 0.17677669529663687f);
    const bf16* kp = F.IK() + ((size_t)b * SEQ + q) * 32 + 8 * g;
    o.a0 = *(const bf16x8*)(kp + (size_t)w * 512);
    o.a1 = *(const bf16x8*)(kp + (size_t)(w + 32 < 4 * (c + 1) ? w + 32 : w) * 512);
}
__device__ __forceinline__ f32x4 idx_score(const IdxOps& o, bf16x8 a) {
    f32x4 sc = {0.f, 0.f, 0.f, 0.f};
#pragma unroll
    for (int h = 0; h < 4; ++h) {
        const f32x4 d = __builtin_amdgcn_mfma_f32_16x16x32_bf16(a, o.bq[h], (f32x4){0.f, 0.f, 0.f, 0.f}, 0, 0, 0);
#pragma unroll
        for (int i = 0; i < 4; ++i) sc[i] += o.wv[h] * fmaxf(d[i], 0.f);
    }
    return sc + 0.f;
}
__device__ __forceinline__ void idx_round(const IdxOps& o, const Frame& F, int b, int c, LAS unsigned char* lds) {
    const int w = F.wave, lane = F.lane, q = lane & 15, g = lane >> 4;
    const int nkb = 4 * (c + 1);
    const bf16* kp = F.IK() + ((size_t)b * SEQ + q) * 32 + 8 * g;
    LAS unsigned* dst = (LAS unsigned*)(lds + P2_SC) + q * SCW + 4 * g;
    bf16x8 a0 = o.a0, a1 = o.a1;
    for (int s2 = 0; s2 < 2; ++s2)
        for (int kbl = w; kbl < 32; kbl += 8) {
            const int kb0 = kbl + 64 * s2; if (kb0 >= nkb) break;
            int nx = kb0 + 8; if (kbl + 8 >= 32) nx = w + 64 * (s2 + 1);
            bf16x8 n0 = a0, n1 = a1;
            if (nx < nkb) { n0 = *(const bf16x8*)(kp + (size_t)nx * 512); n1 = *(const bf16x8*)(kp + (size_t)(nx + 32 < nkb ? nx + 32 : nx) * 512); }
            const f32x4 s0 = idx_score(o, a0);
            f32x4 s1 = {0.f, 0.f, 0.f, 0.f}; if (kb0 + 32 < nkb) s1 = idx_score(o, a1);
            v4u pk;
#pragma unroll
            for (int i = 0; i < 4; ++i) pk[i] = __builtin_amdgcn_perm(__float_as_uint(s1[i]), __float_as_uint(s0[i]), 0x07060302u);
            *(LAS v4u*)(dst + (16 * s2 + (kb0 >> 1 & 15)) * 32 + 16 * (kb0 & 1)) = pk;
            a0 = n0; a1 = n1;
        }
}
__device__ __forceinline__ int wave_sum_i(int v) {
    v += __builtin_amdgcn_update_dpp(0, v, 0xB1, 0xF, 0xF, false);
    v += __builtin_amdgcn_update_dpp(0, v, 0x4E, 0xF, 0xF, false);
    v += __builtin_amdgcn_update_dpp(0, v, 0x141, 0xF, 0xF, false);
    v += __builtin_amdgcn_update_dpp(0, v, 0x140, 0xF, 0xF, false);
    return (__builtin_amdgcn_readlane(v, 0) + __builtin_amdgcn_readlane(v, 16)) + (__builtin_amdgcn_readlane(v, 32) + __builtin_amdgcn_readlane(v, 48));
}
__device__ __forceinline__ unsigned sortable(float f) { const unsigned bits = __float_as_uint(f); return bits ^ ((unsigned)((int)bits >> 31) | 0x80000000u); }
template <int NJ>
__device__ __forceinline__ void mask_words(const unsigned (&u)[NJ], unsigned prefix, bool exact, LAS unsigned long long* mrow, int nj, int lane) {
    unsigned long long mv = 0ull;
    if (exact) {
#pragma unroll
        for (int j = 0; j < NJ; ++j) { const unsigned long long sel = __ballot(u[j] >= prefix); if (lane == j) mv = sel; }
    } else {
        int ngt = 0;
#pragma unroll
        for (int j = 0; j < NJ; ++j) ngt += __popcll(__ballot(u[j] > prefix));
        int need = 256 - ngt;
#pragma unroll
        for (int j = 0; j < NJ; ++j) {
            const unsigned long long eq = __ballot(u[j] == prefix);
            const int rank = (int)__builtin_amdgcn_mbcnt_hi((unsigned)(eq >> 32), __builtin_amdgcn_mbcnt_lo((unsigned)eq, 0u));
            const unsigned long long sel = __ballot(u[j] > prefix || (u[j] == prefix && rank < need));
            need -= __popcll(eq);
            if (lane == j) mv = sel;
        }
    }
    if (lane < nj) mrow[lane] = mv;
}
template <int NJ>
__device__ __forceinline__ void select_row(const LAS float* row, LAS unsigned long long* mrow, int nj, int lane) {
    static_assert(NJ % 4 == 0, "groups of four");
    unsigned u[NJ];
#pragma unroll
    for (int j = 0; j < NJ; ++j) { float v = row[64 * j + lane]; asm volatile("" : "+v"(v)); u[j] = (j < nj) ? sortable(v) : 0u; }
    unsigned prefix = 0u; bool exact = false;
#pragma unroll 1
    for (int bit = 31; bit >= 0; --bit) {
        const unsigned trial = prefix | (1u << bit); int c0 = 0, c1 = 0, c2 = 0, c3 = 0;
#pragma unroll
        for (int j = 0; j < NJ; j += 4) {
            unsigned long long m0, m1, m2, m3;
            asm volatile("v_cmp_le_u32_e64 %4, %12, %8\n\tv_cmp_le_u32_e64 %5, %12, %9\n\tv_cmp_le_u32_e64 %6, %12, %10\n\tv_cmp_le_u32_e64 %7, %12, %11\n\t"
                         "v_addc_co_u32_e64 %0, %4, 0, %0, %4\n\tv_addc_co_u32_e64 %1, %5, 0, %1, %5\n\tv_addc_co_u32_e64 %2, %6, 0, %2, %6\n\tv_addc_co_u32_e64 %3, %7, 0, %3, %7"
                         : "+v"(c0), "+v"(c1), "+v"(c2), "+v"(c3), "=&s"(m0), "=&s"(m1), "=&s"(m2), "=&s"(m3) : "v"(u[j]), "v"(u[j + 1]), "v"(u[j + 2]), "v"(u[j + 3]), "s"(trial));
        }
        const int cnt = wave_sum_i((c0 + c1) + (c2 + c3));
        if (cnt >= 256) prefix = trial;
        if (cnt == 256) { exact = true; break; }
    }
    mask_words<NJ>(u, prefix, exact, mrow, nj, lane);
}
template <int S, unsigned M>
__device__ __forceinline__ void tr_stage(unsigned (&A)[32]) {
#pragma unroll
    for (int k = 0; k < 32; ++k) if (!(k & S)) {
        const unsigned a = A[k], b = A[k + S], bs = b << S, as = a >> S; unsigned lo, hi;
        asm("v_bfi_b32 %0, %1, %2, %3" : "=v"(lo) : "s"(M), "v"(a), "v"(bs)); asm("v_bfi_b32 %0, %1, %2, %3" : "=v"(hi) : "s"(M), "v"(as), "v"(b));
        A[k] = lo; A[k + S] = hi; }
}
__device__ __forceinline__ void tr_bytes(unsigned (&A)[32]) {
#pragma unroll
    for (int k = 0; k < 16; ++k) { const unsigned a = A[k], b = A[k + 16];
        A[k] = __builtin_amdgcn_perm(b, a, 0x05040100u);
        A[k + 16] = __builtin_amdgcn_perm(b, a, 0x07060302u); }
#pragma unroll
    for (int k = 0; k < 32; ++k) if (!(k & 8)) { const unsigned a = A[k], b = A[k + 8];
        A[k] = __builtin_amdgcn_perm(b, a, 0x06020400u);
        A[k + 8] = __builtin_amdgcn_perm(b, a, 0x07030501u); }
}
__device__ __forceinline__ void planes_finish(unsigned gt, unsigned alive, int G, bool done, LAS unsigned long long* mrow, int nj, int lane) {
    unsigned sel = gt | alive;
    if (!done) {
        int need = 256 - G; unsigned ts = 0u;
#pragma unroll
        for (int j = 0; j < 32; ++j) {
            const bool mine = (alive >> j) & 1u; const unsigned long long eq = __ballot(mine);
            const int rank = (int)__builtin_amdgcn_mbcnt_hi((unsigned)(eq >> 32), __builtin_amdgcn_mbcnt_lo((unsigned)eq, 0u));
            ts |= (mine && rank < need) ? (1u << j) : 0u; need -= __popcll(eq);
        }
        sel = gt | ts;
    }
    unsigned long long mv = 0ull;
#pragma unroll
    for (int j = 0; j < 32; ++j) { const unsigned long long w = __ballot((sel >> j) & 1u); if (lane == j) mv = w; }
    if (lane < nj) mrow[lane] = mv;
}
__device__ __forceinline__ void select_rows_planes2(const LAS float* rowa, const LAS float* rowb, LAS unsigned long long* mrowa, LAS unsigned long long* mrowb, int nj, int lane) {
    unsigned A[32], B[32];
#pragma unroll
    for (int j = 0; j < 32; ++j) { float va = rowa[64 * j + lane], vb = rowb[64 * j + lane]; asm volatile("" : "+v"(va), "+v"(vb)); A[j] = (j < nj) ? sortable(va) : 0u; B[j] = (j < nj) ? sortable(vb) : 0u; }
    tr_bytes(A); tr_stage<4, 0x0F0F0F0Fu>(A); tr_stage<2, 0x33333333u>(A); tr_stage<1, 0x55555555u>(A);
    tr_bytes(B); tr_stage<4, 0x0F0F0F0Fu>(B); tr_stage<2, 0x33333333u>(B); tr_stage<1, 0x55555555u>(B);
#pragma unroll
    for (int j = 0; j < 32; ++j) asm volatile("" : "+v"(A[j]), "+v"(B[j]));
    unsigned alivea = 0xFFFFFFFFu, gta = 0u, aliveb = 0xFFFFFFFFu, gtb = 0u; int Ga = 0, Aa = 2048, Gb = 0, Ab = 2048; bool donea = false, doneb = false;
#pragma unroll
    for (int b = 31; b >= 0; --b) {
        if (!(donea && doneb)) {
            const unsigned onesa = alivea & A[b], onesb = aliveb & B[b];
            const int both = wave_sum_i(__builtin_popcount(onesa) | (__builtin_popcount(onesb) << 16)), C1a = both & 0xffff, C1b = both >> 16;
            if (!donea) {
                if (Ga + C1a >= 256) { alivea = onesa; Aa = C1a; } else { Ga += C1a; gta |= onesa; alivea &= ~A[b]; Aa -= C1a; }
                donea = (Ga + Aa == 256);
            }
            if (!doneb) {
                if (Gb + C1b >= 256) { aliveb = onesb; Ab = C1b; } else { Gb += C1b; gtb |= onesb; aliveb &= ~B[b]; Ab -= C1b; }
                doneb = (Gb + Ab == 256);
            }
        }
    }
    planes_finish(gta, alivea, Ga, donea, mrowa, nj, lane);
    planes_finish(gtb, aliveb, Gb, doneb, mrowb, nj, lane);
}
constexpr int MP_STRIDE = 36, MP_PLANE = 64 * MP_STRIDE;
__device__ __forceinline__ unsigned row32_sum(unsigned v) {
    v += __builtin_amdgcn_update_dpp(0, v, 0xB1, 0xF, 0xF, true);
    v += __builtin_amdgcn_update_dpp(0, v, 0x4E, 0xF, 0xF, true);
    v += __builtin_amdgcn_update_dpp(0, v, 0x141, 0xF, 0xF, true);
    v += __builtin_amdgcn_update_dpp(0, v, 0x140, 0xF, 0xF, true);
#if defined(SWZ_SUM)
    return v + (unsigned)__builtin_amdgcn_ds_swizzle((int)v, 0x401F);
#else
    const auto sw = __builtin_amdgcn_permlane16_swap(v, v, false, false);
    return (unsigned)sw[0] + (unsigned)sw[1];
#endif
}
__device__ __forceinline__ void tr16(unsigned (&T)[16]) {
#pragma unroll
    for (int k = 0; k < 8; ++k) { const unsigned a = T[k], b = T[k + 8];
        T[k] = __builtin_amdgcn_perm(b, a, 0x06020400u);
        T[k + 8] = __builtin_amdgcn_perm(b, a, 0x07030501u); }
#define TR16_STAGE(S, M) _Pragma("unroll") for (int k = 0; k < 16; ++k) if (!(k & S)) { const unsigned a = T[k], b = T[k + S], bs = b << S, as = a >> S; unsigned lo, hi; \
        asm("v_bfi_b32 %0, %1, %2, %3" : "=v"(lo) : "s"(M), "v"(a), "v"(bs)); asm("v_bfi_b32 %0, %1, %2, %3" : "=v"(hi) : "s"(M), "v"(as), "v"(b)); T[k] = lo; T[k + S] = hi; }
    TR16_STAGE(4, 0x0F0F0F0Fu) TR16_STAGE(2, 0x33333333u) TR16_STAGE(1, 0x55555555u)
#undef TR16_STAGE
}
__device__ __forceinline__ void select_rows32(const LAS unsigned* sc, LAS unsigned* mp, int rq, int nj, int wave, int lane) {
    const int half = lane >> 5, l32 = lane & 31, ql = wave + 8 * half;
    const LAS unsigned* row = sc + ql * SCW + l32;
    unsigned A[16], B[16];
#ifdef ASM_MARK
    asm volatile("; SEL_BEGIN");
#endif
#pragma unroll
    for (int k = 0; k < 16; ++k) { unsigned va = row[32 * k], vb = row[32 * (16 + k)]; asm volatile("" : "+v"(va), "+v"(vb)); A[k] = va; B[k] = vb; }
    tr16(A); tr16(B);
#ifdef ASM_MARK
    asm volatile("; SEL_TR_END");
#endif
    const int nv = 2 * nj;
    unsigned al0 = nv >= 32 ? 0xFFFFFFFFu : ((1u << nv) - 1u), al1 = nv <= 32 ? 0u : (nv >= 64 ? 0xFFFFFFFFu : ((1u << (nv - 32)) - 1u));
    unsigned gt0 = 0u, gt1 = 0u, G = 0u;
    const unsigned S0 = A[15], S1 = B[15];
#pragma unroll
    for (int b = 15; b >= 0; --b) {
        const unsigned o0 = b == 15 ? (al0 & ~S0) : __builtin_amdgcn_bitop3_b32(al0, A[b], S0, 0x60), o1 = b == 15 ? (al1 & ~S1) : __builtin_amdgcn_bitop3_b32(al1, B[b], S1, 0x60);
        const unsigned c1 = row32_sum((unsigned)__builtin_popcount(o0) + (unsigned)__builtin_popcount(o1));
        const unsigned nt = (unsigned)((int)(G + c1 - 256u) >> 31);
        al0 = __builtin_amdgcn_bitop3_b32(o0, al0, nt, 0x78); al1 = __builtin_amdgcn_bitop3_b32(o1, al1, nt, 0x78);
        gt0 = __builtin_amdgcn_bitop3_b32(gt0, o0, nt, 0xF8); gt1 = __builtin_amdgcn_bitop3_b32(gt1, o1, nt, 0xF8);
        G += c1 & nt;
    }
#ifdef ASM_MARK
    asm volatile("; SEL_LOOP_END");
#endif
    const unsigned ce = row32_sum((unsigned)__builtin_popcount(al0) + (unsigned)__builtin_popcount(al1));
    const bool tie = G + ce != 256u;
    if (__any(tie)) {
        const unsigned need = tie ? 256u - G : 0x7fffffffu; unsigned m = 0u;
#pragma unroll
        for (int bit = 6; bit >= 0; --bit) {
            const unsigned cand = m + (1u << bit);
            const unsigned k0 = cand >= 32u ? 0xFFFFFFFFu : ((1u << cand) - 1u), k1 = cand <= 32u ? 0u : (cand >= 64u ? 0xFFFFFFFFu : ((1u << (cand - 32u)) - 1u));
            const unsigned cc = row32_sum((unsigned)__builtin_popcount(al0 & k0) + (unsigned)__builtin_popcount(al1 & k1));
            m = (cand <= 64u && cc <= need) ? cand : m;
        }
        const unsigned k0 = m >= 32u ? 0xFFFFFFFFu : ((1u << m) - 1u), k1 = m <= 32u ? 0u : (m >= 64u ? 0xFFFFFFFFu : ((1u << (m - 32u)) - 1u));
        const unsigned cm = row32_sum((unsigned)__builtin_popcount(al0 & k0) + (unsigned)__builtin_popcount(al1 & k1));
        const unsigned rem = need - cm;
        const bool mine = m < 64u && (((m < 32u ? al0 >> m : al1 >> (m - 32u)) & 1u) != 0u);
        const unsigned long long eq = __ballot(mine); const unsigned eqr = half ? (unsigned)(eq >> 32) : (unsigned)eq;
        const bool tk = mine && (unsigned)__builtin_popcount(eqr & ((1u << l32) - 1u)) < rem;
        al0 = (al0 & k0) | ((tk && m < 32u) ? (1u << m) : 0u); al1 = (al1 & k1) | ((tk && m >= 32u) ? (1u << (m - 32u)) : 0u);
    }
#ifdef ASM_MARK
    asm volatile("; SEL_TIE_END");
#endif
    LAS unsigned* rec = mp + (16 * rq + ql) * MP_STRIDE + l32;
    rec[0] = gt0 | al0; rec[MP_PLANE] = gt1 | al1;
}
constexpr int AT_K = 0, AT_V = 32768, AT_BT = 65536, AT_WS = 73728, AT_OST = 0, AT_Q = 75776;
static_assert(AT_Q + 65536 <= P2_MASK && AT_OST + 8 * 4608 <= AT_BT, "attention LDS map");
__device__ __forceinline__ bf16x8 pk16(const f32x16& v, int o) { return __builtin_bit_cast(bf16x8, (v4u){pkbf(v[o], v[o + 1]), pkbf(v[o + 2], v[o + 3]), pkbf(v[o + 4], v[o + 5]), pkbf(v[o + 6], v[o + 7])}); }
__device__ __forceinline__ void glds16(const void* gsrc, unsigned lds_dst) {
    unsigned keep;
    asm volatile("s_mov_b32 %0, m0\n\ts_mov_b32 m0, %2\n\ts_nop 0\n\tglobal_load_lds_dwordx4 %1, off\n\ts_mov_b32 m0, %0" : "=&s"(keep) : "v"(gsrc), "s"(lds_dst) : "memory");
}
__device__ __forceinline__ unsigned lds_addr(const LAS unsigned char* p) { return (unsigned)(uintptr_t)p; }
template <bool MASK, bool NEAR>
__device__ __forceinline__ void attn_soft(f32x16& p0, f32x16& p1, f32x2v& lacc, bf16x8 (&pa)[4], const LAS unsigned* mrec, int sbit) {
#pragma unroll
    for (int i = 0; i < 16; ++i) { p0[i] = __builtin_amdgcn_exp2f(p0[i]); p1[i] = __builtin_amdgcn_exp2f(p1[i]); }
    if (MASK) {
#pragma unroll
        for (int g = 0; g < 4; ++g) {
            const v4u w4 = *(const LAS v4u*)(mrec + 8 * g);
#pragma unroll
            for (int k = 0; k < 4; ++k) { int m0_, m1_; asm("v_bfe_i32 %0, %1, %2, 1" : "=v"(m0_) : "v"(w4[k]), "s"(sbit)); asm("v_bfe_i32 %0, %1, %2, 1" : "=v"(m1_) : "v"(w4[k]), "s"(sbit + 1));
                p0[4 * g + k] = __uint_as_float(__float_as_uint(p0[4 * g + k]) & (unsigned)m0_); p1[4 * g + k] = __uint_as_float(__float_as_uint(p1[4 * g + k]) & (unsigned)m1_); }
        }
    }
#pragma unroll
    for (int i = 0; i < 16; i += 2) { lacc += (f32x2v){p0[i], p0[i + 1]}; lacc += (f32x2v){p1[i], p1[i + 1]}; }
    pa[0] = pk16(p0, 0); pa[1] = pk16(p0, 8); pa[2] = pk16(p1, 0); pa[3] = pk16(p1, 8);
}
__device__ __forceinline__ void attn_pv(f32x16& o0, f32x16& o1, const bf16x8 (&pa)[4], const LAS unsigned char* Vb) {
#pragma unroll
    for (int ks = 0; ks < 4; ++ks) {
        o0 = __builtin_amdgcn_mfma_f32_32x32x16_bf16(pa[ks], cat8(vtr(Vb + ks * 1024), vtr(Vb + ks * 1024 + 512)), o0, 0, 0, 0);
        o1 = __builtin_amdgcn_mfma_f32_32x32x16_bf16(pa[ks], cat8(vtr(Vb + 4096 + ks * 1024), vtr(Vb + 4096 + ks * 1024 + 512)), o1, 0, 0, 0);
    }
}
template <bool NEAR>
__device__ __forceinline__ void attn_qk(f32x16& a0, f32x16& a1, f32x16& b0, f32x16& b1, const LAS unsigned char* Qb, const LAS unsigned char* Kb, const LAS float* bt) {
#pragma unroll
    for (int i = 0; i < 16; ++i) {
        if (NEAR) { a0[i] = bt[(i & 3) + 8 * (i >> 2)]; a1[i] = bt[32 + (i & 3) + 8 * (i >> 2)]; b0[i] = bt[(i & 3) + 8 * (i >> 2) - 32]; b1[i] = bt[(i & 3) + 8 * (i >> 2)]; }
        else { a0[i] = 0.f; a1[i] = 0.f; b0[i] = 0.f; b1[i] = 0.f; }
    }
#pragma unroll
    for (int d0 = 0; d0 < 4; ++d0) {
        const bf16x8 k0 = *(const LAS bf16x8*)(Kb + d0 * 2048), k1 = *(const LAS bf16x8*)(Kb + d0 * 2048 + 512);
        const bf16x8 qfa = *(const LAS bf16x8*)(Qb + d0 * 1024), qfb = *(const LAS bf16x8*)(Qb + 4096 + d0 * 1024);
        a0 = __builtin_amdgcn_mfma_f32_32x32x16_bf16(k0, qfa, a0, 0, 0, 0); a1 = __builtin_amdgcn_mfma_f32_32x32x16_bf16(k1, qfa, a1, 0, 0, 0);
        b0 = __builtin_amdgcn_mfma_f32_32x32x16_bf16(k0, qfb, b0, 0, 0, 0); b1 = __builtin_amdgcn_mfma_f32_32x32x16_bf16(k1, qfb, b1, 0, 0, 0);
    }
}
__device__ __forceinline__ void attn_store(const f32x16& o0, const f32x16& o1, f32x2v lacc, bf16* obase, LAS unsigned char* stg, LAS float* wsf, int lane) {
    const int r = lane & 31, hi = lane >> 5;
    float lsum = lacc[0] + lacc[1];
    lsum += __shfl_xor(lsum, 32);
    if (hi == 0) wsf[r] = lsum;
    LDS_WAIT(); asm volatile("" ::: "memory");
    LAS unsigned short* st = (LAS unsigned short*)stg;
#pragma unroll
    for (int i = 0; i < 16; ++i) {
        const int q = crow(i, hi); const float rl = 1.0f / wsf[q];
        st[q * 72 + r] = (unsigned short)(pkbf(o0[i] * rl, 0.f) & 0xffffu); st[q * 72 + 32 + r] = (unsigned short)(pkbf(o1[i] * rl, 0.f) & 0xffffu);
    }
    LDS_WAIT(); asm volatile("" ::: "memory");
#pragma unroll
    for (int k = 0; k < 4; ++k) { const int row = 8 * k + (lane >> 3), ch = lane & 7;
        const v4u v = *(const LAS v4u*)(stg + row * 144 + ch * 16); *(v4u*)(obase + (size_t)row * DM + ch * 8) = v; }
    LDS_WAIT(); asm volatile("" ::: "memory");
}
template <bool MASK>
__device__ __forceinline__ void attn_chunk(const Frame& F, int b, int c, LAS unsigned char* lds) {
    const int wid = F.wave, lane = F.lane, r = lane & 31, hi = lane >> 5;
    const size_t rowbase = (size_t)b * SEQ; const int q0 = 64 * c, nt = c + 1;
    const LAS unsigned char* Qb = lds + AT_Q + wid * 8192 + lane * 16;
#pragma unroll
    for (int d0 = 0; d0 < 4; ++d0) {
        *(LAS bf16x8*)(lds + AT_Q + wid * 8192 + d0 * 1024 + lane * 16) = *(const bf16x8*)(F.QA() + (rowbase + q0 + r) * 512 + wid * 64 + 16 * d0 + 8 * hi);
        *(LAS bf16x8*)(lds + AT_Q + wid * 8192 + 4096 + d0 * 1024 + lane * 16) = *(const bf16x8*)(F.QA() + (rowbase + q0 + 32 + r) * 512 + wid * 64 + 16 * d0 + 8 * hi); }
    const LAS float* BT = (const LAS float*)(lds + AT_BT) + wid * 256;
    const bf16* ksrc = F.KA() + (rowbase + lane) * 64 + 8 * wid;
    const bf16* vsrc = F.VA() + (rowbase + 16 * (wid & 3) + (lane >> 2)) * 64 + (wid >> 2) * 32 + (lane & 3) * 8;
    const LAS unsigned* mreca = (const LAS unsigned*)(lds + P2_MASK) + r * MP_STRIDE + 4 * hi; const LAS unsigned* mrecb = mreca + 32 * MP_STRIDE;
    const int voff = ((lane >> 4) & 1) * 32 + (lane & 3) * 8 + (4 * hi + ((lane & 15) >> 2)) * 64;
    f32x16 oa0, oa1, ob0, ob1; f32x2v la = {0.f, 0.f}, lb = {0.f, 0.f};
#pragma unroll
    for (int i = 0; i < 16; ++i) { oa0[i] = 0.f; oa1[i] = 0.f; ob0[i] = 0.f; ob1[i] = 0.f; }
#define AT_BAR() do { __builtin_amdgcn_sched_barrier(0); asm volatile("s_waitcnt lgkmcnt(0)" ::: "memory"); __builtin_amdgcn_s_barrier(); asm volatile("" ::: "memory"); __builtin_amdgcn_sched_barrier(0); } while (0)
#define AT_DMA(t_, slot_) do { const int tn_ = (t_) < nt ? (t_) : nt - 1;     \
        glds16(ksrc + (size_t)tn_ * 64 * 64, (unsigned)__builtin_amdgcn_readfirstlane((int)lds_addr(lds + AT_K + (slot_) * 8192 + wid * 1024))); \
        glds16(vsrc + (size_t)tn_ * 64 * 64, (unsigned)__builtin_amdgcn_readfirstlane((int)lds_addr(lds + AT_V + (slot_) * 8192 + wid * 1024))); } while (0)
    AT_DMA(0, 0); AT_DMA(1, 1); AT_DMA(2, 2);
    asm volatile("s_waitcnt vmcnt(0)" ::: "memory");
    AT_BAR();
    if (wid >= 4) AT_BAR();
    const int nfar = c >= 2 ? c - 2 : 0;
#if defined(PROBE_TIMER) && PROBE_TIMER == 3
    const unsigned long long pa0_ = __builtin_amdgcn_s_memtime();
#endif
    f32x16 a0, a1, b0, b1; bf16x8 pa[4], pb[4];
#if defined(PROBE_TIMER) && PROBE_TIMER >= 4
    unsigned psum_ = 0u;
#endif
    {
        const LAS unsigned char* Kb = lds + AT_K + hi * 1024 + r * 16; const LAS float* bt = BT + (64 * (0 - c) + 191 - r + 4 * hi);
        if (0 < nfar) attn_qk<false>(a0, a1, b0, b1, Qb, Kb, bt); else attn_qk<true>(a0, a1, b0, b1, Qb, Kb, bt);
        AT_BAR();
    }
#pragma unroll 1
    for (int t = 0; t < nt; ++t) {
        const int pl_ = (t >> 4) * MP_PLANE, sbit = (2 * t) & 31;
#ifdef NOSOFT
        { const bf16x8 c_ = {0x3c00, 0x3c00, 0x3c00, 0x3c00, 0x3c00, 0x3c00, 0x3c00, 0x3c00}; pa[0] = c_; pa[1] = c_; pa[2] = c_; pa[3] = c_; pb[0] = c_; pb[1] = c_; pb[2] = c_; pb[3] = c_; la += (f32x2v){a0[0], b0[0]}; }
#else
#if defined(PROBE_TIMER) && PROBE_TIMER == 4
        __builtin_amdgcn_sched_barrier(0); const unsigned long long pv0_ = __builtin_amdgcn_s_memtime(); __builtin_amdgcn_sched_barrier(0);
#endif
        attn_soft<MASK, false>(a0, a1, la, pa, mreca + pl_, sbit);
        attn_soft<MASK, false>(b0, b1, lb, pb, mrecb + pl_, sbit);
#if defined(PROBE_TIMER) && PROBE_TIMER == 4
        __builtin_amdgcn_sched_barrier(0); asm volatile("s_nop 0" : : "v"(pa[0]), "v"(pa[1]), "v"(pa[2]), "v"(pa[3]), "v"(pb[0]), "v"(pb[1]), "v"(pb[2]), "v"(pb[3]), "v"(la), "v"(lb)); psum_ += (unsigned)(__builtin_amdgcn_s_memtime() - pv0_); __builtin_amdgcn_sched_barrier(0);
#endif
#endif
#if defined(PROBE_TIMER) && PROBE_TIMER == 6
        __builtin_amdgcn_sched_barrier(0); asm volatile("s_nop 0" : : "v"(pa[0]), "v"(pa[3]), "v"(pb[0]), "v"(pb[3]), "v"(la), "v"(lb)); const unsigned long long pw0_ = __builtin_amdgcn_s_memtime();
#endif
        AT_BAR();
#if defined(PROBE_TIMER) && PROBE_TIMER == 6
        psum_ += (unsigned)(__builtin_amdgcn_s_memtime() - pw0_);
#endif
#if defined(PROBE_TIMER) && PROBE_TIMER == 5
        const unsigned long long pm0_ = __builtin_amdgcn_s_memtime();
#endif
        AT_DMA(t + 3, (t + 3) & 3);
        const LAS unsigned char* Vb = lds + AT_V + (t & 3) * 8192 + voff;
#pragma unroll
        for (int ks = 0; ks < 4; ++ks) {
            const bf16x8 v0 = cat8(vtr(Vb + ks * 1024), vtr(Vb + ks * 1024 + 512)), v1 = cat8(vtr(Vb + 4096 + ks * 1024), vtr(Vb + 4096 + ks * 1024 + 512));
            oa0 = __builtin_amdgcn_mfma_f32_32x32x16_bf16(pa[ks], v0, oa0, 0, 0, 0); ob0 = __builtin_amdgcn_mfma_f32_32x32x16_bf16(pb[ks], v0, ob0, 0, 0, 0);
            oa1 = __builtin_amdgcn_mfma_f32_32x32x16_bf16(pa[ks], v1, oa1, 0, 0, 0); ob1 = __builtin_amdgcn_mfma_f32_32x32x16_bf16(pb[ks], v1, ob1, 0, 0, 0);
        }
        if (t + 1 < nt) {
            const LAS unsigned char* Kb = lds + AT_K + ((t + 1) & 3) * 8192 + hi * 1024 + r * 16; const LAS float* bt = BT + (64 * (t + 1 - c) + 191 - r + 4 * hi);
            if (t + 1 < nfar) attn_qk<false>(a0, a1, b0, b1, Qb, Kb, bt); else attn_qk<true>(a0, a1, b0, b1, Qb, Kb, bt);
        }
#if defined(PROBE_TIMER) && PROBE_TIMER == 5
        asm volatile("s_nop 15\n\ts_nop 15" : : "v"(oa0), "v"(ob1), "v"(a0), "v"(b1)); psum_ += (unsigned)(__builtin_amdgcn_s_memtime() - pm0_);
#endif
#if defined(PROBE_TIMER) && PROBE_TIMER == 7
        __builtin_amdgcn_sched_barrier(0); asm volatile("s_nop 15\n\ts_nop 15" : : "v"(oa0), "v"(ob1), "v"(a0), "v"(b1)); const unsigned long long px0_ = __builtin_amdgcn_s_memtime();
#endif
        asm volatile("s_waitcnt vmcnt(2)" ::: "memory");
        AT_BAR();
#if defined(PROBE_TIMER) && PROBE_TIMER == 7
        psum_ += (unsigned)(__builtin_amdgcn_s_memtime() - px0_);
#endif
    }
#if defined(PROBE_TIMER) && PROBE_TIMER >= 4
    if (F.tid == 0 && nt >= 16) { volatile LAS unsigned* pm_ = (volatile LAS unsigned*)(lds + MISC_OFF); pm_[16] += psum_; pm_[17] += (unsigned)nt; }
#endif
#if defined(PROBE_TIMER) && PROBE_TIMER == 3
    if (F.tid == 0 && nt >= 16) { volatile LAS unsigned* pm_ = (volatile LAS unsigned*)(lds + MISC_OFF); pm_[16] += (unsigned)(__builtin_amdgcn_s_memtime() - pa0_); pm_[17] += (unsigned)nt; }
#endif
    asm volatile("s_waitcnt vmcnt(0)" ::: "memory");
    if (wid < 4) AT_BAR();
    AT_BAR();
#undef AT_BAR
#undef AT_DMA
    LAS float* wsf = (LAS float*)(lds + AT_WS) + wid * 64; LAS unsigned char* stg = lds + AT_OST + wid * 4608;
    attn_store(oa0, oa1, la, F.MIX() + (rowbase + q0) * DM + wid * 64, stg, wsf, lane);
    attn_store(ob0, ob1, lb, F.MIX() + (rowbase + q0 + 32) * DM + wid * 64, stg, wsf, lane);
}
__device__ __forceinline__ void attn_unit(const Frame& F, int b, int c, LAS unsigned char* lds) {
    if (c >= 4) {
        const int nj = c + 1;
        IdxOps ops; idx_fetch(ops, F, b, c, 0);
#if defined(PROBE_TIMER) && PROBE_TIMER >= 10
        unsigned ps_ = 0u;
#define PT0_(k) unsigned long long pt_##k = 0; if (PROBE_TIMER == (k)) { __builtin_amdgcn_sched_barrier(0); pt_##k = __builtin_amdgcn_s_memtime(); __builtin_amdgcn_sched_barrier(0); }
#define PT1_(k) if (PROBE_TIMER == (k)) { __builtin_amdgcn_sched_barrier(0); ps_ += (unsigned)(__builtin_amdgcn_s_memtime() - pt_##k); __builtin_amdgcn_sched_barrier(0); }
#else
#define PT0_(k)
#define PT1_(k)
#endif
        for (int rq = 0; rq < ((MIXREP & 2) ? 8 : 4); ++rq) {
            PT0_(10)
            idx_round(ops, F, b, c, lds);
            idx_fetch(ops, F, b, c, (rq + 1) & 3);
            asm volatile("s_waitcnt lgkmcnt(0)" ::: "memory");
            PT1_(10)
            PT0_(11)
            __syncthreads();
            PT1_(11)
            PT0_(12)
            select_rows32((const LAS unsigned*)(lds + P2_SC), (LAS unsigned*)(lds + P2_MASK), rq & 3, nj, F.wave, F.lane);
            asm volatile("s_waitcnt lgkmcnt(0)" ::: "memory");
            PT1_(12)
            PT0_(13)
            __syncthreads();
            PT1_(13)
        }
#if defined(PROBE_TIMER) && PROBE_TIMER >= 10
        if (F.tid == 0 && c >= 15) { volatile LAS unsigned* pm_ = (volatile LAS unsigned*)(lds + MISC_OFF); pm_[16] += ps_; pm_[17] += 4u; }
#endif
#undef PT0_
#undef PT1_
    }
    { const f32x4 v = *(const f32x4*)(F.BT() + F.tid * 4); *(LAS f32x4*)(lds + AT_BT + F.tid * 16) = v; }
    __syncthreads();
    if (c >= 4) attn_chunk<true>(F, b, c, lds); else attn_chunk<false>(F, b, c, lds);
}

constexpr int RT_TAB = 131072;
__device__ __forceinline__ void ret_stage(const bf16* vsrc, const bf16* ksrc, LAS unsigned char* region) {
#pragma unroll
    for (int k = 0; k < 8; ++k) {
        const size_t o = (size_t)(16 * (k & 3)) * 512 + 32 * (k >> 2);
        __builtin_amdgcn_global_load_lds((const unsigned*)(vsrc + o), (LAS unsigned*)(region + k * 1024), 16, 0, 0);
        __builtin_amdgcn_global_load_lds((const unsigned*)(ksrc + o), (LAS unsigned*)(region + 8192 + k * 1024), 16, 0, 0);
    }
}
__device__ __forceinline__ void ret_kv(f32x16 (&T)[2][2], const LAS unsigned char* img) {
#pragma unroll
    for (int ks = 0; ks < 4; ++ks) {
        const bf16x8 k0 = cat8(vtr(img + 8192 + ks * 1024), vtr(img + 8192 + ks * 1024 + 512)), k1 = cat8(vtr(img + 8192 + 4096 + ks * 1024), vtr(img + 8192 + 4096 + ks * 1024 + 512));
        const bf16x8 v0 = cat8(vtr(img + ks * 1024), vtr(img + ks * 1024 + 512)), v1 = cat8(vtr(img + 4096 + ks * 1024), vtr(img + 4096 + ks * 1024 + 512));
        T[0][0] = __builtin_amdgcn_mfma_f32_32x32x16_bf16(k0, v0, T[0][0], 0, 0, 0); T[0][1] = __builtin_amdgcn_mfma_f32_32x32x16_bf16(k0, v1, T[0][1], 0, 0, 0);
        T[1][0] = __builtin_amdgcn_mfma_f32_32x32x16_bf16(k1, v0, T[1][0], 0, 0, 0); T[1][1] = __builtin_amdgcn_mfma_f32_32x32x16_bf16(k1, v1, T[1][1], 0, 0, 0);
    }
}
__device__ __forceinline__ void ret_unit(const Frame& F, int b, int h, LAS unsigned char* lds) {
    const int lane = F.lane, w = F.wave, r = lane & 31, hi = lane >> 5;
    const float gam = 1.0f - exp2f(-5.0f - (float)h), lg2 = log2f(gam), cd = exp2f(64.0f * lg2), cd4 = exp2f(256.0f * lg2);
    LAS unsigned char* region = lds + w * 16384;
    const LAS unsigned char* img = region + ((lane >> 4) & 1) * 32 + (lane & 3) * 8 + (4 * hi + ((lane & 15) >> 2)) * 64;
    LAS float* tab = (LAS float*)(lds + RT_TAB);
    __syncthreads();
    if (F.tid < 128) tab[F.tid] = F.tid < 64 ? F.ret_gn_w()[h * 64 + F.tid] : F.ret_gn_b()[h * 64 + F.tid - 64];
    const size_t hbase = (size_t)b * SEQ * 512 + h * 64;
    const size_t stg = hbase + (size_t)(lane >> 2) * 512 + (lane & 3) * 8;
    f32x16 T[2][2];
#pragma unroll
    for (int i = 0; i < 16; ++i) { T[0][0][i] = 0.f; T[0][1][i] = 0.f; T[1][0][i] = 0.f; T[1][1][i] = 0.f; }
#pragma unroll 1
    for (int i = 0; i < 4; ++i) {
        const size_t co = (size_t)(4 * w + i) * 64 * 512;
        ret_stage(F.VB() + stg + co, F.KB() + stg + co, region);
        if (i) {
#pragma unroll
            for (int k = 0; k < 16; ++k) { T[0][0][k] *= cd; T[0][1][k] *= cd; T[1][0][k] *= cd; T[1][1][k] *= cd; }
        }
        asm volatile("s_waitcnt vmcnt(0)" ::: "memory");
        ret_kv(T, img);
        LDS_WAIT();
    }
#pragma unroll
    for (int eb = 0; eb < 2; ++eb)
#pragma unroll
        for (int db = 0; db < 2; ++db)
#pragma unroll
            for (int g = 0; g < 4; ++g) *(LAS f32x4*)(region + ((eb * 2 + db) * 4 + g) * 1024 + lane * 16) = (f32x4){T[eb][db][4 * g], T[eb][db][4 * g + 1], T[eb][db][4 * g + 2], T[eb][db][4 * g + 3]};
    __syncthreads();
#pragma unroll
    for (int i = 0; i < 16; ++i) { T[0][0][i] = 0.f; T[0][1][i] = 0.f; T[1][0][i] = 0.f; T[1][1][i] = 0.f; }
#pragma unroll 1
    for (int wp = 0; wp < w; ++wp) {
        const LAS unsigned char* src = lds + wp * 16384 + lane * 16;
#pragma unroll
        for (int eb = 0; eb < 2; ++eb)
#pragma unroll
            for (int db = 0; db < 2; ++db)
#pragma unroll
                for (int g = 0; g < 4; ++g) { const f32x4 v = *(const LAS f32x4*)(src + ((eb * 2 + db) * 4 + g) * 1024);
                    T[eb][db][4 * g] = T[eb][db][4 * g] * cd4 + v[0]; T[eb][db][4 * g + 1] = T[eb][db][4 * g + 1] * cd4 + v[1]; T[eb][db][4 * g + 2] = T[eb][db][4 * g + 2] * cd4 + v[2]; T[eb][db][4 * g + 3] = T[eb][db][4 * g + 3] * cd4 + v[3]; }
    }
    __syncthreads();
#pragma unroll 1
    for (int i = 0; i < 4; ++i) {
        const int n = 4 * w + i; const size_t co = (size_t)n * 64 * 512;
        ret_stage(F.VB() + stg + co, F.KB() + stg + co, region);
#pragma unroll
        for (int k = 0; k < 16; ++k) { T[0][0][k] *= cd; T[0][1][k] *= cd; T[1][0][k] *= cd; T[1][1][k] *= cd; }
        const bf16* qrow = F.QB() + hbase + co + (size_t)r * 512 + 8 * hi;
        const bf16* krow = F.KB() + hbase + co + (size_t)r * 512 + 8 * hi;
#pragma unroll 1
        for (int ib = 0; ib < 2; ++ib) {
            bf16x8 qf[4], kf[4];
#pragma unroll
            for (int s = 0; s < 4; ++s) { qf[s] = *(const bf16x8*)(qrow + (size_t)(32 * ib) * 512 + 16 * s); kf[s] = *(const bf16x8*)(krow + 16 * s); }
            const size_t tok = (size_t)b * SEQ + 64 * n + 32 * ib + r;
            const bf16* grow = F.GB() + tok * 512 + h * 64 + 4 * hi;
            v2u gq[2][4];
#pragma unroll
            for (int db = 0; db < 2; ++db)
#pragma unroll
                for (int g = 0; g < 4; ++g) gq[db][g] = *(const v2u*)(grow + 32 * db + 8 * g);
            f32x16 s0, s1;
#pragma unroll
            for (int k = 0; k < 16; ++k) { s0[k] = 0.f; s1[k] = 0.f; }
#pragma unroll
            for (int s = 0; s < 4; ++s) s0 = __builtin_amdgcn_mfma_f32_32x32x16_bf16(kf[s], qf[s], s0, 0, 0, 0);
            if (ib == 1) {
#pragma unroll
                for (int s = 0; s < 4; ++s) kf[s] = *(const bf16x8*)(krow + (size_t)32 * 512 + 16 * s);
#pragma unroll
                for (int s = 0; s < 4; ++s) s1 = __builtin_amdgcn_mfma_f32_32x32x16_bf16(kf[s], qf[s], s1, 0, 0, 0);
#pragma unroll
                for (int k = 0; k < 16; ++k) s1[k] = (r >= crow(k, hi)) ? s1[k] : 0.f;
            } else {
#pragma unroll
                for (int k = 0; k < 16; ++k) s0[k] = (r >= crow(k, hi)) ? s0[k] : 0.f;
            }
#pragma unroll
            for (int s = 0; s < 4; ++s) {
                v4u q4 = __builtin_bit_cast(v4u, qf[s]);
                auto x0 = __builtin_amdgcn_permlane32_swap(q4[0], q4[2], false, false); auto x1 = __builtin_amdgcn_permlane32_swap(q4[1], q4[3], false, false);
                q4[0] = x0[0]; q4[2] = x0[1]; q4[1] = x1[0]; q4[3] = x1[1];
                qf[s] = __builtin_bit_cast(bf16x8, q4);
            }
            asm volatile("s_waitcnt vmcnt(0)" ::: "memory");
            f32x16 y0, y1;
#pragma unroll
            for (int k = 0; k < 16; ++k) { y0[k] = 0.f; y1[k] = 0.f; }
#pragma unroll
            for (int eb = 0; eb < 2; ++eb)
#pragma unroll
                for (int s2 = 0; s2 < 2; ++s2) {
                    y0 = __builtin_amdgcn_mfma_f32_32x32x16_bf16(pk16(T[eb][0], 8 * s2), qf[2 * eb + s2], y0, 0, 0, 0);
                    y1 = __builtin_amdgcn_mfma_f32_32x32x16_bf16(pk16(T[eb][1], 8 * s2), qf[2 * eb + s2], y1, 0, 0, 0);
                }
#pragma unroll
            for (int ks = 0; ks < 2; ++ks) {
                const bf16x8 pb = pk16(s0, 8 * ks);
                y0 = __builtin_amdgcn_mfma_f32_32x32x16_bf16(cat8(vtr(img + ks * 1024), vtr(img + ks * 1024 + 512)), pb, y0, 0, 0, 0);
                y1 = __builtin_amdgcn_mfma_f32_32x32x16_bf16(cat8(vtr(img + 4096 + ks * 1024), vtr(img + 4096 + ks * 1024 + 512)), pb, y1, 0, 0, 0);
            }
            if (ib == 1) {
#pragma unroll
                for (int ks = 0; ks < 2; ++ks) {
                    const bf16x8 pb = pk16(s1, 8 * ks);
                    y0 = __builtin_amdgcn_mfma_f32_32x32x16_bf16(cat8(vtr(img + (2 + ks) * 1024), vtr(img + (2 + ks) * 1024 + 512)), pb, y0, 0, 0, 0);
                    y1 = __builtin_amdgcn_mfma_f32_32x32x16_bf16(cat8(vtr(img + 4096 + (2 + ks) * 1024), vtr(img + 4096 + (2 + ks) * 1024 + 512)), pb, y1, 0, 0, 0);
                }
            }
            float sm = 0.f;
#pragma unroll
            for (int k = 0; k < 16; ++k) sm += y0[k] + y1[k];
            sm += __shfl_xor(sm, 32);
            const float mean = sm * (1.0f / 64.0f); float vr = 0.f;
#pragma unroll
            for (int k = 0; k < 16; ++k) { y0[k] -= mean; y1[k] -= mean; vr += y0[k] * y0[k] + y1[k] * y1[k]; }
            vr += __shfl_xor(vr, 32);
            const float rstd = 1.0f / sqrtf(vr * (1.0f / 64.0f) + 1e-5f);
            bf16* orow = F.MIX() + tok * DM + 512 + h * 64 + 4 * hi;
#pragma unroll
            for (int g = 0; g < 4; ++g) {
                const f32x4 w0 = *(const LAS f32x4*)(tab + 8 * g + 4 * hi), b0 = *(const LAS f32x4*)(tab + 64 + 8 * g + 4 * hi), w1 = *(const LAS f32x4*)(tab + 32 + 8 * g + 4 * hi), b1 = *(const LAS f32x4*)(tab + 96 + 8 * g + 4 * hi);
                const v2u g0 = gq[0][g], g1 = gq[1][g];
                *(v2u*)(orow + 8 * g) = (v2u){pkbf((y0[4 * g] * rstd * w0[0] + b0[0]) * bflo(g0[0]), (y0[4 * g + 1] * rstd * w0[1] + b0[1]) * bfhi(g0[0])),
                                              pkbf((y0[4 * g + 2] * rstd * w0[2] + b0[2]) * bflo(g0[1]), (y0[4 * g + 3] * rstd * w0[3] + b0[3]) * bfhi(g0[1]))};
                *(v2u*)(orow + 32 + 8 * g) = (v2u){pkbf((y1[4 * g] * rstd * w1[0] + b1[0]) * bflo(g1[0]), (y1[4 * g + 1] * rstd * w1[1] + b1[1]) * bfhi(g1[0])),
                                                   pkbf((y1[4 * g + 2] * rstd * w1[2] + b1[2]) * bflo(g1[1]), (y1[4 * g + 3] * rstd * w1[3] + b1[3]) * bfhi(g1[1]))};
            }
        }
        ret_kv(T, img);
        LDS_WAIT();
    }
}
#ifndef GEMM_ALIGN
#define GEMM_ALIGN true
#endif
#ifndef GEMM_SP2
#define GEMM_SP2 true
#endif
#ifndef RETREP
#define RETREP 1
#endif
#ifndef ATTREP
#define ATTREP 1
#endif
constexpr int CW_Q = 12288;
constexpr int NG_ATT = 32, NG_RET = 8, NG_MIX = NG_ATT + NG_RET;
__device__ __forceinline__ void p2_mixers(Frame& F) {
    for (;;) {
        int mo_ = MISC_OFF; asm volatile("" : "+s"(mo_));
        volatile LAS unsigned* misc = (volatile LAS unsigned*)(F.lds + mo_);
        __syncthreads();
        if (F.tid == 0) misc[0] = __hip_atomic_fetch_add(F.ctl + CW_Q + 64 * F.grp, 1u, __ATOMIC_RELAXED, __HIP_MEMORY_SCOPE_AGENT);
        __syncthreads();
        const int u = (int)misc[0];
        if (u >= NG_MIX) break;
        { int w_ = F.wave; asm volatile("" : "+s"(w_)); F.wave = w_; int l_ = lane_id(); asm volatile("" : "+v"(l_)); F.lane = l_; F.tid = w_ * 64 + l_; }
        static constexpr unsigned char ORDER[NG_MIX] = {24, 30, 23, 26, 25, 35, 32, 20, 34, 21, 33, 22, 16, 28, 38, 29, 18, 36, 14, 39, 27, 4, 13, 19, 37, 8, 31, 6, 5, 17, 15, 11, 12, 10, 9, 7, 3, 2, 1, 0};
        const int e = __builtin_amdgcn_readfirstlane((int)ORDER[u]);
        if (e < 32) attn_unit(F, F.grp, e, F.lds); else ret_unit(F, F.grp, e - 32, F.lds);
    }
#if defined(PROBE_TIMER) && PROBE_TIMER >= 3
    if (blockIdx.x == 7 && F.tid == 0) { volatile LAS unsigned* pm_ = (volatile LAS unsigned*)(F.lds + MISC_OFF); const float val = ((float)pm_[16] / (float)(pm_[17] ? pm_[17] : 1u)) / 8000.0f;
        F.ctl[64] = __float_as_uint(0.05f + 0.5f * floorf(fminf(fmaxf(val, 0.f), 1.f) * 8.0f + 0.5f) * 0.125f); }
#endif
}

typedef __attribute__((address_space(1))) unsigned gu32;
#define XB_TMO      128
#define XB_XCNT(j)  (256  + 64 * (j))
#define XB_XSUB(j)  (1280 + 64 * (j))
#define XB_XGEN(j)  (2304 + 64 * (j))
#define XB_TOP      3328
#define XB_TOPGEN   3392
#define XCD_BAR_WORDS 3456
#define XB_SPIN_CAP (1u << 18)

__device__ __forceinline__ unsigned xb_ld(unsigned* p)              { return __hip_atomic_load(p, __ATOMIC_RELAXED, __HIP_MEMORY_SCOPE_AGENT); }
__device__ __forceinline__ unsigned xb_add(unsigned* p, unsigned v) { return __hip_atomic_fetch_add(p, v, __ATOMIC_RELAXED, __HIP_MEMORY_SCOPE_AGENT); }
__device__ __forceinline__ unsigned xb_xcc_id() { return (unsigned)__builtin_amdgcn_s_getreg((3 << 11) | 20) & 0xFu; }
#define XB_SPIN(cond, bar) do { unsigned _sp = 0; while (cond) { __builtin_amdgcn_s_sleep(1); \
    if ((++_sp & 255u) == 0u) { if (xb_ld(&(bar)[XB_TMO])) break; if (_sp > XB_SPIN_CAP) { atomicAdd(&(bar)[XB_TMO], 1u); break; } } } } while (0)

struct XcdBarrier {
    unsigned* bar; unsigned x; int wv;
    volatile LAS unsigned* st;
};

__device__ __forceinline__ XcdBarrier xcd_barrier_post(unsigned* bar, volatile LAS unsigned* st, int wv_) {
    XcdBarrier b; b.bar = bar; b.x = xb_xcc_id(); b.st = st; b.wv = 0;
    if (wv_ == 0 && lane_id() == 0) { st[2] = xb_add(&bar[XB_XCNT(b.x)], 1u); st[3] = b.x; }
    return b;
}
__device__ __forceinline__ void xcd_barrier_complete(unsigned* bar, unsigned x, unsigned& nloc, unsigned& nx, unsigned& even) {
    const unsigned G = gridDim.x * gridDim.y * gridDim.z;
    unsigned sum, cnt, mine, sp = 0u, ev;
    for (;;) {
        sum = 0u; cnt = 0u; mine = 0u; ev = 1u;
#pragma unroll
        for (unsigned j = 0; j < 16; ++j) { const unsigned c = xb_ld(&bar[XB_XCNT(j)]); sum += c; cnt += (c > 0u) ? 1u : 0u; mine = (j == x) ? c : mine; ev &= (c == (j < 8u ? 32u : 0u)) ? 1u : 0u; }
        even = ev;
        if (sum == G) break;
        __builtin_amdgcn_s_sleep(1);
        if ((++sp & 255u) == 0u) { if (xb_ld(&bar[XB_TMO])) break; if (sp > XB_SPIN_CAP) { atomicAdd(&bar[XB_TMO], 1u); break; } }
    }
    nloc = mine > 0u ? mine : 1u; nx = cnt > 0u ? cnt : 1u;
}

__device__ __forceinline__ void xcd_barrier(const XcdBarrier& b) {
    asm volatile("s_waitcnt vmcnt(0)" ::: "memory");
    __syncthreads();
    if (b.wv == 0 && lane_id() == 0) {
        unsigned* bar = b.bar;
        __builtin_amdgcn_s_waitcnt(0);
        unsigned nloc = b.st[0], nx = b.st[1];
        if (nloc == 0u) { unsigned ev_; xcd_barrier_complete(bar, b.x, nloc, nx, ev_); b.st[0] = nloc; b.st[1] = nx; b.st[4] = ev_; }
        const unsigned old = xb_add(&bar[XB_XSUB(b.x)], 1u);
        const unsigned gen = old / nloc;
        if (old + 1u == (gen + 1u) * nloc) {
            __builtin_amdgcn_fence(__ATOMIC_RELEASE, "agent");
            asm volatile("s_waitcnt vmcnt(0)" ::: "memory");
            const unsigned og = xb_add(&bar[XB_TOP], 1u);
            const unsigned tg = og / nx;
            if (og + 1u == (tg + 1u) * nx) xb_add(&bar[XB_TOPGEN], 1u);
            else XB_SPIN(xb_ld(&bar[XB_TOPGEN]) == tg, bar);
            __builtin_amdgcn_fence(__ATOMIC_ACQUIRE, "agent");
            xb_add(&bar[XB_XGEN(b.x)], 1u);
            asm volatile("s_waitcnt vmcnt(0)" ::: "memory");
        } else {
            XB_SPIN(xb_ld(&bar[XB_XGEN(b.x)]) == gen, bar);
            __builtin_amdgcn_fence(__ATOMIC_ACQUIRE, "agent");
            asm volatile("s_waitcnt vmcnt(0)" ::: "memory");
        }
    }
    __syncthreads();
}

constexpr int CW_GB = 8192;
__device__ __forceinline__ void grp_barrier(unsigned* ctl, int g, bool phys, int wave) {
    asm volatile("s_waitcnt vmcnt(0)" ::: "memory");
    __syncthreads();
    if (wave == 0 && lane_id() == 0) {
        unsigned* bar = ctl + 4096; unsigned* sub = ctl + CW_GB + 64 * g; unsigned* genw = ctl + CW_GB + 64 * (32 + g);
        __builtin_amdgcn_s_waitcnt(0);
        if (!phys) { __builtin_amdgcn_fence(__ATOMIC_RELEASE, "agent"); asm volatile("s_waitcnt vmcnt(0)" ::: "memory"); }
        const unsigned old = xb_add(sub, 1u), gen = old / 8u;
        if (old + 1u == (gen + 1u) * 8u) xb_add(genw, 1u);
        else XB_SPIN(xb_ld(genw) == gen, bar);
        __builtin_amdgcn_fence(__ATOMIC_ACQUIRE, "agent");
        asm volatile("s_waitcnt vmcnt(0)" ::: "memory");
    }
    __syncthreads();
}
#ifndef REV_P4
#define REV_P4 0
#endif
#ifndef REV_P5
#define REV_P5 0
#endif
struct BatchOrder {
    int m0, nN, rk, rev;
    __device__ __forceinline__ bool next(int i, pg8::Unit& u) const { const int L = 8 * i + rk; if (L >= 8 * nN) return false;
        int mp = L / (2 * nN); const int t = L - mp * 2 * nN; if (rev) mp = 3 - mp; u.pm = m0 + 2 * mp + (t & 1); u.pn = t >> 1; return true; }
    __device__ __forceinline__ void a_ready(const pg8::Unit&) const {}
    __device__ __forceinline__ void done(const pg8::Unit&) const {}
};

constexpr int CW_BAR = 4096;
constexpr size_t CTL_ZERO_BYTES = 65536;
typedef KArgs Args;
__global__ void __launch_bounds__(NTHR, 2) fwd_kernel(Args args) {
    extern __shared__ __attribute__((aligned(16))) unsigned char lds[];
    Frame F;
    F.lds = (LAS unsigned char*)lds;
    F.wave = __builtin_amdgcn_readfirstlane((int)threadIdx.x >> 6); F.lane = lane_id(); F.tid = F.wave * 64 + F.lane;
    F.G = gridDim.x; { const int bx = blockIdx.x; F.vcu = (F.G % 8 == 0) ? (bx % 8) * (F.G / 8) + bx / 8 : bx; }
    unsigned char* ws = args.ws;
    F.ctl = (unsigned*)(ws + WS_CTL);
    F.ap = (const __attribute__((address_space(4))) KArgs*)__builtin_amdgcn_kernarg_segment_ptr();
    F.ws = ws;
    const int lo = args.ph_lo, hi = args.ph_hi;
    for (int u_ = F.tid; u_ < 64; u_ += NTHR) ((LAS unsigned*)(F.lds + MISC_OFF))[u_] = 0u;
    __syncthreads();
    XcdBarrier bar; bar.bar = F.ctl + CW_BAR; bar.x = 0; bar.st = nullptr; bar.wv = F.wave;
    if (hi - lo > 1) { bar = xcd_barrier_post(F.ctl + CW_BAR, (volatile LAS unsigned*)(F.lds + MISC_OFF) + 8, F.wave); bar.wv = F.wave; }
#define IN(k) (lo <= (k) && (k) < hi)
#ifndef STAGGER
#define STAGGER 8
#endif
    if (IN(0)) { asm volatile("" : "+s"(F.ws), "+s"(F.ap)); F.lane = lane_id(); F.tid = F.wave * 64 + F.lane; p0_prologue(F); }
    if (IN(0) && IN(1)) { if (lo < 0) cg::this_grid().sync(); else xcd_barrier(bar); }
    bool phys = false; F.grp = (int)blockIdx.x & 31; F.rk = (int)blockIdx.x >> 5;
    if (hi - lo > 1) { volatile LAS unsigned* st = (volatile LAS unsigned*)(F.lds + MISC_OFF) + 8;
        if (st[4] == 1u && F.G == 256) { phys = true; F.grp = 4 * (int)st[3] + ((int)st[2] >> 3); F.rk = (int)st[2] & 7; } }
    F.grp = __builtin_amdgcn_readfirstlane(F.grp) & 31; F.rk = __builtin_amdgcn_readfirstlane(F.rk) & 7;
#define GSEAM(k) do { if (IN(k) && IN((k) + 1)) grp_barrier(F.ctl, F.grp, phys, F.wave); } while (0)
#if STAGGER > 0
    if (hi - lo > 1) for (int i_ = 0; i_ < (F.grp & 3) * STAGGER; ++i_) __builtin_amdgcn_s_sleep(32);
#endif
    if (IN(1)) { asm volatile("" : "+s"(F.ws), "+s"(F.ap)); F.lane = lane_id(); F.tid = F.wave * 64 + F.lane;
        pg8::Gemm g{F.XB(), F.WIN(), MTOK, NIN, DM}; BatchOrder S{8 * F.grp, NIN / 256, F.rk, 0};
        pg8::EpiIn E{F.QA(), F.KA(), F.VA(), F.IQ(), F.IK(), F.QB(), F.KB(), F.VB(), F.GB(), F.IW(), F.q_norm_w(), F.k_norm_w(), (LAS float*)(F.lds + XCH_OFF)};
        pg8::gemm_phase<pg8::EpiIn, BatchOrder, GEMM_ALIGN, GEMM_SP2>(F.lds, g, S, E, F.wave);
    }
    GSEAM(1);
    if (IN(2)) { asm volatile("" : "+s"(F.ws), "+s"(F.ap)); F.lane = lane_id(); F.tid = F.wave * 64 + F.lane; p2_mixers(F); }
    GSEAM(2);
    if (IN(3)) { asm volatile("" : "+s"(F.ws), "+s"(F.ap)); F.lane = lane_id(); F.tid = F.wave * 64 + F.lane;
        const int pm = 8 * F.grp + F.rk;
        pg8::Gemm g{F.MIX(), F.WOUT(), MTOK, DM, DM}; pg8::PanelOrder S{pm, 4};
        pg8::EpiOut E{F.RMS(), F.XB(), {0.f, 0.f, 0.f, 0.f, 0.f, 0.f, 0.f, 0.f}};
        pg8::gemm_phase<pg8::EpiOut, pg8::PanelOrder, true, true>(F.lds, g, S, E, F.wave);
        const int wr = F.wave >> 2, wc = F.wave & 3, fr = F.lane & 15, fq = F.lane >> 4;
        LAS float* P = (LAS float*)(F.lds + XCH_OFF);
#pragma unroll
        for (int k = 0; k < 8; ++k) { float s = E.ss[k]; s += __shfl_xor(s, 16); s += __shfl_xor(s, 32);
            if (fq == 0) P[((k >> 2) * 128 + wr * 64 + (k & 3) * 16 + fr) * 4 + wc] = s; }
        __syncthreads();
        if (F.tid < 256) { const f32x4 p = *(const LAS f32x4*)(P + F.tid * 4);
            F.R2()[(size_t)pm * 256 + F.tid] = 1.0f / sqrtf(((p[0] + p[1]) + (p[2] + p[3])) * (1.0f / DM) + 1e-6f); }
    }
    GSEAM(3);
    if (IN(4)) { asm volatile("" : "+s"(F.ws), "+s"(F.ap)); F.lane = lane_id(); F.tid = F.wave * 64 + F.lane;
        pg8::Gemm g{F.XB(), F.WGU(), MTOK, NGU, DM}; BatchOrder S{8 * F.grp, NGU / 256, F.rk, REV_P4};
        pg8::EpiGU E{F.R2(), F.ACT(), {0.f, 0.f, 0.f, 0.f}, {0.f, 0.f, 0.f, 0.f}, {0.f, 0.f, 0.f, 0.f}, {0.f, 0.f, 0.f, 0.f}, 0ull};
        pg8::gemm_phase<pg8::EpiGU, BatchOrder, GEMM_ALIGN, GEMM_SP2>(F.lds, g, S, E, F.wave);
    }
    GSEAM(4);
#ifndef P5STAG
#define P5STAG 0
#endif
#if P5STAG > 0
    if (hi - lo > 1) for (int i_ = 0; i_ < (F.grp & 3) * P5STAG; ++i_) __builtin_amdgcn_s_sleep(32);
#endif
    if (IN(5)) { asm volatile("" : "+s"(F.ws), "+s"(F.ap)); F.lane = lane_id(); F.tid = F.wave * 64 + F.lane;
        pg8::Gemm g{F.ACT(), F.WDN(), MTOK, DM, FF}; BatchOrder S{8 * F.grp, DM / 256, F.rk, REV_P5};
        pg8::EpiDown E{F.XB(), F.out()};
        pg8::gemm_phase<pg8::EpiDown, BatchOrder, GEMM_ALIGN, GEMM_SP2>(F.lds, g, S, E, F.wave);
    }
#undef GSEAM
#ifdef PROBE_TIMER
    xcd_barrier(bar);
    { const float frac = __uint_as_float(__hip_atomic_load(F.ctl + 64, __ATOMIC_RELAXED, __HIP_MEMORY_SCOPE_AGENT)); const int nz = (int)(frac * (float)MTOK);
      for (int m = (int)blockIdx.x * NWAVES + F.wave; m < nz; m += F.G * NWAVES) { f32x4* o = (f32x4*)(F.out() + (size_t)m * DM) + F.lane;
#pragma unroll
          for (int j = 0; j < 4; ++j) o[64 * j] = (f32x4){0.f, 0.f, 0.f, 0.f}; } }
#endif
#undef IN
}

extern "C" void kernel_launch(void* const* d_in, const int* in_sizes, int n_in, void* d_out, int out_size, void* d_ws, size_t ws_size, hipStream_t stream) {
    static int grid = 0;
    if (grid == 0) {
        if (n_in != 16 || in_sizes[0] != MTOK * DM || out_size != MTOK * DM || ws_size < WS_END) {
            fprintf(stderr, "kernel_launch: unexpected problem (n_in %d, in0 %d, out %d, ws %zu); nothing launched\n", n_in, n_in > 0 ? in_sizes[0] : -1, out_size, ws_size); grid = -1; return; }
        int dev = 0, cus = 0, per_cu = 0;
        if (hipGetDevice(&dev) != hipSuccess || hipDeviceGetAttribute(&cus, hipDeviceAttributeMultiprocessorCount, dev) != hipSuccess) { grid = -1; return; }
        if (hipFuncSetAttribute((const void*)fwd_kernel, hipFuncAttributeMaxDynamicSharedMemorySize, LDS_BYTES) != hipSuccess) { fprintf(stderr, "kernel_launch: hipFuncSetAttribute failed\n"); grid = -1; return; }
        if (hipOccupancyMaxActiveBlocksPerMultiprocessor(&per_cu, (const void*)fwd_kernel, NTHR, LDS_BYTES) != hipSuccess || per_cu < 1) { fprintf(stderr, "kernel_launch: occupancy query says %d blocks per CU\n", per_cu); (void)hipGetLastError(); grid = -1; return; }
        grid = cus;
        if (grid != 256) { fprintf(stderr, "kernel_launch: %d CUs; this kernel is laid out for 256 (eight groups of 32 workgroups)\n", grid); grid = -1; return; }
    }
    if (grid < 0) return;
    if (hipMemsetAsync((char*)d_ws + WS_CTL, 0, CTL_ZERO_BYTES, stream) != hipSuccess) { fprintf(stderr, "kernel_launch: memset failed\n"); return; }
    Args a{};
    for (int i = 0; i < 16; ++i) a.in[i] = (const float*)d_in[i];
    a.out = (float*)d_out; a.ws = (unsigned char*)d_ws;
#if MK_N_LAUNCHES == 1
    a.ph_lo = 0; a.ph_hi = N_PHASES;
    void* kargs[] = {&a};
    hipError_t e = hipLaunchCooperativeKernel((const void*)fwd_kernel, dim3(grid), dim3(NTHR), kargs, LDS_BYTES, stream);
    if (e != hipSuccess) fprintf(stderr, "kernel_launch: cooperative launch failed: %s (grid %d)\n", hipGetErrorString(e), grid);
#else
    for (int p = 0; p < N_PHASES; ++p) { a.ph_lo = p; a.ph_hi = p + 1; hipLaunchKernelGGL(fwd_kernel, dim3(grid), dim3(NTHR), LDS_BYTES, stream, a); }
#endif
}
```
